# Optimizing an MI355X kernel written in HIP

```python
import math
import jax, jax.numpy as jnp
from jax import lax
import numpy as np

D_MODEL = 1024
BATCH = 8
SEQ = 2048
DEPTH = 1

PLE_DIM = 256
EPS = 1e-6
ROPE_THETA = 10000.0
MOBA_HEADS = 8
MOBA_HEAD_DIM = 64
MOBA_BLOCK = 256
MOBA_TOPK = 3
MOBA_Q_CHUNK = 16
MOBA_WIDTH = MOBA_HEADS * MOBA_HEAD_DIM
MLA_HEADS = 8
MLA_Q_LORA = 256
MLA_KV_LORA = 128
MLA_NOPE_DIM = 64
MLA_ROPE_DIM = 32
MLA_V_DIM = 64
MLA_QK_DIM = MLA_NOPE_DIM + MLA_ROPE_DIM
MLA_WIDTH = MLA_HEADS * MLA_V_DIM
MLA_Q_BLOCK = 128
N_EXPERTS = 32
TOP_K = 4
D_EXPERT = 1024
SWIGLU_LIMIT = 7.0
SWIGLU_ALPHA = 1.702
EXPERT_ROW_BLOCK = 128
IN_SPLITS = (MOBA_WIDTH, MOBA_WIDTH, MOBA_WIDTH, MLA_Q_LORA, MLA_KV_LORA, MLA_ROPE_DIM, D_MODEL, D_MODEL)
D_IN = 3 * MOBA_WIDTH + MLA_Q_LORA + MLA_KV_LORA + MLA_ROPE_DIM + 2 * D_MODEL

kernel_name = "hybrid_moba_mla_moe_ple_block"


def rmsnorm(x, g):
    xf = x.astype(jnp.float32)
    y = xf * lax.rsqrt(jnp.mean(xf * xf, axis=-1, keepdims=True) + EPS)
    return (y * g.astype(jnp.float32)).astype(x.dtype)


def apply_rope(x):
    s, dim = x.shape[-2], x.shape[-1]
    half = dim // 2
    inv_freq = ROPE_THETA ** (-(jnp.arange(half, dtype=jnp.float32) / half))
    ang = jnp.arange(s, dtype=jnp.float32)[:, None] * inv_freq[None, :]
    cos, sin = jnp.cos(ang), jnp.sin(ang)
    xf = x.astype(jnp.float32)
    x1, x2 = xf[..., :half], xf[..., half:]
    return jnp.concatenate([x1 * cos - x2 * sin, x2 * cos + x1 * sin], axis=-1).astype(x.dtype)


def moba_attention(q, k, v):
    b, h, s, hd = q.shape
    nb = -(-s // MOBA_BLOCK)
    s_pad = nb * MOBA_BLOCK
    padcfg = ((0, 0), (0, 0), (0, s_pad - s), (0, 0))
    q, k, v = jnp.pad(q, padcfg), jnp.pad(k, padcfg), jnp.pad(v, padcfg)
    scale = hd ** -0.5
    q_blk = q.reshape(b, h, nb, MOBA_BLOCK, hd)
    k_blk = k.reshape(b, h, nb, MOBA_BLOCK, hd)
    v_blk = v.reshape(b, h, nb, MOBA_BLOCK, hd)
    k_mean = jnp.mean(k_blk.astype(jnp.float32), axis=3)
    gate = jnp.einsum('bhsd,bhnd->bhsn', q.astype(jnp.float32), k_mean)
    cur_blk = jnp.arange(s_pad) // MOBA_BLOCK
    is_past = jnp.arange(nb)[None, :] < cur_blk[:, None]
    gate = jnp.where(is_past, gate, -jnp.inf)
    n_sel = min(MOBA_TOPK, nb)
    _, sel = lax.top_k(gate, n_sel)
    sel_valid = sel < cur_blk[:, None]
    s_own = jnp.einsum('bhnqd,bhnkd->bhnqk', q_blk, k_blk) * scale
    causal = jnp.tril(jnp.ones((MOBA_BLOCK, MOBA_BLOCK), dtype=bool))
    s_own = jnp.where(causal, s_own, -jnp.inf).reshape(b, h, s_pad, MOBA_BLOCK)
    gather_blocks = jax.vmap(jax.vmap(lambda blocks, ix: blocks[ix]))

    def chunk(ci):
        start = ci * MOBA_Q_CHUNK
        qc = lax.dynamic_slice_in_dim(q, start, MOBA_Q_CHUNK, axis=2)
        ix = lax.dynamic_slice_in_dim(sel, start, MOBA_Q_CHUNK, axis=2)
        ok = lax.dynamic_slice_in_dim(sel_valid, start, MOBA_Q_CHUNK, axis=2)
        so = lax.dynamic_slice_in_dim(s_own, start, MOBA_Q_CHUNK, axis=2)
        v_own = lax.dynamic_index_in_dim(v_blk, start // MOBA_BLOCK, axis=2, keepdims=False)
        k_sel = gather_blocks(k_blk, ix)
        v_sel = gather_blocks(v_blk, ix)
        ss = jnp.einsum('bhqd,bhqjkd->bhqjk', qc, k_sel) * scale
        ss = jnp.where(ok[..., None], ss, -jnp.inf)
        logits = jnp.concatenate([so, ss.reshape(b, h, MOBA_Q_CHUNK, n_sel * MOBA_BLOCK)], axis=-1)
        probs = jax.nn.softmax(logits.astype(jnp.float32), axis=-1).astype(v.dtype)
        p_own = probs[..., :MOBA_BLOCK]
        p_sel = probs[..., MOBA_BLOCK:].reshape(b, h, MOBA_Q_CHUNK, n_sel, MOBA_BLOCK)
        return (jnp.einsum('bhqk,bhkd->bhqd', p_own, v_own)
                + jnp.einsum('bhqjk,bhqjkd->bhqd', p_sel, v_sel))

    out = lax.map(chunk, jnp.arange(s_pad // MOBA_Q_CHUNK))
    out = jnp.moveaxis(out, 0, 2).reshape(b, h, s_pad, hd)
    return out[:, :, :s]


def causal_attention(q, k, v):
    b, h, s, dq = q.shape
    scale = dq ** -0.5
    kpos = jnp.arange(s)

    def blk(ci):
        start = ci * MLA_Q_BLOCK
        qc = lax.dynamic_slice_in_dim(q, start, MLA_Q_BLOCK, axis=2)
        sc = jnp.einsum('bhqd,bhkd->bhqk', qc, k).astype(jnp.float32) * scale
        qpos = start + jnp.arange(MLA_Q_BLOCK)
        sc = jnp.where(kpos[None, :] <= qpos[:, None], sc, -jnp.inf)
        pr = jax.nn.softmax(sc, axis=-1).astype(v.dtype)
        return jnp.einsum('bhqk,bhkd->bhqd', pr, v)

    out = lax.map(blk, jnp.arange(s // MLA_Q_BLOCK))
    return jnp.moveaxis(out, 0, 2).reshape(b, h, s, v.shape[-1])


def routed_experts(h, w_router, b_router, w_gate_up, b_gate_up, w_down, b_down):
    b, s, d = h.shape
    n = b * s
    hf = h.reshape(n, d)
    logits = (hf @ w_router).astype(jnp.float32) + b_router.astype(jnp.float32)
    top_vals, top_idx = lax.top_k(logits, TOP_K)
    top_w = jax.nn.softmax(top_vals, axis=-1)
    nk = n * TOP_K
    m = EXPERT_ROW_BLOCK
    flat_e = top_idx.reshape(nk)
    flat_t = jnp.arange(nk, dtype=jnp.int32) // TOP_K
    flat_w = top_w.reshape(nk)
    order = jnp.argsort(flat_e)
    se = flat_e[order]
    counts = jnp.bincount(flat_e, length=N_EXPERTS)
    starts = jnp.cumsum(counts) - counts
    pcounts = ((counts + m - 1) // m) * m
    pends = jnp.cumsum(pcounts)
    pstarts = pends - pcounts
    dest = pstarts[se] + (jnp.arange(nk) - starts[se])
    n_rows = ((nk + m - 1) // m) * m + N_EXPERTS * m
    n_blocks = n_rows // m
    row_tok = jnp.full((n_rows,), n, dtype=jnp.int32).at[dest].set(flat_t[order])
    row_w = jnp.zeros((n_rows,), jnp.float32).at[dest].set(flat_w[order])
    blk_e = jnp.clip(jnp.searchsorted(pends, jnp.arange(n_blocks) * m, side='right'), 0, N_EXPERTS - 1)
    h_pad = jnp.concatenate([hf, jnp.zeros((1, d), hf.dtype)], axis=0)
    xr = h_pad[row_tok].reshape(n_blocks, m, d)

    def expert_block(args):
        xb, e = args
        gu = xb @ w_gate_up[e] + b_gate_up[e]
        g, u = gu[:, :D_EXPERT], gu[:, D_EXPERT:]
        g = jnp.minimum(g, SWIGLU_LIMIT)
        u = jnp.clip(u, -SWIGLU_LIMIT, SWIGLU_LIMIT)
        glu = g * jax.nn.sigmoid(SWIGLU_ALPHA * g)
        return ((u + 1.0) * glu) @ w_down[e] + b_down[e]

    yr = lax.map(expert_block, (xr, blk_e)).reshape(n_rows, d)
    y = jax.ops.segment_sum(yr * row_w[:, None].astype(yr.dtype), row_tok, num_segments=n + 1)[:n]
    return y.reshape(b, s, d).astype(h.dtype)


def hybrid_layer(x, p_i, g_mix, w_in, moba_q_norm, moba_k_norm, mla_q_lat_norm, w_uq,
                 mla_kv_lat_norm, w_ukv, mla_q_norm, mla_k_norm, w_branch_a, w_branch_b, w_out,
                 g_ffn, w_router, b_router, w_gate_up, b_gate_up, w_down, b_down,
                 g_ple, w_ple_gate, w_ple_proj):
    b, s, d = x.shape
    hn = rmsnorm(x, g_mix)
    proj = hn @ w_in
    parts, off = [], 0
    for wdt in IN_SPLITS:
        parts.append(proj[..., off:off + wdt])
        off += wdt
    q_a, k_a, v_a, c_q, c_kv, k_pe, gate_a, gate_b = parts

    heads_a = lambda t: t.reshape(b, s, MOBA_HEADS, MOBA_HEAD_DIM).transpose(0, 2, 1, 3)
    q_a = apply_rope(rmsnorm(heads_a(q_a), moba_q_norm))
    k_a = apply_rope(rmsnorm(heads_a(k_a), moba_k_norm))
    y_a = moba_attention(q_a, k_a, heads_a(v_a))
    y_a = y_a.transpose(0, 2, 1, 3).reshape(b, s, MOBA_WIDTH)

    q_b = (rmsnorm(c_q, mla_q_lat_norm) @ w_uq).reshape(b, s, MLA_HEADS, MLA_QK_DIM).transpose(0, 2, 1, 3)
    kv = (rmsnorm(c_kv, mla_kv_lat_norm) @ w_ukv).reshape(b, s, MLA_HEADS, MLA_NOPE_DIM + MLA_V_DIM).transpose(0, 2, 1, 3)
    k_nope, v_b = kv[..., :MLA_NOPE_DIM], kv[..., MLA_NOPE_DIM:]
    k_pe_h = jnp.broadcast_to(k_pe[:, None], (b, MLA_HEADS, s, MLA_ROPE_DIM))
    k_b = jnp.concatenate([k_nope, k_pe_h], axis=-1)
    q_b = rmsnorm(q_b, mla_q_norm)
    k_b = rmsnorm(k_b, mla_k_norm)
    q_b = jnp.concatenate([q_b[..., :MLA_NOPE_DIM], apply_rope(q_b[..., MLA_NOPE_DIM:])], axis=-1)
    k_b = jnp.concatenate([k_b[..., :MLA_NOPE_DIM], apply_rope(k_b[..., MLA_NOPE_DIM:])], axis=-1)
    y_b = causal_attention(q_b, k_b, v_b)
    y_b = y_b.transpose(0, 2, 1, 3).reshape(b, s, MLA_WIDTH)

    merged = jax.nn.sigmoid(gate_a) * (y_a @ w_branch_a) + jax.nn.sigmoid(gate_b) * (y_b @ w_branch_b)
    x = x + merged @ w_out

    x = x + routed_experts(rmsnorm(x, g_ffn), w_router, b_router, w_gate_up, b_gate_up, w_down, b_down)

    hp = rmsnorm(x, g_ple)
    x = x + jax.nn.sigmoid(hp @ w_ple_gate) * (p_i @ w_ple_proj)
    return x


def setup_inputs(seed: int = 0) -> dict:
    key = jax.random.key(seed)
    ks = jax.random.split(key, 32)
    f32 = jnp.float32

    def nrm(k, shape, scale):
        return jax.random.normal(k, shape, f32) * scale

    def gain(k, dim):
        return 1.0 + 0.02 * jax.random.normal(k, (DEPTH, dim), f32)

    L = DEPTH
    return {
        "x": nrm(ks[0], (BATCH, SEQ, D_MODEL), 1.0),
        "p": nrm(ks[1], (DEPTH, BATCH, SEQ, PLE_DIM), 1.0),
        "g_mix": gain(ks[2], D_MODEL),
        "w_in": nrm(ks[3], (L, D_MODEL, D_IN), D_MODEL ** -0.5),
        "moba_q_norm": gain(ks[4], MOBA_HEAD_DIM),
        "moba_k_norm": gain(ks[5], MOBA_HEAD_DIM),
        "mla_q_lat_norm": gain(ks[6], MLA_Q_LORA),
        "w_uq": nrm(ks[7], (L, MLA_Q_LORA, MLA_HEADS * MLA_QK_DIM), MLA_Q_LORA ** -0.5),
        "mla_kv_lat_norm": gain(ks[8], MLA_KV_LORA),
        "w_ukv": nrm(ks[9], (L, MLA_KV_LORA, MLA_HEADS * (MLA_NOPE_DIM + MLA_V_DIM)), MLA_KV_LORA ** -0.5),
        "mla_q_norm": gain(ks[10], MLA_QK_DIM),
        "mla_k_norm": gain(ks[11], MLA_QK_DIM),
        "w_branch_a": nrm(ks[12], (L, MOBA_WIDTH, D_MODEL), MOBA_WIDTH ** -0.5),
        "w_branch_b": nrm(ks[13], (L, MLA_WIDTH, D_MODEL), MLA_WIDTH ** -0.5),
        "w_out": nrm(ks[14], (L, D_MODEL, D_MODEL), D_MODEL ** -0.5),
        "g_ffn": gain(ks[15], D_MODEL),
        "w_router": nrm(ks[16], (L, D_MODEL, N_EXPERTS), D_MODEL ** -0.5),
        "b_router": nrm(ks[17], (L, N_EXPERTS), 0.01),
        "w_gate_up": nrm(ks[18], (L, N_EXPERTS, D_MODEL, 2 * D_EXPERT), D_MODEL ** -0.5),
        "b_gate_up": nrm(ks[19], (L, N_EXPERTS, 2 * D_EXPERT), 0.01),
        "w_down": nrm(ks[20], (L, N_EXPERTS, D_EXPERT, D_MODEL), D_EXPERT ** -0.5),
        "b_down": nrm(ks[21], (L, N_EXPERTS, D_MODEL), 0.01),
        "g_ple": gain(ks[22], D_MODEL),
        "w_ple_gate": nrm(ks[23], (L, D_MODEL, D_MODEL), D_MODEL ** -0.5),
        "w_ple_proj": nrm(ks[24], (L, PLE_DIM, D_MODEL), PLE_DIM ** -0.5),
    }


def reference(x, p, g_mix, w_in, moba_q_norm, moba_k_norm, mla_q_lat_norm, w_uq,
              mla_kv_lat_norm, w_ukv, mla_q_norm, mla_k_norm, w_branch_a, w_branch_b, w_out,
              g_ffn, w_router, b_router, w_gate_up, b_gate_up, w_down, b_down,
              g_ple, w_ple_gate, w_ple_proj):
    for i in range(DEPTH):
        x = hybrid_layer(x, p[i], g_mix[i], w_in[i], moba_q_norm[i], moba_k_norm[i],
                         mla_q_lat_norm[i], w_uq[i], mla_kv_lat_norm[i], w_ukv[i],
                         mla_q_norm[i], mla_k_norm[i], w_branch_a[i], w_branch_b[i], w_out[i],
                         g_ffn[i], w_router[i], b_router[i], w_gate_up[i], b_gate_up[i],
                         w_down[i], b_down[i], g_ple[i], w_ple_gate[i], w_ple_proj[i])
    return x
```

```cpp
#include <hip/hip_runtime.h>
#include <hip/hip_cooperative_groups.h>
#include <cstdio>
#include <cstdint>
namespace cg = cooperative_groups;

#define LAS __attribute__((address_space(3)))
typedef unsigned short bf16_t;
typedef short bf16x8 __attribute__((ext_vector_type(8)));
typedef short s16x4 __attribute__((ext_vector_type(4)));
typedef float f32x4 __attribute__((ext_vector_type(4)));
typedef float f32x2 __attribute__((ext_vector_type(2)));
typedef float f32x16 __attribute__((ext_vector_type(16)));
typedef unsigned u32x4 __attribute__((ext_vector_type(4)));
typedef unsigned u32x2 __attribute__((ext_vector_type(2)));
typedef __bf16 bf16x2_t __attribute__((ext_vector_type(2)));

constexpr int NB = 8, SEQ = 2048, NTOK = NB * SEQ, DM = 1024;
constexpr int DIN = 4000, DINP = 4096;
constexpr int NEXP = 32, TOPK = 4, DEXP = 1024;
constexpr int NTHREADS = 512, NWAVES = 8;
constexpr float EPS = 1e-6f;
constexpr float LOG2E = 1.4426950408889634f;
constexpr float C2A = 0.125f * LOG2E;
constexpr float C2B = 0.10206207261596575f * LOG2E;
constexpr int PC_QA = 0, PC_KA = 512, PC_VA = 1024, PC_CQ = 1536, PC_CKV = 1792, PC_KPE = 1920, PC_GA = 2048, PC_GB = 3072;

constexpr size_t MiB = 1u << 20;
constexpr size_t WS_HIST = 0;
constexpr size_t WS_ERR = 64 * 1024;
constexpr size_t WS_BAR = 128 * 1024;
constexpr size_t WS_BAR_BYTES = 16 * 1024;
constexpr size_t WS_ROPE = 1 * MiB;
constexpr size_t WS_KMEAN = 2 * MiB;
constexpr size_t WS_PAIR = 3 * MiB;
constexpr size_t WS_WUQ = 4 * MiB, WS_WUKV = 4 * MiB + 512 * 1024, WS_WPP = 5 * MiB, WS_WA = 6 * MiB, WS_WB = 7 * MiB, WS_WO = 8 * MiB, WS_WPG = 10 * MiB, WS_WIN = 12 * MiB;
constexpr size_t WS_W1 = 20 * MiB, WS_W2 = 148 * MiB;
constexpr size_t WS_HN = 212 * MiB, WS_PB = 244 * MiB;
constexpr size_t WS_CQN = 252 * MiB, WS_CKVN = 260 * MiB, WS_QB = 264 * MiB, WS_KV = 288 * MiB, WS_KB2 = 320 * MiB, WS_Y = 344 * MiB, WS_MERGED = 376 * MiB;
constexpr size_t WS_ACT = 252 * MiB;
constexpr size_t WS_PP = 400 * MiB;
constexpr size_t WS_KA2 = 432 * MiB;
constexpr size_t WS_PROJ = 448 * MiB;
constexpr size_t WS_QA2 = 576 * MiB;
constexpr size_t WS_XG = 448 * MiB;
constexpr size_t WS_END = 592 * MiB;
constexpr int MAXROWS = 73728, MAXMT = 288;

constexpr int RING_BYTES = 131072;
constexpr int LDS_CTL = RING_BYTES;
constexpr int LDS_BARST = RING_BYTES + 8192;
constexpr int LDS_BYTES = 147456;

__device__ __forceinline__ unsigned cvt_pk_bf16(float lo, float hi) { f32x2 v = {lo, hi}; bf16x2_t b = __builtin_convertvector(v, bf16x2_t); return __builtin_bit_cast(unsigned, b); }
__device__ __forceinline__ float bf2f(unsigned short b) { return __uint_as_float(((unsigned)b) << 16); }
__device__ __forceinline__ float bflo(unsigned w) { return __uint_as_float(w << 16); }
__device__ __forceinline__ float bfhi(unsigned w) { return __uint_as_float(w & 0xffff0000u); }
__device__ __forceinline__ float sigmoidf_(float x) { return __builtin_amdgcn_rcpf(1.0f + __builtin_amdgcn_exp2f(-x * LOG2E)); }
__device__ __forceinline__ int lane_id() { return (int)__builtin_amdgcn_mbcnt_hi(~0u, __builtin_amdgcn_mbcnt_lo(~0u, 0u)); }
__device__ __forceinline__ float wave_sum(float v) {
#pragma unroll
    for (int o = 1; o < 64; o <<= 1) v += __shfl_xor(v, o);
    return v;
}

namespace pg8 {
constexpr int BM = 256, BK = 64, HALF = 128, HTB = HALF * BK * 2, STAGE_BYTES = 8 * HTB, NXCD = 8, WGM = 8;
__host__ __device__ __forceinline__ int lds_byte(int r, int c) { const int st = (r >> 4) * 2 + (c >> 5), rr = r & 15, cc = c & 31, ob = rr * 64 + cc * 2; return st * 1024 + (ob ^ (((ob >> 9) & 1) << 5)); }
__host__ __device__ __forceinline__ void stage_rc(int b, int& R, int& C) { const int st = b / 1024, sb = b % 1024, swz = sb ^ (((sb >> 9) & 1) << 5); R = (st >> 1) * 16 + swz / 64; C = (st & 1) * 32 + (swz % 64) / 2; }
__host__ __device__ __forceinline__ int perm32(int rho) { const int n = rho >> 4, i = rho & 15; return 8 * (i >> 2) + 4 * n + (i & 3); }

struct Unit { int pm, pn, pb, e; };
struct Gemm { const bf16_t* A; const bf16_t* Bt; int lda, ldb, K; };

struct StaticOrder {
    int nM, nN, nwg, G, c;
    __device__ void init(int M, int N, int G_, int c_) { nM = M / BM; nN = N / BM; nwg = nM * nN; G = G_; c = c_; }
    __device__ bool next(int i, Unit& u) const {
        const long L = (long)i * G + c; if (L >= nwg) return false;
        int wgid = (int)L; { const int q = nwg / NXCD, r = nwg % NXCD, xcd = wgid % NXCD, off = wgid / NXCD; wgid = (xcd < r ? xcd * (q + 1) : r * (q + 1) + (xcd - r) * q) + off; }
        const int nig = WGM * nN, gid = wgid / nig, fm = gid * WGM, gsz = (nM - fm) < WGM ? (nM - fm) : WGM;
        u.pm = fm + ((wgid % nig) % gsz); u.pn = (wgid % nig) / gsz; u.pb = u.pn; u.e = 0; return true;
    }
};
struct MoeOrder {
    const LAS int* tile_e; int nmt, ntn, G, c;
    __device__ bool next(int i, Unit& u) const {
        const long L = (long)i * G + c; if (L >= (long)nmt * ntn) return false;
        const int mt = (int)(L / ntn), pn = (int)(L % ntn); const int e = __builtin_amdgcn_readfirstlane(tile_e[mt]);
        u.pm = mt; u.pn = pn; u.pb = e * ntn + pn; u.e = e; return true;
    }
};

template <class Epi, class Sched>
__device__ __forceinline__ void gemm_phase(LAS unsigned char* lds, int wave, const Gemm g, const Sched& S, const Epi& E) {
    constexpr bool ALIGN_EPI = true;
    int lane = lane_id(); asm volatile("" : "+v"(lane));
    const int wid = wave, tid = wid * 64 + lane, wr = wid >> 2, wc = wid & 3, fr = lane & 15, fq = lane >> 4;
    int K = g.K; asm volatile("" : "+s"(K));
    const int nt = K / BK;
    unsigned voffA[2], voffB[2];
#pragma unroll
    for (int i = 0; i < 2; ++i) { int R, C; stage_rc(tid * 16 + i * 8192, R, C); const int Rb = (R & ~31) + perm32(R & 31);
        voffA[i] = (unsigned)(R * g.lda + C) * 2u; voffB[i] = (unsigned)(Rb * g.ldb + C) * 2u; }
    const size_t kstep = (size_t)(BK * 2);
    const size_t hstepA = (size_t)HALF * g.lda * 2, hstepB = (size_t)HALF * g.ldb * 2;
    const size_t tstepA = 2 * hstepA, tstepB = 2 * hstepB;
    const unsigned ldsw = (unsigned)wid * 1024u;
    const int aoff = lds_byte(wr * 64 + fr, fq * 8), boff = lds_byte(wc * 32 + fr, fq * 8);
#define PG8_SA(b, h) (((b) * 2 + (h)) * HTB)
#define PG8_SB(b, h) ((4 + (b) * 2 + (h)) * HTB)
#define PG8_STAGE(bufoff, gbase, voff) do { _Pragma("unroll") for (int _i = 0; _i < 2; ++_i) \
        __builtin_amdgcn_global_load_lds((const unsigned*)((const char*)(gbase) + (voff)[_i]), (LAS unsigned*)(lds + (bufoff) + ldsw + _i * 8192), 16, 0, 0); } while (0)
#define PG8_LDA(dst, b, h) do { _Pragma("unroll") for (int m = 0; m < 4; ++m) _Pragma("unroll") for (int k = 0; k < 2; ++k) dst[m][k] = *(const LAS bf16x8*)(lds + PG8_SA(b, h) + aoff + m * 2048 + k * 1024); } while (0)
#define PG8_LDB(dst, b, h) do { _Pragma("unroll") for (int n = 0; n < 2; ++n) _Pragma("unroll") for (int k = 0; k < 2; ++k) dst[n][k] = *(const LAS bf16x8*)(lds + PG8_SB(b, h) + boff + n * 2048 + k * 1024); } while (0)
#define PG8_MMA(ai, bj, At, Bt) do { __builtin_amdgcn_s_setprio(1); _Pragma("unroll") for (int m = 0; m < 4; ++m) _Pragma("unroll") for (int n = 0; n < 2; ++n) _Pragma("unroll") for (int k = 0; k < 2; ++k) \
        acc[ai][bj][m][n] = __builtin_amdgcn_mfma_f32_16x16x32_bf16(Bt[n][k], At[m][k], acc[ai][bj][m][n], 0, 0, 0); __builtin_amdgcn_s_setprio(0); } while (0)
#define PG8_WAIT_V(n) asm volatile("s_waitcnt vmcnt(" #n ")" ::: "memory")
#define PG8_WAIT_L(n) asm volatile("s_waitcnt lgkmcnt(" #n ")" ::: "memory")
#define PG8_BAR __builtin_amdgcn_s_barrier()
#define PG8_SCHED __builtin_amdgcn_sched_barrier(0)
    Unit cur, nxt; int ui = 0;
    if (!S.next(0, cur)) return;
    f32x4 acc[2][2][4][2];
#pragma unroll
    for (int a = 0; a < 2; ++a)
#pragma unroll
        for (int b = 0; b < 2; ++b)
#pragma unroll
            for (int m = 0; m < 4; ++m)
#pragma unroll
                for (int n = 0; n < 2; ++n) acc[a][b][m][n] = (f32x4){0.f, 0.f, 0.f, 0.f};
    bf16x8 At[4][2], B0[2][2], B1[2][2];
    const char* cA = (const char*)g.A + (size_t)cur.pm * tstepA; const char* cB = (const char*)g.Bt + (size_t)cur.pb * tstepB;
    PG8_STAGE(PG8_SB(0, 0), cB, voffB); PG8_STAGE(PG8_SB(0, 1), cB + hstepB, voffB); PG8_STAGE(PG8_SA(0, 0), cA, voffA); PG8_STAGE(PG8_SA(0, 1), cA + hstepA, voffA);
    if (wr == 1) PG8_BAR;
    PG8_WAIT_V(2); PG8_BAR;
    PG8_STAGE(PG8_SB(1, 0), cB + kstep, voffB); PG8_STAGE(PG8_SA(1, 0), cA + kstep, voffA); PG8_STAGE(PG8_SB(1, 1), cB + hstepB + kstep, voffB);
    PG8_WAIT_V(6); PG8_BAR;
    for (;;) {
        const bool has_next = S.next(ui + 1, nxt);
        const char* nA = has_next ? (const char*)g.A + (size_t)nxt.pm * tstepA : cA; const char* nB = has_next ? (const char*)g.Bt + (size_t)nxt.pb * tstepB : cB;
        for (int t = 0; t < nt; t += 2) {
            const bool last = (t == nt - 2);
            const char* a1 = cA + (size_t)(t + 1) * kstep;
            const char* a2 = last ? nA : cA + (size_t)(t + 2) * kstep; const char* b2 = last ? nB : cB + (size_t)(t + 2) * kstep;
            const char* a3 = a2 + kstep; const char* b3 = b2 + kstep;
            PG8_LDB(B0, 0, 0); PG8_LDB(B1, 0, 1); PG8_SCHED; PG8_LDA(At, 0, 0); PG8_STAGE(PG8_SA(1, 1), a1 + hstepA, voffA);
            PG8_WAIT_V(8); PG8_WAIT_L(0); PG8_BAR; PG8_MMA(0, 0, At, B0); PG8_MMA(0, 1, At, B1); PG8_BAR; PG8_SCHED;
            PG8_LDA(At, 0, 1); PG8_STAGE(PG8_SB(0, 0), b2, voffB); PG8_STAGE(PG8_SB(0, 1), b2 + hstepB, voffB); PG8_STAGE(PG8_SA(0, 0), a2, voffA);
            PG8_WAIT_V(8); PG8_WAIT_L(0); PG8_BAR; PG8_MMA(1, 0, At, B0); PG8_MMA(1, 1, At, B1); PG8_BAR; PG8_SCHED;
            PG8_LDB(B0, 1, 0); PG8_LDB(B1, 1, 1); PG8_SCHED; PG8_LDA(At, 1, 0); PG8_STAGE(PG8_SA(0, 1), a2 + hstepA, voffA);
            PG8_WAIT_V(8); PG8_WAIT_L(0); PG8_BAR; PG8_MMA(0, 0, At, B0); PG8_MMA(0, 1, At, B1); PG8_BAR; PG8_SCHED;
            PG8_LDA(At, 1, 1); PG8_STAGE(PG8_SB(1, 0), b3, voffB); PG8_STAGE(PG8_SB(1, 1), b3 + hstepB, voffB); PG8_STAGE(PG8_SA(1, 0), a3, voffA);
            PG8_WAIT_V(8); PG8_WAIT_L(0); PG8_BAR; PG8_MMA(1, 0, At, B0); PG8_MMA(1, 1, At, B1); PG8_BAR; PG8_SCHED;
        }
        if constexpr (ALIGN_EPI) { if (wr == 0) PG8_BAR; }
        E(acc, cur, wr, wc, fr, fq);
        if (!has_next) break;
#pragma unroll
        for (int a = 0; a < 2; ++a)
#pragma unroll
            for (int b = 0; b < 2; ++b)
#pragma unroll
                for (int m = 0; m < 4; ++m)
#pragma unroll
                    for (int n = 0; n < 2; ++n) acc[a][b][m][n] = (f32x4){0.f, 0.f, 0.f, 0.f};
        cur = nxt; cA = nA; cB = nB; ++ui;
        if constexpr (ALIGN_EPI) { if (wr == 1) PG8_BAR; }
    }
    PG8_WAIT_V(0);
    if constexpr (!ALIGN_EPI) { if (wr == 0) PG8_BAR; }
    PG8_BAR;
#undef PG8_SA
#undef PG8_SB
#undef PG8_STAGE
#undef PG8_LDA
#undef PG8_LDB
#undef PG8_MMA
#undef PG8_WAIT_V
#undef PG8_WAIT_L
#undef PG8_BAR
#undef PG8_SCHED
}

#define EPI_ARGS const f32x4 (&acc)[2][2][4][2], const Unit& u, int wr, int wc, int fr, int fq
__device__ __forceinline__ u32x4 pack8(f32x4 v0, f32x4 v1) { u32x4 w; w.x = cvt_pk_bf16(v0[0], v0[1]); w.y = cvt_pk_bf16(v0[2], v0[3]); w.z = cvt_pk_bf16(v1[0], v1[1]); w.w = cvt_pk_bf16(v1[2], v1[3]); return w; }
__device__ __forceinline__ void unpack8(u32x4 w, f32x4& v0, f32x4& v1) { v0 = (f32x4){bflo(w.x), bfhi(w.x), bflo(w.y), bfhi(w.y)}; v1 = (f32x4){bflo(w.z), bfhi(w.z), bflo(w.w), bfhi(w.w)}; }
__device__ __forceinline__ f32x4 sig4(f32x4 v) { return (f32x4){sigmoidf_(v[0]), sigmoidf_(v[1]), sigmoidf_(v[2]), sigmoidf_(v[3])}; }

struct EpiStore {
    bf16_t* O; int ldc; const float* bias; int bias_stride; int sig_from;
    __device__ __forceinline__ void operator()(EPI_ARGS) const {
        const int row0 = u.pm * BM + wr * 64 + fr, col0 = u.pn * BM + wc * 32 + 8 * fq;
        const bool sg = u.pn >= sig_from;
        f32x4 bv[2][2];
#pragma unroll
        for (int bj = 0; bj < 2; ++bj)
#pragma unroll
            for (int n = 0; n < 2; ++n) bv[bj][n] = bias ? *(const f32x4*)(bias + (size_t)u.e * bias_stride + col0 + bj * HALF + 4 * n) : (f32x4){0.f, 0.f, 0.f, 0.f};
#pragma unroll
        for (int ai = 0; ai < 2; ++ai)
#pragma unroll
            for (int m = 0; m < 4; ++m) { bf16_t* rowp = O + (size_t)(row0 + ai * HALF + m * 16) * ldc + col0;
#pragma unroll
                for (int bj = 0; bj < 2; ++bj) { f32x4 v0 = acc[ai][bj][m][0] + bv[bj][0], v1 = acc[ai][bj][m][1] + bv[bj][1];
                    if (sg) { v0 = sig4(v0); v1 = sig4(v1); }
                    *(u32x4*)(rowp + bj * HALF) = pack8(v0, v1); } }
    }
};
template <bool ADD> struct EpiGate {
    bf16_t* O; const bf16_t* G; int ldg;
    __device__ __forceinline__ void operator()(EPI_ARGS) const {
        const int row0 = u.pm * BM + wr * 64 + fr, col0 = u.pn * BM + wc * 32 + 8 * fq;
#pragma unroll
        for (int ai = 0; ai < 2; ++ai)
#pragma unroll
            for (int m = 0; m < 4; ++m) { const size_t r = (size_t)(row0 + ai * HALF + m * 16);
#pragma unroll
                for (int bj = 0; bj < 2; ++bj) { const int c = col0 + bj * HALF;
                    f32x4 g0, g1; unpack8(*(const u32x4*)(G + r * ldg + c), g0, g1);
                    f32x4 v0 = acc[ai][bj][m][0] * g0, v1 = acc[ai][bj][m][1] * g1;
                    if (ADD) { f32x4 o0, o1; unpack8(*(const u32x4*)(O + r * DM + c), o0, o1); v0 += o0; v1 += o1; }
                    *(u32x4*)(O + r * DM + c) = pack8(v0, v1); } }
    }
};
struct EpiResF32 {
    const float* base; float* out;
    __device__ __forceinline__ void operator()(EPI_ARGS) const {
        const int row0 = u.pm * BM + wr * 64 + fr, col0 = u.pn * BM + wc * 32 + 8 * fq;
#pragma unroll
        for (int ai = 0; ai < 2; ++ai)
#pragma unroll
            for (int m = 0; m < 4; ++m) { const size_t r = (size_t)(row0 + ai * HALF + m * 16);
#pragma unroll
                for (int bj = 0; bj < 2; ++bj) { const size_t off = r * DM + col0 + bj * HALF;
                    const f32x4 b0 = *(const f32x4*)(base + off), b1 = *(const f32x4*)(base + off + 4);
                    *(f32x4*)(out + off) = b0 + acc[ai][bj][m][0]; *(f32x4*)(out + off + 4) = b1 + acc[ai][bj][m][1]; } }
    }
};
struct EpiSwiglu {
    bf16_t* O; const float* bias;
    __device__ __forceinline__ void operator()(EPI_ARGS) const {
        const int row0 = u.pm * BM + wr * 64 + fr, j0 = u.pn * HALF + wc * 32 + 8 * fq;
        const float* be = bias + (size_t)u.e * 2048;
        f32x4 bg[2], bu[2];
#pragma unroll
        for (int n = 0; n < 2; ++n) { bg[n] = *(const f32x4*)(be + j0 + 4 * n); bu[n] = *(const f32x4*)(be + 1024 + j0 + 4 * n); }
#pragma unroll
        for (int ai = 0; ai < 2; ++ai)
#pragma unroll
            for (int m = 0; m < 4; ++m) { bf16_t* rowp = O + (size_t)(row0 + ai * HALF + m * 16) * DEXP + j0;
                f32x4 o[2];
#pragma unroll
                for (int n = 0; n < 2; ++n) { const f32x4 gv = acc[ai][0][m][n] + bg[n], uv = acc[ai][1][m][n] + bu[n];
#pragma unroll
                    for (int i = 0; i < 4; ++i) { const float gg = fminf(gv[i], 7.0f), uu = fminf(fmaxf(uv[i], -7.0f), 7.0f);
                        o[n][i] = (uu + 1.0f) * gg * __builtin_amdgcn_rcpf(1.0f + __builtin_amdgcn_exp2f(-1.702f * LOG2E * gg)); } }
                *(u32x4*)rowp = pack8(o[0], o[1]); }
    }
};
struct EpiFinal {
    float* out; const bf16_t* PP;
    __device__ __forceinline__ void operator()(EPI_ARGS) const {
        const int row0 = u.pm * BM + wr * 64 + fr, col0 = u.pn * BM + wc * 32 + 8 * fq;
#pragma unroll
        for (int ai = 0; ai < 2; ++ai)
#pragma unroll
            for (int m = 0; m < 4; ++m) { const size_t r = (size_t)(row0 + ai * HALF + m * 16);
#pragma unroll
                for (int bj = 0; bj < 2; ++bj) { const size_t off = r * DM + col0 + bj * HALF;
                    f32x4 p0, p1; unpack8(*(const u32x4*)(PP + off), p0, p1);
                    const f32x4 b0 = *(const f32x4*)(out + off), b1 = *(const f32x4*)(out + off + 4);
                    *(f32x4*)(out + off) = b0 + sig4(acc[ai][bj][m][0]) * p0; *(f32x4*)(out + off + 4) = b1 + sig4(acc[ai][bj][m][1]) * p1; } }
    }
};
}

namespace att {
__device__ __forceinline__ int crow(int r, int hi) { return (r & 3) + 8 * (r >> 2) + 4 * hi; }
__device__ __forceinline__ void glds16(const void* gsrc, unsigned lds_dst) { unsigned keep;
    asm volatile("s_mov_b32 %0, m0\n\ts_mov_b32 m0, %2\n\ts_nop 0\n\tglobal_load_lds_dwordx4 %1, off\n\ts_mov_b32 m0, %0" : "=&s"(keep) : "v"(gsrc), "s"(lds_dst) : "memory"); }
__device__ __forceinline__ s16x4 vtr(const LAS unsigned char* p) { return __builtin_bit_cast(s16x4, __builtin_amdgcn_ds_read_tr16_b64_v4i16((LAS s16x4*)p)); }
#define MX3(a, b, c) __builtin_fmaxf(__builtin_fmaxf((a), (b)), (c))
constexpr int VSLOT = 8192, OST_BYTES = NWAVES * 4096, WSF_BYTES = NWAVES * 256;

template <int DQK, bool MOBA>
__device__ __forceinline__ void attn_unit(int b, int qb, const bf16_t* Qh, int ldq, const bf16_t* Kh, int ldk, const bf16_t* Vh, int ldv, bf16_t* Oh, int ldo, const float* kmean, LAS unsigned char* shm, int wave) {
    constexpr int ND = DQK / 16, NCH = DQK / 8, KSLOT = NCH * 1024;
    constexpr int LDS_K = 0, LDS_V = 2 * KSLOT, LDS_WS = LDS_V + 2 * VSLOT, LDS_OST = LDS_WS + WSF_BYTES;
    static_assert(LDS_OST + OST_BYTES <= RING_BYTES, "attention LDS");
    int lane = lane_id(); asm volatile("" : "+v"(lane));
    const int r32 = lane & 31, hi = lane >> 5; const int wid = wave;
    const long rowbase = (long)b * SEQ; const int q0 = qb * 256;
    const unsigned lds0 = (unsigned)(uintptr_t)shm;
    LAS float* wsf = (LAS float*)(shm + LDS_WS) + wid * 64;
    const int NT = 4 * (qb + 1);
    const bf16_t* ksrc0 = Kh + (rowbase + lane) * ldk + wid * 8;
    const bf16_t* vsrc0 = Vh + (rowbase + 16 * (wid & 3) + (lane >> 2)) * ldv + (wid >> 2) * 32 + (lane & 3) * 8;
#define ATT_DMA(kt, s) do { const long ro_ = (long)(kt) * 64; \
        glds16(ksrc0 + ro_ * ldk, (unsigned)__builtin_amdgcn_readfirstlane(lds0 + LDS_K + (s) * KSLOT + wid * 1024)); \
        if (NCH > 8 && wid < NCH - 8) glds16(ksrc0 + ro_ * ldk + 64, (unsigned)__builtin_amdgcn_readfirstlane(lds0 + LDS_K + (s) * KSLOT + (wid + 8) * 1024)); \
        glds16(vsrc0 + ro_ * ldv, (unsigned)__builtin_amdgcn_readfirstlane(lds0 + LDS_V + (s) * VSLOT + wid * 1024)); } while (0)
#define ATT_TILE(i) (MOBA ? ((i) < 4 ? 4 * qb + (i) : (i) - 4) : (i))
    ATT_DMA(ATT_TILE(0), 0);
    const bf16_t* Qw = Qh + (rowbase + q0 + wid * 32 + r32) * ldq + hi * 8;
    bf16x8 qr[ND];
#pragma unroll
    for (int d0 = 0; d0 < ND; ++d0) qr[d0] = *(const bf16x8*)(Qw + d0 * 16);
    unsigned bmask = 0xffffffffu;
    if (MOBA) {
        bmask = 1u << qb;
        if (qb <= 3) bmask |= (1u << qb) - 1u;
        else {
            float gsc[7];
#pragma unroll
            for (int n = 0; n < 7; ++n) { float s = 0.f;
                if (n < qb) {
#pragma unroll
                    for (int d0 = 0; d0 < ND; ++d0) { const float* km = kmean + n * 64 + d0 * 16 + hi * 8; const f32x4 k0 = *(const f32x4*)km, k1 = *(const f32x4*)(km + 4);
                        s += bf2f((unsigned short)qr[d0][0]) * k0[0] + bf2f((unsigned short)qr[d0][1]) * k0[1] + bf2f((unsigned short)qr[d0][2]) * k0[2] + bf2f((unsigned short)qr[d0][3]) * k0[3]
                           + bf2f((unsigned short)qr[d0][4]) * k1[0] + bf2f((unsigned short)qr[d0][5]) * k1[1] + bf2f((unsigned short)qr[d0][6]) * k1[2] + bf2f((unsigned short)qr[d0][7]) * k1[3]; }
                    s += __shfl_xor(s, 32);
                } else s = -INFINITY;
                gsc[n] = s; }
#pragma unroll
            for (int pass = 0; pass < 3; ++pass) { float best = -INFINITY; int bi = 0;
#pragma unroll
                for (int n = 0; n < 7; ++n) { const bool ok = (n < qb) && !((bmask >> n) & 1u) && (gsc[n] > best); best = ok ? gsc[n] : best; bi = ok ? n : bi; }
                bmask |= 1u << bi; }
        }
    }
    float mhat = 0.f, l_reg = 0.f; f32x16 o[2]; o[0] = f32x16{}; o[1] = f32x16{}; f32x16 negm = f32x16{}; asm volatile("" : "+v"(negm));
    const int qrel = wid * 32 + r32;
    const LAS unsigned char* kp0 = shm + LDS_K + hi * 1024 + r32 * 16;
    const LAS unsigned char* vp0 = shm + LDS_V + ((lane >> 4) & 1) * 32 + (lane & 3) * 8 + (4 * hi + ((lane & 15) >> 2)) * 64;
    for (int i = 0; i < NT; ++i) {
        const int s = i & 1, kt = ATT_TILE(i);
        asm volatile("s_waitcnt vmcnt(0) lgkmcnt(0)\n\ts_barrier" ::: "memory");
        if (i + 1 < NT) ATT_DMA(ATT_TILE(i + 1), s ^ 1);
        f32x16 cin = negm;
        if (MOBA) { if (i >= 4 && !((bmask >> (kt >> 2)) & 1u)) {
#pragma unroll
            for (int r = 0; r < 16; ++r) cin[r] = -INFINITY; } }
        f32x16 p0, p1;
        { const LAS unsigned char* kb = kp0 + s * KSLOT;
#pragma unroll
            for (int d0 = 0; d0 < ND; ++d0) { const bf16x8 b0 = *(const LAS bf16x8*)(kb + d0 * 2048), b1 = *(const LAS bf16x8*)(kb + d0 * 2048 + 512);
                if (d0 == 0) { p0 = __builtin_amdgcn_mfma_f32_32x32x16_bf16(b0, qr[0], cin, 0, 0, 0); p1 = __builtin_amdgcn_mfma_f32_32x32x16_bf16(b1, qr[0], cin, 0, 0, 0); }
                else { p0 = __builtin_amdgcn_mfma_f32_32x32x16_bf16(b0, qr[d0], p0, 0, 0, 0); p1 = __builtin_amdgcn_mfma_f32_32x32x16_bf16(b1, qr[d0], p1, 0, 0, 0); } } }
        if (kt >= 4 * qb) { const int kb = 64 * (kt - 4 * qb) + 4 * hi;
#pragma unroll
            for (int r = 0; r < 16; ++r) { const int kv = kb + (r & 3) + 8 * (r >> 2); if (kv > qrel) p0[r] = -INFINITY; if (kv + 32 > qrel) p1[r] = -INFINITY; } }
        bool resc = false;
        { float a = MX3(p0[0], p0[1], p1[0]), bb = MX3(p0[2], p0[3], p1[1]); a = MX3(a, p1[2], p1[3]);
#pragma unroll
            for (int r = 4; r < 16; r += 4) { a = MX3(a, p0[r], p0[r + 1]); bb = MX3(bb, p0[r + 2], p0[r + 3]); a = MX3(a, p1[r], p1[r + 1]); bb = MX3(bb, p1[r + 2], p1[r + 3]); }
            float rm = __builtin_fmaxf(a, bb); rm = __builtin_fmaxf(rm, __shfl_xor(rm, 32));
            const bool first = (i == 0);
            if (first || __any(rm > 6.0f)) {
                const float dl = first ? rm : __builtin_fmaxf(rm, 0.f); mhat += dl;
#pragma unroll
                for (int r = 0; r < 16; ++r) { p0[r] -= dl; p1[r] -= dl; }
#pragma unroll
                for (int r = 0; r < 16; ++r) negm[r] = -mhat;
                asm volatile("" : "+v"(negm));
                const float f = __builtin_amdgcn_exp2f(-dl); l_reg *= f; if (hi == 0) wsf[r32] = f; resc = true; } }
        float sacc = 0.f;
#pragma unroll
        for (int r = 0; r < 16; ++r) { p0[r] = __builtin_amdgcn_exp2f(p0[r]); p1[r] = __builtin_amdgcn_exp2f(p1[r]); sacc += p0[r] + p1[r]; }
        l_reg += sacc;
        u32x4 pw0, pw1, pw2, pw3;
        pw0 = (u32x4){cvt_pk_bf16(p0[0], p0[1]), cvt_pk_bf16(p0[2], p0[3]), cvt_pk_bf16(p0[4], p0[5]), cvt_pk_bf16(p0[6], p0[7])};
        pw1 = (u32x4){cvt_pk_bf16(p0[8], p0[9]), cvt_pk_bf16(p0[10], p0[11]), cvt_pk_bf16(p0[12], p0[13]), cvt_pk_bf16(p0[14], p0[15])};
        pw2 = (u32x4){cvt_pk_bf16(p1[0], p1[1]), cvt_pk_bf16(p1[2], p1[3]), cvt_pk_bf16(p1[4], p1[5]), cvt_pk_bf16(p1[6], p1[7])};
        pw3 = (u32x4){cvt_pk_bf16(p1[8], p1[9]), cvt_pk_bf16(p1[10], p1[11]), cvt_pk_bf16(p1[12], p1[13]), cvt_pk_bf16(p1[14], p1[15])};
        if (resc) {
#pragma unroll
            for (int d_ = 0; d_ < 2; ++d_)
#pragma unroll
                for (int r = 0; r < 16; ++r) o[d_][r] *= wsf[crow(r, hi)];
        }
        { const LAS unsigned char* vp = vp0 + s * VSLOT;
#pragma unroll
            for (int d0 = 0; d0 < 2; ++d0) {
                s16x4 lo[4], hh[4];
#pragma unroll
                for (int ks = 0; ks < 4; ++ks) { lo[ks] = vtr(vp + d0 * 4096 + ks * 1024); hh[ks] = vtr(vp + d0 * 4096 + ks * 1024 + 512); }
#define PKV(k) (bf16x8){lo[k][0], lo[k][1], lo[k][2], lo[k][3], hh[k][0], hh[k][1], hh[k][2], hh[k][3]}
                o[d0] = __builtin_amdgcn_mfma_f32_32x32x16_bf16(__builtin_bit_cast(bf16x8, pw0), PKV(0), o[d0], 0, 0, 0);
                o[d0] = __builtin_amdgcn_mfma_f32_32x32x16_bf16(__builtin_bit_cast(bf16x8, pw1), PKV(1), o[d0], 0, 0, 0);
                o[d0] = __builtin_amdgcn_mfma_f32_32x32x16_bf16(__builtin_bit_cast(bf16x8, pw2), PKV(2), o[d0], 0, 0, 0);
                o[d0] = __builtin_amdgcn_mfma_f32_32x32x16_bf16(__builtin_bit_cast(bf16x8, pw3), PKV(3), o[d0], 0, 0, 0);
#undef PKV
            } }
    }
    l_reg += __shfl_xor(l_reg, 32);
    if (hi == 0) wsf[32 + r32] = l_reg;
    float rli[16];
#pragma unroll
    for (int r = 0; r < 16; ++r) rli[r] = __builtin_amdgcn_rcpf(wsf[32 + crow(r, hi)]);
    bf16_t* Ow = Oh + (rowbase + q0 + wid * 32) * ldo;
    { LAS bf16_t* stg = (LAS bf16_t*)(shm + LDS_OST) + wid * 2048;
#pragma unroll
        for (int r = 0; r < 16; ++r) { const int orow = crow(r, hi);
#pragma unroll
            for (int d0 = 0; d0 < 2; ++d0) stg[orow * 64 + d0 * 32 + r32] = (bf16_t)(cvt_pk_bf16(o[d0][r] * rli[r], 0.f) & 0xffffu); }
#pragma unroll
        for (int i = 0; i < 4; ++i) { const int row = i * 8 + (lane >> 3), ch = lane & 7; const u32x4 v = *(const LAS u32x4*)(stg + row * 64 + ch * 8); *(u32x4*)(Ow + (long)row * ldo + ch * 8) = v; } }
    asm volatile("s_waitcnt vmcnt(0) lgkmcnt(0)\n\ts_barrier" ::: "memory");
#undef ATT_DMA
#undef ATT_TILE
}
#undef MX3
}

#define XB_TMO      128
#define XB_XCNT(j)  (256  + 64 * (j))
#define XB_XSUB(j)  (1280 + 64 * (j))
#define XB_XGEN(j)  (2304 + 64 * (j))
#define XB_TOP      3328
#define XB_TOPGEN   3392
#define XCD_BAR_WORDS 3456
#define XB_SPIN_CAP (1u << 22)
__device__ __forceinline__ unsigned xb_ld(unsigned* p)              { return __hip_atomic_load(p, __ATOMIC_RELAXED, __HIP_MEMORY_SCOPE_AGENT); }
__device__ __forceinline__ unsigned xb_add(unsigned* p, unsigned v) { return __hip_atomic_fetch_add(p, v, __ATOMIC_RELAXED, __HIP_MEMORY_SCOPE_AGENT); }
__device__ __forceinline__ unsigned xb_xcc_id() { return (unsigned)__builtin_amdgcn_s_getreg((3 << 11) | 20) & 0xFu; }
#define XB_SPIN(cond, bar) do { unsigned _sp = 0; while (cond) { __builtin_amdgcn_s_sleep(1); \
    if ((++_sp & 255u) == 0u) { if (xb_ld(&(bar)[XB_TMO])) break; if (_sp > XB_SPIN_CAP) { atomicAdd(&(bar)[XB_TMO], 1u); break; } } } } while (0)
struct XcdBarrier { unsigned* bar; unsigned x; volatile LAS unsigned* st; int wave; };
__device__ __forceinline__ XcdBarrier xcd_barrier_post(unsigned* bar, volatile LAS unsigned* st, int wave) {
    XcdBarrier b; b.bar = bar; b.x = xb_xcc_id(); b.st = st; b.wave = wave;
    if (wave == 0 && lane_id() == 0) (void)xb_add(&bar[XB_XCNT(b.x)], 1u);
    return b;
}
__device__ __forceinline__ void xcd_barrier_complete(unsigned* bar, unsigned x, unsigned& nloc, unsigned& nx) {
    const unsigned G = gridDim.x * gridDim.y * gridDim.z;
    unsigned sum, cnt, mine, sp = 0u;
    for (;;) {
        sum = 0u; cnt = 0u; mine = 0u;
#pragma unroll
        for (unsigned j = 0; j < 16; ++j) { const unsigned c = xb_ld(&bar[XB_XCNT(j)]); sum += c; cnt += (c > 0u) ? 1u : 0u; mine = (j == x) ? c : mine; }
        if (sum == G) break;
        __builtin_amdgcn_s_sleep(1);
        if ((++sp & 255u) == 0u) { if (xb_ld(&bar[XB_TMO])) break; if (sp > XB_SPIN_CAP) { atomicAdd(&bar[XB_TMO], 1u); break; } }
    }
    nloc = mine > 0u ? mine : 1u; nx = cnt > 0u ? cnt : 1u;
}
__device__ __forceinline__ void xcd_barrier(const XcdBarrier& b) {
    asm volatile("s_waitcnt vmcnt(0)" ::: "memory");
    __syncthreads();
    if (b.wave == 0 && lane_id() == 0) {
        unsigned* bar = b.bar;
        __builtin_amdgcn_s_waitcnt(0);
        unsigned nloc = b.st[0], nx = b.st[1];
        if (nloc == 0u) { xcd_barrier_complete(bar, b.x, nloc, nx); b.st[0] = nloc; b.st[1] = nx; }
        const unsigned old = xb_add(&bar[XB_XSUB(b.x)], 1u);
        const unsigned gen = old / nloc;
        if (old + 1u == (gen + 1u) * nloc) {
            __builtin_amdgcn_fence(__ATOMIC_RELEASE, "agent");
            asm volatile("s_waitcnt vmcnt(0)" ::: "memory");
            const unsigned og = xb_add(&bar[XB_TOP], 1u);
            const unsigned tg = og / nx;
            if (og + 1u == (tg + 1u) * nx) xb_add(&bar[XB_TOPGEN], 1u);
            else XB_SPIN(xb_ld(&bar[XB_TOPGEN]) == tg, bar);
            __builtin_amdgcn_fence(__ATOMIC_ACQUIRE, "agent");
            xb_add(&bar[XB_XGEN(b.x)], 1u);
            asm volatile("s_waitcnt vmcnt(0)" ::: "memory");
        } else {
            XB_SPIN(xb_ld(&bar[XB_XGEN(b.x)]) == gen, bar);
            __builtin_amdgcn_fence(__ATOMIC_ACQUIRE, "agent");
            asm volatile("s_waitcnt vmcnt(0)" ::: "memory");
        }
    }
    __syncthreads();
}

struct Params { const float* in[25]; float* out; unsigned char* ws; int ph_lo, ph_hi; };
enum { I_X = 0, I_P, I_GMIX, I_WIN, I_MQN, I_MKN, I_QLATN, I_WUQ, I_KVLATN, I_WUKV, I_MLAQN, I_MLAKN, I_WA, I_WB, I_WO, I_GFFN, I_WR, I_BR, I_WGU, I_BGU, I_WD, I_BD, I_GPLE, I_WPG, I_WPP };
constexpr int NPHASE = 16;

struct Frame {
    LAS unsigned char* lds; int vcu, G, wave;
    const Params* P; unsigned char* ws;
};
struct Ids { int tid, lane, wave; };
#define PHASE_IDS() Ids I_; { int l_ = lane_id(); asm volatile("" : "+v"(l_)); I_.lane = l_; I_.wave = F.wave; I_.tid = F.wave * 64 + l_; }

__device__ __forceinline__ void tr_item(const float* W, int ldw, int k0, int n0, bf16_t* dst, int ldd, LAS float* scr, int lane) {
#pragma unroll 8
    for (int i = 0; i < 32; ++i) { const int kk = 2 * i + (lane >> 5); scr[kk * 33 + (lane & 31)] = W[(size_t)(k0 + kk) * ldw + n0 + (lane & 31)]; }
    asm volatile("s_waitcnt lgkmcnt(0)" ::: "memory");
    const int c = lane & 7;
#pragma unroll
    for (int j = 0; j < 4; ++j) { const int n = (lane >> 3) + 8 * j; const LAS float* s = scr + (8 * c) * 33 + n;
        u32x4 o; o.x = cvt_pk_bf16(s[0 * 33], s[1 * 33]); o.y = cvt_pk_bf16(s[2 * 33], s[3 * 33]); o.z = cvt_pk_bf16(s[4 * 33], s[5 * 33]); o.w = cvt_pk_bf16(s[6 * 33], s[7 * 33]);
        *(u32x4*)(dst + (size_t)n * ldd + k0 + 8 * c) = o; }
    asm volatile("s_waitcnt lgkmcnt(0)" ::: "memory");
}

__device__ __forceinline__ void phase0(Frame& F) {
    PHASE_IDS();
    const Params& P = *F.P; unsigned char* ws = F.ws;
    LAS float* scr = (LAS float*)(F.lds + I_.wave * 16384);
    const int gw = F.vcu * NWAVES + I_.wave, NGW = F.G * NWAVES;
    constexpr int I_IN = 16 * 125, I_UQ = 4 * 24, I_UKV = 2 * 32, I_A = 8 * 32, I_O = 16 * 32, I_PP = 4 * 32, I_GU = 32 * 16 * 64, I_DN = 32 * 16 * 32;
    constexpr int NITEMS = I_IN + I_UQ + I_UKV + 2 * I_A + 2 * I_O + I_PP + I_GU + I_DN;
    for (int it = gw; it < NITEMS; it += NGW) {
        int r = it;
        if (r < I_GU) { const int e = r / 1024, q = r % 1024, kb = q / 64, g = q % 64; const int c = 32 * g; const int dr = (c < 1024) ? 256 * (c / 128) + (c % 128) : 256 * ((c - 1024) / 128) + 128 + ((c - 1024) % 128);
            tr_item(P.in[I_WGU] + (size_t)e * 1024 * 2048, 2048, 64 * kb, c, (bf16_t*)(ws + WS_W1) + ((size_t)e * 2048 + dr) * 1024, 1024, scr, I_.lane); continue; } r -= I_GU;
        if (r < I_DN) { const int e = r / 512, q = r % 512, kb = q / 32, g = q % 32;
            tr_item(P.in[I_WD] + (size_t)e * 1024 * 1024, 1024, 64 * kb, 32 * g, (bf16_t*)(ws + WS_W2) + ((size_t)e * 1024 + 32 * g) * 1024, 1024, scr, I_.lane); continue; } r -= I_DN;
        if (r < I_IN) { const int kb = r / 125, g = r % 125; const int dr = 32 * (g < 61 ? g : g + 3);
            tr_item(P.in[I_WIN], DIN, 64 * kb, 32 * g, (bf16_t*)(ws + WS_WIN) + (size_t)dr * 1024, 1024, scr, I_.lane); continue; } r -= I_IN;
        if (r < I_UQ) { const int kb = r / 24, g = r % 24; tr_item(P.in[I_WUQ], 768, 64 * kb, 32 * g, (bf16_t*)(ws + WS_WUQ) + (size_t)(32 * g) * 256, 256, scr, I_.lane); continue; } r -= I_UQ;
        if (r < I_UKV) { const int kb = r / 32, g = r % 32; tr_item(P.in[I_WUKV], 1024, 64 * kb, 32 * g, (bf16_t*)(ws + WS_WUKV) + (size_t)(32 * g) * 128, 128, scr, I_.lane); continue; } r -= I_UKV;
        if (r < I_A) { const int kb = r / 32, g = r % 32; tr_item(P.in[I_WA], 1024, 64 * kb, 32 * g, (bf16_t*)(ws + WS_WA) + (size_t)(32 * g) * 512, 512, scr, I_.lane); continue; } r -= I_A;
        if (r < I_A) { const int kb = r / 32, g = r % 32; tr_item(P.in[I_WB], 1024, 64 * kb, 32 * g, (bf16_t*)(ws + WS_WB) + (size_t)(32 * g) * 512, 512, scr, I_.lane); continue; } r -= I_A;
        if (r < I_O) { const int kb = r / 32, g = r % 32; tr_item(P.in[I_WO], 1024, 64 * kb, 32 * g, (bf16_t*)(ws + WS_WO) + (size_t)(32 * g) * 1024, 1024, scr, I_.lane); continue; } r -= I_O;
        if (r < I_O) { const int kb = r / 32, g = r % 32; tr_item(P.in[I_WPG], 1024, 64 * kb, 32 * g, (bf16_t*)(ws + WS_WPG) + (size_t)(32 * g) * 1024, 1024, scr, I_.lane); continue; } r -= I_O;
        { const int kb = r / 32, g = r % 32; tr_item(P.in[I_WPP], 1024, 64 * kb, 32 * g, (bf16_t*)(ws + WS_WPP) + (size_t)(32 * g) * 256, 256, scr, I_.lane); }
    }
    { const f32x4* gp = (const f32x4*)P.in[I_GMIX] + I_.lane; f32x4 gv[4];
#pragma unroll
        for (int j = 0; j < 4; ++j) gv[j] = gp[64 * j];
        for (int m = gw; m < NTOK; m += NGW) { const f32x4* xr = (const f32x4*)(P.in[I_X] + (size_t)m * DM) + I_.lane; f32x4 v[4]; float s = 0.f;
#pragma unroll
            for (int j = 0; j < 4; ++j) { v[j] = xr[64 * j]; s += (v[j].x * v[j].x + v[j].y * v[j].y) + (v[j].z * v[j].z + v[j].w * v[j].w); }
            const float rstd = 1.0f / sqrtf(wave_sum(s) * (1.f / DM) + EPS);
            u32x2* o8 = (u32x2*)((bf16_t*)(ws + WS_HN) + (size_t)m * DM) + I_.lane;
#pragma unroll
            for (int j = 0; j < 4; ++j) { const f32x4 y = v[j] * rstd * gv[j]; o8[64 * j] = (u32x2){cvt_pk_bf16(y.x, y.y), cvt_pk_bf16(y.z, y.w)}; } } }
    { const size_t n4 = (size_t)NTOK * 256 / 4; const f32x4* pp = (const f32x4*)P.in[I_P]; u32x2* po = (u32x2*)(ws + WS_PB);
        for (size_t i = (size_t)F.vcu * NTHREADS + I_.tid; i < n4; i += (size_t)F.G * NTHREADS) { const f32x4 v = pp[i]; po[i] = (u32x2){cvt_pk_bf16(v.x, v.y), cvt_pk_bf16(v.z, v.w)}; } }
    { float* tab = (float*)(ws + WS_ROPE);
        for (int i = F.vcu * NTHREADS + I_.tid; i < 2048 * 48; i += F.G * NTHREADS) {
            int pos, j, half; float* cdst; float* sdst;
            if (i < 2048 * 32) { pos = i / 32; j = i % 32; half = 32; cdst = tab + i; sdst = tab + 65536 + i; }
            else { const int q = i - 2048 * 32; pos = q / 16; j = q % 16; half = 16; cdst = tab + 131072 + q; sdst = tab + 131072 + 32768 + q; }
            const float inv = powf(10000.0f, -((float)j / (float)half)); const float ang = (float)pos * inv;
            *cdst = cosf(ang); *sdst = sinf(ang); } }
}

__device__ __forceinline__ void phase2(Frame& F) {
    PHASE_IDS();
    const Params& P = *F.P; unsigned char* ws = F.ws;
    const bf16_t* PROJ = (const bf16_t*)(ws + WS_PROJ);
    const float* cosA = (const float*)(ws + WS_ROPE); const float* sinA = cosA + 65536;
    LAS float* kst = (LAS float*)F.lds;
    LAS float* part = kst + 256 * 65;
    for (int it = F.vcu; it < 512; it += F.G) {
        const int b = it >> 6, blk = (it >> 3) & 7, h = it & 7;
        const int sel = I_.lane >> 5, r = I_.wave * 32 + (I_.lane & 31); const int pos = blk * 256 + r; const size_t row = (size_t)b * SEQ + pos;
        const u32x4* src = (const u32x4*)(PROJ + row * DINP + (sel ? PC_KA : PC_QA) + h * 64);
        float v[64]; float ss = 0.f;
#pragma unroll
        for (int c = 0; c < 8; ++c) { const u32x4 w = src[c]; f32x4 a0, a1; pg8::unpack8(w, a0, a1);
#pragma unroll
            for (int j = 0; j < 4; ++j) { v[8 * c + j] = a0[j]; v[8 * c + 4 + j] = a1[j]; ss += a0[j] * a0[j] + a1[j] * a1[j]; } }
        const float rstd = 1.0f / sqrtf(ss * (1.f / 64.f) + EPS);
        const float* gn = sel ? P.in[I_MKN] : P.in[I_MQN];
#pragma unroll
        for (int d = 0; d < 64; ++d) v[d] = v[d] * rstd * gn[d];
        const float sc = sel ? 1.0f : C2A;
#pragma unroll
        for (int i = 0; i < 32; ++i) { const float c = cosA[pos * 32 + i], s = sinA[pos * 32 + i]; const float x1 = v[i], x2 = v[i + 32]; v[i] = x1 * c - x2 * s; v[i + 32] = x2 * c + x1 * s; }
        bf16_t* dst = (bf16_t*)(ws + (sel ? WS_KA2 : WS_QA2)) + row * 512 + h * 64;
#pragma unroll
        for (int c = 0; c < 8; ++c) { u32x4 w; w.x = cvt_pk_bf16(v[8 * c] * sc, v[8 * c + 1] * sc); w.y = cvt_pk_bf16(v[8 * c + 2] * sc, v[8 * c + 3] * sc); w.z = cvt_pk_bf16(v[8 * c + 4] * sc, v[8 * c + 5] * sc); w.w = cvt_pk_bf16(v[8 * c + 6] * sc, v[8 * c + 7] * sc);
            *(u32x4*)(dst + 8 * c) = w; }
        if (sel) {
#pragma unroll
            for (int d = 0; d < 64; ++d) kst[r * 65 + d] = v[d]; }
        __syncthreads();
        { const int d = I_.tid & 63, pt = I_.tid >> 6; float s = 0.f;
            for (int rr = 0; rr < 32; ++rr) s += kst[(pt * 32 + rr) * 65 + d];
            part[pt * 64 + d] = s; }
        __syncthreads();
        if (I_.tid < 64) { float s = 0.f;
#pragma unroll
            for (int pt = 0; pt < 8; ++pt) s += part[pt * 64 + I_.tid];
            ((float*)(ws + WS_KMEAN))[(((size_t)b * 8 + h) * 8 + blk) * 64 + I_.tid] = s * (1.f / 256.f); }
        __syncthreads();
    }
    const int gw = F.vcu * NWAVES + I_.wave, NGW = F.G * NWAVES;
    const f32x4 gq = ((const f32x4*)P.in[I_QLATN])[I_.lane]; const f32x2 gk = ((const f32x2*)P.in[I_KVLATN])[I_.lane];
    for (int m = gw; m < NTOK; m += NGW) {
        const u32x2 wq = *((const u32x2*)(PROJ + (size_t)m * DINP + PC_CQ) + I_.lane); const unsigned wk = *((const unsigned*)(PROJ + (size_t)m * DINP + PC_CKV) + I_.lane);
        const f32x4 q = {bflo(wq.x), bfhi(wq.x), bflo(wq.y), bfhi(wq.y)}; const f32x2 k = {bflo(wk), bfhi(wk)};
        const float sq = wave_sum((q.x * q.x + q.y * q.y) + (q.z * q.z + q.w * q.w)), sk = wave_sum(k.x * k.x + k.y * k.y);
        const float rq = 1.0f / sqrtf(sq * (1.f / 256.f) + EPS), rk = 1.0f / sqrtf(sk * (1.f / 128.f) + EPS);
        const f32x4 yq = q * rq * gq; const f32x2 yk = k * rk * gk;
        *((u32x2*)((bf16_t*)(ws + WS_CQN) + (size_t)m * 256) + I_.lane) = (u32x2){cvt_pk_bf16(yq.x, yq.y), cvt_pk_bf16(yq.z, yq.w)};
        *((unsigned*)((bf16_t*)(ws + WS_CKVN) + (size_t)m * 128) + I_.lane) = cvt_pk_bf16(yk.x, yk.y);
    }
}

__device__ __forceinline__ void phase4(Frame& F) {
    PHASE_IDS();
    const Params& P = *F.P; unsigned char* ws = F.ws;
    const bf16_t* PROJ = (const bf16_t*)(ws + WS_PROJ);
    const float* cosB = (const float*)(ws + WS_ROPE) + 131072; const float* sinB = cosB + 32768;
    const int gw = F.vcu * NWAVES + I_.wave, NGW = F.G * NWAVES;
    for (int it = gw; it < (NTOK / 64) * 16; it += NGW) {
        const int h = it & 7, sel = (it >> 3) & 1, rg = it >> 4; const size_t row = (size_t)rg * 64 + I_.lane; const int pos = (int)(row & (SEQ - 1));
        u32x4 raw[12];
        bf16_t* qrow = (bf16_t*)(ws + WS_QB) + row * 768 + h * 96;
        if (sel == 0) {
#pragma unroll
            for (int c = 0; c < 12; ++c) raw[c] = *(const u32x4*)(qrow + 8 * c);
        } else {
            const bf16_t* kn = (const bf16_t*)(ws + WS_KV) + row * 1024 + h * 128; const bf16_t* kp = PROJ + row * DINP + PC_KPE;
#pragma unroll
            for (int c = 0; c < 8; ++c) raw[c] = *(const u32x4*)(kn + 8 * c);
#pragma unroll
            for (int c = 0; c < 4; ++c) raw[8 + c] = *(const u32x4*)(kp + 8 * c);
        }
        float ss = 0.f;
#pragma unroll
        for (int c = 0; c < 12; ++c) { f32x4 a0, a1; pg8::unpack8(raw[c], a0, a1); ss += (a0[0] * a0[0] + a0[1] * a0[1]) + (a0[2] * a0[2] + a0[3] * a0[3]) + (a1[0] * a1[0] + a1[1] * a1[1]) + (a1[2] * a1[2] + a1[3] * a1[3]); }
        const float rstd = 1.0f / sqrtf(ss * (1.f / 96.f) + EPS);
        const float* gn = sel ? P.in[I_MLAKN] : P.in[I_MLAQN];
        const float sc = sel ? 1.0f : C2B; const float rs = rstd * sc;
        bf16_t* dst = sel ? (bf16_t*)(ws + WS_KB2) + row * 768 + h * 96 : qrow;
#pragma unroll
        for (int c = 0; c < 8; ++c) { f32x4 a0, a1; pg8::unpack8(raw[c], a0, a1); const f32x4 g0 = *(const f32x4*)(gn + 8 * c), g1 = *(const f32x4*)(gn + 8 * c + 4);
            *(u32x4*)(dst + 8 * c) = pg8::pack8(a0 * g0 * rs, a1 * g1 * rs); }
#pragma unroll
        for (int c = 0; c < 2; ++c) { f32x4 x1a, x1b, x2a, x2b; pg8::unpack8(raw[8 + c], x1a, x1b); pg8::unpack8(raw[10 + c], x2a, x2b);
            const f32x4 g1a = *(const f32x4*)(gn + 64 + 8 * c), g1b = *(const f32x4*)(gn + 68 + 8 * c), g2a = *(const f32x4*)(gn + 80 + 8 * c), g2b = *(const f32x4*)(gn + 84 + 8 * c);
            x1a = x1a * g1a * rs; x1b = x1b * g1b * rs; x2a = x2a * g2a * rs; x2b = x2b * g2b * rs;
            const f32x4 ca = *(const f32x4*)(cosB + pos * 16 + 8 * c), cb = *(const f32x4*)(cosB + pos * 16 + 8 * c + 4), sa = *(const f32x4*)(sinB + pos * 16 + 8 * c), sb = *(const f32x4*)(sinB + pos * 16 + 8 * c + 4);
            *(u32x4*)(dst + 64 + 8 * c) = pg8::pack8(x1a * ca - x2a * sa, x1b * cb - x2b * sb);
            *(u32x4*)(dst + 80 + 8 * c) = pg8::pack8(x2a * ca + x1a * sa, x2b * cb + x1b * sb); }
    }
}

__device__ __forceinline__ void phase5(Frame& F) {
    unsigned char* ws = F.ws;
    for (int it = F.vcu; it < 256; it += F.G) {
        const int bh = it >> 2, sidx = it & 3, b = bh >> 3, h = bh & 7;
#pragma unroll 1
        for (int k = 0; k < 2; ++k) { const int qb = k ? 7 - sidx : sidx;
            att::attn_unit<64, true>(b, qb, (const bf16_t*)(ws + WS_QA2) + h * 64, 512, (const bf16_t*)(ws + WS_KA2) + h * 64, 512, (const bf16_t*)(ws + WS_PROJ) + PC_VA + h * 64, DINP,
                                     (bf16_t*)(ws + WS_Y) + h * 64, 1024, (const float*)(ws + WS_KMEAN) + (size_t)bh * 512, F.lds, F.wave); }
#pragma unroll 1
        for (int k = 0; k < 2; ++k) { const int qb = k ? 7 - sidx : sidx;
            att::attn_unit<96, false>(b, qb, (const bf16_t*)(ws + WS_QB) + h * 96, 768, (const bf16_t*)(ws + WS_KB2) + h * 96, 768, (const bf16_t*)(ws + WS_KV) + h * 128 + 64, 1024,
                                      (bf16_t*)(ws + WS_Y) + 512 + h * 64, 1024, nullptr, F.lds, F.wave); }
    }
}

__device__ __forceinline__ void phase8(Frame& F) {
    PHASE_IDS();
    const Params& P = *F.P; unsigned char* ws = F.ws;
    LAS int* pe = (LAS int*)F.lds;
    int* PAIR_E = (int*)(ws + WS_PAIR); int* PAIR_RANK = PAIR_E + 65536; float* PAIR_W = (float*)(PAIR_E + 131072);
    const f32x4* gp = (const f32x4*)P.in[I_GFFN] + I_.lane;
    const float* wr_ = P.in[I_WR]; const float* br_ = P.in[I_BR];
    const int rows_per_blk = NTOK / F.G;
    for (int rr = I_.wave; rr < rows_per_blk; rr += NWAVES) {
        const int m = F.vcu * rows_per_blk + rr;
        const f32x4* xr = (const f32x4*)(P.out + (size_t)m * DM) + I_.lane; float s = 0.f;
#pragma unroll
        for (int j = 0; j < 4; ++j) { const f32x4 v = xr[64 * j]; s += (v.x * v.x + v.y * v.y) + (v.z * v.z + v.w * v.w); }
        const float rstd = 1.0f / sqrtf(wave_sum(s) * (1.f / DM) + EPS);
        u32x2* o8 = (u32x2*)((bf16_t*)(ws + WS_HN) + (size_t)m * DM) + I_.lane;
        float lg[32];
#pragma unroll
        for (int e = 0; e < 32; ++e) lg[e] = 0.f;
#pragma unroll 1
        for (int j = 0; j < 4; ++j) { const f32x4 y = xr[64 * j] * rstd * gp[64 * j]; o8[64 * j] = (u32x2){cvt_pk_bf16(y.x, y.y), cvt_pk_bf16(y.z, y.w)};
#pragma unroll
            for (int i = 0; i < 4; ++i) { const f32x4* wrow = (const f32x4*)(wr_ + (size_t)(256 * j + 4 * I_.lane + i) * 32);
#pragma unroll
                for (int q = 0; q < 8; ++q) { const f32x4 w = wrow[q]; lg[4 * q] += y[i] * w.x; lg[4 * q + 1] += y[i] * w.y; lg[4 * q + 2] += y[i] * w.z; lg[4 * q + 3] += y[i] * w.w; }
                asm volatile("" ::: "memory"); } }
#pragma unroll
        for (int e = 0; e < 32; ++e) lg[e] = wave_sum(lg[e]) + br_[e];
        int te[4]; float tv[4]; unsigned used = 0u;
#pragma unroll
        for (int k = 0; k < 4; ++k) { float best = -INFINITY; int bi = 0;
#pragma unroll
            for (int e = 0; e < 32; ++e) { const bool ok = !((used >> e) & 1u) && (lg[e] > best); best = ok ? lg[e] : best; bi = ok ? e : bi; }
            used |= 1u << bi; te[k] = bi; tv[k] = best; }
        const float e0 = 1.0f, e1 = __expf(tv[1] - tv[0]), e2 = __expf(tv[2] - tv[0]), e3 = __expf(tv[3] - tv[0]); const float inv = 1.0f / (e0 + e1 + e2 + e3);
        if (I_.lane == 0) {
            PAIR_E[m * 4 + 0] = te[0]; PAIR_E[m * 4 + 1] = te[1]; PAIR_E[m * 4 + 2] = te[2]; PAIR_E[m * 4 + 3] = te[3];
            PAIR_W[m * 4 + 0] = e0 * inv; PAIR_W[m * 4 + 1] = e1 * inv; PAIR_W[m * 4 + 2] = e2 * inv; PAIR_W[m * 4 + 3] = e3 * inv;
            pe[rr * 4 + 0] = te[0]; pe[rr * 4 + 1] = te[1]; pe[rr * 4 + 2] = te[2]; pe[rr * 4 + 3] = te[3]; }
    }
    __syncthreads();
    if (I_.tid < 256) { const int e = pe[I_.tid]; int rank = 0;
        for (int j = 0; j < I_.tid; ++j) rank += (pe[j] == e) ? 1 : 0;
        PAIR_RANK[(F.vcu * rows_per_blk) * 4 + I_.tid] = rank; }
    if (I_.tid < 32) { int c = 0; for (int j = 0; j < 256; ++j) c += (pe[j] == I_.tid) ? 1 : 0; ((int*)(ws + WS_HIST))[F.vcu * 32 + I_.tid] = c; }
    __syncthreads();
}

__device__ __forceinline__ int moe_layout(Frame& F) {
    PHASE_IDS();
    LAS int* ctl = (LAS int*)(F.lds + LDS_CTL);
    const int* HIST = (const int*)(F.ws + WS_HIST);
    __syncthreads();
    if (I_.tid < 32) { int tot = 0, before = 0;
        for (int bb = 0; bb < F.G; ++bb) { const int c = HIST[bb * 32 + I_.tid]; tot += c; before += (bb < F.vcu) ? c : 0; }
        ctl[I_.tid] = tot; ctl[65 + I_.tid] = before; }
    __syncthreads();
    if (I_.tid == 0) { int row = 0, mt = 0;
        for (int e = 0; e < 32; ++e) { ctl[32 + e] = row; ctl[65 + e] += row; const int nt_ = (ctl[e] + 255) >> 8;
            for (int t = 0; t < nt_; ++t) ctl[128 + mt + t] = e;
            mt += nt_; row += nt_ * 256; }
        ctl[64] = row; ctl[100] = mt; }
    __syncthreads();
    return ctl[100];
}

__device__ __forceinline__ void phase9(Frame& F) {
    PHASE_IDS();
    unsigned char* ws = F.ws;
    moe_layout(F);
    LAS int* ctl = (LAS int*)(F.lds + LDS_CTL);
    const int* PAIR_E = (const int*)(ws + WS_PAIR); const int* PAIR_RANK = PAIR_E + 65536; int* ROWDEST = (int*)(ws + WS_PAIR) + 196608;
    const int rows_per_blk = NTOK / F.G;
    for (int pi = I_.wave; pi < rows_per_blk * 4; pi += NWAVES) {
        const int gp = F.vcu * rows_per_blk * 4 + pi; const int m = gp >> 2;
        const int e = PAIR_E[gp], rk = PAIR_RANK[gp]; const int dest = ctl[65 + e] + rk;
        if (I_.lane == 0) ROWDEST[gp] = dest;
        const u32x4* src = (const u32x4*)((const bf16_t*)(ws + WS_HN) + (size_t)m * DM) + I_.lane; u32x4* dst = (u32x4*)((bf16_t*)(ws + WS_XG) + (size_t)dest * DM) + I_.lane;
        dst[0] = src[0]; dst[64] = src[64];
    }
}

__device__ __forceinline__ void phase12(Frame& F) {
    PHASE_IDS();
    const Params& P = *F.P; unsigned char* ws = F.ws;
    const int gw = F.vcu * NWAVES + I_.wave, NGW = F.G * NWAVES;
    const float* PAIR_W = (const float*)(ws + WS_PAIR) + 131072; const int* ROWDEST = (const int*)(ws + WS_PAIR) + 196608;
    const bf16_t* YP = (const bf16_t*)(ws + WS_XG);
    const f32x4* gp = (const f32x4*)P.in[I_GPLE] + I_.lane; f32x4 gv[4];
#pragma unroll
    for (int j = 0; j < 4; ++j) gv[j] = gp[64 * j];
    for (int m = gw; m < NTOK; m += NGW) {
        f32x4* xr = (f32x4*)(P.out + (size_t)m * DM) + I_.lane; f32x4 v[4];
#pragma unroll
        for (int j = 0; j < 4; ++j) v[j] = xr[64 * j];
#pragma unroll
        for (int k = 0; k < 4; ++k) { const float w = PAIR_W[m * 4 + k]; const int d = ROWDEST[m * 4 + k]; const u32x2* yr = (const u32x2*)(YP + (size_t)d * DM) + I_.lane;
#pragma unroll
            for (int j = 0; j < 4; ++j) { const u32x2 y = yr[64 * j]; v[j] += (f32x4){bflo(y.x), bfhi(y.x), bflo(y.y), bfhi(y.y)} * w; } }
        float s = 0.f;
#pragma unroll
        for (int j = 0; j < 4; ++j) { xr[64 * j] = v[j]; s += (v[j].x * v[j].x + v[j].y * v[j].y) + (v[j].z * v[j].z + v[j].w * v[j].w); }
        const float rstd = 1.0f / sqrtf(wave_sum(s) * (1.f / DM) + EPS);
        u32x2* o8 = (u32x2*)((bf16_t*)(ws + WS_HN) + (size_t)m * DM) + I_.lane;
#pragma unroll
        for (int j = 0; j < 4; ++j) { const f32x4 y = v[j] * rstd * gv[j]; o8[64 * j] = (u32x2){cvt_pk_bf16(y.x, y.y), cvt_pk_bf16(y.z, y.w)}; }
    }
}

__global__ void __launch_bounds__(NTHREADS, 2) fwd(Params prm) {
    extern __shared__ __attribute__((aligned(16))) unsigned char lds_raw[];
    Frame F;
    F.lds = (LAS unsigned char*)lds_raw;
    F.wave = __builtin_amdgcn_readfirstlane((int)threadIdx.x >> 6);
    if (threadIdx.x < 2) ((volatile LAS unsigned*)(F.lds + LDS_BARST))[threadIdx.x] = 0u;
    const XcdBarrier bar = xcd_barrier_post((unsigned*)(prm.ws + WS_BAR), (volatile LAS unsigned*)(F.lds + LDS_BARST), F.wave);
    cg::this_grid().sync();
    F.G = gridDim.x; { const int bx = blockIdx.x; F.vcu = (F.G % 8 == 0) ? (bx % 8) * (F.G / 8) + bx / 8 : bx; }
    F.P = &prm; F.ws = prm.ws;
    unsigned char* ws = prm.ws;
    const int lo = prm.ph_lo, hi = prm.ph_hi;
#ifndef PH_MASK
#define PH_MASK 0xffffu
#endif
#define IN(k) (((PH_MASK >> (k)) & 1u) && lo <= (k) && (k) < hi)
#define SEAM(k) do { __builtin_amdgcn_sched_barrier(0); asm volatile("" ::: "memory"); if (IN(k) && IN((k) + 1)) xcd_barrier(bar); __builtin_amdgcn_sched_barrier(0); asm volatile("" ::: "memory"); } while (0)
    using namespace pg8;
    if (IN(0)) phase0(F);
    SEAM(0);
    if (IN(1)) { Gemm g{(const bf16_t*)(ws + WS_HN), (const bf16_t*)(ws + WS_WIN), DM, DM, DM}; StaticOrder S; S.init(NTOK, DINP, F.G, (int)blockIdx.x);
        EpiStore E{(bf16_t*)(ws + WS_PROJ), DINP, nullptr, 0, 8}; gemm_phase(F.lds, F.wave, g, S, E); }
    SEAM(1);
    if (IN(2)) phase2(F);
    SEAM(2);
    if (IN(3)) {
        { Gemm g{(const bf16_t*)(ws + WS_CQN), (const bf16_t*)(ws + WS_WUQ), 256, 256, 256}; StaticOrder S; S.init(NTOK, 768, F.G, (int)blockIdx.x);
          EpiStore E{(bf16_t*)(ws + WS_QB), 768, nullptr, 0, 1 << 30}; gemm_phase(F.lds, F.wave, g, S, E); }
        __builtin_amdgcn_sched_barrier(0); asm volatile("" ::: "memory");
        { Gemm g{(const bf16_t*)(ws + WS_CKVN), (const bf16_t*)(ws + WS_WUKV), 128, 128, 128}; StaticOrder S; S.init(NTOK, 1024, F.G, (int)blockIdx.x);
          EpiStore E{(bf16_t*)(ws + WS_KV), 1024, nullptr, 0, 1 << 30}; gemm_phase(F.lds, F.wave, g, S, E); } }
    SEAM(3);
    if (IN(4)) phase4(F);
    SEAM(4);
    if (IN(5)) phase5(F);
    SEAM(5);
    if (IN(6)) { Gemm g{(const bf16_t*)(ws + WS_Y), (const bf16_t*)(ws + WS_WA), DM, 512, 512}; StaticOrder S; S.init(NTOK, DM, F.G, (int)blockIdx.x);
        EpiGate<false> E{(bf16_t*)(ws + WS_MERGED), (const bf16_t*)(ws + WS_PROJ) + PC_GA, DINP}; gemm_phase(F.lds, F.wave, g, S, E); }
    SEAM(6);
    if (IN(7)) { Gemm g{(const bf16_t*)(ws + WS_Y) + 512, (const bf16_t*)(ws + WS_WB), DM, 512, 512}; StaticOrder S; S.init(NTOK, DM, F.G, (int)blockIdx.x);
        EpiGate<true> E{(bf16_t*)(ws + WS_MERGED), (const bf16_t*)(ws + WS_PROJ) + PC_GB, DINP}; gemm_phase(F.lds, F.wave, g, S, E); }
    SEAM(7);
    if (IN(8)) { Gemm g{(const bf16_t*)(ws + WS_MERGED), (const bf16_t*)(ws + WS_WO), DM, DM, DM}; StaticOrder S; S.init(NTOK, DM, F.G, (int)blockIdx.x);
        EpiResF32 E{prm.in[I_X], prm.out}; gemm_phase(F.lds, F.wave, g, S, E); }
    SEAM(8);
    if (IN(9)) phase8(F);
    SEAM(9);
    if (IN(10)) phase9(F);
    SEAM(10);
    if (IN(11)) { const int nmt = moe_layout(F);
        Gemm g{(const bf16_t*)(ws + WS_XG), (const bf16_t*)(ws + WS_W1), DM, DM, DM}; MoeOrder S{(const LAS int*)(F.lds + LDS_CTL) + 128, nmt, 8, F.G, (int)blockIdx.x};
        EpiSwiglu E{(bf16_t*)(ws + WS_ACT), prm.in[I_BGU]}; gemm_phase(F.lds, F.wave, g, S, E); }
    SEAM(11);
    if (IN(12)) { const int nmt = moe_layout(F);
        Gemm g{(const bf16_t*)(ws + WS_ACT), (const bf16_t*)(ws + WS_W2), DM, DM, DM}; MoeOrder S{(const LAS int*)(F.lds + LDS_CTL) + 128, nmt, 4, F.G, (int)blockIdx.x};
        EpiStore E{(bf16_t*)(ws + WS_XG), DM, prm.in[I_BD], 1024, 1 << 30}; gemm_phase(F.lds, F.wave, g, S, E); }
    SEAM(12);
    if (IN(13)) phase12(F);
    SEAM(13);
    if (IN(14)) { Gemm g{(const bf16_t*)(ws + WS_PB), (const bf16_t*)(ws + WS_WPP), 256, 256, 256}; StaticOrder S; S.init(NTOK, DM, F.G, (int)blockIdx.x);
        EpiStore E{(bf16_t*)(ws + WS_PP), DM, nullptr, 0, 1 << 30}; gemm_phase(F.lds, F.wave, g, S, E); }
    SEAM(14);
    if (IN(15)) { Gemm g{(const bf16_t*)(ws + WS_HN), (const bf16_t*)(ws + WS_WPG), DM, DM, DM}; StaticOrder S; S.init(NTOK, DM, F.G, (int)blockIdx.x);
        EpiFinal E{prm.out, (const bf16_t*)(ws + WS_PP)}; gemm_phase(F.lds, F.wave, g, S, E); }
#undef IN
#undef SEAM
}

extern "C" void kernel_launch(void* const* d_in, const int* in_sizes, int n_in, void* d_out, int out_size, void* d_ws, size_t ws_size, hipStream_t stream) {
    static int grid = 0;
    if (grid == 0) {
        int dev = 0, cus = 0, per_cu = 0;
        (void)hipGetDevice(&dev);
        (void)hipDeviceGetAttribute(&cus, hipDeviceAttributeMultiprocessorCount, dev);
        (void)hipFuncSetAttribute((const void*)fwd, hipFuncAttributeMaxDynamicSharedMemorySize, LDS_BYTES);
        (void)hipOccupancyMaxActiveBlocksPerMultiprocessor(&per_cu, (const void*)fwd, NTHREADS, LDS_BYTES);
        fprintf(stderr, "cus %d per_cu %d ws %zu n_in %d\n", cus, per_cu, ws_size, n_in);
        grid = (per_cu >= 1) ? cus : -1;
        if (grid != 256 || n_in != 25 || ws_size < WS_END || out_size != NTOK * DM) { fprintf(stderr, "kernel_launch: unsupported configuration\n"); grid = -1; }
    }
    if (grid < 0) return;
    (void)hipMemsetAsync((char*)d_ws + WS_BAR, 0, WS_BAR_BYTES, stream);
    Params a{};
    for (int i = 0; i < 25; ++i) a.in[i] = (const float*)d_in[i];
    a.out = (float*)d_out; a.ws = (unsigned char*)d_ws;
#ifndef MULTI_LAUNCH
    a.ph_lo = 0; a.ph_hi = NPHASE;
    void* args[] = {&a};
    hipError_t e = hipLaunchCooperativeKernel((const void*)fwd, dim3(grid), dim3(NTHREADS), args, LDS_BYTES, stream);
    if (e != hipSuccess) fprintf(stderr, "cooperative launch failed: %s\n", hipGetErrorString(e));
#else
    for (int k = 0; k < NPHASE; ++k) { a.ph_lo = k; a.ph_hi = k + 1; void* args[] = {&a};
        hipError_t e = hipLaunchCooperativeKernel((const void*)fwd, dim3(grid), dim3(NTHREADS), args, LDS_BYTES, stream);
        if (e != hipSuccess) fprintf(stderr, "launch %d failed: %s\n", k, hipGetErrorString(e)); }
#endif
}
```

```cpp
#include <hip/hip_runtime.h>
#include <hip/hip_cooperative_groups.h>
#include <cstdio>
#include <cstdint>
namespace cg = cooperative_groups;

#define LAS __attribute__((address_space(3)))
typedef unsigned short bf16_t;
typedef short bf16x8 __attribute__((ext_vector_type(8)));
typedef short s16x4 __attribute__((ext_vector_type(4)));
typedef float f32x4 __attribute__((ext_vector_type(4)));
typedef float f32x2 __attribute__((ext_vector_type(2)));
typedef float f32x16 __attribute__((ext_vector_type(16)));
typedef unsigned u32x4 __attribute__((ext_vector_type(4)));
typedef unsigned u32x2 __attribute__((ext_vector_type(2)));
typedef __bf16 bf16x2_t __attribute__((ext_vector_type(2)));

constexpr int NB = 8, SEQ = 2048, NTOK = NB * SEQ, DM = 1024;
constexpr int DIN = 4000, DINP = 4096;
constexpr int NEXP = 32, TOPK = 4, DEXP = 1024;
constexpr int NTHREADS = 512, NWAVES = 8;
constexpr float EPS = 1e-6f;
constexpr float LOG2E = 1.4426950408889634f;
constexpr float C2A = 0.125f * LOG2E;
constexpr float C2B = 0.10206207261596575f * LOG2E;
constexpr int PC_QA = 0, PC_KA = 512, PC_VA = 1024, PC_CQ = 1536, PC_CKV = 1792, PC_KPE = 1920, PC_GA = 2048, PC_GB = 3072;

constexpr size_t MiB = 1u << 20;
constexpr size_t WS_HIST = 0;
constexpr size_t WS_ERR = 64 * 1024;
constexpr size_t WS_BAR = 128 * 1024;
constexpr size_t WS_BAR_BYTES = 16 * 1024;
constexpr size_t WS_ROPE = 1 * MiB;
constexpr size_t WS_KMEAN = 2 * MiB;
constexpr size_t WS_PAIR = 3 * MiB;
constexpr size_t WS_WUQ = 4 * MiB, WS_WUKV = 4 * MiB + 512 * 1024, WS_WPP = 5 * MiB, WS_WA = 6 * MiB, WS_WB = 7 * MiB, WS_WO = 8 * MiB, WS_WPG = 10 * MiB, WS_WIN = 12 * MiB;
constexpr size_t WS_W1 = 20 * MiB, WS_W2 = 148 * MiB;
constexpr size_t WS_HN = 212 * MiB, WS_PB = 244 * MiB;
constexpr size_t WS_CQN = 252 * MiB, WS_CKVN = 260 * MiB, WS_QB = 264 * MiB, WS_KV = 288 * MiB, WS_KB2 = 320 * MiB, WS_Y = 344 * MiB, WS_MERGED = 376 * MiB;
constexpr size_t WS_ACT = 252 * MiB;
constexpr size_t WS_PP = 400 * MiB;
constexpr size_t WS_KA2 = 432 * MiB;
constexpr size_t WS_PROJ = 448 * MiB;
constexpr size_t WS_QA2 = 576 * MiB;
constexpr size_t WS_XG = 448 * MiB;
constexpr size_t WS_END = 592 * MiB;
constexpr int MAXROWS = 73728, MAXMT = 288;

constexpr int RING_BYTES = 131072;
constexpr int LDS_CTL = RING_BYTES;
constexpr int LDS_BARST = RING_BYTES + 8192;
constexpr int LDS_BYTES = 147456;

__device__ __forceinline__ unsigned cvt_pk_bf16(float lo, float hi) { f32x2 v = {lo, hi}; bf16x2_t b = __builtin_convertvector(v, bf16x2_t); return __builtin_bit_cast(unsigned, b); }
__device__ __forceinline__ float bf2f(unsigned short b) { return __uint_as_float(((unsigned)b) << 16); }
__device__ __forceinline__ float bflo(unsigned w) { return __uint_as_float(w << 16); }
__device__ __forceinline__ float bfhi(unsigned w) { return __uint_as_float(w & 0xffff0000u); }
__device__ __forceinline__ float sigmoidf_(float x) { return __builtin_amdgcn_rcpf(1.0f + __builtin_amdgcn_exp2f(-x * LOG2E)); }
__device__ __forceinline__ int lane_id() { return (int)__builtin_amdgcn_mbcnt_hi(~0u, __builtin_amdgcn_mbcnt_lo(~0u, 0u)); }
__device__ __forceinline__ float wave_sum(float v) {
#pragma unroll
    for (int o = 1; o < 64; o <<= 1) v += __shfl_xor(v, o);
    return v;
}

namespace pg8 {
constexpr int BM = 256, BK = 64, HALF = 128, HTB = HALF * BK * 2, STAGE_BYTES = 8 * HTB, NXCD = 8, WGM = 8;
__host__ __device__ __forceinline__ int lds_byte(int r, int c) { const int st = (r >> 4) * 2 + (c >> 5), rr = r & 15, cc = c & 31, ob = rr * 64 + cc * 2; return st * 1024 + (ob ^ (((ob >> 9) & 1) << 5)); }
__host__ __device__ __forceinline__ void stage_rc(int b, int& R, int& C) { const int st = b / 1024, sb = b % 1024, swz = sb ^ (((sb >> 9) & 1) << 5); R = (st >> 1) * 16 + swz / 64; C = (st & 1) * 32 + (swz % 64) / 2; }
__host__ __device__ __forceinline__ int perm32(int rho) { const int n = rho >> 4, i = rho & 15; return 8 * (i >> 2) + 4 * n + (i & 3); }

struct Unit { int pm, pn, pb, e; };
struct Gemm { const bf16_t* A; const bf16_t* Bt; int lda, ldb, K; };

struct StaticOrder {
    int nM, nN, nwg, G, c;
    __device__ void init(int M, int N, int G_, int c_) { nM = M / BM; nN = N / BM; nwg = nM * nN; G = G_; c = c_; }
    __device__ bool next(int i, Unit& u) const {
        const long L = (long)i * G + c; if (L >= nwg) return false;
        int wgid = (int)L; { const int q = nwg / NXCD, r = nwg % NXCD, xcd = wgid % NXCD, off = wgid / NXCD; wgid = (xcd < r ? xcd * (q + 1) : r * (q + 1) + (xcd - r) * q) + off; }
        const int nig = WGM * nN, gid = wgid / nig, fm = gid * WGM, gsz = (nM - fm) < WGM ? (nM - fm) : WGM;
        u.pm = fm + ((wgid % nig) % gsz); u.pn = (wgid % nig) / gsz; u.pb = u.pn; u.e = 0; return true;
    }
};
struct MoeOrder {
    const LAS int* tile_e; int nmt, ntn, G, c;
    __device__ bool next(int i, Unit& u) const {
        const long L = (long)i * G + c; if (L >= (long)nmt * ntn) return false;
        const int mt = (int)(L / ntn), pn = (int)(L % ntn); const int e = __builtin_amdgcn_readfirstlane(tile_e[mt]);
        u.pm = mt; u.pn = pn; u.pb = e * ntn + pn; u.e = e; return true;
    }
};

template <class Epi, class Sched>
__device__ __forceinline__ void gemm_phase(LAS unsigned char* lds, int wave, const Gemm g, const Sched& S, const Epi& E) {
    constexpr bool ALIGN_EPI = true;
    int lane = lane_id(); asm volatile("" : "+v"(lane));
    const int wid = wave, tid = wid * 64 + lane, wr = wid >> 2, wc = wid & 3, fr = lane & 15, fq = lane >> 4;
    int K = g.K; asm volatile("" : "+s"(K));
    const int nt = K / BK;
    unsigned voffA[2], voffB[2];
#pragma unroll
    for (int i = 0; i < 2; ++i) { int R, C; stage_rc(tid * 16 + i * 8192, R, C); const int Rb = (R & ~31) + perm32(R & 31);
        voffA[i] = (unsigned)(R * g.lda + C) * 2u; voffB[i] = (unsigned)(Rb * g.ldb + C) * 2u; }
    const size_t kstep = (size_t)(BK * 2);
    const size_t hstepA = (size_t)HALF * g.lda * 2, hstepB = (size_t)HALF * g.ldb * 2;
    const size_t tstepA = 2 * hstepA, tstepB = 2 * hstepB;
    const unsigned ldsw = (unsigned)wid * 1024u;
    const int aoff = lds_byte(wr * 64 + fr, fq * 8), boff = lds_byte(wc * 32 + fr, fq * 8);
#define PG8_SA(b, h) (((b) * 2 + (h)) * HTB)
#define PG8_SB(b, h) ((4 + (b) * 2 + (h)) * HTB)
#define PG8_STAGE(bufoff, gbase, voff) do { _Pragma("unroll") for (int _i = 0; _i < 2; ++_i) \
        __builtin_amdgcn_global_load_lds((const unsigned*)((const char*)(gbase) + (voff)[_i]), (LAS unsigned*)(lds + (bufoff) + ldsw + _i * 8192), 16, 0, 0); } while (0)
#define PG8_LDA(dst, b, h) do { _Pragma("unroll") for (int m = 0; m < 4; ++m) _Pragma("unroll") for (int k = 0; k < 2; ++k) dst[m][k] = *(const LAS bf16x8*)(lds + PG8_SA(b, h) + aoff + m * 2048 + k * 1024); } while (0)
#define PG8_LDB(dst, b, h) do { _Pragma("unroll") for (int n = 0; n < 2; ++n) _Pragma("unroll") for (int k = 0; k < 2; ++k) dst[n][k] = *(const LAS bf16x8*)(lds + PG8_SB(b, h) + boff + n * 2048 + k * 1024); } while (0)
#define PG8_MMA(ai, bj, At, Bt) do { __builtin_amdgcn_s_setprio(1); _Pragma("unroll") for (int m = 0; m < 4; ++m) _Pragma("unroll") for (int n = 0; n < 2; ++n) _Pragma("unroll") for (int k = 0; k < 2; ++k) \
        acc[ai][bj][m][n] = __builtin_amdgcn_mfma_f32_16x16x32_bf16(Bt[n][k], At[m][k], acc[ai][bj][m][n], 0, 0, 0); __builtin_amdgcn_s_setprio(0); } while (0)
#define PG8_WAIT_V(n) asm volatile("s_waitcnt vmcnt(" #n ")" ::: "memory")
#define PG8_WAIT_L(n) asm volatile("s_waitcnt lgkmcnt(" #n ")" ::: "memory")
#define PG8_BAR __builtin_amdgcn_s_barrier()
#define PG8_SCHED __builtin_amdgcn_sched_barrier(0)
    Unit cur, nxt; int ui = 0;
    if (!S.next(0, cur)) return;
    f32x4 acc[2][2][4][2];
#pragma unroll
    for (int a = 0; a < 2; ++a)
#pragma unroll
        for (int b = 0; b < 2; ++b)
#pragma unroll
            for (int m = 0; m < 4; ++m)
#pragma unroll
                for (int n = 0; n < 2; ++n) acc[a][b][m][n] = (f32x4){0.f, 0.f, 0.f, 0.f};
    bf16x8 At[4][2], B0[2][2], B1[2][2];
    const char* cA = (const char*)g.A + (size_t)cur.pm * tstepA; const char* cB = (const char*)g.Bt + (size_t)cur.pb * tstepB;
    PG8_STAGE(PG8_SB(0, 0), cB, voffB); PG8_STAGE(PG8_SB(0, 1), cB + hstepB, voffB); PG8_STAGE(PG8_SA(0, 0), cA, voffA); PG8_STAGE(PG8_SA(0, 1), cA + hstepA, voffA);
    if (wr == 1) PG8_BAR;
    PG8_WAIT_V(2); PG8_BAR;
    PG8_STAGE(PG8_SB(1, 0), cB + kstep, voffB); PG8_STAGE(PG8_SA(1, 0), cA + kstep, voffA); PG8_STAGE(PG8_SB(1, 1), cB + hstepB + kstep, voffB);
    PG8_WAIT_V(6); PG8_BAR;
    for (;;) {
        const bool has_next = S.next(ui + 1, nxt);
        const char* nA = has_next ? (const char*)g.A + (size_t)nxt.pm * tstepA : cA; const char* nB = has_next ? (const char*)g.Bt + (size_t)nxt.pb * tstepB : cB;
        for (int t = 0; t < nt; t += 2) {
            const bool last = (t == nt - 2);
            const char* a1 = cA + (size_t)(t + 1) * kstep;
            const char* a2 = last ? nA : cA + (size_t)(t + 2) * kstep; const char* b2 = last ? nB : cB + (size_t)(t + 2) * kstep;
            const char* a3 = a2 + kstep; const char* b3 = b2 + kstep;
            PG8_LDB(B0, 0, 0); PG8_LDB(B1, 0, 1); PG8_SCHED; PG8_LDA(At, 0, 0); PG8_STAGE(PG8_SA(1, 1), a1 + hstepA, voffA);
            PG8_WAIT_V(8); PG8_WAIT_L(0); PG8_BAR; PG8_MMA(0, 0, At, B0); PG8_MMA(0, 1, At, B1); PG8_BAR; PG8_SCHED;
            PG8_LDA(At, 0, 1); PG8_STAGE(PG8_SB(0, 0), b2, voffB); PG8_STAGE(PG8_SB(0, 1), b2 + hstepB, voffB); PG8_STAGE(PG8_SA(0, 0), a2, voffA);
            PG8_WAIT_V(8); PG8_WAIT_L(0); PG8_BAR; PG8_MMA(1, 0, At, B0); PG8_MMA(1, 1, At, B1); PG8_BAR; PG8_SCHED;
            PG8_LDB(B0, 1, 0); PG8_LDB(B1, 1, 1); PG8_SCHED; PG8_LDA(At, 1, 0); PG8_STAGE(PG8_SA(0, 1), a2 + hstepA, voffA);
            PG8_WAIT_V(8); PG8_WAIT_L(0); PG8_BAR; PG8_MMA(0, 0, At, B0); PG8_MMA(0, 1, At, B1); PG8_BAR; PG8_SCHED;
            PG8_LDA(At, 1, 1); PG8_STAGE(PG8_SB(1, 0), b3, voffB); PG8_STAGE(PG8_SB(1, 1), b3 + hstepB, voffB); PG8_STAGE(PG8_SA(1, 0), a3, voffA);
            PG8_WAIT_V(8); PG8_WAIT_L(0); PG8_BAR; PG8_MMA(1, 0, At, B0); PG8_MMA(1, 1, At, B1); PG8_BAR; PG8_SCHED;
        }
        if constexpr (ALIGN_EPI) { if (wr == 0) PG8_BAR; }
        E(acc, cur, wr, wc, fr, fq);
        if (!has_next) break;
#pragma unroll
        for (int a = 0; a < 2; ++a)
#pragma unroll
            for (int b = 0; b < 2; ++b)
#pragma unroll
                for (int m = 0; m < 4; ++m)
#pragma unroll
                    for (int n = 0; n < 2; ++n) acc[a][b][m][n] = (f32x4){0.f, 0.f, 0.f, 0.f};
        cur = nxt; cA = nA; cB = nB; ++ui;
        if constexpr (ALIGN_EPI) { if (wr == 1) PG8_BAR; }
    }
    PG8_WAIT_V(0);
    if constexpr (!ALIGN_EPI) { if (wr == 0) PG8_BAR; }
    PG8_BAR;
#undef PG8_SA
#undef PG8_SB
#undef PG8_STAGE
#undef PG8_LDA
#undef PG8_LDB
#undef PG8_MMA
#undef PG8_WAIT_V
#undef PG8_WAIT_L
#undef PG8_BAR
#undef PG8_SCHED
}

#define EPI_ARGS const f32x4 (&acc)[2][2][4][2], const Unit& u, int wr, int wc, int fr, int fq
__device__ __forceinline__ u32x4 pack8(f32x4 v0, f32x4 v1) { u32x4 w; w.x = cvt_pk_bf16(v0[0], v0[1]); w.y = cvt_pk_bf16(v0[2], v0[3]); w.z = cvt_pk_bf16(v1[0], v1[1]); w.w = cvt_pk_bf16(v1[2], v1[3]); return w; }
__device__ __forceinline__ void unpack8(u32x4 w, f32x4& v0, f32x4& v1) { v0 = (f32x4){bflo(w.x), bfhi(w.x), bflo(w.y), bfhi(w.y)}; v1 = (f32x4){bflo(w.z), bfhi(w.z), bflo(w.w), bfhi(w.w)}; }
__device__ __forceinline__ f32x4 sig4(f32x4 v) { return (f32x4){sigmoidf_(v[0]), sigmoidf_(v[1]), sigmoidf_(v[2]), sigmoidf_(v[3])}; }

struct EpiStore {
    bf16_t* O; int ldc; const float* bias; int bias_stride; int sig_from;
    __device__ __forceinline__ void operator()(EPI_ARGS) const {
        const int row0 = u.pm * BM + wr * 64 + fr, col0 = u.pn * BM + wc * 32 + 8 * fq;
        const bool sg = u.pn >= sig_from;
        f32x4 bv[2][2];
#pragma unroll
        for (int bj = 0; bj < 2; ++bj)
#pragma unroll
            for (int n = 0; n < 2; ++n) bv[bj][n] = bias ? *(const f32x4*)(bias + (size_t)u.e * bias_stride + col0 + bj * HALF + 4 * n) : (f32x4){0.f, 0.f, 0.f, 0.f};
#pragma unroll
        for (int ai = 0; ai < 2; ++ai)
#pragma unroll
            for (int m = 0; m < 4; ++m) { bf16_t* rowp = O + (size_t)(row0 + ai * HALF + m * 16) * ldc + col0;
#pragma unroll
                for (int bj = 0; bj < 2; ++bj) { f32x4 v0 = acc[ai][bj][m][0] + bv[bj][0], v1 = acc[ai][bj][m][1] + bv[bj][1];
                    if (sg) { v0 = sig4(v0); v1 = sig4(v1); }
                    *(u32x4*)(rowp + bj * HALF) = pack8(v0, v1); } }
    }
};
template <bool ADD> struct EpiGate {
    bf16_t* O; const bf16_t* G; int ldg;
    __device__ __forceinline__ void operator()(EPI_ARGS) const {
        const int row0 = u.pm * BM + wr * 64 + fr, col0 = u.pn * BM + wc * 32 + 8 * fq;
#pragma unroll
        for (int ai = 0; ai < 2; ++ai)
#pragma unroll
            for (int m = 0; m < 4; ++m) { const size_t r = (size_t)(row0 + ai * HALF + m * 16);
#pragma unroll
                for (int bj = 0; bj < 2; ++bj) { const int c = col0 + bj * HALF;
                    f32x4 g0, g1; unpack8(*(const u32x4*)(G + r * ldg + c), g0, g1);
                    f32x4 v0 = acc[ai][bj][m][0] * g0, v1 = acc[ai][bj][m][1] * g1;
                    if (ADD) { f32x4 o0, o1; unpack8(*(const u32x4*)(O + r * DM + c), o0, o1); v0 += o0; v1 += o1; }
                    *(u32x4*)(O + r * DM + c) = pack8(v0, v1); } }
    }
};
struct EpiResF32 {
    const float* base; float* out;
    __device__ __forceinline__ void operator()(EPI_ARGS) const {
        const int row0 = u.pm * BM + wr * 64 + fr, col0 = u.pn * BM + wc * 32 + 8 * fq;
#pragma unroll
        for (int ai = 0; ai < 2; ++ai)
#pragma unroll
            for (int m = 0; m < 4; ++m) { const size_t r = (size_t)(row0 + ai * HALF + m * 16);
#pragma unroll
                for (int bj = 0; bj < 2; ++bj) { const size_t off = r * DM + col0 + bj * HALF;
                    const f32x4 b0 = *(const f32x4*)(base + off), b1 = *(const f32x4*)(base + off + 4);
                    *(f32x4*)(out + off) = b0 + acc[ai][bj][m][0]; *(f32x4*)(out + off + 4) = b1 + acc[ai][bj][m][1]; } }
    }
};
struct EpiSwiglu {
    bf16_t* O; const float* bias;
    __device__ __forceinline__ void operator()(EPI_ARGS) const {
        const int row0 = u.pm * BM + wr * 64 + fr, j0 = u.pn * HALF + wc * 32 + 8 * fq;
        const float* be = bias + (size_t)u.e * 2048;
        f32x4 bg[2], bu[2];
#pragma unroll
        for (int n = 0; n < 2; ++n) { bg[n] = *(const f32x4*)(be + j0 + 4 * n); bu[n] = *(const f32x4*)(be + 1024 + j0 + 4 * n); }
#pragma unroll
        for (int ai = 0; ai < 2; ++ai)
#pragma unroll
            for (int m = 0; m < 4; ++m) { bf16_t* rowp = O + (size_t)(row0 + ai * HALF + m * 16) * DEXP + j0;
                f32x4 o[2];
#pragma unroll
                for (int n = 0; n < 2; ++n) { const f32x4 gv = acc[ai][0][m][n] + bg[n], uv = acc[ai][1][m][n] + bu[n];
#pragma unroll
                    for (int i = 0; i < 4; ++i) { const float gg = fminf(gv[i], 7.0f), uu = fminf(fmaxf(uv[i], -7.0f), 7.0f);
                        o[n][i] = (uu + 1.0f) * gg * __builtin_amdgcn_rcpf(1.0f + __builtin_amdgcn_exp2f(-1.702f * LOG2E * gg)); } }
                *(u32x4*)rowp = pack8(o[0], o[1]); }
    }
};
struct EpiFinal {
    float* out; const bf16_t* PP;
    __device__ __forceinline__ void operator()(EPI_ARGS) const {
        const int row0 = u.pm * BM + wr * 64 + fr, col0 = u.pn * BM + wc * 32 + 8 * fq;
#pragma unroll
        for (int ai = 0; ai < 2; ++ai)
#pragma unroll
            for (int m = 0; m < 4; ++m) { const size_t r = (size_t)(row0 + ai * HALF + m * 16);
#pragma unroll
                for (int bj = 0; bj < 2; ++bj) { const size_t off = r * DM + col0 + bj * HALF;
                    f32x4 p0, p1; unpack8(*(const u32x4*)(PP + off), p0, p1);
                    const f32x4 b0 = *(const f32x4*)(out + off), b1 = *(const f32x4*)(out + off + 4);
                    *(f32x4*)(out + off) = b0 + sig4(acc[ai][bj][m][0]) * p0; *(f32x4*)(out + off + 4) = b1 + sig4(acc[ai][bj][m][1]) * p1; } }
    }
};
}

namespace att {
__device__ __forceinline__ int crow(int r, int hi) { return (r & 3) + 8 * (r >> 2) + 4 * hi; }
__device__ __forceinline__ void glds16(const void* gsrc, unsigned lds_dst) { unsigned keep;
    asm volatile("s_mov_b32 %0, m0\n\ts_mov_b32 m0, %2\n\ts_nop 0\n\tglobal_load_lds_dwordx4 %1, off\n\ts_mov_b32 m0, %0" : "=&s"(keep) : "v"(gsrc), "s"(lds_dst) : "memory"); }
__device__ __forceinline__ s16x4 vtr(const LAS unsigned char* p) { return __builtin_bit_cast(s16x4, __builtin_amdgcn_ds_read_tr16_b64_v4i16((LAS s16x4*)p)); }
#define MX3(a, b, c) __builtin_fmaxf(__builtin_fmaxf((a), (b)), (c))
constexpr int VSLOT = 8192, OST_BYTES = NWAVES * 4096, WSF_BYTES = NWAVES * 256;

template <int DQK, bool MOBA>
__device__ __forceinline__ void attn_unit(int b, int qb, const bf16_t* Qh, int ldq, const bf16_t* Kh, int ldk, const bf16_t* Vh, int ldv, bf16_t* Oh, int ldo, const float* kmean, LAS unsigned char* shm, int wave) {
    constexpr int ND = DQK / 16, NCH = DQK / 8, KSLOT = NCH * 1024;
    constexpr int LDS_K = 0, LDS_V = 2 * KSLOT, LDS_WS = LDS_V + 2 * VSLOT, LDS_OST = LDS_WS + WSF_BYTES;
    static_assert(LDS_OST + OST_BYTES <= RING_BYTES, "attention LDS");
    int lane = lane_id(); asm volatile("" : "+v"(lane));
    const int r32 = lane & 31, hi = lane >> 5; const int wid = wave;
    const long rowbase = (long)b * SEQ; const int q0 = qb * 256;
    const unsigned lds0 = (unsigned)(uintptr_t)shm;
    LAS float* wsf = (LAS float*)(shm + LDS_WS) + wid * 64;
    const int NT = 4 * (qb + 1);
    const bf16_t* ksrc0 = Kh + (rowbase + lane) * ldk + wid * 8;
    const bf16_t* vsrc0 = Vh + (rowbase + 16 * (wid & 3) + (lane >> 2)) * ldv + (wid >> 2) * 32 + (lane & 3) * 8;
#define ATT_DMA(kt, s) do { const long ro_ = (long)(kt) * 64; \
        glds16(ksrc0 + ro_ * ldk, (unsigned)__builtin_amdgcn_readfirstlane(lds0 + LDS_K + (s) * KSLOT + wid * 1024)); \
        if (NCH > 8 && wid < NCH - 8) glds16(ksrc0 + ro_ * ldk + 64, (unsigned)__builtin_amdgcn_readfirstlane(lds0 + LDS_K + (s) * KSLOT + (wid + 8) * 1024)); \
        glds16(vsrc0 + ro_ * ldv, (unsigned)__builtin_amdgcn_readfirstlane(lds0 + LDS_V + (s) * VSLOT + wid * 1024)); } while (0)
#define ATT_TILE(i) (MOBA ? ((i) < 4 ? 4 * qb + (i) : (i) - 4) : (i))
    ATT_DMA(ATT_TILE(0), 0);
    const bf16_t* Qw = Qh + (rowbase + q0 + wid * 32 + r32) * ldq + hi * 8;
    bf16x8 qr[ND];
#pragma unroll
    for (int d0 = 0; d0 < ND; ++d0) qr[d0] = *(const bf16x8*)(Qw + d0 * 16);
    unsigned bmask = 0xffffffffu;
    if (MOBA) {
        bmask = 1u << qb;
        if (qb <= 3) bmask |= (1u << qb) - 1u;
        else {
            float gsc[7];
#pragma unroll
            for (int n = 0; n < 7; ++n) { float s = 0.f;
                if (n < qb) {
#pragma unroll
                    for (int d0 = 0; d0 < ND; ++d0) { const float* km = kmean + n * 64 + d0 * 16 + hi * 8; const f32x4 k0 = *(const f32x4*)km, k1 = *(const f32x4*)(km + 4);
                        s += bf2f((unsigned short)qr[d0][0]) * k0[0] + bf2f((unsigned short)qr[d0][1]) * k0[1] + bf2f((unsigned short)qr[d0][2]) * k0[2] + bf2f((unsigned short)qr[d0][3]) * k0[3]
                           + bf2f((unsigned short)qr[d0][4]) * k1[0] + bf2f((unsigned short)qr[d0][5]) * k1[1] + bf2f((unsigned short)qr[d0][6]) * k1[2] + bf2f((unsigned short)qr[d0][7]) * k1[3]; }
                    s += __shfl_xor(s, 32);
                } else s = -INFINITY;
                gsc[n] = s; }
#pragma unroll
            for (int pass = 0; pass < 3; ++pass) { float best = -INFINITY; int bi = 0;
#pragma unroll
                for (int n = 0; n < 7; ++n) { const bool ok = (n < qb) && !((bmask >> n) & 1u) && (gsc[n] > best); best = ok ? gsc[n] : best; bi = ok ? n : bi; }
                bmask |= 1u << bi; }
        }
    }
    float mhat = 0.f, l_reg = 0.f; f32x16 o[2]; o[0] = f32x16{}; o[1] = f32x16{}; f32x16 negm = f32x16{}; asm volatile("" : "+v"(negm));
    const int qrel = wid * 32 + r32;
    const LAS unsigned char* kp0 = shm + LDS_K + hi * 1024 + r32 * 16;
    const LAS unsigned char* vp0 = shm + LDS_V + ((lane >> 4) & 1) * 32 + (lane & 3) * 8 + (4 * hi + ((lane & 15) >> 2)) * 64;
    for (int i = 0; i < NT; ++i) {
        const int s = i & 1, kt = ATT_TILE(i);
        asm volatile("s_waitcnt vmcnt(0) lgkmcnt(0)\n\ts_barrier" ::: "memory");
        if (i + 1 < NT) ATT_DMA(ATT_TILE(i + 1), s ^ 1);
        f32x16 cin = negm;
        if (MOBA) { if (i >= 4 && !((bmask >> (kt >> 2)) & 1u)) {
#pragma unroll
            for (int r = 0; r < 16; ++r) cin[r] = -INFINITY; } }
        f32x16 p0, p1;
        { const LAS unsigned char* kb = kp0 + s * KSLOT;
#pragma unroll
            for (int d0 = 0; d0 < ND; ++d0) { const bf16x8 b0 = *(const LAS bf16x8*)(kb + d0 * 2048), b1 = *(const LAS bf16x8*)(kb + d0 * 2048 + 512);
                if (d0 == 0) { p0 = __builtin_amdgcn_mfma_f32_32x32x16_bf16(b0, qr[0], cin, 0, 0, 0); p1 = __builtin_amdgcn_mfma_f32_32x32x16_bf16(b1, qr[0], cin, 0, 0, 0); }
                else { p0 = __builtin_amdgcn_mfma_f32_32x32x16_bf16(b0, qr[d0], p0, 0, 0, 0); p1 = __builtin_amdgcn_mfma_f32_32x32x16_bf16(b1, qr[d0], p1, 0, 0, 0); } } }
        if (kt >= 4 * qb) { const int kb = 64 * (kt - 4 * qb) + 4 * hi;
#pragma unroll
            for (int r = 0; r < 16; ++r) { const int kv = kb + (r & 3) + 8 * (r >> 2); if (kv > qrel) p0[r] = -INFINITY; if (kv + 32 > qrel) p1[r] = -INFINITY; } }
        bool resc = false;
        { float a = MX3(p0[0], p0[1], p1[0]), bb = MX3(p0[2], p0[3], p1[1]); a = MX3(a, p1[2], p1[3]);
#pragma unroll
            for (int r = 4; r < 16; r += 4) { a = MX3(a, p0[r], p0[r + 1]); bb = MX3(bb, p0[r + 2], p0[r + 3]); a = MX3(a, p1[r], p1[r + 1]); bb = MX3(bb, p1[r + 2], p1[r + 3]); }
            float rm = __builtin_fmaxf(a, bb); rm = __builtin_fmaxf(rm, __shfl_xor(rm, 32));
            const bool first = (i == 0);
            if (first || __any(rm > 6.0f)) {
                const float dl = first ? rm : __builtin_fmaxf(rm, 0.f); mhat += dl;
#pragma unroll
                for (int r = 0; r < 16; ++r) { p0[r] -= dl; p1[r] -= dl; }
#pragma unroll
                for (int r = 0; r < 16; ++r) negm[r] = -mhat;
                asm volatile("" : "+v"(negm));
                const float f = __builtin_amdgcn_exp2f(-dl); l_reg *= f; if (hi == 0) wsf[r32] = f; resc = true; } }
        float sacc = 0.f;
#pragma unroll
        for (int r = 0; r < 16; ++r) { p0[r] = __builtin_amdgcn_exp2f(p0[r]); p1[r] = __builtin_amdgcn_exp2f(p1[r]); sacc += p0[r] + p1[r]; }
        l_reg += sacc;
        u32x4 pw0, pw1, pw2, pw3;
        pw0 = (u32x4){cvt_pk_bf16(p0[0], p0[1]), cvt_pk_bf16(p0[2], p0[3]), cvt_pk_bf16(p0[4], p0[5]), cvt_pk_bf16(p0[6], p0[7])};
        pw1 = (u32x4){cvt_pk_bf16(p0[8], p0[9]), cvt_pk_bf16(p0[10], p0[11]), cvt_pk_bf16(p0[12], p0[13]), cvt_pk_bf16(p0[14], p0[15])};
        pw2 = (u32x4){cvt_pk_bf16(p1[0], p1[1]), cvt_pk_bf16(p1[2], p1[3]), cvt_pk_bf16(p1[4], p1[5]), cvt_pk_bf16(p1[6], p1[7])};
        pw3 = (u32x4){cvt_pk_bf16(p1[8], p1[9]), cvt_pk_bf16(p1[10], p1[11]), cvt_pk_bf16(p1[12], p1[13]), cvt_pk_bf16(p1[14], p1[15])};
        if (resc) {
#pragma unroll
            for (int d_ = 0; d_ < 2; ++d_)
#pragma unroll
                for (int r = 0; r < 16; ++r) o[d_][r] *= wsf[crow(r, hi)];
        }
        { const LAS unsigned char* vp = vp0 + s * VSLOT;
#pragma unroll
            for (int d0 = 0; d0 < 2; ++d0) {
                s16x4 lo[4], hh[4];
#pragma unroll
                for (int ks = 0; ks < 4; ++ks) { lo[ks] = vtr(vp + d0 * 4096 + ks * 1024); hh[ks] = vtr(vp + d0 * 4096 + ks * 1024 + 512); }
#define PKV(k) (bf16x8){lo[k][0], lo[k][1], lo[k][2], lo[k][3], hh[k][0], hh[k][1], hh[k][2], hh[k][3]}
                o[d0] = __builtin_amdgcn_mfma_f32_32x32x16_bf16(__builtin_bit_cast(bf16x8, pw0), PKV(0), o[d0], 0, 0, 0);
                o[d0] = __builtin_amdgcn_mfma_f32_32x32x16_bf16(__builtin_bit_cast(bf16x8, pw1), PKV(1), o[d0], 0, 0, 0);
                o[d0] = __builtin_amdgcn_mfma_f32_32x32x16_bf16(__builtin_bit_cast(bf16x8, pw2), PKV(2), o[d0], 0, 0, 0);
                o[d0] = __builtin_amdgcn_mfma_f32_32x32x16_bf16(__builtin_bit_cast(bf16x8, pw3), PKV(3), o[d0], 0, 0, 0);
#undef PKV
            } }
    }
    l_reg += __shfl_xor(l_reg, 32);
    if (hi == 0) wsf[32 + r32] = l_reg;
    float rli[16];
#pragma unroll
    for (int r = 0; r < 16; ++r) rli[r] = __builtin_amdgcn_rcpf(wsf[32 + crow(r, hi)]);
    bf16_t* Ow = Oh + (rowbase + q0 + wid * 32) * ldo;
    { LAS bf16_t* stg = (LAS bf16_t*)(shm + LDS_OST) + wid * 2048;
#pragma unroll
        for (int r = 0; r < 16; ++r) { const int orow = crow(r, hi);
#pragma unroll
            for (int d0 = 0; d0 < 2; ++d0) stg[orow * 64 + d0 * 32 + r32] = (bf16_t)(cvt_pk_bf16(o[d0][r] * rli[r], 0.f) & 0xffffu); }
#pragma unroll
        for (int i = 0; i < 4; ++i) { const int row = i * 8 + (lane >> 3), ch = lane & 7; const u32x4 v = *(const LAS u32x4*)(stg + row * 64 + ch * 8); *(u32x4*)(Ow + (long)row * ldo + ch * 8) = v; } }
    asm volatile("s_waitcnt vmcnt(0) lgkmcnt(0)\n\ts_barrier" ::: "memory");
#undef ATT_DMA
#undef ATT_TILE
}
#undef MX3
}

#define XB_TMO      128
#define XB_XCNT(j)  (256  + 64 * (j))
#define XB_XSUB(j)  (1280 + 64 * (j))
#define XB_XGEN(j)  (2304 + 64 * (j))
#define XB_TOP      3328
#define XB_TOPGEN   3392
#define XCD_BAR_WORDS 3456
#define XB_SPIN_CAP (1u << 22)
__device__ __forceinline__ unsigned xb_ld(unsigned* p)              { return __hip_atomic_load(p, __ATOMIC_RELAXED, __HIP_MEMORY_SCOPE_AGENT); }
__device__ __forceinline__ unsigned xb_add(unsigned* p, unsigned v) { return __hip_atomic_fetch_add(p, v, __ATOMIC_RELAXED, __HIP_MEMORY_SCOPE_AGENT); }
__device__ __forceinline__ unsigned xb_xcc_id() { return (unsigned)__builtin_amdgcn_s_getreg((3 << 11) | 20) & 0xFu; }
#define XB_SPIN(cond, bar) do { unsigned _sp = 0; while (cond) { __builtin_amdgcn_s_sleep(1); \
    if ((++_sp & 255u) == 0u) { if (xb_ld(&(bar)[XB_TMO])) break; if (_sp > XB_SPIN_CAP) { atomicAdd(&(bar)[XB_TMO], 1u); break; } } } } while (0)
struct XcdBarrier { unsigned* bar; unsigned x; volatile LAS unsigned* st; int wave; };
__device__ __forceinline__ XcdBarrier xcd_barrier_post(unsigned* bar, volatile LAS unsigned* st, int wave) {
    XcdBarrier b; b.bar = bar; b.x = xb_xcc_id(); b.st = st; b.wave = wave;
    if (wave == 0 && lane_id() == 0) (void)xb_add(&bar[XB_XCNT(b.x)], 1u);
    return b;
}
__device__ __forceinline__ void xcd_barrier_complete(unsigned* bar, unsigned x, unsigned& nloc, unsigned& nx) {
    const unsigned G = gridDim.x * gridDim.y * gridDim.z;
    unsigned sum, cnt, mine, sp = 0u;
    for (;;) {
        sum = 0u; cnt = 0u; mine = 0u;
#pragma unroll
        for (unsigned j = 0; j < 16; ++j) { const unsigned c = xb_ld(&bar[XB_XCNT(j)]); sum += c; cnt += (c > 0u) ? 1u : 0u; mine = (j == x) ? c : mine; }
        if (sum == G) break;
        __builtin_amdgcn_s_sleep(1);
        if ((++sp & 255u) == 0u) { if (xb_ld(&bar[XB_TMO])) break; if (sp > XB_SPIN_CAP) { atomicAdd(&bar[XB_TMO], 1u); break; } }
    }
    nloc = mine > 0u ? mine : 1u; nx = cnt > 0u ? cnt : 1u;
}
__device__ __forceinline__ void xcd_barrier(const XcdBarrier& b) {
    asm volatile("s_waitcnt vmcnt(0)" ::: "memory");
    __syncthreads();
    if (b.wave == 0 && lane_id() == 0) {
        unsigned* bar = b.bar;
        __builtin_amdgcn_s_waitcnt(0);
        unsigned nloc = b.st[0], nx = b.st[1];
        if (nloc == 0u) { xcd_barrier_complete(bar, b.x, nloc, nx); b.st[0] = nloc; b.st[1] = nx; }
        const unsigned old = xb_add(&bar[XB_XSUB(b.x)], 1u);
        const unsigned gen = old / nloc;
        if (old + 1u == (gen + 1u) * nloc) {
            __builtin_amdgcn_fence(__ATOMIC_RELEASE, "agent");
            asm volatile("s_waitcnt vmcnt(0)" ::: "memory");
            const unsigned og = xb_add(&bar[XB_TOP], 1u);
            const unsigned tg = og / nx;
            if (og + 1u == (tg + 1u) * nx) xb_add(&bar[XB_TOPGEN], 1u);
            else XB_SPIN(xb_ld(&bar[XB_TOPGEN]) == tg, bar);
            __builtin_amdgcn_fence(__ATOMIC_ACQUIRE, "agent");
            xb_add(&bar[XB_XGEN(b.x)], 1u);
            asm volatile("s_waitcnt vmcnt(0)" ::: "memory");
        } else {
            XB_SPIN(xb_ld(&bar[XB_XGEN(b.x)]) == gen, bar);
            __builtin_amdgcn_fence(__ATOMIC_ACQUIRE, "agent");
            asm volatile("s_waitcnt vmcnt(0)" ::: "memory");
        }
    }
    __syncthreads();
}

struct Params { const float* in[25]; float* out; unsigned char* ws; int ph_lo, ph_hi; };
enum { I_X = 0, I_P, I_GMIX, I_WIN, I_MQN, I_MKN, I_QLATN, I_WUQ, I_KVLATN, I_WUKV, I_MLAQN, I_MLAKN, I_WA, I_WB, I_WO, I_GFFN, I_WR, I_BR, I_WGU, I_BGU, I_WD, I_BD, I_GPLE, I_WPG, I_WPP };
constexpr int NPHASE = 16;

struct Frame {
    LAS unsigned char* lds; int vcu, G, wave;
    const Params* P; unsigned char* ws;
};
struct Ids { int tid, lane, wave; };
#define PHASE_IDS() Ids I_; { int l_ = lane_id(); asm volatile("" : "+v"(l_)); I_.lane = l_; I_.wave = F.wave; I_.tid = F.wave * 64 + l_; }

__device__ __forceinline__ void tr_item(const float* W, int ldw, int k0, int n0, bf16_t* dst, int ldd, LAS float* scr, int lane) {
#pragma unroll 8
    for (int i = 0; i < 32; ++i) { const int kk = 2 * i + (lane >> 5); scr[kk * 33 + (lane & 31)] = W[(size_t)(k0 + kk) * ldw + n0 + (lane & 31)]; }
    asm volatile("s_waitcnt lgkmcnt(0)" ::: "memory");
    const int c = lane & 7;
#pragma unroll
    for (int j = 0; j < 4; ++j) { const int n = (lane >> 3) + 8 * j; const LAS float* s = scr + (8 * c) * 33 + n;
        u32x4 o; o.x = cvt_pk_bf16(s[0 * 33], s[1 * 33]); o.y = cvt_pk_bf16(s[2 * 33], s[3 * 33]); o.z = cvt_pk_bf16(s[4 * 33], s[5 * 33]); o.w = cvt_pk_bf16(s[6 * 33], s[7 * 33]);
        *(u32x4*)(dst + (size_t)n * ldd + k0 + 8 * c) = o; }
    asm volatile("s_waitcnt lgkmcnt(0)" ::: "memory");
}

__device__ __forceinline__ void phase0(Frame& F) {
    PHASE_IDS();
    const Params& P = *F.P; unsigned char* ws = F.ws;
    LAS float* scr = (LAS float*)(F.lds + I_.wave * 16384);
    const int gw = F.vcu * NWAVES + I_.wave, NGW = F.G * NWAVES;
    constexpr int I_IN = 16 * 125, I_UQ = 4 * 24, I_UKV = 2 * 32, I_A = 8 * 32, I_O = 16 * 32, I_PP = 4 * 32, I_GU = 32 * 16 * 64, I_DN = 32 * 16 * 32;
    constexpr int NITEMS = I_IN + I_UQ + I_UKV + 2 * I_A + 2 * I_O + I_PP + I_GU + I_DN;
    for (int it = gw; it < NITEMS; it += NGW) {
        int r = it;
        if (r < I_GU) { const int e = r / 1024, q = r % 1024, kb = q / 64, g = q % 64; const int c = 32 * g; const int dr = (c < 1024) ? 256 * (c / 128) + (c % 128) : 256 * ((c - 1024) / 128) + 128 + ((c - 1024) % 128);
            tr_item(P.in[I_WGU] + (size_t)e * 1024 * 2048, 2048, 64 * kb, c, (bf16_t*)(ws + WS_W1) + ((size_t)e * 2048 + dr) * 1024, 1024, scr, I_.lane); continue; } r -= I_GU;
        if (r < I_DN) { const int e = r / 512, q = r % 512, kb = q / 32, g = q % 32;
            tr_item(P.in[I_WD] + (size_t)e * 1024 * 1024, 1024, 64 * kb, 32 * g, (bf16_t*)(ws + WS_W2) + ((size_t)e * 1024 + 32 * g) * 1024, 1024, scr, I_.lane); continue; } r -= I_DN;
        if (r < I_IN) { const int kb = r / 125, g = r % 125; const int dr = 32 * (g < 61 ? g : g + 3);
            tr_item(P.in[I_WIN], DIN, 64 * kb, 32 * g, (bf16_t*)(ws + WS_WIN) + (size_t)dr * 1024, 1024, scr, I_.lane); continue; } r -= I_IN;
        if (r < I_UQ) { const int kb = r / 24, g = r % 24; tr_item(P.in[I_WUQ], 768, 64 * kb, 32 * g, (bf16_t*)(ws + WS_WUQ) + (size_t)(32 * g) * 256, 256, scr, I_.lane); continue; } r -= I_UQ;
        if (r < I_UKV) { const int kb = r / 32, g = r % 32; tr_item(P.in[I_WUKV], 1024, 64 * kb, 32 * g, (bf16_t*)(ws + WS_WUKV) + (size_t)(32 * g) * 128, 128, scr, I_.lane); continue; } r -= I_UKV;
        if (r < I_A) { const int kb = r / 32, g = r % 32; tr_item(P.in[I_WA], 1024, 64 * kb, 32 * g, (bf16_t*)(ws + WS_WA) + (size_t)(32 * g) * 512, 512, scr, I_.lane); continue; } r -= I_A;
        if (r < I_A) { const int kb = r / 32, g = r % 32; tr_item(P.in[I_WB], 1024, 64 * kb, 32 * g, (bf16_t*)(ws + WS_WB) + (size_t)(32 * g) * 512, 512, scr, I_.lane); continue; } r -= I_A;
        if (r < I_O) { const int kb = r / 32, g = r % 32; tr_item(P.in[I_WO], 1024, 64 * kb, 32 * g, (bf16_t*)(ws + WS_WO) + (size_t)(32 * g) * 1024, 1024, scr, I_.lane); continue; } r -= I_O;
        if (r < I_O) { const int kb = r / 32, g = r % 32; tr_item(P.in[I_WPG], 1024, 64 * kb, 32 * g, (bf16_t*)(ws + WS_WPG) + (size_t)(32 * g) * 1024, 1024, scr, I_.lane); continue; } r -= I_O;
        { const int kb = r / 32, g = r % 32; tr_item(P.in[I_WPP], 1024, 64 * kb, 32 * g, (bf16_t*)(ws + WS_WPP) + (size_t)(32 * g) * 256, 256, scr, I_.lane); }
    }
    { const f32x4* gp = (const f32x4*)P.in[I_GMIX] + I_.lane; f32x4 gv[4];
#pragma unroll
        for (int j = 0; j < 4; ++j) gv[j] = gp[64 * j];
        for (int m = gw; m < NTOK; m += NGW) { const f32x4* xr = (const f32x4*)(P.in[I_X] + (size_t)m * DM) + I_.lane; f32x4 v[4]; float s = 0.f;
#pragma unroll
            for (int j = 0; j < 4; ++j) { v[j] = xr[64 * j]; s += (v[j].x * v[j].x + v[j].y * v[j].y) + (v[j].z * v[j].z + v[j].w * v[j].w); }
            const float rstd = 1.0f / sqrtf(wave_sum(s) * (1.f / DM) + EPS);
            u32x2* o8 = (u32x2*)((bf16_t*)(ws + WS_HN) + (size_t)m * DM) + I_.lane;
#pragma unroll
            for (int j = 0; j < 4; ++j) { const f32x4 y = v[j] * rstd * gv[j]; o8[64 * j] = (u32x2){cvt_pk_bf16(y.x, y.y), cvt_pk_bf16(y.z, y.w)}; } } }
    { const size_t n4 = (size_t)NTOK * 256 / 4; const f32x4* pp = (const f32x4*)P.in[I_P]; u32x2* po = (u32x2*)(ws + WS_PB);
        for (size_t i = (size_t)F.vcu * NTHREADS + I_.tid; i < n4; i += (size_t)F.G * NTHREADS) { const f32x4 v = pp[i]; po[i] = (u32x2){cvt_pk_bf16(v.x, v.y), cvt_pk_bf16(v.z, v.w)}; } }
    { float* tab = (float*)(ws + WS_ROPE);
        for (int i = F.vcu * NTHREADS + I_.tid; i < 2048 * 48; i += F.G * NTHREADS) {
            int pos, j, half; float* cdst; float* sdst;
            if (i < 2048 * 32) { pos = i / 32; j = i % 32; half = 32; cdst = tab + i; sdst = tab + 65536 + i; }
            else { const int q = i - 2048 * 32; pos = q / 16; j = q % 16; half = 16; cdst = tab + 131072 + q; sdst = tab + 131072 + 32768 + q; }
            const float inv = powf(10000.0f, -((float)j / (float)half)); const float ang = (float)pos * inv;
            *cdst = cosf(ang); *sdst = sinf(ang); } }
}

__device__ __forceinline__ void phase2(Frame& F) {
    PHASE_IDS();
    const Params& P = *F.P; unsigned char* ws = F.ws;
    const bf16_t* PROJ = (const bf16_t*)(ws + WS_PROJ);
    const float* cosA = (const float*)(ws + WS_ROPE); const float* sinA = cosA + 65536;
    LAS float* kst = (LAS float*)F.lds;
    LAS float* part = kst + 256 * 65;
    for (int it = F.vcu; it < 512; it += F.G) {
        const int b = it >> 6, blk = (it >> 3) & 7, h = it & 7;
        const int sel = I_.lane >> 5, r = I_.wave * 32 + (I_.lane & 31); const int pos = blk * 256 + r; const size_t row = (size_t)b * SEQ + pos;
        const u32x4* src = (const u32x4*)(PROJ + row * DINP + (sel ? PC_KA : PC_QA) + h * 64);
        float v[64]; float ss = 0.f;
#pragma unroll
        for (int c = 0; c < 8; ++c) { const u32x4 w = src[c]; f32x4 a0, a1; pg8::unpack8(w, a0, a1);
#pragma unroll
            for (int j = 0; j < 4; ++j) { v[8 * c + j] = a0[j]; v[8 * c + 4 + j] = a1[j]; ss += a0[j] * a0[j] + a1[j] * a1[j]; } }
        const float rstd = 1.0f / sqrtf(ss * (1.f / 64.f) + EPS);
        const float* gn = sel ? P.in[I_MKN] : P.in[I_MQN];
#pragma unroll
        for (int d = 0; d < 64; ++d) v[d] = v[d] * rstd * gn[d];
        const float sc = sel ? 1.0f : C2A;
#pragma unroll
        for (int i = 0; i < 32; ++i) { const float c = cosA[pos * 32 + i], s = sinA[pos * 32 + i]; const float x1 = v[i], x2 = v[i + 32]; v[i] = x1 * c - x2 * s; v[i + 32] = x2 * c + x1 * s; }
        bf16_t* dst = (bf16_t*)(ws + (sel ? WS_KA2 : WS_QA2)) + row * 512 + h * 64;
#pragma unroll
        for (int c = 0; c < 8; ++c) { u32x4 w; w.x = cvt_pk_bf16(v[8 * c] * sc, v[8 * c + 1] * sc); w.y = cvt_pk_bf16(v[8 * c + 2] * sc, v[8 * c + 3] * sc); w.z = cvt_pk_bf16(v[8 * c + 4] * sc, v[8 * c + 5] * sc); w.w = cvt_pk_bf16(v[8 * c + 6] * sc, v[8 * c + 7] * sc);
            *(u32x4*)(dst + 8 * c) = w; }
        if (sel) {
#pragma unroll
            for (int d = 0; d < 64; ++d) kst[r * 65 + d] = v[d]; }
        __syncthreads();
        { const int d = I_.tid & 63, pt = I_.tid >> 6; float s = 0.f;
            for (int rr = 0; rr < 32; ++rr) s += kst[(pt * 32 + rr) * 65 + d];
            part[pt * 64 + d] = s; }
        __syncthreads();
        if (I_.tid < 64) { float s = 0.f;
#pragma unroll
            for (int pt = 0; pt < 8; ++pt) s += part[pt * 64 + I_.tid];
            ((float*)(ws + WS_KMEAN))[(((size_t)b * 8 + h) * 8 + blk) * 64 + I_.tid] = s * (1.f / 256.f); }
        __syncthreads();
    }
    const int gw = F.vcu * NWAVES + I_.wave, NGW = F.G * NWAVES;
    const f32x4 gq = ((const f32x4*)P.in[I_QLATN])[I_.lane]; const f32x2 gk = ((const f32x2*)P.in[I_KVLATN])[I_.lane];
    for (int m = gw; m < NTOK; m += NGW) {
        const u32x2 wq = *((const u32x2*)(PROJ + (size_t)m * DINP + PC_CQ) + I_.lane); const unsigned wk = *((const unsigned*)(PROJ + (size_t)m * DINP + PC_CKV) + I_.lane);
        const f32x4 q = {bflo(wq.x), bfhi(wq.x), bflo(wq.y), bfhi(wq.y)}; const f32x2 k = {bflo(wk), bfhi(wk)};
        const float sq = wave_sum((q.x * q.x + q.y * q.y) + (q.z * q.z + q.w * q.w)), sk = wave_sum(k.x * k.x + k.y * k.y);
        const float rq = 1.0f / sqrtf(sq * (1.f / 256.f) + EPS), rk = 1.0f / sqrtf(sk * (1.f / 128.f) + EPS);
        const f32x4 yq = q * rq * gq; const f32x2 yk = k * rk * gk;
        *((u32x2*)((bf16_t*)(ws + WS_CQN) + (size_t)m * 256) + I_.lane) = (u32x2){cvt_pk_bf16(yq.x, yq.y), cvt_pk_bf16(yq.z, yq.w)};
        *((unsigned*)((bf16_t*)(ws + WS_CKVN) + (size_t)m * 128) + I_.lane) = cvt_pk_bf16(yk.x, yk.y);
    }
}

__device__ __forceinline__ void phase4(Frame& F) {
    PHASE_IDS();
    const Params& P = *F.P; unsigned char* ws = F.ws;
    const bf16_t* PROJ = (const bf16_t*)(ws + WS_PROJ);
    const float* cosB = (const float*)(ws + WS_ROPE) + 131072; const float* sinB = cosB + 32768;
    const int gw = F.vcu * NWAVES + I_.wave, NGW = F.G * NWAVES;
    for (int it = gw; it < (NTOK / 64) * 16; it += NGW) {
        const int h = it & 7, sel = (it >> 3) & 1, rg = it >> 4; const size_t row = (size_t)rg * 64 + I_.lane; const int pos = (int)(row & (SEQ - 1));
        u32x4 raw[12];
        bf16_t* qrow = (bf16_t*)(ws + WS_QB) + row * 768 + h * 96;
        if (sel == 0) {
#pragma unroll
            for (int c = 0; c < 12; ++c) raw[c] = *(const u32x4*)(qrow + 8 * c);
        } else {
            const bf16_t* kn = (const bf16_t*)(ws + WS_KV) + row * 1024 + h * 128; const bf16_t* kp = PROJ + row * DINP + PC_KPE;
#pragma unroll
            for (int c = 0; c < 8; ++c) raw[c] = *(const u32x4*)(kn + 8 * c);
#pragma unroll
            for (int c = 0; c < 4; ++c) raw[8 + c] = *(const u32x4*)(kp + 8 * c);
        }
        float ss = 0.f;
#pragma unroll
        for (int c = 0; c < 12; ++c) { f32x4 a0, a1; pg8::unpack8(raw[c], a0, a1); ss += (a0[0] * a0[0] + a0[1] * a0[1]) + (a0[2] * a0[2] + a0[3] * a0[3]) + (a1[0] * a1[0] + a1[1] * a1[1]) + (a1[2] * a1[2] + a1[3] * a1[3]); }
        const float rstd = 1.0f / sqrtf(ss * (1.f / 96.f) + EPS);
        const float* gn = sel ? P.in[I_MLAKN] : P.in[I_MLAQN];
        const float sc = sel ? 1.0f : C2B; const float rs = rstd * sc;
        bf16_t* dst = sel ? (bf16_t*)(ws + WS_KB2) + row * 768 + h * 96 : qrow;
#pragma unroll
        for (int c = 0; c < 8; ++c) { f32x4 a0, a1; pg8::unpack8(raw[c], a0, a1); const f32x4 g0 = *(const f32x4*)(gn + 8 * c), g1 = *(const f32x4*)(gn + 8 * c + 4);
            *(u32x4*)(dst + 8 * c) = pg8::pack8(a0 * g0 * rs, a1 * g1 * rs); }
#pragma unroll
        for (int c = 0; c < 2; ++c) { f32x4 x1a, x1b, x2a, x2b; pg8::unpack8(raw[8 + c], x1a, x1b); pg8::unpack8(raw[10 + c], x2a, x2b);
            const f32x4 g1a = *(const f32x4*)(gn + 64 + 8 * c), g1b = *(const f32x4*)(gn + 68 + 8 * c), g2a = *(const f32x4*)(gn + 80 + 8 * c), g2b = *(const f32x4*)(gn + 84 + 8 * c);
            x1a = x1a * g1a * rs; x1b = x1b * g1b * rs; x2a = x2a * g2a * rs; x2b = x2b * g2b * rs;
            const f32x4 ca = *(const f32x4*)(cosB + pos * 16 + 8 * c), cb = *(const f32x4*)(cosB + pos * 16 + 8 * c + 4), sa = *(const f32x4*)(sinB + pos * 16 + 8 * c), sb = *(const f32x4*)(sinB + pos * 16 + 8 * c + 4);
            *(u32x4*)(dst + 64 + 8 * c) = pg8::pack8(x1a * ca - x2a * sa, x1b * cb - x2b * sb);
            *(u32x4*)(dst + 80 + 8 * c) = pg8::pack8(x2a * ca + x1a * sa, x2b * cb + x1b * sb); }
    }
}

__device__ __forceinline__ void phase5(Frame& F) {
    unsigned char* ws = F.ws;
    for (int it = F.vcu; it < 256; it += F.G) {
        const int bh = it >> 2, sidx = it & 3, b = bh >> 3, h = bh & 7;
#pragma unroll 1
        for (int k = 0; k < 2; ++k) { const int qb = k ? 7 - sidx : sidx;
            att::attn_unit<64, true>(b, qb, (const bf16_t*)(ws + WS_QA2) + h * 64, 512, (const bf16_t*)(ws + WS_KA2) + h * 64, 512, (const bf16_t*)(ws + WS_PROJ) + PC_VA + h * 64, DINP,
                                     (bf16_t*)(ws + WS_Y) + h * 64, 1024, (const float*)(ws + WS_KMEAN) + (size_t)bh * 512, F.lds, F.wave); }
#pragma unroll 1
        for (int k = 0; k < 2; ++k) { const int qb = k ? 7 - sidx : sidx;
            att::attn_unit<96, false>(b, qb, (const bf16_t*)(ws + WS_QB) + h * 96, 768, (const bf16_t*)(ws + WS_KB2) + h * 96, 768, (const bf16_t*)(ws + WS_KV) + h * 128 + 64, 1024,
                                      (bf16_t*)(ws + WS_Y) + 512 + h * 64, 1024, nullptr, F.lds, F.wave); }
    }
}

__device__ __forceinline__ void phase8(Frame& F) {
    PHASE_IDS();
    const Params& P = *F.P; unsigned char* ws = F.ws;
    constexpr int HCS = 132;
    LAS float* HC = (LAS float*)F.lds;
    LAS float* RSTD = HC + 2 * 64 * HCS;
    LAS float* LOGIT = RSTD + 64;
    LAS int* pe = (LAS int*)(LOGIT + 64 * 33);
    int* PAIR_E = (int*)(ws + WS_PAIR); int* PAIR_RANK = PAIR_E + 65536; float* PAIR_W = (float*)(PAIR_E + 131072);
    const float* gffn = P.in[I_GFFN]; const float* wr_ = P.in[I_WR]; const float* br_ = P.in[I_BR];
    const int r0 = F.vcu * 64;
    { const f32x4* gp = (const f32x4*)gffn + I_.lane;
        for (int rr = I_.wave * 8; rr < I_.wave * 8 + 8; ++rr) { const int m = r0 + rr;
            const f32x4* xr = (const f32x4*)(P.out + (size_t)m * DM) + I_.lane; f32x4 v[4]; float s = 0.f;
#pragma unroll
            for (int j = 0; j < 4; ++j) { v[j] = xr[64 * j]; s += (v[j].x * v[j].x + v[j].y * v[j].y) + (v[j].z * v[j].z + v[j].w * v[j].w); }
            const float rstd = 1.0f / sqrtf(wave_sum(s) * (1.f / DM) + EPS);
            if (I_.lane == 0) RSTD[rr] = rstd;
            u32x2* o8 = (u32x2*)((bf16_t*)(ws + WS_HN) + (size_t)m * DM) + I_.lane;
#pragma unroll
            for (int j = 0; j < 4; ++j) { const f32x4 y = v[j] * rstd * gp[64 * j]; o8[64 * j] = (u32x2){cvt_pk_bf16(y.x, y.y), cvt_pk_bf16(y.z, y.w)}; } } }
    __syncthreads();
    const int eg = I_.wave & 1, rgp = I_.wave >> 1, l15 = I_.lane & 15, l4 = I_.lane >> 4;
    const int srow = I_.tid >> 5, sc4 = I_.tid & 31;
    f32x4 stg[4];
#define P8_LOAD(kc) do { _Pragma("unroll") for (int i = 0; i < 4; ++i) stg[i] = *(const f32x4*)(P.out + (size_t)(r0 + srow + 16 * i) * DM + (kc) * 128 + 4 * sc4); } while (0)
#define P8_STORE(kc, buf) do { const f32x4 g4 = *(const f32x4*)(gffn + (kc) * 128 + 4 * sc4); _Pragma("unroll") for (int i = 0; i < 4; ++i) { const float rs = RSTD[srow + 16 * i]; \
        *(LAS f32x4*)(HC + ((buf) * 64 + srow + 16 * i) * HCS + 4 * sc4) = stg[i] * rs * g4; } } while (0)
    P8_LOAD(0); P8_STORE(0, 0);
    __syncthreads();
    f32x4 acc = {0.f, 0.f, 0.f, 0.f};
#pragma unroll 1
    for (int kc = 0; kc < 8; ++kc) { const int buf = kc & 1;
        if (kc + 1 < 8) P8_LOAD(kc + 1);
        const float* wp = wr_ + (size_t)(kc * 128 + l4) * 32 + eg * 16 + l15;
        const LAS float* hp = HC + (buf * 64 + rgp * 16 + l15) * HCS + l4;
        float a[32];
#pragma unroll
        for (int kk = 0; kk < 32; ++kk) a[kk] = wp[(size_t)kk * 128];
#pragma unroll
        for (int kk = 0; kk < 32; ++kk) acc = __builtin_amdgcn_mfma_f32_16x16x4f32(a[kk], hp[4 * kk], acc, 0, 0, 0);
        if (kc + 1 < 8) P8_STORE(kc + 1, buf ^ 1);
        __syncthreads(); }
#undef P8_LOAD
#undef P8_STORE
#pragma unroll
    for (int i = 0; i < 4; ++i) { const int e = eg * 16 + 4 * l4 + i; LOGIT[(rgp * 16 + l15) * 33 + e] = acc[i] + br_[e]; }
    __syncthreads();
    if (I_.tid < 64) { const int rr = I_.tid, m = r0 + rr;
        float lg[32];
#pragma unroll
        for (int e = 0; e < 32; ++e) lg[e] = LOGIT[rr * 33 + e];
        int te[4]; float tv[4]; unsigned used = 0u;
#pragma unroll
        for (int k = 0; k < 4; ++k) { float best = -INFINITY; int bi = 0;
#pragma unroll
            for (int e = 0; e < 32; ++e) { const bool ok = !((used >> e) & 1u) && (lg[e] > best); best = ok ? lg[e] : best; bi = ok ? e : bi; }
            used |= 1u << bi; te[k] = bi; tv[k] = best; }
        const float e0 = 1.0f, e1 = __expf(tv[1] - tv[0]), e2 = __expf(tv[2] - tv[0]), e3 = __expf(tv[3] - tv[0]); const float inv = 1.0f / (e0 + e1 + e2 + e3);
        *(int4*)(PAIR_E + m * 4) = make_int4(te[0], te[1], te[2], te[3]);
        *(f32x4*)(PAIR_W + m * 4) = (f32x4){e0 * inv, e1 * inv, e2 * inv, e3 * inv};
        pe[rr * 4 + 0] = te[0]; pe[rr * 4 + 1] = te[1]; pe[rr * 4 + 2] = te[2]; pe[rr * 4 + 3] = te[3]; }
    __syncthreads();
    if (I_.tid < 256) { const int e = pe[I_.tid]; int rank = 0;
        for (int j = 0; j < I_.tid; ++j) rank += (pe[j] == e) ? 1 : 0;
        PAIR_RANK[r0 * 4 + I_.tid] = rank; }
    if (I_.tid >= 256 && I_.tid < 288) { const int e = I_.tid - 256; int c = 0; for (int j = 0; j < 256; ++j) c += (pe[j] == e) ? 1 : 0; ((int*)(ws + WS_HIST))[F.vcu * 32 + e] = c; }
    __syncthreads();
}

__device__ __forceinline__ int moe_layout(Frame& F) {
    PHASE_IDS();
    LAS int* ctl = (LAS int*)(F.lds + LDS_CTL);
    LAS int* part = ctl + 512;
    const int* HIST = (const int*)(F.ws + WS_HIST);
    __syncthreads();
    { const int e = I_.tid & 31, pt = I_.tid >> 5; int tot = 0, before = 0; int c[16];
#pragma unroll
        for (int i = 0; i < 16; ++i) c[i] = HIST[(pt * 16 + i) * 32 + e];
#pragma unroll
        for (int i = 0; i < 16; ++i) { tot += c[i]; before += (pt * 16 + i < F.vcu) ? c[i] : 0; }
        part[pt * 64 + e] = tot; part[pt * 64 + 32 + e] = before; }
    __syncthreads();
    if (I_.tid < 32) { int tot = 0, before = 0;
#pragma unroll
        for (int pt = 0; pt < 16; ++pt) { tot += part[pt * 64 + I_.tid]; before += part[pt * 64 + 32 + I_.tid]; }
        ctl[I_.tid] = tot; ctl[65 + I_.tid] = before; }
    __syncthreads();
    if (I_.tid == 0) { int row = 0, mt = 0;
        for (int e = 0; e < 32; ++e) { ctl[32 + e] = row; ctl[65 + e] += row; const int nt_ = (ctl[e] + 255) >> 8;
            for (int t = 0; t < nt_; ++t) ctl[128 + mt + t] = e;
            mt += nt_; row += nt_ * 256; }
        ctl[64] = row; ctl[100] = mt; }
    __syncthreads();
    return ctl[100];
}

__device__ __forceinline__ void phase9(Frame& F) {
    PHASE_IDS();
    unsigned char* ws = F.ws;
    moe_layout(F);
    LAS int* ctl = (LAS int*)(F.lds + LDS_CTL);
    const int* PAIR_E = (const int*)(ws + WS_PAIR); const int* PAIR_RANK = PAIR_E + 65536; int* ROWDEST = (int*)(ws + WS_PAIR) + 196608;
    const int rows_per_blk = NTOK / F.G;
    for (int pi = I_.wave; pi < rows_per_blk * 4; pi += NWAVES) {
        const int gp = F.vcu * rows_per_blk * 4 + pi; const int m = gp >> 2;
        const int e = PAIR_E[gp], rk = PAIR_RANK[gp]; const int dest = ctl[65 + e] + rk;
        if (I_.lane == 0) ROWDEST[gp] = dest;
        const u32x4* src = (const u32x4*)((const bf16_t*)(ws + WS_HN) + (size_t)m * DM) + I_.lane; u32x4* dst = (u32x4*)((bf16_t*)(ws + WS_XG) + (size_t)dest * DM) + I_.lane;
        dst[0] = src[0]; dst[64] = src[64];
    }
}

__device__ __forceinline__ void phase12(Frame& F) {
    PHASE_IDS();
    const Params& P = *F.P; unsigned char* ws = F.ws;
    const int gw = F.vcu * NWAVES + I_.wave, NGW = F.G * NWAVES;
    const float* PAIR_W = (const float*)(ws + WS_PAIR) + 131072; const int* ROWDEST = (const int*)(ws + WS_PAIR) + 196608;
    const bf16_t* YP = (const bf16_t*)(ws + WS_XG);
    const f32x4* gp = (const f32x4*)P.in[I_GPLE] + I_.lane; f32x4 gv[4];
#pragma unroll
    for (int j = 0; j < 4; ++j) gv[j] = gp[64 * j];
    for (int m = gw; m < NTOK; m += NGW) {
        f32x4* xr = (f32x4*)(P.out + (size_t)m * DM) + I_.lane; f32x4 v[4];
#pragma unroll
        for (int j = 0; j < 4; ++j) v[j] = xr[64 * j];
#pragma unroll
        for (int k = 0; k < 4; ++k) { const float w = PAIR_W[m * 4 + k]; const int d = ROWDEST[m * 4 + k]; const u32x2* yr = (const u32x2*)(YP + (size_t)d * DM) + I_.lane;
#pragma unroll
            for (int j = 0; j < 4; ++j) { const u32x2 y = yr[64 * j]; v[j] += (f32x4){bflo(y.x), bfhi(y.x), bflo(y.y), bfhi(y.y)} * w; } }
        float s = 0.f;
#pragma unroll
        for (int j = 0; j < 4; ++j) { xr[64 * j] = v[j]; s += (v[j].x * v[j].x + v[j].y * v[j].y) + (v[j].z * v[j].z + v[j].w * v[j].w); }
        const float rstd = 1.0f / sqrtf(wave_sum(s) * (1.f / DM) + EPS);
        u32x2* o8 = (u32x2*)((bf16_t*)(ws + WS_HN) + (size_t)m * DM) + I_.lane;
#pragma unroll
        for (int j = 0; j < 4; ++j) { const f32x4 y = v[j] * rstd * gv[j]; o8[64 * j] = (u32x2){cvt_pk_bf16(y.x, y.y), cvt_pk_bf16(y.z, y.w)}; }
    }
}

__global__ void __launch_bounds__(NTHREADS, 2) fwd(Params prm) {
    extern __shared__ __attribute__((aligned(16))) unsigned char lds_raw[];
    Frame F;
    F.lds = (LAS unsigned char*)lds_raw;
    F.wave = __builtin_amdgcn_readfirstlane((int)threadIdx.x >> 6);
    if (threadIdx.x < 2) ((volatile LAS unsigned*)(F.lds + LDS_BARST))[threadIdx.x] = 0u;
    const XcdBarrier bar = xcd_barrier_post((unsigned*)(prm.ws + WS_BAR), (volatile LAS unsigned*)(F.lds + LDS_BARST), F.wave);
    cg::this_grid().sync();
    F.G = gridDim.x; { const int bx = blockIdx.x; F.vcu = (F.G % 8 == 0) ? (bx % 8) * (F.G / 8) + bx / 8 : bx; }
    F.P = &prm; F.ws = prm.ws;
    unsigned char* ws = prm.ws;
    const int lo = prm.ph_lo, hi = prm.ph_hi;
#ifndef PH_MASK
#define PH_MASK 0xffffu
#endif
#ifndef REP_MASK
#define REP_MASK 0u
#endif
#define IN(k) (((PH_MASK >> (k)) & 1u) && lo <= (k) && (k) < hi)
#define REPS(k) for (int rep_ = 0; rep_ < (((REP_MASK >> (k)) & 1u) ? 2 : 1); ++rep_, (((REP_MASK >> (k)) & 1u) && rep_ < 2 ? xcd_barrier(bar) : (void)0))
#define SEAM(k) do { __builtin_amdgcn_sched_barrier(0); asm volatile("" ::: "memory"); if (IN(k) && IN((k) + 1)) xcd_barrier(bar); __builtin_amdgcn_sched_barrier(0); asm volatile("" ::: "memory"); } while (0)
    using namespace pg8;
    if (IN(0)) REPS(0) phase0(F);
    SEAM(0);
    if (IN(1)) REPS(1) { Gemm g{(const bf16_t*)(ws + WS_HN), (const bf16_t*)(ws + WS_WIN), DM, DM, DM}; StaticOrder S; S.init(NTOK, DINP, F.G, (int)blockIdx.x);
        EpiStore E{(bf16_t*)(ws + WS_PROJ), DINP, nullptr, 0, 8}; gemm_phase(F.lds, F.wave, g, S, E); }
    SEAM(1);
    if (IN(2)) REPS(2) phase2(F);
    SEAM(2);
    if (IN(3)) REPS(3) {
        { Gemm g{(const bf16_t*)(ws + WS_CQN), (const bf16_t*)(ws + WS_WUQ), 256, 256, 256}; StaticOrder S; S.init(NTOK, 768, F.G, (int)blockIdx.x);
          EpiStore E{(bf16_t*)(ws + WS_QB), 768, nullptr, 0, 1 << 30}; gemm_phase(F.lds, F.wave, g, S, E); }
        __builtin_amdgcn_sched_barrier(0); asm volatile("" ::: "memory");
        { Gemm g{(const bf16_t*)(ws + WS_CKVN), (const bf16_t*)(ws + WS_WUKV), 128, 128, 128}; StaticOrder S; S.init(NTOK, 1024, F.G, (int)blockIdx.x);
          EpiStore E{(bf16_t*)(ws + WS_KV), 1024, nullptr, 0, 1 << 30}; gemm_phase(F.lds, F.wave, g, S, E); } }
    SEAM(3);
    if (IN(4)) REPS(4) phase4(F);
    SEAM(4);
    if (IN(5)) REPS(5) phase5(F);
    SEAM(5);
    if (IN(6)) REPS(6) { Gemm g{(const bf16_t*)(ws + WS_Y), (const bf16_t*)(ws + WS_WA), DM, 512, 512}; StaticOrder S; S.init(NTOK, DM, F.G, (int)blockIdx.x);
        EpiGate<false> E{(bf16_t*)(ws + WS_MERGED), (const bf16_t*)(ws + WS_PROJ) + PC_GA, DINP}; gemm_phase(F.lds, F.wave, g, S, E); }
    SEAM(6);
    if (IN(7)) REPS(7) { Gemm g{(const bf16_t*)(ws + WS_Y) + 512, (const bf16_t*)(ws + WS_WB), DM, 512, 512}; StaticOrder S; S.init(NTOK, DM, F.G, (int)blockIdx.x);
        EpiGate<true> E{(bf16_t*)(ws + WS_MERGED), (const bf16_t*)(ws + WS_PROJ) + PC_GB, DINP}; gemm_phase(F.lds, F.wave, g, S, E); }
    SEAM(7);
    if (IN(8)) REPS(8) { Gemm g{(const bf16_t*)(ws + WS_MERGED), (const bf16_t*)(ws + WS_WO), DM, DM, DM}; StaticOrder S; S.init(NTOK, DM, F.G, (int)blockIdx.x);
        EpiResF32 E{prm.in[I_X], prm.out}; gemm_phase(F.lds, F.wave, g, S, E); }
    SEAM(8);
    if (IN(9)) REPS(9) phase8(F);
    SEAM(9);
    if (IN(10)) REPS(10) phase9(F);
    SEAM(10);
    if (IN(11)) REPS(11) { const int nmt = moe_layout(F);
        Gemm g{(const bf16_t*)(ws + WS_XG), (const bf16_t*)(ws + WS_W1), DM, DM, DM}; MoeOrder S{(const LAS int*)(F.lds + LDS_CTL) + 128, nmt, 8, F.G, (int)blockIdx.x};
        EpiSwiglu E{(bf16_t*)(ws + WS_ACT), prm.in[I_BGU]}; gemm_phase(F.lds, F.wave, g, S, E); }
    SEAM(11);
    if (IN(12)) REPS(12) { const int nmt = moe_layout(F);
        Gemm g{(const bf16_t*)(ws + WS_ACT), (const bf16_t*)(ws + WS_W2), DM, DM, DM}; MoeOrder S{(const LAS int*)(F.lds + LDS_CTL) + 128, nmt, 4, F.G, (int)blockIdx.x};
        EpiStore E{(bf16_t*)(ws + WS_XG), DM, prm.in[I_BD], 1024, 1 << 30}; gemm_phase(F.lds, F.wave, g, S, E); }
    SEAM(12);
    if (IN(13)) REPS(13) phase12(F);
    SEAM(13);
    if (IN(14)) REPS(14) { Gemm g{(const bf16_t*)(ws + WS_PB), (const bf16_t*)(ws + WS_WPP), 256, 256, 256}; StaticOrder S; S.init(NTOK, DM, F.G, (int)blockIdx.x);
        EpiStore E{(bf16_t*)(ws + WS_PP), DM, nullptr, 0, 1 << 30}; gemm_phase(F.lds, F.wave, g, S, E); }
    SEAM(14);
    if (IN(15)) REPS(15) { Gemm g{(const bf16_t*)(ws + WS_HN), (const bf16_t*)(ws + WS_WPG), DM, DM, DM}; StaticOrder S; S.init(NTOK, DM, F.G, (int)blockIdx.x);
        EpiFinal E{prm.out, (const bf16_t*)(ws + WS_PP)}; gemm_phase(F.lds, F.wave, g, S, E); }
#undef IN
#undef SEAM
}

extern "C" void kernel_launch(void* const* d_in, const int* in_sizes, int n_in, void* d_out, int out_size, void* d_ws, size_t ws_size, hipStream_t stream) {
    static int grid = 0;
    if (grid == 0) {
        int dev = 0, cus = 0, per_cu = 0;
        (void)hipGetDevice(&dev);
        (void)hipDeviceGetAttribute(&cus, hipDeviceAttributeMultiprocessorCount, dev);
        (void)hipFuncSetAttribute((const void*)fwd, hipFuncAttributeMaxDynamicSharedMemorySize, LDS_BYTES);
        (void)hipOccupancyMaxActiveBlocksPerMultiprocessor(&per_cu, (const void*)fwd, NTHREADS, LDS_BYTES);
        fprintf(stderr, "cus %d per_cu %d ws %zu n_in %d\n", cus, per_cu, ws_size, n_in);
        grid = (per_cu >= 1) ? cus : -1;
        if (grid != 256 || n_in != 25 || ws_size < WS_END || out_size != NTOK * DM) { fprintf(stderr, "kernel_launch: unsupported configuration\n"); grid = -1; }
    }
    if (grid < 0) return;
    (void)hipMemsetAsync((char*)d_ws + WS_BAR, 0, WS_BAR_BYTES, stream);
    Params a{};
    for (int i = 0; i < 25; ++i) a.in[i] = (const float*)d_in[i];
    a.out = (float*)d_out; a.ws = (unsigned char*)d_ws;
#ifndef MULTI_LAUNCH
    a.ph_lo = 0; a.ph_hi = NPHASE;
    void* args[] = {&a};
    hipError_t e = hipLaunchCooperativeKernel((const void*)fwd, dim3(grid), dim3(NTHREADS), args, LDS_BYTES, stream);
    if (e != hipSuccess) fprintf(stderr, "cooperative launch failed: %s\n", hipGetErrorString(e));
#else
    for (int k = 0; k < NPHASE; ++k) { a.ph_lo = k; a.ph_hi = k + 1; void* args[] = {&a};
        hipError_t e = hipLaunchCooperativeKernel((const void*)fwd, dim3(grid), dim3(NTHREADS), args, LDS_BYTES, stream);
        if (e != hipSuccess) fprintf(stderr, "launch %d failed: %s\n", k, hipGetErrorString(e)); }
#endif
}
```

```cpp
#include <hip/hip_runtime.h>
#include <hip/hip_cooperative_groups.h>
#include <cstdio>
#include <cstdint>
namespace cg = cooperative_groups;

#define LAS __attribute__((address_space(3)))
typedef unsigned short bf16_t;
typedef short bf16x8 __attribute__((ext_vector_type(8)));
typedef short s16x4 __attribute__((ext_vector_type(4)));
typedef float f32x4 __attribute__((ext_vector_type(4)));
typedef float f32x2 __attribute__((ext_vector_type(2)));
typedef float f32x16 __attribute__((ext_vector_type(16)));
typedef unsigned u32x4 __attribute__((ext_vector_type(4)));
typedef unsigned u32x2 __attribute__((ext_vector_type(2)));
typedef int i32x4 __attribute__((ext_vector_type(4)));
typedef int i32x8 __attribute__((ext_vector_type(8)));
typedef __bf16 bf16x2_t __attribute__((ext_vector_type(2)));

constexpr int NB = 8, SEQ = 2048, NTOK = NB * SEQ, DM = 1024;
constexpr int DIN = 4000, DINP = 4096;
constexpr int NEXP = 32, TOPK = 4, DEXP = 1024;
constexpr int NTHREADS = 512, NWAVES = 8;
constexpr float EPS = 1e-6f;
constexpr float LOG2E = 1.4426950408889634f;
constexpr float C2A = 0.125f * LOG2E;
constexpr float C2B = 0.10206207261596575f * LOG2E;
constexpr int PC_QA = 0, PC_KA = 512, PC_VA = 1024, PC_CQ = 1536, PC_CKV = 1792, PC_KPE = 1920, PC_GA = 2048, PC_GB = 3072;

constexpr size_t MiB = 1u << 20;
constexpr size_t WS_HIST = 0;
constexpr size_t WS_ERR = 64 * 1024;
constexpr size_t WS_BAR = 128 * 1024;
constexpr size_t WS_BAR_BYTES = 16 * 1024;
constexpr size_t WS_KPESS = 576 * 1024;
constexpr size_t WS_TOK = 256 * 1024;
constexpr size_t WS_ROPE = 1 * MiB;
constexpr size_t WS_KMEAN = 2 * MiB;
constexpr size_t WS_SSP = 11 * MiB;
constexpr size_t WS_PAIR = 3 * MiB;
constexpr size_t WS_WUQ = 4 * MiB, WS_WUKV = 4 * MiB + 512 * 1024, WS_WPP = 5 * MiB, WS_WA = 6 * MiB, WS_WB = 7 * MiB, WS_WO = 8 * MiB, WS_WPG = 10 * MiB, WS_WIN = 12 * MiB;
constexpr size_t WS_W1 = 20 * MiB, WS_W2 = 148 * MiB;
constexpr size_t WS_WINF8 = 16 * MiB;
constexpr size_t WS_HNF8 = 84 * MiB;
constexpr size_t WS_HN = 212 * MiB, WS_PB = 244 * MiB;
constexpr size_t WS_CQN = 252 * MiB, WS_CKVN = 260 * MiB, WS_QB = 264 * MiB, WS_KV = 288 * MiB, WS_KB2 = 320 * MiB, WS_Y = 344 * MiB, WS_MERGED = 376 * MiB;
constexpr size_t WS_ACT = 252 * MiB;
constexpr size_t WS_PP = 400 * MiB;
constexpr size_t WS_KA2 = 432 * MiB;
constexpr size_t WS_PROJ = 448 * MiB;
constexpr size_t WS_QA2 = 576 * MiB;
constexpr size_t WS_XG = 448 * MiB;
constexpr size_t WS_END = 592 * MiB;
constexpr int MAXROWS = 73728, MAXMT = 288;

constexpr int RING_BYTES = 131072;
constexpr int LDS_CTL = RING_BYTES;
constexpr int LDS_TOKL = RING_BYTES + 8192 + 256;
constexpr int LDS_BARST = RING_BYTES + 8192;
constexpr int LDS_BYTES = 147456;

__device__ __forceinline__ unsigned cvt_pk_bf16(float lo, float hi) { f32x2 v = {lo, hi}; bf16x2_t b = __builtin_convertvector(v, bf16x2_t); return __builtin_bit_cast(unsigned, b); }
__device__ __forceinline__ unsigned pack4_fp8(float a, float b, float c, float d) { int w = 0; w = __builtin_amdgcn_cvt_pk_fp8_f32(a, b, w, false); w = __builtin_amdgcn_cvt_pk_fp8_f32(c, d, w, true); return (unsigned)w; }
__device__ __forceinline__ float bf2f(unsigned short b) { return __uint_as_float(((unsigned)b) << 16); }
__device__ __forceinline__ float bflo(unsigned w) { return __uint_as_float(w << 16); }
__device__ __forceinline__ float bfhi(unsigned w) { return __uint_as_float(w & 0xffff0000u); }
__device__ __forceinline__ float sigmoidf_(float x) { return __builtin_amdgcn_rcpf(1.0f + __builtin_amdgcn_exp2f(-x * LOG2E)); }
__device__ __forceinline__ int lane_id() { return (int)__builtin_amdgcn_mbcnt_hi(~0u, __builtin_amdgcn_mbcnt_lo(~0u, 0u)); }
__device__ __forceinline__ float wave_sum(float v) {
#pragma unroll
    for (int o = 1; o < 64; o <<= 1) v += __shfl_xor(v, o);
    return v;
}

namespace pg8 {
constexpr int BM = 256, BK = 64, HALF = 128, HTB = HALF * BK * 2, STAGE_BYTES = 8 * HTB, NXCD = 8, WGM = 8;
__host__ __device__ __forceinline__ int lds_byte(int r, int c) { const int st = (r >> 4) * 2 + (c >> 5), rr = r & 15, cc = c & 31, ob = rr * 64 + cc * 2; return st * 1024 + (ob ^ (((ob >> 9) & 1) << 5)); }
__host__ __device__ __forceinline__ void stage_rc(int b, int& R, int& C) { const int st = b / 1024, sb = b % 1024, swz = sb ^ (((sb >> 9) & 1) << 5); R = (st >> 1) * 16 + swz / 64; C = (st & 1) * 32 + (swz % 64) / 2; }
__host__ __device__ __forceinline__ int perm32(int rho) { const int n = rho >> 4, i = rho & 15; return 8 * (i >> 2) + 4 * n + (i & 3); }

struct Unit { int pm, pn, pb, e; };
struct Gemm { const bf16_t* A; const bf16_t* Bt; int lda, ldb, K; };

struct StaticOrder {
    int nM, nN, nwg, G, c;
    __device__ void init(int M, int N, int G_, int c_) { nM = M / BM; nN = N / BM; nwg = nM * nN; G = G_; c = c_; }
    __device__ bool next(int i, Unit& u) const {
        const long L = (long)i * G + c; if (L >= nwg) return false;
        int wgid = (int)L; { const int q = nwg / NXCD, r = nwg % NXCD, xcd = wgid % NXCD, off = wgid / NXCD; wgid = (xcd < r ? xcd * (q + 1) : r * (q + 1) + (xcd - r) * q) + off; }
        const int nig = WGM * nN, gid = wgid / nig, fm = gid * WGM, gsz = (nM - fm) < WGM ? (nM - fm) : WGM;
        u.pm = fm + ((wgid % nig) % gsz); u.pn = (wgid % nig) / gsz; u.pb = u.pn; u.e = 0; return true;
    }
};
struct MoeOrder {
    const LAS int* tile_e; int nmt, ntn, G, c;
    __device__ bool next(int i, Unit& u) const {
        const int j = (i * G + c) >> 3; const int mt = (j / ntn) * 8 + (c & 7), pn = j % ntn; if (mt >= nmt) return false;
        const int e = __builtin_amdgcn_readfirstlane(tile_e[mt]);
        u.pm = mt; u.pn = pn; u.pb = e * ntn + pn; u.e = e; return true;
    }
};

template <class Epi, class Sched, bool GATHER = false, bool FP8 = false>
__device__ __forceinline__ void gemm_phase(LAS unsigned char* lds, int wave, const Gemm g, const Sched& S, const Epi& E, const LAS unsigned short* tokl = nullptr) {
    constexpr bool ALIGN_EPI = true;
    int lane = lane_id(); asm volatile("" : "+v"(lane));
    const int wid = wave, tid = wid * 64 + lane, wr = wid >> 2, wc = wid & 3, fr = lane & 15, fq = lane >> 4;
    int K = g.K; asm volatile("" : "+s"(K));
    const int nt = K / BK;
    unsigned voffA[2], voffB[2]; int gR[2]; unsigned gC[2];
#pragma unroll
    for (int i = 0; i < 2; ++i) { int R, C; stage_rc(tid * 16 + i * 8192, R, C); const int Rb = (R & ~31) + perm32(R & 31);
        voffA[i] = (unsigned)(R * g.lda + C) * 2u; voffB[i] = (unsigned)(Rb * g.ldb + C) * 2u; gR[i] = R; gC[i] = (unsigned)C * 2u; }
    unsigned goff[2][2], noff[2][2];
#define PG8_GOFF(dst, ui_) do { _Pragma("unroll") for (int h_ = 0; h_ < 2; ++h_) _Pragma("unroll") for (int i_ = 0; i_ < 2; ++i_) \
        dst[h_][i_] = (unsigned)tokl[(ui_) * 256 + h_ * HALF + gR[i_]] * (unsigned)(g.lda * 2) + gC[i_]; } while (0)
    const size_t kstep = (size_t)(BK * 2);
    const size_t hstepA = (size_t)HALF * g.lda * 2, hstepB = (size_t)HALF * g.ldb * 2;
    const size_t tstepA = 2 * hstepA, tstepB = 2 * hstepB;
    const unsigned ldsw = (unsigned)wid * 1024u;
    const int aoff = lds_byte(wr * 64 + fr, fq * 8), boff = lds_byte(wc * 32 + fr, fq * 8);
#define PG8_SA(b, h) (((b) * 2 + (h)) * HTB)
#define PG8_SB(b, h) ((4 + (b) * 2 + (h)) * HTB)
#define PG8_STAGE(bufoff, gbase, voff) do { _Pragma("unroll") for (int _i = 0; _i < 2; ++_i) \
        __builtin_amdgcn_global_load_lds((const unsigned*)((const char*)(gbase) + (voff)[_i]), (LAS unsigned*)(lds + (bufoff) + ldsw + _i * 8192), 16, 0, 0); } while (0)
#define PG8_STAGE_A(bufoff, ptr_ng, k_g, off_g) do { if constexpr (GATHER) { const char* gb_ = (const char*)g.A + (size_t)(k_g) * kstep; PG8_STAGE(bufoff, gb_, off_g); } else { PG8_STAGE(bufoff, ptr_ng, voffA); } } while (0)
#define PG8_LDA(dst, b, h) do { if constexpr (FP8) { _Pragma("unroll") for (int m = 0; m < 4; ++m) { const i32x4 lo_ = *(const LAS i32x4*)(lds + PG8_SA(b, h) + aoff + m * 2048), hi_ = *(const LAS i32x4*)(lds + PG8_SA(b, h) + aoff + m * 2048 + 1024); dst##8[m] = __builtin_shufflevector(lo_, hi_, 0, 1, 2, 3, 4, 5, 6, 7); } } \
        else { _Pragma("unroll") for (int m = 0; m < 4; ++m) _Pragma("unroll") for (int k = 0; k < 2; ++k) dst[m][k] = *(const LAS bf16x8*)(lds + PG8_SA(b, h) + aoff + m * 2048 + k * 1024); } } while (0)
#define PG8_LDB(dst, b, h) do { if constexpr (FP8) { _Pragma("unroll") for (int n = 0; n < 2; ++n) { const i32x4 lo_ = *(const LAS i32x4*)(lds + PG8_SB(b, h) + boff + n * 2048), hi_ = *(const LAS i32x4*)(lds + PG8_SB(b, h) + boff + n * 2048 + 1024); dst##8[n] = __builtin_shufflevector(lo_, hi_, 0, 1, 2, 3, 4, 5, 6, 7); } } \
        else { _Pragma("unroll") for (int n = 0; n < 2; ++n) _Pragma("unroll") for (int k = 0; k < 2; ++k) dst[n][k] = *(const LAS bf16x8*)(lds + PG8_SB(b, h) + boff + n * 2048 + k * 1024); } } while (0)
#define PG8_CAT8(x, y) __builtin_shufflevector(__builtin_bit_cast(i32x4, x), __builtin_bit_cast(i32x4, y), 0, 1, 2, 3, 4, 5, 6, 7)
#define PG8_MMA(ai, bj, At, Bt) do { __builtin_amdgcn_s_setprio(1); if constexpr (FP8) { _Pragma("unroll") for (int m = 0; m < 4; ++m) _Pragma("unroll") for (int n = 0; n < 2; ++n) \
        asm volatile("v_mfma_scale_f32_16x16x128_f8f6f4 %0, %1, %2, %0, %3, %3 op_sel_hi:[0,0,0]" : "+v"(acc[ai][bj][m][n]) : "v"(Bt##8[n]), "v"(At##8[m]), "v"(sc8)); } \
        else { _Pragma("unroll") for (int m = 0; m < 4; ++m) _Pragma("unroll") for (int n = 0; n < 2; ++n) _Pragma("unroll") for (int k = 0; k < 2; ++k) \
        acc[ai][bj][m][n] = __builtin_amdgcn_mfma_f32_16x16x32_bf16(Bt[n][k], At[m][k], acc[ai][bj][m][n], 0, 0, 0); } __builtin_amdgcn_s_setprio(0); } while (0)
#define PG8_WAIT_V(n) asm volatile("s_waitcnt vmcnt(" #n ")" ::: "memory")
#define PG8_WAIT_L(n) asm volatile("s_waitcnt lgkmcnt(" #n ")" ::: "memory")
#define PG8_BAR __builtin_amdgcn_s_barrier()
#define PG8_SCHED __builtin_amdgcn_sched_barrier(0)
    Unit cur, nxt; int ui = 0;
    if (!S.next(0, cur)) return;
    f32x4 acc[2][2][4][2];
#pragma unroll
    for (int a = 0; a < 2; ++a)
#pragma unroll
        for (int b = 0; b < 2; ++b)
#pragma unroll
            for (int m = 0; m < 4; ++m)
#pragma unroll
                for (int n = 0; n < 2; ++n) acc[a][b][m][n] = (f32x4){0.f, 0.f, 0.f, 0.f};
    const int sc8 = 0x7c7c7c7c;
    bf16x8 At[4][2], B0[2][2], B1[2][2]; i32x8 At8[4], B08[2], B18[2];
    const char* cA = (const char*)g.A + (size_t)cur.pm * tstepA; const char* cB = (const char*)g.Bt + (size_t)cur.pb * tstepB;
    if constexpr (GATHER) { PG8_GOFF(goff, 0); }
    PG8_STAGE(PG8_SB(0, 0), cB, voffB); PG8_STAGE(PG8_SB(0, 1), cB + hstepB, voffB); PG8_STAGE_A(PG8_SA(0, 0), cA, 0, goff[0]); PG8_STAGE_A(PG8_SA(0, 1), cA + hstepA, 0, goff[1]);
    if (wr == 1) PG8_BAR;
    PG8_WAIT_V(2); PG8_BAR;
    PG8_STAGE(PG8_SB(1, 0), cB + kstep, voffB); PG8_STAGE_A(PG8_SA(1, 0), cA + kstep, 1, goff[0]); PG8_STAGE(PG8_SB(1, 1), cB + hstepB + kstep, voffB);
    PG8_WAIT_V(6); PG8_BAR;
    for (;;) {
        const bool has_next = S.next(ui + 1, nxt);
        const char* nA = has_next ? (const char*)g.A + (size_t)nxt.pm * tstepA : cA; const char* nB = has_next ? (const char*)g.Bt + (size_t)nxt.pb * tstepB : cB;
        if constexpr (GATHER) { if (has_next) { PG8_GOFF(noff, ui + 1); } else {
#pragma unroll
            for (int h_ = 0; h_ < 2; ++h_)
#pragma unroll
                for (int i_ = 0; i_ < 2; ++i_) noff[h_][i_] = goff[h_][i_]; } }
        for (int t = 0; t < nt; t += 2) {
            const bool last = (t == nt - 2);
            const char* a1 = cA + (size_t)(t + 1) * kstep;
            const char* a2 = last ? nA : cA + (size_t)(t + 2) * kstep; const char* b2 = last ? nB : cB + (size_t)(t + 2) * kstep;
            const char* a3 = a2 + kstep; const char* b3 = b2 + kstep;
            const int k2 = last ? 0 : t + 2;
            unsigned soff[2][2];
            if constexpr (GATHER) {
#pragma unroll
                for (int h_ = 0; h_ < 2; ++h_)
#pragma unroll
                    for (int i_ = 0; i_ < 2; ++i_) soff[h_][i_] = last ? noff[h_][i_] : goff[h_][i_]; }
            PG8_LDB(B0, 0, 0); PG8_LDB(B1, 0, 1); PG8_SCHED; PG8_LDA(At, 0, 0); PG8_STAGE_A(PG8_SA(1, 1), a1 + hstepA, t + 1, goff[1]);
            PG8_WAIT_V(8); PG8_WAIT_L(0); PG8_BAR; PG8_MMA(0, 0, At, B0); PG8_MMA(0, 1, At, B1); PG8_BAR; PG8_SCHED;
            PG8_LDA(At, 0, 1); PG8_STAGE(PG8_SB(0, 0), b2, voffB); PG8_STAGE(PG8_SB(0, 1), b2 + hstepB, voffB); PG8_STAGE_A(PG8_SA(0, 0), a2, k2, soff[0]);
            PG8_WAIT_V(8); PG8_WAIT_L(0); PG8_BAR; PG8_MMA(1, 0, At, B0); PG8_MMA(1, 1, At, B1); PG8_BAR; PG8_SCHED;
            PG8_LDB(B0, 1, 0); PG8_LDB(B1, 1, 1); PG8_SCHED; PG8_LDA(At, 1, 0); PG8_STAGE_A(PG8_SA(0, 1), a2 + hstepA, k2, soff[1]);
            PG8_WAIT_V(8); PG8_WAIT_L(0); PG8_BAR; PG8_MMA(0, 0, At, B0); PG8_MMA(0, 1, At, B1); PG8_BAR; PG8_SCHED;
            PG8_LDA(At, 1, 1); PG8_STAGE(PG8_SB(1, 0), b3, voffB); PG8_STAGE(PG8_SB(1, 1), b3 + hstepB, voffB); PG8_STAGE_A(PG8_SA(1, 0), a3, k2 + 1, soff[0]);
            PG8_WAIT_V(8); PG8_WAIT_L(0); PG8_BAR; PG8_MMA(1, 0, At, B0); PG8_MMA(1, 1, At, B1); PG8_BAR; PG8_SCHED;
        }
        if constexpr (ALIGN_EPI) { if (wr == 0) PG8_BAR; }
        if constexpr (FP8) asm volatile("s_nop 15\n\ts_nop 15" ::: "memory");
        E(acc, cur, wr, wc, fr, fq);
        if (!has_next) break;
#pragma unroll
        for (int a = 0; a < 2; ++a)
#pragma unroll
            for (int b = 0; b < 2; ++b)
#pragma unroll
                for (int m = 0; m < 4; ++m)
#pragma unroll
                    for (int n = 0; n < 2; ++n) acc[a][b][m][n] = (f32x4){0.f, 0.f, 0.f, 0.f};
        cur = nxt; cA = nA; cB = nB; ++ui;
        if constexpr (GATHER) {
#pragma unroll
            for (int h_ = 0; h_ < 2; ++h_)
#pragma unroll
                for (int i_ = 0; i_ < 2; ++i_) goff[h_][i_] = noff[h_][i_]; }
        if constexpr (ALIGN_EPI) { if (wr == 1) PG8_BAR; }
    }
    PG8_WAIT_V(0);
    if constexpr (!ALIGN_EPI) { if (wr == 0) PG8_BAR; }
    PG8_BAR;
#undef PG8_SA
#undef PG8_SB
#undef PG8_STAGE
#undef PG8_STAGE_A
#undef PG8_GOFF
#undef PG8_LDA
#undef PG8_LDB
#undef PG8_MMA
#undef PG8_CAT8
#undef PG8_WAIT_V
#undef PG8_WAIT_L
#undef PG8_BAR
#undef PG8_SCHED
}

#define EPI_ARGS const f32x4 (&acc)[2][2][4][2], const Unit& u, int wr, int wc, int fr, int fq
__device__ __forceinline__ u32x4 pack8(f32x4 v0, f32x4 v1) { u32x4 w; w.x = cvt_pk_bf16(v0[0], v0[1]); w.y = cvt_pk_bf16(v0[2], v0[3]); w.z = cvt_pk_bf16(v1[0], v1[1]); w.w = cvt_pk_bf16(v1[2], v1[3]); return w; }
__device__ __forceinline__ void unpack8(u32x4 w, f32x4& v0, f32x4& v1) { v0 = (f32x4){bflo(w.x), bfhi(w.x), bflo(w.y), bfhi(w.y)}; v1 = (f32x4){bflo(w.z), bfhi(w.z), bflo(w.w), bfhi(w.w)}; }
__device__ __forceinline__ f32x4 sig4(f32x4 v) { return (f32x4){sigmoidf_(v[0]), sigmoidf_(v[1]), sigmoidf_(v[2]), sigmoidf_(v[3])}; }

struct EpiStore {
    bf16_t* O; int ldc; const float* bias; int bias_stride; int sig_from;
    __device__ __forceinline__ void operator()(EPI_ARGS) const {
        const int row0 = u.pm * BM + wr * 64 + fr, col0 = u.pn * BM + wc * 32 + 8 * fq;
        const bool sg = u.pn >= sig_from;
        f32x4 bv[2][2];
#pragma unroll
        for (int bj = 0; bj < 2; ++bj)
#pragma unroll
            for (int n = 0; n < 2; ++n) bv[bj][n] = bias ? *(const f32x4*)(bias + (size_t)u.e * bias_stride + col0 + bj * HALF + 4 * n) : (f32x4){0.f, 0.f, 0.f, 0.f};
#pragma unroll
        for (int ai = 0; ai < 2; ++ai)
#pragma unroll
            for (int m = 0; m < 4; ++m) { bf16_t* rowp = O + (size_t)(row0 + ai * HALF + m * 16) * ldc + col0;
#pragma unroll
                for (int bj = 0; bj < 2; ++bj) { f32x4 v0 = acc[ai][bj][m][0] + bv[bj][0], v1 = acc[ai][bj][m][1] + bv[bj][1];
                    if (sg) { v0 = sig4(v0); v1 = sig4(v1); }
                    *(u32x4*)(rowp + bj * HALF) = pack8(v0, v1); } }
    }
};

struct EpiProj {
    bf16_t* PROJ; bf16_t* QA2; bf16_t* KA2; float* KMEAN; bf16_t* CQN; bf16_t* CKVN;
    const float* gq; const float* gk; const float* glq; const float* glkv; const float* cosA; const float* sinA; LAS float* xch;
    float* KPESS;
    __device__ __forceinline__ void operator()(EPI_ARGS) const {
        const int row0 = u.pm * BM + wr * 64 + fr, col0 = u.pn * BM + wc * 32 + 8 * fq;
        if (u.pn < 4) {
            const bool isk = u.pn >= 2; const int h = 4 * (u.pn & 1) + wc; const float* gn = isk ? gk : gq; const float sc = isk ? 1.0f : C2A;
            const f32x4 g1a = *(const f32x4*)(gn + 8 * fq), g1b = *(const f32x4*)(gn + 8 * fq + 4), g2a = *(const f32x4*)(gn + 32 + 8 * fq), g2b = *(const f32x4*)(gn + 36 + 8 * fq);
            bf16_t* dst = isk ? KA2 : QA2;
            f32x4 ks1a = {0.f, 0.f, 0.f, 0.f}, ks1b = ks1a, ks2a = ks1a, ks2b = ks1a;
#pragma unroll
            for (int ai = 0; ai < 2; ++ai)
#pragma unroll
                for (int m = 0; m < 4; ++m) { const int row = row0 + ai * HALF + m * 16; const int pos = row & (SEQ - 1);
                    f32x4 x1a = acc[ai][0][m][0], x1b = acc[ai][0][m][1], x2a = acc[ai][1][m][0], x2b = acc[ai][1][m][1];
                    float ss = (x1a[0] * x1a[0] + x1a[1] * x1a[1]) + (x1a[2] * x1a[2] + x1a[3] * x1a[3]) + (x1b[0] * x1b[0] + x1b[1] * x1b[1]) + (x1b[2] * x1b[2] + x1b[3] * x1b[3])
                             + (x2a[0] * x2a[0] + x2a[1] * x2a[1]) + (x2a[2] * x2a[2] + x2a[3] * x2a[3]) + (x2b[0] * x2b[0] + x2b[1] * x2b[1]) + (x2b[2] * x2b[2] + x2b[3] * x2b[3]);
                    ss += __shfl_xor(ss, 16); ss += __shfl_xor(ss, 32);
                    const float rstd = 1.0f / sqrtf(ss * (1.f / 64.f) + EPS);
                    x1a = x1a * g1a * rstd; x1b = x1b * g1b * rstd; x2a = x2a * g2a * rstd; x2b = x2b * g2b * rstd;
                    const f32x4 ca = *(const f32x4*)(cosA + pos * 32 + 8 * fq), cb = *(const f32x4*)(cosA + pos * 32 + 8 * fq + 4), sa = *(const f32x4*)(sinA + pos * 32 + 8 * fq), sb = *(const f32x4*)(sinA + pos * 32 + 8 * fq + 4);
                    const f32x4 y1a = x1a * ca - x2a * sa, y1b = x1b * cb - x2b * sb, y2a = x2a * ca + x1a * sa, y2b = x2b * cb + x1b * sb;
                    bf16_t* rp = dst + (size_t)row * 512 + h * 64 + 8 * fq;
                    *(u32x4*)rp = pack8(y1a * sc, y1b * sc); *(u32x4*)(rp + 32) = pack8(y2a * sc, y2b * sc);
                    ks1a += y1a; ks1b += y1b; ks2a += y2a; ks2b += y2b; }
            if (isk) {
#pragma unroll
                for (int o = 1; o < 16; o <<= 1) {
#pragma unroll
                    for (int i = 0; i < 4; ++i) { ks1a[i] += __shfl_xor(ks1a[i], o); ks1b[i] += __shfl_xor(ks1b[i], o); ks2a[i] += __shfl_xor(ks2a[i], o); ks2b[i] += __shfl_xor(ks2b[i], o); } }
                if (fr == 0) { float* km = KMEAN + (((size_t)(u.pm >> 3) * 8 + h) * 8 + (u.pm & 7)) * 64 + 8 * fq;
#pragma unroll
                    for (int i = 0; i < 4; ++i) { atomicAdd(km + i, ks1a[i] * (1.f / 256.f)); atomicAdd(km + 4 + i, ks1b[i] * (1.f / 256.f)); atomicAdd(km + 32 + i, ks2a[i] * (1.f / 256.f)); atomicAdd(km + 36 + i, ks2b[i] * (1.f / 256.f)); } } }
        } else if (u.pn == 6 || u.pn == 7) {
            const bool isq = u.pn == 6;
            float ssr[2][4];
#pragma unroll
            for (int ai = 0; ai < 2; ++ai)
#pragma unroll
                for (int m = 0; m < 4; ++m) { float ss = 0.f;
#pragma unroll
                    for (int bj = 0; bj < 2; ++bj) { if (bj == 1 && !isq) continue;
#pragma unroll
                        for (int n = 0; n < 2; ++n) { const f32x4 x = acc[ai][bj][m][n]; ss += (x[0] * x[0] + x[1] * x[1]) + (x[2] * x[2] + x[3] * x[3]); } }
                    ss += __shfl_xor(ss, 16); ss += __shfl_xor(ss, 32);
                    if (fq == 0) xch[(ai * HALF + wr * 64 + m * 16 + fr) * 4 + wc] = ss; }
            asm volatile("s_waitcnt lgkmcnt(0)" ::: "memory"); __builtin_amdgcn_s_barrier(); asm volatile("" ::: "memory");
#pragma unroll
            for (int ai = 0; ai < 2; ++ai)
#pragma unroll
                for (int m = 0; m < 4; ++m) { const f32x4 p4 = *(const LAS f32x4*)(xch + (ai * HALF + wr * 64 + m * 16 + fr) * 4); ssr[ai][m] = (p4[0] + p4[1]) + (p4[2] + p4[3]); }
            asm volatile("s_waitcnt lgkmcnt(0)" ::: "memory"); __builtin_amdgcn_s_barrier(); asm volatile("" ::: "memory");
            const float invn = isq ? (1.f / 256.f) : (1.f / 128.f); const float* gl = isq ? glq : glkv; bf16_t* dn = isq ? CQN : CKVN; const int ldn = isq ? 256 : 128;
            const int c0 = wc * 32 + 8 * fq;
#pragma unroll
            for (int bj = 0; bj < 2; ++bj) {
                if (bj == 1 && !isq) {
#pragma unroll
                    for (int ai = 0; ai < 2; ++ai)
#pragma unroll
                        for (int m = 0; m < 4; ++m) { const f32x4 x0 = acc[ai][1][m][0], x1 = acc[ai][1][m][1];
                            *(u32x4*)(PROJ + (size_t)(row0 + ai * HALF + m * 16) * DINP + col0 + HALF) = pack8(x0, x1);
                            float ss = (x0[0] * x0[0] + x0[1] * x0[1]) + (x0[2] * x0[2] + x0[3] * x0[3]) + (x1[0] * x1[0] + x1[1] * x1[1]) + (x1[2] * x1[2] + x1[3] * x1[3]);
                            ss += __shfl_xor(ss, 16); ss += __shfl_xor(ss, 32);
                            if (wc == 0 && fq == 0) KPESS[row0 + ai * HALF + m * 16] = ss; }
                    continue; }
                const f32x4 ga = *(const f32x4*)(gl + bj * HALF + c0), gb = *(const f32x4*)(gl + bj * HALF + c0 + 4);
#pragma unroll
                for (int ai = 0; ai < 2; ++ai)
#pragma unroll
                    for (int m = 0; m < 4; ++m) { const float rstd = 1.0f / sqrtf(ssr[ai][m] * invn + EPS);
                        *(u32x4*)(dn + (size_t)(row0 + ai * HALF + m * 16) * ldn + bj * HALF + c0) = pack8(acc[ai][bj][m][0] * ga * rstd, acc[ai][bj][m][1] * gb * rstd); } }
        } else {
            const bool sg = u.pn >= 8;
#pragma unroll
            for (int ai = 0; ai < 2; ++ai)
#pragma unroll
                for (int m = 0; m < 4; ++m) { bf16_t* rowp = PROJ + (size_t)(row0 + ai * HALF + m * 16) * DINP + col0;
#pragma unroll
                    for (int bj = 0; bj < 2; ++bj) { f32x4 v0 = acc[ai][bj][m][0], v1 = acc[ai][bj][m][1];
                        if (sg) { v0 = sig4(v0); v1 = sig4(v1); }
                        *(u32x4*)(rowp + bj * HALF) = pack8(v0, v1); } }
        }
    }
};

struct EpiQB {
    bf16_t* QB; const float* gn; const float* cosB; const float* sinB; LAS float* xch;
    __device__ __forceinline__ void operator()(EPI_ARGS) const {
        const int rl0 = wr * 64 + fr, row0 = u.pm * BM + rl0;
#pragma unroll
        for (int ai = 0; ai < 2; ++ai)
#pragma unroll
            for (int m = 0; m < 4; ++m)
#pragma unroll
                for (int bj = 0; bj < 2; ++bj) { const f32x4 x0 = acc[ai][bj][m][0], x1 = acc[ai][bj][m][1];
                    float ss = (x0[0] * x0[0] + x0[1] * x0[1]) + (x0[2] * x0[2] + x0[3] * x0[3]) + (x1[0] * x1[0] + x1[1] * x1[1]) + (x1[2] * x1[2] + x1[3] * x1[3]);
                    ss += __shfl_xor(ss, 16); ss += __shfl_xor(ss, 32);
                    if (fq == 0) xch[((rl0 + ai * HALF + m * 16) * 2 + bj) * 4 + wc] = ss; }
        asm volatile("s_waitcnt lgkmcnt(0)" ::: "memory"); __builtin_amdgcn_s_barrier(); asm volatile("" ::: "memory");
#define QB_RS(ai, m, bj) ({ const f32x4 p4_ = *(const LAS f32x4*)(xch + ((rl0 + (ai) * HALF + (m) * 16) * 2 + (bj)) * 4); C2B / sqrtf(((p4_[0] + p4_[1]) + p4_[2]) * (1.f / 96.f) + EPS); })
        if (wc < 2) { const f32x4 ga = *(const f32x4*)(gn + 32 * wc + 8 * fq), gb = *(const f32x4*)(gn + 32 * wc + 8 * fq + 4);
#pragma unroll
            for (int ai = 0; ai < 2; ++ai)
#pragma unroll
                for (int m = 0; m < 4; ++m)
#pragma unroll
                    for (int bj = 0; bj < 2; ++bj) { const float r = QB_RS(ai, m, bj);
                        *(u32x4*)(QB + (size_t)(row0 + ai * HALF + m * 16) * 768 + (2 * u.pn + bj) * 96 + 32 * wc + 8 * fq) = pack8(acc[ai][bj][m][0] * ga * r, acc[ai][bj][m][1] * gb * r); }
        } else if (wc == 2) { const f32x4 g1 = *(const f32x4*)(gn + 64 + 4 * fq), g2 = *(const f32x4*)(gn + 80 + 4 * fq);
#pragma unroll
            for (int ai = 0; ai < 2; ++ai)
#pragma unroll
                for (int m = 0; m < 4; ++m) { const int row = row0 + ai * HALF + m * 16; const int pos = row & (SEQ - 1);
                    const f32x4 c4 = *(const f32x4*)(cosB + pos * 16 + 4 * fq), s4 = *(const f32x4*)(sinB + pos * 16 + 4 * fq);
#pragma unroll
                    for (int bj = 0; bj < 2; ++bj) { const float r = QB_RS(ai, m, bj); const f32x4 x1 = acc[ai][bj][m][0] * g1 * r, x2 = acc[ai][bj][m][1] * g2 * r;
                        const f32x4 y1 = x1 * c4 - x2 * s4, y2 = x2 * c4 + x1 * s4; bf16_t* rp = QB + (size_t)row * 768 + (2 * u.pn + bj) * 96 + 64 + 4 * fq;
                        *(u32x2*)rp = (u32x2){cvt_pk_bf16(y1[0], y1[1]), cvt_pk_bf16(y1[2], y1[3])}; *(u32x2*)(rp + 16) = (u32x2){cvt_pk_bf16(y2[0], y2[1]), cvt_pk_bf16(y2[2], y2[3])}; } }
        }
    }
};
struct EpiKV {
    bf16_t* KB2; bf16_t* KV; const bf16_t* PROJ; const float* KPESS; const float* gn; const float* cosB; const float* sinB; LAS float* xch;
    __device__ __forceinline__ void operator()(EPI_ARGS) const {
        const int rl0 = wr * 64 + fr, row0 = u.pm * BM + rl0;
        if (wc < 2) {
#pragma unroll
            for (int ai = 0; ai < 2; ++ai)
#pragma unroll
                for (int m = 0; m < 4; ++m)
#pragma unroll
                    for (int bj = 0; bj < 2; ++bj) { const f32x4 x0 = acc[ai][bj][m][0], x1 = acc[ai][bj][m][1];
                        float ss = (x0[0] * x0[0] + x0[1] * x0[1]) + (x0[2] * x0[2] + x0[3] * x0[3]) + (x1[0] * x1[0] + x1[1] * x1[1]) + (x1[2] * x1[2] + x1[3] * x1[3]);
                        ss += __shfl_xor(ss, 16); ss += __shfl_xor(ss, 32);
                        if (fq == 0) xch[((rl0 + ai * HALF + m * 16) * 2 + bj) * 4 + wc] = ss; } }
        asm volatile("s_waitcnt lgkmcnt(0)" ::: "memory"); __builtin_amdgcn_s_barrier(); asm volatile("" ::: "memory");
#define KV_RS(ai, m, bj, pe) ({ const f32x2 p2_ = *(const LAS f32x2*)(xch + ((rl0 + (ai) * HALF + (m) * 16) * 2 + (bj)) * 4); 1.0f / sqrtf(((p2_[0] + p2_[1]) + (pe)) * (1.f / 96.f) + EPS); })
        if (wc < 2) { const f32x4 ga = *(const f32x4*)(gn + 32 * wc + 8 * fq), gb = *(const f32x4*)(gn + 32 * wc + 8 * fq + 4);
#pragma unroll
            for (int ai = 0; ai < 2; ++ai)
#pragma unroll
                for (int m = 0; m < 4; ++m) { const float pe = KPESS[row0 + ai * HALF + m * 16];
#pragma unroll
                    for (int bj = 0; bj < 2; ++bj) { const float r = KV_RS(ai, m, bj, pe);
                        *(u32x4*)(KB2 + (size_t)(row0 + ai * HALF + m * 16) * 768 + (2 * u.pn + bj) * 96 + 32 * wc + 8 * fq) = pack8(acc[ai][bj][m][0] * ga * r, acc[ai][bj][m][1] * gb * r); } }
        } else {
#pragma unroll
            for (int ai = 0; ai < 2; ++ai)
#pragma unroll
                for (int m = 0; m < 4; ++m)
#pragma unroll
                    for (int bj = 0; bj < 2; ++bj) *(u32x4*)(KV + (size_t)(row0 + ai * HALF + m * 16) * 1024 + (2 * u.pn + bj) * 128 + 32 * wc + 8 * fq) = pack8(acc[ai][bj][m][0], acc[ai][bj][m][1]);
            if (wc == 2) {
                const f32x4 g1 = *(const f32x4*)(gn + 64 + 4 * fq), g2 = *(const f32x4*)(gn + 80 + 4 * fq);
#pragma unroll
                for (int ai = 0; ai < 2; ++ai)
#pragma unroll
                    for (int m = 0; m < 4; ++m) { const int row = row0 + ai * HALF + m * 16; const int pos = row & (SEQ - 1); const float pe = KPESS[row];
                        const u32x2 w1 = *(const u32x2*)(PROJ + (size_t)row * DINP + PC_KPE + 4 * fq), w2 = *(const u32x2*)(PROJ + (size_t)row * DINP + PC_KPE + 16 + 4 * fq);
                        const f32x4 k1 = (f32x4){bflo(w1.x), bfhi(w1.x), bflo(w1.y), bfhi(w1.y)} * g1, k2 = (f32x4){bflo(w2.x), bfhi(w2.x), bflo(w2.y), bfhi(w2.y)} * g2;
                        const f32x4 c4 = *(const f32x4*)(cosB + pos * 16 + 4 * fq), s4 = *(const f32x4*)(sinB + pos * 16 + 4 * fq);
                        const f32x4 y1 = k1 * c4 - k2 * s4, y2 = k2 * c4 + k1 * s4;
#pragma unroll
                        for (int bj = 0; bj < 2; ++bj) { const float r = KV_RS(ai, m, bj, pe); bf16_t* rp = KB2 + (size_t)row * 768 + (2 * u.pn + bj) * 96 + 64 + 4 * fq;
                            *(u32x2*)rp = (u32x2){cvt_pk_bf16(y1[0] * r, y1[1] * r), cvt_pk_bf16(y1[2] * r, y1[3] * r)}; *(u32x2*)(rp + 16) = (u32x2){cvt_pk_bf16(y2[0] * r, y2[1] * r), cvt_pk_bf16(y2[2] * r, y2[3] * r)}; } } }
        }
    }
};
#undef QB_RS
#undef KV_RS
template <bool ADD> struct EpiGate {
    bf16_t* O; const bf16_t* G; int ldg; unsigned char* MF8;
    __device__ __forceinline__ void operator()(EPI_ARGS) const {
        const int row0 = u.pm * BM + wr * 64 + fr, col0 = u.pn * BM + wc * 32 + 8 * fq;
#pragma unroll
        for (int ai = 0; ai < 2; ++ai)
#pragma unroll
            for (int m = 0; m < 4; ++m) { const size_t r = (size_t)(row0 + ai * HALF + m * 16);
#pragma unroll
                for (int bj = 0; bj < 2; ++bj) { const int c = col0 + bj * HALF;
                    f32x4 g0, g1; unpack8(*(const u32x4*)(G + r * ldg + c), g0, g1);
                    f32x4 v0 = acc[ai][bj][m][0] * g0, v1 = acc[ai][bj][m][1] * g1;
                    if (ADD) { f32x4 o0, o1; unpack8(*(const u32x4*)(O + r * DM + c), o0, o1); v0 += o0; v1 += o1;
                        *(u32x2*)(MF8 + r * DM + c) = (u32x2){pack4_fp8(v0[0], v0[1], v0[2], v0[3]), pack4_fp8(v1[0], v1[1], v1[2], v1[3])}; }
                    else *(u32x4*)(O + r * DM + c) = pack8(v0, v1); } }
    }
};
struct EpiResF32 {
    const float* base; float* out; float* ssp;
    __device__ __forceinline__ void operator()(EPI_ARGS) const {
        const int row0 = u.pm * BM + wr * 64 + fr, col0 = u.pn * BM + wc * 32 + 8 * fq;
#pragma unroll
        for (int ai = 0; ai < 2; ++ai)
#pragma unroll
            for (int m = 0; m < 4; ++m) { const size_t r = (size_t)(row0 + ai * HALF + m * 16); float ss = 0.f;
#pragma unroll
                for (int bj = 0; bj < 2; ++bj) { const size_t off = r * DM + col0 + bj * HALF;
                    const f32x4 b0 = *(const f32x4*)(base + off), b1 = *(const f32x4*)(base + off + 4);
                    const f32x4 y0 = b0 + acc[ai][bj][m][0], y1 = b1 + acc[ai][bj][m][1];
                    *(f32x4*)(out + off) = y0; *(f32x4*)(out + off + 4) = y1;
                    ss += (y0[0] * y0[0] + y0[1] * y0[1]) + (y0[2] * y0[2] + y0[3] * y0[3]) + (y1[0] * y1[0] + y1[1] * y1[1]) + (y1[2] * y1[2] + y1[3] * y1[3]); }
                ss += __shfl_xor(ss, 16); ss += __shfl_xor(ss, 32);
                if (fq == 0) ssp[r * 16 + u.pn * 4 + wc] = ss; }
    }
};
struct EpiSwiglu {
    unsigned char* O; const float* bias;
    __device__ __forceinline__ void operator()(EPI_ARGS) const {
        const int row0 = u.pm * BM + wr * 64 + fr, j0 = u.pn * HALF + wc * 32 + 8 * fq;
        const float* be = bias + (size_t)u.e * 2048;
        f32x4 bg[2], bu[2];
#pragma unroll
        for (int n = 0; n < 2; ++n) { bg[n] = *(const f32x4*)(be + j0 + 4 * n); bu[n] = *(const f32x4*)(be + 1024 + j0 + 4 * n); }
#pragma unroll
        for (int ai = 0; ai < 2; ++ai)
#pragma unroll
            for (int m = 0; m < 4; ++m) { unsigned char* rowp = O + (size_t)(row0 + ai * HALF + m * 16) * DEXP + j0;
                f32x4 o[2];
#pragma unroll
                for (int n = 0; n < 2; ++n) { const f32x4 gv = acc[ai][0][m][n] + bg[n], uv = acc[ai][1][m][n] + bu[n];
#pragma unroll
                    for (int i = 0; i < 4; ++i) { const float gg = fminf(gv[i], 7.0f), uu = fminf(fmaxf(uv[i], -7.0f), 7.0f);
                        o[n][i] = (uu + 1.0f) * gg * __builtin_amdgcn_rcpf(1.0f + __builtin_amdgcn_exp2f(-1.702f * LOG2E * gg)); } }
                *(u32x2*)rowp = (u32x2){pack4_fp8(o[0][0], o[0][1], o[0][2], o[0][3]), pack4_fp8(o[1][0], o[1][1], o[1][2], o[1][3])}; }
    }
};
struct EpiFinal {
    float* out; const bf16_t* PP;
    __device__ __forceinline__ void operator()(EPI_ARGS) const {
        const int row0 = u.pm * BM + wr * 64 + fr, col0 = u.pn * BM + wc * 32 + 8 * fq;
#pragma unroll
        for (int ai = 0; ai < 2; ++ai)
#pragma unroll
            for (int m = 0; m < 4; ++m) { const size_t r = (size_t)(row0 + ai * HALF + m * 16);
#pragma unroll
                for (int bj = 0; bj < 2; ++bj) { const size_t off = r * DM + col0 + bj * HALF;
                    f32x4 p0, p1; unpack8(*(const u32x4*)(PP + off), p0, p1);
                    const f32x4 b0 = *(const f32x4*)(out + off), b1 = *(const f32x4*)(out + off + 4);
                    *(f32x4*)(out + off) = b0 + sig4(acc[ai][bj][m][0]) * p0; *(f32x4*)(out + off + 4) = b1 + sig4(acc[ai][bj][m][1]) * p1; } }
    }
};
}

namespace att {
__device__ __forceinline__ int crow(int r, int hi) { return (r & 3) + 8 * (r >> 2) + 4 * hi; }
__device__ __forceinline__ void glds16(const void* gsrc, unsigned lds_dst) { unsigned keep;
    asm volatile("s_mov_b32 %0, m0\n\ts_mov_b32 m0, %2\n\ts_nop 0\n\tglobal_load_lds_dwordx4 %1, off\n\ts_mov_b32 m0, %0" : "=&s"(keep) : "v"(gsrc), "s"(lds_dst) : "memory"); }
__device__ __forceinline__ s16x4 vtr(const LAS unsigned char* p) { return __builtin_bit_cast(s16x4, __builtin_amdgcn_ds_read_tr16_b64_v4i16((LAS s16x4*)p)); }
#define MX3(a, b, c) __builtin_fmaxf(__builtin_fmaxf((a), (b)), (c))
constexpr int VSLOT = 8192, OST_BYTES = NWAVES * 4096, WSF_BYTES = NWAVES * 256;

template <int DQK, bool MOBA>
__device__ __forceinline__ void attn_unit(int b, int qb, const bf16_t* Qh, int ldq, const bf16_t* Kh, int ldk, const bf16_t* Vh, int ldv, bf16_t* Oh, int ldo, const float* kmean, LAS unsigned char* shm, int wave) {
    constexpr int ND = DQK / 16, NCH = DQK / 8, KSLOT = NCH * 1024;
    constexpr int LDS_K = 0, LDS_V = 2 * KSLOT, LDS_WS = LDS_V + 2 * VSLOT, LDS_OST = LDS_WS + WSF_BYTES;
    static_assert(LDS_OST + OST_BYTES <= RING_BYTES, "attention LDS");
    int lane = lane_id(); asm volatile("" : "+v"(lane));
    const int r32 = lane & 31, hi = lane >> 5; const int wid = wave;
    const long rowbase = (long)b * SEQ; const int q0 = qb * 256;
    const unsigned lds0 = (unsigned)(uintptr_t)shm;
    LAS float* wsf = (LAS float*)(shm + LDS_WS) + wid * 64;
    const int NT = 4 * (qb + 1);
    const bf16_t* ksrc0 = Kh + (rowbase + lane) * ldk + wid * 8;
    const bf16_t* vsrc0 = Vh + (rowbase + 16 * (wid & 3) + (lane >> 2)) * ldv + (wid >> 2) * 32 + (lane & 3) * 8;
#define ATT_DMA(kt, s) do { const long ro_ = (long)(kt) * 64; \
        glds16(ksrc0 + ro_ * ldk, (unsigned)__builtin_amdgcn_readfirstlane(lds0 + LDS_K + (s) * KSLOT + wid * 1024)); \
        if (NCH > 8 && wid < NCH - 8) glds16(ksrc0 + ro_ * ldk + 64, (unsigned)__builtin_amdgcn_readfirstlane(lds0 + LDS_K + (s) * KSLOT + (wid + 8) * 1024)); \
        glds16(vsrc0 + ro_ * ldv, (unsigned)__builtin_amdgcn_readfirstlane(lds0 + LDS_V + (s) * VSLOT + wid * 1024)); } while (0)
#define ATT_TILE(i) (MOBA ? ((i) < 4 ? 4 * qb + (i) : (i) - 4) : (i))
    ATT_DMA(ATT_TILE(0), 0);
    const bf16_t* Qw = Qh + (rowbase + q0 + wid * 32 + r32) * ldq + hi * 8;
    bf16x8 qr[ND];
#pragma unroll
    for (int d0 = 0; d0 < ND; ++d0) qr[d0] = *(const bf16x8*)(Qw + d0 * 16);
    unsigned bmask = 0xffffffffu;
    if (MOBA) {
        bmask = 1u << qb;
        if (qb <= 3) bmask |= (1u << qb) - 1u;
        else {
            float gsc[7];
#pragma unroll
            for (int n = 0; n < 7; ++n) { float s = 0.f;
                if (n < qb) {
#pragma unroll
                    for (int d0 = 0; d0 < ND; ++d0) { const float* km = kmean + n * 64 + d0 * 16 + hi * 8; const f32x4 k0 = *(const f32x4*)km, k1 = *(const f32x4*)(km + 4);
                        s += bf2f((unsigned short)qr[d0][0]) * k0[0] + bf2f((unsigned short)qr[d0][1]) * k0[1] + bf2f((unsigned short)qr[d0][2]) * k0[2] + bf2f((unsigned short)qr[d0][3]) * k0[3]
                           + bf2f((unsigned short)qr[d0][4]) * k1[0] + bf2f((unsigned short)qr[d0][5]) * k1[1] + bf2f((unsigned short)qr[d0][6]) * k1[2] + bf2f((unsigned short)qr[d0][7]) * k1[3]; }
                    s += __shfl_xor(s, 32);
                } else s = -INFINITY;
                gsc[n] = s; }
#pragma unroll
            for (int pass = 0; pass < 3; ++pass) { float best = -INFINITY; int bi = 0;
#pragma unroll
                for (int n = 0; n < 7; ++n) { const bool ok = (n < qb) && !((bmask >> n) & 1u) && (gsc[n] > best); best = ok ? gsc[n] : best; bi = ok ? n : bi; }
                bmask |= 1u << bi; }
        }
    }
    asm volatile("s_waitcnt vmcnt(0)" ::: "memory");
#pragma unroll
    for (int d0 = 0; d0 < ND; ++d0) asm volatile("" : "+v"(qr[d0]));
    float mhat = 0.f, l_reg = 0.f; f32x16 o[2]; o[0] = f32x16{}; o[1] = f32x16{}; f32x16 negm = f32x16{}; asm volatile("" : "+v"(negm));
    const int qrel = wid * 32 + r32;
    const LAS unsigned char* kp0 = shm + LDS_K + hi * 1024 + r32 * 16;
    const LAS unsigned char* vp0 = shm + LDS_V + ((lane >> 4) & 1) * 32 + (lane & 3) * 8 + (4 * hi + ((lane & 15) >> 2)) * 64;
    for (int i = 0; i < NT; ++i) {
        const int s = i & 1, kt = ATT_TILE(i);
        asm volatile("s_waitcnt vmcnt(0) lgkmcnt(0)\n\ts_barrier" ::: "memory");
        if (i + 1 < NT) ATT_DMA(ATT_TILE(i + 1), s ^ 1);
        f32x16 cin = negm;
        if (MOBA) { if (i >= 4 && !((bmask >> (kt >> 2)) & 1u)) {
#pragma unroll
            for (int r = 0; r < 16; ++r) cin[r] = -INFINITY; } }
        f32x16 p0, p1;
        { const LAS unsigned char* kb = kp0 + s * KSLOT; bf16x8 kf[2 * ND];
#pragma unroll
            for (int d0 = 0; d0 < ND; ++d0) { kf[2 * d0] = *(const LAS bf16x8*)(kb + d0 * 2048); kf[2 * d0 + 1] = *(const LAS bf16x8*)(kb + d0 * 2048 + 512); }
            __builtin_amdgcn_sched_barrier(0);
#pragma unroll
            for (int d0 = 0; d0 < ND; ++d0) {
                if (d0 == 0) { p0 = __builtin_amdgcn_mfma_f32_32x32x16_bf16(kf[0], qr[0], cin, 0, 0, 0); p1 = __builtin_amdgcn_mfma_f32_32x32x16_bf16(kf[1], qr[0], cin, 0, 0, 0); }
                else { p0 = __builtin_amdgcn_mfma_f32_32x32x16_bf16(kf[2 * d0], qr[d0], p0, 0, 0, 0); p1 = __builtin_amdgcn_mfma_f32_32x32x16_bf16(kf[2 * d0 + 1], qr[d0], p1, 0, 0, 0); } } }
        if (kt >= 4 * qb) { const int kb = 64 * (kt - 4 * qb) + 4 * hi;
#pragma unroll
            for (int r = 0; r < 16; ++r) { const int kv = kb + (r & 3) + 8 * (r >> 2); if (kv > qrel) p0[r] = -INFINITY; if (kv + 32 > qrel) p1[r] = -INFINITY; } }
        bool resc = false;
        { float a = MX3(p0[0], p0[1], p1[0]), bb = MX3(p0[2], p0[3], p1[1]); a = MX3(a, p1[2], p1[3]);
#pragma unroll
            for (int r = 4; r < 16; r += 4) { a = MX3(a, p0[r], p0[r + 1]); bb = MX3(bb, p0[r + 2], p0[r + 3]); a = MX3(a, p1[r], p1[r + 1]); bb = MX3(bb, p1[r + 2], p1[r + 3]); }
            float rm = __builtin_fmaxf(a, bb); rm = __builtin_fmaxf(rm, __shfl_xor(rm, 32));
            const bool first = (i == 0);
            if (first || __any(rm > 6.0f)) {
                const float dl = first ? rm : __builtin_fmaxf(rm, 0.f); mhat += dl;
#pragma unroll
                for (int r = 0; r < 16; ++r) { p0[r] -= dl; p1[r] -= dl; }
#pragma unroll
                for (int r = 0; r < 16; ++r) negm[r] = -mhat;
                asm volatile("" : "+v"(negm));
                const float f = __builtin_amdgcn_exp2f(-dl); l_reg *= f; if (hi == 0) wsf[r32] = f; resc = true; } }
        float sacc = 0.f;
#pragma unroll
        for (int r = 0; r < 16; ++r) { p0[r] = __builtin_amdgcn_exp2f(p0[r]); p1[r] = __builtin_amdgcn_exp2f(p1[r]); sacc += p0[r] + p1[r]; }
        l_reg += sacc;
        u32x4 pw0, pw1, pw2, pw3;
        pw0 = (u32x4){cvt_pk_bf16(p0[0], p0[1]), cvt_pk_bf16(p0[2], p0[3]), cvt_pk_bf16(p0[4], p0[5]), cvt_pk_bf16(p0[6], p0[7])};
        pw1 = (u32x4){cvt_pk_bf16(p0[8], p0[9]), cvt_pk_bf16(p0[10], p0[11]), cvt_pk_bf16(p0[12], p0[13]), cvt_pk_bf16(p0[14], p0[15])};
        pw2 = (u32x4){cvt_pk_bf16(p1[0], p1[1]), cvt_pk_bf16(p1[2], p1[3]), cvt_pk_bf16(p1[4], p1[5]), cvt_pk_bf16(p1[6], p1[7])};
        pw3 = (u32x4){cvt_pk_bf16(p1[8], p1[9]), cvt_pk_bf16(p1[10], p1[11]), cvt_pk_bf16(p1[12], p1[13]), cvt_pk_bf16(p1[14], p1[15])};
        if (resc) {
#pragma unroll
            for (int d_ = 0; d_ < 2; ++d_)
#pragma unroll
                for (int r = 0; r < 16; ++r) o[d_][r] *= wsf[crow(r, hi)];
        }
        { const LAS unsigned char* vp = vp0 + s * VSLOT;
#pragma unroll
            for (int d0 = 0; d0 < 2; ++d0) {
                s16x4 lo[4], hh[4];
#pragma unroll
                for (int ks = 0; ks < 4; ++ks) { lo[ks] = vtr(vp + d0 * 4096 + ks * 1024); hh[ks] = vtr(vp + d0 * 4096 + ks * 1024 + 512); }
                __builtin_amdgcn_sched_barrier(0);
#define PKV(k) (bf16x8){lo[k][0], lo[k][1], lo[k][2], lo[k][3], hh[k][0], hh[k][1], hh[k][2], hh[k][3]}
                o[d0] = __builtin_amdgcn_mfma_f32_32x32x16_bf16(__builtin_bit_cast(bf16x8, pw0), PKV(0), o[d0], 0, 0, 0);
                o[d0] = __builtin_amdgcn_mfma_f32_32x32x16_bf16(__builtin_bit_cast(bf16x8, pw1), PKV(1), o[d0], 0, 0, 0);
                o[d0] = __builtin_amdgcn_mfma_f32_32x32x16_bf16(__builtin_bit_cast(bf16x8, pw2), PKV(2), o[d0], 0, 0, 0);
                o[d0] = __builtin_amdgcn_mfma_f32_32x32x16_bf16(__builtin_bit_cast(bf16x8, pw3), PKV(3), o[d0], 0, 0, 0);
#undef PKV
            } }
    }
    l_reg += __shfl_xor(l_reg, 32);
    if (hi == 0) wsf[32 + r32] = l_reg;
    float rli[16];
#pragma unroll
    for (int r = 0; r < 16; ++r) rli[r] = __builtin_amdgcn_rcpf(wsf[32 + crow(r, hi)]);
    bf16_t* Ow = Oh + (rowbase + q0 + wid * 32) * ldo;
    { LAS bf16_t* stg = (LAS bf16_t*)(shm + LDS_OST) + wid * 2048;
#pragma unroll
        for (int r = 0; r < 16; ++r) { const int orow = crow(r, hi);
#pragma unroll
            for (int d0 = 0; d0 < 2; ++d0) stg[orow * 64 + d0 * 32 + r32] = (bf16_t)(cvt_pk_bf16(o[d0][r] * rli[r], 0.f) & 0xffffu); }
#pragma unroll
        for (int i = 0; i < 4; ++i) { const int row = i * 8 + (lane >> 3), ch = lane & 7; const u32x4 v = *(const LAS u32x4*)(stg + row * 64 + ch * 8); *(u32x4*)(Ow + (long)row * ldo + ch * 8) = v; } }
    asm volatile("s_waitcnt vmcnt(0) lgkmcnt(0)\n\ts_barrier" ::: "memory");
#undef ATT_DMA
#undef ATT_TILE
}
#undef MX3
}

#define XB_TMO      128
#define XB_XCNT(j)  (256  + 64 * (j))
#define XB_XSUB(j)  (1280 + 64 * (j))
#define XB_XGEN(j)  (2304 + 64 * (j))
#define XB_TOP      3328
#define XB_TOPGEN   3392
#define XCD_BAR_WORDS 3456
#define XB_SPIN_CAP (1u << 22)
__device__ __forceinline__ unsigned xb_ld(unsigned* p)              { return __hip_atomic_load(p, __ATOMIC_RELAXED, __HIP_MEMORY_SCOPE_AGENT); }
__device__ __forceinline__ unsigned xb_add(unsigned* p, unsigned v) { return __hip_atomic_fetch_add(p, v, __ATOMIC_RELAXED, __HIP_MEMORY_SCOPE_AGENT); }
__device__ __forceinline__ unsigned xb_xcc_id() { return (unsigned)__builtin_amdgcn_s_getreg((3 << 11) | 20) & 0xFu; }
#define XB_SPIN(cond, bar) do { unsigned _sp = 0; while (cond) { __builtin_amdgcn_s_sleep(1); \
    if ((++_sp & 255u) == 0u) { if (xb_ld(&(bar)[XB_TMO])) break; if (_sp > XB_SPIN_CAP) { atomicAdd(&(bar)[XB_TMO], 1u); break; } } } } while (0)
struct XcdBarrier { unsigned* bar; unsigned x; volatile LAS unsigned* st; int wave; };
__device__ __forceinline__ XcdBarrier xcd_barrier_post(unsigned* bar, volatile LAS unsigned* st, int wave) {
    XcdBarrier b; b.bar = bar; b.x = xb_xcc_id(); b.st = st; b.wave = wave;
    if (wave == 0 && lane_id() == 0) (void)xb_add(&bar[XB_XCNT(b.x)], 1u);
    return b;
}
__device__ __forceinline__ void xcd_barrier_complete(unsigned* bar, unsigned x, unsigned& nloc, unsigned& nx) {
    const unsigned G = gridDim.x * gridDim.y * gridDim.z;
    unsigned sum, cnt, mine, sp = 0u;
    for (;;) {
        sum = 0u; cnt = 0u; mine = 0u;
#pragma unroll
        for (unsigned j = 0; j < 16; ++j) { const unsigned c = xb_ld(&bar[XB_XCNT(j)]); sum += c; cnt += (c > 0u) ? 1u : 0u; mine = (j == x) ? c : mine; }
        if (sum == G) break;
        __builtin_amdgcn_s_sleep(1);
        if ((++sp & 255u) == 0u) { if (xb_ld(&bar[XB_TMO])) break; if (sp > XB_SPIN_CAP) { atomicAdd(&bar[XB_TMO], 1u); break; } }
    }
    nloc = mine > 0u ? mine : 1u; nx = cnt > 0u ? cnt : 1u;
}
__device__ __forceinline__ void xcd_barrier(const XcdBarrier& b) {
    asm volatile("s_waitcnt vmcnt(0)" ::: "memory");
    __syncthreads();
    if (b.wave == 0 && lane_id() == 0) {
        unsigned* bar = b.bar;
        __builtin_amdgcn_s_waitcnt(0);
        unsigned nloc = b.st[0], nx = b.st[1];
        if (nloc == 0u) { xcd_barrier_complete(bar, b.x, nloc, nx); b.st[0] = nloc; b.st[1] = nx; }
        const unsigned old = xb_add(&bar[XB_XSUB(b.x)], 1u);
        const unsigned gen = old / nloc;
        if (old + 1u == (gen + 1u) * nloc) {
            __builtin_amdgcn_fence(__ATOMIC_RELEASE, "agent");
            asm volatile("s_waitcnt vmcnt(0)" ::: "memory");
            const unsigned og = xb_add(&bar[XB_TOP], 1u);
            const unsigned tg = og / nx;
            if (og + 1u == (tg + 1u) * nx) xb_add(&bar[XB_TOPGEN], 1u);
            else XB_SPIN(xb_ld(&bar[XB_TOPGEN]) == tg, bar);
            __builtin_amdgcn_fence(__ATOMIC_ACQUIRE, "agent");
            xb_add(&bar[XB_XGEN(b.x)], 1u);
            asm volatile("s_waitcnt vmcnt(0)" ::: "memory");
        } else {
            XB_SPIN(xb_ld(&bar[XB_XGEN(b.x)]) == gen, bar);
            __builtin_amdgcn_fence(__ATOMIC_ACQUIRE, "agent");
            asm volatile("s_waitcnt vmcnt(0)" ::: "memory");
        }
    }
    __syncthreads();
}

struct Params { const float* in[25]; float* out; unsigned char* ws; int ph_lo, ph_hi; };
enum { I_X = 0, I_P, I_GMIX, I_WIN, I_MQN, I_MKN, I_QLATN, I_WUQ, I_KVLATN, I_WUKV, I_MLAQN, I_MLAKN, I_WA, I_WB, I_WO, I_GFFN, I_WR, I_BR, I_WGU, I_BGU, I_WD, I_BD, I_GPLE, I_WPG, I_WPP };
constexpr int NPHASE = 16;

struct Frame {
    LAS unsigned char* lds; int vcu, G, wave;
    const Params* P; unsigned char* ws;
};
struct Ids { int tid, lane, wave; };
#define PHASE_IDS() Ids I_; { int l_ = lane_id(); asm volatile("" : "+v"(l_)); I_.lane = l_; I_.wave = F.wave; I_.tid = F.wave * 64 + l_; }

#ifdef TPROBE_A
#define STAMP(k) do { if (blockIdx.x == 0 && F.wave == 0 && lane_id() == 0) ((volatile unsigned long long*)(ws + WS_ERR))[k] = __builtin_amdgcn_s_memrealtime(); } while (0)
#else
#define STAMP(k) do {} while (0)
#endif
__device__ __forceinline__ int rowmap(int mode, int c) {
    if (mode == 1) {
        if (c < 1024) { const int base = c & 512, s_ = c & 511, h = s_ >> 6, d = s_ & 63; return base + 256 * (h >> 2) + 128 * (d >> 5) + 32 * (h & 3) + (d & 31); }
        return c < 1952 ? c : c + 96; }
    if (mode == 2) return c < 1024 ? 256 * (c >> 7) + (c & 127) : 256 * ((c - 1024) >> 7) + 128 + ((c - 1024) & 127);
    if (mode == 3) {
        const int h = c / 96, d = c % 96; int t;
        if (d < 64) t = d; else if (d < 80) { const int i = d - 64; t = 64 + 8 * (i >> 2) + (i & 3); } else { const int i = d - 80; t = 64 + 8 * (i >> 2) + 4 + (i & 3); }
        return 128 * h + t; }
    return c;
}
__device__ __forceinline__ void tr_item64(const float* W, int ldw, int N, int k0, int n0, bf16_t* dst, int ldd, int mode, LAS float* scr, int lane) {
    const int r = lane >> 4, c4 = lane & 15; const bool inb = (n0 + 4 * c4) < N;
    f32x4 v[16];
#pragma unroll
    for (int i = 0; i < 16; ++i) v[i] = inb ? __builtin_nontemporal_load((const f32x4*)(W + (size_t)(k0 + 4 * i + r) * ldw + n0 + 4 * c4)) : (f32x4){0.f, 0.f, 0.f, 0.f};
#pragma unroll
    for (int i = 0; i < 16; ++i) { LAS float* p = scr + (4 * i + r) * 65 + 4 * c4; p[0] = v[i].x; p[1] = v[i].y; p[2] = v[i].z; p[3] = v[i].w; }
    asm volatile("s_waitcnt lgkmcnt(0)" ::: "memory");
    const int c = lane & 7;
#pragma unroll
    for (int j = 0; j < 8; ++j) { const int n = (lane >> 3) + 8 * j; const LAS float* sp = scr + (8 * c) * 65 + n;
        u32x4 o; o.x = cvt_pk_bf16(sp[0 * 65], sp[1 * 65]); o.y = cvt_pk_bf16(sp[2 * 65], sp[3 * 65]); o.z = cvt_pk_bf16(sp[4 * 65], sp[5 * 65]); o.w = cvt_pk_bf16(sp[6 * 65], sp[7 * 65]);
        if (n0 + n < N) *(u32x4*)(dst + (size_t)rowmap(mode, n0 + n) * ldd + k0 + 8 * c) = o; }
    asm volatile("s_waitcnt lgkmcnt(0)" ::: "memory");
}

__device__ __forceinline__ void tr_item_f8(const float* W, int ldw, int k0, int n0, unsigned char* dst, int ldd, int mode, LAS float* scr, int lane) {
    const int r = lane >> 3, c4 = lane & 7;
    f32x4 v[16];
#pragma unroll
    for (int i = 0; i < 16; ++i) v[i] = __builtin_nontemporal_load((const f32x4*)(W + (size_t)(k0 + 8 * i + r) * ldw + n0 + 4 * c4));
#pragma unroll
    for (int i = 0; i < 16; ++i) { LAS float* p = scr + (8 * i + r) * 33 + 4 * c4; p[0] = v[i].x * 64.f; p[1] = v[i].y * 64.f; p[2] = v[i].z * 64.f; p[3] = v[i].w * 64.f; }
    asm volatile("s_waitcnt lgkmcnt(0)" ::: "memory");
    const int c = lane & 7;
#pragma unroll
    for (int j = 0; j < 4; ++j) { const int n = (lane >> 3) + 8 * j; const LAS float* sp = scr + (16 * c) * 33 + n;
        u32x4 o; o.x = pack4_fp8(sp[0 * 33], sp[1 * 33], sp[2 * 33], sp[3 * 33]); o.y = pack4_fp8(sp[4 * 33], sp[5 * 33], sp[6 * 33], sp[7 * 33]);
        o.z = pack4_fp8(sp[8 * 33], sp[9 * 33], sp[10 * 33], sp[11 * 33]); o.w = pack4_fp8(sp[12 * 33], sp[13 * 33], sp[14 * 33], sp[15 * 33]);
        __builtin_nontemporal_store(o, (u32x4*)(dst + (size_t)rowmap(mode, n0 + n) * ldd + k0 + 16 * c)); }
    asm volatile("s_waitcnt lgkmcnt(0)" ::: "memory");
}

__device__ __forceinline__ void phase0(Frame& F) {
    PHASE_IDS();
    const Params& P = *F.P; unsigned char* ws = F.ws;
    LAS float* scr = (LAS float*)(F.lds + I_.wave * 16896);
    const int gw = F.vcu * NWAVES + I_.wave, NGW = F.G * NWAVES;
    constexpr int I_GU = 32 * 8 * 64, I_DN = 32 * 8 * 32, I_IN = 16 * 31, I_ING = 8 * 64, I_UQ = 4 * 12, I_UKV = 2 * 16, I_A = 8 * 16, I_O = 16 * 16, I_PP = 4 * 16;
    constexpr int I_PG = 8 * 32;
    constexpr int NITEMS = I_GU + I_DN + I_IN + I_ING + I_UQ + I_UKV + 2 * I_A + I_O + I_PG + I_PP;
    for (int it = gw; it < NITEMS; it += NGW) {
        int r = it;
        if (r < I_GU) { const int e = r >> 9, q = r & 511, kb = q >> 6, g = q & 63;
            tr_item_f8(P.in[I_WGU] + (size_t)e * 1024 * 2048, 2048, 128 * kb, 32 * g, ws + WS_W1 + (size_t)e * 2048 * 1024, 1024, 2, scr, I_.lane); continue; } r -= I_GU;
        if (r < I_DN) { const int e = r >> 8, q = r & 255, kb = q >> 5, g = q & 31;
            tr_item_f8(P.in[I_WD] + (size_t)e * 1024 * 1024, 1024, 128 * kb, 32 * g, ws + WS_W2 + (size_t)e * 1024 * 1024, 1024, 0, scr, I_.lane); continue; } r -= I_DN;
        if (r < I_IN) { const int kb = r / 31, g = r % 31; tr_item64(P.in[I_WIN], DIN, 1952, 64 * kb, 64 * g, (bf16_t*)(ws + WS_WIN), 1024, 1, scr, I_.lane); continue; } r -= I_IN;
        if (r < I_ING) { const int kb = r >> 6, g = r & 63; tr_item_f8(P.in[I_WIN] + 1952, DIN, 128 * kb, 32 * g, ws + WS_WINF8, 1024, 0, scr, I_.lane); continue; } r -= I_ING;
        if (r < I_UQ) { const int kb = r / 12, g = r % 12; tr_item64(P.in[I_WUQ], 768, 768, 64 * kb, 64 * g, (bf16_t*)(ws + WS_WUQ), 256, 3, scr, I_.lane); continue; } r -= I_UQ;
        if (r < I_UKV) { const int kb = r / 16, g = r % 16; tr_item64(P.in[I_WUKV], 1024, 1024, 64 * kb, 64 * g, (bf16_t*)(ws + WS_WUKV), 128, 0, scr, I_.lane); continue; } r -= I_UKV;
        if (r < I_A) { const int kb = r / 16, g = r % 16; tr_item64(P.in[I_WA], 1024, 1024, 64 * kb, 64 * g, (bf16_t*)(ws + WS_WA), 512, 0, scr, I_.lane); continue; } r -= I_A;
        if (r < I_A) { const int kb = r / 16, g = r % 16; tr_item64(P.in[I_WB], 1024, 1024, 64 * kb, 64 * g, (bf16_t*)(ws + WS_WB), 512, 0, scr, I_.lane); continue; } r -= I_A;
        if (r < I_PG) { const int kb = r >> 5, g = r & 31; tr_item_f8(P.in[I_WO], 1024, 128 * kb, 32 * g, ws + WS_WO, 1024, 0, scr, I_.lane); continue; } r -= I_PG;
        if (r < I_PG) { const int kb = r >> 5, g = r & 31; tr_item_f8(P.in[I_WPG], 1024, 128 * kb, 32 * g, ws + WS_WPG, 1024, 0, scr, I_.lane); continue; } r -= I_PG;
        { const int kb = r / 16, g = r % 16; tr_item64(P.in[I_WPP], 1024, 1024, 64 * kb, 64 * g, (bf16_t*)(ws + WS_WPP), 256, 0, scr, I_.lane); }
    }
    STAMP(20);
    { const f32x4* gp = (const f32x4*)P.in[I_GMIX] + I_.lane; f32x4 gv[4];
#pragma unroll
        for (int j = 0; j < 4; ++j) gv[j] = gp[64 * j];
        for (int m0 = gw * 4; m0 < NTOK; m0 += NGW * 4) { f32x4 v[4][4];
#pragma unroll
            for (int q = 0; q < 4; ++q) { const f32x4* xr = (const f32x4*)(P.in[I_X] + (size_t)(m0 + q) * DM) + I_.lane;
#pragma unroll
                for (int j = 0; j < 4; ++j) v[q][j] = xr[64 * j]; }
#pragma unroll
            for (int q = 0; q < 4; ++q) { float s = 0.f;
#pragma unroll
                for (int j = 0; j < 4; ++j) s += (v[q][j].x * v[q][j].x + v[q][j].y * v[q][j].y) + (v[q][j].z * v[q][j].z + v[q][j].w * v[q][j].w);
                const float rstd = 1.0f / sqrtf(wave_sum(s) * (1.f / DM) + EPS);
                u32x2* o8 = (u32x2*)((bf16_t*)(ws + WS_HN) + (size_t)(m0 + q) * DM) + I_.lane; unsigned* o4 = (unsigned*)(ws + WS_HNF8 + (size_t)(m0 + q) * DM) + I_.lane;
#pragma unroll
                for (int j = 0; j < 4; ++j) { const f32x4 y = v[q][j] * rstd * gv[j]; o8[64 * j] = (u32x2){cvt_pk_bf16(y.x, y.y), cvt_pk_bf16(y.z, y.w)}; o4[64 * j] = pack4_fp8(y.x, y.y, y.z, y.w); } } } }
    STAMP(21);
    { float* km = (float*)(ws + WS_KMEAN); for (int i = F.vcu * NTHREADS + I_.tid; i < 8 * 8 * 8 * 64; i += F.G * NTHREADS) km[i] = 0.f; }
    { const size_t n4 = (size_t)NTOK * 256 / 4; const f32x4* pp = (const f32x4*)P.in[I_P]; u32x2* po = (u32x2*)(ws + WS_PB); const size_t T = (size_t)F.G * NTHREADS;
        for (size_t i = (size_t)F.vcu * NTHREADS + I_.tid; i < n4; i += 4 * T) { f32x4 v[4];
#pragma unroll
            for (int q = 0; q < 4; ++q) v[q] = __builtin_nontemporal_load(pp + i + q * T);
#pragma unroll
            for (int q = 0; q < 4; ++q) po[i + q * T] = (u32x2){cvt_pk_bf16(v[q].x, v[q].y), cvt_pk_bf16(v[q].z, v[q].w)}; } }
    STAMP(22);
    { float* tab = (float*)(ws + WS_ROPE);
        for (int i = F.vcu * NTHREADS + I_.tid; i < 2048 * 48; i += F.G * NTHREADS) {
            int pos, j, half; float* cdst; float* sdst;
            if (i < 2048 * 32) { pos = i / 32; j = i % 32; half = 32; cdst = tab + i; sdst = tab + 65536 + i; }
            else { const int q = i - 2048 * 32; pos = q / 16; j = q % 16; half = 16; cdst = tab + 131072 + q; sdst = tab + 131072 + 32768 + q; }
            const float inv = powf(10000.0f, -((float)j / (float)half)); const float ang = (float)pos * inv;
            *cdst = cosf(ang); *sdst = sinf(ang); } }
}

__device__ __forceinline__ void phase2(Frame& F) {
    PHASE_IDS();
    const Params& P = *F.P; unsigned char* ws = F.ws;
    const bf16_t* PROJ = (const bf16_t*)(ws + WS_PROJ);
    const float* cosA = (const float*)(ws + WS_ROPE); const float* sinA = cosA + 65536;
    LAS float* kst = (LAS float*)F.lds;
    LAS float* part = kst + 256 * 68;
    for (int it = F.vcu; it < 512; it += F.G) {
        const int b = it >> 6, blk = (it >> 3) & 7, h = it & 7;
        const int sel = I_.lane >> 5, r = I_.wave * 32 + (I_.lane & 31); const int pos = blk * 256 + r; const size_t row = (size_t)b * SEQ + pos;
        const u32x4* src = (const u32x4*)(PROJ + row * DINP + (sel ? PC_KA : PC_QA) + h * 64);
        u32x4 raw[8];
#pragma unroll
        for (int c = 0; c < 8; ++c) raw[c] = src[c];
        float ss = 0.f;
#pragma unroll
        for (int c = 0; c < 8; ++c) { f32x4 a0, a1; pg8::unpack8(raw[c], a0, a1); ss += (a0[0] * a0[0] + a0[1] * a0[1]) + (a0[2] * a0[2] + a0[3] * a0[3]) + (a1[0] * a1[0] + a1[1] * a1[1]) + (a1[2] * a1[2] + a1[3] * a1[3]); }
        const float rstd = 1.0f / sqrtf(ss * (1.f / 64.f) + EPS);
        const float* gn = sel ? P.in[I_MKN] : P.in[I_MQN];
        const float sc = sel ? 1.0f : C2A;
        bf16_t* dst = (bf16_t*)(ws + (sel ? WS_KA2 : WS_QA2)) + row * 512 + h * 64;
#pragma unroll
        for (int c = 0; c < 4; ++c) { f32x4 x1a, x1b, x2a, x2b; pg8::unpack8(raw[c], x1a, x1b); pg8::unpack8(raw[c + 4], x2a, x2b);
            const f32x4 g1a = *(const f32x4*)(gn + 8 * c), g1b = *(const f32x4*)(gn + 8 * c + 4), g2a = *(const f32x4*)(gn + 32 + 8 * c), g2b = *(const f32x4*)(gn + 36 + 8 * c);
            x1a = x1a * g1a * rstd; x1b = x1b * g1b * rstd; x2a = x2a * g2a * rstd; x2b = x2b * g2b * rstd;
            const f32x4 ca = *(const f32x4*)(cosA + pos * 32 + 8 * c), cb = *(const f32x4*)(cosA + pos * 32 + 8 * c + 4), sa = *(const f32x4*)(sinA + pos * 32 + 8 * c), sb = *(const f32x4*)(sinA + pos * 32 + 8 * c + 4);
            const f32x4 y1a = x1a * ca - x2a * sa, y1b = x1b * cb - x2b * sb, y2a = x2a * ca + x1a * sa, y2b = x2b * cb + x1b * sb;
            *(u32x4*)(dst + 8 * c) = pg8::pack8(y1a * sc, y1b * sc); *(u32x4*)(dst + 32 + 8 * c) = pg8::pack8(y2a * sc, y2b * sc);
            if (sel) { LAS f32x4* kr = (LAS f32x4*)(kst + r * 68); kr[2 * c] = y1a; kr[2 * c + 1] = y1b; kr[8 + 2 * c] = y2a; kr[8 + 2 * c + 1] = y2b; } }
        __syncthreads();
        { const int d = I_.tid & 63, pt = I_.tid >> 6; float s = 0.f;
#pragma unroll 8
            for (int rr = 0; rr < 32; ++rr) s += kst[(pt * 32 + rr) * 68 + d];
            part[pt * 64 + d] = s; }
        __syncthreads();
        if (I_.tid < 64) { float s = 0.f;
#pragma unroll
            for (int pt = 0; pt < 8; ++pt) s += part[pt * 64 + I_.tid];
            ((float*)(ws + WS_KMEAN))[(((size_t)b * 8 + h) * 8 + blk) * 64 + I_.tid] = s * (1.f / 256.f); }
        __syncthreads();
    }
    const int gw = F.vcu * NWAVES + I_.wave, NGW = F.G * NWAVES;
    const f32x4 gq = ((const f32x4*)P.in[I_QLATN])[I_.lane]; const f32x2 gk = ((const f32x2*)P.in[I_KVLATN])[I_.lane];
    for (int m0 = gw * 8; m0 < NTOK; m0 += NGW * 8) {
        u32x2 wq[8]; unsigned wk[8];
#pragma unroll
        for (int q = 0; q < 8; ++q) { wq[q] = *((const u32x2*)(PROJ + (size_t)(m0 + q) * DINP + PC_CQ) + I_.lane); wk[q] = *((const unsigned*)(PROJ + (size_t)(m0 + q) * DINP + PC_CKV) + I_.lane); }
#pragma unroll
        for (int r = 0; r < 8; ++r) { const int m = m0 + r;
            const f32x4 q = {bflo(wq[r].x), bfhi(wq[r].x), bflo(wq[r].y), bfhi(wq[r].y)}; const f32x2 k = {bflo(wk[r]), bfhi(wk[r])};
            const float sq = wave_sum((q.x * q.x + q.y * q.y) + (q.z * q.z + q.w * q.w)), sk = wave_sum(k.x * k.x + k.y * k.y);
            const float rq = 1.0f / sqrtf(sq * (1.f / 256.f) + EPS), rk = 1.0f / sqrtf(sk * (1.f / 128.f) + EPS);
            const f32x4 yq = q * rq * gq; const f32x2 yk = k * rk * gk;
            *((u32x2*)((bf16_t*)(ws + WS_CQN) + (size_t)m * 256) + I_.lane) = (u32x2){cvt_pk_bf16(yq.x, yq.y), cvt_pk_bf16(yq.z, yq.w)};
            *((unsigned*)((bf16_t*)(ws + WS_CKVN) + (size_t)m * 128) + I_.lane) = cvt_pk_bf16(yk.x, yk.y); }
    }
}

__device__ __forceinline__ void phase4(Frame& F) {
    PHASE_IDS();
    const Params& P = *F.P; unsigned char* ws = F.ws;
    const bf16_t* PROJ = (const bf16_t*)(ws + WS_PROJ);
    const float* cosB = (const float*)(ws + WS_ROPE) + 131072; const float* sinB = cosB + 32768;
    const int gw = F.vcu * NWAVES + I_.wave, NGW = F.G * NWAVES;
    for (int it = gw; it < (NTOK / 64) * 16; it += NGW) {
        const int h = it & 7, sel = (it >> 3) & 1, rg = it >> 4; const size_t row = (size_t)rg * 64 + I_.lane; const int pos = (int)(row & (SEQ - 1));
        u32x4 raw[12];
        bf16_t* qrow = (bf16_t*)(ws + WS_QB) + row * 768 + h * 96;
        if (sel == 0) {
#pragma unroll
            for (int c = 0; c < 12; ++c) raw[c] = *(const u32x4*)(qrow + 8 * c);
        } else {
            const bf16_t* kn = (const bf16_t*)(ws + WS_KV) + row * 1024 + h * 128; const bf16_t* kp = PROJ + row * DINP + PC_KPE;
#pragma unroll
            for (int c = 0; c < 8; ++c) raw[c] = *(const u32x4*)(kn + 8 * c);
#pragma unroll
            for (int c = 0; c < 4; ++c) raw[8 + c] = *(const u32x4*)(kp + 8 * c);
        }
        float ss = 0.f;
#pragma unroll
        for (int c = 0; c < 12; ++c) { f32x4 a0, a1; pg8::unpack8(raw[c], a0, a1); ss += (a0[0] * a0[0] + a0[1] * a0[1]) + (a0[2] * a0[2] + a0[3] * a0[3]) + (a1[0] * a1[0] + a1[1] * a1[1]) + (a1[2] * a1[2] + a1[3] * a1[3]); }
        const float rstd = 1.0f / sqrtf(ss * (1.f / 96.f) + EPS);
        const float* gn = sel ? P.in[I_MLAKN] : P.in[I_MLAQN];
        const float sc = sel ? 1.0f : C2B; const float rs = rstd * sc;
        bf16_t* dst = sel ? (bf16_t*)(ws + WS_KB2) + row * 768 + h * 96 : qrow;
#pragma unroll
        for (int c = 0; c < 8; ++c) { f32x4 a0, a1; pg8::unpack8(raw[c], a0, a1); const f32x4 g0 = *(const f32x4*)(gn + 8 * c), g1 = *(const f32x4*)(gn + 8 * c + 4);
            *(u32x4*)(dst + 8 * c) = pg8::pack8(a0 * g0 * rs, a1 * g1 * rs); }
#pragma unroll
        for (int c = 0; c < 2; ++c) { f32x4 x1a, x1b, x2a, x2b; pg8::unpack8(raw[8 + c], x1a, x1b); pg8::unpack8(raw[10 + c], x2a, x2b);
            const f32x4 g1a = *(const f32x4*)(gn + 64 + 8 * c), g1b = *(const f32x4*)(gn + 68 + 8 * c), g2a = *(const f32x4*)(gn + 80 + 8 * c), g2b = *(const f32x4*)(gn + 84 + 8 * c);
            x1a = x1a * g1a * rs; x1b = x1b * g1b * rs; x2a = x2a * g2a * rs; x2b = x2b * g2b * rs;
            const f32x4 ca = *(const f32x4*)(cosB + pos * 16 + 8 * c), cb = *(const f32x4*)(cosB + pos * 16 + 8 * c + 4), sa = *(const f32x4*)(sinB + pos * 16 + 8 * c), sb = *(const f32x4*)(sinB + pos * 16 + 8 * c + 4);
            *(u32x4*)(dst + 64 + 8 * c) = pg8::pack8(x1a * ca - x2a * sa, x1b * cb - x2b * sb);
            *(u32x4*)(dst + 80 + 8 * c) = pg8::pack8(x2a * ca + x1a * sa, x2b * cb + x1b * sb); }
    }
}

__device__ __forceinline__ void phase5(Frame& F) {
    unsigned char* ws = F.ws;
    for (int it = F.vcu; it < 256; it += F.G) {
        const int bh = it >> 2, sidx = it & 3, b = bh >> 3, h = bh & 7;
#pragma unroll 1
        for (int k = 0; k < 2; ++k) { const int qb = k ? 7 - sidx : sidx;
            att::attn_unit<64, true>(b, qb, (const bf16_t*)(ws + WS_QA2) + h * 64, 512, (const bf16_t*)(ws + WS_KA2) + h * 64, 512, (const bf16_t*)(ws + WS_PROJ) + PC_VA + h * 64, DINP,
                                     (bf16_t*)(ws + WS_Y) + h * 64, 1024, (const float*)(ws + WS_KMEAN) + (size_t)bh * 512, F.lds, F.wave); }
#pragma unroll 1
        for (int k = 0; k < 2; ++k) { const int qb = k ? 7 - sidx : sidx;
            att::attn_unit<96, false>(b, qb, (const bf16_t*)(ws + WS_QB) + h * 96, 768, (const bf16_t*)(ws + WS_KB2) + h * 96, 768, (const bf16_t*)(ws + WS_KV) + h * 128 + 64, 1024,
                                      (bf16_t*)(ws + WS_Y) + 512 + h * 64, 1024, nullptr, F.lds, F.wave); }
    }
}

__device__ __forceinline__ void phase8(Frame& F) {
    PHASE_IDS();
    const Params& P = *F.P; unsigned char* ws = F.ws;
    constexpr int HCS = 132, WCS = 48;
    LAS float* HC = (LAS float*)F.lds;
    LAS float* WC = HC + 2 * 64 * HCS;
    LAS float* RSTD = WC + 2 * 128 * WCS;
    LAS float* LOGIT = RSTD + 64;
    LAS int* pe = (LAS int*)(LOGIT + 64 * 33);
    int* PAIR_E = (int*)(ws + WS_PAIR); int* PAIR_RANK = PAIR_E + 65536; float* PAIR_W = (float*)(PAIR_E + 131072);
    const float* gffn = P.in[I_GFFN]; const float* wr_ = P.in[I_WR]; const float* br_ = P.in[I_BR];
    const int r0 = F.vcu * 64;
    if (I_.tid < 64) { const f32x4* sp = (const f32x4*)((const float*)(ws + WS_SSP) + (size_t)(r0 + I_.tid) * 16); const f32x4 a = sp[0], b = sp[1], c = sp[2], d = sp[3];
        const float ss = (((a[0] + a[1]) + (a[2] + a[3])) + ((b[0] + b[1]) + (b[2] + b[3]))) + (((c[0] + c[1]) + (c[2] + c[3])) + ((d[0] + d[1]) + (d[2] + d[3])));
        RSTD[I_.tid] = 1.0f / sqrtf(ss * (1.f / DM) + EPS); }
    __syncthreads();
    const int eg = I_.wave & 1, rgp = I_.wave >> 1, l15 = I_.lane & 15, l4 = I_.lane >> 4;
    const int srow = I_.tid >> 5, sc4 = I_.tid & 31;
    const int wrow = I_.tid >> 3, wc4 = I_.tid & 7;
    f32x4 stg[4], wst[2];
#define P8_LOAD(kc) do { _Pragma("unroll") for (int i = 0; i < 4; ++i) stg[i] = *(const f32x4*)(P.out + (size_t)(r0 + srow + 16 * i) * DM + (kc) * 128 + 4 * sc4); \
        _Pragma("unroll") for (int i = 0; i < 2; ++i) wst[i] = *(const f32x4*)(wr_ + (size_t)((kc) * 128 + wrow + 64 * i) * 32 + 4 * wc4); } while (0)
#define P8_STORE(kc, buf) do { const f32x4 g4 = *(const f32x4*)(gffn + (kc) * 128 + 4 * sc4); _Pragma("unroll") for (int i = 0; i < 4; ++i) { const float rs = RSTD[srow + 16 * i]; const f32x4 y = stg[i] * rs * g4; \
        *(LAS f32x4*)(HC + ((buf) * 64 + srow + 16 * i) * HCS + 4 * sc4) = y; *(unsigned*)(ws + WS_HNF8 + (size_t)(r0 + srow + 16 * i) * DM + (kc) * 128 + 4 * sc4) = pack4_fp8(y.x, y.y, y.z, y.w); } \
        _Pragma("unroll") for (int i = 0; i < 2; ++i) *(LAS f32x4*)(WC + ((buf) * 128 + wrow + 64 * i) * WCS + 4 * wc4) = wst[i]; } while (0)
    P8_LOAD(0); P8_STORE(0, 0);
    __syncthreads();
    f32x4 acc = {0.f, 0.f, 0.f, 0.f};
#pragma unroll 1
    for (int kc = 0; kc < 8; ++kc) { const int buf = kc & 1;
        if (kc + 1 < 8) P8_LOAD(kc + 1);
        const LAS float* wp = WC + (buf * 128 + l4) * WCS + eg * 16 + l15;
        const LAS float* hp = HC + (buf * 64 + rgp * 16 + l15) * HCS + l4;
#pragma unroll
        for (int kk = 0; kk < 32; ++kk) acc = __builtin_amdgcn_mfma_f32_16x16x4f32(wp[4 * kk * WCS], hp[4 * kk], acc, 0, 0, 0);
        if (kc + 1 < 8) P8_STORE(kc + 1, buf ^ 1);
        __syncthreads(); }
#undef P8_LOAD
#undef P8_STORE
#pragma unroll
    for (int i = 0; i < 4; ++i) { const int e = eg * 16 + 4 * l4 + i; LOGIT[(rgp * 16 + l15) * 33 + e] = acc[i] + br_[e]; }
    __syncthreads();
    if (I_.tid < 64) { const int rr = I_.tid, m = r0 + rr;
        float lg[32];
#pragma unroll
        for (int e = 0; e < 32; ++e) lg[e] = LOGIT[rr * 33 + e];
        int te[4]; float tv[4]; unsigned used = 0u;
#pragma unroll
        for (int k = 0; k < 4; ++k) { float best = -INFINITY; int bi = 0;
#pragma unroll
            for (int e = 0; e < 32; ++e) { const bool ok = !((used >> e) & 1u) && (lg[e] > best); best = ok ? lg[e] : best; bi = ok ? e : bi; }
            used |= 1u << bi; te[k] = bi; tv[k] = best; }
        const float e0 = 1.0f, e1 = __expf(tv[1] - tv[0]), e2 = __expf(tv[2] - tv[0]), e3 = __expf(tv[3] - tv[0]); const float inv = 1.0f / (e0 + e1 + e2 + e3);
        *(i32x4*)(PAIR_E + m * 4) = (i32x4){te[0], te[1], te[2], te[3]};
        *(f32x4*)(PAIR_W + m * 4) = (f32x4){e0 * inv, e1 * inv, e2 * inv, e3 * inv};
        *(LAS i32x4*)(pe + rr * 4) = (i32x4){te[0], te[1], te[2], te[3]}; }
    __syncthreads();
    if (I_.tid < 256) { const int e = pe[I_.tid]; int rank = 0;
#pragma unroll 16
        for (int j4 = 0; j4 < 64; ++j4) { const i32x4 v = *(const LAS i32x4*)(pe + 4 * j4); const int j = 4 * j4;
            rank += ((j < I_.tid) && v.x == e) + ((j + 1 < I_.tid) && v.y == e) + ((j + 2 < I_.tid) && v.z == e) + ((j + 3 < I_.tid) && v.w == e); }
        PAIR_RANK[r0 * 4 + I_.tid] = rank; }
    else if (I_.tid < 288) { const int e = I_.tid - 256; int c = 0;
#pragma unroll 16
        for (int j4 = 0; j4 < 64; ++j4) { const i32x4 v = *(const LAS i32x4*)(pe + 4 * j4); c += (v.x == e) + (v.y == e) + (v.z == e) + (v.w == e); }
        ((int*)(ws + WS_HIST))[F.vcu * 32 + e] = c; }
    __syncthreads();
}

__device__ __forceinline__ int moe_layout(Frame& F) {
    PHASE_IDS();
    LAS int* ctl = (LAS int*)(F.lds + LDS_CTL);
    LAS int* part = ctl + 512;
    const int* HIST = (const int*)(F.ws + WS_HIST);
    __syncthreads();
    { const int e = I_.tid & 31, pt = I_.tid >> 5; int tot = 0, before = 0; int c[16];
#pragma unroll
        for (int i = 0; i < 16; ++i) c[i] = HIST[(pt * 16 + i) * 32 + e];
#pragma unroll
        for (int i = 0; i < 16; ++i) { tot += c[i]; before += (pt * 16 + i < F.vcu) ? c[i] : 0; }
        part[pt * 64 + e] = tot; part[pt * 64 + 32 + e] = before; }
    __syncthreads();
    if (I_.tid < 32) { int tot = 0, before = 0;
#pragma unroll
        for (int pt = 0; pt < 16; ++pt) { tot += part[pt * 64 + I_.tid]; before += part[pt * 64 + 32 + I_.tid]; }
        ctl[I_.tid] = tot; ctl[65 + I_.tid] = before; }
    __syncthreads();
    if (I_.tid == 0) { int row = 0, mt = 0;
        for (int e = 0; e < 32; ++e) { ctl[32 + e] = row; ctl[65 + e] += row; const int nt_ = (ctl[e] + 255) >> 8;
            for (int t = 0; t < nt_; ++t) ctl[128 + mt + t] = e;
            mt += nt_; row += nt_ * 256; }
        ctl[64] = row; ctl[100] = mt; }
    __syncthreads();
    return ctl[100];
}

__device__ __forceinline__ void phase9(Frame& F) {
    PHASE_IDS();
    unsigned char* ws = F.ws;
    moe_layout(F);
    LAS int* ctl = (LAS int*)(F.lds + LDS_CTL);
    const int* PAIR_E = (const int*)(ws + WS_PAIR); const int* PAIR_RANK = PAIR_E + 65536; int* ROWDEST = (int*)(ws + WS_PAIR) + 196608; int* TOK = (int*)(ws + WS_TOK);
    const int rows_per_blk = NTOK / F.G;
    if (I_.tid < rows_per_blk * 4) { const int gp = F.vcu * rows_per_blk * 4 + I_.tid;
        const int e = PAIR_E[gp], rk = PAIR_RANK[gp]; const int dest = ctl[65 + e] + rk;
        ROWDEST[gp] = dest; TOK[dest] = gp >> 2; }
    if (F.vcu < 32) { const int e = F.vcu; const int lo = ctl[32 + e] + ctl[e], hi = (e == 31) ? ctl[64] : ctl[33 + e];
        for (int r = lo + I_.tid; r < hi; r += NTHREADS) TOK[r] = 0; }
}

__device__ __forceinline__ void stage_tok(Frame& F, int nmt, int ntn) {
    PHASE_IDS();
    const int* TOK = (const int*)(F.ws + WS_TOK); LAS unsigned short* tokl = (LAS unsigned short*)(F.lds + LDS_TOKL);
    for (int i = 0; i < 10; ++i) { const int j = (i * F.G + (int)blockIdx.x) >> 3; const int mt = (j / ntn) * 8 + ((int)blockIdx.x & 7); if (mt >= nmt) break;
        if (I_.tid < 256) tokl[i * 256 + I_.tid] = (unsigned short)TOK[mt * 256 + I_.tid]; }
    __syncthreads();
}

__device__ __forceinline__ void phase12(Frame& F) {
    PHASE_IDS();
    const Params& P = *F.P; unsigned char* ws = F.ws;
    const int gw = F.vcu * NWAVES + I_.wave, NGW = F.G * NWAVES;
    const float* PAIR_W = (const float*)(ws + WS_PAIR) + 131072; const int* ROWDEST = (const int*)(ws + WS_PAIR) + 196608;
    const bf16_t* YP = (const bf16_t*)(ws + WS_XG);
    const f32x4* gp = (const f32x4*)P.in[I_GPLE] + I_.lane; f32x4 gv[4];
#pragma unroll
    for (int j = 0; j < 4; ++j) gv[j] = gp[64 * j];
    for (int m0 = gw; m0 < NTOK; m0 += 2 * NGW) {
        int mm[2]; mm[0] = m0; mm[1] = (m0 + NGW < NTOK) ? m0 + NGW : m0;
        f32x4 wv[2]; i32x4 dv[2];
#pragma unroll
        for (int q = 0; q < 2; ++q) { wv[q] = *(const f32x4*)(PAIR_W + mm[q] * 4); dv[q] = *(const i32x4*)(ROWDEST + mm[q] * 4); }
        f32x4 v[2][4]; u32x2 y[2][4][4];
#pragma unroll
        for (int q = 0; q < 2; ++q) { const f32x4* xr = (const f32x4*)(P.out + (size_t)mm[q] * DM) + I_.lane;
#pragma unroll
            for (int j = 0; j < 4; ++j) v[q][j] = xr[64 * j];
#pragma unroll
            for (int k = 0; k < 4; ++k) { const u32x2* yr = (const u32x2*)(YP + (size_t)dv[q][k] * DM) + I_.lane;
#pragma unroll
                for (int j = 0; j < 4; ++j) y[q][k][j] = yr[64 * j]; } }
#pragma unroll
        for (int q = 0; q < 2; ++q) { if (q == 1 && mm[1] == mm[0]) break;
            float s = 0.f; f32x4* xw = (f32x4*)(P.out + (size_t)mm[q] * DM) + I_.lane;
#pragma unroll
            for (int j = 0; j < 4; ++j) {
#pragma unroll
                for (int k = 0; k < 4; ++k) { const u32x2 yy = y[q][k][j]; v[q][j] += (f32x4){bflo(yy.x), bfhi(yy.x), bflo(yy.y), bfhi(yy.y)} * wv[q][k]; }
                xw[64 * j] = v[q][j]; s += (v[q][j].x * v[q][j].x + v[q][j].y * v[q][j].y) + (v[q][j].z * v[q][j].z + v[q][j].w * v[q][j].w); }
            const float rstd = 1.0f / sqrtf(wave_sum(s) * (1.f / DM) + EPS);
            unsigned* o4 = (unsigned*)(ws + WS_HNF8 + (size_t)mm[q] * DM) + I_.lane;
#pragma unroll
            for (int j = 0; j < 4; ++j) { const f32x4 yo = v[q][j] * rstd * gv[j]; o4[64 * j] = pack4_fp8(yo.x, yo.y, yo.z, yo.w); } }
    }
}

__global__ void __launch_bounds__(NTHREADS, 2) fwd(Params prm) {
    extern __shared__ __attribute__((aligned(16))) unsigned char lds_raw[];
    Frame F;
    F.lds = (LAS unsigned char*)lds_raw;
    F.wave = __builtin_amdgcn_readfirstlane((int)threadIdx.x >> 6);
    if (threadIdx.x < 2) ((volatile LAS unsigned*)(F.lds + LDS_BARST))[threadIdx.x] = 0u;
    const XcdBarrier bar = xcd_barrier_post((unsigned*)(prm.ws + WS_BAR), (volatile LAS unsigned*)(F.lds + LDS_BARST), F.wave);
    if (prm.ph_lo < 0) cg::this_grid().sync();
    __syncthreads();
    F.G = gridDim.x; { const int bx = blockIdx.x; F.vcu = (F.G % 8 == 0) ? (bx % 8) * (F.G / 8) + bx / 8 : bx; }
    F.P = &prm; F.ws = prm.ws;
    unsigned char* ws = prm.ws;
    const int lo = prm.ph_lo, hi = prm.ph_hi;
#ifndef PH_MASK
#define PH_MASK 0xffffu
#endif
#ifndef REP_MASK
#define REP_MASK 0u
#endif
#define IN(k) (((PH_MASK >> (k)) & 1u) && lo <= (k) && (k) < hi)
#define REPS(k) for (int rep_ = 0; rep_ < (((REP_MASK >> (k)) & 1u) ? 2 : 1); ++rep_, (((REP_MASK >> (k)) & 1u) && rep_ < 2 ? xcd_barrier(bar) : (void)0))
#define SEAM(k) do { __builtin_amdgcn_sched_barrier(0); asm volatile("" ::: "memory"); if (IN(k) && IN((k) + 1)) xcd_barrier(bar); STAMP((k) + 1); __builtin_amdgcn_sched_barrier(0); asm volatile("" ::: "memory"); } while (0)
    using namespace pg8;
    STAMP(0);
    if (IN(0)) REPS(0) phase0(F);
    SEAM(0);
    if (IN(1)) REPS(1) {
        { Gemm g{(const bf16_t*)(ws + WS_HN), (const bf16_t*)(ws + WS_WIN), DM, DM, DM}; StaticOrder S; S.init(NTOK, 2048, F.G, (int)blockIdx.x);
          const float* cosA_ = (const float*)(ws + WS_ROPE);
          EpiProj E{(bf16_t*)(ws + WS_PROJ), (bf16_t*)(ws + WS_QA2), (bf16_t*)(ws + WS_KA2), (float*)(ws + WS_KMEAN), (bf16_t*)(ws + WS_CQN), (bf16_t*)(ws + WS_CKVN),
                    prm.in[I_MQN], prm.in[I_MKN], prm.in[I_QLATN], prm.in[I_KVLATN], cosA_, cosA_ + 65536, (LAS float*)(F.lds + LDS_TOKL), (float*)(ws + WS_KPESS)};
          gemm_phase(F.lds, F.wave, g, S, E); }
        __builtin_amdgcn_sched_barrier(0); asm volatile("" ::: "memory");
        { Gemm g{(const bf16_t*)(ws + WS_HNF8), (const bf16_t*)(ws + WS_WINF8), 512, 512, 512}; StaticOrder S; S.init(NTOK, 2048, F.G, (int)blockIdx.x);
          EpiStore E{(bf16_t*)(ws + WS_PROJ) + PC_GA, DINP, nullptr, 0, 0}; gemm_phase<EpiStore, StaticOrder, false, true>(F.lds, F.wave, g, S, E); } }
    SEAM(1);
    if (IN(3)) REPS(3) {
        const float* cosB_ = (const float*)(ws + WS_ROPE) + 131072;
        { Gemm g{(const bf16_t*)(ws + WS_CQN), (const bf16_t*)(ws + WS_WUQ), 256, 256, 256}; StaticOrder S; S.init(NTOK, 1024, F.G, (int)blockIdx.x);
          EpiQB E{(bf16_t*)(ws + WS_QB), prm.in[I_MLAQN], cosB_, cosB_ + 32768, (LAS float*)(F.lds + LDS_CTL)}; gemm_phase(F.lds, F.wave, g, S, E); }
        __builtin_amdgcn_sched_barrier(0); asm volatile("" ::: "memory");
        { Gemm g{(const bf16_t*)(ws + WS_CKVN), (const bf16_t*)(ws + WS_WUKV), 128, 128, 128}; StaticOrder S; S.init(NTOK, 1024, F.G, (int)blockIdx.x);
          EpiKV E{(bf16_t*)(ws + WS_KB2), (bf16_t*)(ws + WS_KV), (const bf16_t*)(ws + WS_PROJ), (const float*)(ws + WS_KPESS), prm.in[I_MLAKN], cosB_, cosB_ + 32768, (LAS float*)(F.lds + LDS_CTL)};
          gemm_phase(F.lds, F.wave, g, S, E); } }
    SEAM(3);
    if (IN(5)) REPS(5) phase5(F);
    SEAM(5);
    if (IN(6)) REPS(6) { Gemm g{(const bf16_t*)(ws + WS_Y), (const bf16_t*)(ws + WS_WA), DM, 512, 512}; StaticOrder S; S.init(NTOK, DM, F.G, (int)blockIdx.x);
        EpiGate<false> E{(bf16_t*)(ws + WS_MERGED), (const bf16_t*)(ws + WS_PROJ) + PC_GA, DINP, nullptr}; gemm_phase(F.lds, F.wave, g, S, E); }
    __builtin_amdgcn_sched_barrier(0); asm volatile("s_waitcnt vmcnt(0)" ::: "memory"); __syncthreads();
    if (IN(7)) REPS(7) { Gemm g{(const bf16_t*)(ws + WS_Y) + 512, (const bf16_t*)(ws + WS_WB), DM, 512, 512}; StaticOrder S; S.init(NTOK, DM, F.G, (int)blockIdx.x);
        EpiGate<true> E{(bf16_t*)(ws + WS_MERGED), (const bf16_t*)(ws + WS_PROJ) + PC_GB, DINP, ws + WS_KA2  }; gemm_phase(F.lds, F.wave, g, S, E); }
    SEAM(7);
    if (IN(8)) REPS(8) { Gemm g{(const bf16_t*)(ws + WS_KA2), (const bf16_t*)(ws + WS_WO), 512, 512, 512}; StaticOrder S; S.init(NTOK, DM, F.G, (int)blockIdx.x);
        EpiResF32 E{prm.in[I_X], prm.out, (float*)(ws + WS_SSP)}; gemm_phase<EpiResF32, StaticOrder, false, true>(F.lds, F.wave, g, S, E); }
    SEAM(8);
    if (IN(9)) REPS(9) phase8(F);
    SEAM(9);
    if (IN(10)) REPS(10) phase9(F);
    SEAM(10);
    if (IN(11)) REPS(11) { const int nmt = ((const LAS int*)(F.lds + LDS_CTL))[100]; stage_tok(F, nmt, 8);
        Gemm g{(const bf16_t*)(ws + WS_HNF8), (const bf16_t*)(ws + WS_W1), 512, 512, 512}; MoeOrder S{(const LAS int*)(F.lds + LDS_CTL) + 128, nmt, 8, F.G, (int)blockIdx.x};
        EpiSwiglu E{ws + WS_ACT, prm.in[I_BGU]}; gemm_phase<EpiSwiglu, MoeOrder, true, true>(F.lds, F.wave, g, S, E, (const LAS unsigned short*)(F.lds + LDS_TOKL)); }
    SEAM(11);
    if (IN(12)) REPS(12) { const int nmt = ((const LAS int*)(F.lds + LDS_CTL))[100];
        Gemm g{(const bf16_t*)(ws + WS_ACT), (const bf16_t*)(ws + WS_W2), 512, 512, 512}; MoeOrder S{(const LAS int*)(F.lds + LDS_CTL) + 128, nmt, 4, F.G, (int)blockIdx.x};
        EpiStore E{(bf16_t*)(ws + WS_XG), DM, prm.in[I_BD], 1024, 1 << 30}; gemm_phase<EpiStore, MoeOrder, false, true>(F.lds, F.wave, g, S, E); }
    SEAM(12);
    if (IN(13)) REPS(13) phase12(F);
    SEAM(13);
    if (IN(14)) REPS(14) { Gemm g{(const bf16_t*)(ws + WS_PB), (const bf16_t*)(ws + WS_WPP), 256, 256, 256}; StaticOrder S; S.init(NTOK, DM, F.G, (int)blockIdx.x);
        EpiStore E{(bf16_t*)(ws + WS_PP), DM, nullptr, 0, 1 << 30}; gemm_phase(F.lds, F.wave, g, S, E); }
    __builtin_amdgcn_sched_barrier(0); asm volatile("s_waitcnt vmcnt(0)" ::: "memory"); __syncthreads();
    if (IN(15)) REPS(15) { Gemm g{(const bf16_t*)(ws + WS_HNF8), (const bf16_t*)(ws + WS_WPG), 512, 512, 512}; StaticOrder S; S.init(NTOK, DM, F.G, (int)blockIdx.x);
        EpiFinal E{prm.out, (const bf16_t*)(ws + WS_PP)}; gemm_phase<EpiFinal, StaticOrder, false, true>(F.lds, F.wave, g, S, E); }
#ifdef TPROBE_A
    STAMP(16);
    xcd_barrier(bar);
    if (blockIdx.x == 0 && F.wave == 0 && lane_id() == 0) {
        volatile unsigned long long* ts = (volatile unsigned long long*)(ws + WS_ERR);
        const unsigned long long da = ts[TPROBE_A1] - ts[TPROBE_A], db = ts[TPROBE_B1] - ts[TPROBE_B];
        asm volatile("s_waitcnt vmcnt(0)" ::: "memory");
        prm.out[0] += (float)db * (0.01f / 4.0f);
        const unsigned long long t0 = __builtin_amdgcn_s_memrealtime();
        while (__builtin_amdgcn_s_memrealtime() - t0 < 4ull * da) __builtin_amdgcn_s_sleep(4);
    }
#endif
#undef IN
#undef SEAM
}

extern "C" void kernel_launch(void* const* d_in, const int* in_sizes, int n_in, void* d_out, int out_size, void* d_ws, size_t ws_size, hipStream_t stream) {
    static int grid = 0;
    if (grid == 0) {
        int dev = 0, cus = 0, per_cu = 0;
        (void)hipGetDevice(&dev);
        (void)hipDeviceGetAttribute(&cus, hipDeviceAttributeMultiprocessorCount, dev);
        (void)hipFuncSetAttribute((const void*)fwd, hipFuncAttributeMaxDynamicSharedMemorySize, LDS_BYTES);
        (void)hipOccupancyMaxActiveBlocksPerMultiprocessor(&per_cu, (const void*)fwd, NTHREADS, LDS_BYTES);
        fprintf(stderr, "cus %d per_cu %d ws %zu n_in %d\n", cus, per_cu, ws_size, n_in);
        grid = (per_cu >= 1) ? cus : -1;
        if (grid != 256 || n_in != 25 || ws_size < WS_END || out_size != NTOK * DM) { fprintf(stderr, "kernel_launch: unsupported configuration\n"); grid = -1; }
    }
    if (grid < 0) return;
    (void)hipMemsetAsync((char*)d_ws + WS_BAR, 0, WS_BAR_BYTES, stream);
    Params a{};
    for (int i = 0; i < 25; ++i) a.in[i] = (const float*)d_in[i];
    a.out = (float*)d_out; a.ws = (unsigned char*)d_ws;
#ifndef MULTI_LAUNCH
    a.ph_lo = 0; a.ph_hi = NPHASE;
    void* args[] = {&a};
    hipError_t e = hipLaunchCooperativeKernel((const void*)fwd, dim3(grid), dim3(NTHREADS), args, LDS_BYTES, stream);
    if (e != hipSuccess) fprintf(stderr, "cooperative launch failed: %s\n", hipGetErrorString(e));
#else
    for (int k = 0; k < NPHASE; ++k) { a.ph_lo = k; a.ph_hi = k + 1; void* args[] = {&a};
        hipError_t e = hipLaunchCooperativeKernel((const void*)fwd, dim3(grid), dim3(NTHREADS), args, LDS_BYTES, stream);
        if (e != hipSuccess) fprintf(stderr, "launch %d failed: %s\n", k, hipGetErrorString(e)); }
#endif
}
```

```cpp
#include <hip/hip_runtime.h>
#include <hip/hip_cooperative_groups.h>
#include <cstdio>
#include <cstdint>
namespace cg = cooperative_groups;

#define LAS __attribute__((address_space(3)))
typedef unsigned short bf16_t;
typedef short bf16x8 __attribute__((ext_vector_type(8)));
typedef short s16x4 __attribute__((ext_vector_type(4)));
typedef float f32x4 __attribute__((ext_vector_type(4)));
typedef float f32x2 __attribute__((ext_vector_type(2)));
typedef float f32x16 __attribute__((ext_vector_type(16)));
typedef unsigned u32x4 __attribute__((ext_vector_type(4)));
typedef unsigned u32x2 __attribute__((ext_vector_type(2)));
typedef int i32x4 __attribute__((ext_vector_type(4)));
typedef int i32x8 __attribute__((ext_vector_type(8)));
typedef __bf16 bf16x2_t __attribute__((ext_vector_type(2)));

constexpr int NB = 8, SEQ = 2048, NTOK = NB * SEQ, DM = 1024;
constexpr int DIN = 4000, DINP = 4096;
constexpr int NEXP = 32, TOPK = 4, DEXP = 1024;
constexpr int NTHREADS = 512, NWAVES = 8;
constexpr float EPS = 1e-6f;
constexpr float LOG2E = 1.4426950408889634f;
constexpr float C2A = 0.125f * LOG2E;
constexpr float C2B = 0.10206207261596575f * LOG2E;
constexpr int PC_QA = 0, PC_KA = 512, PC_VA = 1024, PC_CQ = 1536, PC_CKV = 1792, PC_KPE = 1920, PC_GA = 2048, PC_GB = 3072;

constexpr size_t MiB = 1u << 20;
constexpr size_t WS_HIST = 0;
constexpr size_t WS_ERR = 64 * 1024;
constexpr size_t WS_BAR = 128 * 1024;
constexpr size_t WS_BAR_BYTES = 16 * 1024;
constexpr size_t WS_KPESS = 576 * 1024;
constexpr size_t WS_TOK = 256 * 1024;
constexpr size_t WS_ROPE = 1 * MiB;
constexpr size_t WS_KMEAN = 2 * MiB;
constexpr size_t WS_SSP = 11 * MiB;
constexpr size_t WS_PAIR = 3 * MiB;
constexpr size_t WS_WUQ = 4 * MiB, WS_WUKV = 4 * MiB + 512 * 1024, WS_WPP = 5 * MiB, WS_WA = 6 * MiB, WS_WB = 7 * MiB, WS_WO = 8 * MiB, WS_WPG = 10 * MiB, WS_WIN = 12 * MiB;
constexpr size_t WS_W1 = 20 * MiB, WS_W2 = 148 * MiB;
constexpr size_t WS_WINF8 = 16 * MiB;
constexpr size_t WS_HNF8 = 84 * MiB;
constexpr size_t WS_HN = 212 * MiB, WS_PB = 244 * MiB;
constexpr size_t WS_CQN = 252 * MiB, WS_CKVN = 260 * MiB, WS_QB = 264 * MiB, WS_KV = 288 * MiB, WS_KB2 = 320 * MiB, WS_Y = 344 * MiB, WS_MERGED = 376 * MiB;
constexpr size_t WS_ACT = 252 * MiB;
constexpr size_t WS_PP = 400 * MiB;
constexpr size_t WS_KA2 = 432 * MiB;
constexpr size_t WS_PROJ = 448 * MiB;
constexpr size_t WS_QA2 = 576 * MiB;
constexpr size_t WS_XG = 448 * MiB;
constexpr size_t WS_END = 592 * MiB;
constexpr int MAXROWS = 73728, MAXMT = 288;

constexpr int RING_BYTES = 131072;
constexpr int LDS_CTL = RING_BYTES;
constexpr int LDS_TOKL = RING_BYTES + 8192 + 256;
constexpr int LDS_BARST = RING_BYTES + 8192;
constexpr int LDS_BYTES = 147456;

__device__ __forceinline__ unsigned cvt_pk_bf16(float lo, float hi) { f32x2 v = {lo, hi}; bf16x2_t b = __builtin_convertvector(v, bf16x2_t); return __builtin_bit_cast(unsigned, b); }
__device__ __forceinline__ unsigned pack4_fp8(float a, float b, float c, float d) { int w = 0; w = __builtin_amdgcn_cvt_pk_fp8_f32(a, b, w, false); w = __builtin_amdgcn_cvt_pk_fp8_f32(c, d, w, true); return (unsigned)w; }
__device__ __forceinline__ float bf2f(unsigned short b) { return __uint_as_float(((unsigned)b) << 16); }
__device__ __forceinline__ float bflo(unsigned w) { return __uint_as_float(w << 16); }
__device__ __forceinline__ float bfhi(unsigned w) { return __uint_as_float(w & 0xffff0000u); }
__device__ __forceinline__ float sigmoidf_(float x) { return __builtin_amdgcn_rcpf(1.0f + __builtin_amdgcn_exp2f(-x * LOG2E)); }
__device__ __forceinline__ int lane_id() { return (int)__builtin_amdgcn_mbcnt_hi(~0u, __builtin_amdgcn_mbcnt_lo(~0u, 0u)); }
__device__ __forceinline__ float wave_sum(float v) {
#pragma unroll
    for (int o = 1; o < 64; o <<= 1) v += __shfl_xor(v, o);
    return v;
}

namespace pg8 {
constexpr int BM = 256, BK = 64, HALF = 128, HTB = HALF * BK * 2, STAGE_BYTES = 8 * HTB, NXCD = 8, WGM = 8;
__host__ __device__ __forceinline__ int lds_byte(int r, int c) { const int st = (r >> 4) * 2 + (c >> 5), rr = r & 15, cc = c & 31, ob = rr * 64 + cc * 2; return st * 1024 + (ob ^ (((ob >> 9) & 1) << 5)); }
__host__ __device__ __forceinline__ void stage_rc(int b, int& R, int& C) { const int st = b / 1024, sb = b % 1024, swz = sb ^ (((sb >> 9) & 1) << 5); R = (st >> 1) * 16 + swz / 64; C = (st & 1) * 32 + (swz % 64) / 2; }
__host__ __device__ __forceinline__ int perm32(int rho) { const int n = rho >> 4, i = rho & 15; return 8 * (i >> 2) + 4 * n + (i & 3); }

struct Unit { int pm, pn, pb, e; };
struct Gemm { const bf16_t* A; const bf16_t* Bt; int lda, ldb, K; };

struct StaticOrder {
    int nM, nN, nwg, G, c;
    __device__ void init(int M, int N, int G_, int c_) { nM = M / BM; nN = N / BM; nwg = nM * nN; G = G_; c = c_; }
    __device__ bool next(int i, Unit& u) const {
        const long L = (long)i * G + c; if (L >= nwg) return false;
        int wgid = (int)L; { const int q = nwg / NXCD, r = nwg % NXCD, xcd = wgid % NXCD, off = wgid / NXCD; wgid = (xcd < r ? xcd * (q + 1) : r * (q + 1) + (xcd - r) * q) + off; }
        const int nig = WGM * nN, gid = wgid / nig, fm = gid * WGM, gsz = (nM - fm) < WGM ? (nM - fm) : WGM;
        u.pm = fm + ((wgid % nig) % gsz); u.pn = (wgid % nig) / gsz; u.pb = u.pn; u.e = 0; return true;
    }
};
struct MoeOrder {
    const LAS int* tile_e; int nmt, ntn, G, c;
    __device__ bool next(int i, Unit& u) const {
        const int j = (i * G + c) >> 3; const int mt = (j / ntn) * 8 + (c & 7), pn = j % ntn; if (mt >= nmt) return false;
        const int e = __builtin_amdgcn_readfirstlane(tile_e[mt]);
        u.pm = mt; u.pn = pn; u.pb = e * ntn + pn; u.e = e; return true;
    }
};

template <class Epi, class Sched, bool GATHER = false, bool FP8 = false>
__device__ __forceinline__ void gemm_phase(LAS unsigned char* lds, int wave, const Gemm g, const Sched& S, const Epi& E, const LAS unsigned short* tokl = nullptr) {
    constexpr bool ALIGN_EPI = true;
    int lane = lane_id(); asm volatile("" : "+v"(lane));
    const int wid = wave, tid = wid * 64 + lane, wr = wid >> 2, wc = wid & 3, fr = lane & 15, fq = lane >> 4;
    int K = g.K; asm volatile("" : "+s"(K));
    const int nt = K / BK;
    unsigned voffA[2], voffB[2]; int gR[2]; unsigned gC[2];
#pragma unroll
    for (int i = 0; i < 2; ++i) { int R, C; stage_rc(tid * 16 + i * 8192, R, C); const int Rb = (R & ~31) + perm32(R & 31);
        voffA[i] = (unsigned)(R * g.lda + C) * 2u; voffB[i] = (unsigned)(Rb * g.ldb + C) * 2u; gR[i] = R; gC[i] = (unsigned)C * 2u; }
    unsigned goff[2][2], noff[2][2];
#define PG8_GOFF(dst, ui_) do { _Pragma("unroll") for (int h_ = 0; h_ < 2; ++h_) _Pragma("unroll") for (int i_ = 0; i_ < 2; ++i_) \
        dst[h_][i_] = (unsigned)tokl[(ui_) * 256 + h_ * HALF + gR[i_]] * (unsigned)(g.lda * 2) + gC[i_]; } while (0)
    const size_t kstep = (size_t)(BK * 2);
    const size_t hstepA = (size_t)HALF * g.lda * 2, hstepB = (size_t)HALF * g.ldb * 2;
    const size_t tstepA = 2 * hstepA, tstepB = 2 * hstepB;
    const unsigned ldsw = (unsigned)wid * 1024u;
    const int aoff = lds_byte(wr * 64 + fr, fq * 8), boff = lds_byte(wc * 32 + fr, fq * 8);
#define PG8_SA(b, h) (((b) * 2 + (h)) * HTB)
#define PG8_SB(b, h) ((4 + (b) * 2 + (h)) * HTB)
#define PG8_STAGE(bufoff, gbase, voff) do { _Pragma("unroll") for (int _i = 0; _i < 2; ++_i) \
        __builtin_amdgcn_global_load_lds((const unsigned*)((const char*)(gbase) + (voff)[_i]), (LAS unsigned*)(lds + (bufoff) + ldsw + _i * 8192), 16, 0, 0); } while (0)
#define PG8_STAGE_A(bufoff, ptr_ng, k_g, off_g) do { if constexpr (GATHER) { const char* gb_ = (const char*)g.A + (size_t)(k_g) * kstep; PG8_STAGE(bufoff, gb_, off_g); } else { PG8_STAGE(bufoff, ptr_ng, voffA); } } while (0)
#define PG8_LDA(dst, b, h) do { if constexpr (FP8) { _Pragma("unroll") for (int m = 0; m < 4; ++m) { const i32x4 lo_ = *(const LAS i32x4*)(lds + PG8_SA(b, h) + aoff + m * 2048), hi_ = *(const LAS i32x4*)(lds + PG8_SA(b, h) + aoff + m * 2048 + 1024); dst##8[m] = __builtin_shufflevector(lo_, hi_, 0, 1, 2, 3, 4, 5, 6, 7); } } \
        else { _Pragma("unroll") for (int m = 0; m < 4; ++m) _Pragma("unroll") for (int k = 0; k < 2; ++k) dst[m][k] = *(const LAS bf16x8*)(lds + PG8_SA(b, h) + aoff + m * 2048 + k * 1024); } } while (0)
#define PG8_LDB(dst, b, h) do { if constexpr (FP8) { _Pragma("unroll") for (int n = 0; n < 2; ++n) { const i32x4 lo_ = *(const LAS i32x4*)(lds + PG8_SB(b, h) + boff + n * 2048), hi_ = *(const LAS i32x4*)(lds + PG8_SB(b, h) + boff + n * 2048 + 1024); dst##8[n] = __builtin_shufflevector(lo_, hi_, 0, 1, 2, 3, 4, 5, 6, 7); } } \
        else { _Pragma("unroll") for (int n = 0; n < 2; ++n) _Pragma("unroll") for (int k = 0; k < 2; ++k) dst[n][k] = *(const LAS bf16x8*)(lds + PG8_SB(b, h) + boff + n * 2048 + k * 1024); } } while (0)
#define PG8_CAT8(x, y) __builtin_shufflevector(__builtin_bit_cast(i32x4, x), __builtin_bit_cast(i32x4, y), 0, 1, 2, 3, 4, 5, 6, 7)
#define PG8_MMA(ai, bj, At, Bt) do { __builtin_amdgcn_s_setprio(1); if constexpr (FP8) { _Pragma("unroll") for (int m = 0; m < 4; ++m) _Pragma("unroll") for (int n = 0; n < 2; ++n) \
        asm volatile("v_mfma_scale_f32_16x16x128_f8f6f4 %0, %1, %2, %0, %3, %3 op_sel_hi:[0,0,0]" : "+v"(acc[ai][bj][m][n]) : "v"(Bt##8[n]), "v"(At##8[m]), "v"(sc8)); } \
        else { _Pragma("unroll") for (int m = 0; m < 4; ++m) _Pragma("unroll") for (int n = 0; n < 2; ++n) _Pragma("unroll") for (int k = 0; k < 2; ++k) \
        acc[ai][bj][m][n] = __builtin_amdgcn_mfma_f32_16x16x32_bf16(Bt[n][k], At[m][k], acc[ai][bj][m][n], 0, 0, 0); } __builtin_amdgcn_s_setprio(0); } while (0)
#define PG8_WAIT_V(n) asm volatile("s_waitcnt vmcnt(" #n ")" ::: "memory")
#define PG8_WAIT_L(n) asm volatile("s_waitcnt lgkmcnt(" #n ")" ::: "memory")
#define PG8_BAR __builtin_amdgcn_s_barrier()
#define PG8_SCHED __builtin_amdgcn_sched_barrier(0)
    Unit cur, nxt; int ui = 0;
    if (!S.next(0, cur)) return;
    f32x4 acc[2][2][4][2];
#pragma unroll
    for (int a = 0; a < 2; ++a)
#pragma unroll
        for (int b = 0; b < 2; ++b)
#pragma unroll
            for (int m = 0; m < 4; ++m)
#pragma unroll
                for (int n = 0; n < 2; ++n) acc[a][b][m][n] = (f32x4){0.f, 0.f, 0.f, 0.f};
    const int sc8 = 0x7c7c7c7c;
    bf16x8 At[4][2], B0[2][2], B1[2][2]; i32x8 At8[4], B08[2], B18[2];
    const char* cA = (const char*)g.A + (size_t)cur.pm * tstepA; const char* cB = (const char*)g.Bt + (size_t)cur.pb * tstepB;
    if constexpr (GATHER) { PG8_GOFF(goff, 0); }
    PG8_STAGE(PG8_SB(0, 0), cB, voffB); PG8_STAGE(PG8_SB(0, 1), cB + hstepB, voffB); PG8_STAGE_A(PG8_SA(0, 0), cA, 0, goff[0]); PG8_STAGE_A(PG8_SA(0, 1), cA + hstepA, 0, goff[1]);
    if (wr == 1) PG8_BAR;
    PG8_WAIT_V(2); PG8_BAR;
    PG8_STAGE(PG8_SB(1, 0), cB + kstep, voffB); PG8_STAGE_A(PG8_SA(1, 0), cA + kstep, 1, goff[0]); PG8_STAGE(PG8_SB(1, 1), cB + hstepB + kstep, voffB);
    PG8_WAIT_V(6); PG8_BAR;
    for (;;) {
        const bool has_next = S.next(ui + 1, nxt);
        const char* nA = has_next ? (const char*)g.A + (size_t)nxt.pm * tstepA : cA; const char* nB = has_next ? (const char*)g.Bt + (size_t)nxt.pb * tstepB : cB;
        if constexpr (GATHER) { if (has_next) { PG8_GOFF(noff, ui + 1); } else {
#pragma unroll
            for (int h_ = 0; h_ < 2; ++h_)
#pragma unroll
                for (int i_ = 0; i_ < 2; ++i_) noff[h_][i_] = goff[h_][i_]; } }
        for (int t = 0; t < nt; t += 2) {
            const bool last = (t == nt - 2);
            const char* a1 = cA + (size_t)(t + 1) * kstep;
            const char* a2 = last ? nA : cA + (size_t)(t + 2) * kstep; const char* b2 = last ? nB : cB + (size_t)(t + 2) * kstep;
            const char* a3 = a2 + kstep; const char* b3 = b2 + kstep;
            const int k2 = last ? 0 : t + 2;
            unsigned soff[2][2];
            if constexpr (GATHER) {
#pragma unroll
                for (int h_ = 0; h_ < 2; ++h_)
#pragma unroll
                    for (int i_ = 0; i_ < 2; ++i_) soff[h_][i_] = last ? noff[h_][i_] : goff[h_][i_]; }
            PG8_LDB(B0, 0, 0); PG8_LDB(B1, 0, 1); PG8_SCHED; PG8_LDA(At, 0, 0); PG8_STAGE_A(PG8_SA(1, 1), a1 + hstepA, t + 1, goff[1]);
            PG8_WAIT_V(8); PG8_WAIT_L(0); PG8_BAR; PG8_MMA(0, 0, At, B0); PG8_MMA(0, 1, At, B1); PG8_BAR; PG8_SCHED;
            PG8_LDA(At, 0, 1); PG8_STAGE(PG8_SB(0, 0), b2, voffB); PG8_STAGE(PG8_SB(0, 1), b2 + hstepB, voffB); PG8_STAGE_A(PG8_SA(0, 0), a2, k2, soff[0]);
            PG8_WAIT_V(8); PG8_WAIT_L(0); PG8_BAR; PG8_MMA(1, 0, At, B0); PG8_MMA(1, 1, At, B1); PG8_BAR; PG8_SCHED;
            PG8_LDB(B0, 1, 0); PG8_LDB(B1, 1, 1); PG8_SCHED; PG8_LDA(At, 1, 0); PG8_STAGE_A(PG8_SA(0, 1), a2 + hstepA, k2, soff[1]);
            PG8_WAIT_V(8); PG8_WAIT_L(0); PG8_BAR; PG8_MMA(0, 0, At, B0); PG8_MMA(0, 1, At, B1); PG8_BAR; PG8_SCHED;
            PG8_LDA(At, 1, 1); PG8_STAGE(PG8_SB(1, 0), b3, voffB); PG8_STAGE(PG8_SB(1, 1), b3 + hstepB, voffB); PG8_STAGE_A(PG8_SA(1, 0), a3, k2 + 1, soff[0]);
            PG8_WAIT_V(8); PG8_WAIT_L(0); PG8_BAR; PG8_MMA(1, 0, At, B0); PG8_MMA(1, 1, At, B1); PG8_BAR; PG8_SCHED;
        }
        if constexpr (ALIGN_EPI) { if (wr == 0) PG8_BAR; }
        if constexpr (FP8) asm volatile("s_nop 15\n\ts_nop 15" ::: "memory");
        E(acc, cur, wr, wc, fr, fq);
        if (!has_next) break;
#pragma unroll
        for (int a = 0; a < 2; ++a)
#pragma unroll
            for (int b = 0; b < 2; ++b)
#pragma unroll
                for (int m = 0; m < 4; ++m)
#pragma unroll
                    for (int n = 0; n < 2; ++n) acc[a][b][m][n] = (f32x4){0.f, 0.f, 0.f, 0.f};
        cur = nxt; cA = nA; cB = nB; ++ui;
        if constexpr (GATHER) {
#pragma unroll
            for (int h_ = 0; h_ < 2; ++h_)
#pragma unroll
                for (int i_ = 0; i_ < 2; ++i_) goff[h_][i_] = noff[h_][i_]; }
        if constexpr (ALIGN_EPI) { if (wr == 1) PG8_BAR; }
    }
    PG8_WAIT_V(0);
    if constexpr (!ALIGN_EPI) { if (wr == 0) PG8_BAR; }
    PG8_BAR;
#undef PG8_SA
#undef PG8_SB
#undef PG8_STAGE
#undef PG8_STAGE_A
#undef PG8_GOFF
#undef PG8_LDA
#undef PG8_LDB
#undef PG8_MMA
#undef PG8_CAT8
#undef PG8_WAIT_V
#undef PG8_WAIT_L
#undef PG8_BAR
#undef PG8_SCHED
}

#define EPI_ARGS const f32x4 (&acc)[2][2][4][2], const Unit& u, int wr, int wc, int fr, int fq
__device__ __forceinline__ u32x4 pack8(f32x4 v0, f32x4 v1) { u32x4 w; w.x = cvt_pk_bf16(v0[0], v0[1]); w.y = cvt_pk_bf16(v0[2], v0[3]); w.z = cvt_pk_bf16(v1[0], v1[1]); w.w = cvt_pk_bf16(v1[2], v1[3]); return w; }
__device__ __forceinline__ void unpack8(u32x4 w, f32x4& v0, f32x4& v1) { v0 = (f32x4){bflo(w.x), bfhi(w.x), bflo(w.y), bfhi(w.y)}; v1 = (f32x4){bflo(w.z), bfhi(w.z), bflo(w.w), bfhi(w.w)}; }
__device__ __forceinline__ f32x4 sig4(f32x4 v) { return (f32x4){sigmoidf_(v[0]), sigmoidf_(v[1]), sigmoidf_(v[2]), sigmoidf_(v[3])}; }

struct EpiStore {
    bf16_t* O; int ldc; const float* bias; int bias_stride; int sig_from;
    __device__ __forceinline__ void operator()(EPI_ARGS) const {
        const int row0 = u.pm * BM + wr * 64 + fr, col0 = u.pn * BM + wc * 32 + 8 * fq;
        const bool sg = u.pn >= sig_from;
        f32x4 bv[2][2];
#pragma unroll
        for (int bj = 0; bj < 2; ++bj)
#pragma unroll
            for (int n = 0; n < 2; ++n) bv[bj][n] = bias ? *(const f32x4*)(bias + (size_t)u.e * bias_stride + col0 + bj * HALF + 4 * n) : (f32x4){0.f, 0.f, 0.f, 0.f};
#pragma unroll
        for (int ai = 0; ai < 2; ++ai)
#pragma unroll
            for (int m = 0; m < 4; ++m) { bf16_t* rowp = O + (size_t)(row0 + ai * HALF + m * 16) * ldc + col0;
#pragma unroll
                for (int bj = 0; bj < 2; ++bj) { f32x4 v0 = acc[ai][bj][m][0] + bv[bj][0], v1 = acc[ai][bj][m][1] + bv[bj][1];
                    if (sg) { v0 = sig4(v0); v1 = sig4(v1); }
                    *(u32x4*)(rowp + bj * HALF) = pack8(v0, v1); } }
    }
};

struct EpiProj {
    bf16_t* PROJ; bf16_t* QA2; bf16_t* KA2; float* KMEAN; bf16_t* CQN; bf16_t* CKVN;
    const float* gq; const float* gk; const float* glq; const float* glkv; const float* cosA; const float* sinA; LAS float* xch;
    float* KPESS;
    __device__ __forceinline__ void operator()(EPI_ARGS) const {
        const int row0 = u.pm * BM + wr * 64 + fr, col0 = u.pn * BM + wc * 32 + 8 * fq;
        if (u.pn < 4) {
            const bool isk = u.pn >= 2; const int h = 4 * (u.pn & 1) + wc; const float* gn = isk ? gk : gq; const float sc = isk ? 1.0f : C2A;
            const f32x4 g1a = *(const f32x4*)(gn + 8 * fq), g1b = *(const f32x4*)(gn + 8 * fq + 4), g2a = *(const f32x4*)(gn + 32 + 8 * fq), g2b = *(const f32x4*)(gn + 36 + 8 * fq);
            bf16_t* dst = isk ? KA2 : QA2;
            f32x4 ks1a = {0.f, 0.f, 0.f, 0.f}, ks1b = ks1a, ks2a = ks1a, ks2b = ks1a;
#pragma unroll
            for (int ai = 0; ai < 2; ++ai)
#pragma unroll
                for (int m = 0; m < 4; ++m) { const int row = row0 + ai * HALF + m * 16; const int pos = row & (SEQ - 1);
                    f32x4 x1a = acc[ai][0][m][0], x1b = acc[ai][0][m][1], x2a = acc[ai][1][m][0], x2b = acc[ai][1][m][1];
                    float ss = (x1a[0] * x1a[0] + x1a[1] * x1a[1]) + (x1a[2] * x1a[2] + x1a[3] * x1a[3]) + (x1b[0] * x1b[0] + x1b[1] * x1b[1]) + (x1b[2] * x1b[2] + x1b[3] * x1b[3])
                             + (x2a[0] * x2a[0] + x2a[1] * x2a[1]) + (x2a[2] * x2a[2] + x2a[3] * x2a[3]) + (x2b[0] * x2b[0] + x2b[1] * x2b[1]) + (x2b[2] * x2b[2] + x2b[3] * x2b[3]);
                    ss += __shfl_xor(ss, 16); ss += __shfl_xor(ss, 32);
                    const float rstd = 1.0f / sqrtf(ss * (1.f / 64.f) + EPS);
                    x1a = x1a * g1a * rstd; x1b = x1b * g1b * rstd; x2a = x2a * g2a * rstd; x2b = x2b * g2b * rstd;
                    const f32x4 ca = *(const f32x4*)(cosA + pos * 32 + 8 * fq), cb = *(const f32x4*)(cosA + pos * 32 + 8 * fq + 4), sa = *(const f32x4*)(sinA + pos * 32 + 8 * fq), sb = *(const f32x4*)(sinA + pos * 32 + 8 * fq + 4);
                    const f32x4 y1a = x1a * ca - x2a * sa, y1b = x1b * cb - x2b * sb, y2a = x2a * ca + x1a * sa, y2b = x2b * cb + x1b * sb;
                    bf16_t* rp = dst + (size_t)row * 512 + h * 64 + 8 * fq;
                    *(u32x4*)rp = pack8(y1a * sc, y1b * sc); *(u32x4*)(rp + 32) = pack8(y2a * sc, y2b * sc);
                    ks1a += y1a; ks1b += y1b; ks2a += y2a; ks2b += y2b; }
            if (isk) {
#pragma unroll
                for (int o = 1; o < 16; o <<= 1) {
#pragma unroll
                    for (int i = 0; i < 4; ++i) { ks1a[i] += __shfl_xor(ks1a[i], o); ks1b[i] += __shfl_xor(ks1b[i], o); ks2a[i] += __shfl_xor(ks2a[i], o); ks2b[i] += __shfl_xor(ks2b[i], o); } }
                if (fr == 0) { float* km = KMEAN + (((size_t)(u.pm >> 3) * 8 + h) * 8 + (u.pm & 7)) * 64 + 8 * fq;
#pragma unroll
                    for (int i = 0; i < 4; ++i) { atomicAdd(km + i, ks1a[i] * (1.f / 256.f)); atomicAdd(km + 4 + i, ks1b[i] * (1.f / 256.f)); atomicAdd(km + 32 + i, ks2a[i] * (1.f / 256.f)); atomicAdd(km + 36 + i, ks2b[i] * (1.f / 256.f)); } } }
        } else if (u.pn == 6 || u.pn == 7) {
            const bool isq = u.pn == 6;
            float ssr[2][4];
#pragma unroll
            for (int ai = 0; ai < 2; ++ai)
#pragma unroll
                for (int m = 0; m < 4; ++m) { float ss = 0.f;
#pragma unroll
                    for (int bj = 0; bj < 2; ++bj) { if (bj == 1 && !isq) continue;
#pragma unroll
                        for (int n = 0; n < 2; ++n) { const f32x4 x = acc[ai][bj][m][n]; ss += (x[0] * x[0] + x[1] * x[1]) + (x[2] * x[2] + x[3] * x[3]); } }
                    ss += __shfl_xor(ss, 16); ss += __shfl_xor(ss, 32);
                    if (fq == 0) xch[(ai * HALF + wr * 64 + m * 16 + fr) * 4 + wc] = ss; }
            asm volatile("s_waitcnt lgkmcnt(0)" ::: "memory"); __builtin_amdgcn_s_barrier(); asm volatile("" ::: "memory");
#pragma unroll
            for (int ai = 0; ai < 2; ++ai)
#pragma unroll
                for (int m = 0; m < 4; ++m) { const f32x4 p4 = *(const LAS f32x4*)(xch + (ai * HALF + wr * 64 + m * 16 + fr) * 4); ssr[ai][m] = (p4[0] + p4[1]) + (p4[2] + p4[3]); }
            asm volatile("s_waitcnt lgkmcnt(0)" ::: "memory"); __builtin_amdgcn_s_barrier(); asm volatile("" ::: "memory");
            const float invn = isq ? (1.f / 256.f) : (1.f / 128.f); const float* gl = isq ? glq : glkv; bf16_t* dn = isq ? CQN : CKVN; const int ldn = isq ? 256 : 128;
            const int c0 = wc * 32 + 8 * fq;
#pragma unroll
            for (int bj = 0; bj < 2; ++bj) {
                if (bj == 1 && !isq) {
#pragma unroll
                    for (int ai = 0; ai < 2; ++ai)
#pragma unroll
                        for (int m = 0; m < 4; ++m) { const f32x4 x0 = acc[ai][1][m][0], x1 = acc[ai][1][m][1];
                            *(u32x4*)(PROJ + (size_t)(row0 + ai * HALF + m * 16) * DINP + col0 + HALF) = pack8(x0, x1);
                            float ss = (x0[0] * x0[0] + x0[1] * x0[1]) + (x0[2] * x0[2] + x0[3] * x0[3]) + (x1[0] * x1[0] + x1[1] * x1[1]) + (x1[2] * x1[2] + x1[3] * x1[3]);
                            ss += __shfl_xor(ss, 16); ss += __shfl_xor(ss, 32);
                            if (wc == 0 && fq == 0) KPESS[row0 + ai * HALF + m * 16] = ss; }
                    continue; }
                const f32x4 ga = *(const f32x4*)(gl + bj * HALF + c0), gb = *(const f32x4*)(gl + bj * HALF + c0 + 4);
#pragma unroll
                for (int ai = 0; ai < 2; ++ai)
#pragma unroll
                    for (int m = 0; m < 4; ++m) { const float rstd = 1.0f / sqrtf(ssr[ai][m] * invn + EPS);
                        *(u32x4*)(dn + (size_t)(row0 + ai * HALF + m * 16) * ldn + bj * HALF + c0) = pack8(acc[ai][bj][m][0] * ga * rstd, acc[ai][bj][m][1] * gb * rstd); } }
        } else {
            const bool sg = u.pn >= 8;
#pragma unroll
            for (int ai = 0; ai < 2; ++ai)
#pragma unroll
                for (int m = 0; m < 4; ++m) { bf16_t* rowp = PROJ + (size_t)(row0 + ai * HALF + m * 16) * DINP + col0;
#pragma unroll
                    for (int bj = 0; bj < 2; ++bj) { f32x4 v0 = acc[ai][bj][m][0], v1 = acc[ai][bj][m][1];
                        if (sg) { v0 = sig4(v0); v1 = sig4(v1); }
                        *(u32x4*)(rowp + bj * HALF) = pack8(v0, v1); } }
        }
    }
};

struct EpiQB {
    bf16_t* QB; const float* gn; const float* cosB; const float* sinB; LAS float* xch;
    __device__ __forceinline__ void operator()(EPI_ARGS) const {
        const int rl0 = wr * 64 + fr, row0 = u.pm * BM + rl0;
#pragma unroll
        for (int ai = 0; ai < 2; ++ai)
#pragma unroll
            for (int m = 0; m < 4; ++m)
#pragma unroll
                for (int bj = 0; bj < 2; ++bj) { const f32x4 x0 = acc[ai][bj][m][0], x1 = acc[ai][bj][m][1];
                    float ss = (x0[0] * x0[0] + x0[1] * x0[1]) + (x0[2] * x0[2] + x0[3] * x0[3]) + (x1[0] * x1[0] + x1[1] * x1[1]) + (x1[2] * x1[2] + x1[3] * x1[3]);
                    ss += __shfl_xor(ss, 16); ss += __shfl_xor(ss, 32);
                    if (fq == 0) xch[((rl0 + ai * HALF + m * 16) * 2 + bj) * 4 + wc] = ss; }
        asm volatile("s_waitcnt lgkmcnt(0)" ::: "memory"); __builtin_amdgcn_s_barrier(); asm volatile("" ::: "memory");
#define QB_RS(ai, m, bj) ({ const f32x4 p4_ = *(const LAS f32x4*)(xch + ((rl0 + (ai) * HALF + (m) * 16) * 2 + (bj)) * 4); C2B / sqrtf(((p4_[0] + p4_[1]) + p4_[2]) * (1.f / 96.f) + EPS); })
        if (wc < 2) { const f32x4 ga = *(const f32x4*)(gn + 32 * wc + 8 * fq), gb = *(const f32x4*)(gn + 32 * wc + 8 * fq + 4);
#pragma unroll
            for (int ai = 0; ai < 2; ++ai)
#pragma unroll
                for (int m = 0; m < 4; ++m)
#pragma unroll
                    for (int bj = 0; bj < 2; ++bj) { const float r = QB_RS(ai, m, bj);
                        *(u32x4*)(QB + (size_t)(row0 + ai * HALF + m * 16) * 768 + (2 * u.pn + bj) * 96 + 32 * wc + 8 * fq) = pack8(acc[ai][bj][m][0] * ga * r, acc[ai][bj][m][1] * gb * r); }
        } else if (wc == 2) { const f32x4 g1 = *(const f32x4*)(gn + 64 + 4 * fq), g2 = *(const f32x4*)(gn + 80 + 4 * fq);
#pragma unroll
            for (int ai = 0; ai < 2; ++ai)
#pragma unroll
                for (int m = 0; m < 4; ++m) { const int row = row0 + ai * HALF + m * 16; const int pos = row & (SEQ - 1);
                    const f32x4 c4 = *(const f32x4*)(cosB + pos * 16 + 4 * fq), s4 = *(const f32x4*)(sinB + pos * 16 + 4 * fq);
#pragma unroll
                    for (int bj = 0; bj < 2; ++bj) { const float r = QB_RS(ai, m, bj); const f32x4 x1 = acc[ai][bj][m][0] * g1 * r, x2 = acc[ai][bj][m][1] * g2 * r;
                        const f32x4 y1 = x1 * c4 - x2 * s4, y2 = x2 * c4 + x1 * s4; bf16_t* rp = QB + (size_t)row * 768 + (2 * u.pn + bj) * 96 + 64 + 4 * fq;
                        *(u32x2*)rp = (u32x2){cvt_pk_bf16(y1[0], y1[1]), cvt_pk_bf16(y1[2], y1[3])}; *(u32x2*)(rp + 16) = (u32x2){cvt_pk_bf16(y2[0], y2[1]), cvt_pk_bf16(y2[2], y2[3])}; } }
        }
    }
};
struct EpiKV {
    bf16_t* KB2; bf16_t* KV; const bf16_t* PROJ; const float* KPESS; const float* gn; const float* cosB; const float* sinB; LAS float* xch;
    __device__ __forceinline__ void operator()(EPI_ARGS) const {
        const int rl0 = wr * 64 + fr, row0 = u.pm * BM + rl0;
        if (wc < 2) {
#pragma unroll
            for (int ai = 0; ai < 2; ++ai)
#pragma unroll
                for (int m = 0; m < 4; ++m)
#pragma unroll
                    for (int bj = 0; bj < 2; ++bj) { const f32x4 x0 = acc[ai][bj][m][0], x1 = acc[ai][bj][m][1];
                        float ss = (x0[0] * x0[0] + x0[1] * x0[1]) + (x0[2] * x0[2] + x0[3] * x0[3]) + (x1[0] * x1[0] + x1[1] * x1[1]) + (x1[2] * x1[2] + x1[3] * x1[3]);
                        ss += __shfl_xor(ss, 16); ss += __shfl_xor(ss, 32);
                        if (fq == 0) xch[((rl0 + ai * HALF + m * 16) * 2 + bj) * 4 + wc] = ss; } }
        asm volatile("s_waitcnt lgkmcnt(0)" ::: "memory"); __builtin_amdgcn_s_barrier(); asm volatile("" ::: "memory");
#define KV_RS(ai, m, bj, pe) ({ const f32x2 p2_ = *(const LAS f32x2*)(xch + ((rl0 + (ai) * HALF + (m) * 16) * 2 + (bj)) * 4); 1.0f / sqrtf(((p2_[0] + p2_[1]) + (pe)) * (1.f / 96.f) + EPS); })
        if (wc < 2) { const f32x4 ga = *(const f32x4*)(gn + 32 * wc + 8 * fq), gb = *(const f32x4*)(gn + 32 * wc + 8 * fq + 4);
#pragma unroll
            for (int ai = 0; ai < 2; ++ai)
#pragma unroll
                for (int m = 0; m < 4; ++m) { const float pe = KPESS[row0 + ai * HALF + m * 16];
#pragma unroll
                    for (int bj = 0; bj < 2; ++bj) { const float r = KV_RS(ai, m, bj, pe);
                        *(u32x4*)(KB2 + (size_t)(row0 + ai * HALF + m * 16) * 768 + (2 * u.pn + bj) * 96 + 32 * wc + 8 * fq) = pack8(acc[ai][bj][m][0] * ga * r, acc[ai][bj][m][1] * gb * r); } }
        } else {
#pragma unroll
            for (int ai = 0; ai < 2; ++ai)
#pragma unroll
                for (int m = 0; m < 4; ++m)
#pragma unroll
                    for (int bj = 0; bj < 2; ++bj) *(u32x4*)(KV + (size_t)(row0 + ai * HALF + m * 16) * 1024 + (2 * u.pn + bj) * 128 + 32 * wc + 8 * fq) = pack8(acc[ai][bj][m][0], acc[ai][bj][m][1]);
            if (wc == 2) {
                const f32x4 g1 = *(const f32x4*)(gn + 64 + 4 * fq), g2 = *(const f32x4*)(gn + 80 + 4 * fq);
#pragma unroll
                for (int ai = 0; ai < 2; ++ai)
#pragma unroll
                    for (int m = 0; m < 4; ++m) { const int row = row0 + ai * HALF + m * 16; const int pos = row & (SEQ - 1); const float pe = KPESS[row];
                        const u32x2 w1 = *(const u32x2*)(PROJ + (size_t)row * DINP + PC_KPE + 4 * fq), w2 = *(const u32x2*)(PROJ + (size_t)row * DINP + PC_KPE + 16 + 4 * fq);
                        const f32x4 k1 = (f32x4){bflo(w1.x), bfhi(w1.x), bflo(w1.y), bfhi(w1.y)} * g1, k2 = (f32x4){bflo(w2.x), bfhi(w2.x), bflo(w2.y), bfhi(w2.y)} * g2;
                        const f32x4 c4 = *(const f32x4*)(cosB + pos * 16 + 4 * fq), s4 = *(const f32x4*)(sinB + pos * 16 + 4 * fq);
                        const f32x4 y1 = k1 * c4 - k2 * s4, y2 = k2 * c4 + k1 * s4;
#pragma unroll
                        for (int bj = 0; bj < 2; ++bj) { const float r = KV_RS(ai, m, bj, pe); bf16_t* rp = KB2 + (size_t)row * 768 + (2 * u.pn + bj) * 96 + 64 + 4 * fq;
                            *(u32x2*)rp = (u32x2){cvt_pk_bf16(y1[0] * r, y1[1] * r), cvt_pk_bf16(y1[2] * r, y1[3] * r)}; *(u32x2*)(rp + 16) = (u32x2){cvt_pk_bf16(y2[0] * r, y2[1] * r), cvt_pk_bf16(y2[2] * r, y2[3] * r)}; } } }
        }
    }
};
#undef QB_RS
#undef KV_RS
template <bool ADD> struct EpiGate {
    bf16_t* O; const bf16_t* G; int ldg; unsigned char* MF8;
    __device__ __forceinline__ void operator()(EPI_ARGS) const {
        const int row0 = u.pm * BM + wr * 64 + fr, col0 = u.pn * BM + wc * 32 + 8 * fq;
#pragma unroll
        for (int ai = 0; ai < 2; ++ai)
#pragma unroll
            for (int m = 0; m < 4; ++m) { const size_t r = (size_t)(row0 + ai * HALF + m * 16);
#pragma unroll
                for (int bj = 0; bj < 2; ++bj) { const int c = col0 + bj * HALF;
                    f32x4 g0, g1; unpack8(*(const u32x4*)(G + r * ldg + c), g0, g1);
                    f32x4 v0 = acc[ai][bj][m][0] * g0, v1 = acc[ai][bj][m][1] * g1;
                    if (ADD) { f32x4 o0, o1; unpack8(*(const u32x4*)(O + r * DM + c), o0, o1); v0 += o0; v1 += o1;
                        *(u32x2*)(MF8 + r * DM + c) = (u32x2){pack4_fp8(v0[0], v0[1], v0[2], v0[3]), pack4_fp8(v1[0], v1[1], v1[2], v1[3])}; }
                    else *(u32x4*)(O + r * DM + c) = pack8(v0, v1); } }
    }
};
struct EpiResF32 {
    const float* base; float* out; float* ssp;
    __device__ __forceinline__ void operator()(EPI_ARGS) const {
        const int row0 = u.pm * BM + wr * 64 + fr, col0 = u.pn * BM + wc * 32 + 8 * fq;
#pragma unroll
        for (int ai = 0; ai < 2; ++ai)
#pragma unroll
            for (int m = 0; m < 4; ++m) { const size_t r = (size_t)(row0 + ai * HALF + m * 16); float ss = 0.f;
#pragma unroll
                for (int bj = 0; bj < 2; ++bj) { const size_t off = r * DM + col0 + bj * HALF;
                    const f32x4 b0 = *(const f32x4*)(base + off), b1 = *(const f32x4*)(base + off + 4);
                    const f32x4 y0 = b0 + acc[ai][bj][m][0], y1 = b1 + acc[ai][bj][m][1];
                    *(f32x4*)(out + off) = y0; *(f32x4*)(out + off + 4) = y1;
                    ss += (y0[0] * y0[0] + y0[1] * y0[1]) + (y0[2] * y0[2] + y0[3] * y0[3]) + (y1[0] * y1[0] + y1[1] * y1[1]) + (y1[2] * y1[2] + y1[3] * y1[3]); }
                ss += __shfl_xor(ss, 16); ss += __shfl_xor(ss, 32);
                if (fq == 0) ssp[r * 16 + u.pn * 4 + wc] = ss; }
    }
};
struct EpiSwiglu {
    unsigned char* O; const float* bias;
    __device__ __forceinline__ void operator()(EPI_ARGS) const {
        const int row0 = u.pm * BM + wr * 64 + fr, j0 = u.pn * HALF + wc * 32 + 8 * fq;
        const float* be = bias + (size_t)u.e * 2048;
        f32x4 bg[2], bu[2];
#pragma unroll
        for (int n = 0; n < 2; ++n) { bg[n] = *(const f32x4*)(be + j0 + 4 * n); bu[n] = *(const f32x4*)(be + 1024 + j0 + 4 * n); }
#pragma unroll
        for (int ai = 0; ai < 2; ++ai)
#pragma unroll
            for (int m = 0; m < 4; ++m) { unsigned char* rowp = O + (size_t)(row0 + ai * HALF + m * 16) * DEXP + j0;
                f32x4 o[2];
#pragma unroll
                for (int n = 0; n < 2; ++n) { const f32x4 gv = acc[ai][0][m][n] + bg[n], uv = acc[ai][1][m][n] + bu[n];
#pragma unroll
                    for (int i = 0; i < 4; ++i) { const float gg = fminf(gv[i], 7.0f), uu = fminf(fmaxf(uv[i], -7.0f), 7.0f);
                        o[n][i] = (uu + 1.0f) * gg * __builtin_amdgcn_rcpf(1.0f + __builtin_amdgcn_exp2f(-1.702f * LOG2E * gg)); } }
                *(u32x2*)rowp = (u32x2){pack4_fp8(o[0][0], o[0][1], o[0][2], o[0][3]), pack4_fp8(o[1][0], o[1][1], o[1][2], o[1][3])}; }
    }
};
struct EpiFinal {
    float* out; const bf16_t* PP;
    __device__ __forceinline__ void operator()(EPI_ARGS) const {
        const int row0 = u.pm * BM + wr * 64 + fr, col0 = u.pn * BM + wc * 32 + 8 * fq;
#pragma unroll
        for (int ai = 0; ai < 2; ++ai)
#pragma unroll
            for (int m = 0; m < 4; ++m) { const size_t r = (size_t)(row0 + ai * HALF + m * 16);
#pragma unroll
                for (int bj = 0; bj < 2; ++bj) { const size_t off = r * DM + col0 + bj * HALF;
                    f32x4 p0, p1; unpack8(*(const u32x4*)(PP + off), p0, p1);
                    const f32x4 b0 = *(const f32x4*)(out + off), b1 = *(const f32x4*)(out + off + 4);
                    *(f32x4*)(out + off) = b0 + sig4(acc[ai][bj][m][0]) * p0; *(f32x4*)(out + off + 4) = b1 + sig4(acc[ai][bj][m][1]) * p1; } }
    }
};
}

namespace att {
__device__ __forceinline__ int crow(int r, int hi) { return (r & 3) + 8 * (r >> 2) + 4 * hi; }
__device__ __forceinline__ void glds16(const void* gsrc, unsigned lds_dst) { unsigned keep;
    asm volatile("s_mov_b32 %0, m0\n\ts_mov_b32 m0, %2\n\ts_nop 0\n\tglobal_load_lds_dwordx4 %1, off\n\ts_mov_b32 m0, %0" : "=&s"(keep) : "v"(gsrc), "s"(lds_dst) : "memory"); }
__device__ __forceinline__ s16x4 vtr(const LAS unsigned char* p) { return __builtin_bit_cast(s16x4, __builtin_amdgcn_ds_read_tr16_b64_v4i16((LAS s16x4*)p)); }
#define MX3(a, b, c) __builtin_fmaxf(__builtin_fmaxf((a), (b)), (c))
constexpr int VSLOT = 8192, OST_BYTES = NWAVES * 4096, WSF_BYTES = NWAVES * 256;

template <int DQK, bool MOBA>
__device__ __forceinline__ void attn_unit(int b, int qb, const bf16_t* Qh, int ldq, const bf16_t* Kh, int ldk, const bf16_t* Vh, int ldv, unsigned char* Oh, int ldo, const float* kmean, LAS unsigned char* shm, int wave) {
    constexpr int ND = DQK / 16, NCH = DQK / 8, KSLOT = NCH * 1024;
    constexpr int LDS_K = 0, LDS_V = 2 * KSLOT, LDS_WS = LDS_V + 2 * VSLOT, LDS_OST = LDS_WS + WSF_BYTES;
    static_assert(LDS_OST + OST_BYTES <= RING_BYTES, "attention LDS");
    int lane = lane_id(); asm volatile("" : "+v"(lane));
    const int r32 = lane & 31, hi = lane >> 5; const int wid = wave;
    const long rowbase = (long)b * SEQ; const int q0 = qb * 256;
    const unsigned lds0 = (unsigned)(uintptr_t)shm;
    LAS float* wsf = (LAS float*)(shm + LDS_WS) + wid * 64;
    const int NT = 4 * (qb + 1);
    const bf16_t* ksrc0 = Kh + (rowbase + lane) * ldk + wid * 8;
    const bf16_t* vsrc0 = Vh + (rowbase + 16 * (wid & 3) + (lane >> 2)) * ldv + (wid >> 2) * 32 + (lane & 3) * 8;
#define ATT_DMA(kt, s) do { const long ro_ = (long)(kt) * 64; \
        glds16(ksrc0 + ro_ * ldk, (unsigned)__builtin_amdgcn_readfirstlane(lds0 + LDS_K + (s) * KSLOT + wid * 1024)); \
        if (NCH > 8 && wid < NCH - 8) glds16(ksrc0 + ro_ * ldk + 64, (unsigned)__builtin_amdgcn_readfirstlane(lds0 + LDS_K + (s) * KSLOT + (wid + 8) * 1024)); \
        glds16(vsrc0 + ro_ * ldv, (unsigned)__builtin_amdgcn_readfirstlane(lds0 + LDS_V + (s) * VSLOT + wid * 1024)); } while (0)
#define ATT_TILE(i) (MOBA ? ((i) < 4 ? 4 * qb + (i) : (i) - 4) : (i))
    ATT_DMA(ATT_TILE(0), 0);
    const bf16_t* Qw = Qh + (rowbase + q0 + wid * 32 + r32) * ldq + hi * 8;
    bf16x8 qr[ND];
#pragma unroll
    for (int d0 = 0; d0 < ND; ++d0) qr[d0] = *(const bf16x8*)(Qw + d0 * 16);
    unsigned bmask = 0xffffffffu;
    if (MOBA) {
        bmask = 1u << qb;
        if (qb <= 3) bmask |= (1u << qb) - 1u;
        else {
            float gsc[7];
#pragma unroll
            for (int n = 0; n < 7; ++n) { float s = 0.f;
                if (n < qb) {
#pragma unroll
                    for (int d0 = 0; d0 < ND; ++d0) { const float* km = kmean + n * 64 + d0 * 16 + hi * 8; const f32x4 k0 = *(const f32x4*)km, k1 = *(const f32x4*)(km + 4);
                        s += bf2f((unsigned short)qr[d0][0]) * k0[0] + bf2f((unsigned short)qr[d0][1]) * k0[1] + bf2f((unsigned short)qr[d0][2]) * k0[2] + bf2f((unsigned short)qr[d0][3]) * k0[3]
                           + bf2f((unsigned short)qr[d0][4]) * k1[0] + bf2f((unsigned short)qr[d0][5]) * k1[1] + bf2f((unsigned short)qr[d0][6]) * k1[2] + bf2f((unsigned short)qr[d0][7]) * k1[3]; }
                    s += __shfl_xor(s, 32);
                } else s = -INFINITY;
                gsc[n] = s; }
#pragma unroll
            for (int pass = 0; pass < 3; ++pass) { float best = -INFINITY; int bi = 0;
#pragma unroll
                for (int n = 0; n < 7; ++n) { const bool ok = (n < qb) && !((bmask >> n) & 1u) && (gsc[n] > best); best = ok ? gsc[n] : best; bi = ok ? n : bi; }
                bmask |= 1u << bi; }
        }
    }
    asm volatile("s_waitcnt vmcnt(0)" ::: "memory");
#pragma unroll
    for (int d0 = 0; d0 < ND; ++d0) asm volatile("" : "+v"(qr[d0]));
    float mhat = 0.f, l_reg = 0.f; f32x16 o[2]; o[0] = f32x16{}; o[1] = f32x16{}; f32x16 negm = f32x16{}; asm volatile("" : "+v"(negm));
    const int qrel = wid * 32 + r32;
    const LAS unsigned char* kp0 = shm + LDS_K + hi * 1024 + r32 * 16;
    const LAS unsigned char* vp0 = shm + LDS_V + ((lane >> 4) & 1) * 32 + (lane & 3) * 8 + (4 * hi + ((lane & 15) >> 2)) * 64;
    for (int i = 0; i < NT; ++i) {
        const int s = i & 1, kt = ATT_TILE(i);
        asm volatile("s_waitcnt vmcnt(0) lgkmcnt(0)\n\ts_barrier" ::: "memory");
        if (i + 1 < NT) ATT_DMA(ATT_TILE(i + 1), s ^ 1);
        f32x16 cin = negm;
        if (MOBA) { if (i >= 4 && !((bmask >> (kt >> 2)) & 1u)) {
#pragma unroll
            for (int r = 0; r < 16; ++r) cin[r] = -INFINITY; } }
        f32x16 p0, p1;
        { const LAS unsigned char* kb = kp0 + s * KSLOT; bf16x8 kf[2 * ND];
#pragma unroll
            for (int d0 = 0; d0 < ND; ++d0) { kf[2 * d0] = *(const LAS bf16x8*)(kb + d0 * 2048); kf[2 * d0 + 1] = *(const LAS bf16x8*)(kb + d0 * 2048 + 512); }
            __builtin_amdgcn_sched_barrier(0);
#pragma unroll
            for (int d0 = 0; d0 < ND; ++d0) {
                if (d0 == 0) { p0 = __builtin_amdgcn_mfma_f32_32x32x16_bf16(kf[0], qr[0], cin, 0, 0, 0); p1 = __builtin_amdgcn_mfma_f32_32x32x16_bf16(kf[1], qr[0], cin, 0, 0, 0); }
                else { p0 = __builtin_amdgcn_mfma_f32_32x32x16_bf16(kf[2 * d0], qr[d0], p0, 0, 0, 0); p1 = __builtin_amdgcn_mfma_f32_32x32x16_bf16(kf[2 * d0 + 1], qr[d0], p1, 0, 0, 0); } } }
        if (kt >= 4 * qb) { const int kb = 64 * (kt - 4 * qb) + 4 * hi;
#pragma unroll
            for (int r = 0; r < 16; ++r) { const int kv = kb + (r & 3) + 8 * (r >> 2); if (kv > qrel) p0[r] = -INFINITY; if (kv + 32 > qrel) p1[r] = -INFINITY; } }
        bool resc = false;
        { float a = MX3(p0[0], p0[1], p1[0]), bb = MX3(p0[2], p0[3], p1[1]); a = MX3(a, p1[2], p1[3]);
#pragma unroll
            for (int r = 4; r < 16; r += 4) { a = MX3(a, p0[r], p0[r + 1]); bb = MX3(bb, p0[r + 2], p0[r + 3]); a = MX3(a, p1[r], p1[r + 1]); bb = MX3(bb, p1[r + 2], p1[r + 3]); }
            float rm = __builtin_fmaxf(a, bb); rm = __builtin_fmaxf(rm, __shfl_xor(rm, 32));
            const bool first = (i == 0);
            if (first || __any(rm > 6.0f)) {
                const float dl = first ? rm : __builtin_fmaxf(rm, 0.f); mhat += dl;
#pragma unroll
                for (int r = 0; r < 16; ++r) { p0[r] -= dl; p1[r] -= dl; }
#pragma unroll
                for (int r = 0; r < 16; ++r) negm[r] = -mhat;
                asm volatile("" : "+v"(negm));
                const float f = __builtin_amdgcn_exp2f(-dl); l_reg *= f; if (hi == 0) wsf[r32] = f; resc = true; } }
        float sacc = 0.f;
#pragma unroll
        for (int r = 0; r < 16; ++r) { p0[r] = __builtin_amdgcn_exp2f(p0[r]); p1[r] = __builtin_amdgcn_exp2f(p1[r]); sacc += p0[r] + p1[r]; }
        l_reg += sacc;
        u32x4 pw0, pw1, pw2, pw3;
        pw0 = (u32x4){cvt_pk_bf16(p0[0], p0[1]), cvt_pk_bf16(p0[2], p0[3]), cvt_pk_bf16(p0[4], p0[5]), cvt_pk_bf16(p0[6], p0[7])};
        pw1 = (u32x4){cvt_pk_bf16(p0[8], p0[9]), cvt_pk_bf16(p0[10], p0[11]), cvt_pk_bf16(p0[12], p0[13]), cvt_pk_bf16(p0[14], p0[15])};
        pw2 = (u32x4){cvt_pk_bf16(p1[0], p1[1]), cvt_pk_bf16(p1[2], p1[3]), cvt_pk_bf16(p1[4], p1[5]), cvt_pk_bf16(p1[6], p1[7])};
        pw3 = (u32x4){cvt_pk_bf16(p1[8], p1[9]), cvt_pk_bf16(p1[10], p1[11]), cvt_pk_bf16(p1[12], p1[13]), cvt_pk_bf16(p1[14], p1[15])};
        if (resc) {
#pragma unroll
            for (int d_ = 0; d_ < 2; ++d_)
#pragma unroll
                for (int r = 0; r < 16; ++r) o[d_][r] *= wsf[crow(r, hi)];
        }
        { const LAS unsigned char* vp = vp0 + s * VSLOT;
#pragma unroll
            for (int d0 = 0; d0 < 2; ++d0) {
                s16x4 lo[4], hh[4];
#pragma unroll
                for (int ks = 0; ks < 4; ++ks) { lo[ks] = vtr(vp + d0 * 4096 + ks * 1024); hh[ks] = vtr(vp + d0 * 4096 + ks * 1024 + 512); }
                __builtin_amdgcn_sched_barrier(0);
#define PKV(k) (bf16x8){lo[k][0], lo[k][1], lo[k][2], lo[k][3], hh[k][0], hh[k][1], hh[k][2], hh[k][3]}
                o[d0] = __builtin_amdgcn_mfma_f32_32x32x16_bf16(__builtin_bit_cast(bf16x8, pw0), PKV(0), o[d0], 0, 0, 0);
                o[d0] = __builtin_amdgcn_mfma_f32_32x32x16_bf16(__builtin_bit_cast(bf16x8, pw1), PKV(1), o[d0], 0, 0, 0);
                o[d0] = __builtin_amdgcn_mfma_f32_32x32x16_bf16(__builtin_bit_cast(bf16x8, pw2), PKV(2), o[d0], 0, 0, 0);
                o[d0] = __builtin_amdgcn_mfma_f32_32x32x16_bf16(__builtin_bit_cast(bf16x8, pw3), PKV(3), o[d0], 0, 0, 0);
#undef PKV
            } }
    }
    l_reg += __shfl_xor(l_reg, 32);
    if (hi == 0) wsf[32 + r32] = l_reg;
    float rli[16];
#pragma unroll
    for (int r = 0; r < 16; ++r) rli[r] = __builtin_amdgcn_rcpf(wsf[32 + crow(r, hi)]);
    unsigned char* Ow = (unsigned char*)Oh + (rowbase + q0 + wid * 32) * ldo;
    { LAS unsigned char* stg = shm + LDS_OST + wid * 2048;
#pragma unroll
        for (int r = 0; r < 16; ++r) { const int orow = crow(r, hi);
#pragma unroll
            for (int d0 = 0; d0 < 2; ++d0) stg[orow * 64 + d0 * 32 + r32] = (unsigned char)(pack4_fp8(o[d0][r] * rli[r], 0.f, 0.f, 0.f) & 0xffu); }
#pragma unroll
        for (int i = 0; i < 2; ++i) { const int row = i * 16 + (lane >> 2), ch = lane & 3; const u32x4 v = *(const LAS u32x4*)(stg + row * 64 + ch * 16); *(u32x4*)(Ow + (long)row * ldo + ch * 16) = v; } }
    asm volatile("s_waitcnt vmcnt(0) lgkmcnt(0)\n\ts_barrier" ::: "memory");
#undef ATT_DMA
#undef ATT_TILE
}
#undef MX3
}

#define XB_TMO      128
#define XB_XCNT(j)  (256  + 64 * (j))
#define XB_XSUB(j)  (1280 + 64 * (j))
#define XB_XGEN(j)  (2304 + 64 * (j))
#define XB_TOP      3328
#define XB_TOPGEN   3392
#define XCD_BAR_WORDS 3456
#define XB_SPIN_CAP (1u << 22)
__device__ __forceinline__ unsigned xb_ld(unsigned* p)              { return __hip_atomic_load(p, __ATOMIC_RELAXED, __HIP_MEMORY_SCOPE_AGENT); }
__device__ __forceinline__ unsigned xb_add(unsigned* p, unsigned v) { return __hip_atomic_fetch_add(p, v, __ATOMIC_RELAXED, __HIP_MEMORY_SCOPE_AGENT); }
__device__ __forceinline__ unsigned xb_xcc_id() { return (unsigned)__builtin_amdgcn_s_getreg((3 << 11) | 20) & 0xFu; }
#define XB_SPIN(cond, bar) do { unsigned _sp = 0; while (cond) { __builtin_amdgcn_s_sleep(1); \
    if ((++_sp & 255u) == 0u) { if (xb_ld(&(bar)[XB_TMO])) break; if (_sp > XB_SPIN_CAP) { atomicAdd(&(bar)[XB_TMO], 1u); break; } } } } while (0)
struct XcdBarrier { unsigned* bar; unsigned x; volatile LAS unsigned* st; int wave; };
__device__ __forceinline__ XcdBarrier xcd_barrier_post(unsigned* bar, volatile LAS unsigned* st, int wave) {
    XcdBarrier b; b.bar = bar; b.x = xb_xcc_id(); b.st = st; b.wave = wave;
    if (wave == 0 && lane_id() == 0) (void)xb_add(&bar[XB_XCNT(b.x)], 1u);
    return b;
}
__device__ __forceinline__ void xcd_barrier_complete(unsigned* bar, unsigned x, unsigned& nloc, unsigned& nx) {
    const unsigned G = gridDim.x * gridDim.y * gridDim.z;
    unsigned sum, cnt, mine, sp = 0u;
    for (;;) {
        sum = 0u; cnt = 0u; mine = 0u;
#pragma unroll
        for (unsigned j = 0; j < 16; ++j) { const unsigned c = xb_ld(&bar[XB_XCNT(j)]); sum += c; cnt += (c > 0u) ? 1u : 0u; mine = (j == x) ? c : mine; }
        if (sum == G) break;
        __builtin_amdgcn_s_sleep(1);
        if ((++sp & 255u) == 0u) { if (xb_ld(&bar[XB_TMO])) break; if (sp > XB_SPIN_CAP) { atomicAdd(&bar[XB_TMO], 1u); break; } }
    }
    nloc = mine > 0u ? mine : 1u; nx = cnt > 0u ? cnt : 1u;
}
__device__ __forceinline__ void xcd_barrier(const XcdBarrier& b) {
    asm volatile("s_waitcnt vmcnt(0)" ::: "memory");
    __syncthreads();
    if (b.wave == 0 && lane_id() == 0) {
        unsigned* bar = b.bar;
        __builtin_amdgcn_s_waitcnt(0);
        unsigned nloc = b.st[0], nx = b.st[1];
        if (nloc == 0u) { xcd_barrier_complete(bar, b.x, nloc, nx); b.st[0] = nloc; b.st[1] = nx; }
        const unsigned old = xb_add(&bar[XB_XSUB(b.x)], 1u);
        const unsigned gen = old / nloc;
        if (old + 1u == (gen + 1u) * nloc) {
            __builtin_amdgcn_fence(__ATOMIC_RELEASE, "agent");
            asm volatile("s_waitcnt vmcnt(0)" ::: "memory");
            const unsigned og = xb_add(&bar[XB_TOP], 1u);
            const unsigned tg = og / nx;
            if (og + 1u == (tg + 1u) * nx) xb_add(&bar[XB_TOPGEN], 1u);
            else XB_SPIN(xb_ld(&bar[XB_TOPGEN]) == tg, bar);
            __builtin_amdgcn_fence(__ATOMIC_ACQUIRE, "agent");
            xb_add(&bar[XB_XGEN(b.x)], 1u);
            asm volatile("s_waitcnt vmcnt(0)" ::: "memory");
        } else {
            XB_SPIN(xb_ld(&bar[XB_XGEN(b.x)]) == gen, bar);
            __builtin_amdgcn_fence(__ATOMIC_ACQUIRE, "agent");
            asm volatile("s_waitcnt vmcnt(0)" ::: "memory");
        }
    }
    __syncthreads();
}

struct Params { const float* in[25]; float* out; unsigned char* ws; int ph_lo, ph_hi; };
enum { I_X = 0, I_P, I_GMIX, I_WIN, I_MQN, I_MKN, I_QLATN, I_WUQ, I_KVLATN, I_WUKV, I_MLAQN, I_MLAKN, I_WA, I_WB, I_WO, I_GFFN, I_WR, I_BR, I_WGU, I_BGU, I_WD, I_BD, I_GPLE, I_WPG, I_WPP };
constexpr int NPHASE = 16;

struct Frame {
    LAS unsigned char* lds; int vcu, G, wave;
    const Params* P; unsigned char* ws;
};
struct Ids { int tid, lane, wave; };
#define PHASE_IDS() Ids I_; { int l_ = lane_id(); asm volatile("" : "+v"(l_)); I_.lane = l_; I_.wave = F.wave; I_.tid = F.wave * 64 + l_; }

#ifdef TPROBE_A
#define STAMP(k) do { if (blockIdx.x == 0 && F.wave == 0 && lane_id() == 0) ((volatile unsigned long long*)(ws + WS_ERR))[k] = __builtin_amdgcn_s_memrealtime(); } while (0)
#else
#define STAMP(k) do {} while (0)
#endif
__device__ __forceinline__ int rowmap(int mode, int c) {
    if (mode == 1) {
        if (c < 1024) { const int base = c & 512, s_ = c & 511, h = s_ >> 6, d = s_ & 63; return base + 256 * (h >> 2) + 128 * (d >> 5) + 32 * (h & 3) + (d & 31); }
        return c < 1952 ? c : c + 96; }
    if (mode == 2) return c < 1024 ? 256 * (c >> 7) + (c & 127) : 256 * ((c - 1024) >> 7) + 128 + ((c - 1024) & 127);
    if (mode == 3) {
        const int h = c / 96, d = c % 96; int t;
        if (d < 64) t = d; else if (d < 80) { const int i = d - 64; t = 64 + 8 * (i >> 2) + (i & 3); } else { const int i = d - 80; t = 64 + 8 * (i >> 2) + 4 + (i & 3); }
        return 128 * h + t; }
    return c;
}
__device__ __forceinline__ void tr_item64(const float* W, int ldw, int N, int k0, int n0, bf16_t* dst, int ldd, int mode, LAS float* scr, int lane) {
    const int r = lane >> 4, c4 = lane & 15; const bool inb = (n0 + 4 * c4) < N;
    f32x4 v[16];
#pragma unroll
    for (int i = 0; i < 16; ++i) v[i] = inb ? __builtin_nontemporal_load((const f32x4*)(W + (size_t)(k0 + 4 * i + r) * ldw + n0 + 4 * c4)) : (f32x4){0.f, 0.f, 0.f, 0.f};
#pragma unroll
    for (int i = 0; i < 16; ++i) { LAS float* p = scr + (4 * i + r) * 65 + 4 * c4; p[0] = v[i].x; p[1] = v[i].y; p[2] = v[i].z; p[3] = v[i].w; }
    asm volatile("s_waitcnt lgkmcnt(0)" ::: "memory");
    const int c = lane & 7;
#pragma unroll
    for (int j = 0; j < 8; ++j) { const int n = (lane >> 3) + 8 * j; const LAS float* sp = scr + (8 * c) * 65 + n;
        u32x4 o; o.x = cvt_pk_bf16(sp[0 * 65], sp[1 * 65]); o.y = cvt_pk_bf16(sp[2 * 65], sp[3 * 65]); o.z = cvt_pk_bf16(sp[4 * 65], sp[5 * 65]); o.w = cvt_pk_bf16(sp[6 * 65], sp[7 * 65]);
        if (n0 + n < N) *(u32x4*)(dst + (size_t)rowmap(mode, n0 + n) * ldd + k0 + 8 * c) = o; }
    asm volatile("s_waitcnt lgkmcnt(0)" ::: "memory");
}

__device__ __forceinline__ void tr_item_f8(const float* W, int ldw, int k0, int n0, unsigned char* dst, int ldd, int mode, LAS float* scr, int lane) {
    const int r = lane >> 3, c4 = lane & 7;
    f32x4 v[16];
#pragma unroll
    for (int i = 0; i < 16; ++i) v[i] = __builtin_nontemporal_load((const f32x4*)(W + (size_t)(k0 + 8 * i + r) * ldw + n0 + 4 * c4));
#pragma unroll
    for (int i = 0; i < 16; ++i) { LAS float* p = scr + (8 * i + r) * 33 + 4 * c4; p[0] = v[i].x * 64.f; p[1] = v[i].y * 64.f; p[2] = v[i].z * 64.f; p[3] = v[i].w * 64.f; }
    asm volatile("s_waitcnt lgkmcnt(0)" ::: "memory");
    const int c = lane & 7;
#pragma unroll
    for (int j = 0; j < 4; ++j) { const int n = (lane >> 3) + 8 * j; const LAS float* sp = scr + (16 * c) * 33 + n;
        u32x4 o; o.x = pack4_fp8(sp[0 * 33], sp[1 * 33], sp[2 * 33], sp[3 * 33]); o.y = pack4_fp8(sp[4 * 33], sp[5 * 33], sp[6 * 33], sp[7 * 33]);
        o.z = pack4_fp8(sp[8 * 33], sp[9 * 33], sp[10 * 33], sp[11 * 33]); o.w = pack4_fp8(sp[12 * 33], sp[13 * 33], sp[14 * 33], sp[15 * 33]);
        __builtin_nontemporal_store(o, (u32x4*)(dst + (size_t)rowmap(mode, n0 + n) * ldd + k0 + 16 * c)); }
    asm volatile("s_waitcnt lgkmcnt(0)" ::: "memory");
}

__device__ __forceinline__ void phase0(Frame& F) {
    PHASE_IDS();
    const Params& P = *F.P; unsigned char* ws = F.ws;
    LAS float* scr = (LAS float*)(F.lds + I_.wave * 16896);
    const int gw = F.vcu * NWAVES + I_.wave, NGW = F.G * NWAVES;
    constexpr int I_GU = 32 * 8 * 64, I_DN = 32 * 8 * 32, I_IN = 16 * 31, I_ING = 8 * 64, I_UQ = 4 * 12, I_UKV = 2 * 16, I_A = 8 * 16, I_O = 16 * 16, I_PP = 4 * 16;
    constexpr int I_PG = 8 * 32;
    constexpr int NITEMS = I_GU + I_DN + I_IN + I_ING + I_UQ + I_UKV + 2 * I_A + I_O + I_PG + I_PP;
    for (int it = gw; it < NITEMS; it += NGW) {
        int r = it;
        if (r < I_GU) { const int e = r >> 9, q = r & 511, kb = q >> 6, g = q & 63;
            tr_item_f8(P.in[I_WGU] + (size_t)e * 1024 * 2048, 2048, 128 * kb, 32 * g, ws + WS_W1 + (size_t)e * 2048 * 1024, 1024, 2, scr, I_.lane); continue; } r -= I_GU;
        if (r < I_DN) { const int e = r >> 8, q = r & 255, kb = q >> 5, g = q & 31;
            tr_item_f8(P.in[I_WD] + (size_t)e * 1024 * 1024, 1024, 128 * kb, 32 * g, ws + WS_W2 + (size_t)e * 1024 * 1024, 1024, 0, scr, I_.lane); continue; } r -= I_DN;
        if (r < I_IN) { const int kb = r / 31, g = r % 31; tr_item64(P.in[I_WIN], DIN, 1952, 64 * kb, 64 * g, (bf16_t*)(ws + WS_WIN), 1024, 1, scr, I_.lane); continue; } r -= I_IN;
        if (r < I_ING) { const int kb = r >> 6, g = r & 63; tr_item_f8(P.in[I_WIN] + 1952, DIN, 128 * kb, 32 * g, ws + WS_WINF8, 1024, 0, scr, I_.lane); continue; } r -= I_ING;
        if (r < I_UQ) { const int kb = r / 12, g = r % 12; tr_item64(P.in[I_WUQ], 768, 768, 64 * kb, 64 * g, (bf16_t*)(ws + WS_WUQ), 256, 3, scr, I_.lane); continue; } r -= I_UQ;
        if (r < I_UKV) { const int kb = r / 16, g = r % 16; tr_item64(P.in[I_WUKV], 1024, 1024, 64 * kb, 64 * g, (bf16_t*)(ws + WS_WUKV), 128, 0, scr, I_.lane); continue; } r -= I_UKV;
        if (r < I_A) { const int kb = r >> 5, g = r & 31; tr_item_f8(P.in[I_WA], 1024, 128 * kb, 32 * g, ws + WS_WA, 512, 0, scr, I_.lane); continue; } r -= I_A;
        if (r < I_A) { const int kb = r >> 5, g = r & 31; tr_item_f8(P.in[I_WB], 1024, 128 * kb, 32 * g, ws + WS_WB, 512, 0, scr, I_.lane); continue; } r -= I_A;
        if (r < I_PG) { const int kb = r >> 5, g = r & 31; tr_item_f8(P.in[I_WO], 1024, 128 * kb, 32 * g, ws + WS_WO, 1024, 0, scr, I_.lane); continue; } r -= I_PG;
        if (r < I_PG) { const int kb = r >> 5, g = r & 31; tr_item_f8(P.in[I_WPG], 1024, 128 * kb, 32 * g, ws + WS_WPG, 1024, 0, scr, I_.lane); continue; } r -= I_PG;
        { const int kb = r / 16, g = r % 16; tr_item64(P.in[I_WPP], 1024, 1024, 64 * kb, 64 * g, (bf16_t*)(ws + WS_WPP), 256, 0, scr, I_.lane); }
    }
    STAMP(20);
    { const f32x4* gp = (const f32x4*)P.in[I_GMIX] + I_.lane; f32x4 gv[4];
#pragma unroll
        for (int j = 0; j < 4; ++j) gv[j] = gp[64 * j];
        for (int m0 = gw * 4; m0 < NTOK; m0 += NGW * 4) { f32x4 v[4][4];
#pragma unroll
            for (int q = 0; q < 4; ++q) { const f32x4* xr = (const f32x4*)(P.in[I_X] + (size_t)(m0 + q) * DM) + I_.lane;
#pragma unroll
                for (int j = 0; j < 4; ++j) v[q][j] = xr[64 * j]; }
#pragma unroll
            for (int q = 0; q < 4; ++q) { float s = 0.f;
#pragma unroll
                for (int j = 0; j < 4; ++j) s += (v[q][j].x * v[q][j].x + v[q][j].y * v[q][j].y) + (v[q][j].z * v[q][j].z + v[q][j].w * v[q][j].w);
                const float rstd = 1.0f / sqrtf(wave_sum(s) * (1.f / DM) + EPS);
                u32x2* o8 = (u32x2*)((bf16_t*)(ws + WS_HN) + (size_t)(m0 + q) * DM) + I_.lane; unsigned* o4 = (unsigned*)(ws + WS_HNF8 + (size_t)(m0 + q) * DM) + I_.lane;
#pragma unroll
                for (int j = 0; j < 4; ++j) { const f32x4 y = v[q][j] * rstd * gv[j]; o8[64 * j] = (u32x2){cvt_pk_bf16(y.x, y.y), cvt_pk_bf16(y.z, y.w)}; o4[64 * j] = pack4_fp8(y.x, y.y, y.z, y.w); } } } }
    STAMP(21);
    { float* km = (float*)(ws + WS_KMEAN); for (int i = F.vcu * NTHREADS + I_.tid; i < 8 * 8 * 8 * 64; i += F.G * NTHREADS) km[i] = 0.f; }
    { const size_t n4 = (size_t)NTOK * 256 / 4; const f32x4* pp = (const f32x4*)P.in[I_P]; u32x2* po = (u32x2*)(ws + WS_PB); const size_t T = (size_t)F.G * NTHREADS;
        for (size_t i = (size_t)F.vcu * NTHREADS + I_.tid; i < n4; i += 4 * T) { f32x4 v[4];
#pragma unroll
            for (int q = 0; q < 4; ++q) v[q] = __builtin_nontemporal_load(pp + i + q * T);
#pragma unroll
            for (int q = 0; q < 4; ++q) po[i + q * T] = (u32x2){cvt_pk_bf16(v[q].x, v[q].y), cvt_pk_bf16(v[q].z, v[q].w)}; } }
    STAMP(22);
    { float* tab = (float*)(ws + WS_ROPE);
        for (int i = F.vcu * NTHREADS + I_.tid; i < 2048 * 48; i += F.G * NTHREADS) {
            int pos, j, half; float* cdst; float* sdst;
            if (i < 2048 * 32) { pos = i / 32; j = i % 32; half = 32; cdst = tab + i; sdst = tab + 65536 + i; }
            else { const int q = i - 2048 * 32; pos = q / 16; j = q % 16; half = 16; cdst = tab + 131072 + q; sdst = tab + 131072 + 32768 + q; }
            const float inv = powf(10000.0f, -((float)j / (float)half)); const float ang = (float)pos * inv;
            *cdst = cosf(ang); *sdst = sinf(ang); } }
}

__device__ __forceinline__ void phase2(Frame& F) {
    PHASE_IDS();
    const Params& P = *F.P; unsigned char* ws = F.ws;
    const bf16_t* PROJ = (const bf16_t*)(ws + WS_PROJ);
    const float* cosA = (const float*)(ws + WS_ROPE); const float* sinA = cosA + 65536;
    LAS float* kst = (LAS float*)F.lds;
    LAS float* part = kst + 256 * 68;
    for (int it = F.vcu; it < 512; it += F.G) {
        const int b = it >> 6, blk = (it >> 3) & 7, h = it & 7;
        const int sel = I_.lane >> 5, r = I_.wave * 32 + (I_.lane & 31); const int pos = blk * 256 + r; const size_t row = (size_t)b * SEQ + pos;
        const u32x4* src = (const u32x4*)(PROJ + row * DINP + (sel ? PC_KA : PC_QA) + h * 64);
        u32x4 raw[8];
#pragma unroll
        for (int c = 0; c < 8; ++c) raw[c] = src[c];
        float ss = 0.f;
#pragma unroll
        for (int c = 0; c < 8; ++c) { f32x4 a0, a1; pg8::unpack8(raw[c], a0, a1); ss += (a0[0] * a0[0] + a0[1] * a0[1]) + (a0[2] * a0[2] + a0[3] * a0[3]) + (a1[0] * a1[0] + a1[1] * a1[1]) + (a1[2] * a1[2] + a1[3] * a1[3]); }
        const float rstd = 1.0f / sqrtf(ss * (1.f / 64.f) + EPS);
        const float* gn = sel ? P.in[I_MKN] : P.in[I_MQN];
        const float sc = sel ? 1.0f : C2A;
        bf16_t* dst = (bf16_t*)(ws + (sel ? WS_KA2 : WS_QA2)) + row * 512 + h * 64;
#pragma unroll
        for (int c = 0; c < 4; ++c) { f32x4 x1a, x1b, x2a, x2b; pg8::unpack8(raw[c], x1a, x1b); pg8::unpack8(raw[c + 4], x2a, x2b);
            const f32x4 g1a = *(const f32x4*)(gn + 8 * c), g1b = *(const f32x4*)(gn + 8 * c + 4), g2a = *(const f32x4*)(gn + 32 + 8 * c), g2b = *(const f32x4*)(gn + 36 + 8 * c);
            x1a = x1a * g1a * rstd; x1b = x1b * g1b * rstd; x2a = x2a * g2a * rstd; x2b = x2b * g2b * rstd;
            const f32x4 ca = *(const f32x4*)(cosA + pos * 32 + 8 * c), cb = *(const f32x4*)(cosA + pos * 32 + 8 * c + 4), sa = *(const f32x4*)(sinA + pos * 32 + 8 * c), sb = *(const f32x4*)(sinA + pos * 32 + 8 * c + 4);
            const f32x4 y1a = x1a * ca - x2a * sa, y1b = x1b * cb - x2b * sb, y2a = x2a * ca + x1a * sa, y2b = x2b * cb + x1b * sb;
            *(u32x4*)(dst + 8 * c) = pg8::pack8(y1a * sc, y1b * sc); *(u32x4*)(dst + 32 + 8 * c) = pg8::pack8(y2a * sc, y2b * sc);
            if (sel) { LAS f32x4* kr = (LAS f32x4*)(kst + r * 68); kr[2 * c] = y1a; kr[2 * c + 1] = y1b; kr[8 + 2 * c] = y2a; kr[8 + 2 * c + 1] = y2b; } }
        __syncthreads();
        { const int d = I_.tid & 63, pt = I_.tid >> 6; float s = 0.f;
#pragma unroll 8
            for (int rr = 0; rr < 32; ++rr) s += kst[(pt * 32 + rr) * 68 + d];
            part[pt * 64 + d] = s; }
        __syncthreads();
        if (I_.tid < 64) { float s = 0.f;
#pragma unroll
            for (int pt = 0; pt < 8; ++pt) s += part[pt * 64 + I_.tid];
            ((float*)(ws + WS_KMEAN))[(((size_t)b * 8 + h) * 8 + blk) * 64 + I_.tid] = s * (1.f / 256.f); }
        __syncthreads();
    }
    const int gw = F.vcu * NWAVES + I_.wave, NGW = F.G * NWAVES;
    const f32x4 gq = ((const f32x4*)P.in[I_QLATN])[I_.lane]; const f32x2 gk = ((const f32x2*)P.in[I_KVLATN])[I_.lane];
    for (int m0 = gw * 8; m0 < NTOK; m0 += NGW * 8) {
        u32x2 wq[8]; unsigned wk[8];
#pragma unroll
        for (int q = 0; q < 8; ++q) { wq[q] = *((const u32x2*)(PROJ + (size_t)(m0 + q) * DINP + PC_CQ) + I_.lane); wk[q] = *((const unsigned*)(PROJ + (size_t)(m0 + q) * DINP + PC_CKV) + I_.lane); }
#pragma unroll
        for (int r = 0; r < 8; ++r) { const int m = m0 + r;
            const f32x4 q = {bflo(wq[r].x), bfhi(wq[r].x), bflo(wq[r].y), bfhi(wq[r].y)}; const f32x2 k = {bflo(wk[r]), bfhi(wk[r])};
            const float sq = wave_sum((q.x * q.x + q.y * q.y) + (q.z * q.z + q.w * q.w)), sk = wave_sum(k.x * k.x + k.y * k.y);
            const float rq = 1.0f / sqrtf(sq * (1.f / 256.f) + EPS), rk = 1.0f / sqrtf(sk * (1.f / 128.f) + EPS);
            const f32x4 yq = q * rq * gq; const f32x2 yk = k * rk * gk;
            *((u32x2*)((bf16_t*)(ws + WS_CQN) + (size_t)m * 256) + I_.lane) = (u32x2){cvt_pk_bf16(yq.x, yq.y), cvt_pk_bf16(yq.z, yq.w)};
            *((unsigned*)((bf16_t*)(ws + WS_CKVN) + (size_t)m * 128) + I_.lane) = cvt_pk_bf16(yk.x, yk.y); }
    }
}

__device__ __forceinline__ void phase4(Frame& F) {
    PHASE_IDS();
    const Params& P = *F.P; unsigned char* ws = F.ws;
    const bf16_t* PROJ = (const bf16_t*)(ws + WS_PROJ);
    const float* cosB = (const float*)(ws + WS_ROPE) + 131072; const float* sinB = cosB + 32768;
    const int gw = F.vcu * NWAVES + I_.wave, NGW = F.G * NWAVES;
    for (int it = gw; it < (NTOK / 64) * 16; it += NGW) {
        const int h = it & 7, sel = (it >> 3) & 1, rg = it >> 4; const size_t row = (size_t)rg * 64 + I_.lane; const int pos = (int)(row & (SEQ - 1));
        u32x4 raw[12];
        bf16_t* qrow = (bf16_t*)(ws + WS_QB) + row * 768 + h * 96;
        if (sel == 0) {
#pragma unroll
            for (int c = 0; c < 12; ++c) raw[c] = *(const u32x4*)(qrow + 8 * c);
        } else {
            const bf16_t* kn = (const bf16_t*)(ws + WS_KV) + row * 1024 + h * 128; const bf16_t* kp = PROJ + row * DINP + PC_KPE;
#pragma unroll
            for (int c = 0; c < 8; ++c) raw[c] = *(const u32x4*)(kn + 8 * c);
#pragma unroll
            for (int c = 0; c < 4; ++c) raw[8 + c] = *(const u32x4*)(kp + 8 * c);
        }
        float ss = 0.f;
#pragma unroll
        for (int c = 0; c < 12; ++c) { f32x4 a0, a1; pg8::unpack8(raw[c], a0, a1); ss += (a0[0] * a0[0] + a0[1] * a0[1]) + (a0[2] * a0[2] + a0[3] * a0[3]) + (a1[0] * a1[0] + a1[1] * a1[1]) + (a1[2] * a1[2] + a1[3] * a1[3]); }
        const float rstd = 1.0f / sqrtf(ss * (1.f / 96.f) + EPS);
        const float* gn = sel ? P.in[I_MLAKN] : P.in[I_MLAQN];
        const float sc = sel ? 1.0f : C2B; const float rs = rstd * sc;
        bf16_t* dst = sel ? (bf16_t*)(ws + WS_KB2) + row * 768 + h * 96 : qrow;
#pragma unroll
        for (int c = 0; c < 8; ++c) { f32x4 a0, a1; pg8::unpack8(raw[c], a0, a1); const f32x4 g0 = *(const f32x4*)(gn + 8 * c), g1 = *(const f32x4*)(gn + 8 * c + 4);
            *(u32x4*)(dst + 8 * c) = pg8::pack8(a0 * g0 * rs, a1 * g1 * rs); }
#pragma unroll
        for (int c = 0; c < 2; ++c) { f32x4 x1a, x1b, x2a, x2b; pg8::unpack8(raw[8 + c], x1a, x1b); pg8::unpack8(raw[10 + c], x2a, x2b);
            const f32x4 g1a = *(const f32x4*)(gn + 64 + 8 * c), g1b = *(const f32x4*)(gn + 68 + 8 * c), g2a = *(const f32x4*)(gn + 80 + 8 * c), g2b = *(const f32x4*)(gn + 84 + 8 * c);
            x1a = x1a * g1a * rs; x1b = x1b * g1b * rs; x2a = x2a * g2a * rs; x2b = x2b * g2b * rs;
            const f32x4 ca = *(const f32x4*)(cosB + pos * 16 + 8 * c), cb = *(const f32x4*)(cosB + pos * 16 + 8 * c + 4), sa = *(const f32x4*)(sinB + pos * 16 + 8 * c), sb = *(const f32x4*)(sinB + pos * 16 + 8 * c + 4);
            *(u32x4*)(dst + 64 + 8 * c) = pg8::pack8(x1a * ca - x2a * sa, x1b * cb - x2b * sb);
            *(u32x4*)(dst + 80 + 8 * c) = pg8::pack8(x2a * ca + x1a * sa, x2b * cb + x1b * sb); }
    }
}

__device__ __forceinline__ void phase5(Frame& F) {
    unsigned char* ws = F.ws;
    for (int it = F.vcu; it < 256; it += F.G) {
        const int bh = it >> 2, sidx = it & 3, b = bh >> 3, h = bh & 7;
#pragma unroll 1
        for (int k = 0; k < 2; ++k) { const int qb = k ? 7 - sidx : sidx;
            att::attn_unit<64, true>(b, qb, (const bf16_t*)(ws + WS_QA2) + h * 64, 512, (const bf16_t*)(ws + WS_KA2) + h * 64, 512, (const bf16_t*)(ws + WS_PROJ) + PC_VA + h * 64, DINP,
                                     ws + WS_Y + h * 64, 1024, (const float*)(ws + WS_KMEAN) + (size_t)bh * 512, F.lds, F.wave); }
#pragma unroll 1
        for (int k = 0; k < 2; ++k) { const int qb = k ? 7 - sidx : sidx;
            att::attn_unit<96, false>(b, qb, (const bf16_t*)(ws + WS_QB) + h * 96, 768, (const bf16_t*)(ws + WS_KB2) + h * 96, 768, (const bf16_t*)(ws + WS_KV) + h * 128 + 64, 1024,
                                      ws + WS_Y + 512 + h * 64, 1024, nullptr, F.lds, F.wave); }
    }
}

__device__ __forceinline__ void phase8(Frame& F) {
    PHASE_IDS();
    const Params& P = *F.P; unsigned char* ws = F.ws;
    constexpr int HCS = 132, WCS = 48;
    LAS float* HC = (LAS float*)F.lds;
    LAS float* WC = HC + 2 * 64 * HCS;
    LAS float* RSTD = WC + 2 * 128 * WCS;
    LAS float* LOGIT = RSTD + 64;
    LAS int* pe = (LAS int*)(LOGIT + 64 * 33);
    int* PAIR_E = (int*)(ws + WS_PAIR); int* PAIR_RANK = PAIR_E + 65536; float* PAIR_W = (float*)(PAIR_E + 131072);
    const float* gffn = P.in[I_GFFN]; const float* wr_ = P.in[I_WR]; const float* br_ = P.in[I_BR];
    const int r0 = F.vcu * 64;
    if (I_.tid < 64) { const f32x4* sp = (const f32x4*)((const float*)(ws + WS_SSP) + (size_t)(r0 + I_.tid) * 16); const f32x4 a = sp[0], b = sp[1], c = sp[2], d = sp[3];
        const float ss = (((a[0] + a[1]) + (a[2] + a[3])) + ((b[0] + b[1]) + (b[2] + b[3]))) + (((c[0] + c[1]) + (c[2] + c[3])) + ((d[0] + d[1]) + (d[2] + d[3])));
        RSTD[I_.tid] = 1.0f / sqrtf(ss * (1.f / DM) + EPS); }
    __syncthreads();
    const int eg = I_.wave & 1, rgp = I_.wave >> 1, l15 = I_.lane & 15, l4 = I_.lane >> 4;
    const int srow = I_.tid >> 5, sc4 = I_.tid & 31;
    const int wrow = I_.tid >> 3, wc4 = I_.tid & 7;
    f32x4 stg[4], wst[2];
#define P8_LOAD(kc) do { _Pragma("unroll") for (int i = 0; i < 4; ++i) stg[i] = *(const f32x4*)(P.out + (size_t)(r0 + srow + 16 * i) * DM + (kc) * 128 + 4 * sc4); \
        _Pragma("unroll") for (int i = 0; i < 2; ++i) wst[i] = *(const f32x4*)(wr_ + (size_t)((kc) * 128 + wrow + 64 * i) * 32 + 4 * wc4); } while (0)
#define P8_STORE(kc, buf) do { const f32x4 g4 = *(const f32x4*)(gffn + (kc) * 128 + 4 * sc4); _Pragma("unroll") for (int i = 0; i < 4; ++i) { const float rs = RSTD[srow + 16 * i]; const f32x4 y = stg[i] * rs * g4; \
        *(LAS f32x4*)(HC + ((buf) * 64 + srow + 16 * i) * HCS + 4 * sc4) = y; *(unsigned*)(ws + WS_HNF8 + (size_t)(r0 + srow + 16 * i) * DM + (kc) * 128 + 4 * sc4) = pack4_fp8(y.x, y.y, y.z, y.w); } \
        _Pragma("unroll") for (int i = 0; i < 2; ++i) *(LAS f32x4*)(WC + ((buf) * 128 + wrow + 64 * i) * WCS + 4 * wc4) = wst[i]; } while (0)
    P8_LOAD(0); P8_STORE(0, 0);
    __syncthreads();
    f32x4 acc = {0.f, 0.f, 0.f, 0.f};
#pragma unroll 1
    for (int kc = 0; kc < 8; ++kc) { const int buf = kc & 1;
        if (kc + 1 < 8) P8_LOAD(kc + 1);
        const LAS float* wp = WC + (buf * 128 + l4) * WCS + eg * 16 + l15;
        const LAS float* hp = HC + (buf * 64 + rgp * 16 + l15) * HCS + l4;
#pragma unroll
        for (int kk = 0; kk < 32; ++kk) acc = __builtin_amdgcn_mfma_f32_16x16x4f32(wp[4 * kk * WCS], hp[4 * kk], acc, 0, 0, 0);
        if (kc + 1 < 8) P8_STORE(kc + 1, buf ^ 1);
        __syncthreads(); }
#undef P8_LOAD
#undef P8_STORE
#pragma unroll
    for (int i = 0; i < 4; ++i) { const int e = eg * 16 + 4 * l4 + i; LOGIT[(rgp * 16 + l15) * 33 + e] = acc[i] + br_[e]; }
    __syncthreads();
    if (I_.tid < 64) { const int rr = I_.tid, m = r0 + rr;
        float lg[32];
#pragma unroll
        for (int e = 0; e < 32; ++e) lg[e] = LOGIT[rr * 33 + e];
        int te[4]; float tv[4]; unsigned used = 0u;
#pragma unroll
        for (int k = 0; k < 4; ++k) { float best = -INFINITY; int bi = 0;
#pragma unroll
            for (int e = 0; e < 32; ++e) { const bool ok = !((used >> e) & 1u) && (lg[e] > best); best = ok ? lg[e] : best; bi = ok ? e : bi; }
            used |= 1u << bi; te[k] = bi; tv[k] = best; }
        const float e0 = 1.0f, e1 = __expf(tv[1] - tv[0]), e2 = __expf(tv[2] - tv[0]), e3 = __expf(tv[3] - tv[0]); const float inv = 1.0f / (e0 + e1 + e2 + e3);
        *(i32x4*)(PAIR_E + m * 4) = (i32x4){te[0], te[1], te[2], te[3]};
        *(f32x4*)(PAIR_W + m * 4) = (f32x4){e0 * inv, e1 * inv, e2 * inv, e3 * inv};
        *(LAS i32x4*)(pe + rr * 4) = (i32x4){te[0], te[1], te[2], te[3]}; }
    __syncthreads();
    if (I_.tid < 256) { const int e = pe[I_.tid]; int rank = 0;
#pragma unroll 16
        for (int j4 = 0; j4 < 64; ++j4) { const i32x4 v = *(const LAS i32x4*)(pe + 4 * j4); const int j = 4 * j4;
            rank += ((j < I_.tid) && v.x == e) + ((j + 1 < I_.tid) && v.y == e) + ((j + 2 < I_.tid) && v.z == e) + ((j + 3 < I_.tid) && v.w == e); }
        PAIR_RANK[r0 * 4 + I_.tid] = rank; }
    else if (I_.tid < 288) { const int e = I_.tid - 256; int c = 0;
#pragma unroll 16
        for (int j4 = 0; j4 < 64; ++j4) { const i32x4 v = *(const LAS i32x4*)(pe + 4 * j4); c += (v.x == e) + (v.y == e) + (v.z == e) + (v.w == e); }
        ((int*)(ws + WS_HIST))[F.vcu * 32 + e] = c; }
    __syncthreads();
}

__device__ __forceinline__ int moe_layout(Frame& F) {
    PHASE_IDS();
    LAS int* ctl = (LAS int*)(F.lds + LDS_CTL);
    LAS int* part = ctl + 512;
    const int* HIST = (const int*)(F.ws + WS_HIST);
    __syncthreads();
    { const int e = I_.tid & 31, pt = I_.tid >> 5; int tot = 0, before = 0; int c[16];
#pragma unroll
        for (int i = 0; i < 16; ++i) c[i] = HIST[(pt * 16 + i) * 32 + e];
#pragma unroll
        for (int i = 0; i < 16; ++i) { tot += c[i]; before += (pt * 16 + i < F.vcu) ? c[i] : 0; }
        part[pt * 64 + e] = tot; part[pt * 64 + 32 + e] = before; }
    __syncthreads();
    if (I_.tid < 32) { int tot = 0, before = 0;
#pragma unroll
        for (int pt = 0; pt < 16; ++pt) { tot += part[pt * 64 + I_.tid]; before += part[pt * 64 + 32 + I_.tid]; }
        ctl[I_.tid] = tot; ctl[65 + I_.tid] = before; }
    __syncthreads();
    if (I_.tid == 0) { int row = 0, mt = 0;
        for (int e = 0; e < 32; ++e) { ctl[32 + e] = row; ctl[65 + e] += row; const int nt_ = (ctl[e] + 255) >> 8;
            for (int t = 0; t < nt_; ++t) ctl[128 + mt + t] = e;
            mt += nt_; row += nt_ * 256; }
        ctl[64] = row; ctl[100] = mt; }
    __syncthreads();
    return ctl[100];
}

__device__ __forceinline__ void phase9(Frame& F) {
    PHASE_IDS();
    unsigned char* ws = F.ws;
    moe_layout(F);
    LAS int* ctl = (LAS int*)(F.lds + LDS_CTL);
    const int* PAIR_E = (const int*)(ws + WS_PAIR); const int* PAIR_RANK = PAIR_E + 65536; int* ROWDEST = (int*)(ws + WS_PAIR) + 196608; int* TOK = (int*)(ws + WS_TOK);
    const int rows_per_blk = NTOK / F.G;
    if (I_.tid < rows_per_blk * 4) { const int gp = F.vcu * rows_per_blk * 4 + I_.tid;
        const int e = PAIR_E[gp], rk = PAIR_RANK[gp]; const int dest = ctl[65 + e] + rk;
        ROWDEST[gp] = dest; TOK[dest] = gp >> 2; }
    if (F.vcu < 32) { const int e = F.vcu; const int lo = ctl[32 + e] + ctl[e], hi = (e == 31) ? ctl[64] : ctl[33 + e];
        for (int r = lo + I_.tid; r < hi; r += NTHREADS) TOK[r] = 0; }
}

__device__ __forceinline__ void stage_tok(Frame& F, int nmt, int ntn) {
    PHASE_IDS();
    const int* TOK = (const int*)(F.ws + WS_TOK); LAS unsigned short* tokl = (LAS unsigned short*)(F.lds + LDS_TOKL);
    for (int i = 0; i < 10; ++i) { const int j = (i * F.G + (int)blockIdx.x) >> 3; const int mt = (j / ntn) * 8 + ((int)blockIdx.x & 7); if (mt >= nmt) break;
        if (I_.tid < 256) tokl[i * 256 + I_.tid] = (unsigned short)TOK[mt * 256 + I_.tid]; }
    __syncthreads();
}

__device__ __forceinline__ void phase12(Frame& F) {
    PHASE_IDS();
    const Params& P = *F.P; unsigned char* ws = F.ws;
    const int gw = F.vcu * NWAVES + I_.wave, NGW = F.G * NWAVES;
    const float* PAIR_W = (const float*)(ws + WS_PAIR) + 131072; const int* ROWDEST = (const int*)(ws + WS_PAIR) + 196608;
    const bf16_t* YP = (const bf16_t*)(ws + WS_XG);
    const f32x4* gp = (const f32x4*)P.in[I_GPLE] + I_.lane; f32x4 gv[4];
#pragma unroll
    for (int j = 0; j < 4; ++j) gv[j] = gp[64 * j];
    for (int m0 = gw; m0 < NTOK; m0 += 2 * NGW) {
        int mm[2]; mm[0] = m0; mm[1] = (m0 + NGW < NTOK) ? m0 + NGW : m0;
        f32x4 wv[2]; i32x4 dv[2];
#pragma unroll
        for (int q = 0; q < 2; ++q) { wv[q] = *(const f32x4*)(PAIR_W + mm[q] * 4); dv[q] = *(const i32x4*)(ROWDEST + mm[q] * 4); }
        f32x4 v[2][4]; u32x2 y[2][4][4];
#pragma unroll
        for (int q = 0; q < 2; ++q) { const f32x4* xr = (const f32x4*)(P.out + (size_t)mm[q] * DM) + I_.lane;
#pragma unroll
            for (int j = 0; j < 4; ++j) v[q][j] = xr[64 * j];
#pragma unroll
            for (int k = 0; k < 4; ++k) { const u32x2* yr = (const u32x2*)(YP + (size_t)dv[q][k] * DM) + I_.lane;
#pragma unroll
                for (int j = 0; j < 4; ++j) y[q][k][j] = yr[64 * j]; } }
#pragma unroll
        for (int q = 0; q < 2; ++q) { if (q == 1 && mm[1] == mm[0]) break;
            float s = 0.f; f32x4* xw = (f32x4*)(P.out + (size_t)mm[q] * DM) + I_.lane;
#pragma unroll
            for (int j = 0; j < 4; ++j) {
#pragma unroll
                for (int k = 0; k < 4; ++k) { const u32x2 yy = y[q][k][j]; v[q][j] += (f32x4){bflo(yy.x), bfhi(yy.x), bflo(yy.y), bfhi(yy.y)} * wv[q][k]; }
                xw[64 * j] = v[q][j]; s += (v[q][j].x * v[q][j].x + v[q][j].y * v[q][j].y) + (v[q][j].z * v[q][j].z + v[q][j].w * v[q][j].w); }
            const float rstd = 1.0f / sqrtf(wave_sum(s) * (1.f / DM) + EPS);
            unsigned* o4 = (unsigned*)(ws + WS_HNF8 + (size_t)mm[q] * DM) + I_.lane;
#pragma unroll
            for (int j = 0; j < 4; ++j) { const f32x4 yo = v[q][j] * rstd * gv[j]; o4[64 * j] = pack4_fp8(yo.x, yo.y, yo.z, yo.w); } }
    }
}

__global__ void __launch_bounds__(NTHREADS, 2) fwd(Params prm) {
    extern __shared__ __attribute__((aligned(16))) unsigned char lds_raw[];
    Frame F;
    F.lds = (LAS unsigned char*)lds_raw;
    F.wave = __builtin_amdgcn_readfirstlane((int)threadIdx.x >> 6);
    if (threadIdx.x < 2) ((volatile LAS unsigned*)(F.lds + LDS_BARST))[threadIdx.x] = 0u;
    const XcdBarrier bar = xcd_barrier_post((unsigned*)(prm.ws + WS_BAR), (volatile LAS unsigned*)(F.lds + LDS_BARST), F.wave);
    if (prm.ph_lo < 0) cg::this_grid().sync();
    __syncthreads();
    F.G = gridDim.x; { const int bx = blockIdx.x; F.vcu = (F.G % 8 == 0) ? (bx % 8) * (F.G / 8) + bx / 8 : bx; }
    F.P = &prm; F.ws = prm.ws;
    unsigned char* ws = prm.ws;
    const int lo = prm.ph_lo, hi = prm.ph_hi;
#ifndef PH_MASK
#define PH_MASK 0xffffu
#endif
#ifndef REP_MASK
#define REP_MASK 0u
#endif
#define IN(k) (((PH_MASK >> (k)) & 1u) && lo <= (k) && (k) < hi)
#define REPS(k) for (int rep_ = 0; rep_ < (((REP_MASK >> (k)) & 1u) ? 2 : 1); ++rep_, (((REP_MASK >> (k)) & 1u) && rep_ < 2 ? xcd_barrier(bar) : (void)0))
#define SEAM(k) do { __builtin_amdgcn_sched_barrier(0); asm volatile("" ::: "memory"); if (IN(k) && IN((k) + 1)) xcd_barrier(bar); STAMP((k) + 1); __builtin_amdgcn_sched_barrier(0); asm volatile("" ::: "memory"); } while (0)
    using namespace pg8;
    STAMP(0);
    if (IN(0)) REPS(0) phase0(F);
    SEAM(0);
    if (IN(1)) REPS(1) {
        { Gemm g{(const bf16_t*)(ws + WS_HN), (const bf16_t*)(ws + WS_WIN), DM, DM, DM}; StaticOrder S; S.init(NTOK, 2048, F.G, (int)blockIdx.x);
          const float* cosA_ = (const float*)(ws + WS_ROPE);
          EpiProj E{(bf16_t*)(ws + WS_PROJ), (bf16_t*)(ws + WS_QA2), (bf16_t*)(ws + WS_KA2), (float*)(ws + WS_KMEAN), (bf16_t*)(ws + WS_CQN), (bf16_t*)(ws + WS_CKVN),
                    prm.in[I_MQN], prm.in[I_MKN], prm.in[I_QLATN], prm.in[I_KVLATN], cosA_, cosA_ + 65536, (LAS float*)(F.lds + LDS_TOKL), (float*)(ws + WS_KPESS)};
          gemm_phase(F.lds, F.wave, g, S, E); }
        __builtin_amdgcn_sched_barrier(0); asm volatile("" ::: "memory");
        { Gemm g{(const bf16_t*)(ws + WS_HNF8), (const bf16_t*)(ws + WS_WINF8), 512, 512, 512}; StaticOrder S; S.init(NTOK, 2048, F.G, (int)blockIdx.x);
          EpiStore E{(bf16_t*)(ws + WS_PROJ) + PC_GA, DINP, nullptr, 0, 0}; gemm_phase<EpiStore, StaticOrder, false, true>(F.lds, F.wave, g, S, E); } }
    SEAM(1);
    if (IN(3)) REPS(3) {
        const float* cosB_ = (const float*)(ws + WS_ROPE) + 131072;
        { Gemm g{(const bf16_t*)(ws + WS_CQN), (const bf16_t*)(ws + WS_WUQ), 256, 256, 256}; StaticOrder S; S.init(NTOK, 1024, F.G, (int)blockIdx.x);
          EpiQB E{(bf16_t*)(ws + WS_QB), prm.in[I_MLAQN], cosB_, cosB_ + 32768, (LAS float*)(F.lds + LDS_CTL)}; gemm_phase(F.lds, F.wave, g, S, E); }
        __builtin_amdgcn_sched_barrier(0); asm volatile("" ::: "memory");
        { Gemm g{(const bf16_t*)(ws + WS_CKVN), (const bf16_t*)(ws + WS_WUKV), 128, 128, 128}; StaticOrder S; S.init(NTOK, 1024, F.G, (int)blockIdx.x);
          EpiKV E{(bf16_t*)(ws + WS_KB2), (bf16_t*)(ws + WS_KV), (const bf16_t*)(ws + WS_PROJ), (const float*)(ws + WS_KPESS), prm.in[I_MLAKN], cosB_, cosB_ + 32768, (LAS float*)(F.lds + LDS_CTL)};
          gemm_phase(F.lds, F.wave, g, S, E); } }
    SEAM(3);
    if (IN(5)) REPS(5) phase5(F);
    SEAM(5);
    if (IN(6)) REPS(6) { Gemm g{(const bf16_t*)(ws + WS_Y), (const bf16_t*)(ws + WS_WA), 512, 256, 256}; StaticOrder S; S.init(NTOK, DM, F.G, (int)blockIdx.x);
        EpiGate<false> E{(bf16_t*)(ws + WS_MERGED), (const bf16_t*)(ws + WS_PROJ) + PC_GA, DINP, nullptr}; gemm_phase<EpiGate<false>, StaticOrder, false, true>(F.lds, F.wave, g, S, E); }
    __builtin_amdgcn_sched_barrier(0); asm volatile("s_waitcnt vmcnt(0)" ::: "memory"); __syncthreads();
    if (IN(7)) REPS(7) { Gemm g{(const bf16_t*)(ws + WS_Y + 512), (const bf16_t*)(ws + WS_WB), 512, 256, 256}; StaticOrder S; S.init(NTOK, DM, F.G, (int)blockIdx.x);
        EpiGate<true> E{(bf16_t*)(ws + WS_MERGED), (const bf16_t*)(ws + WS_PROJ) + PC_GB, DINP, ws + WS_KA2  }; gemm_phase<EpiGate<true>, StaticOrder, false, true>(F.lds, F.wave, g, S, E); }
    SEAM(7);
    if (IN(8)) REPS(8) { Gemm g{(const bf16_t*)(ws + WS_KA2), (const bf16_t*)(ws + WS_WO), 512, 512, 512}; StaticOrder S; S.init(NTOK, DM, F.G, (int)blockIdx.x);
        EpiResF32 E{prm.in[I_X], prm.out, (float*)(ws + WS_SSP)}; gemm_phase<EpiResF32, StaticOrder, false, true>(F.lds, F.wave, g, S, E); }
    SEAM(8);
    if (IN(9)) REPS(9) phase8(F);
    SEAM(9);
    if (IN(10)) REPS(10) phase9(F);
    SEAM(10);
    if (IN(11)) REPS(11) { const int nmt = ((const LAS int*)(F.lds + LDS_CTL))[100]; stage_tok(F, nmt, 8);
        Gemm g{(const bf16_t*)(ws + WS_HNF8), (const bf16_t*)(ws + WS_W1), 512, 512, 512}; MoeOrder S{(const LAS int*)(F.lds + LDS_CTL) + 128, nmt, 8, F.G, (int)blockIdx.x};
        EpiSwiglu E{ws + WS_ACT, prm.in[I_BGU]}; gemm_phase<EpiSwiglu, MoeOrder, true, true>(F.lds, F.wave, g, S, E, (const LAS unsigned short*)(F.lds + LDS_TOKL)); }
    SEAM(11);
    if (IN(12)) REPS(12) { const int nmt = ((const LAS int*)(F.lds + LDS_CTL))[100];
        Gemm g{(const bf16_t*)(ws + WS_ACT), (const bf16_t*)(ws + WS_W2), 512, 512, 512}; MoeOrder S{(const LAS int*)(F.lds + LDS_CTL) + 128, nmt, 4, F.G, (int)blockIdx.x};
        EpiStore E{(bf16_t*)(ws + WS_XG), DM, prm.in[I_BD], 1024, 1 << 30}; gemm_phase<EpiStore, MoeOrder, false, true>(F.lds, F.wave, g, S, E); }
    SEAM(12);
    if (IN(13)) REPS(13) phase12(F);
    SEAM(13);
    if (IN(14)) REPS(14) { Gemm g{(const bf16_t*)(ws + WS_PB), (const bf16_t*)(ws + WS_WPP), 256, 256, 256}; StaticOrder S; S.init(NTOK, DM, F.G, (int)blockIdx.x);
        EpiStore E{(bf16_t*)(ws + WS_PP), DM, nullptr, 0, 1 << 30}; gemm_phase(F.lds, F.wave, g, S, E); }
    __builtin_amdgcn_sched_barrier(0); asm volatile("s_waitcnt vmcnt(0)" ::: "memory"); __syncthreads();
    if (IN(15)) REPS(15) { Gemm g{(const bf16_t*)(ws + WS_HNF8), (const bf16_t*)(ws + WS_WPG), 512, 512, 512}; StaticOrder S; S.init(NTOK, DM, F.G, (int)blockIdx.x);
        EpiFinal E{prm.out, (const bf16_t*)(ws + WS_PP)}; gemm_phase<EpiFinal, StaticOrder, false, true>(F.lds, F.wave, g, S, E); }
#ifdef TPROBE_A
    STAMP(16);
    xcd_barrier(bar);
    if (blockIdx.x == 0 && F.wave == 0 && lane_id() == 0) {
        volatile unsigned long long* ts = (volatile unsigned long long*)(ws + WS_ERR);
        const unsigned long long da = ts[TPROBE_A1] - ts[TPROBE_A], db = ts[TPROBE_B1] - ts[TPROBE_B];
        asm volatile("s_waitcnt vmcnt(0)" ::: "memory");
        prm.out[0] += (float)db * (0.01f / 4.0f);
        const unsigned long long t0 = __builtin_amdgcn_s_memrealtime();
        while (__builtin_amdgcn_s_memrealtime() - t0 < 4ull * da) __builtin_amdgcn_s_sleep(4);
    }
#endif
#undef IN
#undef SEAM
}

extern "C" void kernel_launch(void* const* d_in, const int* in_sizes, int n_in, void* d_out, int out_size, void* d_ws, size_t ws_size, hipStream_t stream) {
    static int grid = 0;
    if (grid == 0) {
        int dev = 0, cus = 0, per_cu = 0;
        (void)hipGetDevice(&dev);
        (void)hipDeviceGetAttribute(&cus, hipDeviceAttributeMultiprocessorCount, dev);
        (void)hipFuncSetAttribute((const void*)fwd, hipFuncAttributeMaxDynamicSharedMemorySize, LDS_BYTES);
        (void)hipOccupancyMaxActiveBlocksPerMultiprocessor(&per_cu, (const void*)fwd, NTHREADS, LDS_BYTES);
        fprintf(stderr, "cus %d per_cu %d ws %zu n_in %d\n", cus, per_cu, ws_size, n_in);
        grid = (per_cu >= 1) ? cus : -1;
        if (grid != 256 || n_in != 25 || ws_size < WS_END || out_size != NTOK * DM) { fprintf(stderr, "kernel_launch: unsupported configuration\n"); grid = -1; }
    }
    if (grid < 0) return;
    (void)hipMemsetAsync((char*)d_ws + WS_BAR, 0, WS_BAR_BYTES, stream);
    Params a{};
    for (int i = 0; i < 25; ++i) a.in[i] = (const float*)d_in[i];
    a.out = (float*)d_out; a.ws = (unsigned char*)d_ws;
#ifndef MULTI_LAUNCH
    a.ph_lo = 0; a.ph_hi = NPHASE;
    void* args[] = {&a};
    hipError_t e = hipLaunchCooperativeKernel((const void*)fwd, dim3(grid), dim3(NTHREADS), args, LDS_BYTES, stream);
    if (e != hipSuccess) fprintf(stderr, "cooperative launch failed: %s\n", hipGetErrorString(e));
#else
    for (int k = 0; k < NPHASE; ++k) { a.ph_lo = k; a.ph_hi = k + 1; void* args[] = {&a};
        hipError_t e = hipLaunchCooperativeKernel((const void*)fwd, dim3(grid), dim3(NTHREADS), args, LDS_BYTES, stream);
        if (e != hipSuccess) fprintf(stderr, "launch %d failed: %s\n", k, hipGetErrorString(e)); }
#endif
}
```

```cpp
#include <hip/hip_runtime.h>
#include <hip/hip_cooperative_groups.h>
#include <cstdio>
#include <cstdint>
namespace cg = cooperative_groups;

#define LAS __attribute__((address_space(3)))
typedef unsigned short bf16_t;
typedef short bf16x8 __attribute__((ext_vector_type(8)));
typedef short s16x4 __attribute__((ext_vector_type(4)));
typedef float f32x4 __attribute__((ext_vector_type(4)));
typedef float f32x2 __attribute__((ext_vector_type(2)));
typedef float f32x16 __attribute__((ext_vector_type(16)));
typedef unsigned u32x4 __attribute__((ext_vector_type(4)));
typedef unsigned u32x2 __attribute__((ext_vector_type(2)));
typedef int i32x4 __attribute__((ext_vector_type(4)));
typedef int i32x8 __attribute__((ext_vector_type(8)));
typedef __bf16 bf16x2_t __attribute__((ext_vector_type(2)));

constexpr int NB = 8, SEQ = 2048, NTOK = NB * SEQ, DM = 1024;
constexpr int DIN = 4000, DINP = 4096;
constexpr int NEXP = 32, TOPK = 4, DEXP = 1024;
constexpr int NTHREADS = 512, NWAVES = 8;
constexpr float EPS = 1e-6f;
constexpr float LOG2E = 1.4426950408889634f;
constexpr float C2A = 0.125f * LOG2E;
constexpr float C2B = 0.10206207261596575f * LOG2E;
constexpr int PC_QA = 0, PC_KA = 512, PC_VA = 1024, PC_CQ = 1536, PC_CKV = 1792, PC_KPE = 1920, PC_GA = 2048, PC_GB = 3072;

constexpr size_t MiB = 1u << 20;
constexpr size_t WS_HIST = 0;
constexpr size_t WS_ERR = 64 * 1024;
constexpr size_t WS_BAR = 128 * 1024;
constexpr size_t WS_BAR_BYTES = 16 * 1024;
constexpr size_t WS_KPESS = 576 * 1024;
constexpr size_t WS_TOK = 256 * 1024;
constexpr size_t WS_ROPE = 1 * MiB;
constexpr size_t WS_KMEAN = 2 * MiB;
constexpr size_t WS_SSP = 11 * MiB;
constexpr size_t WS_PAIR = 3 * MiB;
constexpr size_t WS_WUQ = 4 * MiB, WS_WUKV = 4 * MiB + 512 * 1024, WS_WPP = 5 * MiB, WS_WA = 6 * MiB, WS_WB = 7 * MiB, WS_WO = 8 * MiB, WS_WPG = 10 * MiB, WS_WIN = 12 * MiB;
constexpr size_t WS_W1 = 20 * MiB, WS_W2 = 148 * MiB;
constexpr size_t WS_WINF8 = 16 * MiB;
constexpr size_t WS_HNF8 = 84 * MiB;
constexpr size_t WS_HN = 212 * MiB, WS_PB = 244 * MiB;
constexpr size_t WS_CQN = 252 * MiB, WS_CKVN = 260 * MiB, WS_QB = 264 * MiB, WS_KV = 288 * MiB, WS_KB2 = 320 * MiB, WS_Y = 344 * MiB, WS_MERGED = 376 * MiB;
constexpr size_t WS_ACT = 252 * MiB;
constexpr size_t WS_PP = 400 * MiB;
constexpr size_t WS_KA2 = 432 * MiB;
constexpr size_t WS_PROJ = 448 * MiB;
constexpr size_t WS_QA2 = 576 * MiB;
constexpr size_t WS_XG = 448 * MiB;
constexpr size_t WS_END = 592 * MiB;
constexpr int MAXROWS = 73728, MAXMT = 288;

constexpr int RING_BYTES = 131072;
constexpr int LDS_CTL = RING_BYTES;
constexpr int LDS_TOKL = RING_BYTES + 8192 + 256;
constexpr int LDS_BARST = RING_BYTES + 8192;
constexpr int LDS_BYTES = 147456;

__device__ __forceinline__ unsigned cvt_pk_bf16(float lo, float hi) { f32x2 v = {lo, hi}; bf16x2_t b = __builtin_convertvector(v, bf16x2_t); return __builtin_bit_cast(unsigned, b); }
__device__ __forceinline__ unsigned pack4_fp8(float a, float b, float c, float d) { int w = 0; w = __builtin_amdgcn_cvt_pk_fp8_f32(a, b, w, false); w = __builtin_amdgcn_cvt_pk_fp8_f32(c, d, w, true); return (unsigned)w; }
__device__ __forceinline__ float bf2f(unsigned short b) { return __uint_as_float(((unsigned)b) << 16); }
__device__ __forceinline__ float bflo(unsigned w) { return __uint_as_float(w << 16); }
__device__ __forceinline__ float bfhi(unsigned w) { return __uint_as_float(w & 0xffff0000u); }
__device__ __forceinline__ float sigmoidf_(float x) { return __builtin_amdgcn_rcpf(1.0f + __builtin_amdgcn_exp2f(-x * LOG2E)); }
__device__ __forceinline__ int lane_id() { return (int)__builtin_amdgcn_mbcnt_hi(~0u, __builtin_amdgcn_mbcnt_lo(~0u, 0u)); }
__device__ __forceinline__ float wave_sum(float v) {
#pragma unroll
    for (int o = 1; o < 64; o <<= 1) v += __shfl_xor(v, o);
    return v;
}

namespace pg8 {
constexpr int BM = 256, BK = 64, HALF = 128, HTB = HALF * BK * 2, STAGE_BYTES = 8 * HTB, NXCD = 8, WGM = 8;
__host__ __device__ __forceinline__ int lds_byte(int r, int c) { const int st = (r >> 4) * 2 + (c >> 5), rr = r & 15, cc = c & 31, ob = rr * 64 + cc * 2; return st * 1024 + (ob ^ (((ob >> 9) & 1) << 5)); }
__host__ __device__ __forceinline__ void stage_rc(int b, int& R, int& C) { const int st = b / 1024, sb = b % 1024, swz = sb ^ (((sb >> 9) & 1) << 5); R = (st >> 1) * 16 + swz / 64; C = (st & 1) * 32 + (swz % 64) / 2; }
__host__ __device__ __forceinline__ int perm32(int rho) { const int n = rho >> 4, i = rho & 15; return 8 * (i >> 2) + 4 * n + (i & 3); }

struct Unit { int pm, pn, pb, e; int aofs = 0; };
struct Gemm { const bf16_t* A; const bf16_t* Bt; int lda, ldb, K; };

struct StaticOrder {
    int nM, nN, nwg, G, c;
    __device__ void init(int M, int N, int G_, int c_) { nM = M / BM; nN = N / BM; nwg = nM * nN; G = G_; c = c_; }
    __device__ bool next(int i, Unit& u) const {
        const long L = (long)i * G + c; if (L >= nwg) return false;
        int wgid = (int)L; { const int q = nwg / NXCD, r = nwg % NXCD, xcd = wgid % NXCD, off = wgid / NXCD; wgid = (xcd < r ? xcd * (q + 1) : r * (q + 1) + (xcd - r) * q) + off; }
        const int nig = WGM * nN, gid = wgid / nig, fm = gid * WGM, gsz = (nM - fm) < WGM ? (nM - fm) : WGM;
        u.pm = fm + ((wgid % nig) % gsz); u.pn = (wgid % nig) / gsz; u.pb = u.pn; u.e = 0; return true;
    }
};
struct MoeOrder {
    const LAS int* tile_e; int nmt, ntn, G, c;
    __device__ bool next(int i, Unit& u) const {
        const int j = (i * G + c) >> 3; const int mt = (j / ntn) * 8 + (c & 7), pn = j % ntn; if (mt >= nmt) return false;
        const int e = __builtin_amdgcn_readfirstlane(tile_e[mt]);
        u.pm = mt; u.pn = pn; u.pb = e * ntn + pn; u.e = e; return true;
    }
};

template <class Epi, class Sched, bool GATHER = false, bool FP8 = false>
__device__ __forceinline__ void gemm_phase(LAS unsigned char* lds, int wave, const Gemm g, const Sched& S, const Epi& E, const LAS unsigned short* tokl = nullptr) {
    constexpr bool ALIGN_EPI = true;
    int lane = lane_id(); asm volatile("" : "+v"(lane));
    const int wid = wave, tid = wid * 64 + lane, wr = wid >> 2, wc = wid & 3, fr = lane & 15, fq = lane >> 4;
    int K = g.K; asm volatile("" : "+s"(K));
    const int nt = K / BK;
    unsigned voffA[2], voffB[2]; int gR[2]; unsigned gC[2];
#pragma unroll
    for (int i = 0; i < 2; ++i) { int R, C; stage_rc(tid * 16 + i * 8192, R, C); const int Rb = (R & ~31) + perm32(R & 31);
        voffA[i] = (unsigned)(R * g.lda + C) * 2u; voffB[i] = (unsigned)(Rb * g.ldb + C) * 2u; gR[i] = R; gC[i] = (unsigned)C * 2u; }
    unsigned goff[2][2], noff[2][2];
#define PG8_GOFF(dst, ui_) do { _Pragma("unroll") for (int h_ = 0; h_ < 2; ++h_) _Pragma("unroll") for (int i_ = 0; i_ < 2; ++i_) \
        dst[h_][i_] = (unsigned)tokl[(ui_) * 256 + h_ * HALF + gR[i_]] * (unsigned)(g.lda * 2) + gC[i_]; } while (0)
    const size_t kstep = (size_t)(BK * 2);
    const size_t hstepA = (size_t)HALF * g.lda * 2, hstepB = (size_t)HALF * g.ldb * 2;
    const size_t tstepA = 2 * hstepA, tstepB = 2 * hstepB;
    const unsigned ldsw = (unsigned)wid * 1024u;
    const int aoff = lds_byte(wr * 64 + fr, fq * 8), boff = lds_byte(wc * 32 + fr, fq * 8);
#define PG8_SA(b, h) (((b) * 2 + (h)) * HTB)
#define PG8_SB(b, h) ((4 + (b) * 2 + (h)) * HTB)
#define PG8_STAGE(bufoff, gbase, voff) do { _Pragma("unroll") for (int _i = 0; _i < 2; ++_i) \
        __builtin_amdgcn_global_load_lds((const unsigned*)((const char*)(gbase) + (voff)[_i]), (LAS unsigned*)(lds + (bufoff) + ldsw + _i * 8192), 16, 0, 0); } while (0)
#define PG8_STAGE_A(bufoff, ptr_ng, k_g, off_g) do { if constexpr (GATHER) { const char* gb_ = (const char*)g.A + (size_t)(k_g) * kstep; PG8_STAGE(bufoff, gb_, off_g); } else { PG8_STAGE(bufoff, ptr_ng, voffA); } } while (0)
#define PG8_LDA(dst, b, h) do { if constexpr (FP8) { _Pragma("unroll") for (int m = 0; m < 4; ++m) { const i32x4 lo_ = *(const LAS i32x4*)(lds + PG8_SA(b, h) + aoff + m * 2048), hi_ = *(const LAS i32x4*)(lds + PG8_SA(b, h) + aoff + m * 2048 + 1024); dst##8[m] = __builtin_shufflevector(lo_, hi_, 0, 1, 2, 3, 4, 5, 6, 7); } } \
        else { _Pragma("unroll") for (int m = 0; m < 4; ++m) _Pragma("unroll") for (int k = 0; k < 2; ++k) dst[m][k] = *(const LAS bf16x8*)(lds + PG8_SA(b, h) + aoff + m * 2048 + k * 1024); } } while (0)
#define PG8_LDB(dst, b, h) do { if constexpr (FP8) { _Pragma("unroll") for (int n = 0; n < 2; ++n) { const i32x4 lo_ = *(const LAS i32x4*)(lds + PG8_SB(b, h) + boff + n * 2048), hi_ = *(const LAS i32x4*)(lds + PG8_SB(b, h) + boff + n * 2048 + 1024); dst##8[n] = __builtin_shufflevector(lo_, hi_, 0, 1, 2, 3, 4, 5, 6, 7); } } \
        else { _Pragma("unroll") for (int n = 0; n < 2; ++n) _Pragma("unroll") for (int k = 0; k < 2; ++k) dst[n][k] = *(const LAS bf16x8*)(lds + PG8_SB(b, h) + boff + n * 2048 + k * 1024); } } while (0)
#define PG8_CAT8(x, y) __builtin_shufflevector(__builtin_bit_cast(i32x4, x), __builtin_bit_cast(i32x4, y), 0, 1, 2, 3, 4, 5, 6, 7)
#define PG8_MMA(ai, bj, At, Bt) do { __builtin_amdgcn_s_setprio(1); if constexpr (FP8) { _Pragma("unroll") for (int m = 0; m < 4; ++m) _Pragma("unroll") for (int n = 0; n < 2; ++n) \
        asm volatile("v_mfma_scale_f32_16x16x128_f8f6f4 %0, %1, %2, %0, %3, %3 op_sel_hi:[0,0,0]" : "+v"(acc[ai][bj][m][n]) : "v"(Bt##8[n]), "v"(At##8[m]), "v"(sc8)); } \
        else { _Pragma("unroll") for (int m = 0; m < 4; ++m) _Pragma("unroll") for (int n = 0; n < 2; ++n) _Pragma("unroll") for (int k = 0; k < 2; ++k) \
        acc[ai][bj][m][n] = __builtin_amdgcn_mfma_f32_16x16x32_bf16(Bt[n][k], At[m][k], acc[ai][bj][m][n], 0, 0, 0); } __builtin_amdgcn_s_setprio(0); } while (0)
#define PG8_WAIT_V(n) asm volatile("s_waitcnt vmcnt(" #n ")" ::: "memory")
#define PG8_WAIT_L(n) asm volatile("s_waitcnt lgkmcnt(" #n ")" ::: "memory")
#define PG8_BAR __builtin_amdgcn_s_barrier()
#define PG8_SCHED __builtin_amdgcn_sched_barrier(0)
    Unit cur, nxt; int ui = 0;
    if (!S.next(0, cur)) return;
    f32x4 acc[2][2][4][2];
#pragma unroll
    for (int a = 0; a < 2; ++a)
#pragma unroll
        for (int b = 0; b < 2; ++b)
#pragma unroll
            for (int m = 0; m < 4; ++m)
#pragma unroll
                for (int n = 0; n < 2; ++n) acc[a][b][m][n] = (f32x4){0.f, 0.f, 0.f, 0.f};
    const int sc8 = 0x7c7c7c7c;
    bf16x8 At[4][2], B0[2][2], B1[2][2]; i32x8 At8[4], B08[2], B18[2];
    const char* cA = (const char*)g.A + (size_t)cur.pm * tstepA + cur.aofs; const char* cB = (const char*)g.Bt + (size_t)cur.pb * tstepB;
    if constexpr (GATHER) { PG8_GOFF(goff, 0); }
    PG8_STAGE(PG8_SB(0, 0), cB, voffB); PG8_STAGE(PG8_SB(0, 1), cB + hstepB, voffB); PG8_STAGE_A(PG8_SA(0, 0), cA, 0, goff[0]); PG8_STAGE_A(PG8_SA(0, 1), cA + hstepA, 0, goff[1]);
    if (wr == 1) PG8_BAR;
    PG8_WAIT_V(2); PG8_BAR;
    PG8_STAGE(PG8_SB(1, 0), cB + kstep, voffB); PG8_STAGE_A(PG8_SA(1, 0), cA + kstep, 1, goff[0]); PG8_STAGE(PG8_SB(1, 1), cB + hstepB + kstep, voffB);
    PG8_WAIT_V(6); PG8_BAR;
    for (;;) {
        const bool has_next = S.next(ui + 1, nxt);
        const char* nA = has_next ? (const char*)g.A + (size_t)nxt.pm * tstepA + nxt.aofs : cA; const char* nB = has_next ? (const char*)g.Bt + (size_t)nxt.pb * tstepB : cB;
        if constexpr (GATHER) { if (has_next) { PG8_GOFF(noff, ui + 1); } else {
#pragma unroll
            for (int h_ = 0; h_ < 2; ++h_)
#pragma unroll
                for (int i_ = 0; i_ < 2; ++i_) noff[h_][i_] = goff[h_][i_]; } }
        for (int t = 0; t < nt; t += 2) {
            const bool last = (t == nt - 2);
            const char* a1 = cA + (size_t)(t + 1) * kstep;
            const char* a2 = last ? nA : cA + (size_t)(t + 2) * kstep; const char* b2 = last ? nB : cB + (size_t)(t + 2) * kstep;
            const char* a3 = a2 + kstep; const char* b3 = b2 + kstep;
            const int k2 = last ? 0 : t + 2;
            unsigned soff[2][2];
            if constexpr (GATHER) {
#pragma unroll
                for (int h_ = 0; h_ < 2; ++h_)
#pragma unroll
                    for (int i_ = 0; i_ < 2; ++i_) soff[h_][i_] = last ? noff[h_][i_] : goff[h_][i_]; }
            PG8_LDB(B0, 0, 0); PG8_LDB(B1, 0, 1); PG8_SCHED; PG8_LDA(At, 0, 0); PG8_STAGE_A(PG8_SA(1, 1), a1 + hstepA, t + 1, goff[1]);
            PG8_WAIT_V(8); PG8_WAIT_L(0); PG8_BAR; PG8_MMA(0, 0, At, B0); PG8_MMA(0, 1, At, B1); PG8_BAR; PG8_SCHED;
            PG8_LDA(At, 0, 1); PG8_STAGE(PG8_SB(0, 0), b2, voffB); PG8_STAGE(PG8_SB(0, 1), b2 + hstepB, voffB); PG8_STAGE_A(PG8_SA(0, 0), a2, k2, soff[0]);
            PG8_WAIT_V(8); PG8_WAIT_L(0); PG8_BAR; PG8_MMA(1, 0, At, B0); PG8_MMA(1, 1, At, B1); PG8_BAR; PG8_SCHED;
            PG8_LDB(B0, 1, 0); PG8_LDB(B1, 1, 1); PG8_SCHED; PG8_LDA(At, 1, 0); PG8_STAGE_A(PG8_SA(0, 1), a2 + hstepA, k2, soff[1]);
            PG8_WAIT_V(8); PG8_WAIT_L(0); PG8_BAR; PG8_MMA(0, 0, At, B0); PG8_MMA(0, 1, At, B1); PG8_BAR; PG8_SCHED;
            PG8_LDA(At, 1, 1); PG8_STAGE(PG8_SB(1, 0), b3, voffB); PG8_STAGE(PG8_SB(1, 1), b3 + hstepB, voffB); PG8_STAGE_A(PG8_SA(1, 0), a3, k2 + 1, soff[0]);
            PG8_WAIT_V(8); PG8_WAIT_L(0); PG8_BAR; PG8_MMA(1, 0, At, B0); PG8_MMA(1, 1, At, B1); PG8_BAR; PG8_SCHED;
        }
        if constexpr (ALIGN_EPI) { if (wr == 0) PG8_BAR; }
        if constexpr (FP8) asm volatile("s_nop 15\n\ts_nop 15" ::: "memory");
        E(acc, cur, wr, wc, fr, fq);
        if (!has_next) break;
#pragma unroll
        for (int a = 0; a < 2; ++a)
#pragma unroll
            for (int b = 0; b < 2; ++b)
#pragma unroll
                for (int m = 0; m < 4; ++m)
#pragma unroll
                    for (int n = 0; n < 2; ++n) acc[a][b][m][n] = (f32x4){0.f, 0.f, 0.f, 0.f};
        cur = nxt; cA = nA; cB = nB; ++ui;
        if constexpr (GATHER) {
#pragma unroll
            for (int h_ = 0; h_ < 2; ++h_)
#pragma unroll
                for (int i_ = 0; i_ < 2; ++i_) goff[h_][i_] = noff[h_][i_]; }
        if constexpr (ALIGN_EPI) { if (wr == 1) PG8_BAR; }
    }
    PG8_WAIT_V(0);
    if constexpr (!ALIGN_EPI) { if (wr == 0) PG8_BAR; }
    PG8_BAR;
#undef PG8_SA
#undef PG8_SB
#undef PG8_STAGE
#undef PG8_STAGE_A
#undef PG8_GOFF
#undef PG8_LDA
#undef PG8_LDB
#undef PG8_MMA
#undef PG8_CAT8
#undef PG8_WAIT_V
#undef PG8_WAIT_L
#undef PG8_BAR
#undef PG8_SCHED
}

#define EPI_ARGS const f32x4 (&acc)[2][2][4][2], const Unit& u, int wr, int wc, int fr, int fq
__device__ __forceinline__ u32x4 pack8(f32x4 v0, f32x4 v1) { u32x4 w; w.x = cvt_pk_bf16(v0[0], v0[1]); w.y = cvt_pk_bf16(v0[2], v0[3]); w.z = cvt_pk_bf16(v1[0], v1[1]); w.w = cvt_pk_bf16(v1[2], v1[3]); return w; }
__device__ __forceinline__ void unpack8(u32x4 w, f32x4& v0, f32x4& v1) { v0 = (f32x4){bflo(w.x), bfhi(w.x), bflo(w.y), bfhi(w.y)}; v1 = (f32x4){bflo(w.z), bfhi(w.z), bflo(w.w), bfhi(w.w)}; }
__device__ __forceinline__ f32x4 sig4(f32x4 v) { return (f32x4){sigmoidf_(v[0]), sigmoidf_(v[1]), sigmoidf_(v[2]), sigmoidf_(v[3])}; }

struct EpiStore {
    bf16_t* O; int ldc; const float* bias; int bias_stride; int sig_from;
    __device__ __forceinline__ void operator()(EPI_ARGS) const {
        const int row0 = u.pm * BM + wr * 64 + fr, col0 = u.pn * BM + wc * 32 + 8 * fq;
        const bool sg = u.pn >= sig_from;
        f32x4 bv[2][2];
#pragma unroll
        for (int bj = 0; bj < 2; ++bj)
#pragma unroll
            for (int n = 0; n < 2; ++n) bv[bj][n] = bias ? *(const f32x4*)(bias + (size_t)u.e * bias_stride + col0 + bj * HALF + 4 * n) : (f32x4){0.f, 0.f, 0.f, 0.f};
#pragma unroll
        for (int ai = 0; ai < 2; ++ai)
#pragma unroll
            for (int m = 0; m < 4; ++m) { bf16_t* rowp = O + (size_t)(row0 + ai * HALF + m * 16) * ldc + col0;
#pragma unroll
                for (int bj = 0; bj < 2; ++bj) { f32x4 v0 = acc[ai][bj][m][0] + bv[bj][0], v1 = acc[ai][bj][m][1] + bv[bj][1];
                    if (sg) { v0 = sig4(v0); v1 = sig4(v1); }
                    *(u32x4*)(rowp + bj * HALF) = pack8(v0, v1); } }
    }
};

struct EpiProj {
    bf16_t* PROJ; bf16_t* QA2; bf16_t* KA2; float* KMEAN; bf16_t* CQN; bf16_t* CKVN;
    const float* gq; const float* gk; const float* glq; const float* glkv; const float* cosA; const float* sinA; LAS float* xch;
    float* KPESS;
    __device__ __forceinline__ void operator()(EPI_ARGS) const {
        const int row0 = u.pm * BM + wr * 64 + fr, col0 = u.pn * BM + wc * 32 + 8 * fq;
        if (u.pn < 4) {
            const bool isk = u.pn >= 2; const int h = 4 * (u.pn & 1) + wc; const float* gn = isk ? gk : gq; const float sc = isk ? 1.0f : C2A;
            const f32x4 g1a = *(const f32x4*)(gn + 8 * fq), g1b = *(const f32x4*)(gn + 8 * fq + 4), g2a = *(const f32x4*)(gn + 32 + 8 * fq), g2b = *(const f32x4*)(gn + 36 + 8 * fq);
            bf16_t* dst = isk ? KA2 : QA2;
            f32x4 ks1a = {0.f, 0.f, 0.f, 0.f}, ks1b = ks1a, ks2a = ks1a, ks2b = ks1a;
#pragma unroll
            for (int ai = 0; ai < 2; ++ai)
#pragma unroll
                for (int m = 0; m < 4; ++m) { const int row = row0 + ai * HALF + m * 16; const int pos = row & (SEQ - 1);
                    f32x4 x1a = acc[ai][0][m][0], x1b = acc[ai][0][m][1], x2a = acc[ai][1][m][0], x2b = acc[ai][1][m][1];
                    float ss = (x1a[0] * x1a[0] + x1a[1] * x1a[1]) + (x1a[2] * x1a[2] + x1a[3] * x1a[3]) + (x1b[0] * x1b[0] + x1b[1] * x1b[1]) + (x1b[2] * x1b[2] + x1b[3] * x1b[3])
                             + (x2a[0] * x2a[0] + x2a[1] * x2a[1]) + (x2a[2] * x2a[2] + x2a[3] * x2a[3]) + (x2b[0] * x2b[0] + x2b[1] * x2b[1]) + (x2b[2] * x2b[2] + x2b[3] * x2b[3]);
                    ss += __shfl_xor(ss, 16); ss += __shfl_xor(ss, 32);
                    const float rstd = 1.0f / sqrtf(ss * (1.f / 64.f) + EPS);
                    x1a = x1a * g1a * rstd; x1b = x1b * g1b * rstd; x2a = x2a * g2a * rstd; x2b = x2b * g2b * rstd;
                    const f32x4 ca = *(const f32x4*)(cosA + pos * 32 + 8 * fq), cb = *(const f32x4*)(cosA + pos * 32 + 8 * fq + 4), sa = *(const f32x4*)(sinA + pos * 32 + 8 * fq), sb = *(const f32x4*)(sinA + pos * 32 + 8 * fq + 4);
                    const f32x4 y1a = x1a * ca - x2a * sa, y1b = x1b * cb - x2b * sb, y2a = x2a * ca + x1a * sa, y2b = x2b * cb + x1b * sb;
                    bf16_t* rp = dst + (size_t)row * 512 + h * 64 + 8 * fq;
                    *(u32x4*)rp = pack8(y1a * sc, y1b * sc); *(u32x4*)(rp + 32) = pack8(y2a * sc, y2b * sc);
                    ks1a += y1a; ks1b += y1b; ks2a += y2a; ks2b += y2b; }
            if (isk) {
#pragma unroll
                for (int o = 1; o < 16; o <<= 1) {
#pragma unroll
                    for (int i = 0; i < 4; ++i) { ks1a[i] += __shfl_xor(ks1a[i], o); ks1b[i] += __shfl_xor(ks1b[i], o); ks2a[i] += __shfl_xor(ks2a[i], o); ks2b[i] += __shfl_xor(ks2b[i], o); } }
                if (fr == 0) { float* km = KMEAN + (((size_t)(u.pm >> 3) * 8 + h) * 8 + (u.pm & 7)) * 64 + 8 * fq;
#pragma unroll
                    for (int i = 0; i < 4; ++i) { atomicAdd(km + i, ks1a[i] * (1.f / 256.f)); atomicAdd(km + 4 + i, ks1b[i] * (1.f / 256.f)); atomicAdd(km + 32 + i, ks2a[i] * (1.f / 256.f)); atomicAdd(km + 36 + i, ks2b[i] * (1.f / 256.f)); } } }
        } else if (u.pn == 6 || u.pn == 7) {
            const bool isq = u.pn == 6;
            float ssr[2][4];
#pragma unroll
            for (int ai = 0; ai < 2; ++ai)
#pragma unroll
                for (int m = 0; m < 4; ++m) { float ss = 0.f;
#pragma unroll
                    for (int bj = 0; bj < 2; ++bj) { if (bj == 1 && !isq) continue;
#pragma unroll
                        for (int n = 0; n < 2; ++n) { const f32x4 x = acc[ai][bj][m][n]; ss += (x[0] * x[0] + x[1] * x[1]) + (x[2] * x[2] + x[3] * x[3]); } }
                    ss += __shfl_xor(ss, 16); ss += __shfl_xor(ss, 32);
                    if (fq == 0) xch[(ai * HALF + wr * 64 + m * 16 + fr) * 4 + wc] = ss; }
            asm volatile("s_waitcnt lgkmcnt(0)" ::: "memory"); __builtin_amdgcn_s_barrier(); asm volatile("" ::: "memory");
#pragma unroll
            for (int ai = 0; ai < 2; ++ai)
#pragma unroll
                for (int m = 0; m < 4; ++m) { const f32x4 p4 = *(const LAS f32x4*)(xch + (ai * HALF + wr * 64 + m * 16 + fr) * 4); ssr[ai][m] = (p4[0] + p4[1]) + (p4[2] + p4[3]); }
            asm volatile("s_waitcnt lgkmcnt(0)" ::: "memory"); __builtin_amdgcn_s_barrier(); asm volatile("" ::: "memory");
            const float invn = isq ? (1.f / 256.f) : (1.f / 128.f); const float* gl = isq ? glq : glkv; bf16_t* dn = isq ? CQN : CKVN; const int ldn = isq ? 256 : 128;
            const int c0 = wc * 32 + 8 * fq;
#pragma unroll
            for (int bj = 0; bj < 2; ++bj) {
                if (bj == 1 && !isq) {
#pragma unroll
                    for (int ai = 0; ai < 2; ++ai)
#pragma unroll
                        for (int m = 0; m < 4; ++m) { const f32x4 x0 = acc[ai][1][m][0], x1 = acc[ai][1][m][1];
                            *(u32x4*)(PROJ + (size_t)(row0 + ai * HALF + m * 16) * DINP + col0 + HALF) = pack8(x0, x1);
                            float ss = (x0[0] * x0[0] + x0[1] * x0[1]) + (x0[2] * x0[2] + x0[3] * x0[3]) + (x1[0] * x1[0] + x1[1] * x1[1]) + (x1[2] * x1[2] + x1[3] * x1[3]);
                            ss += __shfl_xor(ss, 16); ss += __shfl_xor(ss, 32);
                            if (wc == 0 && fq == 0) KPESS[row0 + ai * HALF + m * 16] = ss; }
                    continue; }
                const f32x4 ga = *(const f32x4*)(gl + bj * HALF + c0), gb = *(const f32x4*)(gl + bj * HALF + c0 + 4);
#pragma unroll
                for (int ai = 0; ai < 2; ++ai)
#pragma unroll
                    for (int m = 0; m < 4; ++m) { const float rstd = 1.0f / sqrtf(ssr[ai][m] * invn + EPS);
                        *(u32x4*)(dn + (size_t)(row0 + ai * HALF + m * 16) * ldn + bj * HALF + c0) = pack8(acc[ai][bj][m][0] * ga * rstd, acc[ai][bj][m][1] * gb * rstd); } }
        } else {
            const bool sg = u.pn >= 8;
#pragma unroll
            for (int ai = 0; ai < 2; ++ai)
#pragma unroll
                for (int m = 0; m < 4; ++m) { bf16_t* rowp = PROJ + (size_t)(row0 + ai * HALF + m * 16) * DINP + col0;
#pragma unroll
                    for (int bj = 0; bj < 2; ++bj) { f32x4 v0 = acc[ai][bj][m][0], v1 = acc[ai][bj][m][1];
                        if (sg) { v0 = sig4(v0); v1 = sig4(v1); }
                        *(u32x4*)(rowp + bj * HALF) = pack8(v0, v1); } }
        }
    }
};

struct EpiQB {
    bf16_t* QB; const float* gn; const float* cosB; const float* sinB; LAS float* xch;
    __device__ __forceinline__ void operator()(EPI_ARGS) const {
        const int rl0 = wr * 64 + fr, row0 = u.pm * BM + rl0;
#pragma unroll
        for (int ai = 0; ai < 2; ++ai)
#pragma unroll
            for (int m = 0; m < 4; ++m)
#pragma unroll
                for (int bj = 0; bj < 2; ++bj) { const f32x4 x0 = acc[ai][bj][m][0], x1 = acc[ai][bj][m][1];
                    float ss = (x0[0] * x0[0] + x0[1] * x0[1]) + (x0[2] * x0[2] + x0[3] * x0[3]) + (x1[0] * x1[0] + x1[1] * x1[1]) + (x1[2] * x1[2] + x1[3] * x1[3]);
                    ss += __shfl_xor(ss, 16); ss += __shfl_xor(ss, 32);
                    if (fq == 0) xch[((rl0 + ai * HALF + m * 16) * 2 + bj) * 4 + wc] = ss; }
        asm volatile("s_waitcnt lgkmcnt(0)" ::: "memory"); __builtin_amdgcn_s_barrier(); asm volatile("" ::: "memory");
#define QB_RS(ai, m, bj) ({ const f32x4 p4_ = *(const LAS f32x4*)(xch + ((rl0 + (ai) * HALF + (m) * 16) * 2 + (bj)) * 4); C2B / sqrtf(((p4_[0] + p4_[1]) + p4_[2]) * (1.f / 96.f) + EPS); })
        if (wc < 2) { const f32x4 ga = *(const f32x4*)(gn + 32 * wc + 8 * fq), gb = *(const f32x4*)(gn + 32 * wc + 8 * fq + 4);
#pragma unroll
            for (int ai = 0; ai < 2; ++ai)
#pragma unroll
                for (int m = 0; m < 4; ++m)
#pragma unroll
                    for (int bj = 0; bj < 2; ++bj) { const float r = QB_RS(ai, m, bj);
                        *(u32x4*)(QB + (size_t)(row0 + ai * HALF + m * 16) * 768 + (2 * u.pn + bj) * 96 + 32 * wc + 8 * fq) = pack8(acc[ai][bj][m][0] * ga * r, acc[ai][bj][m][1] * gb * r); }
        } else if (wc == 2) { const f32x4 g1 = *(const f32x4*)(gn + 64 + 4 * fq), g2 = *(const f32x4*)(gn + 80 + 4 * fq);
#pragma unroll
            for (int ai = 0; ai < 2; ++ai)
#pragma unroll
                for (int m = 0; m < 4; ++m) { const int row = row0 + ai * HALF + m * 16; const int pos = row & (SEQ - 1);
                    const f32x4 c4 = *(const f32x4*)(cosB + pos * 16 + 4 * fq), s4 = *(const f32x4*)(sinB + pos * 16 + 4 * fq);
#pragma unroll
                    for (int bj = 0; bj < 2; ++bj) { const float r = QB_RS(ai, m, bj); const f32x4 x1 = acc[ai][bj][m][0] * g1 * r, x2 = acc[ai][bj][m][1] * g2 * r;
                        const f32x4 y1 = x1 * c4 - x2 * s4, y2 = x2 * c4 + x1 * s4; bf16_t* rp = QB + (size_t)row * 768 + (2 * u.pn + bj) * 96 + 64 + 4 * fq;
                        *(u32x2*)rp = (u32x2){cvt_pk_bf16(y1[0], y1[1]), cvt_pk_bf16(y1[2], y1[3])}; *(u32x2*)(rp + 16) = (u32x2){cvt_pk_bf16(y2[0], y2[1]), cvt_pk_bf16(y2[2], y2[3])}; } }
        }
    }
};
struct EpiKV {
    bf16_t* KB2; bf16_t* KV; const bf16_t* PROJ; const float* KPESS; const float* gn; const float* cosB; const float* sinB; LAS float* xch;
    __device__ __forceinline__ void operator()(EPI_ARGS) const {
        const int rl0 = wr * 64 + fr, row0 = u.pm * BM + rl0;
        if (wc < 2) {
#pragma unroll
            for (int ai = 0; ai < 2; ++ai)
#pragma unroll
                for (int m = 0; m < 4; ++m)
#pragma unroll
                    for (int bj = 0; bj < 2; ++bj) { const f32x4 x0 = acc[ai][bj][m][0], x1 = acc[ai][bj][m][1];
                        float ss = (x0[0] * x0[0] + x0[1] * x0[1]) + (x0[2] * x0[2] + x0[3] * x0[3]) + (x1[0] * x1[0] + x1[1] * x1[1]) + (x1[2] * x1[2] + x1[3] * x1[3]);
                        ss += __shfl_xor(ss, 16); ss += __shfl_xor(ss, 32);
                        if (fq == 0) xch[((rl0 + ai * HALF + m * 16) * 2 + bj) * 4 + wc] = ss; } }
        asm volatile("s_waitcnt lgkmcnt(0)" ::: "memory"); __builtin_amdgcn_s_barrier(); asm volatile("" ::: "memory");
#define KV_RS(ai, m, bj, pe) ({ const f32x2 p2_ = *(const LAS f32x2*)(xch + ((rl0 + (ai) * HALF + (m) * 16) * 2 + (bj)) * 4); 1.0f / sqrtf(((p2_[0] + p2_[1]) + (pe)) * (1.f / 96.f) + EPS); })
        if (wc < 2) { const f32x4 ga = *(const f32x4*)(gn + 32 * wc + 8 * fq), gb = *(const f32x4*)(gn + 32 * wc + 8 * fq + 4);
#pragma unroll
            for (int ai = 0; ai < 2; ++ai)
#pragma unroll
                for (int m = 0; m < 4; ++m) { const float pe = KPESS[row0 + ai * HALF + m * 16];
#pragma unroll
                    for (int bj = 0; bj < 2; ++bj) { const float r = KV_RS(ai, m, bj, pe);
                        *(u32x4*)(KB2 + (size_t)(row0 + ai * HALF + m * 16) * 768 + (2 * u.pn + bj) * 96 + 32 * wc + 8 * fq) = pack8(acc[ai][bj][m][0] * ga * r, acc[ai][bj][m][1] * gb * r); } }
        } else {
#pragma unroll
            for (int ai = 0; ai < 2; ++ai)
#pragma unroll
                for (int m = 0; m < 4; ++m)
#pragma unroll
                    for (int bj = 0; bj < 2; ++bj) *(u32x4*)(KV + (size_t)(row0 + ai * HALF + m * 16) * 1024 + (2 * u.pn + bj) * 128 + 32 * wc + 8 * fq) = pack8(acc[ai][bj][m][0], acc[ai][bj][m][1]);
            if (wc == 2) {
                const f32x4 g1 = *(const f32x4*)(gn + 64 + 4 * fq), g2 = *(const f32x4*)(gn + 80 + 4 * fq);
#pragma unroll
                for (int ai = 0; ai < 2; ++ai)
#pragma unroll
                    for (int m = 0; m < 4; ++m) { const int row = row0 + ai * HALF + m * 16; const int pos = row & (SEQ - 1); const float pe = KPESS[row];
                        const u32x2 w1 = *(const u32x2*)(PROJ + (size_t)row * DINP + PC_KPE + 4 * fq), w2 = *(const u32x2*)(PROJ + (size_t)row * DINP + PC_KPE + 16 + 4 * fq);
                        const f32x4 k1 = (f32x4){bflo(w1.x), bfhi(w1.x), bflo(w1.y), bfhi(w1.y)} * g1, k2 = (f32x4){bflo(w2.x), bfhi(w2.x), bflo(w2.y), bfhi(w2.y)} * g2;
                        const f32x4 c4 = *(const f32x4*)(cosB + pos * 16 + 4 * fq), s4 = *(const f32x4*)(sinB + pos * 16 + 4 * fq);
                        const f32x4 y1 = k1 * c4 - k2 * s4, y2 = k2 * c4 + k1 * s4;
#pragma unroll
                        for (int bj = 0; bj < 2; ++bj) { const float r = KV_RS(ai, m, bj, pe); bf16_t* rp = KB2 + (size_t)row * 768 + (2 * u.pn + bj) * 96 + 64 + 4 * fq;
                            *(u32x2*)rp = (u32x2){cvt_pk_bf16(y1[0] * r, y1[1] * r), cvt_pk_bf16(y1[2] * r, y1[3] * r)}; *(u32x2*)(rp + 16) = (u32x2){cvt_pk_bf16(y2[0] * r, y2[1] * r), cvt_pk_bf16(y2[2] * r, y2[3] * r)}; } } }
        }
    }
};
#undef QB_RS
#undef KV_RS
template <bool ADD> struct EpiGate {
    bf16_t* O; const bf16_t* G; int ldg; unsigned char* MF8;
    __device__ __forceinline__ void operator()(EPI_ARGS) const {
        const int row0 = u.pm * BM + wr * 64 + fr, col0 = u.pn * BM + wc * 32 + 8 * fq;
#pragma unroll
        for (int ai = 0; ai < 2; ++ai)
#pragma unroll
            for (int m = 0; m < 4; ++m) { const size_t r = (size_t)(row0 + ai * HALF + m * 16);
#pragma unroll
                for (int bj = 0; bj < 2; ++bj) { const int c = col0 + bj * HALF;
                    f32x4 g0, g1; unpack8(*(const u32x4*)(G + r * ldg + c), g0, g1);
                    f32x4 v0 = acc[ai][bj][m][0] * g0, v1 = acc[ai][bj][m][1] * g1;
                    if (ADD) { f32x4 o0, o1; unpack8(*(const u32x4*)(O + r * DM + c), o0, o1); v0 += o0; v1 += o1;
                        *(u32x2*)(MF8 + r * DM + c) = (u32x2){pack4_fp8(v0[0], v0[1], v0[2], v0[3]), pack4_fp8(v1[0], v1[1], v1[2], v1[3])}; }
                    else *(u32x4*)(O + r * DM + c) = pack8(v0, v1); } }
    }
};

struct BranchOrder {
    StaticOrder so;
    __device__ bool next(int i, Unit& u) const { if (i >= 2) return false; if (!so.next(0, u)) return false; u.e = i; u.aofs = i * 512; u.pb = u.pn + 8 * i; return true; }
};
struct EpiGateAB {
    bf16_t* O; const bf16_t* Ga; const bf16_t* Gb; int ldg; unsigned char* MF8;
    __device__ __forceinline__ void operator()(EPI_ARGS) const {
        if (u.e == 0) { EpiGate<false> E{O, Ga, ldg, nullptr}; E(acc, u, wr, wc, fr, fq); }
        else { asm volatile("s_waitcnt vmcnt(0)" ::: "memory");
               EpiGate<true> E{O, Gb, ldg, MF8}; E(acc, u, wr, wc, fr, fq); }
    }
};
struct EpiResF32 {
    const float* base; float* out; float* ssp;
    __device__ __forceinline__ void operator()(EPI_ARGS) const {
        const int row0 = u.pm * BM + wr * 64 + fr, col0 = u.pn * BM + wc * 32 + 8 * fq;
#pragma unroll
        for (int ai = 0; ai < 2; ++ai)
#pragma unroll
            for (int m = 0; m < 4; ++m) { const size_t r = (size_t)(row0 + ai * HALF + m * 16); float ss = 0.f;
#pragma unroll
                for (int bj = 0; bj < 2; ++bj) { const size_t off = r * DM + col0 + bj * HALF;
                    const f32x4 b0 = *(const f32x4*)(base + off), b1 = *(const f32x4*)(base + off + 4);
                    const f32x4 y0 = b0 + acc[ai][bj][m][0], y1 = b1 + acc[ai][bj][m][1];
                    *(f32x4*)(out + off) = y0; *(f32x4*)(out + off + 4) = y1;
                    ss += (y0[0] * y0[0] + y0[1] * y0[1]) + (y0[2] * y0[2] + y0[3] * y0[3]) + (y1[0] * y1[0] + y1[1] * y1[1]) + (y1[2] * y1[2] + y1[3] * y1[3]); }
                ss += __shfl_xor(ss, 16); ss += __shfl_xor(ss, 32);
                if (fq == 0) ssp[r * 16 + u.pn * 4 + wc] = ss; }
    }
};
struct EpiSwiglu {
    unsigned char* O; const float* bias;
    __device__ __forceinline__ void operator()(EPI_ARGS) const {
        const int row0 = u.pm * BM + wr * 64 + fr, j0 = u.pn * HALF + wc * 32 + 8 * fq;
        const float* be = bias + (size_t)u.e * 2048;
        f32x4 bg[2], bu[2];
#pragma unroll
        for (int n = 0; n < 2; ++n) { bg[n] = *(const f32x4*)(be + j0 + 4 * n); bu[n] = *(const f32x4*)(be + 1024 + j0 + 4 * n); }
#pragma unroll
        for (int ai = 0; ai < 2; ++ai)
#pragma unroll
            for (int m = 0; m < 4; ++m) { unsigned char* rowp = O + (size_t)(row0 + ai * HALF + m * 16) * DEXP + j0;
                f32x4 o[2];
#pragma unroll
                for (int n = 0; n < 2; ++n) { const f32x4 gv = acc[ai][0][m][n] + bg[n], uv = acc[ai][1][m][n] + bu[n];
#pragma unroll
                    for (int i = 0; i < 4; ++i) { const float gg = fminf(gv[i], 7.0f), uu = fminf(fmaxf(uv[i], -7.0f), 7.0f);
                        o[n][i] = (uu + 1.0f) * gg * __builtin_amdgcn_rcpf(1.0f + __builtin_amdgcn_exp2f(-1.702f * LOG2E * gg)); } }
                *(u32x2*)rowp = (u32x2){pack4_fp8(o[0][0], o[0][1], o[0][2], o[0][3]), pack4_fp8(o[1][0], o[1][1], o[1][2], o[1][3])}; }
    }
};
struct EpiFinal {
    float* out; const bf16_t* PP;
    __device__ __forceinline__ void operator()(EPI_ARGS) const {
        const int row0 = u.pm * BM + wr * 64 + fr, col0 = u.pn * BM + wc * 32 + 8 * fq;
#pragma unroll
        for (int ai = 0; ai < 2; ++ai)
#pragma unroll
            for (int m = 0; m < 4; ++m) { const size_t r = (size_t)(row0 + ai * HALF + m * 16);
#pragma unroll
                for (int bj = 0; bj < 2; ++bj) { const size_t off = r * DM + col0 + bj * HALF;
                    f32x4 p0, p1; unpack8(*(const u32x4*)(PP + off), p0, p1);
                    const f32x4 b0 = *(const f32x4*)(out + off), b1 = *(const f32x4*)(out + off + 4);
                    *(f32x4*)(out + off) = b0 + sig4(acc[ai][bj][m][0]) * p0; *(f32x4*)(out + off + 4) = b1 + sig4(acc[ai][bj][m][1]) * p1; } }
    }
};
}

namespace att {
__device__ __forceinline__ int crow(int r, int hi) { return (r & 3) + 8 * (r >> 2) + 4 * hi; }
__device__ __forceinline__ void glds16(const void* gsrc, unsigned lds_dst) { unsigned keep;
    asm volatile("s_mov_b32 %0, m0\n\ts_mov_b32 m0, %2\n\ts_nop 0\n\tglobal_load_lds_dwordx4 %1, off\n\ts_mov_b32 m0, %0" : "=&s"(keep) : "v"(gsrc), "s"(lds_dst) : "memory"); }
__device__ __forceinline__ s16x4 vtr(const LAS unsigned char* p) { return __builtin_bit_cast(s16x4, __builtin_amdgcn_ds_read_tr16_b64_v4i16((LAS s16x4*)p)); }
#define MX3(a, b, c) __builtin_fmaxf(__builtin_fmaxf((a), (b)), (c))
constexpr int VSLOT = 8192, OST_BYTES = NWAVES * 4096, WSF_BYTES = NWAVES * 256;

template <int DQK, bool MOBA>
__device__ __forceinline__ void attn_unit(int b, int qb, const bf16_t* Qh, int ldq, const bf16_t* Kh, int ldk, const bf16_t* Vh, int ldv, unsigned char* Oh, int ldo, const float* kmean, LAS unsigned char* shm, int wave) {
    constexpr int ND = DQK / 16, NCH = DQK / 8, KSLOT = NCH * 1024;
    constexpr int LDS_K = 0, LDS_V = 2 * KSLOT, LDS_WS = LDS_V + 2 * VSLOT, LDS_OST = LDS_WS + WSF_BYTES;
    static_assert(LDS_OST + OST_BYTES <= RING_BYTES, "attention LDS");
    int lane = lane_id(); asm volatile("" : "+v"(lane));
    const int r32 = lane & 31, hi = lane >> 5; const int wid = wave;
    const long rowbase = (long)b * SEQ; const int q0 = qb * 256;
    const unsigned lds0 = (unsigned)(uintptr_t)shm;
    LAS float* wsf = (LAS float*)(shm + LDS_WS) + wid * 64;
    const int NT = 4 * (qb + 1);
    const bf16_t* ksrc0 = Kh + (rowbase + lane) * ldk + wid * 8;
    const bf16_t* vsrc0 = Vh + (rowbase + 16 * (wid & 3) + (lane >> 2)) * ldv + (wid >> 2) * 32 + (lane & 3) * 8;
#define ATT_DMA(kt, s) do { const long ro_ = (long)(kt) * 64; \
        glds16(ksrc0 + ro_ * ldk, (unsigned)__builtin_amdgcn_readfirstlane(lds0 + LDS_K + (s) * KSLOT + wid * 1024)); \
        if (NCH > 8 && wid < NCH - 8) glds16(ksrc0 + ro_ * ldk + 64, (unsigned)__builtin_amdgcn_readfirstlane(lds0 + LDS_K + (s) * KSLOT + (wid + 8) * 1024)); \
        glds16(vsrc0 + ro_ * ldv, (unsigned)__builtin_amdgcn_readfirstlane(lds0 + LDS_V + (s) * VSLOT + wid * 1024)); } while (0)
#define ATT_TILE(i) (MOBA ? ((i) < 4 ? 4 * qb + (i) : (i) - 4) : (i))
    ATT_DMA(ATT_TILE(0), 0);
    const bf16_t* Qw = Qh + (rowbase + q0 + wid * 32 + r32) * ldq + hi * 8;
    bf16x8 qr[ND];
#pragma unroll
    for (int d0 = 0; d0 < ND; ++d0) qr[d0] = *(const bf16x8*)(Qw + d0 * 16);
    unsigned bmask = 0xffffffffu;
    if (MOBA) {
        bmask = 1u << qb;
        if (qb <= 3) bmask |= (1u << qb) - 1u;
        else {
            float gsc[7];
#pragma unroll
            for (int n = 0; n < 7; ++n) { float s = 0.f;
                if (n < qb) {
#pragma unroll
                    for (int d0 = 0; d0 < ND; ++d0) { const float* km = kmean + n * 64 + d0 * 16 + hi * 8; const f32x4 k0 = *(const f32x4*)km, k1 = *(const f32x4*)(km + 4);
                        s += bf2f((unsigned short)qr[d0][0]) * k0[0] + bf2f((unsigned short)qr[d0][1]) * k0[1] + bf2f((unsigned short)qr[d0][2]) * k0[2] + bf2f((unsigned short)qr[d0][3]) * k0[3]
                           + bf2f((unsigned short)qr[d0][4]) * k1[0] + bf2f((unsigned short)qr[d0][5]) * k1[1] + bf2f((unsigned short)qr[d0][6]) * k1[2] + bf2f((unsigned short)qr[d0][7]) * k1[3]; }
                    s += __shfl_xor(s, 32);
                } else s = -INFINITY;
                gsc[n] = s; }
#pragma unroll
            for (int pass = 0; pass < 3; ++pass) { float best = -INFINITY; int bi = 0;
#pragma unroll
                for (int n = 0; n < 7; ++n) { const bool ok = (n < qb) && !((bmask >> n) & 1u) && (gsc[n] > best); best = ok ? gsc[n] : best; bi = ok ? n : bi; }
                bmask |= 1u << bi; }
        }
    }
    asm volatile("s_waitcnt vmcnt(0)" ::: "memory");
#pragma unroll
    for (int d0 = 0; d0 < ND; ++d0) asm volatile("" : "+v"(qr[d0]));
    float mhat = 0.f, l_reg = 0.f; f32x16 o[2]; o[0] = f32x16{}; o[1] = f32x16{}; f32x16 negm = f32x16{}; asm volatile("" : "+v"(negm));
    const int qrel = wid * 32 + r32;
    const LAS unsigned char* kp0 = shm + LDS_K + hi * 1024 + r32 * 16;
    const LAS unsigned char* vp0 = shm + LDS_V + ((lane >> 4) & 1) * 32 + (lane & 3) * 8 + (4 * hi + ((lane & 15) >> 2)) * 64;
    for (int i = 0; i < NT; ++i) {
        const int s = i & 1, kt = ATT_TILE(i);
        asm volatile("s_waitcnt vmcnt(0) lgkmcnt(0)\n\ts_barrier" ::: "memory");
        if (i + 1 < NT) ATT_DMA(ATT_TILE(i + 1), s ^ 1);
        f32x16 cin = negm;
        if (MOBA) { if (i >= 4 && !((bmask >> (kt >> 2)) & 1u)) {
#pragma unroll
            for (int r = 0; r < 16; ++r) cin[r] = -INFINITY; } }
        f32x16 p0, p1;
        { const LAS unsigned char* kb = kp0 + s * KSLOT; bf16x8 kf[2 * ND];
#pragma unroll
            for (int d0 = 0; d0 < ND; ++d0) { kf[2 * d0] = *(const LAS bf16x8*)(kb + d0 * 2048); kf[2 * d0 + 1] = *(const LAS bf16x8*)(kb + d0 * 2048 + 512); }
            __builtin_amdgcn_sched_barrier(0);
#pragma unroll
            for (int d0 = 0; d0 < ND; ++d0) {
                if (d0 == 0) { p0 = __builtin_amdgcn_mfma_f32_32x32x16_bf16(kf[0], qr[0], cin, 0, 0, 0); p1 = __builtin_amdgcn_mfma_f32_32x32x16_bf16(kf[1], qr[0], cin, 0, 0, 0); }
                else { p0 = __builtin_amdgcn_mfma_f32_32x32x16_bf16(kf[2 * d0], qr[d0], p0, 0, 0, 0); p1 = __builtin_amdgcn_mfma_f32_32x32x16_bf16(kf[2 * d0 + 1], qr[d0], p1, 0, 0, 0); } } }
        if (kt >= 4 * qb) { const int kb = 64 * (kt - 4 * qb) + 4 * hi;
#pragma unroll
            for (int r = 0; r < 16; ++r) { const int kv = kb + (r & 3) + 8 * (r >> 2); if (kv > qrel) p0[r] = -INFINITY; if (kv + 32 > qrel) p1[r] = -INFINITY; } }
        bool resc = false;
        { float a = MX3(p0[0], p0[1], p1[0]), bb = MX3(p0[2], p0[3], p1[1]); a = MX3(a, p1[2], p1[3]);
#pragma unroll
            for (int r = 4; r < 16; r += 4) { a = MX3(a, p0[r], p0[r + 1]); bb = MX3(bb, p0[r + 2], p0[r + 3]); a = MX3(a, p1[r], p1[r + 1]); bb = MX3(bb, p1[r + 2], p1[r + 3]); }
            float rm = __builtin_fmaxf(a, bb); rm = __builtin_fmaxf(rm, __shfl_xor(rm, 32));
            const bool first = (i == 0);
            if (first || __any(rm > 6.0f)) {
                const float dl = first ? rm : __builtin_fmaxf(rm, 0.f); mhat += dl;
#pragma unroll
                for (int r = 0; r < 16; ++r) { p0[r] -= dl; p1[r] -= dl; }
#pragma unroll
                for (int r = 0; r < 16; ++r) negm[r] = -mhat;
                asm volatile("" : "+v"(negm));
                const float f = __builtin_amdgcn_exp2f(-dl); l_reg *= f; if (hi == 0) wsf[r32] = f; resc = true; } }
        float sacc = 0.f;
#pragma unroll
        for (int r = 0; r < 16; ++r) { p0[r] = __builtin_amdgcn_exp2f(p0[r]); p1[r] = __builtin_amdgcn_exp2f(p1[r]); sacc += p0[r] + p1[r]; }
        l_reg += sacc;
        u32x4 pw0, pw1, pw2, pw3;
        pw0 = (u32x4){cvt_pk_bf16(p0[0], p0[1]), cvt_pk_bf16(p0[2], p0[3]), cvt_pk_bf16(p0[4], p0[5]), cvt_pk_bf16(p0[6], p0[7])};
        pw1 = (u32x4){cvt_pk_bf16(p0[8], p0[9]), cvt_pk_bf16(p0[10], p0[11]), cvt_pk_bf16(p0[12], p0[13]), cvt_pk_bf16(p0[14], p0[15])};
        pw2 = (u32x4){cvt_pk_bf16(p1[0], p1[1]), cvt_pk_bf16(p1[2], p1[3]), cvt_pk_bf16(p1[4], p1[5]), cvt_pk_bf16(p1[6], p1[7])};
        pw3 = (u32x4){cvt_pk_bf16(p1[8], p1[9]), cvt_pk_bf16(p1[10], p1[11]), cvt_pk_bf16(p1[12], p1[13]), cvt_pk_bf16(p1[14], p1[15])};
        if (resc) {
#pragma unroll
            for (int d_ = 0; d_ < 2; ++d_)
#pragma unroll
                for (int r = 0; r < 16; ++r) o[d_][r] *= wsf[crow(r, hi)];
        }
        { const LAS unsigned char* vp = vp0 + s * VSLOT;
#pragma unroll
            for (int d0 = 0; d0 < 2; ++d0) {
                s16x4 lo[4], hh[4];
#pragma unroll
                for (int ks = 0; ks < 4; ++ks) { lo[ks] = vtr(vp + d0 * 4096 + ks * 1024); hh[ks] = vtr(vp + d0 * 4096 + ks * 1024 + 512); }
                __builtin_amdgcn_sched_barrier(0);
#define PKV(k) (bf16x8){lo[k][0], lo[k][1], lo[k][2], lo[k][3], hh[k][0], hh[k][1], hh[k][2], hh[k][3]}
                o[d0] = __builtin_amdgcn_mfma_f32_32x32x16_bf16(__builtin_bit_cast(bf16x8, pw0), PKV(0), o[d0], 0, 0, 0);
                o[d0] = __builtin_amdgcn_mfma_f32_32x32x16_bf16(__builtin_bit_cast(bf16x8, pw1), PKV(1), o[d0], 0, 0, 0);
                o[d0] = __builtin_amdgcn_mfma_f32_32x32x16_bf16(__builtin_bit_cast(bf16x8, pw2), PKV(2), o[d0], 0, 0, 0);
                o[d0] = __builtin_amdgcn_mfma_f32_32x32x16_bf16(__builtin_bit_cast(bf16x8, pw3), PKV(3), o[d0], 0, 0, 0);
#undef PKV
            } }
    }
    l_reg += __shfl_xor(l_reg, 32);
    if (hi == 0) wsf[32 + r32] = l_reg;
    float rli[16];
#pragma unroll
    for (int r = 0; r < 16; ++r) rli[r] = __builtin_amdgcn_rcpf(wsf[32 + crow(r, hi)]);
    unsigned char* Ow = (unsigned char*)Oh + (rowbase + q0 + wid * 32) * ldo;
    { LAS unsigned char* stg = shm + LDS_OST + wid * 2048;
#pragma unroll
        for (int r = 0; r < 16; ++r) { const int orow = crow(r, hi);
#pragma unroll
            for (int d0 = 0; d0 < 2; ++d0) stg[orow * 64 + d0 * 32 + r32] = (unsigned char)(pack4_fp8(o[d0][r] * rli[r], 0.f, 0.f, 0.f) & 0xffu); }
#pragma unroll
        for (int i = 0; i < 2; ++i) { const int row = i * 16 + (lane >> 2), ch = lane & 3; const u32x4 v = *(const LAS u32x4*)(stg + row * 64 + ch * 16); *(u32x4*)(Ow + (long)row * ldo + ch * 16) = v; } }
    asm volatile("s_waitcnt vmcnt(0) lgkmcnt(0)\n\ts_barrier" ::: "memory");
#undef ATT_DMA
#undef ATT_TILE
}
#undef MX3
}

#define XB_TMO      128
#define XB_XCNT(j)  (256  + 64 * (j))
#define XB_XSUB(j)  (1280 + 64 * (j))
#define XB_XGEN(j)  (2304 + 64 * (j))
#define XB_TOP      3328
#define XB_TOPGEN   3392
#define XCD_BAR_WORDS 3456
#define XB_SPIN_CAP (1u << 22)
__device__ __forceinline__ unsigned xb_ld(unsigned* p)              { return __hip_atomic_load(p, __ATOMIC_RELAXED, __HIP_MEMORY_SCOPE_AGENT); }
__device__ __forceinline__ unsigned xb_add(unsigned* p, unsigned v) { return __hip_atomic_fetch_add(p, v, __ATOMIC_RELAXED, __HIP_MEMORY_SCOPE_AGENT); }
__device__ __forceinline__ unsigned xb_xcc_id() { return (unsigned)__builtin_amdgcn_s_getreg((3 << 11) | 20) & 0xFu; }
#define XB_SPIN(cond, bar) do { unsigned _sp = 0; while (cond) { __builtin_amdgcn_s_sleep(1); \
    if ((++_sp & 255u) == 0u) { if (xb_ld(&(bar)[XB_TMO])) break; if (_sp > XB_SPIN_CAP) { atomicAdd(&(bar)[XB_TMO], 1u); break; } } } } while (0)
struct XcdBarrier { unsigned* bar; unsigned x; volatile LAS unsigned* st; int wave; };
__device__ __forceinline__ XcdBarrier xcd_barrier_post(unsigned* bar, volatile LAS unsigned* st, int wave) {
    XcdBarrier b; b.bar = bar; b.x = xb_xcc_id(); b.st = st; b.wave = wave;
    if (wave == 0 && lane_id() == 0) (void)xb_add(&bar[XB_XCNT(b.x)], 1u);
    return b;
}
__device__ __forceinline__ void xcd_barrier_complete(unsigned* bar, unsigned x, unsigned& nloc, unsigned& nx) {
    const unsigned G = gridDim.x * gridDim.y * gridDim.z;
    unsigned sum, cnt, mine, sp = 0u;
    for (;;) {
        sum = 0u; cnt = 0u; mine = 0u;
#pragma unroll
        for (unsigned j = 0; j < 16; ++j) { const unsigned c = xb_ld(&bar[XB_XCNT(j)]); sum += c; cnt += (c > 0u) ? 1u : 0u; mine = (j == x) ? c : mine; }
        if (sum == G) break;
        __builtin_amdgcn_s_sleep(1);
        if ((++sp & 255u) == 0u) { if (xb_ld(&bar[XB_TMO])) break; if (sp > XB_SPIN_CAP) { atomicAdd(&bar[XB_TMO], 1u); break; } }
    }
    nloc = mine > 0u ? mine : 1u; nx = cnt > 0u ? cnt : 1u;
}
__device__ __forceinline__ void xcd_barrier(const XcdBarrier& b) {
    asm volatile("s_waitcnt vmcnt(0)" ::: "memory");
    __syncthreads();
    if (b.wave == 0 && lane_id() == 0) {
        unsigned* bar = b.bar;
        __builtin_amdgcn_s_waitcnt(0);
        unsigned nloc = b.st[0], nx = b.st[1];
        if (nloc == 0u) { xcd_barrier_complete(bar, b.x, nloc, nx); b.st[0] = nloc; b.st[1] = nx; }
        const unsigned old = xb_add(&bar[XB_XSUB(b.x)], 1u);
        const unsigned gen = old / nloc;
        if (old + 1u == (gen + 1u) * nloc) {
            __builtin_amdgcn_fence(__ATOMIC_RELEASE, "agent");
            asm volatile("s_waitcnt vmcnt(0)" ::: "memory");
            const unsigned og = xb_add(&bar[XB_TOP], 1u);
            const unsigned tg = og / nx;
            if (og + 1u == (tg + 1u) * nx) xb_add(&bar[XB_TOPGEN], 1u);
            else XB_SPIN(xb_ld(&bar[XB_TOPGEN]) == tg, bar);
            __builtin_amdgcn_fence(__ATOMIC_ACQUIRE, "agent");
            xb_add(&bar[XB_XGEN(b.x)], 1u);
            asm volatile("s_waitcnt vmcnt(0)" ::: "memory");
        } else {
            XB_SPIN(xb_ld(&bar[XB_XGEN(b.x)]) == gen, bar);
            __builtin_amdgcn_fence(__ATOMIC_ACQUIRE, "agent");
            asm volatile("s_waitcnt vmcnt(0)" ::: "memory");
        }
    }
    __syncthreads();
}

struct Params { const float* in[25]; float* out; unsigned char* ws; int ph_lo, ph_hi; };
enum { I_X = 0, I_P, I_GMIX, I_WIN, I_MQN, I_MKN, I_QLATN, I_WUQ, I_KVLATN, I_WUKV, I_MLAQN, I_MLAKN, I_WA, I_WB, I_WO, I_GFFN, I_WR, I_BR, I_WGU, I_BGU, I_WD, I_BD, I_GPLE, I_WPG, I_WPP };
constexpr int NPHASE = 16;

struct Frame {
    LAS unsigned char* lds; int vcu, G, wave;
    const Params* P; unsigned char* ws;
};
struct Ids { int tid, lane, wave; };
#define PHASE_IDS() Ids I_; { int l_ = lane_id(); asm volatile("" : "+v"(l_)); I_.lane = l_; I_.wave = F.wave; I_.tid = F.wave * 64 + l_; }

#ifdef TPROBE_A
#define STAMP(k) do { if (blockIdx.x == 0 && F.wave == 0 && lane_id() == 0) ((volatile unsigned long long*)(ws + WS_ERR))[k] = __builtin_amdgcn_s_memrealtime(); } while (0)
#else
#define STAMP(k) do {} while (0)
#endif
__device__ __forceinline__ int rowmap(int mode, int c) {
    if (mode == 1) {
        if (c < 1024) { const int base = c & 512, s_ = c & 511, h = s_ >> 6, d = s_ & 63; return base + 256 * (h >> 2) + 128 * (d >> 5) + 32 * (h & 3) + (d & 31); }
        return c < 1952 ? c : c + 96; }
    if (mode == 2) return c < 1024 ? 256 * (c >> 7) + (c & 127) : 256 * ((c - 1024) >> 7) + 128 + ((c - 1024) & 127);
    if (mode == 3) {
        const int h = c / 96, d = c % 96; int t;
        if (d < 64) t = d; else if (d < 80) { const int i = d - 64; t = 64 + 8 * (i >> 2) + (i & 3); } else { const int i = d - 80; t = 64 + 8 * (i >> 2) + 4 + (i & 3); }
        return 128 * h + t; }
    return c;
}
__device__ __forceinline__ void tr_item64(const float* W, int ldw, int N, int k0, int n0, bf16_t* dst, int ldd, int mode, LAS float* scr, int lane) {
    const int r = lane >> 4, c4 = lane & 15; const bool inb = (n0 + 4 * c4) < N;
    f32x4 v[16];
#pragma unroll
    for (int i = 0; i < 16; ++i) v[i] = inb ? __builtin_nontemporal_load((const f32x4*)(W + (size_t)(k0 + 4 * i + r) * ldw + n0 + 4 * c4)) : (f32x4){0.f, 0.f, 0.f, 0.f};
#pragma unroll
    for (int i = 0; i < 16; ++i) { LAS float* p = scr + (4 * i + r) * 65 + 4 * c4; p[0] = v[i].x; p[1] = v[i].y; p[2] = v[i].z; p[3] = v[i].w; }
    asm volatile("s_waitcnt lgkmcnt(0)" ::: "memory");
    const int c = lane & 7;
#pragma unroll
    for (int j = 0; j < 8; ++j) { const int n = (lane >> 3) + 8 * j; const LAS float* sp = scr + (8 * c) * 65 + n;
        u32x4 o; o.x = cvt_pk_bf16(sp[0 * 65], sp[1 * 65]); o.y = cvt_pk_bf16(sp[2 * 65], sp[3 * 65]); o.z = cvt_pk_bf16(sp[4 * 65], sp[5 * 65]); o.w = cvt_pk_bf16(sp[6 * 65], sp[7 * 65]);
        if (n0 + n < N) *(u32x4*)(dst + (size_t)rowmap(mode, n0 + n) * ldd + k0 + 8 * c) = o; }
    asm volatile("s_waitcnt lgkmcnt(0)" ::: "memory");
}

__device__ __forceinline__ void tr_item_f8(const float* W, int ldw, int k0, int n0, unsigned char* dst, int ldd, int mode, LAS float* scr, int lane) {
    const int r = lane >> 3, c4 = lane & 7;
    f32x4 v[16];
#pragma unroll
    for (int i = 0; i < 16; ++i) v[i] = __builtin_nontemporal_load((const f32x4*)(W + (size_t)(k0 + 8 * i + r) * ldw + n0 + 4 * c4));
#pragma unroll
    for (int i = 0; i < 16; ++i) { LAS float* p = scr + (8 * i + r) * 33 + 4 * c4; p[0] = v[i].x * 64.f; p[1] = v[i].y * 64.f; p[2] = v[i].z * 64.f; p[3] = v[i].w * 64.f; }
    asm volatile("s_waitcnt lgkmcnt(0)" ::: "memory");
    const int c = lane & 7;
#pragma unroll
    for (int j = 0; j < 4; ++j) { const int n = (lane >> 3) + 8 * j; const LAS float* sp = scr + (16 * c) * 33 + n;
        u32x4 o; o.x = pack4_fp8(sp[0 * 33], sp[1 * 33], sp[2 * 33], sp[3 * 33]); o.y = pack4_fp8(sp[4 * 33], sp[5 * 33], sp[6 * 33], sp[7 * 33]);
        o.z = pack4_fp8(sp[8 * 33], sp[9 * 33], sp[10 * 33], sp[11 * 33]); o.w = pack4_fp8(sp[12 * 33], sp[13 * 33], sp[14 * 33], sp[15 * 33]);
        __builtin_nontemporal_store(o, (u32x4*)(dst + (size_t)rowmap(mode, n0 + n) * ldd + k0 + 16 * c)); }
    asm volatile("s_waitcnt lgkmcnt(0)" ::: "memory");
}

__device__ __forceinline__ void phase0(Frame& F) {
    PHASE_IDS();
    const Params& P = *F.P; unsigned char* ws = F.ws;
    LAS float* scr = (LAS float*)(F.lds + I_.wave * 16896);
    const int gw = F.vcu * NWAVES + I_.wave, NGW = F.G * NWAVES;
    constexpr int I_GU = 32 * 8 * 64, I_DN = 32 * 8 * 32, I_IN = 16 * 31, I_ING = 8 * 64, I_UQ = 4 * 12, I_UKV = 2 * 16, I_A = 8 * 16, I_O = 16 * 16, I_PP = 4 * 16;
    constexpr int I_PG = 8 * 32;
    constexpr int NITEMS = I_GU + I_DN + I_IN + I_ING + I_UQ + I_UKV + 2 * I_A + I_O + I_PG + I_PP;
    for (int it = gw; it < NITEMS; it += NGW) {
        int r = it;
        if (r < I_GU) { const int e = r >> 9, q = r & 511, kb = q >> 6, g = q & 63;
            tr_item_f8(P.in[I_WGU] + (size_t)e * 1024 * 2048, 2048, 128 * kb, 32 * g, ws + WS_W1 + (size_t)e * 2048 * 1024, 1024, 2, scr, I_.lane); continue; } r -= I_GU;
        if (r < I_DN) { const int e = r >> 8, q = r & 255, kb = q >> 5, g = q & 31;
            tr_item_f8(P.in[I_WD] + (size_t)e * 1024 * 1024, 1024, 128 * kb, 32 * g, ws + WS_W2 + (size_t)e * 1024 * 1024, 1024, 0, scr, I_.lane); continue; } r -= I_DN;
        if (r < I_IN) { const int kb = r / 31, g = r % 31; tr_item64(P.in[I_WIN], DIN, 1952, 64 * kb, 64 * g, (bf16_t*)(ws + WS_WIN), 1024, 1, scr, I_.lane); continue; } r -= I_IN;
        if (r < I_ING) { const int kb = r >> 6, g = r & 63; tr_item_f8(P.in[I_WIN] + 1952, DIN, 128 * kb, 32 * g, ws + WS_WINF8, 1024, 0, scr, I_.lane); continue; } r -= I_ING;
        if (r < I_UQ) { const int kb = r / 12, g = r % 12; tr_item64(P.in[I_WUQ], 768, 768, 64 * kb, 64 * g, (bf16_t*)(ws + WS_WUQ), 256, 3, scr, I_.lane); continue; } r -= I_UQ;
        if (r < I_UKV) { const int kb = r / 16, g = r % 16; tr_item64(P.in[I_WUKV], 1024, 1024, 64 * kb, 64 * g, (bf16_t*)(ws + WS_WUKV), 128, 0, scr, I_.lane); continue; } r -= I_UKV;
        if (r < I_A) { const int kb = r >> 5, g = r & 31; tr_item_f8(P.in[I_WA], 1024, 128 * kb, 32 * g, ws + WS_WA, 512, 0, scr, I_.lane); continue; } r -= I_A;
        if (r < I_A) { const int kb = r >> 5, g = r & 31; tr_item_f8(P.in[I_WB], 1024, 128 * kb, 32 * g, ws + WS_WB, 512, 0, scr, I_.lane); continue; } r -= I_A;
        if (r < I_PG) { const int kb = r >> 5, g = r & 31; tr_item_f8(P.in[I_WO], 1024, 128 * kb, 32 * g, ws + WS_WO, 1024, 0, scr, I_.lane); continue; } r -= I_PG;
        if (r < I_PG) { const int kb = r >> 5, g = r & 31; tr_item_f8(P.in[I_WPG], 1024, 128 * kb, 32 * g, ws + WS_WPG, 1024, 0, scr, I_.lane); continue; } r -= I_PG;
        { const int kb = r / 16, g = r % 16; tr_item64(P.in[I_WPP], 1024, 1024, 64 * kb, 64 * g, (bf16_t*)(ws + WS_WPP), 256, 0, scr, I_.lane); }
    }
    STAMP(20);
    { const f32x4* gp = (const f32x4*)P.in[I_GMIX] + I_.lane; f32x4 gv[4];
#pragma unroll
        for (int j = 0; j < 4; ++j) gv[j] = gp[64 * j];
        for (int m0 = gw * 4; m0 < NTOK; m0 += NGW * 4) { f32x4 v[4][4];
#pragma unroll
            for (int q = 0; q < 4; ++q) { const f32x4* xr = (const f32x4*)(P.in[I_X] + (size_t)(m0 + q) * DM) + I_.lane;
#pragma unroll
                for (int j = 0; j < 4; ++j) v[q][j] = xr[64 * j]; }
#pragma unroll
            for (int q = 0; q < 4; ++q) { float s = 0.f;
#pragma unroll
                for (int j = 0; j < 4; ++j) s += (v[q][j].x * v[q][j].x + v[q][j].y * v[q][j].y) + (v[q][j].z * v[q][j].z + v[q][j].w * v[q][j].w);
                const float rstd = 1.0f / sqrtf(wave_sum(s) * (1.f / DM) + EPS);
                u32x2* o8 = (u32x2*)((bf16_t*)(ws + WS_HN) + (size_t)(m0 + q) * DM) + I_.lane; unsigned* o4 = (unsigned*)(ws + WS_HNF8 + (size_t)(m0 + q) * DM) + I_.lane;
#pragma unroll
                for (int j = 0; j < 4; ++j) { const f32x4 y = v[q][j] * rstd * gv[j]; o8[64 * j] = (u32x2){cvt_pk_bf16(y.x, y.y), cvt_pk_bf16(y.z, y.w)}; o4[64 * j] = pack4_fp8(y.x, y.y, y.z, y.w); } } } }
    STAMP(21);
    { float* km = (float*)(ws + WS_KMEAN); for (int i = F.vcu * NTHREADS + I_.tid; i < 8 * 8 * 8 * 64; i += F.G * NTHREADS) km[i] = 0.f; }
    { const size_t n4 = (size_t)NTOK * 256 / 4; const f32x4* pp = (const f32x4*)P.in[I_P]; u32x2* po = (u32x2*)(ws + WS_PB); const size_t T = (size_t)F.G * NTHREADS;
        for (size_t i = (size_t)F.vcu * NTHREADS + I_.tid; i < n4; i += 4 * T) { f32x4 v[4];
#pragma unroll
            for (int q = 0; q < 4; ++q) v[q] = __builtin_nontemporal_load(pp + i + q * T);
#pragma unroll
            for (int q = 0; q < 4; ++q) po[i + q * T] = (u32x2){cvt_pk_bf16(v[q].x, v[q].y), cvt_pk_bf16(v[q].z, v[q].w)}; } }
    STAMP(22);
    { float* tab = (float*)(ws + WS_ROPE);
        for (int i = F.vcu * NTHREADS + I_.tid; i < 2048 * 48; i += F.G * NTHREADS) {
            int pos, j, half; float* cdst; float* sdst;
            if (i < 2048 * 32) { pos = i / 32; j = i % 32; half = 32; cdst = tab + i; sdst = tab + 65536 + i; }
            else { const int q = i - 2048 * 32; pos = q / 16; j = q % 16; half = 16; cdst = tab + 131072 + q; sdst = tab + 131072 + 32768 + q; }
            const float inv = powf(10000.0f, -((float)j / (float)half)); const float ang = (float)pos * inv;
            *cdst = cosf(ang); *sdst = sinf(ang); } }
}

__device__ __forceinline__ void phase2(Frame& F) {
    PHASE_IDS();
    const Params& P = *F.P; unsigned char* ws = F.ws;
    const bf16_t* PROJ = (const bf16_t*)(ws + WS_PROJ);
    const float* cosA = (const float*)(ws + WS_ROPE); const float* sinA = cosA + 65536;
    LAS float* kst = (LAS float*)F.lds;
    LAS float* part = kst + 256 * 68;
    for (int it = F.vcu; it < 512; it += F.G) {
        const int b = it >> 6, blk = (it >> 3) & 7, h = it & 7;
        const int sel = I_.lane >> 5, r = I_.wave * 32 + (I_.lane & 31); const int pos = blk * 256 + r; const size_t row = (size_t)b * SEQ + pos;
        const u32x4* src = (const u32x4*)(PROJ + row * DINP + (sel ? PC_KA : PC_QA) + h * 64);
        u32x4 raw[8];
#pragma unroll
        for (int c = 0; c < 8; ++c) raw[c] = src[c];
        float ss = 0.f;
#pragma unroll
        for (int c = 0; c < 8; ++c) { f32x4 a0, a1; pg8::unpack8(raw[c], a0, a1); ss += (a0[0] * a0[0] + a0[1] * a0[1]) + (a0[2] * a0[2] + a0[3] * a0[3]) + (a1[0] * a1[0] + a1[1] * a1[1]) + (a1[2] * a1[2] + a1[3] * a1[3]); }
        const float rstd = 1.0f / sqrtf(ss * (1.f / 64.f) + EPS);
        const float* gn = sel ? P.in[I_MKN] : P.in[I_MQN];
        const float sc = sel ? 1.0f : C2A;
        bf16_t* dst = (bf16_t*)(ws + (sel ? WS_KA2 : WS_QA2)) + row * 512 + h * 64;
#pragma unroll
        for (int c = 0; c < 4; ++c) { f32x4 x1a, x1b, x2a, x2b; pg8::unpack8(raw[c], x1a, x1b); pg8::unpack8(raw[c + 4], x2a, x2b);
            const f32x4 g1a = *(const f32x4*)(gn + 8 * c), g1b = *(const f32x4*)(gn + 8 * c + 4), g2a = *(const f32x4*)(gn + 32 + 8 * c), g2b = *(const f32x4*)(gn + 36 + 8 * c);
            x1a = x1a * g1a * rstd; x1b = x1b * g1b * rstd; x2a = x2a * g2a * rstd; x2b = x2b * g2b * rstd;
            const f32x4 ca = *(const f32x4*)(cosA + pos * 32 + 8 * c), cb = *(const f32x4*)(cosA + pos * 32 + 8 * c + 4), sa = *(const f32x4*)(sinA + pos * 32 + 8 * c), sb = *(const f32x4*)(sinA + pos * 32 + 8 * c + 4);
            const f32x4 y1a = x1a * ca - x2a * sa, y1b = x1b * cb - x2b * sb, y2a = x2a * ca + x1a * sa, y2b = x2b * cb + x1b * sb;
            *(u32x4*)(dst + 8 * c) = pg8::pack8(y1a * sc, y1b * sc); *(u32x4*)(dst + 32 + 8 * c) = pg8::pack8(y2a * sc, y2b * sc);
            if (sel) { LAS f32x4* kr = (LAS f32x4*)(kst + r * 68); kr[2 * c] = y1a; kr[2 * c + 1] = y1b; kr[8 + 2 * c] = y2a; kr[8 + 2 * c + 1] = y2b; } }
        __syncthreads();
        { const int d = I_.tid & 63, pt = I_.tid >> 6; float s = 0.f;
#pragma unroll 8
            for (int rr = 0; rr < 32; ++rr) s += kst[(pt * 32 + rr) * 68 + d];
            part[pt * 64 + d] = s; }
        __syncthreads();
        if (I_.tid < 64) { float s = 0.f;
#pragma unroll
            for (int pt = 0; pt < 8; ++pt) s += part[pt * 64 + I_.tid];
            ((float*)(ws + WS_KMEAN))[(((size_t)b * 8 + h) * 8 + blk) * 64 + I_.tid] = s * (1.f / 256.f); }
        __syncthreads();
    }
    const int gw = F.vcu * NWAVES + I_.wave, NGW = F.G * NWAVES;
    const f32x4 gq = ((const f32x4*)P.in[I_QLATN])[I_.lane]; const f32x2 gk = ((const f32x2*)P.in[I_KVLATN])[I_.lane];
    for (int m0 = gw * 8; m0 < NTOK; m0 += NGW * 8) {
        u32x2 wq[8]; unsigned wk[8];
#pragma unroll
        for (int q = 0; q < 8; ++q) { wq[q] = *((const u32x2*)(PROJ + (size_t)(m0 + q) * DINP + PC_CQ) + I_.lane); wk[q] = *((const unsigned*)(PROJ + (size_t)(m0 + q) * DINP + PC_CKV) + I_.lane); }
#pragma unroll
        for (int r = 0; r < 8; ++r) { const int m = m0 + r;
            const f32x4 q = {bflo(wq[r].x), bfhi(wq[r].x), bflo(wq[r].y), bfhi(wq[r].y)}; const f32x2 k = {bflo(wk[r]), bfhi(wk[r])};
            const float sq = wave_sum((q.x * q.x + q.y * q.y) + (q.z * q.z + q.w * q.w)), sk = wave_sum(k.x * k.x + k.y * k.y);
            const float rq = 1.0f / sqrtf(sq * (1.f / 256.f) + EPS), rk = 1.0f / sqrtf(sk * (1.f / 128.f) + EPS);
            const f32x4 yq = q * rq * gq; const f32x2 yk = k * rk * gk;
            *((u32x2*)((bf16_t*)(ws + WS_CQN) + (size_t)m * 256) + I_.lane) = (u32x2){cvt_pk_bf16(yq.x, yq.y), cvt_pk_bf16(yq.z, yq.w)};
            *((unsigned*)((bf16_t*)(ws + WS_CKVN) + (size_t)m * 128) + I_.lane) = cvt_pk_bf16(yk.x, yk.y); }
    }
}

__device__ __forceinline__ void phase4(Frame& F) {
    PHASE_IDS();
    const Params& P = *F.P; unsigned char* ws = F.ws;
    const bf16_t* PROJ = (const bf16_t*)(ws + WS_PROJ);
    const float* cosB = (const float*)(ws + WS_ROPE) + 131072; const float* sinB = cosB + 32768;
    const int gw = F.vcu * NWAVES + I_.wave, NGW = F.G * NWAVES;
    for (int it = gw; it < (NTOK / 64) * 16; it += NGW) {
        const int h = it & 7, sel = (it >> 3) & 1, rg = it >> 4; const size_t row = (size_t)rg * 64 + I_.lane; const int pos = (int)(row & (SEQ - 1));
        u32x4 raw[12];
        bf16_t* qrow = (bf16_t*)(ws + WS_QB) + row * 768 + h * 96;
        if (sel == 0) {
#pragma unroll
            for (int c = 0; c < 12; ++c) raw[c] = *(const u32x4*)(qrow + 8 * c);
        } else {
            const bf16_t* kn = (const bf16_t*)(ws + WS_KV) + row * 1024 + h * 128; const bf16_t* kp = PROJ + row * DINP + PC_KPE;
#pragma unroll
            for (int c = 0; c < 8; ++c) raw[c] = *(const u32x4*)(kn + 8 * c);
#pragma unroll
            for (int c = 0; c < 4; ++c) raw[8 + c] = *(const u32x4*)(kp + 8 * c);
        }
        float ss = 0.f;
#pragma unroll
        for (int c = 0; c < 12; ++c) { f32x4 a0, a1; pg8::unpack8(raw[c], a0, a1); ss += (a0[0] * a0[0] + a0[1] * a0[1]) + (a0[2] * a0[2] + a0[3] * a0[3]) + (a1[0] * a1[0] + a1[1] * a1[1]) + (a1[2] * a1[2] + a1[3] * a1[3]); }
        const float rstd = 1.0f / sqrtf(ss * (1.f / 96.f) + EPS);
        const float* gn = sel ? P.in[I_MLAKN] : P.in[I_MLAQN];
        const float sc = sel ? 1.0f : C2B; const float rs = rstd * sc;
        bf16_t* dst = sel ? (bf16_t*)(ws + WS_KB2) + row * 768 + h * 96 : qrow;
#pragma unroll
        for (int c = 0; c < 8; ++c) { f32x4 a0, a1; pg8::unpack8(raw[c], a0, a1); const f32x4 g0 = *(const f32x4*)(gn + 8 * c), g1 = *(const f32x4*)(gn + 8 * c + 4);
            *(u32x4*)(dst + 8 * c) = pg8::pack8(a0 * g0 * rs, a1 * g1 * rs); }
#pragma unroll
        for (int c = 0; c < 2; ++c) { f32x4 x1a, x1b, x2a, x2b; pg8::unpack8(raw[8 + c], x1a, x1b); pg8::unpack8(raw[10 + c], x2a, x2b);
            const f32x4 g1a = *(const f32x4*)(gn + 64 + 8 * c), g1b = *(const f32x4*)(gn + 68 + 8 * c), g2a = *(const f32x4*)(gn + 80 + 8 * c), g2b = *(const f32x4*)(gn + 84 + 8 * c);
            x1a = x1a * g1a * rs; x1b = x1b * g1b * rs; x2a = x2a * g2a * rs; x2b = x2b * g2b * rs;
            const f32x4 ca = *(const f32x4*)(cosB + pos * 16 + 8 * c), cb = *(const f32x4*)(cosB + pos * 16 + 8 * c + 4), sa = *(const f32x4*)(sinB + pos * 16 + 8 * c), sb = *(const f32x4*)(sinB + pos * 16 + 8 * c + 4);
            *(u32x4*)(dst + 64 + 8 * c) = pg8::pack8(x1a * ca - x2a * sa, x1b * cb - x2b * sb);
            *(u32x4*)(dst + 80 + 8 * c) = pg8::pack8(x2a * ca + x1a * sa, x2b * cb + x1b * sb); }
    }
}

__device__ __forceinline__ void phase5(Frame& F) {
    unsigned char* ws = F.ws;
    for (int it = F.vcu; it < 256; it += F.G) {
        const int bh = it >> 2, sidx = it & 3, b = bh >> 3, h = bh & 7;
#pragma unroll 1
        for (int k = 0; k < 2; ++k) { const int qb = k ? 7 - sidx : sidx;
            att::attn_unit<64, true>(b, qb, (const bf16_t*)(ws + WS_QA2) + h * 64, 512, (const bf16_t*)(ws + WS_KA2) + h * 64, 512, (const bf16_t*)(ws + WS_PROJ) + PC_VA + h * 64, DINP,
                                     ws + WS_Y + h * 64, 1024, (const float*)(ws + WS_KMEAN) + (size_t)bh * 512, F.lds, F.wave); }
#pragma unroll 1
        for (int k = 0; k < 2; ++k) { const int qb = k ? 7 - sidx : sidx;
            att::attn_unit<96, false>(b, qb, (const bf16_t*)(ws + WS_QB) + h * 96, 768, (const bf16_t*)(ws + WS_KB2) + h * 96, 768, (const bf16_t*)(ws + WS_KV) + h * 128 + 64, 1024,
                                      ws + WS_Y + 512 + h * 64, 1024, nullptr, F.lds, F.wave); }
    }
}

__device__ __forceinline__ void phase8(Frame& F) {
    PHASE_IDS();
    const Params& P = *F.P; unsigned char* ws = F.ws;
    constexpr int HCS = 132, WCS = 48;
    LAS float* HC = (LAS float*)F.lds;
    LAS float* WC = HC + 2 * 64 * HCS;
    LAS float* RSTD = WC + 2 * 128 * WCS;
    LAS float* LOGIT = RSTD + 64;
    LAS int* pe = (LAS int*)(LOGIT + 64 * 33);
    int* PAIR_E = (int*)(ws + WS_PAIR); int* PAIR_RANK = PAIR_E + 65536; float* PAIR_W = (float*)(PAIR_E + 131072);
    const float* gffn = P.in[I_GFFN]; const float* wr_ = P.in[I_WR]; const float* br_ = P.in[I_BR];
    const int r0 = F.vcu * 64;
    if (I_.tid < 64) { const f32x4* sp = (const f32x4*)((const float*)(ws + WS_SSP) + (size_t)(r0 + I_.tid) * 16); const f32x4 a = sp[0], b = sp[1], c = sp[2], d = sp[3];
        const float ss = (((a[0] + a[1]) + (a[2] + a[3])) + ((b[0] + b[1]) + (b[2] + b[3]))) + (((c[0] + c[1]) + (c[2] + c[3])) + ((d[0] + d[1]) + (d[2] + d[3])));
        RSTD[I_.tid] = 1.0f / sqrtf(ss * (1.f / DM) + EPS); }
    __syncthreads();
    const int eg = I_.wave & 1, rgp = I_.wave >> 1, l15 = I_.lane & 15, l4 = I_.lane >> 4;
    const int srow = I_.tid >> 5, sc4 = I_.tid & 31;
    const int wrow = I_.tid >> 3, wc4 = I_.tid & 7;
    f32x4 stg[4], wst[2];
#define P8_LOAD(kc) do { _Pragma("unroll") for (int i = 0; i < 4; ++i) stg[i] = *(const f32x4*)(P.out + (size_t)(r0 + srow + 16 * i) * DM + (kc) * 128 + 4 * sc4); \
        _Pragma("unroll") for (int i = 0; i < 2; ++i) wst[i] = *(const f32x4*)(wr_ + (size_t)((kc) * 128 + wrow + 64 * i) * 32 + 4 * wc4); } while (0)
#define P8_STORE(kc, buf) do { const f32x4 g4 = *(const f32x4*)(gffn + (kc) * 128 + 4 * sc4); _Pragma("unroll") for (int i = 0; i < 4; ++i) { const float rs = RSTD[srow + 16 * i]; const f32x4 y = stg[i] * rs * g4; \
        *(LAS f32x4*)(HC + ((buf) * 64 + srow + 16 * i) * HCS + 4 * sc4) = y; *(unsigned*)(ws + WS_HNF8 + (size_t)(r0 + srow + 16 * i) * DM + (kc) * 128 + 4 * sc4) = pack4_fp8(y.x, y.y, y.z, y.w); } \
        _Pragma("unroll") for (int i = 0; i < 2; ++i) *(LAS f32x4*)(WC + ((buf) * 128 + wrow + 64 * i) * WCS + 4 * wc4) = wst[i]; } while (0)
    P8_LOAD(0); P8_STORE(0, 0);
    __syncthreads();
    f32x4 acc = {0.f, 0.f, 0.f, 0.f};
#pragma unroll 1
    for (int kc = 0; kc < 8; ++kc) { const int buf = kc & 1;
        if (kc + 1 < 8) P8_LOAD(kc + 1);
        const LAS float* wp = WC + (buf * 128 + l4) * WCS + eg * 16 + l15;
        const LAS float* hp = HC + (buf * 64 + rgp * 16 + l15) * HCS + l4;
#pragma unroll
        for (int kk = 0; kk < 32; ++kk) acc = __builtin_amdgcn_mfma_f32_16x16x4f32(wp[4 * kk * WCS], hp[4 * kk], acc, 0, 0, 0);
        if (kc + 1 < 8) P8_STORE(kc + 1, buf ^ 1);
        __syncthreads(); }
#undef P8_LOAD
#undef P8_STORE
#pragma unroll
    for (int i = 0; i < 4; ++i) { const int e = eg * 16 + 4 * l4 + i; LOGIT[(rgp * 16 + l15) * 33 + e] = acc[i] + br_[e]; }
    __syncthreads();
    if (I_.tid < 64) { const int rr = I_.tid, m = r0 + rr;
        float lg[32];
#pragma unroll
        for (int e = 0; e < 32; ++e) lg[e] = LOGIT[rr * 33 + e];
        int te[4]; float tv[4]; unsigned used = 0u;
#pragma unroll
        for (int k = 0; k < 4; ++k) { float best = -INFINITY; int bi = 0;
#pragma unroll
            for (int e = 0; e < 32; ++e) { const bool ok = !((used >> e) & 1u) && (lg[e] > best); best = ok ? lg[e] : best; bi = ok ? e : bi; }
            used |= 1u << bi; te[k] = bi; tv[k] = best; }
        const float e0 = 1.0f, e1 = __expf(tv[1] - tv[0]), e2 = __expf(tv[2] - tv[0]), e3 = __expf(tv[3] - tv[0]); const float inv = 1.0f / (e0 + e1 + e2 + e3);
        *(i32x4*)(PAIR_E + m * 4) = (i32x4){te[0], te[1], te[2], te[3]};
        *(f32x4*)(PAIR_W + m * 4) = (f32x4){e0 * inv, e1 * inv, e2 * inv, e3 * inv};
        *(LAS i32x4*)(pe + rr * 4) = (i32x4){te[0], te[1], te[2], te[3]}; }
    __syncthreads();
    if (I_.tid < 256) { const int e = pe[I_.tid]; int rank = 0;
#pragma unroll 16
        for (int j4 = 0; j4 < 64; ++j4) { const i32x4 v = *(const LAS i32x4*)(pe + 4 * j4); const int j = 4 * j4;
            rank += ((j < I_.tid) && v.x == e) + ((j + 1 < I_.tid) && v.y == e) + ((j + 2 < I_.tid) && v.z == e) + ((j + 3 < I_.tid) && v.w == e); }
        PAIR_RANK[r0 * 4 + I_.tid] = rank; }
    else if (I_.tid < 288) { const int e = I_.tid - 256; int c = 0;
#pragma unroll 16
        for (int j4 = 0; j4 < 64; ++j4) { const i32x4 v = *(const LAS i32x4*)(pe + 4 * j4); c += (v.x == e) + (v.y == e) + (v.z == e) + (v.w == e); }
        ((int*)(ws + WS_HIST))[F.vcu * 32 + e] = c; }
    __syncthreads();
}

__device__ __forceinline__ int moe_layout(Frame& F) {
    PHASE_IDS();
    LAS int* ctl = (LAS int*)(F.lds + LDS_CTL);
    LAS int* part = ctl + 512;
    const int* HIST = (const int*)(F.ws + WS_HIST);
    __syncthreads();
    { const int e = I_.tid & 31, pt = I_.tid >> 5; int tot = 0, before = 0; int c[16];
#pragma unroll
        for (int i = 0; i < 16; ++i) c[i] = HIST[(pt * 16 + i) * 32 + e];
#pragma unroll
        for (int i = 0; i < 16; ++i) { tot += c[i]; before += (pt * 16 + i < F.vcu) ? c[i] : 0; }
        part[pt * 64 + e] = tot; part[pt * 64 + 32 + e] = before; }
    __syncthreads();
    if (I_.tid < 32) { int tot = 0, before = 0;
#pragma unroll
        for (int pt = 0; pt < 16; ++pt) { tot += part[pt * 64 + I_.tid]; before += part[pt * 64 + 32 + I_.tid]; }
        ctl[I_.tid] = tot; ctl[65 + I_.tid] = before; }
    __syncthreads();
    if (I_.tid == 0) { int row = 0, mt = 0;
        for (int e = 0; e < 32; ++e) { ctl[32 + e] = row; ctl[65 + e] += row; const int nt_ = (ctl[e] + 255) >> 8;
            for (int t = 0; t < nt_; ++t) ctl[128 + mt + t] = e;
            mt += nt_; row += nt_ * 256; }
        ctl[64] = row; ctl[100] = mt; }
    __syncthreads();
    return ctl[100];
}

__device__ __forceinline__ void phase9(Frame& F) {
    PHASE_IDS();
    unsigned char* ws = F.ws;
    moe_layout(F);
    LAS int* ctl = (LAS int*)(F.lds + LDS_CTL);
    const int* PAIR_E = (const int*)(ws + WS_PAIR); const int* PAIR_RANK = PAIR_E + 65536; int* ROWDEST = (int*)(ws + WS_PAIR) + 196608; int* TOK = (int*)(ws + WS_TOK);
    const int rows_per_blk = NTOK / F.G;
    if (I_.tid < rows_per_blk * 4) { const int gp = F.vcu * rows_per_blk * 4 + I_.tid;
        const int e = PAIR_E[gp], rk = PAIR_RANK[gp]; const int dest = ctl[65 + e] + rk;
        ROWDEST[gp] = dest; TOK[dest] = gp >> 2; }
    if (F.vcu < 32) { const int e = F.vcu; const int lo = ctl[32 + e] + ctl[e], hi = (e == 31) ? ctl[64] : ctl[33 + e];
        for (int r = lo + I_.tid; r < hi; r += NTHREADS) TOK[r] = 0; }
}

__device__ __forceinline__ void stage_tok(Frame& F, int nmt, int ntn) {
    PHASE_IDS();
    const int* TOK = (const int*)(F.ws + WS_TOK); LAS unsigned short* tokl = (LAS unsigned short*)(F.lds + LDS_TOKL);
    for (int i = 0; i < 10; ++i) { const int j = (i * F.G + (int)blockIdx.x) >> 3; const int mt = (j / ntn) * 8 + ((int)blockIdx.x & 7); if (mt >= nmt) break;
        if (I_.tid < 256) tokl[i * 256 + I_.tid] = (unsigned short)TOK[mt * 256 + I_.tid]; }
    __syncthreads();
}

__device__ __forceinline__ void phase12(Frame& F) {
    PHASE_IDS();
    const Params& P = *F.P; unsigned char* ws = F.ws;
    const int gw = F.vcu * NWAVES + I_.wave, NGW = F.G * NWAVES;
    const float* PAIR_W = (const float*)(ws + WS_PAIR) + 131072; const int* ROWDEST = (const int*)(ws + WS_PAIR) + 196608;
    const bf16_t* YP = (const bf16_t*)(ws + WS_XG);
    const f32x4* gp = (const f32x4*)P.in[I_GPLE] + I_.lane; f32x4 gv[4];
#pragma unroll
    for (int j = 0; j < 4; ++j) gv[j] = gp[64 * j];
    for (int m0 = gw; m0 < NTOK; m0 += 2 * NGW) {
        int mm[2]; mm[0] = m0; mm[1] = (m0 + NGW < NTOK) ? m0 + NGW : m0;
        f32x4 wv[2]; i32x4 dv[2];
#pragma unroll
        for (int q = 0; q < 2; ++q) { wv[q] = *(const f32x4*)(PAIR_W + mm[q] * 4); dv[q] = *(const i32x4*)(ROWDEST + mm[q] * 4); }
        f32x4 v[2][4]; u32x2 y[2][4][4];
#pragma unroll
        for (int q = 0; q < 2; ++q) { const f32x4* xr = (const f32x4*)(P.out + (size_t)mm[q] * DM) + I_.lane;
#pragma unroll
            for (int j = 0; j < 4; ++j) v[q][j] = xr[64 * j];
#pragma unroll
            for (int k = 0; k < 4; ++k) { const u32x2* yr = (const u32x2*)(YP + (size_t)dv[q][k] * DM) + I_.lane;
#pragma unroll
                for (int j = 0; j < 4; ++j) y[q][k][j] = yr[64 * j]; } }
#pragma unroll
        for (int q = 0; q < 2; ++q) { if (q == 1 && mm[1] == mm[0]) break;
            float s = 0.f; f32x4* xw = (f32x4*)(P.out + (size_t)mm[q] * DM) + I_.lane;
#pragma unroll
            for (int j = 0; j < 4; ++j) {
#pragma unroll
                for (int k = 0; k < 4; ++k) { const u32x2 yy = y[q][k][j]; v[q][j] += (f32x4){bflo(yy.x), bfhi(yy.x), bflo(yy.y), bfhi(yy.y)} * wv[q][k]; }
                xw[64 * j] = v[q][j]; s += (v[q][j].x * v[q][j].x + v[q][j].y * v[q][j].y) + (v[q][j].z * v[q][j].z + v[q][j].w * v[q][j].w); }
            const float rstd = 1.0f / sqrtf(wave_sum(s) * (1.f / DM) + EPS);
            unsigned* o4 = (unsigned*)(ws + WS_HNF8 + (size_t)mm[q] * DM) + I_.lane;
#pragma unroll
            for (int j = 0; j < 4; ++j) { const f32x4 yo = v[q][j] * rstd * gv[j]; o4[64 * j] = pack4_fp8(yo.x, yo.y, yo.z, yo.w); } }
    }
}

__global__ void __launch_bounds__(NTHREADS, 2) fwd(Params prm) {
    extern __shared__ __attribute__((aligned(16))) unsigned char lds_raw[];
    Frame F;
    F.lds = (LAS unsigned char*)lds_raw;
    F.wave = __builtin_amdgcn_readfirstlane((int)threadIdx.x >> 6);
    if (threadIdx.x < 2) ((volatile LAS unsigned*)(F.lds + LDS_BARST))[threadIdx.x] = 0u;
    const XcdBarrier bar = xcd_barrier_post((unsigned*)(prm.ws + WS_BAR), (volatile LAS unsigned*)(F.lds + LDS_BARST), F.wave);
    if (prm.ph_lo < 0) cg::this_grid().sync();
    __syncthreads();
    F.G = gridDim.x; { const int bx = blockIdx.x; F.vcu = (F.G % 8 == 0) ? (bx % 8) * (F.G / 8) + bx / 8 : bx; }
    F.P = &prm; F.ws = prm.ws;
    unsigned char* ws = prm.ws;
    const int lo = prm.ph_lo, hi = prm.ph_hi;
#ifndef PH_MASK
#define PH_MASK 0xffffu
#endif
#ifndef REP_MASK
#define REP_MASK 0u
#endif
#define IN(k) (((PH_MASK >> (k)) & 1u) && lo <= (k) && (k) < hi)
#define REPS(k) for (int rep_ = 0; rep_ < (((REP_MASK >> (k)) & 1u) ? 2 : 1); ++rep_, (((REP_MASK >> (k)) & 1u) && rep_ < 2 ? xcd_barrier(bar) : (void)0))
#define SEAM(k) do { __builtin_amdgcn_sched_barrier(0); asm volatile("" ::: "memory"); if (IN(k) && IN((k) + 1)) xcd_barrier(bar); STAMP((k) + 1); __builtin_amdgcn_sched_barrier(0); asm volatile("" ::: "memory"); } while (0)
    using namespace pg8;
    STAMP(0);
    if (IN(0)) REPS(0) phase0(F);
    SEAM(0);
    if (IN(1)) REPS(1) {
        { Gemm g{(const bf16_t*)(ws + WS_HN), (const bf16_t*)(ws + WS_WIN), DM, DM, DM}; StaticOrder S; S.init(NTOK, 2048, F.G, (int)blockIdx.x);
          const float* cosA_ = (const float*)(ws + WS_ROPE);
          EpiProj E{(bf16_t*)(ws + WS_PROJ), (bf16_t*)(ws + WS_QA2), (bf16_t*)(ws + WS_KA2), (float*)(ws + WS_KMEAN), (bf16_t*)(ws + WS_CQN), (bf16_t*)(ws + WS_CKVN),
                    prm.in[I_MQN], prm.in[I_MKN], prm.in[I_QLATN], prm.in[I_KVLATN], cosA_, cosA_ + 65536, (LAS float*)(F.lds + LDS_TOKL), (float*)(ws + WS_KPESS)};
          gemm_phase(F.lds, F.wave, g, S, E); }
        __builtin_amdgcn_sched_barrier(0); asm volatile("" ::: "memory");
        { Gemm g{(const bf16_t*)(ws + WS_HNF8), (const bf16_t*)(ws + WS_WINF8), 512, 512, 512}; StaticOrder S; S.init(NTOK, 2048, F.G, (int)blockIdx.x);
          EpiStore E{(bf16_t*)(ws + WS_PROJ) + PC_GA, DINP, nullptr, 0, 0}; gemm_phase<EpiStore, StaticOrder, false, true>(F.lds, F.wave, g, S, E); } }
    SEAM(1);
    if (IN(3)) REPS(3) {
        const float* cosB_ = (const float*)(ws + WS_ROPE) + 131072;
        { Gemm g{(const bf16_t*)(ws + WS_CQN), (const bf16_t*)(ws + WS_WUQ), 256, 256, 256}; StaticOrder S; S.init(NTOK, 1024, F.G, (int)blockIdx.x);
          EpiQB E{(bf16_t*)(ws + WS_QB), prm.in[I_MLAQN], cosB_, cosB_ + 32768, (LAS float*)(F.lds + LDS_CTL)}; gemm_phase(F.lds, F.wave, g, S, E); }
        __builtin_amdgcn_sched_barrier(0); asm volatile("" ::: "memory");
        { Gemm g{(const bf16_t*)(ws + WS_CKVN), (const bf16_t*)(ws + WS_WUKV), 128, 128, 128}; StaticOrder S; S.init(NTOK, 1024, F.G, (int)blockIdx.x);
          EpiKV E{(bf16_t*)(ws + WS_KB2), (bf16_t*)(ws + WS_KV), (const bf16_t*)(ws + WS_PROJ), (const float*)(ws + WS_KPESS), prm.in[I_MLAKN], cosB_, cosB_ + 32768, (LAS float*)(F.lds + LDS_CTL)};
          gemm_phase(F.lds, F.wave, g, S, E); } }
    SEAM(3);
    if (IN(5)) REPS(5) phase5(F);
    SEAM(5);
    if (IN(6)) REPS(6) { Gemm g{(const bf16_t*)(ws + WS_Y), (const bf16_t*)(ws + WS_WA), 512, 256, 256}; BranchOrder S; S.so.init(NTOK, DM, F.G, (int)blockIdx.x);
        EpiGateAB E{(bf16_t*)(ws + WS_MERGED), (const bf16_t*)(ws + WS_PROJ) + PC_GA, (const bf16_t*)(ws + WS_PROJ) + PC_GB, DINP, ws + WS_KA2  };
        gemm_phase<EpiGateAB, BranchOrder, false, true>(F.lds, F.wave, g, S, E); }
    SEAM(7);
    if (IN(8)) REPS(8) { Gemm g{(const bf16_t*)(ws + WS_KA2), (const bf16_t*)(ws + WS_WO), 512, 512, 512}; StaticOrder S; S.init(NTOK, DM, F.G, (int)blockIdx.x);
        EpiResF32 E{prm.in[I_X], prm.out, (float*)(ws + WS_SSP)}; gemm_phase<EpiResF32, StaticOrder, false, true>(F.lds, F.wave, g, S, E); }
    SEAM(8);
    if (IN(9)) REPS(9) phase8(F);
    SEAM(9);
    if (IN(10)) REPS(10) phase9(F);
    SEAM(10);
    if (IN(11)) REPS(11) { const int nmt = ((const LAS int*)(F.lds + LDS_CTL))[100]; stage_tok(F, nmt, 8);
        Gemm g{(const bf16_t*)(ws + WS_HNF8), (const bf16_t*)(ws + WS_W1), 512, 512, 512}; MoeOrder S{(const LAS int*)(F.lds + LDS_CTL) + 128, nmt, 8, F.G, (int)blockIdx.x};
        EpiSwiglu E{ws + WS_ACT, prm.in[I_BGU]}; gemm_phase<EpiSwiglu, MoeOrder, true, true>(F.lds, F.wave, g, S, E, (const LAS unsigned short*)(F.lds + LDS_TOKL)); }
    SEAM(11);
    if (IN(12)) REPS(12) { const int nmt = ((const LAS int*)(F.lds + LDS_CTL))[100];
        Gemm g{(const bf16_t*)(ws + WS_ACT), (const bf16_t*)(ws + WS_W2), 512, 512, 512}; MoeOrder S{(const LAS int*)(F.lds + LDS_CTL) + 128, nmt, 4, F.G, (int)blockIdx.x};
        EpiStore E{(bf16_t*)(ws + WS_XG), DM, prm.in[I_BD], 1024, 1 << 30}; gemm_phase<EpiStore, MoeOrder, false, true>(F.lds, F.wave, g, S, E); }
    SEAM(12);
    if (IN(13)) REPS(13) phase12(F);
    SEAM(13);
    if (IN(14)) REPS(14) { Gemm g{(const bf16_t*)(ws + WS_PB), (const bf16_t*)(ws + WS_WPP), 256, 256, 256}; StaticOrder S; S.init(NTOK, DM, F.G, (int)blockIdx.x);
        EpiStore E{(bf16_t*)(ws + WS_PP), DM, nullptr, 0, 1 << 30}; gemm_phase(F.lds, F.wave, g, S, E); }
    __builtin_amdgcn_sched_barrier(0); asm volatile("s_waitcnt vmcnt(0)" ::: "memory"); __syncthreads();
    if (IN(15)) REPS(15) { Gemm g{(const bf16_t*)(ws + WS_HNF8), (const bf16_t*)(ws + WS_WPG), 512, 512, 512}; StaticOrder S; S.init(NTOK, DM, F.G, (int)blockIdx.x);
        EpiFinal E{prm.out, (const bf16_t*)(ws + WS_PP)}; gemm_phase<EpiFinal, StaticOrder, false, true>(F.lds, F.wave, g, S, E); }
#ifdef TPROBE_A
    STAMP(16);
    xcd_barrier(bar);
    if (blockIdx.x == 0 && F.wave == 0 && lane_id() == 0) {
        volatile unsigned long long* ts = (volatile unsigned long long*)(ws + WS_ERR);
        const unsigned long long da = ts[TPROBE_A1] - ts[TPROBE_A], db = ts[TPROBE_B1] - ts[TPROBE_B];
        asm volatile("s_waitcnt vmcnt(0)" ::: "memory");
        prm.out[0] += (float)db * (0.01f / 4.0f);
        const unsigned long long t0 = __builtin_amdgcn_s_memrealtime();
        while (__builtin_amdgcn_s_memrealtime() - t0 < 4ull * da) __builtin_amdgcn_s_sleep(4);
    }
#endif
#undef IN
#undef SEAM
}

extern "C" void kernel_launch(void* const* d_in, const int* in_sizes, int n_in, void* d_out, int out_size, void* d_ws, size_t ws_size, hipStream_t stream) {
    static int grid = 0;
    if (grid == 0) {
        int dev = 0, cus = 0, per_cu = 0;
        (void)hipGetDevice(&dev);
        (void)hipDeviceGetAttribute(&cus, hipDeviceAttributeMultiprocessorCount, dev);
        (void)hipFuncSetAttribute((const void*)fwd, hipFuncAttributeMaxDynamicSharedMemorySize, LDS_BYTES);
        (void)hipOccupancyMaxActiveBlocksPerMultiprocessor(&per_cu, (const void*)fwd, NTHREADS, LDS_BYTES);
        fprintf(stderr, "cus %d per_cu %d ws %zu n_in %d\n", cus, per_cu, ws_size, n_in);
        grid = (per_cu >= 1) ? cus : -1;
        if (grid != 256 || n_in != 25 || ws_size < WS_END || out_size != NTOK * DM) { fprintf(stderr, "kernel_launch: unsupported configuration\n"); grid = -1; }
    }
    if (grid < 0) return;
    (void)hipMemsetAsync((char*)d_ws + WS_BAR, 0, WS_BAR_BYTES, stream);
    Params a{};
    for (int i = 0; i < 25; ++i) a.in[i] = (const float*)d_in[i];
    a.out = (float*)d_out; a.ws = (unsigned char*)d_ws;
#ifndef MULTI_LAUNCH
    a.ph_lo = 0; a.ph_hi = NPHASE;
    void* args[] = {&a};
    hipError_t e = hipLaunchCooperativeKernel((const void*)fwd, dim3(grid), dim3(NTHREADS), args, LDS_BYTES, stream);
    if (e != hipSuccess) fprintf(stderr, "cooperative launch failed: %s\n", hipGetErrorString(e));
#else
    for (int k = 0; k < NPHASE; ++k) { a.ph_lo = k; a.ph_hi = k + 1; void* args[] = {&a};
        hipError_t e = hipLaunchCooperativeKernel((const void*)fwd, dim3(grid), dim3(NTHREADS), args, LDS_BYTES, stream);
        if (e != hipSuccess) fprintf(stderr, "launch %d failed: %s\n", k, hipGetErrorString(e)); }
#endif
}
```

```cpp
#include <hip/hip_runtime.h>
#include <hip/hip_cooperative_groups.h>
#include <cstdio>
#include <cstdint>
namespace cg = cooperative_groups;

#define LAS __attribute__((address_space(3)))
typedef unsigned short bf16_t;
typedef short bf16x8 __attribute__((ext_vector_type(8)));
typedef short s16x4 __attribute__((ext_vector_type(4)));
typedef float f32x4 __attribute__((ext_vector_type(4)));
typedef float f32x2 __attribute__((ext_vector_type(2)));
typedef float f32x16 __attribute__((ext_vector_type(16)));
typedef unsigned u32x4 __attribute__((ext_vector_type(4)));
typedef unsigned u32x2 __attribute__((ext_vector_type(2)));
typedef int i32x4 __attribute__((ext_vector_type(4)));
typedef int i32x8 __attribute__((ext_vector_type(8)));
typedef __bf16 bf16x2_t __attribute__((ext_vector_type(2)));

constexpr int NB = 8, SEQ = 2048, NTOK = NB * SEQ, DM = 1024;
constexpr int DIN = 4000, DINP = 4096;
constexpr int NEXP = 32, TOPK = 4, DEXP = 1024;
constexpr int NTHREADS = 512, NWAVES = 8;
constexpr float EPS = 1e-6f;
constexpr float LOG2E = 1.4426950408889634f;
constexpr float C2A = 0.125f * LOG2E;
constexpr float C2B = 0.10206207261596575f * LOG2E;
constexpr int PC_QA = 0, PC_KA = 512, PC_VA = 1024, PC_CQ = 1536, PC_CKV = 1792, PC_KPE = 1920, PC_GA = 2048, PC_GB = 3072;

constexpr size_t MiB = 1u << 20;
constexpr size_t WS_HIST = 0;
constexpr size_t WS_ERR = 64 * 1024;
constexpr size_t WS_BAR = 128 * 1024;
constexpr size_t WS_BAR_BYTES = 16 * 1024;
constexpr size_t WS_KPESS = 576 * 1024;
constexpr size_t WS_TOK = 256 * 1024;
constexpr size_t WS_ROPE = 1 * MiB;
constexpr size_t WS_KMEAN = 2 * MiB;
constexpr size_t WS_SSP = 11 * MiB;
constexpr size_t WS_PAIR = 3 * MiB;
constexpr size_t WS_WUQ = 4 * MiB, WS_WUKV = 4 * MiB + 512 * 1024, WS_WPP = 5 * MiB, WS_WA = 6 * MiB, WS_WB = 7 * MiB, WS_WO = 8 * MiB, WS_WPG = 10 * MiB, WS_WIN = 12 * MiB;
constexpr size_t WS_W1 = 20 * MiB, WS_W2 = 148 * MiB;
constexpr size_t WS_WINF8 = 16 * MiB;
constexpr size_t WS_HNF8 = 84 * MiB;
constexpr size_t WS_HN = 212 * MiB, WS_PB = 244 * MiB;
constexpr size_t WS_X1B = WS_HN;
constexpr size_t WS_CQN = 252 * MiB, WS_CKVN = 260 * MiB, WS_QB = 264 * MiB, WS_KV = 288 * MiB, WS_KB2 = 320 * MiB, WS_Y = 344 * MiB, WS_MERGED = 376 * MiB;
constexpr size_t WS_ACT = 252 * MiB;
constexpr size_t WS_PP = 400 * MiB;
constexpr size_t WS_KA2 = 432 * MiB;
constexpr size_t WS_PROJ = 448 * MiB;
constexpr size_t WS_QA2 = 576 * MiB;
constexpr size_t WS_XG = 448 * MiB;
constexpr size_t WS_END = 592 * MiB;
constexpr int MAXROWS = 73728, MAXMT = 288;

constexpr int RING_BYTES = 131072;
constexpr int LDS_CTL = RING_BYTES;
constexpr int LDS_TOKL = RING_BYTES + 8192 + 256;
constexpr int LDS_BARST = RING_BYTES + 8192;
constexpr int LDS_BYTES = 147456;

__device__ __forceinline__ unsigned cvt_pk_bf16(float lo, float hi) { f32x2 v = {lo, hi}; bf16x2_t b = __builtin_convertvector(v, bf16x2_t); return __builtin_bit_cast(unsigned, b); }
__device__ __forceinline__ unsigned pack4_fp8(float a, float b, float c, float d) { int w = 0; w = __builtin_amdgcn_cvt_pk_fp8_f32(a, b, w, false); w = __builtin_amdgcn_cvt_pk_fp8_f32(c, d, w, true); return (unsigned)w; }
__device__ __forceinline__ float bf2f(unsigned short b) { return __uint_as_float(((unsigned)b) << 16); }
__device__ __forceinline__ float bflo(unsigned w) { return __uint_as_float(w << 16); }
__device__ __forceinline__ float bfhi(unsigned w) { return __uint_as_float(w & 0xffff0000u); }
__device__ __forceinline__ float sigmoidf_(float x) { return __builtin_amdgcn_rcpf(1.0f + __builtin_amdgcn_exp2f(-x * LOG2E)); }
__device__ __forceinline__ int lane_id() { return (int)__builtin_amdgcn_mbcnt_hi(~0u, __builtin_amdgcn_mbcnt_lo(~0u, 0u)); }
__device__ __forceinline__ float wave_sum(float v) {
#pragma unroll
    for (int o = 1; o < 64; o <<= 1) v += __shfl_xor(v, o);
    return v;
}

namespace pg8 {
constexpr int BM = 256, BK = 64, HALF = 128, HTB = HALF * BK * 2, STAGE_BYTES = 8 * HTB, NXCD = 8, WGM = 8;
__host__ __device__ __forceinline__ int lds_byte(int r, int c) { const int st = (r >> 4) * 2 + (c >> 5), rr = r & 15, cc = c & 31, ob = rr * 64 + cc * 2; return st * 1024 + (ob ^ (((ob >> 9) & 1) << 5)); }
__host__ __device__ __forceinline__ void stage_rc(int b, int& R, int& C) { const int st = b / 1024, sb = b % 1024, swz = sb ^ (((sb >> 9) & 1) << 5); R = (st >> 1) * 16 + swz / 64; C = (st & 1) * 32 + (swz % 64) / 2; }
__host__ __device__ __forceinline__ int perm32(int rho) { const int n = rho >> 4, i = rho & 15; return 8 * (i >> 2) + 4 * n + (i & 3); }

struct Unit { int pm, pn, pb, e; int aofs = 0; };
struct Gemm { const bf16_t* A; const bf16_t* Bt; int lda, ldb, K; };

struct StaticOrder {
    int nM, nN, nwg, G, c;
    __device__ void init(int M, int N, int G_, int c_) { nM = M / BM; nN = N / BM; nwg = nM * nN; G = G_; c = c_; }
    __device__ bool next(int i, Unit& u) const {
        const long L = (long)i * G + c; if (L >= nwg) return false;
        int wgid = (int)L; { const int q = nwg / NXCD, r = nwg % NXCD, xcd = wgid % NXCD, off = wgid / NXCD; wgid = (xcd < r ? xcd * (q + 1) : r * (q + 1) + (xcd - r) * q) + off; }
        const int nig = WGM * nN, gid = wgid / nig, fm = gid * WGM, gsz = (nM - fm) < WGM ? (nM - fm) : WGM;
        u.pm = fm + ((wgid % nig) % gsz); u.pn = (wgid % nig) / gsz; u.pb = u.pn; u.e = 0; return true;
    }
};
struct MoeOrder {
    const LAS int* tile_e; int nmt, ntn, G, c;
    __device__ bool next(int i, Unit& u) const {
        const int j = (i * G + c) >> 3; const int mt = (j / ntn) * 8 + (c & 7), pn = j % ntn; if (mt >= nmt) return false;
        const int e = __builtin_amdgcn_readfirstlane(tile_e[mt]);
        u.pm = mt; u.pn = pn; u.pb = e * ntn + pn; u.e = e; return true;
    }
};

template <class Epi, class Sched, bool GATHER = false, bool FP8 = false>
__device__ __forceinline__ void gemm_phase(LAS unsigned char* lds, int wave, const Gemm g, const Sched& S, const Epi& E, const LAS unsigned short* tokl = nullptr) {
    constexpr bool ALIGN_EPI = true;
    int lane = lane_id(); asm volatile("" : "+v"(lane));
    const int wid = wave, tid = wid * 64 + lane, wr = wid >> 2, wc = wid & 3, fr = lane & 15, fq = lane >> 4;
    int K = g.K; asm volatile("" : "+s"(K));
    const int nt = K / BK;
    unsigned voffA[2], voffB[2]; int gR[2]; unsigned gC[2];
#pragma unroll
    for (int i = 0; i < 2; ++i) { int R, C; stage_rc(tid * 16 + i * 8192, R, C); const int Rb = (R & ~31) + perm32(R & 31);
        voffA[i] = (unsigned)(R * g.lda + C) * 2u; voffB[i] = (unsigned)(Rb * g.ldb + C) * 2u; gR[i] = R; gC[i] = (unsigned)C * 2u; }
    unsigned goff[2][2], noff[2][2];
#define PG8_GOFF(dst, ui_) do { _Pragma("unroll") for (int h_ = 0; h_ < 2; ++h_) _Pragma("unroll") for (int i_ = 0; i_ < 2; ++i_) \
        dst[h_][i_] = (unsigned)tokl[(ui_) * 256 + h_ * HALF + gR[i_]] * (unsigned)(g.lda * 2) + gC[i_]; } while (0)
    const size_t kstep = (size_t)(BK * 2);
    const size_t hstepA = (size_t)HALF * g.lda * 2, hstepB = (size_t)HALF * g.ldb * 2;
    const size_t tstepA = 2 * hstepA, tstepB = 2 * hstepB;
    const unsigned ldsw = (unsigned)wid * 1024u;
    const int aoff = lds_byte(wr * 64 + fr, fq * 8), boff = lds_byte(wc * 32 + fr, fq * 8);
#define PG8_SA(b, h) (((b) * 2 + (h)) * HTB)
#define PG8_SB(b, h) ((4 + (b) * 2 + (h)) * HTB)
#define PG8_STAGE(bufoff, gbase, voff) do { _Pragma("unroll") for (int _i = 0; _i < 2; ++_i) \
        __builtin_amdgcn_global_load_lds((const unsigned*)((const char*)(gbase) + (voff)[_i]), (LAS unsigned*)(lds + (bufoff) + ldsw + _i * 8192), 16, 0, 0); } while (0)
#define PG8_STAGE_A(bufoff, ptr_ng, k_g, off_g) do { if constexpr (GATHER) { const char* gb_ = (const char*)g.A + (size_t)(k_g) * kstep; PG8_STAGE(bufoff, gb_, off_g); } else { PG8_STAGE(bufoff, ptr_ng, voffA); } } while (0)
#define PG8_LDA(dst, b, h) do { if constexpr (FP8) { _Pragma("unroll") for (int m = 0; m < 4; ++m) { const i32x4 lo_ = *(const LAS i32x4*)(lds + PG8_SA(b, h) + aoff + m * 2048), hi_ = *(const LAS i32x4*)(lds + PG8_SA(b, h) + aoff + m * 2048 + 1024); dst##8[m] = __builtin_shufflevector(lo_, hi_, 0, 1, 2, 3, 4, 5, 6, 7); } } \
        else { _Pragma("unroll") for (int m = 0; m < 4; ++m) _Pragma("unroll") for (int k = 0; k < 2; ++k) dst[m][k] = *(const LAS bf16x8*)(lds + PG8_SA(b, h) + aoff + m * 2048 + k * 1024); } } while (0)
#define PG8_LDB(dst, b, h) do { if constexpr (FP8) { _Pragma("unroll") for (int n = 0; n < 2; ++n) { const i32x4 lo_ = *(const LAS i32x4*)(lds + PG8_SB(b, h) + boff + n * 2048), hi_ = *(const LAS i32x4*)(lds + PG8_SB(b, h) + boff + n * 2048 + 1024); dst##8[n] = __builtin_shufflevector(lo_, hi_, 0, 1, 2, 3, 4, 5, 6, 7); } } \
        else { _Pragma("unroll") for (int n = 0; n < 2; ++n) _Pragma("unroll") for (int k = 0; k < 2; ++k) dst[n][k] = *(const LAS bf16x8*)(lds + PG8_SB(b, h) + boff + n * 2048 + k * 1024); } } while (0)
#define PG8_CAT8(x, y) __builtin_shufflevector(__builtin_bit_cast(i32x4, x), __builtin_bit_cast(i32x4, y), 0, 1, 2, 3, 4, 5, 6, 7)
#define PG8_MMA(ai, bj, At, Bt) do { __builtin_amdgcn_s_setprio(1); if constexpr (FP8) { _Pragma("unroll") for (int m = 0; m < 4; ++m) _Pragma("unroll") for (int n = 0; n < 2; ++n) \
        asm volatile("v_mfma_scale_f32_16x16x128_f8f6f4 %0, %1, %2, %0, %3, %3 op_sel_hi:[0,0,0]" : "+v"(acc[ai][bj][m][n]) : "v"(Bt##8[n]), "v"(At##8[m]), "v"(sc8)); } \
        else { _Pragma("unroll") for (int m = 0; m < 4; ++m) _Pragma("unroll") for (int n = 0; n < 2; ++n) _Pragma("unroll") for (int k = 0; k < 2; ++k) \
        acc[ai][bj][m][n] = __builtin_amdgcn_mfma_f32_16x16x32_bf16(Bt[n][k], At[m][k], acc[ai][bj][m][n], 0, 0, 0); } __builtin_amdgcn_s_setprio(0); } while (0)
#define PG8_WAIT_V(n) asm volatile("s_waitcnt vmcnt(" #n ")" ::: "memory")
#define PG8_WAIT_L(n) asm volatile("s_waitcnt lgkmcnt(" #n ")" ::: "memory")
#define PG8_BAR __builtin_amdgcn_s_barrier()
#define PG8_SCHED __builtin_amdgcn_sched_barrier(0)
    Unit cur, nxt; int ui = 0;
    if (!S.next(0, cur)) return;
    f32x4 acc[2][2][4][2];
#pragma unroll
    for (int a = 0; a < 2; ++a)
#pragma unroll
        for (int b = 0; b < 2; ++b)
#pragma unroll
            for (int m = 0; m < 4; ++m)
#pragma unroll
                for (int n = 0; n < 2; ++n) acc[a][b][m][n] = (f32x4){0.f, 0.f, 0.f, 0.f};
    const int sc8 = 0x7c7c7c7c;
    bf16x8 At[4][2], B0[2][2], B1[2][2]; i32x8 At8[4], B08[2], B18[2];
    const char* cA = (const char*)g.A + (size_t)cur.pm * tstepA + cur.aofs; const char* cB = (const char*)g.Bt + (size_t)cur.pb * tstepB;
    if constexpr (GATHER) { PG8_GOFF(goff, 0); }
    PG8_STAGE(PG8_SB(0, 0), cB, voffB); PG8_STAGE(PG8_SB(0, 1), cB + hstepB, voffB); PG8_STAGE_A(PG8_SA(0, 0), cA, 0, goff[0]); PG8_STAGE_A(PG8_SA(0, 1), cA + hstepA, 0, goff[1]);
    if (wr == 1) PG8_BAR;
    PG8_WAIT_V(2); PG8_BAR;
    PG8_STAGE(PG8_SB(1, 0), cB + kstep, voffB); PG8_STAGE_A(PG8_SA(1, 0), cA + kstep, 1, goff[0]); PG8_STAGE(PG8_SB(1, 1), cB + hstepB + kstep, voffB);
    PG8_WAIT_V(6); PG8_BAR;
    for (;;) {
        const bool has_next = S.next(ui + 1, nxt);
        const char* nA = has_next ? (const char*)g.A + (size_t)nxt.pm * tstepA + nxt.aofs : cA; const char* nB = has_next ? (const char*)g.Bt + (size_t)nxt.pb * tstepB : cB;
        if constexpr (GATHER) { if (has_next) { PG8_GOFF(noff, ui + 1); } else {
#pragma unroll
            for (int h_ = 0; h_ < 2; ++h_)
#pragma unroll
                for (int i_ = 0; i_ < 2; ++i_) noff[h_][i_] = goff[h_][i_]; } }
        for (int t = 0; t < nt; t += 2) {
            const bool last = (t == nt - 2);
            const char* a1 = cA + (size_t)(t + 1) * kstep;
            const char* a2 = last ? nA : cA + (size_t)(t + 2) * kstep; const char* b2 = last ? nB : cB + (size_t)(t + 2) * kstep;
            const char* a3 = a2 + kstep; const char* b3 = b2 + kstep;
            const int k2 = last ? 0 : t + 2;
            unsigned soff[2][2];
            if constexpr (GATHER) {
#pragma unroll
                for (int h_ = 0; h_ < 2; ++h_)
#pragma unroll
                    for (int i_ = 0; i_ < 2; ++i_) soff[h_][i_] = last ? noff[h_][i_] : goff[h_][i_]; }
            PG8_LDB(B0, 0, 0); PG8_LDB(B1, 0, 1); PG8_SCHED; PG8_LDA(At, 0, 0); PG8_STAGE_A(PG8_SA(1, 1), a1 + hstepA, t + 1, goff[1]);
            PG8_WAIT_V(8); PG8_WAIT_L(0); PG8_BAR; PG8_MMA(0, 0, At, B0); PG8_MMA(0, 1, At, B1); PG8_BAR; PG8_SCHED;
            PG8_LDA(At, 0, 1); PG8_STAGE(PG8_SB(0, 0), b2, voffB); PG8_STAGE(PG8_SB(0, 1), b2 + hstepB, voffB); PG8_STAGE_A(PG8_SA(0, 0), a2, k2, soff[0]);
            PG8_WAIT_V(8); PG8_WAIT_L(0); PG8_BAR; PG8_MMA(1, 0, At, B0); PG8_MMA(1, 1, At, B1); PG8_BAR; PG8_SCHED;
            PG8_LDB(B0, 1, 0); PG8_LDB(B1, 1, 1); PG8_SCHED; PG8_LDA(At, 1, 0); PG8_STAGE_A(PG8_SA(0, 1), a2 + hstepA, k2, soff[1]);
            PG8_WAIT_V(8); PG8_WAIT_L(0); PG8_BAR; PG8_MMA(0, 0, At, B0); PG8_MMA(0, 1, At, B1); PG8_BAR; PG8_SCHED;
            PG8_LDA(At, 1, 1); PG8_STAGE(PG8_SB(1, 0), b3, voffB); PG8_STAGE(PG8_SB(1, 1), b3 + hstepB, voffB); PG8_STAGE_A(PG8_SA(1, 0), a3, k2 + 1, soff[0]);
            PG8_WAIT_V(8); PG8_WAIT_L(0); PG8_BAR; PG8_MMA(1, 0, At, B0); PG8_MMA(1, 1, At, B1); PG8_BAR; PG8_SCHED;
        }
        if constexpr (ALIGN_EPI) { if (wr == 0) PG8_BAR; }
        if constexpr (FP8) asm volatile("s_nop 15\n\ts_nop 15" ::: "memory");
        E(acc, cur, wr, wc, fr, fq);
        if (!has_next) break;
#pragma unroll
        for (int a = 0; a < 2; ++a)
#pragma unroll
            for (int b = 0; b < 2; ++b)
#pragma unroll
                for (int m = 0; m < 4; ++m)
#pragma unroll
                    for (int n = 0; n < 2; ++n) acc[a][b][m][n] = (f32x4){0.f, 0.f, 0.f, 0.f};
        cur = nxt; cA = nA; cB = nB; ++ui;
        if constexpr (GATHER) {
#pragma unroll
            for (int h_ = 0; h_ < 2; ++h_)
#pragma unroll
                for (int i_ = 0; i_ < 2; ++i_) goff[h_][i_] = noff[h_][i_]; }
        if constexpr (ALIGN_EPI) { if (wr == 1) PG8_BAR; }
    }
    PG8_WAIT_V(0);
    if constexpr (!ALIGN_EPI) { if (wr == 0) PG8_BAR; }
    PG8_BAR;
#undef PG8_SA
#undef PG8_SB
#undef PG8_STAGE
#undef PG8_STAGE_A
#undef PG8_GOFF
#undef PG8_LDA
#undef PG8_LDB
#undef PG8_MMA
#undef PG8_CAT8
#undef PG8_WAIT_V
#undef PG8_WAIT_L
#undef PG8_BAR
#undef PG8_SCHED
}

#define EPI_ARGS const f32x4 (&acc)[2][2][4][2], const Unit& u, int wr, int wc, int fr, int fq
__device__ __forceinline__ u32x4 pack8(f32x4 v0, f32x4 v1) { u32x4 w; w.x = cvt_pk_bf16(v0[0], v0[1]); w.y = cvt_pk_bf16(v0[2], v0[3]); w.z = cvt_pk_bf16(v1[0], v1[1]); w.w = cvt_pk_bf16(v1[2], v1[3]); return w; }
__device__ __forceinline__ void unpack8(u32x4 w, f32x4& v0, f32x4& v1) { v0 = (f32x4){bflo(w.x), bfhi(w.x), bflo(w.y), bfhi(w.y)}; v1 = (f32x4){bflo(w.z), bfhi(w.z), bflo(w.w), bfhi(w.w)}; }
__device__ __forceinline__ f32x4 sig4(f32x4 v) { return (f32x4){sigmoidf_(v[0]), sigmoidf_(v[1]), sigmoidf_(v[2]), sigmoidf_(v[3])}; }

struct EpiStore {
    bf16_t* O; int ldc; const float* bias; int bias_stride; int sig_from;
    __device__ __forceinline__ void operator()(EPI_ARGS) const {
        const int row0 = u.pm * BM + wr * 64 + fr, col0 = u.pn * BM + wc * 32 + 8 * fq;
        const bool sg = u.pn >= sig_from;
        f32x4 bv[2][2];
#pragma unroll
        for (int bj = 0; bj < 2; ++bj)
#pragma unroll
            for (int n = 0; n < 2; ++n) bv[bj][n] = bias ? *(const f32x4*)(bias + (size_t)u.e * bias_stride + col0 + bj * HALF + 4 * n) : (f32x4){0.f, 0.f, 0.f, 0.f};
#pragma unroll
        for (int ai = 0; ai < 2; ++ai)
#pragma unroll
            for (int m = 0; m < 4; ++m) { bf16_t* rowp = O + (size_t)(row0 + ai * HALF + m * 16) * ldc + col0;
#pragma unroll
                for (int bj = 0; bj < 2; ++bj) { f32x4 v0 = acc[ai][bj][m][0] + bv[bj][0], v1 = acc[ai][bj][m][1] + bv[bj][1];
                    if (sg) { v0 = sig4(v0); v1 = sig4(v1); }
                    *(u32x4*)(rowp + bj * HALF) = pack8(v0, v1); } }
    }
};

struct EpiProj {
    bf16_t* PROJ; bf16_t* QA2; bf16_t* KA2; float* KMEAN; bf16_t* CQN; bf16_t* CKVN;
    const float* gq; const float* gk; const float* glq; const float* glkv; const float* cosA; const float* sinA; LAS float* xch;
    float* KPESS;
    __device__ __forceinline__ void operator()(EPI_ARGS) const {
        const int row0 = u.pm * BM + wr * 64 + fr, col0 = u.pn * BM + wc * 32 + 8 * fq;
        if (u.pn < 4) {
            const bool isk = u.pn >= 2; const int h = 4 * (u.pn & 1) + wc; const float* gn = isk ? gk : gq; const float sc = isk ? 1.0f : C2A;
            const f32x4 g1a = *(const f32x4*)(gn + 8 * fq), g1b = *(const f32x4*)(gn + 8 * fq + 4), g2a = *(const f32x4*)(gn + 32 + 8 * fq), g2b = *(const f32x4*)(gn + 36 + 8 * fq);
            bf16_t* dst = isk ? KA2 : QA2;
            f32x4 ks1a = {0.f, 0.f, 0.f, 0.f}, ks1b = ks1a, ks2a = ks1a, ks2b = ks1a;
#pragma unroll
            for (int ai = 0; ai < 2; ++ai)
#pragma unroll
                for (int m = 0; m < 4; ++m) { const int row = row0 + ai * HALF + m * 16; const int pos = row & (SEQ - 1);
                    f32x4 x1a = acc[ai][0][m][0], x1b = acc[ai][0][m][1], x2a = acc[ai][1][m][0], x2b = acc[ai][1][m][1];
                    float ss = (x1a[0] * x1a[0] + x1a[1] * x1a[1]) + (x1a[2] * x1a[2] + x1a[3] * x1a[3]) + (x1b[0] * x1b[0] + x1b[1] * x1b[1]) + (x1b[2] * x1b[2] + x1b[3] * x1b[3])
                             + (x2a[0] * x2a[0] + x2a[1] * x2a[1]) + (x2a[2] * x2a[2] + x2a[3] * x2a[3]) + (x2b[0] * x2b[0] + x2b[1] * x2b[1]) + (x2b[2] * x2b[2] + x2b[3] * x2b[3]);
                    ss += __shfl_xor(ss, 16); ss += __shfl_xor(ss, 32);
                    const float rstd = 1.0f / sqrtf(ss * (1.f / 64.f) + EPS);
                    x1a = x1a * g1a * rstd; x1b = x1b * g1b * rstd; x2a = x2a * g2a * rstd; x2b = x2b * g2b * rstd;
                    const f32x4 ca = *(const f32x4*)(cosA + pos * 32 + 8 * fq), cb = *(const f32x4*)(cosA + pos * 32 + 8 * fq + 4), sa = *(const f32x4*)(sinA + pos * 32 + 8 * fq), sb = *(const f32x4*)(sinA + pos * 32 + 8 * fq + 4);
                    const f32x4 y1a = x1a * ca - x2a * sa, y1b = x1b * cb - x2b * sb, y2a = x2a * ca + x1a * sa, y2b = x2b * cb + x1b * sb;
                    bf16_t* rp = dst + (size_t)row * 512 + h * 64 + 8 * fq;
                    *(u32x4*)rp = pack8(y1a * sc, y1b * sc); *(u32x4*)(rp + 32) = pack8(y2a * sc, y2b * sc);
                    ks1a += y1a; ks1b += y1b; ks2a += y2a; ks2b += y2b; }
            if (isk) {
#pragma unroll
                for (int o = 1; o < 16; o <<= 1) {
#pragma unroll
                    for (int i = 0; i < 4; ++i) { ks1a[i] += __shfl_xor(ks1a[i], o); ks1b[i] += __shfl_xor(ks1b[i], o); ks2a[i] += __shfl_xor(ks2a[i], o); ks2b[i] += __shfl_xor(ks2b[i], o); } }
                if (fr == 0) { float* km = KMEAN + (((size_t)(u.pm >> 3) * 8 + h) * 8 + (u.pm & 7)) * 64 + 8 * fq;
#pragma unroll
                    for (int i = 0; i < 4; ++i) { atomicAdd(km + i, ks1a[i] * (1.f / 256.f)); atomicAdd(km + 4 + i, ks1b[i] * (1.f / 256.f)); atomicAdd(km + 32 + i, ks2a[i] * (1.f / 256.f)); atomicAdd(km + 36 + i, ks2b[i] * (1.f / 256.f)); } } }
        } else if (u.pn == 6 || u.pn == 7) {
            const bool isq = u.pn == 6;
            float ssr[2][4];
#pragma unroll
            for (int ai = 0; ai < 2; ++ai)
#pragma unroll
                for (int m = 0; m < 4; ++m) { float ss = 0.f;
#pragma unroll
                    for (int bj = 0; bj < 2; ++bj) { if (bj == 1 && !isq) continue;
#pragma unroll
                        for (int n = 0; n < 2; ++n) { const f32x4 x = acc[ai][bj][m][n]; ss += (x[0] * x[0] + x[1] * x[1]) + (x[2] * x[2] + x[3] * x[3]); } }
                    ss += __shfl_xor(ss, 16); ss += __shfl_xor(ss, 32);
                    if (fq == 0) xch[(ai * HALF + wr * 64 + m * 16 + fr) * 4 + wc] = ss; }
            asm volatile("s_waitcnt lgkmcnt(0)" ::: "memory"); __builtin_amdgcn_s_barrier(); asm volatile("" ::: "memory");
#pragma unroll
            for (int ai = 0; ai < 2; ++ai)
#pragma unroll
                for (int m = 0; m < 4; ++m) { const f32x4 p4 = *(const LAS f32x4*)(xch + (ai * HALF + wr * 64 + m * 16 + fr) * 4); ssr[ai][m] = (p4[0] + p4[1]) + (p4[2] + p4[3]); }
            asm volatile("s_waitcnt lgkmcnt(0)" ::: "memory"); __builtin_amdgcn_s_barrier(); asm volatile("" ::: "memory");
            const float invn = isq ? (1.f / 256.f) : (1.f / 128.f); const float* gl = isq ? glq : glkv; bf16_t* dn = isq ? CQN : CKVN; const int ldn = isq ? 256 : 128;
            const int c0 = wc * 32 + 8 * fq;
#pragma unroll
            for (int bj = 0; bj < 2; ++bj) {
                if (bj == 1 && !isq) {
#pragma unroll
                    for (int ai = 0; ai < 2; ++ai)
#pragma unroll
                        for (int m = 0; m < 4; ++m) { const f32x4 x0 = acc[ai][1][m][0], x1 = acc[ai][1][m][1];
                            *(u32x4*)(PROJ + (size_t)(row0 + ai * HALF + m * 16) * DINP + col0 + HALF) = pack8(x0, x1);
                            float ss = (x0[0] * x0[0] + x0[1] * x0[1]) + (x0[2] * x0[2] + x0[3] * x0[3]) + (x1[0] * x1[0] + x1[1] * x1[1]) + (x1[2] * x1[2] + x1[3] * x1[3]);
                            ss += __shfl_xor(ss, 16); ss += __shfl_xor(ss, 32);
                            if (wc == 0 && fq == 0) KPESS[row0 + ai * HALF + m * 16] = ss; }
                    continue; }
                const f32x4 ga = *(const f32x4*)(gl + bj * HALF + c0), gb = *(const f32x4*)(gl + bj * HALF + c0 + 4);
#pragma unroll
                for (int ai = 0; ai < 2; ++ai)
#pragma unroll
                    for (int m = 0; m < 4; ++m) { const float rstd = 1.0f / sqrtf(ssr[ai][m] * invn + EPS);
                        *(u32x4*)(dn + (size_t)(row0 + ai * HALF + m * 16) * ldn + bj * HALF + c0) = pack8(acc[ai][bj][m][0] * ga * rstd, acc[ai][bj][m][1] * gb * rstd); } }
        } else {
            const bool sg = u.pn >= 8;
#pragma unroll
            for (int ai = 0; ai < 2; ++ai)
#pragma unroll
                for (int m = 0; m < 4; ++m) { bf16_t* rowp = PROJ + (size_t)(row0 + ai * HALF + m * 16) * DINP + col0;
#pragma unroll
                    for (int bj = 0; bj < 2; ++bj) { f32x4 v0 = acc[ai][bj][m][0], v1 = acc[ai][bj][m][1];
                        if (sg) { v0 = sig4(v0); v1 = sig4(v1); }
                        *(u32x4*)(rowp + bj * HALF) = pack8(v0, v1); } }
        }
    }
};

struct EpiQB {
    bf16_t* QB; const float* gn; const float* cosB; const float* sinB; LAS float* xch;
    __device__ __forceinline__ void operator()(EPI_ARGS) const {
        const int rl0 = wr * 64 + fr, row0 = u.pm * BM + rl0;
#pragma unroll
        for (int ai = 0; ai < 2; ++ai)
#pragma unroll
            for (int m = 0; m < 4; ++m)
#pragma unroll
                for (int bj = 0; bj < 2; ++bj) { const f32x4 x0 = acc[ai][bj][m][0], x1 = acc[ai][bj][m][1];
                    float ss = (x0[0] * x0[0] + x0[1] * x0[1]) + (x0[2] * x0[2] + x0[3] * x0[3]) + (x1[0] * x1[0] + x1[1] * x1[1]) + (x1[2] * x1[2] + x1[3] * x1[3]);
                    ss += __shfl_xor(ss, 16); ss += __shfl_xor(ss, 32);
                    if (fq == 0) xch[((rl0 + ai * HALF + m * 16) * 2 + bj) * 4 + wc] = ss; }
        asm volatile("s_waitcnt lgkmcnt(0)" ::: "memory"); __builtin_amdgcn_s_barrier(); asm volatile("" ::: "memory");
#define QB_RS(ai, m, bj) ({ const f32x4 p4_ = *(const LAS f32x4*)(xch + ((rl0 + (ai) * HALF + (m) * 16) * 2 + (bj)) * 4); C2B / sqrtf(((p4_[0] + p4_[1]) + p4_[2]) * (1.f / 96.f) + EPS); })
        if (wc < 2) { const f32x4 ga = *(const f32x4*)(gn + 32 * wc + 8 * fq), gb = *(const f32x4*)(gn + 32 * wc + 8 * fq + 4);
#pragma unroll
            for (int ai = 0; ai < 2; ++ai)
#pragma unroll
                for (int m = 0; m < 4; ++m)
#pragma unroll
                    for (int bj = 0; bj < 2; ++bj) { const float r = QB_RS(ai, m, bj);
                        *(u32x4*)(QB + (size_t)(row0 + ai * HALF + m * 16) * 768 + (2 * u.pn + bj) * 96 + 32 * wc + 8 * fq) = pack8(acc[ai][bj][m][0] * ga * r, acc[ai][bj][m][1] * gb * r); }
        } else if (wc == 2) { const f32x4 g1 = *(const f32x4*)(gn + 64 + 4 * fq), g2 = *(const f32x4*)(gn + 80 + 4 * fq);
#pragma unroll
            for (int ai = 0; ai < 2; ++ai)
#pragma unroll
                for (int m = 0; m < 4; ++m) { const int row = row0 + ai * HALF + m * 16; const int pos = row & (SEQ - 1);
                    const f32x4 c4 = *(const f32x4*)(cosB + pos * 16 + 4 * fq), s4 = *(const f32x4*)(sinB + pos * 16 + 4 * fq);
#pragma unroll
                    for (int bj = 0; bj < 2; ++bj) { const float r = QB_RS(ai, m, bj); const f32x4 x1 = acc[ai][bj][m][0] * g1 * r, x2 = acc[ai][bj][m][1] * g2 * r;
                        const f32x4 y1 = x1 * c4 - x2 * s4, y2 = x2 * c4 + x1 * s4; bf16_t* rp = QB + (size_t)row * 768 + (2 * u.pn + bj) * 96 + 64 + 4 * fq;
                        *(u32x2*)rp = (u32x2){cvt_pk_bf16(y1[0], y1[1]), cvt_pk_bf16(y1[2], y1[3])}; *(u32x2*)(rp + 16) = (u32x2){cvt_pk_bf16(y2[0], y2[1]), cvt_pk_bf16(y2[2], y2[3])}; } }
        }
    }
};
struct EpiKV {
    bf16_t* KB2; bf16_t* KV; const bf16_t* PROJ; const float* KPESS; const float* gn; const float* cosB; const float* sinB; LAS float* xch;
    __device__ __forceinline__ void operator()(EPI_ARGS) const {
        const int rl0 = wr * 64 + fr, row0 = u.pm * BM + rl0;
        if (wc < 2) {
#pragma unroll
            for (int ai = 0; ai < 2; ++ai)
#pragma unroll
                for (int m = 0; m < 4; ++m)
#pragma unroll
                    for (int bj = 0; bj < 2; ++bj) { const f32x4 x0 = acc[ai][bj][m][0], x1 = acc[ai][bj][m][1];
                        float ss = (x0[0] * x0[0] + x0[1] * x0[1]) + (x0[2] * x0[2] + x0[3] * x0[3]) + (x1[0] * x1[0] + x1[1] * x1[1]) + (x1[2] * x1[2] + x1[3] * x1[3]);
                        ss += __shfl_xor(ss, 16); ss += __shfl_xor(ss, 32);
                        if (fq == 0) xch[((rl0 + ai * HALF + m * 16) * 2 + bj) * 4 + wc] = ss; } }
        asm volatile("s_waitcnt lgkmcnt(0)" ::: "memory"); __builtin_amdgcn_s_barrier(); asm volatile("" ::: "memory");
#define KV_RS(ai, m, bj, pe) ({ const f32x2 p2_ = *(const LAS f32x2*)(xch + ((rl0 + (ai) * HALF + (m) * 16) * 2 + (bj)) * 4); 1.0f / sqrtf(((p2_[0] + p2_[1]) + (pe)) * (1.f / 96.f) + EPS); })
        if (wc < 2) { const f32x4 ga = *(const f32x4*)(gn + 32 * wc + 8 * fq), gb = *(const f32x4*)(gn + 32 * wc + 8 * fq + 4);
#pragma unroll
            for (int ai = 0; ai < 2; ++ai)
#pragma unroll
                for (int m = 0; m < 4; ++m) { const float pe = KPESS[row0 + ai * HALF + m * 16];
#pragma unroll
                    for (int bj = 0; bj < 2; ++bj) { const float r = KV_RS(ai, m, bj, pe);
                        *(u32x4*)(KB2 + (size_t)(row0 + ai * HALF + m * 16) * 768 + (2 * u.pn + bj) * 96 + 32 * wc + 8 * fq) = pack8(acc[ai][bj][m][0] * ga * r, acc[ai][bj][m][1] * gb * r); } }
        } else {
#pragma unroll
            for (int ai = 0; ai < 2; ++ai)
#pragma unroll
                for (int m = 0; m < 4; ++m)
#pragma unroll
                    for (int bj = 0; bj < 2; ++bj) *(u32x4*)(KV + (size_t)(row0 + ai * HALF + m * 16) * 1024 + (2 * u.pn + bj) * 128 + 32 * wc + 8 * fq) = pack8(acc[ai][bj][m][0], acc[ai][bj][m][1]);
            if (wc == 2) {
                const f32x4 g1 = *(const f32x4*)(gn + 64 + 4 * fq), g2 = *(const f32x4*)(gn + 80 + 4 * fq);
#pragma unroll
                for (int ai = 0; ai < 2; ++ai)
#pragma unroll
                    for (int m = 0; m < 4; ++m) { const int row = row0 + ai * HALF + m * 16; const int pos = row & (SEQ - 1); const float pe = KPESS[row];
                        const u32x2 w1 = *(const u32x2*)(PROJ + (size_t)row * DINP + PC_KPE + 4 * fq), w2 = *(const u32x2*)(PROJ + (size_t)row * DINP + PC_KPE + 16 + 4 * fq);
                        const f32x4 k1 = (f32x4){bflo(w1.x), bfhi(w1.x), bflo(w1.y), bfhi(w1.y)} * g1, k2 = (f32x4){bflo(w2.x), bfhi(w2.x), bflo(w2.y), bfhi(w2.y)} * g2;
                        const f32x4 c4 = *(const f32x4*)(cosB + pos * 16 + 4 * fq), s4 = *(const f32x4*)(sinB + pos * 16 + 4 * fq);
                        const f32x4 y1 = k1 * c4 - k2 * s4, y2 = k2 * c4 + k1 * s4;
#pragma unroll
                        for (int bj = 0; bj < 2; ++bj) { const float r = KV_RS(ai, m, bj, pe); bf16_t* rp = KB2 + (size_t)row * 768 + (2 * u.pn + bj) * 96 + 64 + 4 * fq;
                            *(u32x2*)rp = (u32x2){cvt_pk_bf16(y1[0] * r, y1[1] * r), cvt_pk_bf16(y1[2] * r, y1[3] * r)}; *(u32x2*)(rp + 16) = (u32x2){cvt_pk_bf16(y2[0] * r, y2[1] * r), cvt_pk_bf16(y2[2] * r, y2[3] * r)}; } } }
        }
    }
};
#undef QB_RS
#undef KV_RS
template <bool ADD> struct EpiGate {
    bf16_t* O; const bf16_t* G; int ldg; unsigned char* MF8;
    __device__ __forceinline__ void operator()(EPI_ARGS) const {
        const int row0 = u.pm * BM + wr * 64 + fr, col0 = u.pn * BM + wc * 32 + 8 * fq;
#pragma unroll
        for (int ai = 0; ai < 2; ++ai)
#pragma unroll
            for (int m = 0; m < 4; ++m) { const size_t r = (size_t)(row0 + ai * HALF + m * 16);
#pragma unroll
                for (int bj = 0; bj < 2; ++bj) { const int c = col0 + bj * HALF;
                    f32x4 g0, g1; unpack8(*(const u32x4*)(G + r * ldg + c), g0, g1);
                    f32x4 v0 = acc[ai][bj][m][0] * g0, v1 = acc[ai][bj][m][1] * g1;
                    if (ADD) { f32x4 o0, o1; unpack8(*(const u32x4*)(O + r * DM + c), o0, o1); v0 += o0; v1 += o1;
                        *(u32x2*)(MF8 + r * DM + c) = (u32x2){pack4_fp8(v0[0], v0[1], v0[2], v0[3]), pack4_fp8(v1[0], v1[1], v1[2], v1[3])}; }
                    else *(u32x4*)(O + r * DM + c) = pack8(v0, v1); } }
    }
};

struct BranchOrder {
    StaticOrder so;
    __device__ bool next(int i, Unit& u) const { if (i >= 2) return false; if (!so.next(0, u)) return false; u.e = i; u.aofs = i * 512; u.pb = u.pn + 8 * i; return true; }
};
struct EpiGateAB {
    bf16_t* O; const bf16_t* Ga; const bf16_t* Gb; int ldg; unsigned char* MF8;
    __device__ __forceinline__ void operator()(EPI_ARGS) const {
        if (u.e == 0) { EpiGate<false> E{O, Ga, ldg, nullptr}; E(acc, u, wr, wc, fr, fq); }
        else { asm volatile("s_waitcnt vmcnt(0)" ::: "memory");
               EpiGate<true> E{O, Gb, ldg, MF8}; E(acc, u, wr, wc, fr, fq); }
    }
};
struct EpiResF32 {
    const float* base; bf16_t* out; float* ssp;
    __device__ __forceinline__ void operator()(EPI_ARGS) const {
        const int row0 = u.pm * BM + wr * 64 + fr, col0 = u.pn * BM + wc * 32 + 8 * fq;
#pragma unroll
        for (int ai = 0; ai < 2; ++ai)
#pragma unroll
            for (int m = 0; m < 4; ++m) { const size_t r = (size_t)(row0 + ai * HALF + m * 16); float ss = 0.f;
#pragma unroll
                for (int bj = 0; bj < 2; ++bj) { const size_t off = r * DM + col0 + bj * HALF;
                    const f32x4 b0 = *(const f32x4*)(base + off), b1 = *(const f32x4*)(base + off + 4);
                    const f32x4 y0 = b0 + acc[ai][bj][m][0], y1 = b1 + acc[ai][bj][m][1];
                    *(u32x4*)(out + off) = pack8(y0, y1);
                    ss += (y0[0] * y0[0] + y0[1] * y0[1]) + (y0[2] * y0[2] + y0[3] * y0[3]) + (y1[0] * y1[0] + y1[1] * y1[1]) + (y1[2] * y1[2] + y1[3] * y1[3]); }
                ss += __shfl_xor(ss, 16); ss += __shfl_xor(ss, 32);
                if (fq == 0) ssp[r * 16 + u.pn * 4 + wc] = ss; }
    }
};
struct EpiSwiglu {
    unsigned char* O; const float* bias;
    __device__ __forceinline__ void operator()(EPI_ARGS) const {
        const int row0 = u.pm * BM + wr * 64 + fr, j0 = u.pn * HALF + wc * 32 + 8 * fq;
        const float* be = bias + (size_t)u.e * 2048;
        f32x4 bg[2], bu[2];
#pragma unroll
        for (int n = 0; n < 2; ++n) { bg[n] = *(const f32x4*)(be + j0 + 4 * n); bu[n] = *(const f32x4*)(be + 1024 + j0 + 4 * n); }
#pragma unroll
        for (int ai = 0; ai < 2; ++ai)
#pragma unroll
            for (int m = 0; m < 4; ++m) { unsigned char* rowp = O + (size_t)(row0 + ai * HALF + m * 16) * DEXP + j0;
                f32x4 o[2];
#pragma unroll
                for (int n = 0; n < 2; ++n) { const f32x4 gv = acc[ai][0][m][n] + bg[n], uv = acc[ai][1][m][n] + bu[n];
#pragma unroll
                    for (int i = 0; i < 4; ++i) { const float gg = fminf(gv[i], 7.0f), uu = fminf(fmaxf(uv[i], -7.0f), 7.0f);
                        o[n][i] = (uu + 1.0f) * gg * __builtin_amdgcn_rcpf(1.0f + __builtin_amdgcn_exp2f(-1.702f * LOG2E * gg)); } }
                *(u32x2*)rowp = (u32x2){pack4_fp8(o[0][0], o[0][1], o[0][2], o[0][3]), pack4_fp8(o[1][0], o[1][1], o[1][2], o[1][3])}; }
    }
};
struct EpiFinal {
    float* out; const bf16_t* PP; const bf16_t* X2;
    __device__ __forceinline__ void operator()(EPI_ARGS) const {
        const int row0 = u.pm * BM + wr * 64 + fr, col0 = u.pn * BM + wc * 32 + 8 * fq;
#pragma unroll
        for (int ai = 0; ai < 2; ++ai)
#pragma unroll
            for (int m = 0; m < 4; ++m) { const size_t r = (size_t)(row0 + ai * HALF + m * 16);
#pragma unroll
                for (int bj = 0; bj < 2; ++bj) { const size_t off = r * DM + col0 + bj * HALF;
                    f32x4 p0, p1, b0, b1; unpack8(*(const u32x4*)(PP + off), p0, p1); unpack8(*(const u32x4*)(X2 + off), b0, b1);
                    *(f32x4*)(out + off) = b0 + sig4(acc[ai][bj][m][0]) * p0; *(f32x4*)(out + off + 4) = b1 + sig4(acc[ai][bj][m][1]) * p1; } }
    }
};
}

namespace att {
__device__ __forceinline__ int crow(int r, int hi) { return (r & 3) + 8 * (r >> 2) + 4 * hi; }
__device__ __forceinline__ void glds16(const void* gsrc, unsigned lds_dst) { unsigned keep;
    asm volatile("s_mov_b32 %0, m0\n\ts_mov_b32 m0, %2\n\ts_nop 0\n\tglobal_load_lds_dwordx4 %1, off\n\ts_mov_b32 m0, %0" : "=&s"(keep) : "v"(gsrc), "s"(lds_dst) : "memory"); }
__device__ __forceinline__ s16x4 vtr(const LAS unsigned char* p) { return __builtin_bit_cast(s16x4, __builtin_amdgcn_ds_read_tr16_b64_v4i16((LAS s16x4*)p)); }
#define MX3(a, b, c) __builtin_fmaxf(__builtin_fmaxf((a), (b)), (c))
constexpr int VSLOT = 8192, OST_BYTES = NWAVES * 4096, WSF_BYTES = NWAVES * 256;

template <int DQK, bool MOBA>
__device__ __forceinline__ void attn_unit(int b, int qb, const bf16_t* Qh, int ldq, const bf16_t* Kh, int ldk, const bf16_t* Vh, int ldv, unsigned char* Oh, int ldo, const float* kmean, LAS unsigned char* shm, int wave) {
    constexpr int ND = DQK / 16, NCH = DQK / 8, KSLOT = NCH * 1024;
    constexpr int LDS_K = 0, LDS_V = 2 * KSLOT, LDS_WS = LDS_V + 2 * VSLOT, LDS_OST = LDS_WS + WSF_BYTES;
    static_assert(LDS_OST + OST_BYTES <= RING_BYTES, "attention LDS");
    int lane = lane_id(); asm volatile("" : "+v"(lane));
    const int r32 = lane & 31, hi = lane >> 5; const int wid = wave;
    const long rowbase = (long)b * SEQ; const int q0 = qb * 256;
    const unsigned lds0 = (unsigned)(uintptr_t)shm;
    LAS float* wsf = (LAS float*)(shm + LDS_WS) + wid * 64;
    const int NT = 4 * (qb + 1);
    const bf16_t* ksrc0 = Kh + (rowbase + lane) * ldk + wid * 8;
    const bf16_t* vsrc0 = Vh + (rowbase + 16 * (wid & 3) + (lane >> 2)) * ldv + (wid >> 2) * 32 + (lane & 3) * 8;
#define ATT_DMA(kt, s) do { const long ro_ = (long)(kt) * 64; \
        glds16(ksrc0 + ro_ * ldk, (unsigned)__builtin_amdgcn_readfirstlane(lds0 + LDS_K + (s) * KSLOT + wid * 1024)); \
        if (NCH > 8 && wid < NCH - 8) glds16(ksrc0 + ro_ * ldk + 64, (unsigned)__builtin_amdgcn_readfirstlane(lds0 + LDS_K + (s) * KSLOT + (wid + 8) * 1024)); \
        glds16(vsrc0 + ro_ * ldv, (unsigned)__builtin_amdgcn_readfirstlane(lds0 + LDS_V + (s) * VSLOT + wid * 1024)); } while (0)
#define ATT_TILE(i) (MOBA ? ((i) < 4 ? 4 * qb + (i) : (i) - 4) : (i))
    ATT_DMA(ATT_TILE(0), 0);
    const bf16_t* Qw = Qh + (rowbase + q0 + wid * 32 + r32) * ldq + hi * 8;
    bf16x8 qr[ND];
#pragma unroll
    for (int d0 = 0; d0 < ND; ++d0) qr[d0] = *(const bf16x8*)(Qw + d0 * 16);
    unsigned bmask = 0xffffffffu;
    if (MOBA) {
        bmask = 1u << qb;
        if (qb <= 3) bmask |= (1u << qb) - 1u;
        else {
            float gsc[7];
#pragma unroll
            for (int n = 0; n < 7; ++n) { float s = 0.f;
                if (n < qb) {
#pragma unroll
                    for (int d0 = 0; d0 < ND; ++d0) { const float* km = kmean + n * 64 + d0 * 16 + hi * 8; const f32x4 k0 = *(const f32x4*)km, k1 = *(const f32x4*)(km + 4);
                        s += bf2f((unsigned short)qr[d0][0]) * k0[0] + bf2f((unsigned short)qr[d0][1]) * k0[1] + bf2f((unsigned short)qr[d0][2]) * k0[2] + bf2f((unsigned short)qr[d0][3]) * k0[3]
                           + bf2f((unsigned short)qr[d0][4]) * k1[0] + bf2f((unsigned short)qr[d0][5]) * k1[1] + bf2f((unsigned short)qr[d0][6]) * k1[2] + bf2f((unsigned short)qr[d0][7]) * k1[3]; }
                    s += __shfl_xor(s, 32);
                } else s = -INFINITY;
                gsc[n] = s; }
#pragma unroll
            for (int pass = 0; pass < 3; ++pass) { float best = -INFINITY; int bi = 0;
#pragma unroll
                for (int n = 0; n < 7; ++n) { const bool ok = (n < qb) && !((bmask >> n) & 1u) && (gsc[n] > best); best = ok ? gsc[n] : best; bi = ok ? n : bi; }
                bmask |= 1u << bi; }
        }
    }
    asm volatile("s_waitcnt vmcnt(0)" ::: "memory");
#pragma unroll
    for (int d0 = 0; d0 < ND; ++d0) asm volatile("" : "+v"(qr[d0]));
    float mhat = 0.f, l_reg = 0.f; f32x16 o[2]; o[0] = f32x16{}; o[1] = f32x16{}; f32x16 negm = f32x16{}; asm volatile("" : "+v"(negm));
    const int qrel = wid * 32 + r32;
    const LAS unsigned char* kp0 = shm + LDS_K + hi * 1024 + r32 * 16;
    const LAS unsigned char* vp0 = shm + LDS_V + ((lane >> 4) & 1) * 32 + (lane & 3) * 8 + (4 * hi + ((lane & 15) >> 2)) * 64;
    for (int i = 0; i < NT; ++i) {
        const int s = i & 1, kt = ATT_TILE(i);
        asm volatile("s_waitcnt vmcnt(0) lgkmcnt(0)\n\ts_barrier" ::: "memory");
        if (i + 1 < NT) ATT_DMA(ATT_TILE(i + 1), s ^ 1);
        f32x16 cin = negm;
        if (MOBA) { if (i >= 4 && !((bmask >> (kt >> 2)) & 1u)) {
#pragma unroll
            for (int r = 0; r < 16; ++r) cin[r] = -INFINITY; } }
        f32x16 p0, p1;
        { const LAS unsigned char* kb = kp0 + s * KSLOT; bf16x8 kf[2 * ND];
#pragma unroll
            for (int d0 = 0; d0 < ND; ++d0) { kf[2 * d0] = *(const LAS bf16x8*)(kb + d0 * 2048); kf[2 * d0 + 1] = *(const LAS bf16x8*)(kb + d0 * 2048 + 512); }
            __builtin_amdgcn_sched_barrier(0);
#pragma unroll
            for (int d0 = 0; d0 < ND; ++d0) {
                if (d0 == 0) { p0 = __builtin_amdgcn_mfma_f32_32x32x16_bf16(kf[0], qr[0], cin, 0, 0, 0); p1 = __builtin_amdgcn_mfma_f32_32x32x16_bf16(kf[1], qr[0], cin, 0, 0, 0); }
                else { p0 = __builtin_amdgcn_mfma_f32_32x32x16_bf16(kf[2 * d0], qr[d0], p0, 0, 0, 0); p1 = __builtin_amdgcn_mfma_f32_32x32x16_bf16(kf[2 * d0 + 1], qr[d0], p1, 0, 0, 0); } } }
        if (kt >= 4 * qb) { const int kb = 64 * (kt - 4 * qb) + 4 * hi;
#pragma unroll
            for (int r = 0; r < 16; ++r) { const int kv = kb + (r & 3) + 8 * (r >> 2); if (kv > qrel) p0[r] = -INFINITY; if (kv + 32 > qrel) p1[r] = -INFINITY; } }
        bool resc = false;
        { float a = MX3(p0[0], p0[1], p1[0]), bb = MX3(p0[2], p0[3], p1[1]); a = MX3(a, p1[2], p1[3]);
#pragma unroll
            for (int r = 4; r < 16; r += 4) { a = MX3(a, p0[r], p0[r + 1]); bb = MX3(bb, p0[r + 2], p0[r + 3]); a = MX3(a, p1[r], p1[r + 1]); bb = MX3(bb, p1[r + 2], p1[r + 3]); }
            float rm = __builtin_fmaxf(a, bb); rm = __builtin_fmaxf(rm, __shfl_xor(rm, 32));
            const bool first = (i == 0);
            if (first || __any(rm > 6.0f)) {
                const float dl = first ? rm : __builtin_fmaxf(rm, 0.f); mhat += dl;
#pragma unroll
                for (int r = 0; r < 16; ++r) { p0[r] -= dl; p1[r] -= dl; }
#pragma unroll
                for (int r = 0; r < 16; ++r) negm[r] = -mhat;
                asm volatile("" : "+v"(negm));
                const float f = __builtin_amdgcn_exp2f(-dl); l_reg *= f; if (hi == 0) wsf[r32] = f; resc = true; } }
        float sacc = 0.f;
#pragma unroll
        for (int r = 0; r < 16; ++r) { p0[r] = __builtin_amdgcn_exp2f(p0[r]); p1[r] = __builtin_amdgcn_exp2f(p1[r]); sacc += p0[r] + p1[r]; }
        l_reg += sacc;
        u32x4 pw0, pw1, pw2, pw3;
        pw0 = (u32x4){cvt_pk_bf16(p0[0], p0[1]), cvt_pk_bf16(p0[2], p0[3]), cvt_pk_bf16(p0[4], p0[5]), cvt_pk_bf16(p0[6], p0[7])};
        pw1 = (u32x4){cvt_pk_bf16(p0[8], p0[9]), cvt_pk_bf16(p0[10], p0[11]), cvt_pk_bf16(p0[12], p0[13]), cvt_pk_bf16(p0[14], p0[15])};
        pw2 = (u32x4){cvt_pk_bf16(p1[0], p1[1]), cvt_pk_bf16(p1[2], p1[3]), cvt_pk_bf16(p1[4], p1[5]), cvt_pk_bf16(p1[6], p1[7])};
        pw3 = (u32x4){cvt_pk_bf16(p1[8], p1[9]), cvt_pk_bf16(p1[10], p1[11]), cvt_pk_bf16(p1[12], p1[13]), cvt_pk_bf16(p1[14], p1[15])};
        if (resc) {
#pragma unroll
            for (int d_ = 0; d_ < 2; ++d_)
#pragma unroll
                for (int r = 0; r < 16; ++r) o[d_][r] *= wsf[crow(r, hi)];
        }
        { const LAS unsigned char* vp = vp0 + s * VSLOT;
#pragma unroll
            for (int d0 = 0; d0 < 2; ++d0) {
                s16x4 lo[4], hh[4];
#pragma unroll
                for (int ks = 0; ks < 4; ++ks) { lo[ks] = vtr(vp + d0 * 4096 + ks * 1024); hh[ks] = vtr(vp + d0 * 4096 + ks * 1024 + 512); }
                __builtin_amdgcn_sched_barrier(0);
#define PKV(k) (bf16x8){lo[k][0], lo[k][1], lo[k][2], lo[k][3], hh[k][0], hh[k][1], hh[k][2], hh[k][3]}
                o[d0] = __builtin_amdgcn_mfma_f32_32x32x16_bf16(__builtin_bit_cast(bf16x8, pw0), PKV(0), o[d0], 0, 0, 0);
                o[d0] = __builtin_amdgcn_mfma_f32_32x32x16_bf16(__builtin_bit_cast(bf16x8, pw1), PKV(1), o[d0], 0, 0, 0);
                o[d0] = __builtin_amdgcn_mfma_f32_32x32x16_bf16(__builtin_bit_cast(bf16x8, pw2), PKV(2), o[d0], 0, 0, 0);
                o[d0] = __builtin_amdgcn_mfma_f32_32x32x16_bf16(__builtin_bit_cast(bf16x8, pw3), PKV(3), o[d0], 0, 0, 0);
#undef PKV
            } }
    }
    l_reg += __shfl_xor(l_reg, 32);
    if (hi == 0) wsf[32 + r32] = l_reg;
    float rli[16];
#pragma unroll
    for (int r = 0; r < 16; ++r) rli[r] = __builtin_amdgcn_rcpf(wsf[32 + crow(r, hi)]);
    unsigned char* Ow = (unsigned char*)Oh + (rowbase + q0 + wid * 32) * ldo;
    { LAS unsigned char* stg = shm + LDS_OST + wid * 2048;
#pragma unroll
        for (int r = 0; r < 16; ++r) { const int orow = crow(r, hi);
#pragma unroll
            for (int d0 = 0; d0 < 2; ++d0) stg[orow * 64 + d0 * 32 + r32] = (unsigned char)(pack4_fp8(o[d0][r] * rli[r], 0.f, 0.f, 0.f) & 0xffu); }
#pragma unroll
        for (int i = 0; i < 2; ++i) { const int row = i * 16 + (lane >> 2), ch = lane & 3; const u32x4 v = *(const LAS u32x4*)(stg + row * 64 + ch * 16); *(u32x4*)(Ow + (long)row * ldo + ch * 16) = v; } }
    asm volatile("s_waitcnt vmcnt(0) lgkmcnt(0)\n\ts_barrier" ::: "memory");
#undef ATT_DMA
#undef ATT_TILE
}
#undef MX3
}

#define XB_TMO      128
#define XB_XCNT(j)  (256  + 64 * (j))
#define XB_XSUB(j)  (1280 + 64 * (j))
#define XB_XGEN(j)  (2304 + 64 * (j))
#define XB_TOP      3328
#define XB_TOPGEN   3392
#define XCD_BAR_WORDS 3456
#define XB_SPIN_CAP (1u << 22)
__device__ __forceinline__ unsigned xb_ld(unsigned* p)              { return __hip_atomic_load(p, __ATOMIC_RELAXED, __HIP_MEMORY_SCOPE_AGENT); }
__device__ __forceinline__ unsigned xb_add(unsigned* p, unsigned v) { return __hip_atomic_fetch_add(p, v, __ATOMIC_RELAXED, __HIP_MEMORY_SCOPE_AGENT); }
__device__ __forceinline__ unsigned xb_xcc_id() { return (unsigned)__builtin_amdgcn_s_getreg((3 << 11) | 20) & 0xFu; }
#define XB_SPIN(cond, bar) do { unsigned _sp = 0; while (cond) { __builtin_amdgcn_s_sleep(1); \
    if ((++_sp & 255u) == 0u) { if (xb_ld(&(bar)[XB_TMO])) break; if (_sp > XB_SPIN_CAP) { atomicAdd(&(bar)[XB_TMO], 1u); break; } } } } while (0)
struct XcdBarrier { unsigned* bar; unsigned x; volatile LAS unsigned* st; int wave; };
__device__ __forceinline__ XcdBarrier xcd_barrier_post(unsigned* bar, volatile LAS unsigned* st, int wave) {
    XcdBarrier b; b.bar = bar; b.x = xb_xcc_id(); b.st = st; b.wave = wave;
    if (wave == 0 && lane_id() == 0) (void)xb_add(&bar[XB_XCNT(b.x)], 1u);
    return b;
}
__device__ __forceinline__ void xcd_barrier_complete(unsigned* bar, unsigned x, unsigned& nloc, unsigned& nx) {
    const unsigned G = gridDim.x * gridDim.y * gridDim.z;
    unsigned sum, cnt, mine, sp = 0u;
    for (;;) {
        sum = 0u; cnt = 0u; mine = 0u;
#pragma unroll
        for (unsigned j = 0; j < 16; ++j) { const unsigned c = xb_ld(&bar[XB_XCNT(j)]); sum += c; cnt += (c > 0u) ? 1u : 0u; mine = (j == x) ? c : mine; }
        if (sum == G) break;
        __builtin_amdgcn_s_sleep(1);
        if ((++sp & 255u) == 0u) { if (xb_ld(&bar[XB_TMO])) break; if (sp > XB_SPIN_CAP) { atomicAdd(&bar[XB_TMO], 1u); break; } }
    }
    nloc = mine > 0u ? mine : 1u; nx = cnt > 0u ? cnt : 1u;
}
__device__ __forceinline__ void xcd_barrier(const XcdBarrier& b) {
    asm volatile("s_waitcnt vmcnt(0)" ::: "memory");
    __syncthreads();
    if (b.wave == 0 && lane_id() == 0) {
        unsigned* bar = b.bar;
        __builtin_amdgcn_s_waitcnt(0);
        unsigned nloc = b.st[0], nx = b.st[1];
        if (nloc == 0u) { xcd_barrier_complete(bar, b.x, nloc, nx); b.st[0] = nloc; b.st[1] = nx; }
        const unsigned old = xb_add(&bar[XB_XSUB(b.x)], 1u);
        const unsigned gen = old / nloc;
        if (old + 1u == (gen + 1u) * nloc) {
            __builtin_amdgcn_fence(__ATOMIC_RELEASE, "agent");
            asm volatile("s_waitcnt vmcnt(0)" ::: "memory");
            const unsigned og = xb_add(&bar[XB_TOP], 1u);
            const unsigned tg = og / nx;
            if (og + 1u == (tg + 1u) * nx) xb_add(&bar[XB_TOPGEN], 1u);
            else XB_SPIN(xb_ld(&bar[XB_TOPGEN]) == tg, bar);
            __builtin_amdgcn_fence(__ATOMIC_ACQUIRE, "agent");
            xb_add(&bar[XB_XGEN(b.x)], 1u);
            asm volatile("s_waitcnt vmcnt(0)" ::: "memory");
        } else {
            XB_SPIN(xb_ld(&bar[XB_XGEN(b.x)]) == gen, bar);
            __builtin_amdgcn_fence(__ATOMIC_ACQUIRE, "agent");
            asm volatile("s_waitcnt vmcnt(0)" ::: "memory");
        }
    }
    __syncthreads();
}

struct Params { const float* in[25]; float* out; unsigned char* ws; int ph_lo, ph_hi; };
enum { I_X = 0, I_P, I_GMIX, I_WIN, I_MQN, I_MKN, I_QLATN, I_WUQ, I_KVLATN, I_WUKV, I_MLAQN, I_MLAKN, I_WA, I_WB, I_WO, I_GFFN, I_WR, I_BR, I_WGU, I_BGU, I_WD, I_BD, I_GPLE, I_WPG, I_WPP };
constexpr int NPHASE = 16;

struct Frame {
    LAS unsigned char* lds; int vcu, G, wave;
    const Params* P; unsigned char* ws;
};
struct Ids { int tid, lane, wave; };
#define PHASE_IDS() Ids I_; { int l_ = lane_id(); asm volatile("" : "+v"(l_)); I_.lane = l_; I_.wave = F.wave; I_.tid = F.wave * 64 + l_; }

#ifdef TPROBE_A
#define STAMP(k) do { if (blockIdx.x == 0 && F.wave == 0 && lane_id() == 0) ((volatile unsigned long long*)(ws + WS_ERR))[k] = __builtin_amdgcn_s_memrealtime(); } while (0)
#else
#define STAMP(k) do {} while (0)
#endif
__device__ __forceinline__ int rowmap(int mode, int c) {
    if (mode == 1) {
        if (c < 1024) { const int base = c & 512, s_ = c & 511, h = s_ >> 6, d = s_ & 63; return base + 256 * (h >> 2) + 128 * (d >> 5) + 32 * (h & 3) + (d & 31); }
        return c < 1952 ? c : c + 96; }
    if (mode == 2) return c < 1024 ? 256 * (c >> 7) + (c & 127) : 256 * ((c - 1024) >> 7) + 128 + ((c - 1024) & 127);
    if (mode == 3) {
        const int h = c / 96, d = c % 96; int t;
        if (d < 64) t = d; else if (d < 80) { const int i = d - 64; t = 64 + 8 * (i >> 2) + (i & 3); } else { const int i = d - 80; t = 64 + 8 * (i >> 2) + 4 + (i & 3); }
        return 128 * h + t; }
    return c;
}
__device__ __forceinline__ void tr_item64(const float* W, int ldw, int N, int k0, int n0, bf16_t* dst, int ldd, int mode, LAS float* scr, int lane) {
    const int r = lane >> 4, c4 = lane & 15; const bool inb = (n0 + 4 * c4) < N;
    f32x4 v[16];
#pragma unroll
    for (int i = 0; i < 16; ++i) v[i] = inb ? __builtin_nontemporal_load((const f32x4*)(W + (size_t)(k0 + 4 * i + r) * ldw + n0 + 4 * c4)) : (f32x4){0.f, 0.f, 0.f, 0.f};
#pragma unroll
    for (int i = 0; i < 16; ++i) { LAS float* p = scr + (4 * i + r) * 65 + 4 * c4; p[0] = v[i].x; p[1] = v[i].y; p[2] = v[i].z; p[3] = v[i].w; }
    asm volatile("s_waitcnt lgkmcnt(0)" ::: "memory");
    const int c = lane & 7;
#pragma unroll
    for (int j = 0; j < 8; ++j) { const int n = (lane >> 3) + 8 * j; const LAS float* sp = scr + (8 * c) * 65 + n;
        u32x4 o; o.x = cvt_pk_bf16(sp[0 * 65], sp[1 * 65]); o.y = cvt_pk_bf16(sp[2 * 65], sp[3 * 65]); o.z = cvt_pk_bf16(sp[4 * 65], sp[5 * 65]); o.w = cvt_pk_bf16(sp[6 * 65], sp[7 * 65]);
        if (n0 + n < N) *(u32x4*)(dst + (size_t)rowmap(mode, n0 + n) * ldd + k0 + 8 * c) = o; }
    asm volatile("s_waitcnt lgkmcnt(0)" ::: "memory");
}

__device__ __forceinline__ void tr_item_f8(const float* W, int ldw, int k0, int n0, unsigned char* dst, int ldd, int mode, LAS float* scr, int lane) {
    const int r = lane >> 3, c4 = lane & 7;
    f32x4 v[16];
#pragma unroll
    for (int i = 0; i < 16; ++i) v[i] = __builtin_nontemporal_load((const f32x4*)(W + (size_t)(k0 + 8 * i + r) * ldw + n0 + 4 * c4));
#pragma unroll
    for (int i = 0; i < 16; ++i) { LAS float* p = scr + (8 * i + r) * 33 + 4 * c4; p[0] = v[i].x * 64.f; p[1] = v[i].y * 64.f; p[2] = v[i].z * 64.f; p[3] = v[i].w * 64.f; }
    asm volatile("s_waitcnt lgkmcnt(0)" ::: "memory");
    const int c = lane & 7;
#pragma unroll
    for (int j = 0; j < 4; ++j) { const int n = (lane >> 3) + 8 * j; const LAS float* sp = scr + (16 * c) * 33 + n;
        u32x4 o; o.x = pack4_fp8(sp[0 * 33], sp[1 * 33], sp[2 * 33], sp[3 * 33]); o.y = pack4_fp8(sp[4 * 33], sp[5 * 33], sp[6 * 33], sp[7 * 33]);
        o.z = pack4_fp8(sp[8 * 33], sp[9 * 33], sp[10 * 33], sp[11 * 33]); o.w = pack4_fp8(sp[12 * 33], sp[13 * 33], sp[14 * 33], sp[15 * 33]);
        __builtin_nontemporal_store(o, (u32x4*)(dst + (size_t)rowmap(mode, n0 + n) * ldd + k0 + 16 * c)); }
    asm volatile("s_waitcnt lgkmcnt(0)" ::: "memory");
}

__device__ __forceinline__ void phase0(Frame& F) {
    PHASE_IDS();
    const Params& P = *F.P; unsigned char* ws = F.ws;
    LAS float* scr = (LAS float*)(F.lds + I_.wave * 16896);
    const int gw = F.vcu * NWAVES + I_.wave, NGW = F.G * NWAVES;
    constexpr int I_GU = 32 * 8 * 64, I_DN = 32 * 8 * 32, I_IN = 16 * 31, I_ING = 8 * 64, I_UQ = 4 * 12, I_UKV = 2 * 16, I_A = 8 * 16, I_O = 16 * 16, I_PP = 4 * 16;
    constexpr int I_PG = 8 * 32;
    constexpr int NITEMS = I_GU + I_DN + I_IN + I_ING + I_UQ + I_UKV + 2 * I_A + I_O + I_PG + I_PP;
    for (int it = gw; it < NITEMS; it += NGW) {
        int r = it;
        if (r < I_GU) { const int e = r >> 9, q = r & 511, kb = q >> 6, g = q & 63;
            tr_item_f8(P.in[I_WGU] + (size_t)e * 1024 * 2048, 2048, 128 * kb, 32 * g, ws + WS_W1 + (size_t)e * 2048 * 1024, 1024, 2, scr, I_.lane); continue; } r -= I_GU;
        if (r < I_DN) { const int e = r >> 8, q = r & 255, kb = q >> 5, g = q & 31;
            tr_item_f8(P.in[I_WD] + (size_t)e * 1024 * 1024, 1024, 128 * kb, 32 * g, ws + WS_W2 + (size_t)e * 1024 * 1024, 1024, 0, scr, I_.lane); continue; } r -= I_DN;
        if (r < I_IN) { const int kb = r / 31, g = r % 31; tr_item64(P.in[I_WIN], DIN, 1952, 64 * kb, 64 * g, (bf16_t*)(ws + WS_WIN), 1024, 1, scr, I_.lane); continue; } r -= I_IN;
        if (r < I_ING) { const int kb = r >> 6, g = r & 63; tr_item_f8(P.in[I_WIN] + 1952, DIN, 128 * kb, 32 * g, ws + WS_WINF8, 1024, 0, scr, I_.lane); continue; } r -= I_ING;
        if (r < I_UQ) { const int kb = r / 12, g = r % 12; tr_item64(P.in[I_WUQ], 768, 768, 64 * kb, 64 * g, (bf16_t*)(ws + WS_WUQ), 256, 3, scr, I_.lane); continue; } r -= I_UQ;
        if (r < I_UKV) { const int kb = r / 16, g = r % 16; tr_item64(P.in[I_WUKV], 1024, 1024, 64 * kb, 64 * g, (bf16_t*)(ws + WS_WUKV), 128, 0, scr, I_.lane); continue; } r -= I_UKV;
        if (r < I_A) { const int kb = r >> 5, g = r & 31; tr_item_f8(P.in[I_WA], 1024, 128 * kb, 32 * g, ws + WS_WA, 512, 0, scr, I_.lane); continue; } r -= I_A;
        if (r < I_A) { const int kb = r >> 5, g = r & 31; tr_item_f8(P.in[I_WB], 1024, 128 * kb, 32 * g, ws + WS_WB, 512, 0, scr, I_.lane); continue; } r -= I_A;
        if (r < I_PG) { const int kb = r >> 5, g = r & 31; tr_item_f8(P.in[I_WO], 1024, 128 * kb, 32 * g, ws + WS_WO, 1024, 0, scr, I_.lane); continue; } r -= I_PG;
        if (r < I_PG) { const int kb = r >> 5, g = r & 31; tr_item_f8(P.in[I_WPG], 1024, 128 * kb, 32 * g, ws + WS_WPG, 1024, 0, scr, I_.lane); continue; } r -= I_PG;
        { const int kb = r / 16, g = r % 16; tr_item64(P.in[I_WPP], 1024, 1024, 64 * kb, 64 * g, (bf16_t*)(ws + WS_WPP), 256, 0, scr, I_.lane); }
    }
    STAMP(20);
    { const f32x4* gp = (const f32x4*)P.in[I_GMIX] + I_.lane; f32x4 gv[4];
#pragma unroll
        for (int j = 0; j < 4; ++j) gv[j] = gp[64 * j];
        for (int m0 = gw * 4; m0 < NTOK; m0 += NGW * 4) { f32x4 v[4][4];
#pragma unroll
            for (int q = 0; q < 4; ++q) { const f32x4* xr = (const f32x4*)(P.in[I_X] + (size_t)(m0 + q) * DM) + I_.lane;
#pragma unroll
                for (int j = 0; j < 4; ++j) v[q][j] = xr[64 * j]; }
#pragma unroll
            for (int q = 0; q < 4; ++q) { float s = 0.f;
#pragma unroll
                for (int j = 0; j < 4; ++j) s += (v[q][j].x * v[q][j].x + v[q][j].y * v[q][j].y) + (v[q][j].z * v[q][j].z + v[q][j].w * v[q][j].w);
                const float rstd = 1.0f / sqrtf(wave_sum(s) * (1.f / DM) + EPS);
                u32x2* o8 = (u32x2*)((bf16_t*)(ws + WS_HN) + (size_t)(m0 + q) * DM) + I_.lane; unsigned* o4 = (unsigned*)(ws + WS_HNF8 + (size_t)(m0 + q) * DM) + I_.lane;
#pragma unroll
                for (int j = 0; j < 4; ++j) { const f32x4 y = v[q][j] * rstd * gv[j]; o8[64 * j] = (u32x2){cvt_pk_bf16(y.x, y.y), cvt_pk_bf16(y.z, y.w)}; o4[64 * j] = pack4_fp8(y.x, y.y, y.z, y.w); } } } }
    STAMP(21);
    { float* km = (float*)(ws + WS_KMEAN); for (int i = F.vcu * NTHREADS + I_.tid; i < 8 * 8 * 8 * 64; i += F.G * NTHREADS) km[i] = 0.f; }
    { const size_t n4 = (size_t)NTOK * 256 / 4; const f32x4* pp = (const f32x4*)P.in[I_P]; u32x2* po = (u32x2*)(ws + WS_PB); const size_t T = (size_t)F.G * NTHREADS;
        for (size_t i = (size_t)F.vcu * NTHREADS + I_.tid; i < n4; i += 4 * T) { f32x4 v[4];
#pragma unroll
            for (int q = 0; q < 4; ++q) v[q] = __builtin_nontemporal_load(pp + i + q * T);
#pragma unroll
            for (int q = 0; q < 4; ++q) po[i + q * T] = (u32x2){cvt_pk_bf16(v[q].x, v[q].y), cvt_pk_bf16(v[q].z, v[q].w)}; } }
    STAMP(22);
    { float* tab = (float*)(ws + WS_ROPE);
        for (int i = F.vcu * NTHREADS + I_.tid; i < 2048 * 48; i += F.G * NTHREADS) {
            int pos, j, half; float* cdst; float* sdst;
            if (i < 2048 * 32) { pos = i / 32; j = i % 32; half = 32; cdst = tab + i; sdst = tab + 65536 + i; }
            else { const int q = i - 2048 * 32; pos = q / 16; j = q % 16; half = 16; cdst = tab + 131072 + q; sdst = tab + 131072 + 32768 + q; }
            const float inv = powf(10000.0f, -((float)j / (float)half)); const float ang = (float)pos * inv;
            *cdst = cosf(ang); *sdst = sinf(ang); } }
}

__device__ __forceinline__ void phase2(Frame& F) {
    PHASE_IDS();
    const Params& P = *F.P; unsigned char* ws = F.ws;
    const bf16_t* PROJ = (const bf16_t*)(ws + WS_PROJ);
    const float* cosA = (const float*)(ws + WS_ROPE); const float* sinA = cosA + 65536;
    LAS float* kst = (LAS float*)F.lds;
    LAS float* part = kst + 256 * 68;
    for (int it = F.vcu; it < 512; it += F.G) {
        const int b = it >> 6, blk = (it >> 3) & 7, h = it & 7;
        const int sel = I_.lane >> 5, r = I_.wave * 32 + (I_.lane & 31); const int pos = blk * 256 + r; const size_t row = (size_t)b * SEQ + pos;
        const u32x4* src = (const u32x4*)(PROJ + row * DINP + (sel ? PC_KA : PC_QA) + h * 64);
        u32x4 raw[8];
#pragma unroll
        for (int c = 0; c < 8; ++c) raw[c] = src[c];
        float ss = 0.f;
#pragma unroll
        for (int c = 0; c < 8; ++c) { f32x4 a0, a1; pg8::unpack8(raw[c], a0, a1); ss += (a0[0] * a0[0] + a0[1] * a0[1]) + (a0[2] * a0[2] + a0[3] * a0[3]) + (a1[0] * a1[0] + a1[1] * a1[1]) + (a1[2] * a1[2] + a1[3] * a1[3]); }
        const float rstd = 1.0f / sqrtf(ss * (1.f / 64.f) + EPS);
        const float* gn = sel ? P.in[I_MKN] : P.in[I_MQN];
        const float sc = sel ? 1.0f : C2A;
        bf16_t* dst = (bf16_t*)(ws + (sel ? WS_KA2 : WS_QA2)) + row * 512 + h * 64;
#pragma unroll
        for (int c = 0; c < 4; ++c) { f32x4 x1a, x1b, x2a, x2b; pg8::unpack8(raw[c], x1a, x1b); pg8::unpack8(raw[c + 4], x2a, x2b);
            const f32x4 g1a = *(const f32x4*)(gn + 8 * c), g1b = *(const f32x4*)(gn + 8 * c + 4), g2a = *(const f32x4*)(gn + 32 + 8 * c), g2b = *(const f32x4*)(gn + 36 + 8 * c);
            x1a = x1a * g1a * rstd; x1b = x1b * g1b * rstd; x2a = x2a * g2a * rstd; x2b = x2b * g2b * rstd;
            const f32x4 ca = *(const f32x4*)(cosA + pos * 32 + 8 * c), cb = *(const f32x4*)(cosA + pos * 32 + 8 * c + 4), sa = *(const f32x4*)(sinA + pos * 32 + 8 * c), sb = *(const f32x4*)(sinA + pos * 32 + 8 * c + 4);
            const f32x4 y1a = x1a * ca - x2a * sa, y1b = x1b * cb - x2b * sb, y2a = x2a * ca + x1a * sa, y2b = x2b * cb + x1b * sb;
            *(u32x4*)(dst + 8 * c) = pg8::pack8(y1a * sc, y1b * sc); *(u32x4*)(dst + 32 + 8 * c) = pg8::pack8(y2a * sc, y2b * sc);
            if (sel) { LAS f32x4* kr = (LAS f32x4*)(kst + r * 68); kr[2 * c] = y1a; kr[2 * c + 1] = y1b; kr[8 + 2 * c] = y2a; kr[8 + 2 * c + 1] = y2b; } }
        __syncthreads();
        { const int d = I_.tid & 63, pt = I_.tid >> 6; float s = 0.f;
#pragma unroll 8
            for (int rr = 0; rr < 32; ++rr) s += kst[(pt * 32 + rr) * 68 + d];
            part[pt * 64 + d] = s; }
        __syncthreads();
        if (I_.tid < 64) { float s = 0.f;
#pragma unroll
            for (int pt = 0; pt < 8; ++pt) s += part[pt * 64 + I_.tid];
            ((float*)(ws + WS_KMEAN))[(((size_t)b * 8 + h) * 8 + blk) * 64 + I_.tid] = s * (1.f / 256.f); }
        __syncthreads();
    }
    const int gw = F.vcu * NWAVES + I_.wave, NGW = F.G * NWAVES;
    const f32x4 gq = ((const f32x4*)P.in[I_QLATN])[I_.lane]; const f32x2 gk = ((const f32x2*)P.in[I_KVLATN])[I_.lane];
    for (int m0 = gw * 8; m0 < NTOK; m0 += NGW * 8) {
        u32x2 wq[8]; unsigned wk[8];
#pragma unroll
        for (int q = 0; q < 8; ++q) { wq[q] = *((const u32x2*)(PROJ + (size_t)(m0 + q) * DINP + PC_CQ) + I_.lane); wk[q] = *((const unsigned*)(PROJ + (size_t)(m0 + q) * DINP + PC_CKV) + I_.lane); }
#pragma unroll
        for (int r = 0; r < 8; ++r) { const int m = m0 + r;
            const f32x4 q = {bflo(wq[r].x), bfhi(wq[r].x), bflo(wq[r].y), bfhi(wq[r].y)}; const f32x2 k = {bflo(wk[r]), bfhi(wk[r])};
            const float sq = wave_sum((q.x * q.x + q.y * q.y) + (q.z * q.z + q.w * q.w)), sk = wave_sum(k.x * k.x + k.y * k.y);
            const float rq = 1.0f / sqrtf(sq * (1.f / 256.f) + EPS), rk = 1.0f / sqrtf(sk * (1.f / 128.f) + EPS);
            const f32x4 yq = q * rq * gq; const f32x2 yk = k * rk * gk;
            *((u32x2*)((bf16_t*)(ws + WS_CQN) + (size_t)m * 256) + I_.lane) = (u32x2){cvt_pk_bf16(yq.x, yq.y), cvt_pk_bf16(yq.z, yq.w)};
            *((unsigned*)((bf16_t*)(ws + WS_CKVN) + (size_t)m * 128) + I_.lane) = cvt_pk_bf16(yk.x, yk.y); }
    }
}

__device__ __forceinline__ void phase4(Frame& F) {
    PHASE_IDS();
    const Params& P = *F.P; unsigned char* ws = F.ws;
    const bf16_t* PROJ = (const bf16_t*)(ws + WS_PROJ);
    const float* cosB = (const float*)(ws + WS_ROPE) + 131072; const float* sinB = cosB + 32768;
    const int gw = F.vcu * NWAVES + I_.wave, NGW = F.G * NWAVES;
    for (int it = gw; it < (NTOK / 64) * 16; it += NGW) {
        const int h = it & 7, sel = (it >> 3) & 1, rg = it >> 4; const size_t row = (size_t)rg * 64 + I_.lane; const int pos = (int)(row & (SEQ - 1));
        u32x4 raw[12];
        bf16_t* qrow = (bf16_t*)(ws + WS_QB) + row * 768 + h * 96;
        if (sel == 0) {
#pragma unroll
            for (int c = 0; c < 12; ++c) raw[c] = *(const u32x4*)(qrow + 8 * c);
        } else {
            const bf16_t* kn = (const bf16_t*)(ws + WS_KV) + row * 1024 + h * 128; const bf16_t* kp = PROJ + row * DINP + PC_KPE;
#pragma unroll
            for (int c = 0; c < 8; ++c) raw[c] = *(const u32x4*)(kn + 8 * c);
#pragma unroll
            for (int c = 0; c < 4; ++c) raw[8 + c] = *(const u32x4*)(kp + 8 * c);
        }
        float ss = 0.f;
#pragma unroll
        for (int c = 0; c < 12; ++c) { f32x4 a0, a1; pg8::unpack8(raw[c], a0, a1); ss += (a0[0] * a0[0] + a0[1] * a0[1]) + (a0[2] * a0[2] + a0[3] * a0[3]) + (a1[0] * a1[0] + a1[1] * a1[1]) + (a1[2] * a1[2] + a1[3] * a1[3]); }
        const float rstd = 1.0f / sqrtf(ss * (1.f / 96.f) + EPS);
        const float* gn = sel ? P.in[I_MLAKN] : P.in[I_MLAQN];
        const float sc = sel ? 1.0f : C2B; const float rs = rstd * sc;
        bf16_t* dst = sel ? (bf16_t*)(ws + WS_KB2) + row * 768 + h * 96 : qrow;
#pragma unroll
        for (int c = 0; c < 8; ++c) { f32x4 a0, a1; pg8::unpack8(raw[c], a0, a1); const f32x4 g0 = *(const f32x4*)(gn + 8 * c), g1 = *(const f32x4*)(gn + 8 * c + 4);
            *(u32x4*)(dst + 8 * c) = pg8::pack8(a0 * g0 * rs, a1 * g1 * rs); }
#pragma unroll
        for (int c = 0; c < 2; ++c) { f32x4 x1a, x1b, x2a, x2b; pg8::unpack8(raw[8 + c], x1a, x1b); pg8::unpack8(raw[10 + c], x2a, x2b);
            const f32x4 g1a = *(const f32x4*)(gn + 64 + 8 * c), g1b = *(const f32x4*)(gn + 68 + 8 * c), g2a = *(const f32x4*)(gn + 80 + 8 * c), g2b = *(const f32x4*)(gn + 84 + 8 * c);
            x1a = x1a * g1a * rs; x1b = x1b * g1b * rs; x2a = x2a * g2a * rs; x2b = x2b * g2b * rs;
            const f32x4 ca = *(const f32x4*)(cosB + pos * 16 + 8 * c), cb = *(const f32x4*)(cosB + pos * 16 + 8 * c + 4), sa = *(const f32x4*)(sinB + pos * 16 + 8 * c), sb = *(const f32x4*)(sinB + pos * 16 + 8 * c + 4);
            *(u32x4*)(dst + 64 + 8 * c) = pg8::pack8(x1a * ca - x2a * sa, x1b * cb - x2b * sb);
            *(u32x4*)(dst + 80 + 8 * c) = pg8::pack8(x2a * ca + x1a * sa, x2b * cb + x1b * sb); }
    }
}

__device__ __forceinline__ void phase5(Frame& F) {
    unsigned char* ws = F.ws;
    for (int it = F.vcu; it < 256; it += F.G) {
        const int bh = it >> 2, sidx = it & 3, b = bh >> 3, h = bh & 7;
#pragma unroll 1
        for (int k = 0; k < 2; ++k) { const int qb = k ? 7 - sidx : sidx;
            att::attn_unit<64, true>(b, qb, (const bf16_t*)(ws + WS_QA2) + h * 64, 512, (const bf16_t*)(ws + WS_KA2) + h * 64, 512, (const bf16_t*)(ws + WS_PROJ) + PC_VA + h * 64, DINP,
                                     ws + WS_Y + h * 64, 1024, (const float*)(ws + WS_KMEAN) + (size_t)bh * 512, F.lds, F.wave); }
#pragma unroll 1
        for (int k = 0; k < 2; ++k) { const int qb = k ? 7 - sidx : sidx;
            att::attn_unit<96, false>(b, qb, (const bf16_t*)(ws + WS_QB) + h * 96, 768, (const bf16_t*)(ws + WS_KB2) + h * 96, 768, (const bf16_t*)(ws + WS_KV) + h * 128 + 64, 1024,
                                      ws + WS_Y + 512 + h * 64, 1024, nullptr, F.lds, F.wave); }
    }
}

__device__ __forceinline__ void phase8(Frame& F) {
    PHASE_IDS();
    const Params& P = *F.P; unsigned char* ws = F.ws;
    constexpr int HCS = 132, WCS = 48;
    LAS float* HC = (LAS float*)F.lds;
    LAS float* WC = HC + 2 * 64 * HCS;
    LAS float* RSTD = WC + 2 * 128 * WCS;
    LAS float* LOGIT = RSTD + 64;
    LAS int* pe = (LAS int*)(LOGIT + 64 * 33);
    int* PAIR_E = (int*)(ws + WS_PAIR); int* PAIR_RANK = PAIR_E + 65536; float* PAIR_W = (float*)(PAIR_E + 131072);
    const float* gffn = P.in[I_GFFN]; const float* wr_ = P.in[I_WR]; const float* br_ = P.in[I_BR];
    const int r0 = F.vcu * 64;
    if (I_.tid < 64) { const f32x4* sp = (const f32x4*)((const float*)(ws + WS_SSP) + (size_t)(r0 + I_.tid) * 16); const f32x4 a = sp[0], b = sp[1], c = sp[2], d = sp[3];
        const float ss = (((a[0] + a[1]) + (a[2] + a[3])) + ((b[0] + b[1]) + (b[2] + b[3]))) + (((c[0] + c[1]) + (c[2] + c[3])) + ((d[0] + d[1]) + (d[2] + d[3])));
        RSTD[I_.tid] = 1.0f / sqrtf(ss * (1.f / DM) + EPS); }
    __syncthreads();
    const int eg = I_.wave & 1, rgp = I_.wave >> 1, l15 = I_.lane & 15, l4 = I_.lane >> 4;
    const int srow = I_.tid >> 5, sc4 = I_.tid & 31;
    const int wrow = I_.tid >> 3, wc4 = I_.tid & 7;
    f32x4 stg[4], wst[2];
#define P8_LOAD(kc) do { _Pragma("unroll") for (int i = 0; i < 4; ++i) { const u32x2 w_ = *(const u32x2*)((const bf16_t*)(ws + WS_X1B) + (size_t)(r0 + srow + 16 * i) * DM + (kc) * 128 + 4 * sc4); stg[i] = (f32x4){bflo(w_.x), bfhi(w_.x), bflo(w_.y), bfhi(w_.y)}; } \
        _Pragma("unroll") for (int i = 0; i < 2; ++i) wst[i] = *(const f32x4*)(wr_ + (size_t)((kc) * 128 + wrow + 64 * i) * 32 + 4 * wc4); } while (0)
#define P8_STORE(kc, buf) do { const f32x4 g4 = *(const f32x4*)(gffn + (kc) * 128 + 4 * sc4); _Pragma("unroll") for (int i = 0; i < 4; ++i) { const float rs = RSTD[srow + 16 * i]; const f32x4 y = stg[i] * rs * g4; \
        *(LAS f32x4*)(HC + ((buf) * 64 + srow + 16 * i) * HCS + 4 * sc4) = y; *(unsigned*)(ws + WS_HNF8 + (size_t)(r0 + srow + 16 * i) * DM + (kc) * 128 + 4 * sc4) = pack4_fp8(y.x, y.y, y.z, y.w); } \
        _Pragma("unroll") for (int i = 0; i < 2; ++i) *(LAS f32x4*)(WC + ((buf) * 128 + wrow + 64 * i) * WCS + 4 * wc4) = wst[i]; } while (0)
    P8_LOAD(0); P8_STORE(0, 0);
    __syncthreads();
    f32x4 acc = {0.f, 0.f, 0.f, 0.f};
#pragma unroll 1
    for (int kc = 0; kc < 8; ++kc) { const int buf = kc & 1;
        if (kc + 1 < 8) P8_LOAD(kc + 1);
        const LAS float* wp = WC + (buf * 128 + l4) * WCS + eg * 16 + l15;
        const LAS float* hp = HC + (buf * 64 + rgp * 16 + l15) * HCS + l4;
#pragma unroll
        for (int kk = 0; kk < 32; ++kk) acc = __builtin_amdgcn_mfma_f32_16x16x4f32(wp[4 * kk * WCS], hp[4 * kk], acc, 0, 0, 0);
        if (kc + 1 < 8) P8_STORE(kc + 1, buf ^ 1);
        __syncthreads(); }
#undef P8_LOAD
#undef P8_STORE
#pragma unroll
    for (int i = 0; i < 4; ++i) { const int e = eg * 16 + 4 * l4 + i; LOGIT[(rgp * 16 + l15) * 33 + e] = acc[i] + br_[e]; }
    __syncthreads();
    if (I_.tid < 64) { const int rr = I_.tid, m = r0 + rr;
        float lg[32];
#pragma unroll
        for (int e = 0; e < 32; ++e) lg[e] = LOGIT[rr * 33 + e];
        int te[4]; float tv[4]; unsigned used = 0u;
#pragma unroll
        for (int k = 0; k < 4; ++k) { float best = -INFINITY; int bi = 0;
#pragma unroll
            for (int e = 0; e < 32; ++e) { const bool ok = !((used >> e) & 1u) && (lg[e] > best); best = ok ? lg[e] : best; bi = ok ? e : bi; }
            used |= 1u << bi; te[k] = bi; tv[k] = best; }
        const float e0 = 1.0f, e1 = __expf(tv[1] - tv[0]), e2 = __expf(tv[2] - tv[0]), e3 = __expf(tv[3] - tv[0]); const float inv = 1.0f / (e0 + e1 + e2 + e3);
        *(i32x4*)(PAIR_E + m * 4) = (i32x4){te[0], te[1], te[2], te[3]};
        *(f32x4*)(PAIR_W + m * 4) = (f32x4){e0 * inv, e1 * inv, e2 * inv, e3 * inv};
        *(LAS i32x4*)(pe + rr * 4) = (i32x4){te[0], te[1], te[2], te[3]}; }
    __syncthreads();
    if (I_.tid < 256) { const int e = pe[I_.tid]; int rank = 0;
#pragma unroll 16
        for (int j4 = 0; j4 < 64; ++j4) { const i32x4 v = *(const LAS i32x4*)(pe + 4 * j4); const int j = 4 * j4;
            rank += ((j < I_.tid) && v.x == e) + ((j + 1 < I_.tid) && v.y == e) + ((j + 2 < I_.tid) && v.z == e) + ((j + 3 < I_.tid) && v.w == e); }
        PAIR_RANK[r0 * 4 + I_.tid] = rank; }
    else if (I_.tid < 288) { const int e = I_.tid - 256; int c = 0;
#pragma unroll 16
        for (int j4 = 0; j4 < 64; ++j4) { const i32x4 v = *(const LAS i32x4*)(pe + 4 * j4); c += (v.x == e) + (v.y == e) + (v.z == e) + (v.w == e); }
        ((int*)(ws + WS_HIST))[F.vcu * 32 + e] = c; }
    __syncthreads();
}

__device__ __forceinline__ int moe_layout(Frame& F) {
    PHASE_IDS();
    LAS int* ctl = (LAS int*)(F.lds + LDS_CTL);
    LAS int* part = ctl + 512;
    const int* HIST = (const int*)(F.ws + WS_HIST);
    __syncthreads();
    { const int e = I_.tid & 31, pt = I_.tid >> 5; int tot = 0, before = 0; int c[16];
#pragma unroll
        for (int i = 0; i < 16; ++i) c[i] = HIST[(pt * 16 + i) * 32 + e];
#pragma unroll
        for (int i = 0; i < 16; ++i) { tot += c[i]; before += (pt * 16 + i < F.vcu) ? c[i] : 0; }
        part[pt * 64 + e] = tot; part[pt * 64 + 32 + e] = before; }
    __syncthreads();
    if (I_.tid < 32) { int tot = 0, before = 0;
#pragma unroll
        for (int pt = 0; pt < 16; ++pt) { tot += part[pt * 64 + I_.tid]; before += part[pt * 64 + 32 + I_.tid]; }
        ctl[I_.tid] = tot; ctl[65 + I_.tid] = before; }
    __syncthreads();
    if (I_.tid == 0) { int row = 0, mt = 0;
        for (int e = 0; e < 32; ++e) { ctl[32 + e] = row; ctl[65 + e] += row; const int nt_ = (ctl[e] + 255) >> 8;
            for (int t = 0; t < nt_; ++t) ctl[128 + mt + t] = e;
            mt += nt_; row += nt_ * 256; }
        ctl[64] = row; ctl[100] = mt; }
    __syncthreads();
    return ctl[100];
}

__device__ __forceinline__ void phase9(Frame& F) {
    PHASE_IDS();
    unsigned char* ws = F.ws;
    moe_layout(F);
    LAS int* ctl = (LAS int*)(F.lds + LDS_CTL);
    const int* PAIR_E = (const int*)(ws + WS_PAIR); const int* PAIR_RANK = PAIR_E + 65536; int* ROWDEST = (int*)(ws + WS_PAIR) + 196608; int* TOK = (int*)(ws + WS_TOK);
    const int rows_per_blk = NTOK / F.G;
    if (I_.tid < rows_per_blk * 4) { const int gp = F.vcu * rows_per_blk * 4 + I_.tid;
        const int e = PAIR_E[gp], rk = PAIR_RANK[gp]; const int dest = ctl[65 + e] + rk;
        ROWDEST[gp] = dest; TOK[dest] = gp >> 2; }
    if (F.vcu < 32) { const int e = F.vcu; const int lo = ctl[32 + e] + ctl[e], hi = (e == 31) ? ctl[64] : ctl[33 + e];
        for (int r = lo + I_.tid; r < hi; r += NTHREADS) TOK[r] = 0; }
}

__device__ __forceinline__ void stage_tok(Frame& F, int nmt, int ntn) {
    PHASE_IDS();
    const int* TOK = (const int*)(F.ws + WS_TOK); LAS unsigned short* tokl = (LAS unsigned short*)(F.lds + LDS_TOKL);
    for (int i = 0; i < 10; ++i) { const int j = (i * F.G + (int)blockIdx.x) >> 3; const int mt = (j / ntn) * 8 + ((int)blockIdx.x & 7); if (mt >= nmt) break;
        if (I_.tid < 256) tokl[i * 256 + I_.tid] = (unsigned short)TOK[mt * 256 + I_.tid]; }
    __syncthreads();
}

__device__ __forceinline__ void phase12(Frame& F) {
    PHASE_IDS();
    const Params& P = *F.P; unsigned char* ws = F.ws;
    const int gw = F.vcu * NWAVES + I_.wave, NGW = F.G * NWAVES;
    const float* PAIR_W = (const float*)(ws + WS_PAIR) + 131072; const int* ROWDEST = (const int*)(ws + WS_PAIR) + 196608;
    const bf16_t* YP = (const bf16_t*)(ws + WS_XG);
    const f32x4* gp = (const f32x4*)P.in[I_GPLE] + I_.lane; f32x4 gv[4];
#pragma unroll
    for (int j = 0; j < 4; ++j) gv[j] = gp[64 * j];
    for (int m0 = gw; m0 < NTOK; m0 += 2 * NGW) {
        int mm[2]; mm[0] = m0; mm[1] = (m0 + NGW < NTOK) ? m0 + NGW : m0;
        f32x4 wv[2]; i32x4 dv[2];
#pragma unroll
        for (int q = 0; q < 2; ++q) { wv[q] = *(const f32x4*)(PAIR_W + mm[q] * 4); dv[q] = *(const i32x4*)(ROWDEST + mm[q] * 4); }
        f32x4 v[2][4]; u32x2 y[2][4][4];
#pragma unroll
        for (int q = 0; q < 2; ++q) { const u32x2* xr = (const u32x2*)((const bf16_t*)(ws + WS_X1B) + (size_t)mm[q] * DM) + I_.lane;
#pragma unroll
            for (int j = 0; j < 4; ++j) { const u32x2 w_ = xr[64 * j]; v[q][j] = (f32x4){bflo(w_.x), bfhi(w_.x), bflo(w_.y), bfhi(w_.y)}; }
#pragma unroll
            for (int k = 0; k < 4; ++k) { const u32x2* yr = (const u32x2*)(YP + (size_t)dv[q][k] * DM) + I_.lane;
#pragma unroll
                for (int j = 0; j < 4; ++j) y[q][k][j] = yr[64 * j]; } }
#pragma unroll
        for (int q = 0; q < 2; ++q) { if (q == 1 && mm[1] == mm[0]) break;
            float s = 0.f; u32x2* xw = (u32x2*)((bf16_t*)(ws + WS_X1B) + (size_t)mm[q] * DM) + I_.lane;
#pragma unroll
            for (int j = 0; j < 4; ++j) {
#pragma unroll
                for (int k = 0; k < 4; ++k) { const u32x2 yy = y[q][k][j]; v[q][j] += (f32x4){bflo(yy.x), bfhi(yy.x), bflo(yy.y), bfhi(yy.y)} * wv[q][k]; }
                xw[64 * j] = (u32x2){cvt_pk_bf16(v[q][j].x, v[q][j].y), cvt_pk_bf16(v[q][j].z, v[q][j].w)}; s += (v[q][j].x * v[q][j].x + v[q][j].y * v[q][j].y) + (v[q][j].z * v[q][j].z + v[q][j].w * v[q][j].w); }
            const float rstd = 1.0f / sqrtf(wave_sum(s) * (1.f / DM) + EPS);
            unsigned* o4 = (unsigned*)(ws + WS_HNF8 + (size_t)mm[q] * DM) + I_.lane;
#pragma unroll
            for (int j = 0; j < 4; ++j) { const f32x4 yo = v[q][j] * rstd * gv[j]; o4[64 * j] = pack4_fp8(yo.x, yo.y, yo.z, yo.w); } }
    }
}

__global__ void __launch_bounds__(NTHREADS, 2) fwd(Params prm) {
    extern __shared__ __attribute__((aligned(16))) unsigned char lds_raw[];
    Frame F;
    F.lds = (LAS unsigned char*)lds_raw;
    F.wave = __builtin_amdgcn_readfirstlane((int)threadIdx.x >> 6);
    if (threadIdx.x < 2) ((volatile LAS unsigned*)(F.lds + LDS_BARST))[threadIdx.x] = 0u;
    const XcdBarrier bar = xcd_barrier_post((unsigned*)(prm.ws + WS_BAR), (volatile LAS unsigned*)(F.lds + LDS_BARST), F.wave);
    if (prm.ph_lo < 0) cg::this_grid().sync();
    __syncthreads();
    F.G = gridDim.x; { const int bx = blockIdx.x; F.vcu = (F.G % 8 == 0) ? (bx % 8) * (F.G / 8) + bx / 8 : bx; }
    F.P = &prm; F.ws = prm.ws;
    unsigned char* ws = prm.ws;
    const int lo = prm.ph_lo, hi = prm.ph_hi;
#ifndef PH_MASK
#define PH_MASK 0xffffu
#endif
#ifndef REP_MASK
#define REP_MASK 0u
#endif
#define IN(k) (((PH_MASK >> (k)) & 1u) && lo <= (k) && (k) < hi)
#define REPS(k) for (int rep_ = 0; rep_ < (((REP_MASK >> (k)) & 1u) ? 2 : 1); ++rep_, (((REP_MASK >> (k)) & 1u) && rep_ < 2 ? xcd_barrier(bar) : (void)0))
#define SEAM(k) do { __builtin_amdgcn_sched_barrier(0); asm volatile("" ::: "memory"); if (IN(k) && IN((k) + 1)) xcd_barrier(bar); STAMP((k) + 1); __builtin_amdgcn_sched_barrier(0); asm volatile("" ::: "memory"); } while (0)
    using namespace pg8;
    STAMP(0);
    if (IN(0)) REPS(0) phase0(F);
    SEAM(0);
    if (IN(1)) REPS(1) {
        { Gemm g{(const bf16_t*)(ws + WS_HN), (const bf16_t*)(ws + WS_WIN), DM, DM, DM}; StaticOrder S; S.init(NTOK, 2048, F.G, (int)blockIdx.x);
          const float* cosA_ = (const float*)(ws + WS_ROPE);
          EpiProj E{(bf16_t*)(ws + WS_PROJ), (bf16_t*)(ws + WS_QA2), (bf16_t*)(ws + WS_KA2), (float*)(ws + WS_KMEAN), (bf16_t*)(ws + WS_CQN), (bf16_t*)(ws + WS_CKVN),
                    prm.in[I_MQN], prm.in[I_MKN], prm.in[I_QLATN], prm.in[I_KVLATN], cosA_, cosA_ + 65536, (LAS float*)(F.lds + LDS_TOKL), (float*)(ws + WS_KPESS)};
          gemm_phase(F.lds, F.wave, g, S, E); }
        __builtin_amdgcn_sched_barrier(0); asm volatile("" ::: "memory");
        { Gemm g{(const bf16_t*)(ws + WS_HNF8), (const bf16_t*)(ws + WS_WINF8), 512, 512, 512}; StaticOrder S; S.init(NTOK, 2048, F.G, (int)blockIdx.x);
          EpiStore E{(bf16_t*)(ws + WS_PROJ) + PC_GA, DINP, nullptr, 0, 0}; gemm_phase<EpiStore, StaticOrder, false, true>(F.lds, F.wave, g, S, E); } }
    SEAM(1);
    if (IN(3)) REPS(3) {
        const float* cosB_ = (const float*)(ws + WS_ROPE) + 131072;
        { Gemm g{(const bf16_t*)(ws + WS_CQN), (const bf16_t*)(ws + WS_WUQ), 256, 256, 256}; StaticOrder S; S.init(NTOK, 1024, F.G, (int)blockIdx.x);
          EpiQB E{(bf16_t*)(ws + WS_QB), prm.in[I_MLAQN], cosB_, cosB_ + 32768, (LAS float*)(F.lds + LDS_CTL)}; gemm_phase(F.lds, F.wave, g, S, E); }
        __builtin_amdgcn_sched_barrier(0); asm volatile("" ::: "memory");
        { Gemm g{(const bf16_t*)(ws + WS_CKVN), (const bf16_t*)(ws + WS_WUKV), 128, 128, 128}; StaticOrder S; S.init(NTOK, 1024, F.G, (int)blockIdx.x);
          EpiKV E{(bf16_t*)(ws + WS_KB2), (bf16_t*)(ws + WS_KV), (const bf16_t*)(ws + WS_PROJ), (const float*)(ws + WS_KPESS), prm.in[I_MLAKN], cosB_, cosB_ + 32768, (LAS float*)(F.lds + LDS_CTL)};
          gemm_phase(F.lds, F.wave, g, S, E); } }
    SEAM(3);
    if (IN(5)) REPS(5) phase5(F);
    SEAM(5);
    if (IN(6)) REPS(6) { Gemm g{(const bf16_t*)(ws + WS_Y), (const bf16_t*)(ws + WS_WA), 512, 256, 256}; BranchOrder S; S.so.init(NTOK, DM, F.G, (int)blockIdx.x);
        EpiGateAB E{(bf16_t*)(ws + WS_MERGED), (const bf16_t*)(ws + WS_PROJ) + PC_GA, (const bf16_t*)(ws + WS_PROJ) + PC_GB, DINP, ws + WS_KA2  };
        gemm_phase<EpiGateAB, BranchOrder, false, true>(F.lds, F.wave, g, S, E); }
    SEAM(7);
    if (IN(8)) REPS(8) { Gemm g{(const bf16_t*)(ws + WS_KA2), (const bf16_t*)(ws + WS_WO), 512, 512, 512}; StaticOrder S; S.init(NTOK, DM, F.G, (int)blockIdx.x);
        EpiResF32 E{prm.in[I_X], (bf16_t*)(ws + WS_X1B), (float*)(ws + WS_SSP)}; gemm_phase<EpiResF32, StaticOrder, false, true>(F.lds, F.wave, g, S, E); }
    SEAM(8);
    if (IN(9)) REPS(9) phase8(F);
    SEAM(9);
    if (IN(10)) REPS(10) phase9(F);
    SEAM(10);
    if (IN(11)) REPS(11) { const int nmt = ((const LAS int*)(F.lds + LDS_CTL))[100]; stage_tok(F, nmt, 8);
        Gemm g{(const bf16_t*)(ws + WS_HNF8), (const bf16_t*)(ws + WS_W1), 512, 512, 512}; MoeOrder S{(const LAS int*)(F.lds + LDS_CTL) + 128, nmt, 8, F.G, (int)blockIdx.x};
        EpiSwiglu E{ws + WS_ACT, prm.in[I_BGU]}; gemm_phase<EpiSwiglu, MoeOrder, true, true>(F.lds, F.wave, g, S, E, (const LAS unsigned short*)(F.lds + LDS_TOKL)); }
    SEAM(11);
    if (IN(12)) REPS(12) { const int nmt = ((const LAS int*)(F.lds + LDS_CTL))[100];
        Gemm g{(const bf16_t*)(ws + WS_ACT), (const bf16_t*)(ws + WS_W2), 512, 512, 512}; MoeOrder S{(const LAS int*)(F.lds + LDS_CTL) + 128, nmt, 4, F.G, (int)blockIdx.x};
        EpiStore E{(bf16_t*)(ws + WS_XG), DM, prm.in[I_BD], 1024, 1 << 30}; gemm_phase<EpiStore, MoeOrder, false, true>(F.lds, F.wave, g, S, E); }
    SEAM(12);
    if (IN(13)) REPS(13) phase12(F);
    SEAM(13);
    if (IN(14)) REPS(14) { Gemm g{(const bf16_t*)(ws + WS_PB), (const bf16_t*)(ws + WS_WPP), 256, 256, 256}; StaticOrder S; S.init(NTOK, DM, F.G, (int)blockIdx.x);
        EpiStore E{(bf16_t*)(ws + WS_PP), DM, nullptr, 0, 1 << 30}; gemm_phase(F.lds, F.wave, g, S, E); }
    __builtin_amdgcn_sched_barrier(0); asm volatile("s_waitcnt vmcnt(0)" ::: "memory"); __syncthreads();
    if (IN(15)) REPS(15) { Gemm g{(const bf16_t*)(ws + WS_HNF8), (const bf16_t*)(ws + WS_WPG), 512, 512, 512}; StaticOrder S; S.init(NTOK, DM, F.G, (int)blockIdx.x);
        EpiFinal E{prm.out, (const bf16_t*)(ws + WS_PP), (const bf16_t*)(ws + WS_X1B)}; gemm_phase<EpiFinal, StaticOrder, false, true>(F.lds, F.wave, g, S, E); }
#ifdef TPROBE_A
    STAMP(16);
    xcd_barrier(bar);
    if (blockIdx.x == 0 && F.wave == 0 && lane_id() == 0) {
        volatile unsigned long long* ts = (volatile unsigned long long*)(ws + WS_ERR);
        const unsigned long long da = ts[TPROBE_A1] - ts[TPROBE_A], db = ts[TPROBE_B1] - ts[TPROBE_B];
        asm volatile("s_waitcnt vmcnt(0)" ::: "memory");
        prm.out[0] += (float)db * (0.01f / 4.0f);
        const unsigned long long t0 = __builtin_amdgcn_s_memrealtime();
        while (__builtin_amdgcn_s_memrealtime() - t0 < 4ull * da) __builtin_amdgcn_s_sleep(4);
    }
#endif
#undef IN
#undef SEAM
}

extern "C" void kernel_launch(void* const* d_in, const int* in_sizes, int n_in, void* d_out, int out_size, void* d_ws, size_t ws_size, hipStream_t stream) {
    static int grid = 0;
    if (grid == 0) {
        int dev = 0, cus = 0, per_cu = 0;
        (void)hipGetDevice(&dev);
        (void)hipDeviceGetAttribute(&cus, hipDeviceAttributeMultiprocessorCount, dev);
        (void)hipFuncSetAttribute((const void*)fwd, hipFuncAttributeMaxDynamicSharedMemorySize, LDS_BYTES);
        (void)hipOccupancyMaxActiveBlocksPerMultiprocessor(&per_cu, (const void*)fwd, NTHREADS, LDS_BYTES);
        fprintf(stderr, "cus %d per_cu %d ws %zu n_in %d\n", cus, per_cu, ws_size, n_in);
        grid = (per_cu >= 1) ? cus : -1;
        if (grid != 256 || n_in != 25 || ws_size < WS_END || out_size != NTOK * DM) { fprintf(stderr, "kernel_launch: unsupported configuration\n"); grid = -1; }
    }
    if (grid < 0) return;
    (void)hipMemsetAsync((char*)d_ws + WS_BAR, 0, WS_BAR_BYTES, stream);
    Params a{};
    for (int i = 0; i < 25; ++i) a.in[i] = (const float*)d_in[i];
    a.out = (float*)d_out; a.ws = (unsigned char*)d_ws;
#ifndef MULTI_LAUNCH
    a.ph_lo = 0; a.ph_hi = NPHASE;
    void* args[] = {&a};
    hipError_t e = hipLaunchCooperativeKernel((const void*)fwd, dim3(grid), dim3(NTHREADS), args, LDS_BYTES, stream);
    if (e != hipSuccess) fprintf(stderr, "cooperative launch failed: %s\n", hipGetErrorString(e));
#else
    for (int k = 0; k < NPHASE; ++k) { a.ph_lo = k; a.ph_hi = k + 1; void* args[] = {&a};
        hipError_t e = hipLaunchCooperativeKernel((const void*)fwd, dim3(grid), dim3(NTHREADS), args, LDS_BYTES, stream);
        if (e != hipSuccess) fprintf(stderr, "launch %d failed: %s\n", k, hipGetErrorString(e)); }
#endif
}
```

```cpp
#include <hip/hip_runtime.h>
#include <hip/hip_cooperative_groups.h>
#include <cstdio>
#include <cstdint>
namespace cg = cooperative_groups;

#define LAS __attribute__((address_space(3)))
typedef unsigned short bf16_t;
typedef short bf16x8 __attribute__((ext_vector_type(8)));
typedef short s16x4 __attribute__((ext_vector_type(4)));
typedef float f32x4 __attribute__((ext_vector_type(4)));
typedef float f32x2 __attribute__((ext_vector_type(2)));
typedef float f32x16 __attribute__((ext_vector_type(16)));
typedef unsigned u32x4 __attribute__((ext_vector_type(4)));
typedef unsigned u32x2 __attribute__((ext_vector_type(2)));
typedef int i32x4 __attribute__((ext_vector_type(4)));
typedef int i32x8 __attribute__((ext_vector_type(8)));
typedef __bf16 bf16x2_t __attribute__((ext_vector_type(2)));

constexpr int NB = 8, SEQ = 2048, NTOK = NB * SEQ, DM = 1024;
constexpr int DIN = 4000, DINP = 4096;
constexpr int NEXP = 32, TOPK = 4, DEXP = 1024;
constexpr int NTHREADS = 512, NWAVES = 8;
constexpr float EPS = 1e-6f;
constexpr float LOG2E = 1.4426950408889634f;
constexpr float C2A = 0.125f * LOG2E;
constexpr float C2B = 0.10206207261596575f * LOG2E;
constexpr int PC_QA = 0, PC_KA = 512, PC_VA = 1024, PC_CQ = 1536, PC_CKV = 1792, PC_KPE = 1920, PC_GA = 2048, PC_GB = 3072;

constexpr size_t MiB = 1u << 20;
constexpr size_t WS_HIST = 0;
constexpr size_t WS_ERR = 64 * 1024;
constexpr size_t WS_BAR = 128 * 1024;
constexpr size_t WS_BAR_BYTES = 16 * 1024;
constexpr size_t WS_KPESS = 576 * 1024;
constexpr size_t WS_TOK = 256 * 1024;
constexpr size_t WS_ROPE = 1 * MiB;
constexpr size_t WS_KMEAN = 2 * MiB;
constexpr size_t WS_SSP = 11 * MiB;
constexpr size_t WS_PAIR = 3 * MiB;
constexpr size_t WS_WUQ = 4 * MiB, WS_WUKV = 4 * MiB + 512 * 1024, WS_WPP = 5 * MiB, WS_WA = 6 * MiB, WS_WB = 7 * MiB, WS_WO = 8 * MiB, WS_WPG = 10 * MiB, WS_WIN = 12 * MiB;
constexpr size_t WS_W1 = 20 * MiB, WS_W2 = 148 * MiB;
constexpr size_t WS_WINF8 = 16 * MiB;
constexpr size_t WS_HNF8 = 84 * MiB;
constexpr size_t WS_HN = 212 * MiB, WS_PB = 244 * MiB;
constexpr size_t WS_X1B = WS_HN;
constexpr size_t WS_CQN = 252 * MiB, WS_CKVN = 260 * MiB, WS_QB = 264 * MiB, WS_KV = 288 * MiB, WS_KB2 = 320 * MiB, WS_Y = 344 * MiB, WS_MERGED = 376 * MiB;
constexpr size_t WS_ACT = 252 * MiB;
constexpr size_t WS_PP = 400 * MiB;
constexpr size_t WS_KA2 = 432 * MiB;
constexpr size_t WS_PROJ = 448 * MiB;
constexpr size_t WS_QA2 = 576 * MiB;
constexpr size_t WS_XG = 448 * MiB;
constexpr size_t WS_END = 592 * MiB;
constexpr int MAXROWS = 73728, MAXMT = 288;

constexpr int RING_BYTES = 131072;
constexpr int LDS_CTL = RING_BYTES;
constexpr int LDS_TOKL = RING_BYTES + 8192 + 256;
constexpr int LDS_BARST = RING_BYTES + 8192;
constexpr int LDS_BYTES = 147456;

__device__ __forceinline__ unsigned cvt_pk_bf16(float lo, float hi) { f32x2 v = {lo, hi}; bf16x2_t b = __builtin_convertvector(v, bf16x2_t); return __builtin_bit_cast(unsigned, b); }
__device__ __forceinline__ unsigned pack4_fp8(float a, float b, float c, float d) { int w = 0; w = __builtin_amdgcn_cvt_pk_fp8_f32(a, b, w, false); w = __builtin_amdgcn_cvt_pk_fp8_f32(c, d, w, true); return (unsigned)w; }
__device__ __forceinline__ float bf2f(unsigned short b) { return __uint_as_float(((unsigned)b) << 16); }
__device__ __forceinline__ float bflo(unsigned w) { return __uint_as_float(w << 16); }
__device__ __forceinline__ float bfhi(unsigned w) { return __uint_as_float(w & 0xffff0000u); }
__device__ __forceinline__ float sigmoidf_(float x) { return __builtin_amdgcn_rcpf(1.0f + __builtin_amdgcn_exp2f(-x * LOG2E)); }
__device__ __forceinline__ int lane_id() { return (int)__builtin_amdgcn_mbcnt_hi(~0u, __builtin_amdgcn_mbcnt_lo(~0u, 0u)); }
__device__ __forceinline__ float wave_sum(float v) {
#pragma unroll
    for (int o = 1; o < 64; o <<= 1) v += __shfl_xor(v, o);
    return v;
}

namespace pg8 {
constexpr int BM = 256, BK = 64, HALF = 128, HTB = HALF * BK * 2, STAGE_BYTES = 8 * HTB, NXCD = 8, WGM = 8;
__host__ __device__ __forceinline__ int lds_byte(int r, int c) { const int st = (r >> 4) * 2 + (c >> 5), rr = r & 15, cc = c & 31, ob = rr * 64 + cc * 2; return st * 1024 + (ob ^ (((ob >> 9) & 1) << 5)); }
__host__ __device__ __forceinline__ void stage_rc(int b, int& R, int& C) { const int st = b / 1024, sb = b % 1024, swz = sb ^ (((sb >> 9) & 1) << 5); R = (st >> 1) * 16 + swz / 64; C = (st & 1) * 32 + (swz % 64) / 2; }
__host__ __device__ __forceinline__ int perm32(int rho) { const int n = rho >> 4, i = rho & 15; return 8 * (i >> 2) + 4 * n + (i & 3); }

struct Unit { int pm, pn, pb, e; int aofs = 0; };
struct Gemm { const bf16_t* A; const bf16_t* Bt; int lda, ldb, K; };

struct StaticOrder {
    int nM, nN, nwg, G, c;
    __device__ void init(int M, int N, int G_, int c_) { nM = M / BM; nN = N / BM; nwg = nM * nN; G = G_; c = c_; }
    __device__ bool next(int i, Unit& u) const {
        const long L = (long)i * G + c; if (L >= nwg) return false;
        int wgid = (int)L; { const int q = nwg / NXCD, r = nwg % NXCD, xcd = wgid % NXCD, off = wgid / NXCD; wgid = (xcd < r ? xcd * (q + 1) : r * (q + 1) + (xcd - r) * q) + off; }
        const int nig = WGM * nN, gid = wgid / nig, fm = gid * WGM, gsz = (nM - fm) < WGM ? (nM - fm) : WGM;
        u.pm = fm + ((wgid % nig) % gsz); u.pn = (wgid % nig) / gsz; u.pb = u.pn; u.e = 0; return true;
    }
};
struct MoeOrder {
    const LAS int* tile_e; int nmt, ntn, G, c;
    __device__ bool next(int i, Unit& u) const {
        const int j = (i * G + c) >> 3; const int mt = (j / ntn) * 8 + (c & 7), pn = j % ntn; if (mt >= nmt) return false;
        const int e = __builtin_amdgcn_readfirstlane(tile_e[mt]);
        u.pm = mt; u.pn = pn; u.pb = e * ntn + pn; u.e = e; return true;
    }
};

template <class Epi, class Sched, bool GATHER = false, bool FP8 = false>
__device__ __forceinline__ void gemm_phase(LAS unsigned char* lds, int wave, const Gemm g, const Sched& S, const Epi& E, const LAS unsigned short* tokl = nullptr) {
    constexpr bool ALIGN_EPI = true;
    int lane = lane_id(); asm volatile("" : "+v"(lane));
    const int wid = wave, tid = wid * 64 + lane, wr = wid >> 2, wc = wid & 3, fr = lane & 15, fq = lane >> 4;
    int K = g.K; asm volatile("" : "+s"(K));
    const int nt = K / BK;
    unsigned voffA[2], voffB[2]; int gR[2]; unsigned gC[2];
#pragma unroll
    for (int i = 0; i < 2; ++i) { int R, C; stage_rc(tid * 16 + i * 8192, R, C); const int Rb = (R & ~31) + perm32(R & 31);
        voffA[i] = (unsigned)(R * g.lda + C) * 2u; voffB[i] = (unsigned)(Rb * g.ldb + C) * 2u; gR[i] = R; gC[i] = (unsigned)C * 2u; }
    unsigned goff[2][2], noff[2][2];
#define PG8_GOFF(dst, ui_) do { _Pragma("unroll") for (int h_ = 0; h_ < 2; ++h_) _Pragma("unroll") for (int i_ = 0; i_ < 2; ++i_) \
        dst[h_][i_] = (unsigned)tokl[(ui_) * 256 + h_ * HALF + gR[i_]] * (unsigned)(g.lda * 2) + gC[i_]; } while (0)
    const size_t kstep = (size_t)(BK * 2);
    const size_t hstepA = (size_t)HALF * g.lda * 2, hstepB = (size_t)HALF * g.ldb * 2;
    const size_t tstepA = 2 * hstepA, tstepB = 2 * hstepB;
    const unsigned ldsw = (unsigned)wid * 1024u;
    const int aoff = lds_byte(wr * 64 + fr, fq * 8), boff = lds_byte(wc * 32 + fr, fq * 8);
#define PG8_SA(b, h) (((b) * 2 + (h)) * HTB)
#define PG8_SB(b, h) ((4 + (b) * 2 + (h)) * HTB)
#define PG8_STAGE(bufoff, gbase, voff) do { _Pragma("unroll") for (int _i = 0; _i < 2; ++_i) \
        __builtin_amdgcn_global_load_lds((const unsigned*)((const char*)(gbase) + (voff)[_i]), (LAS unsigned*)(lds + (bufoff) + ldsw + _i * 8192), 16, 0, 0); } while (0)
#define PG8_STAGE_A(bufoff, ptr_ng, k_g, off_g) do { if constexpr (GATHER) { const char* gb_ = (const char*)g.A + (size_t)(k_g) * kstep; PG8_STAGE(bufoff, gb_, off_g); } else { PG8_STAGE(bufoff, ptr_ng, voffA); } } while (0)
#define PG8_LDA(dst, b, h) do { if constexpr (FP8) { _Pragma("unroll") for (int m = 0; m < 4; ++m) { const i32x4 lo_ = *(const LAS i32x4*)(lds + PG8_SA(b, h) + aoff + m * 2048), hi_ = *(const LAS i32x4*)(lds + PG8_SA(b, h) + aoff + m * 2048 + 1024); dst##8[m] = __builtin_shufflevector(lo_, hi_, 0, 1, 2, 3, 4, 5, 6, 7); } } \
        else { _Pragma("unroll") for (int m = 0; m < 4; ++m) _Pragma("unroll") for (int k = 0; k < 2; ++k) dst[m][k] = *(const LAS bf16x8*)(lds + PG8_SA(b, h) + aoff + m * 2048 + k * 1024); } } while (0)
#define PG8_LDB(dst, b, h) do { if constexpr (FP8) { _Pragma("unroll") for (int n = 0; n < 2; ++n) { const i32x4 lo_ = *(const LAS i32x4*)(lds + PG8_SB(b, h) + boff + n * 2048), hi_ = *(const LAS i32x4*)(lds + PG8_SB(b, h) + boff + n * 2048 + 1024); dst##8[n] = __builtin_shufflevector(lo_, hi_, 0, 1, 2, 3, 4, 5, 6, 7); } } \
        else { _Pragma("unroll") for (int n = 0; n < 2; ++n) _Pragma("unroll") for (int k = 0; k < 2; ++k) dst[n][k] = *(const LAS bf16x8*)(lds + PG8_SB(b, h) + boff + n * 2048 + k * 1024); } } while (0)
#define PG8_CAT8(x, y) __builtin_shufflevector(__builtin_bit_cast(i32x4, x), __builtin_bit_cast(i32x4, y), 0, 1, 2, 3, 4, 5, 6, 7)
#define PG8_MMA(ai, bj, At, Bt) do { __builtin_amdgcn_s_setprio(1); if constexpr (FP8) { _Pragma("unroll") for (int m = 0; m < 4; ++m) _Pragma("unroll") for (int n = 0; n < 2; ++n) \
        asm volatile("v_mfma_scale_f32_16x16x128_f8f6f4 %0, %1, %2, %0, %3, %3 op_sel_hi:[0,0,0]" : "+v"(acc[ai][bj][m][n]) : "v"(Bt##8[n]), "v"(At##8[m]), "v"(sc8)); } \
        else { _Pragma("unroll") for (int m = 0; m < 4; ++m) _Pragma("unroll") for (int n = 0; n < 2; ++n) _Pragma("unroll") for (int k = 0; k < 2; ++k) \
        acc[ai][bj][m][n] = __builtin_amdgcn_mfma_f32_16x16x32_bf16(Bt[n][k], At[m][k], acc[ai][bj][m][n], 0, 0, 0); } __builtin_amdgcn_s_setprio(0); } while (0)
#define PG8_WAIT_V(n) asm volatile("s_waitcnt vmcnt(" #n ")" ::: "memory")
#define PG8_WAIT_L(n) asm volatile("s_waitcnt lgkmcnt(" #n ")" ::: "memory")
#define PG8_BAR __builtin_amdgcn_s_barrier()
#define PG8_SCHED __builtin_amdgcn_sched_barrier(0)
    Unit cur, nxt; int ui = 0;
    if (!S.next(0, cur)) return;
    f32x4 acc[2][2][4][2];
#pragma unroll
    for (int a = 0; a < 2; ++a)
#pragma unroll
        for (int b = 0; b < 2; ++b)
#pragma unroll
            for (int m = 0; m < 4; ++m)
#pragma unroll
                for (int n = 0; n < 2; ++n) acc[a][b][m][n] = (f32x4){0.f, 0.f, 0.f, 0.f};
    const int sc8 = 0x7c7c7c7c;
    bf16x8 At[4][2], B0[2][2], B1[2][2]; i32x8 At8[4], B08[2], B18[2];
    const char* cA = (const char*)g.A + (size_t)cur.pm * tstepA + cur.aofs; const char* cB = (const char*)g.Bt + (size_t)cur.pb * tstepB;
    if constexpr (GATHER) { PG8_GOFF(goff, 0); }
    PG8_STAGE(PG8_SB(0, 0), cB, voffB); PG8_STAGE(PG8_SB(0, 1), cB + hstepB, voffB); PG8_STAGE_A(PG8_SA(0, 0), cA, 0, goff[0]); PG8_STAGE_A(PG8_SA(0, 1), cA + hstepA, 0, goff[1]);
    if (wr == 1) PG8_BAR;
    PG8_WAIT_V(2); PG8_BAR;
    PG8_STAGE(PG8_SB(1, 0), cB + kstep, voffB); PG8_STAGE_A(PG8_SA(1, 0), cA + kstep, 1, goff[0]); PG8_STAGE(PG8_SB(1, 1), cB + hstepB + kstep, voffB);
    PG8_WAIT_V(6); PG8_BAR;
    for (;;) {
        const bool has_next = S.next(ui + 1, nxt);
        const char* nA = has_next ? (const char*)g.A + (size_t)nxt.pm * tstepA + nxt.aofs : cA; const char* nB = has_next ? (const char*)g.Bt + (size_t)nxt.pb * tstepB : cB;
        if constexpr (GATHER) { if (has_next) { PG8_GOFF(noff, ui + 1); } else {
#pragma unroll
            for (int h_ = 0; h_ < 2; ++h_)
#pragma unroll
                for (int i_ = 0; i_ < 2; ++i_) noff[h_][i_] = goff[h_][i_]; } }
        for (int t = 0; t < nt; t += 2) {
            const bool last = (t == nt - 2);
            const char* a1 = cA + (size_t)(t + 1) * kstep;
            const char* a2 = last ? nA : cA + (size_t)(t + 2) * kstep; const char* b2 = last ? nB : cB + (size_t)(t + 2) * kstep;
            const char* a3 = a2 + kstep; const char* b3 = b2 + kstep;
            const int k2 = last ? 0 : t + 2;
            unsigned soff[2][2];
            if constexpr (GATHER) {
#pragma unroll
                for (int h_ = 0; h_ < 2; ++h_)
#pragma unroll
                    for (int i_ = 0; i_ < 2; ++i_) soff[h_][i_] = last ? noff[h_][i_] : goff[h_][i_]; }
            PG8_LDB(B0, 0, 0); PG8_LDB(B1, 0, 1); PG8_SCHED; PG8_LDA(At, 0, 0); PG8_STAGE_A(PG8_SA(1, 1), a1 + hstepA, t + 1, goff[1]);
            PG8_WAIT_V(8); PG8_WAIT_L(0); PG8_BAR; PG8_MMA(0, 0, At, B0); PG8_MMA(0, 1, At, B1); PG8_BAR; PG8_SCHED;
            PG8_LDA(At, 0, 1); PG8_STAGE(PG8_SB(0, 0), b2, voffB); PG8_STAGE(PG8_SB(0, 1), b2 + hstepB, voffB); PG8_STAGE_A(PG8_SA(0, 0), a2, k2, soff[0]);
            PG8_WAIT_V(8); PG8_WAIT_L(0); PG8_BAR; PG8_MMA(1, 0, At, B0); PG8_MMA(1, 1, At, B1); PG8_BAR; PG8_SCHED;
            PG8_LDB(B0, 1, 0); PG8_LDB(B1, 1, 1); PG8_SCHED; PG8_LDA(At, 1, 0); PG8_STAGE_A(PG8_SA(0, 1), a2 + hstepA, k2, soff[1]);
            PG8_WAIT_V(8); PG8_WAIT_L(0); PG8_BAR; PG8_MMA(0, 0, At, B0); PG8_MMA(0, 1, At, B1); PG8_BAR; PG8_SCHED;
            PG8_LDA(At, 1, 1); PG8_STAGE(PG8_SB(1, 0), b3, voffB); PG8_STAGE(PG8_SB(1, 1), b3 + hstepB, voffB); PG8_STAGE_A(PG8_SA(1, 0), a3, k2 + 1, soff[0]);
            PG8_WAIT_V(8); PG8_WAIT_L(0); PG8_BAR; PG8_MMA(1, 0, At, B0); PG8_MMA(1, 1, At, B1); PG8_BAR; PG8_SCHED;
        }
        if constexpr (ALIGN_EPI) { if (wr == 0) PG8_BAR; }
        if constexpr (FP8) asm volatile("s_nop 15\n\ts_nop 15" ::: "memory");
        E(acc, cur, wr, wc, fr, fq);
        if (!has_next) break;
#pragma unroll
        for (int a = 0; a < 2; ++a)
#pragma unroll
            for (int b = 0; b < 2; ++b)
#pragma unroll
                for (int m = 0; m < 4; ++m)
#pragma unroll
                    for (int n = 0; n < 2; ++n) acc[a][b][m][n] = (f32x4){0.f, 0.f, 0.f, 0.f};
        cur = nxt; cA = nA; cB = nB; ++ui;
        if constexpr (GATHER) {
#pragma unroll
            for (int h_ = 0; h_ < 2; ++h_)
#pragma unroll
                for (int i_ = 0; i_ < 2; ++i_) goff[h_][i_] = noff[h_][i_]; }
        if constexpr (ALIGN_EPI) { if (wr == 1) PG8_BAR; }
    }
    PG8_WAIT_V(0);
    if constexpr (!ALIGN_EPI) { if (wr == 0) PG8_BAR; }
    PG8_BAR;
#undef PG8_SA
#undef PG8_SB
#undef PG8_STAGE
#undef PG8_STAGE_A
#undef PG8_GOFF
#undef PG8_LDA
#undef PG8_LDB
#undef PG8_MMA
#undef PG8_CAT8
#undef PG8_WAIT_V
#undef PG8_WAIT_L
#undef PG8_BAR
#undef PG8_SCHED
}

#define EPI_ARGS const f32x4 (&acc)[2][2][4][2], const Unit& u, int wr, int wc, int fr, int fq
__device__ __forceinline__ u32x4 pack8(f32x4 v0, f32x4 v1) { u32x4 w; w.x = cvt_pk_bf16(v0[0], v0[1]); w.y = cvt_pk_bf16(v0[2], v0[3]); w.z = cvt_pk_bf16(v1[0], v1[1]); w.w = cvt_pk_bf16(v1[2], v1[3]); return w; }
__device__ __forceinline__ void unpack8(u32x4 w, f32x4& v0, f32x4& v1) { v0 = (f32x4){bflo(w.x), bfhi(w.x), bflo(w.y), bfhi(w.y)}; v1 = (f32x4){bflo(w.z), bfhi(w.z), bflo(w.w), bfhi(w.w)}; }
__device__ __forceinline__ f32x4 sig4(f32x4 v) { return (f32x4){sigmoidf_(v[0]), sigmoidf_(v[1]), sigmoidf_(v[2]), sigmoidf_(v[3])}; }

struct EpiStore {
    bf16_t* O; int ldc; const float* bias; int bias_stride; int sig_from;
    __device__ __forceinline__ void operator()(EPI_ARGS) const {
        const int row0 = u.pm * BM + wr * 64 + fr, col0 = u.pn * BM + wc * 32 + 8 * fq;
        const bool sg = u.pn >= sig_from;
        f32x4 bv[2][2];
#pragma unroll
        for (int bj = 0; bj < 2; ++bj)
#pragma unroll
            for (int n = 0; n < 2; ++n) bv[bj][n] = bias ? *(const f32x4*)(bias + (size_t)u.e * bias_stride + col0 + bj * HALF + 4 * n) : (f32x4){0.f, 0.f, 0.f, 0.f};
#pragma unroll
        for (int ai = 0; ai < 2; ++ai)
#pragma unroll
            for (int m = 0; m < 4; ++m) { bf16_t* rowp = O + (size_t)(row0 + ai * HALF + m * 16) * ldc + col0;
#pragma unroll
                for (int bj = 0; bj < 2; ++bj) { f32x4 v0 = acc[ai][bj][m][0] + bv[bj][0], v1 = acc[ai][bj][m][1] + bv[bj][1];
                    if (sg) { v0 = sig4(v0); v1 = sig4(v1); }
                    *(u32x4*)(rowp + bj * HALF) = pack8(v0, v1); } }
    }
};

struct EpiProj {
    bf16_t* PROJ; bf16_t* QA2; bf16_t* KA2; float* KMEAN; bf16_t* CQN; bf16_t* CKVN;
    const float* gq; const float* gk; const float* glq; const float* glkv; const float* cosA; const float* sinA; LAS float* xch;
    float* KPESS;
    __device__ __forceinline__ void operator()(EPI_ARGS) const {
        const int row0 = u.pm * BM + wr * 64 + fr, col0 = u.pn * BM + wc * 32 + 8 * fq;
        if (u.pn < 4) {
            const bool isk = u.pn >= 2; const int h = 4 * (u.pn & 1) + wc; const float* gn = isk ? gk : gq; const float sc = isk ? 1.0f : C2A;
            const f32x4 g1a = *(const f32x4*)(gn + 8 * fq), g1b = *(const f32x4*)(gn + 8 * fq + 4), g2a = *(const f32x4*)(gn + 32 + 8 * fq), g2b = *(const f32x4*)(gn + 36 + 8 * fq);
            bf16_t* dst = isk ? KA2 : QA2;
            f32x4 ks1a = {0.f, 0.f, 0.f, 0.f}, ks1b = ks1a, ks2a = ks1a, ks2b = ks1a;
#pragma unroll
            for (int ai = 0; ai < 2; ++ai)
#pragma unroll
                for (int m = 0; m < 4; ++m) { const int row = row0 + ai * HALF + m * 16; const int pos = row & (SEQ - 1);
                    f32x4 x1a = acc[ai][0][m][0], x1b = acc[ai][0][m][1], x2a = acc[ai][1][m][0], x2b = acc[ai][1][m][1];
                    float ss = (x1a[0] * x1a[0] + x1a[1] * x1a[1]) + (x1a[2] * x1a[2] + x1a[3] * x1a[3]) + (x1b[0] * x1b[0] + x1b[1] * x1b[1]) + (x1b[2] * x1b[2] + x1b[3] * x1b[3])
                             + (x2a[0] * x2a[0] + x2a[1] * x2a[1]) + (x2a[2] * x2a[2] + x2a[3] * x2a[3]) + (x2b[0] * x2b[0] + x2b[1] * x2b[1]) + (x2b[2] * x2b[2] + x2b[3] * x2b[3]);
                    ss += __shfl_xor(ss, 16); ss += __shfl_xor(ss, 32);
                    const float rstd = 1.0f / sqrtf(ss * (1.f / 64.f) + EPS);
                    x1a = x1a * g1a * rstd; x1b = x1b * g1b * rstd; x2a = x2a * g2a * rstd; x2b = x2b * g2b * rstd;
                    const f32x4 ca = *(const f32x4*)(cosA + pos * 32 + 8 * fq), cb = *(const f32x4*)(cosA + pos * 32 + 8 * fq + 4), sa = *(const f32x4*)(sinA + pos * 32 + 8 * fq), sb = *(const f32x4*)(sinA + pos * 32 + 8 * fq + 4);
                    const f32x4 y1a = x1a * ca - x2a * sa, y1b = x1b * cb - x2b * sb, y2a = x2a * ca + x1a * sa, y2b = x2b * cb + x1b * sb;
                    bf16_t* rp = dst + (size_t)row * 512 + h * 64 + 8 * fq;
                    *(u32x4*)rp = pack8(y1a * sc, y1b * sc); *(u32x4*)(rp + 32) = pack8(y2a * sc, y2b * sc);
                    ks1a += y1a; ks1b += y1b; ks2a += y2a; ks2b += y2b; }
            if (isk) {
#pragma unroll
                for (int o = 1; o < 16; o <<= 1) {
#pragma unroll
                    for (int i = 0; i < 4; ++i) { ks1a[i] += __shfl_xor(ks1a[i], o); ks1b[i] += __shfl_xor(ks1b[i], o); ks2a[i] += __shfl_xor(ks2a[i], o); ks2b[i] += __shfl_xor(ks2b[i], o); } }
                if (fr == 0) { float* km = KMEAN + (((size_t)(u.pm >> 3) * 8 + h) * 8 + (u.pm & 7)) * 64 + 8 * fq;
#pragma unroll
                    for (int i = 0; i < 4; ++i) { atomicAdd(km + i, ks1a[i] * (1.f / 256.f)); atomicAdd(km + 4 + i, ks1b[i] * (1.f / 256.f)); atomicAdd(km + 32 + i, ks2a[i] * (1.f / 256.f)); atomicAdd(km + 36 + i, ks2b[i] * (1.f / 256.f)); } } }
        } else if (u.pn == 6 || u.pn == 7) {
            const bool isq = u.pn == 6;
            float ssr[2][4];
#pragma unroll
            for (int ai = 0; ai < 2; ++ai)
#pragma unroll
                for (int m = 0; m < 4; ++m) { float ss = 0.f;
#pragma unroll
                    for (int bj = 0; bj < 2; ++bj) { if (bj == 1 && !isq) continue;
#pragma unroll
                        for (int n = 0; n < 2; ++n) { const f32x4 x = acc[ai][bj][m][n]; ss += (x[0] * x[0] + x[1] * x[1]) + (x[2] * x[2] + x[3] * x[3]); } }
                    ss += __shfl_xor(ss, 16); ss += __shfl_xor(ss, 32);
                    if (fq == 0) xch[(ai * HALF + wr * 64 + m * 16 + fr) * 4 + wc] = ss; }
            asm volatile("s_waitcnt lgkmcnt(0)" ::: "memory"); __builtin_amdgcn_s_barrier(); asm volatile("" ::: "memory");
#pragma unroll
            for (int ai = 0; ai < 2; ++ai)
#pragma unroll
                for (int m = 0; m < 4; ++m) { const f32x4 p4 = *(const LAS f32x4*)(xch + (ai * HALF + wr * 64 + m * 16 + fr) * 4); ssr[ai][m] = (p4[0] + p4[1]) + (p4[2] + p4[3]); }
            asm volatile("s_waitcnt lgkmcnt(0)" ::: "memory"); __builtin_amdgcn_s_barrier(); asm volatile("" ::: "memory");
            const float invn = isq ? (1.f / 256.f) : (1.f / 128.f); const float* gl = isq ? glq : glkv; bf16_t* dn = isq ? CQN : CKVN; const int ldn = isq ? 256 : 128;
            const int c0 = wc * 32 + 8 * fq;
#pragma unroll
            for (int bj = 0; bj < 2; ++bj) {
                if (bj == 1 && !isq) {
#pragma unroll
                    for (int ai = 0; ai < 2; ++ai)
#pragma unroll
                        for (int m = 0; m < 4; ++m) { const f32x4 x0 = acc[ai][1][m][0], x1 = acc[ai][1][m][1];
                            *(u32x4*)(PROJ + (size_t)(row0 + ai * HALF + m * 16) * DINP + col0 + HALF) = pack8(x0, x1);
                            float ss = (x0[0] * x0[0] + x0[1] * x0[1]) + (x0[2] * x0[2] + x0[3] * x0[3]) + (x1[0] * x1[0] + x1[1] * x1[1]) + (x1[2] * x1[2] + x1[3] * x1[3]);
                            ss += __shfl_xor(ss, 16); ss += __shfl_xor(ss, 32);
                            if (wc == 0 && fq == 0) KPESS[row0 + ai * HALF + m * 16] = ss; }
                    continue; }
                const f32x4 ga = *(const f32x4*)(gl + bj * HALF + c0), gb = *(const f32x4*)(gl + bj * HALF + c0 + 4);
#pragma unroll
                for (int ai = 0; ai < 2; ++ai)
#pragma unroll
                    for (int m = 0; m < 4; ++m) { const float rstd = 1.0f / sqrtf(ssr[ai][m] * invn + EPS);
                        *(u32x4*)(dn + (size_t)(row0 + ai * HALF + m * 16) * ldn + bj * HALF + c0) = pack8(acc[ai][bj][m][0] * ga * rstd, acc[ai][bj][m][1] * gb * rstd); } }
        } else {
            const bool sg = u.pn >= 8;
#pragma unroll
            for (int ai = 0; ai < 2; ++ai)
#pragma unroll
                for (int m = 0; m < 4; ++m) { bf16_t* rowp = PROJ + (size_t)(row0 + ai * HALF + m * 16) * DINP + col0;
#pragma unroll
                    for (int bj = 0; bj < 2; ++bj) { f32x4 v0 = acc[ai][bj][m][0], v1 = acc[ai][bj][m][1];
                        if (sg) { v0 = sig4(v0); v1 = sig4(v1); }
                        *(u32x4*)(rowp + bj * HALF) = pack8(v0, v1); } }
        }
    }
};

struct EpiQB {
    bf16_t* QB; const float* gn; const float* cosB; const float* sinB; LAS float* xch;
    __device__ __forceinline__ void operator()(EPI_ARGS) const {
        const int rl0 = wr * 64 + fr, row0 = u.pm * BM + rl0;
#pragma unroll
        for (int ai = 0; ai < 2; ++ai)
#pragma unroll
            for (int m = 0; m < 4; ++m)
#pragma unroll
                for (int bj = 0; bj < 2; ++bj) { const f32x4 x0 = acc[ai][bj][m][0], x1 = acc[ai][bj][m][1];
                    float ss = (x0[0] * x0[0] + x0[1] * x0[1]) + (x0[2] * x0[2] + x0[3] * x0[3]) + (x1[0] * x1[0] + x1[1] * x1[1]) + (x1[2] * x1[2] + x1[3] * x1[3]);
                    ss += __shfl_xor(ss, 16); ss += __shfl_xor(ss, 32);
                    if (fq == 0) xch[((rl0 + ai * HALF + m * 16) * 2 + bj) * 4 + wc] = ss; }
        asm volatile("s_waitcnt lgkmcnt(0)" ::: "memory"); __builtin_amdgcn_s_barrier(); asm volatile("" ::: "memory");
#define QB_RS(ai, m, bj) ({ const f32x4 p4_ = *(const LAS f32x4*)(xch + ((rl0 + (ai) * HALF + (m) * 16) * 2 + (bj)) * 4); C2B / sqrtf(((p4_[0] + p4_[1]) + p4_[2]) * (1.f / 96.f) + EPS); })
        if (wc < 2) { const f32x4 ga = *(const f32x4*)(gn + 32 * wc + 8 * fq), gb = *(const f32x4*)(gn + 32 * wc + 8 * fq + 4);
#pragma unroll
            for (int ai = 0; ai < 2; ++ai)
#pragma unroll
                for (int m = 0; m < 4; ++m)
#pragma unroll
                    for (int bj = 0; bj < 2; ++bj) { const float r = QB_RS(ai, m, bj);
                        *(u32x4*)(QB + (size_t)(row0 + ai * HALF + m * 16) * 768 + (2 * u.pn + bj) * 96 + 32 * wc + 8 * fq) = pack8(acc[ai][bj][m][0] * ga * r, acc[ai][bj][m][1] * gb * r); }
        } else if (wc == 2) { const f32x4 g1 = *(const f32x4*)(gn + 64 + 4 * fq), g2 = *(const f32x4*)(gn + 80 + 4 * fq);
#pragma unroll
            for (int ai = 0; ai < 2; ++ai)
#pragma unroll
                for (int m = 0; m < 4; ++m) { const int row = row0 + ai * HALF + m * 16; const int pos = row & (SEQ - 1);
                    const f32x4 c4 = *(const f32x4*)(cosB + pos * 16 + 4 * fq), s4 = *(const f32x4*)(sinB + pos * 16 + 4 * fq);
#pragma unroll
                    for (int bj = 0; bj < 2; ++bj) { const float r = QB_RS(ai, m, bj); const f32x4 x1 = acc[ai][bj][m][0] * g1 * r, x2 = acc[ai][bj][m][1] * g2 * r;
                        const f32x4 y1 = x1 * c4 - x2 * s4, y2 = x2 * c4 + x1 * s4; bf16_t* rp = QB + (size_t)row * 768 + (2 * u.pn + bj) * 96 + 64 + 4 * fq;
                        *(u32x2*)rp = (u32x2){cvt_pk_bf16(y1[0], y1[1]), cvt_pk_bf16(y1[2], y1[3])}; *(u32x2*)(rp + 16) = (u32x2){cvt_pk_bf16(y2[0], y2[1]), cvt_pk_bf16(y2[2], y2[3])}; } }
        }
    }
};
struct EpiKV {
    bf16_t* KB2; bf16_t* KV; const bf16_t* PROJ; const float* KPESS; const float* gn; const float* cosB; const float* sinB; LAS float* xch;
    __device__ __forceinline__ void operator()(EPI_ARGS) const {
        const int rl0 = wr * 64 + fr, row0 = u.pm * BM + rl0;
        if (wc < 2) {
#pragma unroll
            for (int ai = 0; ai < 2; ++ai)
#pragma unroll
                for (int m = 0; m < 4; ++m)
#pragma unroll
                    for (int bj = 0; bj < 2; ++bj) { const f32x4 x0 = acc[ai][bj][m][0], x1 = acc[ai][bj][m][1];
                        float ss = (x0[0] * x0[0] + x0[1] * x0[1]) + (x0[2] * x0[2] + x0[3] * x0[3]) + (x1[0] * x1[0] + x1[1] * x1[1]) + (x1[2] * x1[2] + x1[3] * x1[3]);
                        ss += __shfl_xor(ss, 16); ss += __shfl_xor(ss, 32);
                        if (fq == 0) xch[((rl0 + ai * HALF + m * 16) * 2 + bj) * 4 + wc] = ss; } }
        asm volatile("s_waitcnt lgkmcnt(0)" ::: "memory"); __builtin_amdgcn_s_barrier(); asm volatile("" ::: "memory");
#define KV_RS(ai, m, bj, pe) ({ const f32x2 p2_ = *(const LAS f32x2*)(xch + ((rl0 + (ai) * HALF + (m) * 16) * 2 + (bj)) * 4); 1.0f / sqrtf(((p2_[0] + p2_[1]) + (pe)) * (1.f / 96.f) + EPS); })
        if (wc < 2) { const f32x4 ga = *(const f32x4*)(gn + 32 * wc + 8 * fq), gb = *(const f32x4*)(gn + 32 * wc + 8 * fq + 4);
#pragma unroll
            for (int ai = 0; ai < 2; ++ai)
#pragma unroll
                for (int m = 0; m < 4; ++m) { const float pe = KPESS[row0 + ai * HALF + m * 16];
#pragma unroll
                    for (int bj = 0; bj < 2; ++bj) { const float r = KV_RS(ai, m, bj, pe);
                        *(u32x4*)(KB2 + (size_t)(row0 + ai * HALF + m * 16) * 768 + (2 * u.pn + bj) * 96 + 32 * wc + 8 * fq) = pack8(acc[ai][bj][m][0] * ga * r, acc[ai][bj][m][1] * gb * r); } }
        } else {
#pragma unroll
            for (int ai = 0; ai < 2; ++ai)
#pragma unroll
                for (int m = 0; m < 4; ++m)
#pragma unroll
                    for (int bj = 0; bj < 2; ++bj) *(u32x4*)(KV + (size_t)(row0 + ai * HALF + m * 16) * 1024 + (2 * u.pn + bj) * 128 + 32 * wc + 8 * fq) = pack8(acc[ai][bj][m][0], acc[ai][bj][m][1]);
            if (wc == 2) {
                const f32x4 g1 = *(const f32x4*)(gn + 64 + 4 * fq), g2 = *(const f32x4*)(gn + 80 + 4 * fq);
#pragma unroll
                for (int ai = 0; ai < 2; ++ai)
#pragma unroll
                    for (int m = 0; m < 4; ++m) { const int row = row0 + ai * HALF + m * 16; const int pos = row & (SEQ - 1); const float pe = KPESS[row];
                        const u32x2 w1 = *(const u32x2*)(PROJ + (size_t)row * DINP + PC_KPE + 4 * fq), w2 = *(const u32x2*)(PROJ + (size_t)row * DINP + PC_KPE + 16 + 4 * fq);
                        const f32x4 k1 = (f32x4){bflo(w1.x), bfhi(w1.x), bflo(w1.y), bfhi(w1.y)} * g1, k2 = (f32x4){bflo(w2.x), bfhi(w2.x), bflo(w2.y), bfhi(w2.y)} * g2;
                        const f32x4 c4 = *(const f32x4*)(cosB + pos * 16 + 4 * fq), s4 = *(const f32x4*)(sinB + pos * 16 + 4 * fq);
                        const f32x4 y1 = k1 * c4 - k2 * s4, y2 = k2 * c4 + k1 * s4;
#pragma unroll
                        for (int bj = 0; bj < 2; ++bj) { const float r = KV_RS(ai, m, bj, pe); bf16_t* rp = KB2 + (size_t)row * 768 + (2 * u.pn + bj) * 96 + 64 + 4 * fq;
                            *(u32x2*)rp = (u32x2){cvt_pk_bf16(y1[0] * r, y1[1] * r), cvt_pk_bf16(y1[2] * r, y1[3] * r)}; *(u32x2*)(rp + 16) = (u32x2){cvt_pk_bf16(y2[0] * r, y2[1] * r), cvt_pk_bf16(y2[2] * r, y2[3] * r)}; } } }
        }
    }
};
#undef QB_RS
#undef KV_RS
template <bool ADD> struct EpiGate {
    bf16_t* O; const bf16_t* G; int ldg; unsigned char* MF8;
    __device__ __forceinline__ void operator()(EPI_ARGS) const {
        const int row0 = u.pm * BM + wr * 64 + fr, col0 = u.pn * BM + wc * 32 + 8 * fq;
#pragma unroll
        for (int ai = 0; ai < 2; ++ai)
#pragma unroll
            for (int m = 0; m < 4; ++m) { const size_t r = (size_t)(row0 + ai * HALF + m * 16);
#pragma unroll
                for (int bj = 0; bj < 2; ++bj) { const int c = col0 + bj * HALF;
                    f32x4 g0, g1; unpack8(*(const u32x4*)(G + r * ldg + c), g0, g1);
                    f32x4 v0 = acc[ai][bj][m][0] * g0, v1 = acc[ai][bj][m][1] * g1;
                    if (ADD) { f32x4 o0, o1; unpack8(*(const u32x4*)(O + r * DM + c), o0, o1); v0 += o0; v1 += o1;
                        *(u32x2*)(MF8 + r * DM + c) = (u32x2){pack4_fp8(v0[0], v0[1], v0[2], v0[3]), pack4_fp8(v1[0], v1[1], v1[2], v1[3])}; }
                    else *(u32x4*)(O + r * DM + c) = pack8(v0, v1); } }
    }
};

struct BranchOrder {
    StaticOrder so;
    __device__ bool next(int i, Unit& u) const { if (i >= 2) return false; if (!so.next(0, u)) return false; u.e = i; u.aofs = i * 512; u.pb = u.pn + 8 * i; return true; }
};
struct EpiGateAB {
    bf16_t* O; const bf16_t* Ga; const bf16_t* Gb; int ldg; unsigned char* MF8;
    __device__ __forceinline__ void operator()(EPI_ARGS) const {
        if (u.e == 0) { EpiGate<false> E{O, Ga, ldg, nullptr}; E(acc, u, wr, wc, fr, fq); }
        else { asm volatile("s_waitcnt vmcnt(0)" ::: "memory");
               EpiGate<true> E{O, Gb, ldg, MF8}; E(acc, u, wr, wc, fr, fq); }
    }
};
struct EpiResF32 {
    const float* base; bf16_t* out; float* ssp;
    __device__ __forceinline__ void operator()(EPI_ARGS) const {
        const int row0 = u.pm * BM + wr * 64 + fr, col0 = u.pn * BM + wc * 32 + 8 * fq;
#pragma unroll
        for (int ai = 0; ai < 2; ++ai)
#pragma unroll
            for (int m = 0; m < 4; ++m) { const size_t r = (size_t)(row0 + ai * HALF + m * 16); float ss = 0.f;
#pragma unroll
                for (int bj = 0; bj < 2; ++bj) { const size_t off = r * DM + col0 + bj * HALF;
                    const f32x4 b0 = *(const f32x4*)(base + off), b1 = *(const f32x4*)(base + off + 4);
                    const f32x4 y0 = b0 + acc[ai][bj][m][0], y1 = b1 + acc[ai][bj][m][1];
                    *(u32x4*)(out + off) = pack8(y0, y1);
                    ss += (y0[0] * y0[0] + y0[1] * y0[1]) + (y0[2] * y0[2] + y0[3] * y0[3]) + (y1[0] * y1[0] + y1[1] * y1[1]) + (y1[2] * y1[2] + y1[3] * y1[3]); }
                ss += __shfl_xor(ss, 16); ss += __shfl_xor(ss, 32);
                if (fq == 0) ssp[r * 16 + u.pn * 4 + wc] = ss; }
    }
};
struct EpiSwiglu {
    unsigned char* O; const float* bias;
    __device__ __forceinline__ void operator()(EPI_ARGS) const {
        const int row0 = u.pm * BM + wr * 64 + fr, j0 = u.pn * HALF + wc * 32 + 8 * fq;
        const float* be = bias + (size_t)u.e * 2048;
        f32x4 bg[2], bu[2];
#pragma unroll
        for (int n = 0; n < 2; ++n) { bg[n] = *(const f32x4*)(be + j0 + 4 * n); bu[n] = *(const f32x4*)(be + 1024 + j0 + 4 * n); }
#pragma unroll
        for (int ai = 0; ai < 2; ++ai)
#pragma unroll
            for (int m = 0; m < 4; ++m) { unsigned char* rowp = O + (size_t)(row0 + ai * HALF + m * 16) * DEXP + j0;
                f32x4 o[2];
#pragma unroll
                for (int n = 0; n < 2; ++n) { const f32x4 gv = acc[ai][0][m][n] + bg[n], uv = acc[ai][1][m][n] + bu[n];
#pragma unroll
                    for (int i = 0; i < 4; ++i) { const float gg = fminf(gv[i], 7.0f), uu = fminf(fmaxf(uv[i], -7.0f), 7.0f);
                        o[n][i] = (uu + 1.0f) * gg * __builtin_amdgcn_rcpf(1.0f + __builtin_amdgcn_exp2f(-1.702f * LOG2E * gg)); } }
                *(u32x2*)rowp = (u32x2){pack4_fp8(o[0][0], o[0][1], o[0][2], o[0][3]), pack4_fp8(o[1][0], o[1][1], o[1][2], o[1][3])}; }
    }
};
struct EpiFinal {
    float* out; const bf16_t* PP; const bf16_t* X2;
    __device__ __forceinline__ void operator()(EPI_ARGS) const {
        const int row0 = u.pm * BM + wr * 64 + fr, col0 = u.pn * BM + wc * 32 + 8 * fq;
#pragma unroll
        for (int ai = 0; ai < 2; ++ai)
#pragma unroll
            for (int m = 0; m < 4; ++m) { const size_t r = (size_t)(row0 + ai * HALF + m * 16);
#pragma unroll
                for (int bj = 0; bj < 2; ++bj) { const size_t off = r * DM + col0 + bj * HALF;
                    f32x4 p0, p1, b0, b1; unpack8(*(const u32x4*)(PP + off), p0, p1); unpack8(*(const u32x4*)(X2 + off), b0, b1);
                    *(f32x4*)(out + off) = b0 + sig4(acc[ai][bj][m][0]) * p0; *(f32x4*)(out + off + 4) = b1 + sig4(acc[ai][bj][m][1]) * p1; } }
    }
};
}

namespace att {
__device__ __forceinline__ int crow(int r, int hi) { return (r & 3) + 8 * (r >> 2) + 4 * hi; }
__device__ __forceinline__ void glds16(const void* gsrc, unsigned lds_dst) { unsigned keep;
    asm volatile("s_mov_b32 %0, m0\n\ts_mov_b32 m0, %2\n\ts_nop 0\n\tglobal_load_lds_dwordx4 %1, off\n\ts_mov_b32 m0, %0" : "=&s"(keep) : "v"(gsrc), "s"(lds_dst) : "memory"); }
__device__ __forceinline__ s16x4 vtr(const LAS unsigned char* p) { return __builtin_bit_cast(s16x4, __builtin_amdgcn_ds_read_tr16_b64_v4i16((LAS s16x4*)p)); }
#define MX3(a, b, c) __builtin_fmaxf(__builtin_fmaxf((a), (b)), (c))
constexpr int VSLOT = 8192, OST_BYTES = NWAVES * 4096, WSF_BYTES = NWAVES * 256;

template <int DQK, bool MOBA>
__device__ __forceinline__ void attn_unit(int b, int qb, const bf16_t* Qh, int ldq, const bf16_t* Kh, int ldk, const bf16_t* Vh, int ldv, unsigned char* Oh, int ldo, const float* kmean, LAS unsigned char* shm, int wave) {
    constexpr int ND = DQK / 16, NCH = DQK / 8, KSLOT = NCH * 1024;
    constexpr int LDS_K = 0, LDS_V = 2 * KSLOT, LDS_WS = LDS_V + 2 * VSLOT, LDS_OST = LDS_WS + WSF_BYTES;
    static_assert(LDS_OST + OST_BYTES <= RING_BYTES, "attention LDS");
    int lane = lane_id(); asm volatile("" : "+v"(lane));
    const int r32 = lane & 31, hi = lane >> 5; const int wid = wave;
    const long rowbase = (long)b * SEQ; const int q0 = qb * 256;
    const unsigned lds0 = (unsigned)(uintptr_t)shm;
    LAS float* wsf = (LAS float*)(shm + LDS_WS) + wid * 64;
    const int NT = 4 * (qb + 1);
    const bf16_t* ksrc0 = Kh + (rowbase + lane) * ldk + wid * 8;
    const bf16_t* vsrc0 = Vh + (rowbase + 16 * (wid & 3) + (lane >> 2)) * ldv + (wid >> 2) * 32 + (lane & 3) * 8;
#define ATT_DMA(kt, s) do { const long ro_ = (long)(kt) * 64; \
        glds16(ksrc0 + ro_ * ldk, (unsigned)__builtin_amdgcn_readfirstlane(lds0 + LDS_K + (s) * KSLOT + wid * 1024)); \
        if (NCH > 8 && wid < NCH - 8) glds16(ksrc0 + ro_ * ldk + 64, (unsigned)__builtin_amdgcn_readfirstlane(lds0 + LDS_K + (s) * KSLOT + (wid + 8) * 1024)); \
        glds16(vsrc0 + ro_ * ldv, (unsigned)__builtin_amdgcn_readfirstlane(lds0 + LDS_V + (s) * VSLOT + wid * 1024)); } while (0)
#define ATT_TILE(i) (MOBA ? ((i) < 4 ? 4 * qb + (i) : (i) - 4) : (i))
    ATT_DMA(ATT_TILE(0), 0);
    const bf16_t* Qw = Qh + (rowbase + q0 + wid * 32 + r32) * ldq + hi * 8;
    bf16x8 qr[ND];
#pragma unroll
    for (int d0 = 0; d0 < ND; ++d0) qr[d0] = *(const bf16x8*)(Qw + d0 * 16);
    unsigned bmask = 0xffffffffu;
    if (MOBA) {
        bmask = 1u << qb;
        if (qb <= 3) bmask |= (1u << qb) - 1u;
        else {
            float gsc[7];
#pragma unroll
            for (int n = 0; n < 7; ++n) { float s = 0.f;
                if (n < qb) {
#pragma unroll
                    for (int d0 = 0; d0 < ND; ++d0) { const float* km = kmean + n * 64 + d0 * 16 + hi * 8; const f32x4 k0 = *(const f32x4*)km, k1 = *(const f32x4*)(km + 4);
                        s += bf2f((unsigned short)qr[d0][0]) * k0[0] + bf2f((unsigned short)qr[d0][1]) * k0[1] + bf2f((unsigned short)qr[d0][2]) * k0[2] + bf2f((unsigned short)qr[d0][3]) * k0[3]
                           + bf2f((unsigned short)qr[d0][4]) * k1[0] + bf2f((unsigned short)qr[d0][5]) * k1[1] + bf2f((unsigned short)qr[d0][6]) * k1[2] + bf2f((unsigned short)qr[d0][7]) * k1[3]; }
                    s += __shfl_xor(s, 32);
                } else s = -INFINITY;
                gsc[n] = s; }
#pragma unroll
            for (int pass = 0; pass < 3; ++pass) { float best = -INFINITY; int bi = 0;
#pragma unroll
                for (int n = 0; n < 7; ++n) { const bool ok = (n < qb) && !((bmask >> n) & 1u) && (gsc[n] > best); best = ok ? gsc[n] : best; bi = ok ? n : bi; }
                bmask |= 1u << bi; }
        }
    }
    asm volatile("s_waitcnt vmcnt(0)" ::: "memory");
#pragma unroll
    for (int d0 = 0; d0 < ND; ++d0) asm volatile("" : "+v"(qr[d0]));
    float mhat = 0.f, l_reg = 0.f; f32x16 o[2]; o[0] = f32x16{}; o[1] = f32x16{}; f32x16 negm = f32x16{}; asm volatile("" : "+v"(negm));
    const int qrel = wid * 32 + r32;
    const LAS unsigned char* kp0 = shm + LDS_K + hi * 1024 + r32 * 16;
    const LAS unsigned char* vp0 = shm + LDS_V + ((lane >> 4) & 1) * 32 + (lane & 3) * 8 + (4 * hi + ((lane & 15) >> 2)) * 64;
    for (int i = 0; i < NT; ++i) {
        const int s = i & 1, kt = ATT_TILE(i);
        asm volatile("s_waitcnt vmcnt(0) lgkmcnt(0)\n\ts_barrier" ::: "memory");
        if (i + 1 < NT) ATT_DMA(ATT_TILE(i + 1), s ^ 1);
        f32x16 cin = negm;
        if (MOBA) { if (i >= 4 && !((bmask >> (kt >> 2)) & 1u)) {
#pragma unroll
            for (int r = 0; r < 16; ++r) cin[r] = -INFINITY; } }
        f32x16 p0, p1;
        { const LAS unsigned char* kb = kp0 + s * KSLOT; bf16x8 kf[2 * ND];
#pragma unroll
            for (int d0 = 0; d0 < ND; ++d0) { kf[2 * d0] = *(const LAS bf16x8*)(kb + d0 * 2048); kf[2 * d0 + 1] = *(const LAS bf16x8*)(kb + d0 * 2048 + 512); }
            __builtin_amdgcn_sched_barrier(0);
#pragma unroll
            for (int d0 = 0; d0 < ND; ++d0) {
                if (d0 == 0) { p0 = __builtin_amdgcn_mfma_f32_32x32x16_bf16(kf[0], qr[0], cin, 0, 0, 0); p1 = __builtin_amdgcn_mfma_f32_32x32x16_bf16(kf[1], qr[0], cin, 0, 0, 0); }
                else { p0 = __builtin_amdgcn_mfma_f32_32x32x16_bf16(kf[2 * d0], qr[d0], p0, 0, 0, 0); p1 = __builtin_amdgcn_mfma_f32_32x32x16_bf16(kf[2 * d0 + 1], qr[d0], p1, 0, 0, 0); } } }
        if (kt >= 4 * qb) { const int kb = 64 * (kt - 4 * qb) + 4 * hi;
#pragma unroll
            for (int r = 0; r < 16; ++r) { const int kv = kb + (r & 3) + 8 * (r >> 2); if (kv > qrel) p0[r] = -INFINITY; if (kv + 32 > qrel) p1[r] = -INFINITY; } }
        bool resc = false;
        { float a = MX3(p0[0], p0[1], p1[0]), bb = MX3(p0[2], p0[3], p1[1]); a = MX3(a, p1[2], p1[3]);
#pragma unroll
            for (int r = 4; r < 16; r += 4) { a = MX3(a, p0[r], p0[r + 1]); bb = MX3(bb, p0[r + 2], p0[r + 3]); a = MX3(a, p1[r], p1[r + 1]); bb = MX3(bb, p1[r + 2], p1[r + 3]); }
            float rm = __builtin_fmaxf(a, bb); rm = __builtin_fmaxf(rm, __shfl_xor(rm, 32));
            const bool first = (i == 0);
            if (first || __any(rm > 6.0f)) {
                const float dl = first ? rm : __builtin_fmaxf(rm, 0.f); mhat += dl;
#pragma unroll
                for (int r = 0; r < 16; ++r) { p0[r] -= dl; p1[r] -= dl; }
#pragma unroll
                for (int r = 0; r < 16; ++r) negm[r] = -mhat;
                asm volatile("" : "+v"(negm));
                const float f = __builtin_amdgcn_exp2f(-dl); l_reg *= f; if (hi == 0) wsf[r32] = f; resc = true; } }
        float sacc = 0.f;
#pragma unroll
        for (int r = 0; r < 16; ++r) { p0[r] = __builtin_amdgcn_exp2f(p0[r]); p1[r] = __builtin_amdgcn_exp2f(p1[r]); sacc += p0[r] + p1[r]; }
        l_reg += sacc;
        u32x4 pw0, pw1, pw2, pw3;
        pw0 = (u32x4){cvt_pk_bf16(p0[0], p0[1]), cvt_pk_bf16(p0[2], p0[3]), cvt_pk_bf16(p0[4], p0[5]), cvt_pk_bf16(p0[6], p0[7])};
        pw1 = (u32x4){cvt_pk_bf16(p0[8], p0[9]), cvt_pk_bf16(p0[10], p0[11]), cvt_pk_bf16(p0[12], p0[13]), cvt_pk_bf16(p0[14], p0[15])};
        pw2 = (u32x4){cvt_pk_bf16(p1[0], p1[1]), cvt_pk_bf16(p1[2], p1[3]), cvt_pk_bf16(p1[4], p1[5]), cvt_pk_bf16(p1[6], p1[7])};
        pw3 = (u32x4){cvt_pk_bf16(p1[8], p1[9]), cvt_pk_bf16(p1[10], p1[11]), cvt_pk_bf16(p1[12], p1[13]), cvt_pk_bf16(p1[14], p1[15])};
        if (resc) {
#pragma unroll
            for (int d_ = 0; d_ < 2; ++d_)
#pragma unroll
                for (int r = 0; r < 16; ++r) o[d_][r] *= wsf[crow(r, hi)];
        }
        { const LAS unsigned char* vp = vp0 + s * VSLOT;
#pragma unroll
            for (int d0 = 0; d0 < 2; ++d0) {
                s16x4 lo[4], hh[4];
#pragma unroll
                for (int ks = 0; ks < 4; ++ks) { lo[ks] = vtr(vp + d0 * 4096 + ks * 1024); hh[ks] = vtr(vp + d0 * 4096 + ks * 1024 + 512); }
                __builtin_amdgcn_sched_barrier(0);
#define PKV(k) (bf16x8){lo[k][0], lo[k][1], lo[k][2], lo[k][3], hh[k][0], hh[k][1], hh[k][2], hh[k][3]}
                o[d0] = __builtin_amdgcn_mfma_f32_32x32x16_bf16(__builtin_bit_cast(bf16x8, pw0), PKV(0), o[d0], 0, 0, 0);
                o[d0] = __builtin_amdgcn_mfma_f32_32x32x16_bf16(__builtin_bit_cast(bf16x8, pw1), PKV(1), o[d0], 0, 0, 0);
                o[d0] = __builtin_amdgcn_mfma_f32_32x32x16_bf16(__builtin_bit_cast(bf16x8, pw2), PKV(2), o[d0], 0, 0, 0);
                o[d0] = __builtin_amdgcn_mfma_f32_32x32x16_bf16(__builtin_bit_cast(bf16x8, pw3), PKV(3), o[d0], 0, 0, 0);
#undef PKV
            } }
    }
    l_reg += __shfl_xor(l_reg, 32);
    if (hi == 0) wsf[32 + r32] = l_reg;
    float rli[16];
#pragma unroll
    for (int r = 0; r < 16; ++r) rli[r] = __builtin_amdgcn_rcpf(wsf[32 + crow(r, hi)]);
    unsigned char* Ow = (unsigned char*)Oh + (rowbase + q0 + wid * 32) * ldo;
    { LAS unsigned char* stg = shm + LDS_OST + wid * 2048;
#pragma unroll
        for (int r = 0; r < 16; ++r) { const int orow = crow(r, hi);
#pragma unroll
            for (int d0 = 0; d0 < 2; ++d0) stg[orow * 64 + d0 * 32 + r32] = (unsigned char)(pack4_fp8(o[d0][r] * rli[r], 0.f, 0.f, 0.f) & 0xffu); }
#pragma unroll
        for (int i = 0; i < 2; ++i) { const int row = i * 16 + (lane >> 2), ch = lane & 3; const u32x4 v = *(const LAS u32x4*)(stg + row * 64 + ch * 16); *(u32x4*)(Ow + (long)row * ldo + ch * 16) = v; } }
    asm volatile("s_waitcnt lgkmcnt(0)\n\ts_barrier" ::: "memory");
#undef ATT_DMA
#undef ATT_TILE
}
#undef MX3
}

#define XB_TMO      128
#define XB_XCNT(j)  (256  + 64 * (j))
#define XB_XSUB(j)  (1280 + 64 * (j))
#define XB_XGEN(j)  (2304 + 64 * (j))
#define XB_TOP      3328
#define XB_TOPGEN   3392
#define XCD_BAR_WORDS 3456
#define XB_SPIN_CAP (1u << 22)
__device__ __forceinline__ unsigned xb_ld(unsigned* p)              { return __hip_atomic_load(p, __ATOMIC_RELAXED, __HIP_MEMORY_SCOPE_AGENT); }
__device__ __forceinline__ unsigned xb_add(unsigned* p, unsigned v) { return __hip_atomic_fetch_add(p, v, __ATOMIC_RELAXED, __HIP_MEMORY_SCOPE_AGENT); }
__device__ __forceinline__ unsigned xb_xcc_id() { return (unsigned)__builtin_amdgcn_s_getreg((3 << 11) | 20) & 0xFu; }
#define XB_SPIN(cond, bar) do { unsigned _sp = 0; while (cond) { __builtin_amdgcn_s_sleep(1); \
    if ((++_sp & 255u) == 0u) { if (xb_ld(&(bar)[XB_TMO])) break; if (_sp > XB_SPIN_CAP) { atomicAdd(&(bar)[XB_TMO], 1u); break; } } } } while (0)
struct XcdBarrier { unsigned* bar; unsigned x; volatile LAS unsigned* st; int wave; };
__device__ __forceinline__ XcdBarrier xcd_barrier_post(unsigned* bar, volatile LAS unsigned* st, int wave) {
    XcdBarrier b; b.bar = bar; b.x = xb_xcc_id(); b.st = st; b.wave = wave;
    if (wave == 0 && lane_id() == 0) (void)xb_add(&bar[XB_XCNT(b.x)], 1u);
    return b;
}
__device__ __forceinline__ void xcd_barrier_complete(unsigned* bar, unsigned x, unsigned& nloc, unsigned& nx) {
    const unsigned G = gridDim.x * gridDim.y * gridDim.z;
    unsigned sum, cnt, mine, sp = 0u;
    for (;;) {
        sum = 0u; cnt = 0u; mine = 0u;
#pragma unroll
        for (unsigned j = 0; j < 16; ++j) { const unsigned c = xb_ld(&bar[XB_XCNT(j)]); sum += c; cnt += (c > 0u) ? 1u : 0u; mine = (j == x) ? c : mine; }
        if (sum == G) break;
        __builtin_amdgcn_s_sleep(1);
        if ((++sp & 255u) == 0u) { if (xb_ld(&bar[XB_TMO])) break; if (sp > XB_SPIN_CAP) { atomicAdd(&bar[XB_TMO], 1u); break; } }
    }
    nloc = mine > 0u ? mine : 1u; nx = cnt > 0u ? cnt : 1u;
}
__device__ __forceinline__ void xcd_barrier(const XcdBarrier& b) {
    asm volatile("s_waitcnt vmcnt(0)" ::: "memory");
    __syncthreads();
    if (b.wave == 0 && lane_id() == 0) {
        unsigned* bar = b.bar;
        __builtin_amdgcn_s_waitcnt(0);
        unsigned nloc = b.st[0], nx = b.st[1];
        if (nloc == 0u) { xcd_barrier_complete(bar, b.x, nloc, nx); b.st[0] = nloc; b.st[1] = nx; }
        const unsigned old = xb_add(&bar[XB_XSUB(b.x)], 1u);
        const unsigned gen = old / nloc;
        if (old + 1u == (gen + 1u) * nloc) {
            __builtin_amdgcn_fence(__ATOMIC_RELEASE, "agent");
            asm volatile("s_waitcnt vmcnt(0)" ::: "memory");
            const unsigned og = xb_add(&bar[XB_TOP], 1u);
            const unsigned tg = og / nx;
            if (og + 1u == (tg + 1u) * nx) xb_add(&bar[XB_TOPGEN], 1u);
            else XB_SPIN(xb_ld(&bar[XB_TOPGEN]) == tg, bar);
            __builtin_amdgcn_fence(__ATOMIC_ACQUIRE, "agent");
            xb_add(&bar[XB_XGEN(b.x)], 1u);
            asm volatile("s_waitcnt vmcnt(0)" ::: "memory");
        } else {
            XB_SPIN(xb_ld(&bar[XB_XGEN(b.x)]) == gen, bar);
            __builtin_amdgcn_fence(__ATOMIC_ACQUIRE, "agent");
            asm volatile("s_waitcnt vmcnt(0)" ::: "memory");
        }
    }
    __syncthreads();
}

struct Params { const float* in[25]; float* out; unsigned char* ws; int ph_lo, ph_hi; };
enum { I_X = 0, I_P, I_GMIX, I_WIN, I_MQN, I_MKN, I_QLATN, I_WUQ, I_KVLATN, I_WUKV, I_MLAQN, I_MLAKN, I_WA, I_WB, I_WO, I_GFFN, I_WR, I_BR, I_WGU, I_BGU, I_WD, I_BD, I_GPLE, I_WPG, I_WPP };
constexpr int NPHASE = 16;

struct Frame {
    LAS unsigned char* lds; int vcu, G, wave;
    const Params* P; unsigned char* ws;
};
struct Ids { int tid, lane, wave; };
#define PHASE_IDS() Ids I_; { int l_ = lane_id(); asm volatile("" : "+v"(l_)); I_.lane = l_; I_.wave = F.wave; I_.tid = F.wave * 64 + l_; }

#ifdef TPROBE_A
#define STAMP(k) do { if (blockIdx.x == 0 && F.wave == 0 && lane_id() == 0) ((volatile unsigned long long*)(ws + WS_ERR))[k] = __builtin_amdgcn_s_memrealtime(); } while (0)
#else
#define STAMP(k) do {} while (0)
#endif
__device__ __forceinline__ int rowmap(int mode, int c) {
    if (mode == 1) {
        if (c < 1024) { const int base = c & 512, s_ = c & 511, h = s_ >> 6, d = s_ & 63; return base + 256 * (h >> 2) + 128 * (d >> 5) + 32 * (h & 3) + (d & 31); }
        return c < 1952 ? c : c + 96; }
    if (mode == 2) return c < 1024 ? 256 * (c >> 7) + (c & 127) : 256 * ((c - 1024) >> 7) + 128 + ((c - 1024) & 127);
    if (mode == 3) {
        const int h = c / 96, d = c % 96; int t;
        if (d < 64) t = d; else if (d < 80) { const int i = d - 64; t = 64 + 8 * (i >> 2) + (i & 3); } else { const int i = d - 80; t = 64 + 8 * (i >> 2) + 4 + (i & 3); }
        return 128 * h + t; }
    return c;
}
__device__ __forceinline__ void tr_item64(const float* W, int ldw, int N, int k0, int n0, bf16_t* dst, int ldd, int mode, LAS float* scr, int lane) {
    const int r = lane >> 4, c4 = lane & 15; const bool inb = (n0 + 4 * c4) < N;
    f32x4 v[16];
#pragma unroll
    for (int i = 0; i < 16; ++i) v[i] = inb ? __builtin_nontemporal_load((const f32x4*)(W + (size_t)(k0 + 4 * i + r) * ldw + n0 + 4 * c4)) : (f32x4){0.f, 0.f, 0.f, 0.f};
#pragma unroll
    for (int i = 0; i < 16; ++i) { LAS float* p = scr + (4 * i + r) * 65 + 4 * c4; p[0] = v[i].x; p[1] = v[i].y; p[2] = v[i].z; p[3] = v[i].w; }
    asm volatile("s_waitcnt lgkmcnt(0)" ::: "memory");
    const int c = lane & 7;
#pragma unroll
    for (int j = 0; j < 8; ++j) { const int n = (lane >> 3) + 8 * j; const LAS float* sp = scr + (8 * c) * 65 + n;
        u32x4 o; o.x = cvt_pk_bf16(sp[0 * 65], sp[1 * 65]); o.y = cvt_pk_bf16(sp[2 * 65], sp[3 * 65]); o.z = cvt_pk_bf16(sp[4 * 65], sp[5 * 65]); o.w = cvt_pk_bf16(sp[6 * 65], sp[7 * 65]);
        if (n0 + n < N) *(u32x4*)(dst + (size_t)rowmap(mode, n0 + n) * ldd + k0 + 8 * c) = o; }
    asm volatile("s_waitcnt lgkmcnt(0)" ::: "memory");
}

__device__ __forceinline__ void tr_item_f8(const float* W, int ldw, int k0, int n0, unsigned char* dst, int ldd, int mode, LAS float* scr, int lane) {
    const int r = lane >> 3, c4 = lane & 7;
    f32x4 v[16];
#pragma unroll
    for (int i = 0; i < 16; ++i) v[i] = __builtin_nontemporal_load((const f32x4*)(W + (size_t)(k0 + 8 * i + r) * ldw + n0 + 4 * c4));
#pragma unroll
    for (int i = 0; i < 16; ++i) { LAS float* p = scr + (8 * i + r) * 33 + 4 * c4; p[0] = v[i].x * 64.f; p[1] = v[i].y * 64.f; p[2] = v[i].z * 64.f; p[3] = v[i].w * 64.f; }
    asm volatile("s_waitcnt lgkmcnt(0)" ::: "memory");
    const int c = lane & 7;
#pragma unroll
    for (int j = 0; j < 4; ++j) { const int n = (lane >> 3) + 8 * j; const LAS float* sp = scr + (16 * c) * 33 + n;
        u32x4 o; o.x = pack4_fp8(sp[0 * 33], sp[1 * 33], sp[2 * 33], sp[3 * 33]); o.y = pack4_fp8(sp[4 * 33], sp[5 * 33], sp[6 * 33], sp[7 * 33]);
        o.z = pack4_fp8(sp[8 * 33], sp[9 * 33], sp[10 * 33], sp[11 * 33]); o.w = pack4_fp8(sp[12 * 33], sp[13 * 33], sp[14 * 33], sp[15 * 33]);
        __builtin_nontemporal_store(o, (u32x4*)(dst + (size_t)rowmap(mode, n0 + n) * ldd + k0 + 16 * c)); }
    asm volatile("s_waitcnt lgkmcnt(0)" ::: "memory");
}

__device__ __forceinline__ void phase0(Frame& F) {
    PHASE_IDS();
    const Params& P = *F.P; unsigned char* ws = F.ws;
    LAS float* scr = (LAS float*)(F.lds + I_.wave * 16896);
    const int gw = F.vcu * NWAVES + I_.wave, NGW = F.G * NWAVES;
    constexpr int I_GU = 32 * 8 * 64, I_DN = 32 * 8 * 32, I_IN = 16 * 31, I_ING = 8 * 64, I_UQ = 4 * 12, I_UKV = 2 * 16, I_A = 8 * 16, I_O = 16 * 16, I_PP = 4 * 16;
    constexpr int I_PG = 8 * 32;
    constexpr int NITEMS = I_GU + I_DN + I_IN + I_ING + I_UQ + I_UKV + 2 * I_A + I_O + I_PG + I_PP;
    for (int it = gw; it < NITEMS; it += NGW) {
        int r = it;
        if (r < I_GU) { const int e = r >> 9, q = r & 511, kb = q >> 6, g = q & 63;
            tr_item_f8(P.in[I_WGU] + (size_t)e * 1024 * 2048, 2048, 128 * kb, 32 * g, ws + WS_W1 + (size_t)e * 2048 * 1024, 1024, 2, scr, I_.lane); continue; } r -= I_GU;
        if (r < I_DN) { const int e = r >> 8, q = r & 255, kb = q >> 5, g = q & 31;
            tr_item_f8(P.in[I_WD] + (size_t)e * 1024 * 1024, 1024, 128 * kb, 32 * g, ws + WS_W2 + (size_t)e * 1024 * 1024, 1024, 0, scr, I_.lane); continue; } r -= I_DN;
        if (r < I_IN) { const int kb = r / 31, g = r % 31; tr_item64(P.in[I_WIN], DIN, 1952, 64 * kb, 64 * g, (bf16_t*)(ws + WS_WIN), 1024, 1, scr, I_.lane); continue; } r -= I_IN;
        if (r < I_ING) { const int kb = r >> 6, g = r & 63; tr_item_f8(P.in[I_WIN] + 1952, DIN, 128 * kb, 32 * g, ws + WS_WINF8, 1024, 0, scr, I_.lane); continue; } r -= I_ING;
        if (r < I_UQ) { const int kb = r / 12, g = r % 12; tr_item64(P.in[I_WUQ], 768, 768, 64 * kb, 64 * g, (bf16_t*)(ws + WS_WUQ), 256, 3, scr, I_.lane); continue; } r -= I_UQ;
        if (r < I_UKV) { const int kb = r / 16, g = r % 16; tr_item64(P.in[I_WUKV], 1024, 1024, 64 * kb, 64 * g, (bf16_t*)(ws + WS_WUKV), 128, 0, scr, I_.lane); continue; } r -= I_UKV;
        if (r < I_A) { const int kb = r >> 5, g = r & 31; tr_item_f8(P.in[I_WA], 1024, 128 * kb, 32 * g, ws + WS_WA, 512, 0, scr, I_.lane); continue; } r -= I_A;
        if (r < I_A) { const int kb = r >> 5, g = r & 31; tr_item_f8(P.in[I_WB], 1024, 128 * kb, 32 * g, ws + WS_WB, 512, 0, scr, I_.lane); continue; } r -= I_A;
        if (r < I_PG) { const int kb = r >> 5, g = r & 31; tr_item_f8(P.in[I_WO], 1024, 128 * kb, 32 * g, ws + WS_WO, 1024, 0, scr, I_.lane); continue; } r -= I_PG;
        if (r < I_PG) { const int kb = r >> 5, g = r & 31; tr_item_f8(P.in[I_WPG], 1024, 128 * kb, 32 * g, ws + WS_WPG, 1024, 0, scr, I_.lane); continue; } r -= I_PG;
        { const int kb = r / 16, g = r % 16; tr_item64(P.in[I_WPP], 1024, 1024, 64 * kb, 64 * g, (bf16_t*)(ws + WS_WPP), 256, 0, scr, I_.lane); }
    }
    STAMP(20);
    { const f32x4* gp = (const f32x4*)P.in[I_GMIX] + I_.lane; f32x4 gv[4];
#pragma unroll
        for (int j = 0; j < 4; ++j) gv[j] = gp[64 * j];
        for (int m0 = gw * 4; m0 < NTOK; m0 += NGW * 4) { f32x4 v[4][4];
#pragma unroll
            for (int q = 0; q < 4; ++q) { const f32x4* xr = (const f32x4*)(P.in[I_X] + (size_t)(m0 + q) * DM) + I_.lane;
#pragma unroll
                for (int j = 0; j < 4; ++j) v[q][j] = xr[64 * j]; }
#pragma unroll
            for (int q = 0; q < 4; ++q) { float s = 0.f;
#pragma unroll
                for (int j = 0; j < 4; ++j) s += (v[q][j].x * v[q][j].x + v[q][j].y * v[q][j].y) + (v[q][j].z * v[q][j].z + v[q][j].w * v[q][j].w);
                const float rstd = 1.0f / sqrtf(wave_sum(s) * (1.f / DM) + EPS);
                u32x2* o8 = (u32x2*)((bf16_t*)(ws + WS_HN) + (size_t)(m0 + q) * DM) + I_.lane; unsigned* o4 = (unsigned*)(ws + WS_HNF8 + (size_t)(m0 + q) * DM) + I_.lane;
#pragma unroll
                for (int j = 0; j < 4; ++j) { const f32x4 y = v[q][j] * rstd * gv[j]; o8[64 * j] = (u32x2){cvt_pk_bf16(y.x, y.y), cvt_pk_bf16(y.z, y.w)}; o4[64 * j] = pack4_fp8(y.x, y.y, y.z, y.w); } } } }
    STAMP(21);
    { float* km = (float*)(ws + WS_KMEAN); for (int i = F.vcu * NTHREADS + I_.tid; i < 8 * 8 * 8 * 64; i += F.G * NTHREADS) km[i] = 0.f; }
    { const size_t n4 = (size_t)NTOK * 256 / 4; const f32x4* pp = (const f32x4*)P.in[I_P]; u32x2* po = (u32x2*)(ws + WS_PB); const size_t T = (size_t)F.G * NTHREADS;
        for (size_t i = (size_t)F.vcu * NTHREADS + I_.tid; i < n4; i += 4 * T) { f32x4 v[4];
#pragma unroll
            for (int q = 0; q < 4; ++q) v[q] = __builtin_nontemporal_load(pp + i + q * T);
#pragma unroll
            for (int q = 0; q < 4; ++q) po[i + q * T] = (u32x2){cvt_pk_bf16(v[q].x, v[q].y), cvt_pk_bf16(v[q].z, v[q].w)}; } }
    STAMP(22);
    { float* tab = (float*)(ws + WS_ROPE);
        for (int i = F.vcu * NTHREADS + I_.tid; i < 2048 * 48; i += F.G * NTHREADS) {
            int pos, j, half; float* cdst; float* sdst;
            if (i < 2048 * 32) { pos = i / 32; j = i % 32; half = 32; cdst = tab + i; sdst = tab + 65536 + i; }
            else { const int q = i - 2048 * 32; pos = q / 16; j = q % 16; half = 16; cdst = tab + 131072 + q; sdst = tab + 131072 + 32768 + q; }
            const float inv = powf(10000.0f, -((float)j / (float)half)); const float ang = (float)pos * inv;
            *cdst = cosf(ang); *sdst = sinf(ang); } }
}

__device__ __forceinline__ void phase2(Frame& F) {
    PHASE_IDS();
    const Params& P = *F.P; unsigned char* ws = F.ws;
    const bf16_t* PROJ = (const bf16_t*)(ws + WS_PROJ);
    const float* cosA = (const float*)(ws + WS_ROPE); const float* sinA = cosA + 65536;
    LAS float* kst = (LAS float*)F.lds;
    LAS float* part = kst + 256 * 68;
    for (int it = F.vcu; it < 512; it += F.G) {
        const int b = it >> 6, blk = (it >> 3) & 7, h = it & 7;
        const int sel = I_.lane >> 5, r = I_.wave * 32 + (I_.lane & 31); const int pos = blk * 256 + r; const size_t row = (size_t)b * SEQ + pos;
        const u32x4* src = (const u32x4*)(PROJ + row * DINP + (sel ? PC_KA : PC_QA) + h * 64);
        u32x4 raw[8];
#pragma unroll
        for (int c = 0; c < 8; ++c) raw[c] = src[c];
        float ss = 0.f;
#pragma unroll
        for (int c = 0; c < 8; ++c) { f32x4 a0, a1; pg8::unpack8(raw[c], a0, a1); ss += (a0[0] * a0[0] + a0[1] * a0[1]) + (a0[2] * a0[2] + a0[3] * a0[3]) + (a1[0] * a1[0] + a1[1] * a1[1]) + (a1[2] * a1[2] + a1[3] * a1[3]); }
        const float rstd = 1.0f / sqrtf(ss * (1.f / 64.f) + EPS);
        const float* gn = sel ? P.in[I_MKN] : P.in[I_MQN];
        const float sc = sel ? 1.0f : C2A;
        bf16_t* dst = (bf16_t*)(ws + (sel ? WS_KA2 : WS_QA2)) + row * 512 + h * 64;
#pragma unroll
        for (int c = 0; c < 4; ++c) { f32x4 x1a, x1b, x2a, x2b; pg8::unpack8(raw[c], x1a, x1b); pg8::unpack8(raw[c + 4], x2a, x2b);
            const f32x4 g1a = *(const f32x4*)(gn + 8 * c), g1b = *(const f32x4*)(gn + 8 * c + 4), g2a = *(const f32x4*)(gn + 32 + 8 * c), g2b = *(const f32x4*)(gn + 36 + 8 * c);
            x1a = x1a * g1a * rstd; x1b = x1b * g1b * rstd; x2a = x2a * g2a * rstd; x2b = x2b * g2b * rstd;
            const f32x4 ca = *(const f32x4*)(cosA + pos * 32 + 8 * c), cb = *(const f32x4*)(cosA + pos * 32 + 8 * c + 4), sa = *(const f32x4*)(sinA + pos * 32 + 8 * c), sb = *(const f32x4*)(sinA + pos * 32 + 8 * c + 4);
            const f32x4 y1a = x1a * ca - x2a * sa, y1b = x1b * cb - x2b * sb, y2a = x2a * ca + x1a * sa, y2b = x2b * cb + x1b * sb;
            *(u32x4*)(dst + 8 * c) = pg8::pack8(y1a * sc, y1b * sc); *(u32x4*)(dst + 32 + 8 * c) = pg8::pack8(y2a * sc, y2b * sc);
            if (sel) { LAS f32x4* kr = (LAS f32x4*)(kst + r * 68); kr[2 * c] = y1a; kr[2 * c + 1] = y1b; kr[8 + 2 * c] = y2a; kr[8 + 2 * c + 1] = y2b; } }
        __syncthreads();
        { const int d = I_.tid & 63, pt = I_.tid >> 6; float s = 0.f;
#pragma unroll 8
            for (int rr = 0; rr < 32; ++rr) s += kst[(pt * 32 + rr) * 68 + d];
            part[pt * 64 + d] = s; }
        __syncthreads();
        if (I_.tid < 64) { float s = 0.f;
#pragma unroll
            for (int pt = 0; pt < 8; ++pt) s += part[pt * 64 + I_.tid];
            ((float*)(ws + WS_KMEAN))[(((size_t)b * 8 + h) * 8 + blk) * 64 + I_.tid] = s * (1.f / 256.f); }
        __syncthreads();
    }
    const int gw = F.vcu * NWAVES + I_.wave, NGW = F.G * NWAVES;
    const f32x4 gq = ((const f32x4*)P.in[I_QLATN])[I_.lane]; const f32x2 gk = ((const f32x2*)P.in[I_KVLATN])[I_.lane];
    for (int m0 = gw * 8; m0 < NTOK; m0 += NGW * 8) {
        u32x2 wq[8]; unsigned wk[8];
#pragma unroll
        for (int q = 0; q < 8; ++q) { wq[q] = *((const u32x2*)(PROJ + (size_t)(m0 + q) * DINP + PC_CQ) + I_.lane); wk[q] = *((const unsigned*)(PROJ + (size_t)(m0 + q) * DINP + PC_CKV) + I_.lane); }
#pragma unroll
        for (int r = 0; r < 8; ++r) { const int m = m0 + r;
            const f32x4 q = {bflo(wq[r].x), bfhi(wq[r].x), bflo(wq[r].y), bfhi(wq[r].y)}; const f32x2 k = {bflo(wk[r]), bfhi(wk[r])};
            const float sq = wave_sum((q.x * q.x + q.y * q.y) + (q.z * q.z + q.w * q.w)), sk = wave_sum(k.x * k.x + k.y * k.y);
            const float rq = 1.0f / sqrtf(sq * (1.f / 256.f) + EPS), rk = 1.0f / sqrtf(sk * (1.f / 128.f) + EPS);
            const f32x4 yq = q * rq * gq; const f32x2 yk = k * rk * gk;
            *((u32x2*)((bf16_t*)(ws + WS_CQN) + (size_t)m * 256) + I_.lane) = (u32x2){cvt_pk_bf16(yq.x, yq.y), cvt_pk_bf16(yq.z, yq.w)};
            *((unsigned*)((bf16_t*)(ws + WS_CKVN) + (size_t)m * 128) + I_.lane) = cvt_pk_bf16(yk.x, yk.y); }
    }
}

__device__ __forceinline__ void phase4(Frame& F) {
    PHASE_IDS();
    const Params& P = *F.P; unsigned char* ws = F.ws;
    const bf16_t* PROJ = (const bf16_t*)(ws + WS_PROJ);
    const float* cosB = (const float*)(ws + WS_ROPE) + 131072; const float* sinB = cosB + 32768;
    const int gw = F.vcu * NWAVES + I_.wave, NGW = F.G * NWAVES;
    for (int it = gw; it < (NTOK / 64) * 16; it += NGW) {
        const int h = it & 7, sel = (it >> 3) & 1, rg = it >> 4; const size_t row = (size_t)rg * 64 + I_.lane; const int pos = (int)(row & (SEQ - 1));
        u32x4 raw[12];
        bf16_t* qrow = (bf16_t*)(ws + WS_QB) + row * 768 + h * 96;
        if (sel == 0) {
#pragma unroll
            for (int c = 0; c < 12; ++c) raw[c] = *(const u32x4*)(qrow + 8 * c);
        } else {
            const bf16_t* kn = (const bf16_t*)(ws + WS_KV) + row * 1024 + h * 128; const bf16_t* kp = PROJ + row * DINP + PC_KPE;
#pragma unroll
            for (int c = 0; c < 8; ++c) raw[c] = *(const u32x4*)(kn + 8 * c);
#pragma unroll
            for (int c = 0; c < 4; ++c) raw[8 + c] = *(const u32x4*)(kp + 8 * c);
        }
        float ss = 0.f;
#pragma unroll
        for (int c = 0; c < 12; ++c) { f32x4 a0, a1; pg8::unpack8(raw[c], a0, a1); ss += (a0[0] * a0[0] + a0[1] * a0[1]) + (a0[2] * a0[2] + a0[3] * a0[3]) + (a1[0] * a1[0] + a1[1] * a1[1]) + (a1[2] * a1[2] + a1[3] * a1[3]); }
        const float rstd = 1.0f / sqrtf(ss * (1.f / 96.f) + EPS);
        const float* gn = sel ? P.in[I_MLAKN] : P.in[I_MLAQN];
        const float sc = sel ? 1.0f : C2B; const float rs = rstd * sc;
        bf16_t* dst = sel ? (bf16_t*)(ws + WS_KB2) + row * 768 + h * 96 : qrow;
#pragma unroll
        for (int c = 0; c < 8; ++c) { f32x4 a0, a1; pg8::unpack8(raw[c], a0, a1); const f32x4 g0 = *(const f32x4*)(gn + 8 * c), g1 = *(const f32x4*)(gn + 8 * c + 4);
            *(u32x4*)(dst + 8 * c) = pg8::pack8(a0 * g0 * rs, a1 * g1 * rs); }
#pragma unroll
        for (int c = 0; c < 2; ++c) { f32x4 x1a, x1b, x2a, x2b; pg8::unpack8(raw[8 + c], x1a, x1b); pg8::unpack8(raw[10 + c], x2a, x2b);
            const f32x4 g1a = *(const f32x4*)(gn + 64 + 8 * c), g1b = *(const f32x4*)(gn + 68 + 8 * c), g2a = *(const f32x4*)(gn + 80 + 8 * c), g2b = *(const f32x4*)(gn + 84 + 8 * c);
            x1a = x1a * g1a * rs; x1b = x1b * g1b * rs; x2a = x2a * g2a * rs; x2b = x2b * g2b * rs;
            const f32x4 ca = *(const f32x4*)(cosB + pos * 16 + 8 * c), cb = *(const f32x4*)(cosB + pos * 16 + 8 * c + 4), sa = *(const f32x4*)(sinB + pos * 16 + 8 * c), sb = *(const f32x4*)(sinB + pos * 16 + 8 * c + 4);
            *(u32x4*)(dst + 64 + 8 * c) = pg8::pack8(x1a * ca - x2a * sa, x1b * cb - x2b * sb);
            *(u32x4*)(dst + 80 + 8 * c) = pg8::pack8(x2a * ca + x1a * sa, x2b * cb + x1b * sb); }
    }
}

__device__ __forceinline__ void phase5(Frame& F) {
    unsigned char* ws = F.ws;
    for (int it = F.vcu; it < 256; it += F.G) {
        const int bh = it >> 2, sidx = it & 3, b = bh >> 3, h = bh & 7;
#pragma unroll 1
        for (int k = 0; k < 2; ++k) { const int qb = k ? 7 - sidx : sidx;
            att::attn_unit<64, true>(b, qb, (const bf16_t*)(ws + WS_QA2) + h * 64, 512, (const bf16_t*)(ws + WS_KA2) + h * 64, 512, (const bf16_t*)(ws + WS_PROJ) + PC_VA + h * 64, DINP,
                                     ws + WS_Y + h * 64, 1024, (const float*)(ws + WS_KMEAN) + (size_t)bh * 512, F.lds, F.wave); }
#pragma unroll 1
        for (int k = 0; k < 2; ++k) { const int qb = k ? 7 - sidx : sidx;
            att::attn_unit<96, false>(b, qb, (const bf16_t*)(ws + WS_QB) + h * 96, 768, (const bf16_t*)(ws + WS_KB2) + h * 96, 768, (const bf16_t*)(ws + WS_KV) + h * 128 + 64, 1024,
                                      ws + WS_Y + 512 + h * 64, 1024, nullptr, F.lds, F.wave); }
    }
}

__device__ __forceinline__ void phase8(Frame& F) {
    PHASE_IDS();
    const Params& P = *F.P; unsigned char* ws = F.ws;
    constexpr int HCS = 132, WCS = 48;
    LAS float* HC = (LAS float*)F.lds;
    LAS float* WC = HC + 2 * 64 * HCS;
    LAS float* RSTD = WC + 2 * 128 * WCS;
    LAS float* LOGIT = RSTD + 64;
    LAS int* pe = (LAS int*)(LOGIT + 64 * 33);
    int* PAIR_E = (int*)(ws + WS_PAIR); int* PAIR_RANK = PAIR_E + 65536; float* PAIR_W = (float*)(PAIR_E + 131072);
    const float* gffn = P.in[I_GFFN]; const float* wr_ = P.in[I_WR]; const float* br_ = P.in[I_BR];
    const int r0 = F.vcu * 64;
    if (I_.tid < 64) { const f32x4* sp = (const f32x4*)((const float*)(ws + WS_SSP) + (size_t)(r0 + I_.tid) * 16); const f32x4 a = sp[0], b = sp[1], c = sp[2], d = sp[3];
        const float ss = (((a[0] + a[1]) + (a[2] + a[3])) + ((b[0] + b[1]) + (b[2] + b[3]))) + (((c[0] + c[1]) + (c[2] + c[3])) + ((d[0] + d[1]) + (d[2] + d[3])));
        RSTD[I_.tid] = 1.0f / sqrtf(ss * (1.f / DM) + EPS); }
    __syncthreads();
    const int eg = I_.wave & 1, rgp = I_.wave >> 1, l15 = I_.lane & 15, l4 = I_.lane >> 4;
    const int srow = I_.tid >> 5, sc4 = I_.tid & 31;
    const int wrow = I_.tid >> 3, wc4 = I_.tid & 7;
    f32x4 stg[4], wst[2];
#define P8_LOAD(kc) do { _Pragma("unroll") for (int i = 0; i < 4; ++i) { const u32x2 w_ = *(const u32x2*)((const bf16_t*)(ws + WS_X1B) + (size_t)(r0 + srow + 16 * i) * DM + (kc) * 128 + 4 * sc4); stg[i] = (f32x4){bflo(w_.x), bfhi(w_.x), bflo(w_.y), bfhi(w_.y)}; } \
        _Pragma("unroll") for (int i = 0; i < 2; ++i) wst[i] = *(const f32x4*)(wr_ + (size_t)((kc) * 128 + wrow + 64 * i) * 32 + 4 * wc4); } while (0)
#define P8_STORE(kc, buf) do { const f32x4 g4 = *(const f32x4*)(gffn + (kc) * 128 + 4 * sc4); _Pragma("unroll") for (int i = 0; i < 4; ++i) { const float rs = RSTD[srow + 16 * i]; const f32x4 y = stg[i] * rs * g4; \
        *(LAS f32x4*)(HC + ((buf) * 64 + srow + 16 * i) * HCS + 4 * sc4) = y; *(unsigned*)(ws + WS_HNF8 + (size_t)(r0 + srow + 16 * i) * DM + (kc) * 128 + 4 * sc4) = pack4_fp8(y.x, y.y, y.z, y.w); } \
        _Pragma("unroll") for (int i = 0; i < 2; ++i) *(LAS f32x4*)(WC + ((buf) * 128 + wrow + 64 * i) * WCS + 4 * wc4) = wst[i]; } while (0)
    P8_LOAD(0); P8_STORE(0, 0);
    __syncthreads();
    f32x4 acc = {0.f, 0.f, 0.f, 0.f};
#pragma unroll 1
    for (int kc = 0; kc < 8; ++kc) { const int buf = kc & 1;
        if (kc + 1 < 8) P8_LOAD(kc + 1);
        const LAS float* wp = WC + (buf * 128 + l4) * WCS + eg * 16 + l15;
        const LAS float* hp = HC + (buf * 64 + rgp * 16 + l15) * HCS + l4;
#pragma unroll
        for (int kk = 0; kk < 32; ++kk) acc = __builtin_amdgcn_mfma_f32_16x16x4f32(wp[4 * kk * WCS], hp[4 * kk], acc, 0, 0, 0);
        if (kc + 1 < 8) P8_STORE(kc + 1, buf ^ 1);
        __syncthreads(); }
#undef P8_LOAD
#undef P8_STORE
#pragma unroll
    for (int i = 0; i < 4; ++i) { const int e = eg * 16 + 4 * l4 + i; LOGIT[(rgp * 16 + l15) * 33 + e] = acc[i] + br_[e]; }
    __syncthreads();
    if (I_.tid < 64) { const int rr = I_.tid, m = r0 + rr;
        float lg[32];
#pragma unroll
        for (int e = 0; e < 32; ++e) lg[e] = LOGIT[rr * 33 + e];
        int te[4]; float tv[4]; unsigned used = 0u;
#pragma unroll
        for (int k = 0; k < 4; ++k) { float best = -INFINITY; int bi = 0;
#pragma unroll
            for (int e = 0; e < 32; ++e) { const bool ok = !((used >> e) & 1u) && (lg[e] > best); best = ok ? lg[e] : best; bi = ok ? e : bi; }
            used |= 1u << bi; te[k] = bi; tv[k] = best; }
        const float e0 = 1.0f, e1 = __expf(tv[1] - tv[0]), e2 = __expf(tv[2] - tv[0]), e3 = __expf(tv[3] - tv[0]); const float inv = 1.0f / (e0 + e1 + e2 + e3);
        *(i32x4*)(PAIR_E + m * 4) = (i32x4){te[0], te[1], te[2], te[3]};
        *(f32x4*)(PAIR_W + m * 4) = (f32x4){e0 * inv, e1 * inv, e2 * inv, e3 * inv};
        *(LAS i32x4*)(pe + rr * 4) = (i32x4){te[0], te[1], te[2], te[3]}; }
    __syncthreads();
    if (I_.tid < 256) { const int e = pe[I_.tid]; int rank = 0;
#pragma unroll 16
        for (int j4 = 0; j4 < 64; ++j4) { const i32x4 v = *(const LAS i32x4*)(pe + 4 * j4); const int j = 4 * j4;
            rank += ((j < I_.tid) && v.x == e) + ((j + 1 < I_.tid) && v.y == e) + ((j + 2 < I_.tid) && v.z == e) + ((j + 3 < I_.tid) && v.w == e); }
        PAIR_RANK[r0 * 4 + I_.tid] = rank; }
    else if (I_.tid < 288) { const int e = I_.tid - 256; int c = 0;
#pragma unroll 16
        for (int j4 = 0; j4 < 64; ++j4) { const i32x4 v = *(const LAS i32x4*)(pe + 4 * j4); c += (v.x == e) + (v.y == e) + (v.z == e) + (v.w == e); }
        ((int*)(ws + WS_HIST))[F.vcu * 32 + e] = c; }
    __syncthreads();
}

__device__ __forceinline__ int moe_layout(Frame& F) {
    PHASE_IDS();
    LAS int* ctl = (LAS int*)(F.lds + LDS_CTL);
    LAS int* part = ctl + 512;
    const int* HIST = (const int*)(F.ws + WS_HIST);
    __syncthreads();
    { const int e = I_.tid & 31, pt = I_.tid >> 5; int tot = 0, before = 0; int c[16];
#pragma unroll
        for (int i = 0; i < 16; ++i) c[i] = HIST[(pt * 16 + i) * 32 + e];
#pragma unroll
        for (int i = 0; i < 16; ++i) { tot += c[i]; before += (pt * 16 + i < F.vcu) ? c[i] : 0; }
        part[pt * 64 + e] = tot; part[pt * 64 + 32 + e] = before; }
    __syncthreads();
    if (I_.tid < 32) { int tot = 0, before = 0;
#pragma unroll
        for (int pt = 0; pt < 16; ++pt) { tot += part[pt * 64 + I_.tid]; before += part[pt * 64 + 32 + I_.tid]; }
        ctl[I_.tid] = tot; ctl[65 + I_.tid] = before; }
    __syncthreads();
    if (I_.tid == 0) { int row = 0, mt = 0;
        for (int e = 0; e < 32; ++e) { ctl[32 + e] = row; ctl[65 + e] += row; const int nt_ = (ctl[e] + 255) >> 8;
            for (int t = 0; t < nt_; ++t) ctl[128 + mt + t] = e;
            mt += nt_; row += nt_ * 256; }
        ctl[64] = row; ctl[100] = mt; }
    __syncthreads();
    return ctl[100];
}

__device__ __forceinline__ void phase9(Frame& F) {
    PHASE_IDS();
    unsigned char* ws = F.ws;
    moe_layout(F);
    LAS int* ctl = (LAS int*)(F.lds + LDS_CTL);
    const int* PAIR_E = (const int*)(ws + WS_PAIR); const int* PAIR_RANK = PAIR_E + 65536; int* ROWDEST = (int*)(ws + WS_PAIR) + 196608; int* TOK = (int*)(ws + WS_TOK);
    const int rows_per_blk = NTOK / F.G;
    if (I_.tid < rows_per_blk * 4) { const int gp = F.vcu * rows_per_blk * 4 + I_.tid;
        const int e = PAIR_E[gp], rk = PAIR_RANK[gp]; const int dest = ctl[65 + e] + rk;
        ROWDEST[gp] = dest; TOK[dest] = gp >> 2; }
    if (F.vcu < 32) { const int e = F.vcu; const int lo = ctl[32 + e] + ctl[e], hi = (e == 31) ? ctl[64] : ctl[33 + e];
        for (int r = lo + I_.tid; r < hi; r += NTHREADS) TOK[r] = 0; }
}

__device__ __forceinline__ void stage_tok(Frame& F, int nmt, int ntn) {
    PHASE_IDS();
    const int* TOK = (const int*)(F.ws + WS_TOK); LAS unsigned short* tokl = (LAS unsigned short*)(F.lds + LDS_TOKL);
    for (int i = 0; i < 10; ++i) { const int j = (i * F.G + (int)blockIdx.x) >> 3; const int mt = (j / ntn) * 8 + ((int)blockIdx.x & 7); if (mt >= nmt) break;
        if (I_.tid < 256) tokl[i * 256 + I_.tid] = (unsigned short)TOK[mt * 256 + I_.tid]; }
    __syncthreads();
}

__device__ __forceinline__ void phase12(Frame& F) {
    PHASE_IDS();
    const Params& P = *F.P; unsigned char* ws = F.ws;
    const int gw = F.vcu * NWAVES + I_.wave, NGW = F.G * NWAVES;
    const float* PAIR_W = (const float*)(ws + WS_PAIR) + 131072; const int* ROWDEST = (const int*)(ws + WS_PAIR) + 196608;
    const bf16_t* YP = (const bf16_t*)(ws + WS_XG);
    const f32x4* gp = (const f32x4*)P.in[I_GPLE] + I_.lane; f32x4 gv[4];
#pragma unroll
    for (int j = 0; j < 4; ++j) gv[j] = gp[64 * j];
    for (int m0 = gw; m0 < NTOK; m0 += 2 * NGW) {
        int mm[2]; mm[0] = m0; mm[1] = (m0 + NGW < NTOK) ? m0 + NGW : m0;
        f32x4 wv[2]; i32x4 dv[2];
#pragma unroll
        for (int q = 0; q < 2; ++q) { wv[q] = *(const f32x4*)(PAIR_W + mm[q] * 4); dv[q] = *(const i32x4*)(ROWDEST + mm[q] * 4); }
        f32x4 v[2][4]; u32x2 y[2][4][4];
#pragma unroll
        for (int q = 0; q < 2; ++q) { const u32x2* xr = (const u32x2*)((const bf16_t*)(ws + WS_X1B) + (size_t)mm[q] * DM) + I_.lane;
#pragma unroll
            for (int j = 0; j < 4; ++j) { const u32x2 w_ = xr[64 * j]; v[q][j] = (f32x4){bflo(w_.x), bfhi(w_.x), bflo(w_.y), bfhi(w_.y)}; }
#pragma unroll
            for (int k = 0; k < 4; ++k) { const u32x2* yr = (const u32x2*)(YP + (size_t)dv[q][k] * DM) + I_.lane;
#pragma unroll
                for (int j = 0; j < 4; ++j) y[q][k][j] = yr[64 * j]; } }
#pragma unroll
        for (int q = 0; q < 2; ++q) { if (q == 1 && mm[1] == mm[0]) break;
            float s = 0.f; u32x2* xw = (u32x2*)((bf16_t*)(ws + WS_X1B) + (size_t)mm[q] * DM) + I_.lane;
#pragma unroll
            for (int j = 0; j < 4; ++j) {
#pragma unroll
                for (int k = 0; k < 4; ++k) { const u32x2 yy = y[q][k][j]; v[q][j] += (f32x4){bflo(yy.x), bfhi(yy.x), bflo(yy.y), bfhi(yy.y)} * wv[q][k]; }
                xw[64 * j] = (u32x2){cvt_pk_bf16(v[q][j].x, v[q][j].y), cvt_pk_bf16(v[q][j].z, v[q][j].w)}; s += (v[q][j].x * v[q][j].x + v[q][j].y * v[q][j].y) + (v[q][j].z * v[q][j].z + v[q][j].w * v[q][j].w); }
            const float rstd = 1.0f / sqrtf(wave_sum(s) * (1.f / DM) + EPS);
            unsigned* o4 = (unsigned*)(ws + WS_HNF8 + (size_t)mm[q] * DM) + I_.lane;
#pragma unroll
            for (int j = 0; j < 4; ++j) { const f32x4 yo = v[q][j] * rstd * gv[j]; o4[64 * j] = pack4_fp8(yo.x, yo.y, yo.z, yo.w); } }
    }
}

__global__ void __launch_bounds__(NTHREADS, 2) fwd(Params prm) {
    extern __shared__ __attribute__((aligned(16))) unsigned char lds_raw[];
    Frame F;
    F.lds = (LAS unsigned char*)lds_raw;
    F.wave = __builtin_amdgcn_readfirstlane((int)threadIdx.x >> 6);
    if (threadIdx.x < 2) ((volatile LAS unsigned*)(F.lds + LDS_BARST))[threadIdx.x] = 0u;
    const XcdBarrier bar = xcd_barrier_post((unsigned*)(prm.ws + WS_BAR), (volatile LAS unsigned*)(F.lds + LDS_BARST), F.wave);
    if (prm.ph_lo < 0) cg::this_grid().sync();
    __syncthreads();
    F.G = gridDim.x; { const int bx = blockIdx.x; F.vcu = (F.G % 8 == 0) ? (bx % 8) * (F.G / 8) + bx / 8 : bx; }
    F.P = &prm; F.ws = prm.ws;
    unsigned char* ws = prm.ws;
    const int lo = prm.ph_lo, hi = prm.ph_hi;
#ifndef PH_MASK
#define PH_MASK 0xffffu
#endif
#ifndef REP_MASK
#define REP_MASK 0u
#endif
#define IN(k) (((PH_MASK >> (k)) & 1u) && lo <= (k) && (k) < hi)
#define REPS(k) for (int rep_ = 0; rep_ < (((REP_MASK >> (k)) & 1u) ? 2 : 1); ++rep_, (((REP_MASK >> (k)) & 1u) && rep_ < 2 ? xcd_barrier(bar) : (void)0))
#define SEAM(k) do { __builtin_amdgcn_sched_barrier(0); asm volatile("" ::: "memory"); if (IN(k) && IN((k) + 1)) xcd_barrier(bar); STAMP((k) + 1); __builtin_amdgcn_sched_barrier(0); asm volatile("" ::: "memory"); } while (0)
    using namespace pg8;
    STAMP(0);
    if (IN(0)) REPS(0) phase0(F);
    SEAM(0);
    if (IN(1)) REPS(1) {
        { Gemm g{(const bf16_t*)(ws + WS_HN), (const bf16_t*)(ws + WS_WIN), DM, DM, DM}; StaticOrder S; S.init(NTOK, 2048, F.G, (int)blockIdx.x);
          const float* cosA_ = (const float*)(ws + WS_ROPE);
          EpiProj E{(bf16_t*)(ws + WS_PROJ), (bf16_t*)(ws + WS_QA2), (bf16_t*)(ws + WS_KA2), (float*)(ws + WS_KMEAN), (bf16_t*)(ws + WS_CQN), (bf16_t*)(ws + WS_CKVN),
                    prm.in[I_MQN], prm.in[I_MKN], prm.in[I_QLATN], prm.in[I_KVLATN], cosA_, cosA_ + 65536, (LAS float*)(F.lds + LDS_TOKL), (float*)(ws + WS_KPESS)};
          gemm_phase(F.lds, F.wave, g, S, E); }
        __builtin_amdgcn_sched_barrier(0); asm volatile("" ::: "memory");
        { Gemm g{(const bf16_t*)(ws + WS_HNF8), (const bf16_t*)(ws + WS_WINF8), 512, 512, 512}; StaticOrder S; S.init(NTOK, 2048, F.G, (int)blockIdx.x);
          EpiStore E{(bf16_t*)(ws + WS_PROJ) + PC_GA, DINP, nullptr, 0, 0}; gemm_phase<EpiStore, StaticOrder, false, true>(F.lds, F.wave, g, S, E); } }
    SEAM(1);
    if (IN(3)) REPS(3) {
        const float* cosB_ = (const float*)(ws + WS_ROPE) + 131072;
        { Gemm g{(const bf16_t*)(ws + WS_CQN), (const bf16_t*)(ws + WS_WUQ), 256, 256, 256}; StaticOrder S; S.init(NTOK, 1024, F.G, (int)blockIdx.x);
          EpiQB E{(bf16_t*)(ws + WS_QB), prm.in[I_MLAQN], cosB_, cosB_ + 32768, (LAS float*)(F.lds + LDS_CTL)}; gemm_phase(F.lds, F.wave, g, S, E); }
        __builtin_amdgcn_sched_barrier(0); asm volatile("" ::: "memory");
        { Gemm g{(const bf16_t*)(ws + WS_CKVN), (const bf16_t*)(ws + WS_WUKV), 128, 128, 128}; StaticOrder S; S.init(NTOK, 1024, F.G, (int)blockIdx.x);
          EpiKV E{(bf16_t*)(ws + WS_KB2), (bf16_t*)(ws + WS_KV), (const bf16_t*)(ws + WS_PROJ), (const float*)(ws + WS_KPESS), prm.in[I_MLAKN], cosB_, cosB_ + 32768, (LAS float*)(F.lds + LDS_CTL)};
          gemm_phase(F.lds, F.wave, g, S, E); } }
    SEAM(3);
    if (IN(5)) REPS(5) phase5(F);
    SEAM(5);
    if (IN(6)) REPS(6) { Gemm g{(const bf16_t*)(ws + WS_Y), (const bf16_t*)(ws + WS_WA), 512, 256, 256}; BranchOrder S; S.so.init(NTOK, DM, F.G, (int)blockIdx.x);
        EpiGateAB E{(bf16_t*)(ws + WS_MERGED), (const bf16_t*)(ws + WS_PROJ) + PC_GA, (const bf16_t*)(ws + WS_PROJ) + PC_GB, DINP, ws + WS_KA2  };
        gemm_phase<EpiGateAB, BranchOrder, false, true>(F.lds, F.wave, g, S, E); }
    SEAM(7);
    if (IN(8)) REPS(8) { Gemm g{(const bf16_t*)(ws + WS_KA2), (const bf16_t*)(ws + WS_WO), 512, 512, 512}; StaticOrder S; S.init(NTOK, DM, F.G, (int)blockIdx.x);
        EpiResF32 E{prm.in[I_X], (bf16_t*)(ws + WS_X1B), (float*)(ws + WS_SSP)}; gemm_phase<EpiResF32, StaticOrder, false, true>(F.lds, F.wave, g, S, E); }
    SEAM(8);
    if (IN(9)) REPS(9) phase8(F);
    SEAM(9);
    if (IN(10)) REPS(10) phase9(F);
    SEAM(10);
    if (IN(11)) REPS(11) { const int nmt = ((const LAS int*)(F.lds + LDS_CTL))[100]; stage_tok(F, nmt, 8);
        Gemm g{(const bf16_t*)(ws + WS_HNF8), (const bf16_t*)(ws + WS_W1), 512, 512, 512}; MoeOrder S{(const LAS int*)(F.lds + LDS_CTL) + 128, nmt, 8, F.G, (int)blockIdx.x};
        EpiSwiglu E{ws + WS_ACT, prm.in[I_BGU]}; gemm_phase<EpiSwiglu, MoeOrder, true, true>(F.lds, F.wave, g, S, E, (const LAS unsigned short*)(F.lds + LDS_TOKL)); }
    SEAM(11);
    if (IN(12)) REPS(12) { const int nmt = ((const LAS int*)(F.lds + LDS_CTL))[100];
        Gemm g{(const bf16_t*)(ws + WS_ACT), (const bf16_t*)(ws + WS_W2), 512, 512, 512}; MoeOrder S{(const LAS int*)(F.lds + LDS_CTL) + 128, nmt, 4, F.G, (int)blockIdx.x};
        EpiStore E{(bf16_t*)(ws + WS_XG), DM, prm.in[I_BD], 1024, 1 << 30}; gemm_phase<EpiStore, MoeOrder, false, true>(F.lds, F.wave, g, S, E); }
    SEAM(12);
    if (IN(13)) REPS(13) phase12(F);
    SEAM(13);
    if (IN(14)) REPS(14) { Gemm g{(const bf16_t*)(ws + WS_PB), (const bf16_t*)(ws + WS_WPP), 256, 256, 256}; StaticOrder S; S.init(NTOK, DM, F.G, (int)blockIdx.x);
        EpiStore E{(bf16_t*)(ws + WS_PP), DM, nullptr, 0, 1 << 30}; gemm_phase(F.lds, F.wave, g, S, E); }
    __builtin_amdgcn_sched_barrier(0); asm volatile("s_waitcnt vmcnt(0)" ::: "memory"); __syncthreads();
    if (IN(15)) REPS(15) { Gemm g{(const bf16_t*)(ws + WS_HNF8), (const bf16_t*)(ws + WS_WPG), 512, 512, 512}; StaticOrder S; S.init(NTOK, DM, F.G, (int)blockIdx.x);
        EpiFinal E{prm.out, (const bf16_t*)(ws + WS_PP), (const bf16_t*)(ws + WS_X1B)}; gemm_phase<EpiFinal, StaticOrder, false, true>(F.lds, F.wave, g, S, E); }
#ifdef TPROBE_A
    STAMP(16);
    xcd_barrier(bar);
    if (blockIdx.x == 0 && F.wave == 0 && lane_id() == 0) {
        volatile unsigned long long* ts = (volatile unsigned long long*)(ws + WS_ERR);
        const unsigned long long da = ts[TPROBE_A1] - ts[TPROBE_A], db = ts[TPROBE_B1] - ts[TPROBE_B];
        asm volatile("s_waitcnt vmcnt(0)" ::: "memory");
        prm.out[0] += (float)db * (0.01f / 4.0f);
        const unsigned long long t0 = __builtin_amdgcn_s_memrealtime();
        while (__builtin_amdgcn_s_memrealtime() - t0 < 4ull * da) __builtin_amdgcn_s_sleep(4);
    }
#endif
#undef IN
#undef SEAM
}

extern "C" void kernel_launch(void* const* d_in, const int* in_sizes, int n_in, void* d_out, int out_size, void* d_ws, size_t ws_size, hipStream_t stream) {
    static int grid = 0;
    if (grid == 0) {
        int dev = 0, cus = 0, per_cu = 0;
        (void)hipGetDevice(&dev);
        (void)hipDeviceGetAttribute(&cus, hipDeviceAttributeMultiprocessorCount, dev);
        (void)hipFuncSetAttribute((const void*)fwd, hipFuncAttributeMaxDynamicSharedMemorySize, LDS_BYTES);
        (void)hipOccupancyMaxActiveBlocksPerMultiprocessor(&per_cu, (const void*)fwd, NTHREADS, LDS_BYTES);
        fprintf(stderr, "cus %d per_cu %d ws %zu n_in %d\n", cus, per_cu, ws_size, n_in);
        grid = (per_cu >= 1) ? cus : -1;
        if (grid != 256 || n_in != 25 || ws_size < WS_END || out_size != NTOK * DM) { fprintf(stderr, "kernel_launch: unsupported configuration\n"); grid = -1; }
    }
    if (grid < 0) return;
    (void)hipMemsetAsync((char*)d_ws + WS_BAR, 0, WS_BAR_BYTES, stream);
    Params a{};
    for (int i = 0; i < 25; ++i) a.in[i] = (const float*)d_in[i];
    a.out = (float*)d_out; a.ws = (unsigned char*)d_ws;
#ifndef MULTI_LAUNCH
    a.ph_lo = 0; a.ph_hi = NPHASE;
    void* args[] = {&a};
    hipError_t e = hipLaunchCooperativeKernel((const void*)fwd, dim3(grid), dim3(NTHREADS), args, LDS_BYTES, stream);
    if (e != hipSuccess) fprintf(stderr, "cooperative launch failed: %s\n", hipGetErrorString(e));
#else
    for (int k = 0; k < NPHASE; ++k) { a.ph_lo = k; a.ph_hi = k + 1; void* args[] = {&a};
        hipError_t e = hipLaunchCooperativeKernel((const void*)fwd, dim3(grid), dim3(NTHREADS), args, LDS_BYTES, stream);
        if (e != hipSuccess) fprintf(stderr, "launch %d failed: %s\n", k, hipGetErrorString(e)); }
#endif
}
```

```cpp
#include <hip/hip_runtime.h>
#include <hip/hip_cooperative_groups.h>
#include <cstdio>
#include <cstdint>
namespace cg = cooperative_groups;

#define LAS __attribute__((address_space(3)))
typedef unsigned short bf16_t;
typedef short bf16x8 __attribute__((ext_vector_type(8)));
typedef short s16x4 __attribute__((ext_vector_type(4)));
typedef float f32x4 __attribute__((ext_vector_type(4)));
typedef float f32x2 __attribute__((ext_vector_type(2)));
typedef float f32x16 __attribute__((ext_vector_type(16)));
typedef unsigned u32x4 __attribute__((ext_vector_type(4)));
typedef unsigned u32x2 __attribute__((ext_vector_type(2)));
typedef int i32x4 __attribute__((ext_vector_type(4)));
typedef int i32x8 __attribute__((ext_vector_type(8)));
typedef __bf16 bf16x2_t __attribute__((ext_vector_type(2)));

constexpr int NB = 8, SEQ = 2048, NTOK = NB * SEQ, DM = 1024;
constexpr int DIN = 4000, DINP = 4096;
constexpr int NEXP = 32, TOPK = 4, DEXP = 1024;
constexpr int NTHREADS = 512, NWAVES = 8;
constexpr float EPS = 1e-6f;
constexpr float LOG2E = 1.4426950408889634f;
constexpr float C2A = 0.125f * LOG2E;
constexpr float C2B = 0.10206207261596575f * LOG2E;
constexpr int PC_QA = 0, PC_KA = 512, PC_VA = 1024, PC_CQ = 1536, PC_CKV = 1792, PC_KPE = 1920, PC_GA = 2048, PC_GB = 3072;

constexpr size_t MiB = 1u << 20;
constexpr size_t WS_HIST = 0;
constexpr size_t WS_ERR = 64 * 1024;
constexpr size_t WS_BAR = 128 * 1024;
constexpr size_t WS_BAR_BYTES = 16 * 1024;
constexpr size_t WS_KPESS = 576 * 1024;
constexpr size_t WS_TOK = 256 * 1024;
constexpr size_t WS_ROPE = 1 * MiB;
constexpr size_t WS_KMEAN = 2 * MiB;
constexpr size_t WS_SSP = 11 * MiB;
constexpr size_t WS_PAIR = 3 * MiB;
constexpr size_t WS_WUQ = 4 * MiB, WS_WUKV = 4 * MiB + 512 * 1024, WS_WPP = 5 * MiB, WS_WA = 6 * MiB, WS_WB = 7 * MiB, WS_WO = 8 * MiB, WS_WPG = 10 * MiB, WS_WIN = 12 * MiB;
constexpr size_t WS_W1 = 20 * MiB, WS_W2 = 148 * MiB;
constexpr size_t WS_WINF8 = 16 * MiB;
constexpr size_t WS_HNF8 = 84 * MiB;
constexpr size_t WS_HN = 212 * MiB, WS_PB = 244 * MiB;
constexpr size_t WS_X1B = WS_HN;
constexpr size_t WS_CQN = 252 * MiB, WS_CKVN = 260 * MiB, WS_QB = 264 * MiB, WS_KV = 288 * MiB, WS_KB2 = 320 * MiB, WS_Y = 344 * MiB, WS_MERGED = 376 * MiB;
constexpr size_t WS_ACT = 252 * MiB;
constexpr size_t WS_PP = 400 * MiB;
constexpr size_t WS_KA2 = 432 * MiB;
constexpr size_t WS_PROJ = 448 * MiB;
constexpr size_t WS_QA2 = 576 * MiB;
constexpr size_t WS_XG = 448 * MiB;
constexpr size_t WS_END = 592 * MiB;
constexpr int MAXROWS = 73728, MAXMT = 288;

constexpr int RING_BYTES = 131072;
constexpr int LDS_CTL = RING_BYTES;
constexpr int LDS_TOKL = RING_BYTES + 8192 + 256;
constexpr int LDS_BARST = RING_BYTES + 8192;
constexpr int LDS_BYTES = 147456;

__device__ __forceinline__ unsigned cvt_pk_bf16(float lo, float hi) { f32x2 v = {lo, hi}; bf16x2_t b = __builtin_convertvector(v, bf16x2_t); return __builtin_bit_cast(unsigned, b); }
__device__ __forceinline__ unsigned pack4_fp8(float a, float b, float c, float d) { int w = 0; w = __builtin_amdgcn_cvt_pk_fp8_f32(a, b, w, false); w = __builtin_amdgcn_cvt_pk_fp8_f32(c, d, w, true); return (unsigned)w; }
__device__ __forceinline__ float bf2f(unsigned short b) { return __uint_as_float(((unsigned)b) << 16); }
__device__ __forceinline__ float bflo(unsigned w) { return __uint_as_float(w << 16); }
__device__ __forceinline__ float bfhi(unsigned w) { return __uint_as_float(w & 0xffff0000u); }
__device__ __forceinline__ float sigmoidf_(float x) { return __builtin_amdgcn_rcpf(1.0f + __builtin_amdgcn_exp2f(-x * LOG2E)); }
__device__ __forceinline__ int lane_id() { return (int)__builtin_amdgcn_mbcnt_hi(~0u, __builtin_amdgcn_mbcnt_lo(~0u, 0u)); }
__device__ __forceinline__ float wave_sum(float v) {
#pragma unroll
    for (int o = 1; o < 64; o <<= 1) v += __shfl_xor(v, o);
    return v;
}

namespace pg8 {
constexpr int BM = 256, BK = 64, HALF = 128, HTB = HALF * BK * 2, STAGE_BYTES = 8 * HTB, NXCD = 8, WGM = 8;
__host__ __device__ __forceinline__ int lds_byte(int r, int c) { const int st = (r >> 4) * 2 + (c >> 5), rr = r & 15, cc = c & 31, ob = rr * 64 + cc * 2; return st * 1024 + (ob ^ (((ob >> 9) & 1) << 5)); }
__host__ __device__ __forceinline__ void stage_rc(int b, int& R, int& C) { const int st = b / 1024, sb = b % 1024, swz = sb ^ (((sb >> 9) & 1) << 5); R = (st >> 1) * 16 + swz / 64; C = (st & 1) * 32 + (swz % 64) / 2; }
__host__ __device__ __forceinline__ int perm32(int rho) { const int n = rho >> 4, i = rho & 15; return 8 * (i >> 2) + 4 * n + (i & 3); }

struct Unit { int pm, pn, pb, e; int aofs = 0; };
struct Gemm { const bf16_t* A; const bf16_t* Bt; int lda, ldb, K; };

struct StaticOrder {
    int nM, nN, nwg, G, c;
    __device__ void init(int M, int N, int G_, int c_) { nM = M / BM; nN = N / BM; nwg = nM * nN; G = G_; c = c_; }
    __device__ bool next(int i, Unit& u) const {
        const long L = (long)i * G + c; if (L >= nwg) return false;
        int wgid = (int)L; { const int q = nwg / NXCD, r = nwg % NXCD, xcd = wgid % NXCD, off = wgid / NXCD; wgid = (xcd < r ? xcd * (q + 1) : r * (q + 1) + (xcd - r) * q) + off; }
        const int nig = WGM * nN, gid = wgid / nig, fm = gid * WGM, gsz = (nM - fm) < WGM ? (nM - fm) : WGM;
        u.pm = fm + ((wgid % nig) % gsz); u.pn = (wgid % nig) / gsz; u.pb = u.pn; u.e = 0; return true;
    }
};
struct MoeOrder {
    const LAS int* tile_e; int nmt, ntn, G, c;
    __device__ bool next(int i, Unit& u) const {
        const int j = (i * G + c) >> 3; const int mt = (j / ntn) * 8 + (c & 7), pn = j % ntn; if (mt >= nmt) return false;
        const int e = __builtin_amdgcn_readfirstlane(tile_e[mt]);
        u.pm = mt; u.pn = pn; u.pb = e * ntn + pn; u.e = e; return true;
    }
};

template <class Epi, class Sched, bool GATHER = false, bool FP8 = false>
__device__ __forceinline__ void gemm_phase(LAS unsigned char* lds, int wave, const Gemm g, const Sched& S, const Epi& E, const LAS unsigned short* tokl = nullptr) {
    constexpr bool ALIGN_EPI = true;
    int lane = lane_id(); asm volatile("" : "+v"(lane));
    const int wid = wave, tid = wid * 64 + lane, wr = wid >> 2, wc = wid & 3, fr = lane & 15, fq = lane >> 4;
    int K = g.K; asm volatile("" : "+s"(K));
    const int nt = K / BK;
    unsigned voffA[2], voffB[2]; int gR[2]; unsigned gC[2];
#pragma unroll
    for (int i = 0; i < 2; ++i) { int R, C; stage_rc(tid * 16 + i * 8192, R, C); const int Rb = (R & ~31) + perm32(R & 31);
        voffA[i] = (unsigned)(R * g.lda + C) * 2u; voffB[i] = (unsigned)(Rb * g.ldb + C) * 2u; gR[i] = R; gC[i] = (unsigned)C * 2u; }
    unsigned goff[2][2], noff[2][2];
#define PG8_GOFF(dst, ui_) do { _Pragma("unroll") for (int h_ = 0; h_ < 2; ++h_) _Pragma("unroll") for (int i_ = 0; i_ < 2; ++i_) \
        dst[h_][i_] = (unsigned)tokl[(ui_) * 256 + h_ * HALF + gR[i_]] * (unsigned)(g.lda * 2) + gC[i_]; } while (0)
    const size_t kstep = (size_t)(BK * 2);
    const size_t hstepA = (size_t)HALF * g.lda * 2, hstepB = (size_t)HALF * g.ldb * 2;
    const size_t tstepA = 2 * hstepA, tstepB = 2 * hstepB;
    const unsigned ldsw = (unsigned)wid * 1024u;
    const int aoff = lds_byte(wr * 64 + fr, fq * 8), boff = lds_byte(wc * 32 + fr, fq * 8);
#define PG8_SA(b, h) (((b) * 2 + (h)) * HTB)
#define PG8_SB(b, h) ((4 + (b) * 2 + (h)) * HTB)
#define PG8_STAGE(bufoff, gbase, voff) do { _Pragma("unroll") for (int _i = 0; _i < 2; ++_i) \
        __builtin_amdgcn_global_load_lds((const unsigned*)((const char*)(gbase) + (voff)[_i]), (LAS unsigned*)(lds + (bufoff) + ldsw + _i * 8192), 16, 0, 0); } while (0)
#define PG8_STAGE_A(bufoff, ptr_ng, k_g, off_g) do { if constexpr (GATHER) { const char* gb_ = (const char*)g.A + (size_t)(k_g) * kstep; PG8_STAGE(bufoff, gb_, off_g); } else { PG8_STAGE(bufoff, ptr_ng, voffA); } } while (0)
#define PG8_LDA(dst, b, h) do { if constexpr (FP8) { _Pragma("unroll") for (int m = 0; m < 4; ++m) { const i32x4 lo_ = *(const LAS i32x4*)(lds + PG8_SA(b, h) + aoff + m * 2048), hi_ = *(const LAS i32x4*)(lds + PG8_SA(b, h) + aoff + m * 2048 + 1024); dst##8[m] = __builtin_shufflevector(lo_, hi_, 0, 1, 2, 3, 4, 5, 6, 7); } } \
        else { _Pragma("unroll") for (int m = 0; m < 4; ++m) _Pragma("unroll") for (int k = 0; k < 2; ++k) dst[m][k] = *(const LAS bf16x8*)(lds + PG8_SA(b, h) + aoff + m * 2048 + k * 1024); } } while (0)
#define PG8_LDB(dst, b, h) do { if constexpr (FP8) { _Pragma("unroll") for (int n = 0; n < 2; ++n) { const i32x4 lo_ = *(const LAS i32x4*)(lds + PG8_SB(b, h) + boff + n * 2048), hi_ = *(const LAS i32x4*)(lds + PG8_SB(b, h) + boff + n * 2048 + 1024); dst##8[n] = __builtin_shufflevector(lo_, hi_, 0, 1, 2, 3, 4, 5, 6, 7); } } \
        else { _Pragma("unroll") for (int n = 0; n < 2; ++n) _Pragma("unroll") for (int k = 0; k < 2; ++k) dst[n][k] = *(const LAS bf16x8*)(lds + PG8_SB(b, h) + boff + n * 2048 + k * 1024); } } while (0)
#define PG8_CAT8(x, y) __builtin_shufflevector(__builtin_bit_cast(i32x4, x), __builtin_bit_cast(i32x4, y), 0, 1, 2, 3, 4, 5, 6, 7)
#define PG8_MMA(ai, bj, At, Bt) do { __builtin_amdgcn_s_setprio(1); if constexpr (FP8) { _Pragma("unroll") for (int m = 0; m < 4; ++m) _Pragma("unroll") for (int n = 0; n < 2; ++n) \
        asm volatile("v_mfma_scale_f32_16x16x128_f8f6f4 %0, %1, %2, %0, %3, %3 op_sel_hi:[0,0,0]" : "+v"(acc[ai][bj][m][n]) : "v"(Bt##8[n]), "v"(At##8[m]), "v"(sc8)); } \
        else { _Pragma("unroll") for (int m = 0; m < 4; ++m) _Pragma("unroll") for (int n = 0; n < 2; ++n) _Pragma("unroll") for (int k = 0; k < 2; ++k) \
        acc[ai][bj][m][n] = __builtin_amdgcn_mfma_f32_16x16x32_bf16(Bt[n][k], At[m][k], acc[ai][bj][m][n], 0, 0, 0); } __builtin_amdgcn_s_setprio(0); } while (0)
#define PG8_WAIT_V(n) asm volatile("s_waitcnt vmcnt(" #n ")" ::: "memory")
#define PG8_WAIT_L(n) asm volatile("s_waitcnt lgkmcnt(" #n ")" ::: "memory")
#define PG8_BAR __builtin_amdgcn_s_barrier()
#define PG8_SCHED __builtin_amdgcn_sched_barrier(0)
    Unit cur, nxt; int ui = 0;
    if (!S.next(0, cur)) return;
    f32x4 acc[2][2][4][2];
#pragma unroll
    for (int a = 0; a < 2; ++a)
#pragma unroll
        for (int b = 0; b < 2; ++b)
#pragma unroll
            for (int m = 0; m < 4; ++m)
#pragma unroll
                for (int n = 0; n < 2; ++n) acc[a][b][m][n] = (f32x4){0.f, 0.f, 0.f, 0.f};
    const int sc8 = 0x7c7c7c7c;
    bf16x8 At[4][2], B0[2][2], B1[2][2]; i32x8 At8[4], B08[2], B18[2];
    const char* cA = (const char*)g.A + (size_t)cur.pm * tstepA + cur.aofs; const char* cB = (const char*)g.Bt + (size_t)cur.pb * tstepB;
    if constexpr (GATHER) { PG8_GOFF(goff, 0); }
    PG8_STAGE(PG8_SB(0, 0), cB, voffB); PG8_STAGE(PG8_SB(0, 1), cB + hstepB, voffB); PG8_STAGE_A(PG8_SA(0, 0), cA, 0, goff[0]); PG8_STAGE_A(PG8_SA(0, 1), cA + hstepA, 0, goff[1]);
    if (wr == 1) PG8_BAR;
    PG8_WAIT_V(2); PG8_BAR;
    PG8_STAGE(PG8_SB(1, 0), cB + kstep, voffB); PG8_STAGE_A(PG8_SA(1, 0), cA + kstep, 1, goff[0]); PG8_STAGE(PG8_SB(1, 1), cB + hstepB + kstep, voffB);
    PG8_WAIT_V(6); PG8_BAR;
    for (;;) {
        const bool has_next = S.next(ui + 1, nxt);
        const char* nA = has_next ? (const char*)g.A + (size_t)nxt.pm * tstepA + nxt.aofs : cA; const char* nB = has_next ? (const char*)g.Bt + (size_t)nxt.pb * tstepB : cB;
        if constexpr (GATHER) { if (has_next) { PG8_GOFF(noff, ui + 1); } else {
#pragma unroll
            for (int h_ = 0; h_ < 2; ++h_)
#pragma unroll
                for (int i_ = 0; i_ < 2; ++i_) noff[h_][i_] = goff[h_][i_]; } }
        for (int t = 0; t < nt; t += 2) {
            const bool last = (t == nt - 2);
            const char* a1 = cA + (size_t)(t + 1) * kstep;
            const char* a2 = last ? nA : cA + (size_t)(t + 2) * kstep; const char* b2 = last ? nB : cB + (size_t)(t + 2) * kstep;
            const char* a3 = a2 + kstep; const char* b3 = b2 + kstep;
            const int k2 = last ? 0 : t + 2;
            unsigned soff[2][2];
            if constexpr (GATHER) {
#pragma unroll
                for (int h_ = 0; h_ < 2; ++h_)
#pragma unroll
                    for (int i_ = 0; i_ < 2; ++i_) soff[h_][i_] = last ? noff[h_][i_] : goff[h_][i_]; }
            PG8_LDB(B0, 0, 0); PG8_LDB(B1, 0, 1); PG8_SCHED; PG8_LDA(At, 0, 0); PG8_STAGE_A(PG8_SA(1, 1), a1 + hstepA, t + 1, goff[1]);
            PG8_WAIT_V(8); PG8_WAIT_L(0); PG8_BAR; PG8_MMA(0, 0, At, B0); PG8_MMA(0, 1, At, B1); PG8_BAR; PG8_SCHED;
            PG8_LDA(At, 0, 1); PG8_STAGE(PG8_SB(0, 0), b2, voffB); PG8_STAGE(PG8_SB(0, 1), b2 + hstepB, voffB); PG8_STAGE_A(PG8_SA(0, 0), a2, k2, soff[0]);
            PG8_WAIT_V(8); PG8_WAIT_L(0); PG8_BAR; PG8_MMA(1, 0, At, B0); PG8_MMA(1, 1, At, B1); PG8_BAR; PG8_SCHED;
            PG8_LDB(B0, 1, 0); PG8_LDB(B1, 1, 1); PG8_SCHED; PG8_LDA(At, 1, 0); PG8_STAGE_A(PG8_SA(0, 1), a2 + hstepA, k2, soff[1]);
            PG8_WAIT_V(8); PG8_WAIT_L(0); PG8_BAR; PG8_MMA(0, 0, At, B0); PG8_MMA(0, 1, At, B1); PG8_BAR; PG8_SCHED;
            PG8_LDA(At, 1, 1); PG8_STAGE(PG8_SB(1, 0), b3, voffB); PG8_STAGE(PG8_SB(1, 1), b3 + hstepB, voffB); PG8_STAGE_A(PG8_SA(1, 0), a3, k2 + 1, soff[0]);
            PG8_WAIT_V(8); PG8_WAIT_L(0); PG8_BAR; PG8_MMA(1, 0, At, B0); PG8_MMA(1, 1, At, B1); PG8_BAR; PG8_SCHED;
        }
        if constexpr (ALIGN_EPI) { if (wr == 0) PG8_BAR; }
        if constexpr (FP8) asm volatile("s_nop 15\n\ts_nop 15" ::: "memory");
        E(acc, cur, wr, wc, fr, fq);
        if (!has_next) break;
#pragma unroll
        for (int a = 0; a < 2; ++a)
#pragma unroll
            for (int b = 0; b < 2; ++b)
#pragma unroll
                for (int m = 0; m < 4; ++m)
#pragma unroll
                    for (int n = 0; n < 2; ++n) acc[a][b][m][n] = (f32x4){0.f, 0.f, 0.f, 0.f};
        cur = nxt; cA = nA; cB = nB; ++ui;
        if constexpr (GATHER) {
#pragma unroll
            for (int h_ = 0; h_ < 2; ++h_)
#pragma unroll
                for (int i_ = 0; i_ < 2; ++i_) goff[h_][i_] = noff[h_][i_]; }
        if constexpr (ALIGN_EPI) { if (wr == 1) PG8_BAR; }
    }
    PG8_WAIT_V(0);
    if constexpr (!ALIGN_EPI) { if (wr == 0) PG8_BAR; }
    PG8_BAR;
#undef PG8_SA
#undef PG8_SB
#undef PG8_STAGE
#undef PG8_STAGE_A
#undef PG8_GOFF
#undef PG8_LDA
#undef PG8_LDB
#undef PG8_MMA
#undef PG8_CAT8
#undef PG8_WAIT_V
#undef PG8_WAIT_L
#undef PG8_BAR
#undef PG8_SCHED
}

#define EPI_ARGS const f32x4 (&acc)[2][2][4][2], const Unit& u, int wr, int wc, int fr, int fq
__device__ __forceinline__ u32x4 pack8(f32x4 v0, f32x4 v1) { u32x4 w; w.x = cvt_pk_bf16(v0[0], v0[1]); w.y = cvt_pk_bf16(v0[2], v0[3]); w.z = cvt_pk_bf16(v1[0], v1[1]); w.w = cvt_pk_bf16(v1[2], v1[3]); return w; }
__device__ __forceinline__ void unpack8(u32x4 w, f32x4& v0, f32x4& v1) { v0 = (f32x4){bflo(w.x), bfhi(w.x), bflo(w.y), bfhi(w.y)}; v1 = (f32x4){bflo(w.z), bfhi(w.z), bflo(w.w), bfhi(w.w)}; }
__device__ __forceinline__ f32x4 sig4(f32x4 v) { return (f32x4){sigmoidf_(v[0]), sigmoidf_(v[1]), sigmoidf_(v[2]), sigmoidf_(v[3])}; }

struct EpiStore {
    bf16_t* O; int ldc; const float* bias; int bias_stride; int sig_from;
    __device__ __forceinline__ void operator()(EPI_ARGS) const {
        const int row0 = u.pm * BM + wr * 64 + fr, col0 = u.pn * BM + wc * 32 + 8 * fq;
        const bool sg = u.pn >= sig_from;
        f32x4 bv[2][2];
#pragma unroll
        for (int bj = 0; bj < 2; ++bj)
#pragma unroll
            for (int n = 0; n < 2; ++n) bv[bj][n] = bias ? *(const f32x4*)(bias + (size_t)u.e * bias_stride + col0 + bj * HALF + 4 * n) : (f32x4){0.f, 0.f, 0.f, 0.f};
#pragma unroll
        for (int ai = 0; ai < 2; ++ai)
#pragma unroll
            for (int m = 0; m < 4; ++m) { bf16_t* rowp = O + (size_t)(row0 + ai * HALF + m * 16) * ldc + col0;
#pragma unroll
                for (int bj = 0; bj < 2; ++bj) { f32x4 v0 = acc[ai][bj][m][0] + bv[bj][0], v1 = acc[ai][bj][m][1] + bv[bj][1];
                    if (sg) { v0 = sig4(v0); v1 = sig4(v1); }
                    *(u32x4*)(rowp + bj * HALF) = pack8(v0, v1); } }
    }
};

struct EpiProj {
    bf16_t* PROJ; bf16_t* QA2; bf16_t* KA2; float* KMEAN; bf16_t* CQN; bf16_t* CKVN;
    const float* gq; const float* gk; const float* glq; const float* glkv; const float* cosA; const float* sinA; LAS float* xch;
    float* KPESS;
    __device__ __forceinline__ void operator()(EPI_ARGS) const {
        const int row0 = u.pm * BM + wr * 64 + fr, col0 = u.pn * BM + wc * 32 + 8 * fq;
        if (u.pn < 4) {
            const bool isk = u.pn >= 2; const int h = 4 * (u.pn & 1) + wc; const float* gn = isk ? gk : gq; const float sc = isk ? 1.0f : C2A;
            const f32x4 g1a = *(const f32x4*)(gn + 8 * fq), g1b = *(const f32x4*)(gn + 8 * fq + 4), g2a = *(const f32x4*)(gn + 32 + 8 * fq), g2b = *(const f32x4*)(gn + 36 + 8 * fq);
            bf16_t* dst = isk ? KA2 : QA2;
            f32x4 ks1a = {0.f, 0.f, 0.f, 0.f}, ks1b = ks1a, ks2a = ks1a, ks2b = ks1a;
#pragma unroll
            for (int ai = 0; ai < 2; ++ai)
#pragma unroll
                for (int m = 0; m < 4; ++m) { const int row = row0 + ai * HALF + m * 16; const int pos = row & (SEQ - 1);
                    f32x4 x1a = acc[ai][0][m][0], x1b = acc[ai][0][m][1], x2a = acc[ai][1][m][0], x2b = acc[ai][1][m][1];
                    float ss = (x1a[0] * x1a[0] + x1a[1] * x1a[1]) + (x1a[2] * x1a[2] + x1a[3] * x1a[3]) + (x1b[0] * x1b[0] + x1b[1] * x1b[1]) + (x1b[2] * x1b[2] + x1b[3] * x1b[3])
                             + (x2a[0] * x2a[0] + x2a[1] * x2a[1]) + (x2a[2] * x2a[2] + x2a[3] * x2a[3]) + (x2b[0] * x2b[0] + x2b[1] * x2b[1]) + (x2b[2] * x2b[2] + x2b[3] * x2b[3]);
                    ss += __shfl_xor(ss, 16); ss += __shfl_xor(ss, 32);
                    const float rstd = 1.0f / sqrtf(ss * (1.f / 64.f) + EPS);
                    x1a = x1a * g1a * rstd; x1b = x1b * g1b * rstd; x2a = x2a * g2a * rstd; x2b = x2b * g2b * rstd;
                    const f32x4 ca = *(const f32x4*)(cosA + pos * 32 + 8 * fq), cb = *(const f32x4*)(cosA + pos * 32 + 8 * fq + 4), sa = *(const f32x4*)(sinA + pos * 32 + 8 * fq), sb = *(const f32x4*)(sinA + pos * 32 + 8 * fq + 4);
                    const f32x4 y1a = x1a * ca - x2a * sa, y1b = x1b * cb - x2b * sb, y2a = x2a * ca + x1a * sa, y2b = x2b * cb + x1b * sb;
                    bf16_t* rp = dst + (size_t)row * 512 + h * 64 + 8 * fq;
                    *(u32x4*)rp = pack8(y1a * sc, y1b * sc); *(u32x4*)(rp + 32) = pack8(y2a * sc, y2b * sc);
                    ks1a += y1a; ks1b += y1b; ks2a += y2a; ks2b += y2b; }
            if (isk) {
#pragma unroll
                for (int o = 1; o < 16; o <<= 1) {
#pragma unroll
                    for (int i = 0; i < 4; ++i) { ks1a[i] += __shfl_xor(ks1a[i], o); ks1b[i] += __shfl_xor(ks1b[i], o); ks2a[i] += __shfl_xor(ks2a[i], o); ks2b[i] += __shfl_xor(ks2b[i], o); } }
                if (fr == 0) { float* km = KMEAN + (((size_t)(u.pm >> 3) * 8 + h) * 8 + (u.pm & 7)) * 64 + 8 * fq;
#pragma unroll
                    for (int i = 0; i < 4; ++i) { atomicAdd(km + i, ks1a[i] * (1.f / 256.f)); atomicAdd(km + 4 + i, ks1b[i] * (1.f / 256.f)); atomicAdd(km + 32 + i, ks2a[i] * (1.f / 256.f)); atomicAdd(km + 36 + i, ks2b[i] * (1.f / 256.f)); } } }
        } else if (u.pn == 6 || u.pn == 7) {
            const bool isq = u.pn == 6;
            float ssr[2][4];
#pragma unroll
            for (int ai = 0; ai < 2; ++ai)
#pragma unroll
                for (int m = 0; m < 4; ++m) { float ss = 0.f;
#pragma unroll
                    for (int bj = 0; bj < 2; ++bj) { if (bj == 1 && !isq) continue;
#pragma unroll
                        for (int n = 0; n < 2; ++n) { const f32x4 x = acc[ai][bj][m][n]; ss += (x[0] * x[0] + x[1] * x[1]) + (x[2] * x[2] + x[3] * x[3]); } }
                    ss += __shfl_xor(ss, 16); ss += __shfl_xor(ss, 32);
                    if (fq == 0) xch[(ai * HALF + wr * 64 + m * 16 + fr) * 4 + wc] = ss; }
            asm volatile("s_waitcnt lgkmcnt(0)" ::: "memory"); __builtin_amdgcn_s_barrier(); asm volatile("" ::: "memory");
#pragma unroll
            for (int ai = 0; ai < 2; ++ai)
#pragma unroll
                for (int m = 0; m < 4; ++m) { const f32x4 p4 = *(const LAS f32x4*)(xch + (ai * HALF + wr * 64 + m * 16 + fr) * 4); ssr[ai][m] = (p4[0] + p4[1]) + (p4[2] + p4[3]); }
            asm volatile("s_waitcnt lgkmcnt(0)" ::: "memory"); __builtin_amdgcn_s_barrier(); asm volatile("" ::: "memory");
            const float invn = isq ? (1.f / 256.f) : (1.f / 128.f); const float* gl = isq ? glq : glkv; bf16_t* dn = isq ? CQN : CKVN; const int ldn = isq ? 256 : 128;
            const int c0 = wc * 32 + 8 * fq;
#pragma unroll
            for (int bj = 0; bj < 2; ++bj) {
                if (bj == 1 && !isq) {
#pragma unroll
                    for (int ai = 0; ai < 2; ++ai)
#pragma unroll
                        for (int m = 0; m < 4; ++m) { const f32x4 x0 = acc[ai][1][m][0], x1 = acc[ai][1][m][1];
                            *(u32x4*)(PROJ + (size_t)(row0 + ai * HALF + m * 16) * DINP + col0 + HALF) = pack8(x0, x1);
                            float ss = (x0[0] * x0[0] + x0[1] * x0[1]) + (x0[2] * x0[2] + x0[3] * x0[3]) + (x1[0] * x1[0] + x1[1] * x1[1]) + (x1[2] * x1[2] + x1[3] * x1[3]);
                            ss += __shfl_xor(ss, 16); ss += __shfl_xor(ss, 32);
                            if (wc == 0 && fq == 0) KPESS[row0 + ai * HALF + m * 16] = ss; }
                    continue; }
                const f32x4 ga = *(const f32x4*)(gl + bj * HALF + c0), gb = *(const f32x4*)(gl + bj * HALF + c0 + 4);
#pragma unroll
                for (int ai = 0; ai < 2; ++ai)
#pragma unroll
                    for (int m = 0; m < 4; ++m) { const float rstd = 1.0f / sqrtf(ssr[ai][m] * invn + EPS);
                        *(u32x4*)(dn + (size_t)(row0 + ai * HALF + m * 16) * ldn + bj * HALF + c0) = pack8(acc[ai][bj][m][0] * ga * rstd, acc[ai][bj][m][1] * gb * rstd); } }
        } else {
            const bool sg = u.pn >= 8;
#pragma unroll
            for (int ai = 0; ai < 2; ++ai)
#pragma unroll
                for (int m = 0; m < 4; ++m) { bf16_t* rowp = PROJ + (size_t)(row0 + ai * HALF + m * 16) * DINP + col0;
#pragma unroll
                    for (int bj = 0; bj < 2; ++bj) { f32x4 v0 = acc[ai][bj][m][0], v1 = acc[ai][bj][m][1];
                        if (sg) { v0 = sig4(v0); v1 = sig4(v1); }
                        *(u32x4*)(rowp + bj * HALF) = pack8(v0, v1); } }
        }
    }
};

struct EpiQB {
    bf16_t* QB; const float* gn; const float* cosB; const float* sinB; LAS float* xch;
    __device__ __forceinline__ void operator()(EPI_ARGS) const {
        const int rl0 = wr * 64 + fr, row0 = u.pm * BM + rl0;
#pragma unroll
        for (int ai = 0; ai < 2; ++ai)
#pragma unroll
            for (int m = 0; m < 4; ++m)
#pragma unroll
                for (int bj = 0; bj < 2; ++bj) { const f32x4 x0 = acc[ai][bj][m][0], x1 = acc[ai][bj][m][1];
                    float ss = (x0[0] * x0[0] + x0[1] * x0[1]) + (x0[2] * x0[2] + x0[3] * x0[3]) + (x1[0] * x1[0] + x1[1] * x1[1]) + (x1[2] * x1[2] + x1[3] * x1[3]);
                    ss += __shfl_xor(ss, 16); ss += __shfl_xor(ss, 32);
                    if (fq == 0) xch[((rl0 + ai * HALF + m * 16) * 2 + bj) * 4 + wc] = ss; }
        asm volatile("s_waitcnt lgkmcnt(0)" ::: "memory"); __builtin_amdgcn_s_barrier(); asm volatile("" ::: "memory");
#define QB_RS(ai, m, bj) ({ const f32x4 p4_ = *(const LAS f32x4*)(xch + ((rl0 + (ai) * HALF + (m) * 16) * 2 + (bj)) * 4); C2B / sqrtf(((p4_[0] + p4_[1]) + p4_[2]) * (1.f / 96.f) + EPS); })
        if (wc < 2) { const f32x4 ga = *(const f32x4*)(gn + 32 * wc + 8 * fq), gb = *(const f32x4*)(gn + 32 * wc + 8 * fq + 4);
#pragma unroll
            for (int ai = 0; ai < 2; ++ai)
#pragma unroll
                for (int m = 0; m < 4; ++m)
#pragma unroll
                    for (int bj = 0; bj < 2; ++bj) { const float r = QB_RS(ai, m, bj);
                        *(u32x4*)(QB + (size_t)(row0 + ai * HALF + m * 16) * 768 + (2 * u.pn + bj) * 96 + 32 * wc + 8 * fq) = pack8(acc[ai][bj][m][0] * ga * r, acc[ai][bj][m][1] * gb * r); }
        } else if (wc == 2) { const f32x4 g1 = *(const f32x4*)(gn + 64 + 4 * fq), g2 = *(const f32x4*)(gn + 80 + 4 * fq);
#pragma unroll
            for (int ai = 0; ai < 2; ++ai)
#pragma unroll
                for (int m = 0; m < 4; ++m) { const int row = row0 + ai * HALF + m * 16; const int pos = row & (SEQ - 1);
                    const f32x4 c4 = *(const f32x4*)(cosB + pos * 16 + 4 * fq), s4 = *(const f32x4*)(sinB + pos * 16 + 4 * fq);
#pragma unroll
                    for (int bj = 0; bj < 2; ++bj) { const float r = QB_RS(ai, m, bj); const f32x4 x1 = acc[ai][bj][m][0] * g1 * r, x2 = acc[ai][bj][m][1] * g2 * r;
                        const f32x4 y1 = x1 * c4 - x2 * s4, y2 = x2 * c4 + x1 * s4; bf16_t* rp = QB + (size_t)row * 768 + (2 * u.pn + bj) * 96 + 64 + 4 * fq;
                        *(u32x2*)rp = (u32x2){cvt_pk_bf16(y1[0], y1[1]), cvt_pk_bf16(y1[2], y1[3])}; *(u32x2*)(rp + 16) = (u32x2){cvt_pk_bf16(y2[0], y2[1]), cvt_pk_bf16(y2[2], y2[3])}; } }
        }
    }
};
struct EpiKV {
    bf16_t* KB2; bf16_t* KV; const bf16_t* PROJ; const float* KPESS; const float* gn; const float* cosB; const float* sinB; LAS float* xch;
    __device__ __forceinline__ void operator()(EPI_ARGS) const {
        const int rl0 = wr * 64 + fr, row0 = u.pm * BM + rl0;
        if (wc < 2) {
#pragma unroll
            for (int ai = 0; ai < 2; ++ai)
#pragma unroll
                for (int m = 0; m < 4; ++m)
#pragma unroll
                    for (int bj = 0; bj < 2; ++bj) { const f32x4 x0 = acc[ai][bj][m][0], x1 = acc[ai][bj][m][1];
                        float ss = (x0[0] * x0[0] + x0[1] * x0[1]) + (x0[2] * x0[2] + x0[3] * x0[3]) + (x1[0] * x1[0] + x1[1] * x1[1]) + (x1[2] * x1[2] + x1[3] * x1[3]);
                        ss += __shfl_xor(ss, 16); ss += __shfl_xor(ss, 32);
                        if (fq == 0) xch[((rl0 + ai * HALF + m * 16) * 2 + bj) * 4 + wc] = ss; } }
        asm volatile("s_waitcnt lgkmcnt(0)" ::: "memory"); __builtin_amdgcn_s_barrier(); asm volatile("" ::: "memory");
#define KV_RS(ai, m, bj, pe) ({ const f32x2 p2_ = *(const LAS f32x2*)(xch + ((rl0 + (ai) * HALF + (m) * 16) * 2 + (bj)) * 4); 1.0f / sqrtf(((p2_[0] + p2_[1]) + (pe)) * (1.f / 96.f) + EPS); })
        if (wc < 2) { const f32x4 ga = *(const f32x4*)(gn + 32 * wc + 8 * fq), gb = *(const f32x4*)(gn + 32 * wc + 8 * fq + 4);
#pragma unroll
            for (int ai = 0; ai < 2; ++ai)
#pragma unroll
                for (int m = 0; m < 4; ++m) { const float pe = KPESS[row0 + ai * HALF + m * 16];
#pragma unroll
                    for (int bj = 0; bj < 2; ++bj) { const float r = KV_RS(ai, m, bj, pe);
                        *(u32x4*)(KB2 + (size_t)(row0 + ai * HALF + m * 16) * 768 + (2 * u.pn + bj) * 96 + 32 * wc + 8 * fq) = pack8(acc[ai][bj][m][0] * ga * r, acc[ai][bj][m][1] * gb * r); } }
        } else {
#pragma unroll
            for (int ai = 0; ai < 2; ++ai)
#pragma unroll
                for (int m = 0; m < 4; ++m)
#pragma unroll
                    for (int bj = 0; bj < 2; ++bj) *(u32x4*)(KV + (size_t)(row0 + ai * HALF + m * 16) * 1024 + (2 * u.pn + bj) * 128 + 32 * wc + 8 * fq) = pack8(acc[ai][bj][m][0], acc[ai][bj][m][1]);
            if (wc == 2) {
                const f32x4 g1 = *(const f32x4*)(gn + 64 + 4 * fq), g2 = *(const f32x4*)(gn + 80 + 4 * fq);
#pragma unroll
                for (int ai = 0; ai < 2; ++ai)
#pragma unroll
                    for (int m = 0; m < 4; ++m) { const int row = row0 + ai * HALF + m * 16; const int pos = row & (SEQ - 1); const float pe = KPESS[row];
                        const u32x2 w1 = *(const u32x2*)(PROJ + (size_t)row * DINP + PC_KPE + 4 * fq), w2 = *(const u32x2*)(PROJ + (size_t)row * DINP + PC_KPE + 16 + 4 * fq);
                        const f32x4 k1 = (f32x4){bflo(w1.x), bfhi(w1.x), bflo(w1.y), bfhi(w1.y)} * g1, k2 = (f32x4){bflo(w2.x), bfhi(w2.x), bflo(w2.y), bfhi(w2.y)} * g2;
                        const f32x4 c4 = *(const f32x4*)(cosB + pos * 16 + 4 * fq), s4 = *(const f32x4*)(sinB + pos * 16 + 4 * fq);
                        const f32x4 y1 = k1 * c4 - k2 * s4, y2 = k2 * c4 + k1 * s4;
#pragma unroll
                        for (int bj = 0; bj < 2; ++bj) { const float r = KV_RS(ai, m, bj, pe); bf16_t* rp = KB2 + (size_t)row * 768 + (2 * u.pn + bj) * 96 + 64 + 4 * fq;
                            *(u32x2*)rp = (u32x2){cvt_pk_bf16(y1[0] * r, y1[1] * r), cvt_pk_bf16(y1[2] * r, y1[3] * r)}; *(u32x2*)(rp + 16) = (u32x2){cvt_pk_bf16(y2[0] * r, y2[1] * r), cvt_pk_bf16(y2[2] * r, y2[3] * r)}; } } }
        }
    }
};
#undef QB_RS
#undef KV_RS
template <bool ADD> struct EpiGate {
    bf16_t* O; const bf16_t* G; int ldg; unsigned char* MF8;
    __device__ __forceinline__ void operator()(EPI_ARGS) const {
        const int row0 = u.pm * BM + wr * 64 + fr, col0 = u.pn * BM + wc * 32 + 8 * fq;
#pragma unroll
        for (int ai = 0; ai < 2; ++ai)
#pragma unroll
            for (int m = 0; m < 4; ++m) { const size_t r = (size_t)(row0 + ai * HALF + m * 16);
#pragma unroll
                for (int bj = 0; bj < 2; ++bj) { const int c = col0 + bj * HALF;
                    f32x4 g0, g1; unpack8(*(const u32x4*)(G + r * ldg + c), g0, g1);
                    f32x4 v0 = acc[ai][bj][m][0] * g0, v1 = acc[ai][bj][m][1] * g1;
                    if (ADD) { f32x4 o0, o1; unpack8(*(const u32x4*)(O + r * DM + c), o0, o1); v0 += o0; v1 += o1;
                        *(u32x2*)(MF8 + r * DM + c) = (u32x2){pack4_fp8(v0[0], v0[1], v0[2], v0[3]), pack4_fp8(v1[0], v1[1], v1[2], v1[3])}; }
                    else *(u32x4*)(O + r * DM + c) = pack8(v0, v1); } }
    }
};

struct BranchOrder {
    StaticOrder so;
    __device__ bool next(int i, Unit& u) const { if (i >= 2) return false; if (!so.next(0, u)) return false; u.e = i; u.aofs = i * 512; u.pb = u.pn + 8 * i; return true; }
};
struct EpiGateAB {
    bf16_t* O; const bf16_t* Ga; const bf16_t* Gb; int ldg; unsigned char* MF8;
    __device__ __forceinline__ void operator()(EPI_ARGS) const {
        if (u.e == 0) { EpiGate<false> E{O, Ga, ldg, nullptr}; E(acc, u, wr, wc, fr, fq); }
        else { asm volatile("s_waitcnt vmcnt(0)" ::: "memory");
               EpiGate<true> E{O, Gb, ldg, MF8}; E(acc, u, wr, wc, fr, fq); }
    }
};
struct EpiResF32 {
    const float* base; bf16_t* out; float* ssp;
    __device__ __forceinline__ void operator()(EPI_ARGS) const {
        const int row0 = u.pm * BM + wr * 64 + fr, col0 = u.pn * BM + wc * 32 + 8 * fq;
#pragma unroll
        for (int ai = 0; ai < 2; ++ai)
#pragma unroll
            for (int m = 0; m < 4; ++m) { const size_t r = (size_t)(row0 + ai * HALF + m * 16); float ss = 0.f;
#pragma unroll
                for (int bj = 0; bj < 2; ++bj) { const size_t off = r * DM + col0 + bj * HALF;
                    const f32x4 b0 = *(const f32x4*)(base + off), b1 = *(const f32x4*)(base + off + 4);
                    const f32x4 y0 = b0 + acc[ai][bj][m][0], y1 = b1 + acc[ai][bj][m][1];
                    *(u32x4*)(out + off) = pack8(y0, y1);
                    ss += (y0[0] * y0[0] + y0[1] * y0[1]) + (y0[2] * y0[2] + y0[3] * y0[3]) + (y1[0] * y1[0] + y1[1] * y1[1]) + (y1[2] * y1[2] + y1[3] * y1[3]); }
                ss += __shfl_xor(ss, 16); ss += __shfl_xor(ss, 32);
                if (fq == 0) ssp[r * 16 + u.pn * 4 + wc] = ss; }
    }
};
struct EpiSwiglu {
    unsigned char* O; const float* bias;
    __device__ __forceinline__ void operator()(EPI_ARGS) const {
        const int row0 = u.pm * BM + wr * 64 + fr, j0 = u.pn * HALF + wc * 32 + 8 * fq;
        const float* be = bias + (size_t)u.e * 2048;
        f32x4 bg[2], bu[2];
#pragma unroll
        for (int n = 0; n < 2; ++n) { bg[n] = *(const f32x4*)(be + j0 + 4 * n); bu[n] = *(const f32x4*)(be + 1024 + j0 + 4 * n); }
#pragma unroll
        for (int ai = 0; ai < 2; ++ai)
#pragma unroll
            for (int m = 0; m < 4; ++m) { unsigned char* rowp = O + (size_t)(row0 + ai * HALF + m * 16) * DEXP + j0;
                f32x4 o[2];
#pragma unroll
                for (int n = 0; n < 2; ++n) { const f32x4 gv = acc[ai][0][m][n] + bg[n], uv = acc[ai][1][m][n] + bu[n];
#pragma unroll
                    for (int i = 0; i < 4; ++i) { const float gg = fminf(gv[i], 7.0f), uu = fminf(fmaxf(uv[i], -7.0f), 7.0f);
                        o[n][i] = (uu + 1.0f) * gg * __builtin_amdgcn_rcpf(1.0f + __builtin_amdgcn_exp2f(-1.702f * LOG2E * gg)); } }
                *(u32x2*)rowp = (u32x2){pack4_fp8(o[0][0], o[0][1], o[0][2], o[0][3]), pack4_fp8(o[1][0], o[1][1], o[1][2], o[1][3])}; }
    }
};
struct EpiFinal {
    float* out; const bf16_t* PP; const bf16_t* X2;
    __device__ __forceinline__ void operator()(EPI_ARGS) const {
        const int row0 = u.pm * BM + wr * 64 + fr, col0 = u.pn * BM + wc * 32 + 8 * fq;
#pragma unroll
        for (int ai = 0; ai < 2; ++ai)
#pragma unroll
            for (int m = 0; m < 4; ++m) { const size_t r = (size_t)(row0 + ai * HALF + m * 16);
#pragma unroll
                for (int bj = 0; bj < 2; ++bj) { const size_t off = r * DM + col0 + bj * HALF;
                    f32x4 p0, p1, b0, b1; unpack8(*(const u32x4*)(PP + off), p0, p1); unpack8(*(const u32x4*)(X2 + off), b0, b1);
                    *(f32x4*)(out + off) = b0 + sig4(acc[ai][bj][m][0]) * p0; *(f32x4*)(out + off + 4) = b1 + sig4(acc[ai][bj][m][1]) * p1; } }
    }
};
}

namespace att {
__device__ __forceinline__ int crow(int r, int hi) { return (r & 3) + 8 * (r >> 2) + 4 * hi; }
__device__ __forceinline__ void glds16(const void* gsrc, unsigned lds_dst) { unsigned keep;
    asm volatile("s_mov_b32 %0, m0\n\ts_mov_b32 m0, %2\n\ts_nop 0\n\tglobal_load_lds_dwordx4 %1, off\n\ts_mov_b32 m0, %0" : "=&s"(keep) : "v"(gsrc), "s"(lds_dst) : "memory"); }
__device__ __forceinline__ s16x4 vtr(const LAS unsigned char* p) { return __builtin_bit_cast(s16x4, __builtin_amdgcn_ds_read_tr16_b64_v4i16((LAS s16x4*)p)); }
#define MX3(a, b, c) __builtin_fmaxf(__builtin_fmaxf((a), (b)), (c))
constexpr int VSLOT = 8192, OST_BYTES = NWAVES * 4096, WSF_BYTES = NWAVES * 256;

template <int DQK, bool MOBA>
__device__ __forceinline__ void attn_unit(int b, int qb, const bf16_t* Qh, int ldq, const bf16_t* Kh, int ldk, const bf16_t* Vh, int ldv, unsigned char* Oh, int ldo, const float* kmean, LAS unsigned char* shm, int wave) {
    constexpr int ND = DQK / 16, NCH = DQK / 8, KSLOT = NCH * 1024;
    constexpr int LDS_K = 0, LDS_V = 2 * KSLOT, LDS_WS = LDS_V + 2 * VSLOT, LDS_OST = LDS_WS + WSF_BYTES;
    static_assert(LDS_OST + OST_BYTES <= RING_BYTES, "attention LDS");
    int lane = lane_id(); asm volatile("" : "+v"(lane));
    const int r32 = lane & 31, hi = lane >> 5; const int wid = wave;
    const long rowbase = (long)b * SEQ; const int q0 = qb * 256;
    const unsigned lds0 = (unsigned)(uintptr_t)shm;
    LAS float* wsf = (LAS float*)(shm + LDS_WS) + wid * 64;
    const int NT = 4 * (qb + 1);
    const bf16_t* ksrc0 = Kh + (rowbase + lane) * ldk + wid * 8;
    const bf16_t* vsrc0 = Vh + (rowbase + 16 * (wid & 3) + (lane >> 2)) * ldv + (wid >> 2) * 32 + (lane & 3) * 8;
#define ATT_DMA(kt, s) do { const long ro_ = (long)(kt) * 64; \
        glds16(ksrc0 + ro_ * ldk, (unsigned)__builtin_amdgcn_readfirstlane(lds0 + LDS_K + (s) * KSLOT + wid * 1024)); \
        if (NCH > 8 && wid < NCH - 8) glds16(ksrc0 + ro_ * ldk + 64, (unsigned)__builtin_amdgcn_readfirstlane(lds0 + LDS_K + (s) * KSLOT + (wid + 8) * 1024)); \
        glds16(vsrc0 + ro_ * ldv, (unsigned)__builtin_amdgcn_readfirstlane(lds0 + LDS_V + (s) * VSLOT + wid * 1024)); } while (0)
#define ATT_TILE(i) (MOBA ? ((i) < 4 ? 4 * qb + (i) : (i) - 4) : (i))
    ATT_DMA(ATT_TILE(0), 0);
    const bf16_t* Qw = Qh + (rowbase + q0 + wid * 32 + r32) * ldq + hi * 8;
    bf16x8 qr[ND];
#pragma unroll
    for (int d0 = 0; d0 < ND; ++d0) qr[d0] = *(const bf16x8*)(Qw + d0 * 16);
    unsigned bmask = 0xffffffffu;
    if (MOBA) {
        bmask = 1u << qb;
        if (qb <= 3) bmask |= (1u << qb) - 1u;
        else {
            float gsc[7];
#pragma unroll
            for (int n = 0; n < 7; ++n) { float s = 0.f;
                if (n < qb) {
#pragma unroll
                    for (int d0 = 0; d0 < ND; ++d0) { const float* km = kmean + n * 64 + d0 * 16 + hi * 8; const f32x4 k0 = *(const f32x4*)km, k1 = *(const f32x4*)(km + 4);
                        s += bf2f((unsigned short)qr[d0][0]) * k0[0] + bf2f((unsigned short)qr[d0][1]) * k0[1] + bf2f((unsigned short)qr[d0][2]) * k0[2] + bf2f((unsigned short)qr[d0][3]) * k0[3]
                           + bf2f((unsigned short)qr[d0][4]) * k1[0] + bf2f((unsigned short)qr[d0][5]) * k1[1] + bf2f((unsigned short)qr[d0][6]) * k1[2] + bf2f((unsigned short)qr[d0][7]) * k1[3]; }
                    s += __shfl_xor(s, 32);
                } else s = -INFINITY;
                gsc[n] = s; }
#pragma unroll
            for (int pass = 0; pass < 3; ++pass) { float best = -INFINITY; int bi = 0;
#pragma unroll
                for (int n = 0; n < 7; ++n) { const bool ok = (n < qb) && !((bmask >> n) & 1u) && (gsc[n] > best); best = ok ? gsc[n] : best; bi = ok ? n : bi; }
                bmask |= 1u << bi; }
        }
    }
    asm volatile("s_waitcnt vmcnt(0)" ::: "memory");
#pragma unroll
    for (int d0 = 0; d0 < ND; ++d0) asm volatile("" : "+v"(qr[d0]));
    float mhat = 0.f, l_reg = 0.f; f32x16 o[2]; o[0] = f32x16{}; o[1] = f32x16{}; f32x16 negm = f32x16{}; asm volatile("" : "+v"(negm));
    const int qrel = wid * 32 + r32;
    const LAS unsigned char* kp0 = shm + LDS_K + hi * 1024 + r32 * 16;
    const LAS unsigned char* vp0 = shm + LDS_V + ((lane >> 4) & 1) * 32 + (lane & 3) * 8 + (4 * hi + ((lane & 15) >> 2)) * 64;
    for (int i = 0; i < NT; ++i) {
        const int s = i & 1, kt = ATT_TILE(i);
        asm volatile("s_waitcnt vmcnt(0) lgkmcnt(0)\n\ts_barrier" ::: "memory");
        if (i + 1 < NT) ATT_DMA(ATT_TILE(i + 1), s ^ 1);
        f32x16 cin = negm;
        if (MOBA) { if (i >= 4 && !((bmask >> (kt >> 2)) & 1u)) {
#pragma unroll
            for (int r = 0; r < 16; ++r) cin[r] = -INFINITY; } }
        f32x16 p0, p1;
        { const LAS unsigned char* kb = kp0 + s * KSLOT; bf16x8 kf[2 * ND];
#pragma unroll
            for (int d0 = 0; d0 < ND; ++d0) { kf[2 * d0] = *(const LAS bf16x8*)(kb + d0 * 2048); kf[2 * d0 + 1] = *(const LAS bf16x8*)(kb + d0 * 2048 + 512); }
            __builtin_amdgcn_sched_barrier(0);
#pragma unroll
            for (int d0 = 0; d0 < ND; ++d0) {
                if (d0 == 0) { p0 = __builtin_amdgcn_mfma_f32_32x32x16_bf16(kf[0], qr[0], cin, 0, 0, 0); p1 = __builtin_amdgcn_mfma_f32_32x32x16_bf16(kf[1], qr[0], cin, 0, 0, 0); }
                else { p0 = __builtin_amdgcn_mfma_f32_32x32x16_bf16(kf[2 * d0], qr[d0], p0, 0, 0, 0); p1 = __builtin_amdgcn_mfma_f32_32x32x16_bf16(kf[2 * d0 + 1], qr[d0], p1, 0, 0, 0); } } }
        if (kt >= 4 * qb) { const int kb = 64 * (kt - 4 * qb) + 4 * hi;
#pragma unroll
            for (int r = 0; r < 16; ++r) { const int kv = kb + (r & 3) + 8 * (r >> 2); if (kv > qrel) p0[r] = -INFINITY; if (kv + 32 > qrel) p1[r] = -INFINITY; } }
        bool resc = false;
        { float a = MX3(p0[0], p0[1], p1[0]), bb = MX3(p0[2], p0[3], p1[1]); a = MX3(a, p1[2], p1[3]);
#pragma unroll
            for (int r = 4; r < 16; r += 4) { a = MX3(a, p0[r], p0[r + 1]); bb = MX3(bb, p0[r + 2], p0[r + 3]); a = MX3(a, p1[r], p1[r + 1]); bb = MX3(bb, p1[r + 2], p1[r + 3]); }
            float rm = __builtin_fmaxf(a, bb); rm = __builtin_fmaxf(rm, __shfl_xor(rm, 32));
            const bool first = (i == 0);
            if (first || __any(rm > 6.0f)) {
                const float dl = first ? rm : __builtin_fmaxf(rm, 0.f); mhat += dl;
#pragma unroll
                for (int r = 0; r < 16; ++r) { p0[r] -= dl; p1[r] -= dl; }
#pragma unroll
                for (int r = 0; r < 16; ++r) negm[r] = -mhat;
                asm volatile("" : "+v"(negm));
                const float f = __builtin_amdgcn_exp2f(-dl); l_reg *= f; if (hi == 0) wsf[r32] = f; resc = true; } }
        float sacc = 0.f;
#pragma unroll
        for (int r = 0; r < 16; ++r) { p0[r] = __builtin_amdgcn_exp2f(p0[r]); p1[r] = __builtin_amdgcn_exp2f(p1[r]); sacc += p0[r] + p1[r]; }
        l_reg += sacc;
        u32x4 pw0, pw1, pw2, pw3;
        pw0 = (u32x4){cvt_pk_bf16(p0[0], p0[1]), cvt_pk_bf16(p0[2], p0[3]), cvt_pk_bf16(p0[4], p0[5]), cvt_pk_bf16(p0[6], p0[7])};
        pw1 = (u32x4){cvt_pk_bf16(p0[8], p0[9]), cvt_pk_bf16(p0[10], p0[11]), cvt_pk_bf16(p0[12], p0[13]), cvt_pk_bf16(p0[14], p0[15])};
        pw2 = (u32x4){cvt_pk_bf16(p1[0], p1[1]), cvt_pk_bf16(p1[2], p1[3]), cvt_pk_bf16(p1[4], p1[5]), cvt_pk_bf16(p1[6], p1[7])};
        pw3 = (u32x4){cvt_pk_bf16(p1[8], p1[9]), cvt_pk_bf16(p1[10], p1[11]), cvt_pk_bf16(p1[12], p1[13]), cvt_pk_bf16(p1[14], p1[15])};
        if (resc) {
#pragma unroll
            for (int d_ = 0; d_ < 2; ++d_)
#pragma unroll
                for (int r = 0; r < 16; ++r) o[d_][r] *= wsf[crow(r, hi)];
        }
        { const LAS unsigned char* vp = vp0 + s * VSLOT;
#pragma unroll
            for (int d0 = 0; d0 < 2; ++d0) {
                s16x4 lo[4], hh[4];
#pragma unroll
                for (int ks = 0; ks < 4; ++ks) { lo[ks] = vtr(vp + d0 * 4096 + ks * 1024); hh[ks] = vtr(vp + d0 * 4096 + ks * 1024 + 512); }
                __builtin_amdgcn_sched_barrier(0);
#define PKV(k) (bf16x8){lo[k][0], lo[k][1], lo[k][2], lo[k][3], hh[k][0], hh[k][1], hh[k][2], hh[k][3]}
                o[d0] = __builtin_amdgcn_mfma_f32_32x32x16_bf16(__builtin_bit_cast(bf16x8, pw0), PKV(0), o[d0], 0, 0, 0);
                o[d0] = __builtin_amdgcn_mfma_f32_32x32x16_bf16(__builtin_bit_cast(bf16x8, pw1), PKV(1), o[d0], 0, 0, 0);
                o[d0] = __builtin_amdgcn_mfma_f32_32x32x16_bf16(__builtin_bit_cast(bf16x8, pw2), PKV(2), o[d0], 0, 0, 0);
                o[d0] = __builtin_amdgcn_mfma_f32_32x32x16_bf16(__builtin_bit_cast(bf16x8, pw3), PKV(3), o[d0], 0, 0, 0);
#undef PKV
            } }
    }
    l_reg += __shfl_xor(l_reg, 32);
    if (hi == 0) wsf[32 + r32] = l_reg;
    float rli[16];
#pragma unroll
    for (int r = 0; r < 16; ++r) rli[r] = __builtin_amdgcn_rcpf(wsf[32 + crow(r, hi)]);
    unsigned char* Ow = (unsigned char*)Oh + (rowbase + q0 + wid * 32) * ldo;
    { LAS unsigned char* stg = shm + LDS_OST + wid * 2048;
#pragma unroll
        for (int r = 0; r < 16; ++r) { const int orow = crow(r, hi);
#pragma unroll
            for (int d0 = 0; d0 < 2; ++d0) stg[orow * 64 + d0 * 32 + r32] = (unsigned char)(pack4_fp8(o[d0][r] * rli[r], 0.f, 0.f, 0.f) & 0xffu); }
#pragma unroll
        for (int i = 0; i < 2; ++i) { const int row = i * 16 + (lane >> 2), ch = lane & 3; const u32x4 v = *(const LAS u32x4*)(stg + row * 64 + ch * 16); *(u32x4*)(Ow + (long)row * ldo + ch * 16) = v; } }
    asm volatile("s_waitcnt lgkmcnt(0)\n\ts_barrier" ::: "memory");
#undef ATT_DMA
#undef ATT_TILE
}
#undef MX3
}

#define XB_TMO      128
#define XB_XCNT(j)  (256  + 64 * (j))
#define XB_XSUB(j)  (1280 + 64 * (j))
#define XB_XGEN(j)  (2304 + 64 * (j))
#define XB_TOP      3328
#define XB_TOPGEN   3392
#define XCD_BAR_WORDS 3456
#define XB_SPIN_CAP (1u << 22)
__device__ __forceinline__ unsigned xb_ld(unsigned* p)              { return __hip_atomic_load(p, __ATOMIC_RELAXED, __HIP_MEMORY_SCOPE_AGENT); }
__device__ __forceinline__ unsigned xb_add(unsigned* p, unsigned v) { return __hip_atomic_fetch_add(p, v, __ATOMIC_RELAXED, __HIP_MEMORY_SCOPE_AGENT); }
__device__ __forceinline__ unsigned xb_xcc_id() { return (unsigned)__builtin_amdgcn_s_getreg((3 << 11) | 20) & 0xFu; }
#define XB_SPIN(cond, bar) do { unsigned _sp = 0; while (cond) { __builtin_amdgcn_s_sleep(1); \
    if ((++_sp & 255u) == 0u) { if (xb_ld(&(bar)[XB_TMO])) break; if (_sp > XB_SPIN_CAP) { atomicAdd(&(bar)[XB_TMO], 1u); break; } } } } while (0)
struct XcdBarrier { unsigned* bar; unsigned x; volatile LAS unsigned* st; int wave; };
__device__ __forceinline__ XcdBarrier xcd_barrier_post(unsigned* bar, volatile LAS unsigned* st, int wave) {
    XcdBarrier b; b.bar = bar; b.x = xb_xcc_id(); b.st = st; b.wave = wave;
    if (wave == 0 && lane_id() == 0) (void)xb_add(&bar[XB_XCNT(b.x)], 1u);
    return b;
}
__device__ __forceinline__ void xcd_barrier_complete(unsigned* bar, unsigned x, unsigned& nloc, unsigned& nx) {
    const unsigned G = gridDim.x * gridDim.y * gridDim.z;
    unsigned sum, cnt, mine, sp = 0u;
    for (;;) {
        sum = 0u; cnt = 0u; mine = 0u;
#pragma unroll
        for (unsigned j = 0; j < 16; ++j) { const unsigned c = xb_ld(&bar[XB_XCNT(j)]); sum += c; cnt += (c > 0u) ? 1u : 0u; mine = (j == x) ? c : mine; }
        if (sum == G) break;
        __builtin_amdgcn_s_sleep(1);
        if ((++sp & 255u) == 0u) { if (xb_ld(&bar[XB_TMO])) break; if (sp > XB_SPIN_CAP) { atomicAdd(&bar[XB_TMO], 1u); break; } }
    }
    nloc = mine > 0u ? mine : 1u; nx = cnt > 0u ? cnt : 1u;
}
__device__ __forceinline__ void xcd_barrier(const XcdBarrier& b) {
    asm volatile("s_waitcnt vmcnt(0)" ::: "memory");
    __syncthreads();
    if (b.wave == 0 && lane_id() == 0) {
        unsigned* bar = b.bar;
        __builtin_amdgcn_s_waitcnt(0);
        unsigned nloc = b.st[0], nx = b.st[1];
        if (nloc == 0u) { xcd_barrier_complete(bar, b.x, nloc, nx); b.st[0] = nloc; b.st[1] = nx; }
        const unsigned old = xb_add(&bar[XB_XSUB(b.x)], 1u);
        const unsigned gen = old / nloc;
        if (old + 1u == (gen + 1u) * nloc) {
            __builtin_amdgcn_fence(__ATOMIC_RELEASE, "agent");
            asm volatile("s_waitcnt vmcnt(0)" ::: "memory");
            const unsigned og = xb_add(&bar[XB_TOP], 1u);
            const unsigned tg = og / nx;
            if (og + 1u == (tg + 1u) * nx) xb_add(&bar[XB_TOPGEN], 1u);
            else XB_SPIN(xb_ld(&bar[XB_TOPGEN]) == tg, bar);
            __builtin_amdgcn_fence(__ATOMIC_ACQUIRE, "agent");
            xb_add(&bar[XB_XGEN(b.x)], 1u);
            asm volatile("s_waitcnt vmcnt(0)" ::: "memory");
        } else {
            XB_SPIN(xb_ld(&bar[XB_XGEN(b.x)]) == gen, bar);
            __builtin_amdgcn_fence(__ATOMIC_ACQUIRE, "agent");
            asm volatile("s_waitcnt vmcnt(0)" ::: "memory");
        }
    }
    __syncthreads();
}

struct Params { const float* in[25]; float* out; unsigned char* ws; int ph_lo, ph_hi; };
enum { I_X = 0, I_P, I_GMIX, I_WIN, I_MQN, I_MKN, I_QLATN, I_WUQ, I_KVLATN, I_WUKV, I_MLAQN, I_MLAKN, I_WA, I_WB, I_WO, I_GFFN, I_WR, I_BR, I_WGU, I_BGU, I_WD, I_BD, I_GPLE, I_WPG, I_WPP };
constexpr int NPHASE = 16;

struct Frame {
    LAS unsigned char* lds; int vcu, G, wave;
    const Params* P; unsigned char* ws;
};
struct Ids { int tid, lane, wave; };
#define PHASE_IDS() Ids I_; { int l_ = lane_id(); asm volatile("" : "+v"(l_)); I_.lane = l_; I_.wave = F.wave; I_.tid = F.wave * 64 + l_; }

#ifdef TPROBE_A
#define STAMP(k) do { if (blockIdx.x == 0 && F.wave == 0 && lane_id() == 0) ((volatile unsigned long long*)(ws + WS_ERR))[k] = __builtin_amdgcn_s_memrealtime(); } while (0)
#else
#define STAMP(k) do {} while (0)
#endif
__device__ __forceinline__ int rowmap(int mode, int c) {
    if (mode == 1) {
        if (c < 1024) { const int base = c & 512, s_ = c & 511, h = s_ >> 6, d = s_ & 63; return base + 256 * (h >> 2) + 128 * (d >> 5) + 32 * (h & 3) + (d & 31); }
        return c < 1952 ? c : c + 96; }
    if (mode == 2) return c < 1024 ? 256 * (c >> 7) + (c & 127) : 256 * ((c - 1024) >> 7) + 128 + ((c - 1024) & 127);
    if (mode == 3) {
        const int h = c / 96, d = c % 96; int t;
        if (d < 64) t = d; else if (d < 80) { const int i = d - 64; t = 64 + 8 * (i >> 2) + (i & 3); } else { const int i = d - 80; t = 64 + 8 * (i >> 2) + 4 + (i & 3); }
        return 128 * h + t; }
    return c;
}
__device__ __forceinline__ void tr_item64(const float* W, int ldw, int N, int k0, int n0, bf16_t* dst, int ldd, int mode, LAS float* scr, int lane) {
    const int r = lane >> 4, c4 = lane & 15; const bool inb = (n0 + 4 * c4) < N;
    f32x4 v[16];
#pragma unroll
    for (int i = 0; i < 16; ++i) v[i] = inb ? __builtin_nontemporal_load((const f32x4*)(W + (size_t)(k0 + 4 * i + r) * ldw + n0 + 4 * c4)) : (f32x4){0.f, 0.f, 0.f, 0.f};
#pragma unroll
    for (int i = 0; i < 16; ++i) { LAS float* p = scr + (4 * i + r) * 65 + 4 * c4; p[0] = v[i].x; p[1] = v[i].y; p[2] = v[i].z; p[3] = v[i].w; }
    asm volatile("s_waitcnt lgkmcnt(0)" ::: "memory");
    const int c = lane & 7;
#pragma unroll
    for (int j = 0; j < 8; ++j) { const int n = (lane >> 3) + 8 * j; const LAS float* sp = scr + (8 * c) * 65 + n;
        u32x4 o; o.x = cvt_pk_bf16(sp[0 * 65], sp[1 * 65]); o.y = cvt_pk_bf16(sp[2 * 65], sp[3 * 65]); o.z = cvt_pk_bf16(sp[4 * 65], sp[5 * 65]); o.w = cvt_pk_bf16(sp[6 * 65], sp[7 * 65]);
        if (n0 + n < N) *(u32x4*)(dst + (size_t)rowmap(mode, n0 + n) * ldd + k0 + 8 * c) = o; }
    asm volatile("s_waitcnt lgkmcnt(0)" ::: "memory");
}

__device__ __forceinline__ void tr_item_f8(const float* W, int ldw, int k0, int n0, unsigned char* dst, int ldd, int mode, LAS float* scr, int lane) {
    const int r = lane >> 3, c4 = lane & 7;
    f32x4 v[16];
#pragma unroll
    for (int i = 0; i < 16; ++i) v[i] = __builtin_nontemporal_load((const f32x4*)(W + (size_t)(k0 + 8 * i + r) * ldw + n0 + 4 * c4));
#pragma unroll
    for (int i = 0; i < 16; ++i) { LAS float* p = scr + (8 * i + r) * 33 + 4 * c4; p[0] = v[i].x * 64.f; p[1] = v[i].y * 64.f; p[2] = v[i].z * 64.f; p[3] = v[i].w * 64.f; }
    asm volatile("s_waitcnt lgkmcnt(0)" ::: "memory");
    const int c = lane & 7;
#pragma unroll
    for (int j = 0; j < 4; ++j) { const int n = (lane >> 3) + 8 * j; const LAS float* sp = scr + (16 * c) * 33 + n;
        u32x4 o; o.x = pack4_fp8(sp[0 * 33], sp[1 * 33], sp[2 * 33], sp[3 * 33]); o.y = pack4_fp8(sp[4 * 33], sp[5 * 33], sp[6 * 33], sp[7 * 33]);
        o.z = pack4_fp8(sp[8 * 33], sp[9 * 33], sp[10 * 33], sp[11 * 33]); o.w = pack4_fp8(sp[12 * 33], sp[13 * 33], sp[14 * 33], sp[15 * 33]);
        __builtin_nontemporal_store(o, (u32x4*)(dst + (size_t)rowmap(mode, n0 + n) * ldd + k0 + 16 * c)); }
    asm volatile("s_waitcnt lgkmcnt(0)" ::: "memory");
}

__device__ __forceinline__ void phase0(Frame& F) {
    PHASE_IDS();
    const Params& P = *F.P; unsigned char* ws = F.ws;
    LAS float* scr = (LAS float*)(F.lds + I_.wave * 16896);
    const int gw = F.vcu * NWAVES + I_.wave, NGW = F.G * NWAVES;
    constexpr int I_GU = 32 * 8 * 64, I_DN = 32 * 8 * 32, I_IN = 16 * 31, I_ING = 8 * 64, I_UQ = 4 * 12, I_UKV = 2 * 16, I_A = 8 * 16, I_O = 16 * 16, I_PP = 4 * 16;
    constexpr int I_PG = 8 * 32;
    constexpr int NITEMS = I_GU + I_DN + I_IN + I_ING + I_UQ + I_UKV + 2 * I_A + I_O + I_PG + I_PP;
    for (int it = gw; it < NITEMS; it += NGW) {
        int r = it;
        if (r < I_GU) { const int e = r >> 9, q = r & 511, kb = q >> 6, g = q & 63;
            tr_item_f8(P.in[I_WGU] + (size_t)e * 1024 * 2048, 2048, 128 * kb, 32 * g, ws + WS_W1 + (size_t)e * 2048 * 1024, 1024, 2, scr, I_.lane); continue; } r -= I_GU;
        if (r < I_DN) { const int e = r >> 8, q = r & 255, kb = q >> 5, g = q & 31;
            tr_item_f8(P.in[I_WD] + (size_t)e * 1024 * 1024, 1024, 128 * kb, 32 * g, ws + WS_W2 + (size_t)e * 1024 * 1024, 1024, 0, scr, I_.lane); continue; } r -= I_DN;
        if (r < I_IN) { const int kb = r / 31, g = r % 31; tr_item64(P.in[I_WIN], DIN, 1952, 64 * kb, 64 * g, (bf16_t*)(ws + WS_WIN), 1024, 1, scr, I_.lane); continue; } r -= I_IN;
        if (r < I_ING) { const int kb = r >> 6, g = r & 63; tr_item_f8(P.in[I_WIN] + 1952, DIN, 128 * kb, 32 * g, ws + WS_WINF8, 1024, 0, scr, I_.lane); continue; } r -= I_ING;
        if (r < I_UQ) { const int kb = r / 12, g = r % 12; tr_item64(P.in[I_WUQ], 768, 768, 64 * kb, 64 * g, (bf16_t*)(ws + WS_WUQ), 256, 3, scr, I_.lane); continue; } r -= I_UQ;
        if (r < I_UKV) { const int kb = r / 16, g = r % 16; tr_item64(P.in[I_WUKV], 1024, 1024, 64 * kb, 64 * g, (bf16_t*)(ws + WS_WUKV), 128, 0, scr, I_.lane); continue; } r -= I_UKV;
        if (r < I_A) { const int kb = r >> 5, g = r & 31; tr_item_f8(P.in[I_WA], 1024, 128 * kb, 32 * g, ws + WS_WA, 512, 0, scr, I_.lane); continue; } r -= I_A;
        if (r < I_A) { const int kb = r >> 5, g = r & 31; tr_item_f8(P.in[I_WB], 1024, 128 * kb, 32 * g, ws + WS_WB, 512, 0, scr, I_.lane); continue; } r -= I_A;
        if (r < I_PG) { const int kb = r >> 5, g = r & 31; tr_item_f8(P.in[I_WO], 1024, 128 * kb, 32 * g, ws + WS_WO, 1024, 0, scr, I_.lane); continue; } r -= I_PG;
        if (r < I_PG) { const int kb = r >> 5, g = r & 31; tr_item_f8(P.in[I_WPG], 1024, 128 * kb, 32 * g, ws + WS_WPG, 1024, 0, scr, I_.lane); continue; } r -= I_PG;
        { const int kb = r / 16, g = r % 16; tr_item64(P.in[I_WPP], 1024, 1024, 64 * kb, 64 * g, (bf16_t*)(ws + WS_WPP), 256, 0, scr, I_.lane); }
    }
    STAMP(20);
    { const f32x4* gp = (const f32x4*)P.in[I_GMIX] + I_.lane; f32x4 gv[4];
#pragma unroll
        for (int j = 0; j < 4; ++j) gv[j] = gp[64 * j];
        for (int m0 = gw * 4; m0 < NTOK; m0 += NGW * 4) { f32x4 v[4][4];
#pragma unroll
            for (int q = 0; q < 4; ++q) { const f32x4* xr = (const f32x4*)(P.in[I_X] + (size_t)(m0 + q) * DM) + I_.lane;
#pragma unroll
                for (int j = 0; j < 4; ++j) v[q][j] = xr[64 * j]; }
#pragma unroll
            for (int q = 0; q < 4; ++q) { float s = 0.f;
#pragma unroll
                for (int j = 0; j < 4; ++j) s += (v[q][j].x * v[q][j].x + v[q][j].y * v[q][j].y) + (v[q][j].z * v[q][j].z + v[q][j].w * v[q][j].w);
                const float rstd = 1.0f / sqrtf(wave_sum(s) * (1.f / DM) + EPS);
                u32x2* o8 = (u32x2*)((bf16_t*)(ws + WS_HN) + (size_t)(m0 + q) * DM) + I_.lane; unsigned* o4 = (unsigned*)(ws + WS_HNF8 + (size_t)(m0 + q) * DM) + I_.lane;
#pragma unroll
                for (int j = 0; j < 4; ++j) { const f32x4 y = v[q][j] * rstd * gv[j]; o8[64 * j] = (u32x2){cvt_pk_bf16(y.x, y.y), cvt_pk_bf16(y.z, y.w)}; o4[64 * j] = pack4_fp8(y.x, y.y, y.z, y.w); } } } }
    STAMP(21);
    { float* km = (float*)(ws + WS_KMEAN); for (int i = F.vcu * NTHREADS + I_.tid; i < 8 * 8 * 8 * 64; i += F.G * NTHREADS) km[i] = 0.f; }
    { const size_t n4 = (size_t)NTOK * 256 / 4; const f32x4* pp = (const f32x4*)P.in[I_P]; u32x2* po = (u32x2*)(ws + WS_PB); const size_t T = (size_t)F.G * NTHREADS;
        for (size_t i = (size_t)F.vcu * NTHREADS + I_.tid; i < n4; i += 4 * T) { f32x4 v[4];
#pragma unroll
            for (int q = 0; q < 4; ++q) v[q] = __builtin_nontemporal_load(pp + i + q * T);
#pragma unroll
            for (int q = 0; q < 4; ++q) po[i + q * T] = (u32x2){cvt_pk_bf16(v[q].x, v[q].y), cvt_pk_bf16(v[q].z, v[q].w)}; } }
    STAMP(22);
    { float* tab = (float*)(ws + WS_ROPE);
        for (int i = F.vcu * NTHREADS + I_.tid; i < 2048 * 48; i += F.G * NTHREADS) {
            int pos, j, half; float* cdst; float* sdst;
            if (i < 2048 * 32) { pos = i / 32; j = i % 32; half = 32; cdst = tab + i; sdst = tab + 65536 + i; }
            else { const int q = i - 2048 * 32; pos = q / 16; j = q % 16; half = 16; cdst = tab + 131072 + q; sdst = tab + 131072 + 32768 + q; }
            const float inv = powf(10000.0f, -((float)j / (float)half)); const float ang = (float)pos * inv;
            *cdst = cosf(ang); *sdst = sinf(ang); } }
}

__device__ __forceinline__ void phase2(Frame& F) {
    PHASE_IDS();
    const Params& P = *F.P; unsigned char* ws = F.ws;
    const bf16_t* PROJ = (const bf16_t*)(ws + WS_PROJ);
    const float* cosA = (const float*)(ws + WS_ROPE); const float* sinA = cosA + 65536;
    LAS float* kst = (LAS float*)F.lds;
    LAS float* part = kst + 256 * 68;
    for (int it = F.vcu; it < 512; it += F.G) {
        const int b = it >> 6, blk = (it >> 3) & 7, h = it & 7;
        const int sel = I_.lane >> 5, r = I_.wave * 32 + (I_.lane & 31); const int pos = blk * 256 + r; const size_t row = (size_t)b * SEQ + pos;
        const u32x4* src = (const u32x4*)(PROJ + row * DINP + (sel ? PC_KA : PC_QA) + h * 64);
        u32x4 raw[8];
#pragma unroll
        for (int c = 0; c < 8; ++c) raw[c] = src[c];
        float ss = 0.f;
#pragma unroll
        for (int c = 0; c < 8; ++c) { f32x4 a0, a1; pg8::unpack8(raw[c], a0, a1); ss += (a0[0] * a0[0] + a0[1] * a0[1]) + (a0[2] * a0[2] + a0[3] * a0[3]) + (a1[0] * a1[0] + a1[1] * a1[1]) + (a1[2] * a1[2] + a1[3] * a1[3]); }
        const float rstd = 1.0f / sqrtf(ss * (1.f / 64.f) + EPS);
        const float* gn = sel ? P.in[I_MKN] : P.in[I_MQN];
        const float sc = sel ? 1.0f : C2A;
        bf16_t* dst = (bf16_t*)(ws + (sel ? WS_KA2 : WS_QA2)) + row * 512 + h * 64;
#pragma unroll
        for (int c = 0; c < 4; ++c) { f32x4 x1a, x1b, x2a, x2b; pg8::unpack8(raw[c], x1a, x1b); pg8::unpack8(raw[c + 4], x2a, x2b);
            const f32x4 g1a = *(const f32x4*)(gn + 8 * c), g1b = *(const f32x4*)(gn + 8 * c + 4), g2a = *(const f32x4*)(gn + 32 + 8 * c), g2b = *(const f32x4*)(gn + 36 + 8 * c);
            x1a = x1a * g1a * rstd; x1b = x1b * g1b * rstd; x2a = x2a * g2a * rstd; x2b = x2b * g2b * rstd;
            const f32x4 ca = *(const f32x4*)(cosA + pos * 32 + 8 * c), cb = *(const f32x4*)(cosA + pos * 32 + 8 * c + 4), sa = *(const f32x4*)(sinA + pos * 32 + 8 * c), sb = *(const f32x4*)(sinA + pos * 32 + 8 * c + 4);
            const f32x4 y1a = x1a * ca - x2a * sa, y1b = x1b * cb - x2b * sb, y2a = x2a * ca + x1a * sa, y2b = x2b * cb + x1b * sb;
            *(u32x4*)(dst + 8 * c) = pg8::pack8(y1a * sc, y1b * sc); *(u32x4*)(dst + 32 + 8 * c) = pg8::pack8(y2a * sc, y2b * sc);
            if (sel) { LAS f32x4* kr = (LAS f32x4*)(kst + r * 68); kr[2 * c] = y1a; kr[2 * c + 1] = y1b; kr[8 + 2 * c] = y2a; kr[8 + 2 * c + 1] = y2b; } }
        __syncthreads();
        { const int d = I_.tid & 63, pt = I_.tid >> 6; float s = 0.f;
#pragma unroll 8
            for (int rr = 0; rr < 32; ++rr) s += kst[(pt * 32 + rr) * 68 + d];
            part[pt * 64 + d] = s; }
        __syncthreads();
        if (I_.tid < 64) { float s = 0.f;
#pragma unroll
            for (int pt = 0; pt < 8; ++pt) s += part[pt * 64 + I_.tid];
            ((float*)(ws + WS_KMEAN))[(((size_t)b * 8 + h) * 8 + blk) * 64 + I_.tid] = s * (1.f / 256.f); }
        __syncthreads();
    }
    const int gw = F.vcu * NWAVES + I_.wave, NGW = F.G * NWAVES;
    const f32x4 gq = ((const f32x4*)P.in[I_QLATN])[I_.lane]; const f32x2 gk = ((const f32x2*)P.in[I_KVLATN])[I_.lane];
    for (int m0 = gw * 8; m0 < NTOK; m0 += NGW * 8) {
        u32x2 wq[8]; unsigned wk[8];
#pragma unroll
        for (int q = 0; q < 8; ++q) { wq[q] = *((const u32x2*)(PROJ + (size_t)(m0 + q) * DINP + PC_CQ) + I_.lane); wk[q] = *((const unsigned*)(PROJ + (size_t)(m0 + q) * DINP + PC_CKV) + I_.lane); }
#pragma unroll
        for (int r = 0; r < 8; ++r) { const int m = m0 + r;
            const f32x4 q = {bflo(wq[r].x), bfhi(wq[r].x), bflo(wq[r].y), bfhi(wq[r].y)}; const f32x2 k = {bflo(wk[r]), bfhi(wk[r])};
            const float sq = wave_sum((q.x * q.x + q.y * q.y) + (q.z * q.z + q.w * q.w)), sk = wave_sum(k.x * k.x + k.y * k.y);
            const float rq = 1.0f / sqrtf(sq * (1.f / 256.f) + EPS), rk = 1.0f / sqrtf(sk * (1.f / 128.f) + EPS);
            const f32x4 yq = q * rq * gq; const f32x2 yk = k * rk * gk;
            *((u32x2*)((bf16_t*)(ws + WS_CQN) + (size_t)m * 256) + I_.lane) = (u32x2){cvt_pk_bf16(yq.x, yq.y), cvt_pk_bf16(yq.z, yq.w)};
            *((unsigned*)((bf16_t*)(ws + WS_CKVN) + (size_t)m * 128) + I_.lane) = cvt_pk_bf16(yk.x, yk.y); }
    }
}

__device__ __forceinline__ void phase4(Frame& F) {
    PHASE_IDS();
    const Params& P = *F.P; unsigned char* ws = F.ws;
    const bf16_t* PROJ = (const bf16_t*)(ws + WS_PROJ);
    const float* cosB = (const float*)(ws + WS_ROPE) + 131072; const float* sinB = cosB + 32768;
    const int gw = F.vcu * NWAVES + I_.wave, NGW = F.G * NWAVES;
    for (int it = gw; it < (NTOK / 64) * 16; it += NGW) {
        const int h = it & 7, sel = (it >> 3) & 1, rg = it >> 4; const size_t row = (size_t)rg * 64 + I_.lane; const int pos = (int)(row & (SEQ - 1));
        u32x4 raw[12];
        bf16_t* qrow = (bf16_t*)(ws + WS_QB) + row * 768 + h * 96;
        if (sel == 0) {
#pragma unroll
            for (int c = 0; c < 12; ++c) raw[c] = *(const u32x4*)(qrow + 8 * c);
        } else {
            const bf16_t* kn = (const bf16_t*)(ws + WS_KV) + row * 1024 + h * 128; const bf16_t* kp = PROJ + row * DINP + PC_KPE;
#pragma unroll
            for (int c = 0; c < 8; ++c) raw[c] = *(const u32x4*)(kn + 8 * c);
#pragma unroll
            for (int c = 0; c < 4; ++c) raw[8 + c] = *(const u32x4*)(kp + 8 * c);
        }
        float ss = 0.f;
#pragma unroll
        for (int c = 0; c < 12; ++c) { f32x4 a0, a1; pg8::unpack8(raw[c], a0, a1); ss += (a0[0] * a0[0] + a0[1] * a0[1]) + (a0[2] * a0[2] + a0[3] * a0[3]) + (a1[0] * a1[0] + a1[1] * a1[1]) + (a1[2] * a1[2] + a1[3] * a1[3]); }
        const float rstd = 1.0f / sqrtf(ss * (1.f / 96.f) + EPS);
        const float* gn = sel ? P.in[I_MLAKN] : P.in[I_MLAQN];
        const float sc = sel ? 1.0f : C2B; const float rs = rstd * sc;
        bf16_t* dst = sel ? (bf16_t*)(ws + WS_KB2) + row * 768 + h * 96 : qrow;
#pragma unroll
        for (int c = 0; c < 8; ++c) { f32x4 a0, a1; pg8::unpack8(raw[c], a0, a1); const f32x4 g0 = *(const f32x4*)(gn + 8 * c), g1 = *(const f32x4*)(gn + 8 * c + 4);
            *(u32x4*)(dst + 8 * c) = pg8::pack8(a0 * g0 * rs, a1 * g1 * rs); }
#pragma unroll
        for (int c = 0; c < 2; ++c) { f32x4 x1a, x1b, x2a, x2b; pg8::unpack8(raw[8 + c], x1a, x1b); pg8::unpack8(raw[10 + c], x2a, x2b);
            const f32x4 g1a = *(const f32x4*)(gn + 64 + 8 * c), g1b = *(const f32x4*)(gn + 68 + 8 * c), g2a = *(const f32x4*)(gn + 80 + 8 * c), g2b = *(const f32x4*)(gn + 84 + 8 * c);
            x1a = x1a * g1a * rs; x1b = x1b * g1b * rs; x2a = x2a * g2a * rs; x2b = x2b * g2b * rs;
            const f32x4 ca = *(const f32x4*)(cosB + pos * 16 + 8 * c), cb = *(const f32x4*)(cosB + pos * 16 + 8 * c + 4), sa = *(const f32x4*)(sinB + pos * 16 + 8 * c), sb = *(const f32x4*)(sinB + pos * 16 + 8 * c + 4);
            *(u32x4*)(dst + 64 + 8 * c) = pg8::pack8(x1a * ca - x2a * sa, x1b * cb - x2b * sb);
            *(u32x4*)(dst + 80 + 8 * c) = pg8::pack8(x2a * ca + x1a * sa, x2b * cb + x1b * sb); }
    }
}

__device__ __forceinline__ void phase5(Frame& F) {
    unsigned char* ws = F.ws;
    for (int it = F.vcu; it < 256; it += F.G) {
        const int bh = it >> 2, sidx = it & 3, b = bh >> 3, h = bh & 7;
#pragma unroll 1
        for (int k = 0; k < 2; ++k) { const int qb = k ? 7 - sidx : sidx;
            att::attn_unit<64, true>(b, qb, (const bf16_t*)(ws + WS_QA2) + h * 64, 512, (const bf16_t*)(ws + WS_KA2) + h * 64, 512, (const bf16_t*)(ws + WS_PROJ) + PC_VA + h * 64, DINP,
                                     ws + WS_Y + h * 64, 1024, (const float*)(ws + WS_KMEAN) + (size_t)bh * 512, F.lds, F.wave); }
#pragma unroll 1
        for (int k = 0; k < 2; ++k) { const int qb = k ? 7 - sidx : sidx;
            att::attn_unit<96, false>(b, qb, (const bf16_t*)(ws + WS_QB) + h * 96, 768, (const bf16_t*)(ws + WS_KB2) + h * 96, 768, (const bf16_t*)(ws + WS_KV) + h * 128 + 64, 1024,
                                      ws + WS_Y + 512 + h * 64, 1024, nullptr, F.lds, F.wave); }
    }
}

__device__ __forceinline__ void phase8(Frame& F) {
    PHASE_IDS();
    const Params& P = *F.P; unsigned char* ws = F.ws;
    constexpr int HCS = 132, WCS = 48;
    LAS float* HC = (LAS float*)F.lds;
    LAS float* WC = HC + 2 * 64 * HCS;
    LAS float* RSTD = WC + 2 * 128 * WCS;
    LAS float* LOGIT = RSTD + 64;
    LAS int* pe = (LAS int*)(LOGIT + 64 * 33);
    int* PAIR_E = (int*)(ws + WS_PAIR); int* PAIR_RANK = PAIR_E + 65536; float* PAIR_W = (float*)(PAIR_E + 131072);
    const float* gffn = P.in[I_GFFN]; const float* wr_ = P.in[I_WR]; const float* br_ = P.in[I_BR];
    const int r0 = F.vcu * 64;
    if (I_.tid < 64) { const f32x4* sp = (const f32x4*)((const float*)(ws + WS_SSP) + (size_t)(r0 + I_.tid) * 16); const f32x4 a = sp[0], b = sp[1], c = sp[2], d = sp[3];
        const float ss = (((a[0] + a[1]) + (a[2] + a[3])) + ((b[0] + b[1]) + (b[2] + b[3]))) + (((c[0] + c[1]) + (c[2] + c[3])) + ((d[0] + d[1]) + (d[2] + d[3])));
        RSTD[I_.tid] = 1.0f / sqrtf(ss * (1.f / DM) + EPS); }
    __syncthreads();
    const int eg = I_.wave & 1, rgp = I_.wave >> 1, l15 = I_.lane & 15, l4 = I_.lane >> 4;
    const int srow = I_.tid >> 5, sc4 = I_.tid & 31;
    const int wrow = I_.tid >> 3, wc4 = I_.tid & 7;
    f32x4 stg[4], wst[2];
#define P8_LOAD(kc) do { _Pragma("unroll") for (int i = 0; i < 4; ++i) { const u32x2 w_ = *(const u32x2*)((const bf16_t*)(ws + WS_X1B) + (size_t)(r0 + srow + 16 * i) * DM + (kc) * 128 + 4 * sc4); stg[i] = (f32x4){bflo(w_.x), bfhi(w_.x), bflo(w_.y), bfhi(w_.y)}; } \
        _Pragma("unroll") for (int i = 0; i < 2; ++i) wst[i] = *(const f32x4*)(wr_ + (size_t)((kc) * 128 + wrow + 64 * i) * 32 + 4 * wc4); } while (0)
#define P8_STORE(kc, buf) do { const f32x4 g4 = *(const f32x4*)(gffn + (kc) * 128 + 4 * sc4); _Pragma("unroll") for (int i = 0; i < 4; ++i) { const float rs = RSTD[srow + 16 * i]; const f32x4 y = stg[i] * rs * g4; \
        *(LAS f32x4*)(HC + ((buf) * 64 + srow + 16 * i) * HCS + 4 * sc4) = y; *(unsigned*)(ws + WS_HNF8 + (size_t)(r0 + srow + 16 * i) * DM + (kc) * 128 + 4 * sc4) = pack4_fp8(y.x, y.y, y.z, y.w); } \
        _Pragma("unroll") for (int i = 0; i < 2; ++i) *(LAS f32x4*)(WC + ((buf) * 128 + wrow + 64 * i) * WCS + 4 * wc4) = wst[i]; } while (0)
    P8_LOAD(0); P8_STORE(0, 0);
    __syncthreads();
    f32x4 acc = {0.f, 0.f, 0.f, 0.f};
#pragma unroll 1
    for (int kc = 0; kc < 8; ++kc) { const int buf = kc & 1;
        if (kc + 1 < 8) P8_LOAD(kc + 1);
        const LAS float* wp = WC + (buf * 128 + l4) * WCS + eg * 16 + l15;
        const LAS float* hp = HC + (buf * 64 + rgp * 16 + l15) * HCS + l4;
#pragma unroll
        for (int kk = 0; kk < 32; ++kk) acc = __builtin_amdgcn_mfma_f32_16x16x4f32(wp[4 * kk * WCS], hp[4 * kk], acc, 0, 0, 0);
        if (kc + 1 < 8) P8_STORE(kc + 1, buf ^ 1);
        __syncthreads(); }
#undef P8_LOAD
#undef P8_STORE
#pragma unroll
    for (int i = 0; i < 4; ++i) { const int e = eg * 16 + 4 * l4 + i; LOGIT[(rgp * 16 + l15) * 33 + e] = acc[i] + br_[e]; }
    __syncthreads();
    if (I_.tid < 64) { const int rr = I_.tid, m = r0 + rr;
        float lg[32];
#pragma unroll
        for (int e = 0; e < 32; ++e) lg[e] = LOGIT[rr * 33 + e];
        int te[4]; float tv[4]; unsigned used = 0u;
#pragma unroll
        for (int k = 0; k < 4; ++k) { float best = -INFINITY; int bi = 0;
#pragma unroll
            for (int e = 0; e < 32; ++e) { const bool ok = !((used >> e) & 1u) && (lg[e] > best); best = ok ? lg[e] : best; bi = ok ? e : bi; }
            used |= 1u << bi; te[k] = bi; tv[k] = best; }
        const float e0 = 1.0f, e1 = __expf(tv[1] - tv[0]), e2 = __expf(tv[2] - tv[0]), e3 = __expf(tv[3] - tv[0]); const float inv = 1.0f / (e0 + e1 + e2 + e3);
        *(i32x4*)(PAIR_E + m * 4) = (i32x4){te[0], te[1], te[2], te[3]};
        *(f32x4*)(PAIR_W + m * 4) = (f32x4){e0 * inv, e1 * inv, e2 * inv, e3 * inv};
        *(LAS i32x4*)(pe + rr * 4) = (i32x4){te[0], te[1], te[2], te[3]}; }
    __syncthreads();
    if (I_.tid < 256) { const int e = pe[I_.tid]; int rank = 0;
#pragma unroll 16
        for (int j4 = 0; j4 < 64; ++j4) { const i32x4 v = *(const LAS i32x4*)(pe + 4 * j4); const int j = 4 * j4;
            rank += ((j < I_.tid) && v.x == e) + ((j + 1 < I_.tid) && v.y == e) + ((j + 2 < I_.tid) && v.z == e) + ((j + 3 < I_.tid) && v.w == e); }
        PAIR_RANK[r0 * 4 + I_.tid] = rank; }
    else if (I_.tid < 288) { const int e = I_.tid - 256; int c = 0;
#pragma unroll 16
        for (int j4 = 0; j4 < 64; ++j4) { const i32x4 v = *(const LAS i32x4*)(pe + 4 * j4); c += (v.x == e) + (v.y == e) + (v.z == e) + (v.w == e); }
        ((int*)(ws + WS_HIST))[F.vcu * 32 + e] = c; }
    __syncthreads();
}

__device__ __forceinline__ int moe_layout(Frame& F) {
    PHASE_IDS();
    LAS int* ctl = (LAS int*)(F.lds + LDS_CTL);
    LAS int* part = ctl + 512;
    const int* HIST = (const int*)(F.ws + WS_HIST);
    __syncthreads();
    { const int e = I_.tid & 31, pt = I_.tid >> 5; int tot = 0, before = 0; int c[16];
#pragma unroll
        for (int i = 0; i < 16; ++i) c[i] = HIST[(pt * 16 + i) * 32 + e];
#pragma unroll
        for (int i = 0; i < 16; ++i) { tot += c[i]; before += (pt * 16 + i < F.vcu) ? c[i] : 0; }
        part[pt * 64 + e] = tot; part[pt * 64 + 32 + e] = before; }
    __syncthreads();
    if (I_.tid < 32) { int tot = 0, before = 0;
#pragma unroll
        for (int pt = 0; pt < 16; ++pt) { tot += part[pt * 64 + I_.tid]; before += part[pt * 64 + 32 + I_.tid]; }
        ctl[I_.tid] = tot; ctl[65 + I_.tid] = before; }
    __syncthreads();
    if (I_.tid < 32) { const int e = I_.tid; const int nt_ = (ctl[e] + 255) >> 8; int sc = nt_;
#pragma unroll
        for (int o = 1; o < 32; o <<= 1) { const int up = __shfl_up(sc, o); sc += (e >= o) ? up : 0; }
        const int t0 = sc - nt_; ctl[32 + e] = t0 * 256; ctl[65 + e] += t0 * 256;
        for (int t = 0; t < nt_; ++t) ctl[128 + t0 + t] = e;
        if (e == 31) { ctl[64] = sc * 256; ctl[100] = sc; } }
    __syncthreads();
    return ctl[100];
}

__device__ __forceinline__ void phase9(Frame& F) {
    PHASE_IDS();
    unsigned char* ws = F.ws;
    moe_layout(F);
    LAS int* ctl = (LAS int*)(F.lds + LDS_CTL);
    const int* PAIR_E = (const int*)(ws + WS_PAIR); const int* PAIR_RANK = PAIR_E + 65536; int* ROWDEST = (int*)(ws + WS_PAIR) + 196608; int* TOK = (int*)(ws + WS_TOK);
    const int rows_per_blk = NTOK / F.G;
    if (I_.tid < rows_per_blk * 4) { const int gp = F.vcu * rows_per_blk * 4 + I_.tid;
        const int e = PAIR_E[gp], rk = PAIR_RANK[gp]; const int dest = ctl[65 + e] + rk;
        ROWDEST[gp] = dest; TOK[dest] = gp >> 2; }
    if (F.vcu < 32) { const int e = F.vcu; const int lo = ctl[32 + e] + ctl[e], hi = (e == 31) ? ctl[64] : ctl[33 + e];
        for (int r = lo + I_.tid; r < hi; r += NTHREADS) TOK[r] = 0; }
}

__device__ __forceinline__ void stage_tok(Frame& F, int nmt, int ntn) {
    PHASE_IDS();
    const int* TOK = (const int*)(F.ws + WS_TOK); LAS unsigned short* tokl = (LAS unsigned short*)(F.lds + LDS_TOKL);
    for (int i = 0; i < 10; ++i) { const int j = (i * F.G + (int)blockIdx.x) >> 3; const int mt = (j / ntn) * 8 + ((int)blockIdx.x & 7); if (mt >= nmt) break;
        if (I_.tid < 256) tokl[i * 256 + I_.tid] = (unsigned short)TOK[mt * 256 + I_.tid]; }
    __syncthreads();
}

__device__ __forceinline__ void phase12(Frame& F) {
    PHASE_IDS();
    const Params& P = *F.P; unsigned char* ws = F.ws;
    const int gw = F.vcu * NWAVES + I_.wave, NGW = F.G * NWAVES;
    const float* PAIR_W = (const float*)(ws + WS_PAIR) + 131072; const int* ROWDEST = (const int*)(ws + WS_PAIR) + 196608;
    const bf16_t* YP = (const bf16_t*)(ws + WS_XG);
    const f32x4* gp = (const f32x4*)P.in[I_GPLE] + I_.lane; f32x4 gv[4];
#pragma unroll
    for (int j = 0; j < 4; ++j) gv[j] = gp[64 * j];
    for (int m0 = gw; m0 < NTOK; m0 += 2 * NGW) {
        int mm[2]; mm[0] = m0; mm[1] = (m0 + NGW < NTOK) ? m0 + NGW : m0;
        f32x4 wv[2]; i32x4 dv[2];
#pragma unroll
        for (int q = 0; q < 2; ++q) { wv[q] = *(const f32x4*)(PAIR_W + mm[q] * 4); dv[q] = *(const i32x4*)(ROWDEST + mm[q] * 4); }
        f32x4 v[2][4]; u32x2 y[2][4][4];
#pragma unroll
        for (int q = 0; q < 2; ++q) { const u32x2* xr = (const u32x2*)((const bf16_t*)(ws + WS_X1B) + (size_t)mm[q] * DM) + I_.lane;
#pragma unroll
            for (int j = 0; j < 4; ++j) { const u32x2 w_ = xr[64 * j]; v[q][j] = (f32x4){bflo(w_.x), bfhi(w_.x), bflo(w_.y), bfhi(w_.y)}; }
#pragma unroll
            for (int k = 0; k < 4; ++k) { const u32x2* yr = (const u32x2*)(YP + (size_t)dv[q][k] * DM) + I_.lane;
#pragma unroll
                for (int j = 0; j < 4; ++j) y[q][k][j] = yr[64 * j]; } }
#pragma unroll
        for (int q = 0; q < 2; ++q) { if (q == 1 && mm[1] == mm[0]) break;
            float s = 0.f; u32x2* xw = (u32x2*)((bf16_t*)(ws + WS_X1B) + (size_t)mm[q] * DM) + I_.lane;
#pragma unroll
            for (int j = 0; j < 4; ++j) {
#pragma unroll
                for (int k = 0; k < 4; ++k) { const u32x2 yy = y[q][k][j]; v[q][j] += (f32x4){bflo(yy.x), bfhi(yy.x), bflo(yy.y), bfhi(yy.y)} * wv[q][k]; }
                xw[64 * j] = (u32x2){cvt_pk_bf16(v[q][j].x, v[q][j].y), cvt_pk_bf16(v[q][j].z, v[q][j].w)}; s += (v[q][j].x * v[q][j].x + v[q][j].y * v[q][j].y) + (v[q][j].z * v[q][j].z + v[q][j].w * v[q][j].w); }
            const float rstd = 1.0f / sqrtf(wave_sum(s) * (1.f / DM) + EPS);
            unsigned* o4 = (unsigned*)(ws + WS_HNF8 + (size_t)mm[q] * DM) + I_.lane;
#pragma unroll
            for (int j = 0; j < 4; ++j) { const f32x4 yo = v[q][j] * rstd * gv[j]; o4[64 * j] = pack4_fp8(yo.x, yo.y, yo.z, yo.w); } }
    }
}

__global__ void __launch_bounds__(NTHREADS, 2) fwd(Params prm) {
    extern __shared__ __attribute__((aligned(16))) unsigned char lds_raw[];
    Frame F;
    F.lds = (LAS unsigned char*)lds_raw;
    F.wave = __builtin_amdgcn_readfirstlane((int)threadIdx.x >> 6);
    if (threadIdx.x < 2) ((volatile LAS unsigned*)(F.lds + LDS_BARST))[threadIdx.x] = 0u;
    const XcdBarrier bar = xcd_barrier_post((unsigned*)(prm.ws + WS_BAR), (volatile LAS unsigned*)(F.lds + LDS_BARST), F.wave);
    if (prm.ph_lo < 0) cg::this_grid().sync();
    __syncthreads();
    F.G = gridDim.x; { const int bx = blockIdx.x; F.vcu = (F.G % 8 == 0) ? (bx % 8) * (F.G / 8) + bx / 8 : bx; }
    F.P = &prm; F.ws = prm.ws;
    unsigned char* ws = prm.ws;
    const int lo = prm.ph_lo, hi = prm.ph_hi;
#ifndef PH_MASK
#define PH_MASK 0xffffu
#endif
#ifndef REP_MASK
#define REP_MASK 0u
#endif
#define IN(k) (((PH_MASK >> (k)) & 1u) && lo <= (k) && (k) < hi)
#define REPS(k) for (int rep_ = 0; rep_ < (((REP_MASK >> (k)) & 1u) ? 2 : 1); ++rep_, (((REP_MASK >> (k)) & 1u) && rep_ < 2 ? xcd_barrier(bar) : (void)0))
#define SEAM(k) do { __builtin_amdgcn_sched_barrier(0); asm volatile("" ::: "memory"); if (IN(k) && IN((k) + 1)) xcd_barrier(bar); STAMP((k) + 1); __builtin_amdgcn_sched_barrier(0); asm volatile("" ::: "memory"); } while (0)
    using namespace pg8;
    STAMP(0);
    if (IN(0)) REPS(0) phase0(F);
    SEAM(0);
    if (IN(1)) REPS(1) {
        { Gemm g{(const bf16_t*)(ws + WS_HN), (const bf16_t*)(ws + WS_WIN), DM, DM, DM}; StaticOrder S; S.init(NTOK, 2048, F.G, (int)blockIdx.x);
          const float* cosA_ = (const float*)(ws + WS_ROPE);
          EpiProj E{(bf16_t*)(ws + WS_PROJ), (bf16_t*)(ws + WS_QA2), (bf16_t*)(ws + WS_KA2), (float*)(ws + WS_KMEAN), (bf16_t*)(ws + WS_CQN), (bf16_t*)(ws + WS_CKVN),
                    prm.in[I_MQN], prm.in[I_MKN], prm.in[I_QLATN], prm.in[I_KVLATN], cosA_, cosA_ + 65536, (LAS float*)(F.lds + LDS_TOKL), (float*)(ws + WS_KPESS)};
          gemm_phase(F.lds, F.wave, g, S, E); }
        __builtin_amdgcn_sched_barrier(0); asm volatile("" ::: "memory");
        { Gemm g{(const bf16_t*)(ws + WS_HNF8), (const bf16_t*)(ws + WS_WINF8), 512, 512, 512}; StaticOrder S; S.init(NTOK, 2048, F.G, (int)blockIdx.x);
          EpiStore E{(bf16_t*)(ws + WS_PROJ) + PC_GA, DINP, nullptr, 0, 0}; gemm_phase<EpiStore, StaticOrder, false, true>(F.lds, F.wave, g, S, E); } }
    SEAM(1);
    if (IN(3)) REPS(3) {
        const float* cosB_ = (const float*)(ws + WS_ROPE) + 131072;
        { Gemm g{(const bf16_t*)(ws + WS_CQN), (const bf16_t*)(ws + WS_WUQ), 256, 256, 256}; StaticOrder S; S.init(NTOK, 1024, F.G, (int)blockIdx.x);
          EpiQB E{(bf16_t*)(ws + WS_QB), prm.in[I_MLAQN], cosB_, cosB_ + 32768, (LAS float*)(F.lds + LDS_CTL)}; gemm_phase(F.lds, F.wave, g, S, E); }
        __builtin_amdgcn_sched_barrier(0); asm volatile("" ::: "memory");
        { Gemm g{(const bf16_t*)(ws + WS_CKVN), (const bf16_t*)(ws + WS_WUKV), 128, 128, 128}; StaticOrder S; S.init(NTOK, 1024, F.G, (int)blockIdx.x);
          EpiKV E{(bf16_t*)(ws + WS_KB2), (bf16_t*)(ws + WS_KV), (const bf16_t*)(ws + WS_PROJ), (const float*)(ws + WS_KPESS), prm.in[I_MLAKN], cosB_, cosB_ + 32768, (LAS float*)(F.lds + LDS_CTL)};
          gemm_phase(F.lds, F.wave, g, S, E); } }
    SEAM(3);
    if (IN(5)) REPS(5) phase5(F);
    SEAM(5);
    if (IN(6)) REPS(6) { Gemm g{(const bf16_t*)(ws + WS_Y), (const bf16_t*)(ws + WS_WA), 512, 256, 256}; BranchOrder S; S.so.init(NTOK, DM, F.G, (int)blockIdx.x);
        EpiGateAB E{(bf16_t*)(ws + WS_MERGED), (const bf16_t*)(ws + WS_PROJ) + PC_GA, (const bf16_t*)(ws + WS_PROJ) + PC_GB, DINP, ws + WS_KA2  };
        gemm_phase<EpiGateAB, BranchOrder, false, true>(F.lds, F.wave, g, S, E); }
    SEAM(7);
    if (IN(8)) REPS(8) { Gemm g{(const bf16_t*)(ws + WS_KA2), (const bf16_t*)(ws + WS_WO), 512, 512, 512}; StaticOrder S; S.init(NTOK, DM, F.G, (int)blockIdx.x);
        EpiResF32 E{prm.in[I_X], (bf16_t*)(ws + WS_X1B), (float*)(ws + WS_SSP)}; gemm_phase<EpiResF32, StaticOrder, false, true>(F.lds, F.wave, g, S, E); }
    SEAM(8);
    if (IN(9)) REPS(9) phase8(F);
    SEAM(9);
    if (IN(10)) REPS(10) phase9(F);
    SEAM(10);
    if (IN(11)) REPS(11) { const int nmt = ((const LAS int*)(F.lds + LDS_CTL))[100]; stage_tok(F, nmt, 8);
        Gemm g{(const bf16_t*)(ws + WS_HNF8), (const bf16_t*)(ws + WS_W1), 512, 512, 512}; MoeOrder S{(const LAS int*)(F.lds + LDS_CTL) + 128, nmt, 8, F.G, (int)blockIdx.x};
        EpiSwiglu E{ws + WS_ACT, prm.in[I_BGU]}; gemm_phase<EpiSwiglu, MoeOrder, true, true>(F.lds, F.wave, g, S, E, (const LAS unsigned short*)(F.lds + LDS_TOKL)); }
    SEAM(11);
    if (IN(12)) REPS(12) { const int nmt = ((const LAS int*)(F.lds + LDS_CTL))[100];
        Gemm g{(const bf16_t*)(ws + WS_ACT), (const bf16_t*)(ws + WS_W2), 512, 512, 512}; MoeOrder S{(const LAS int*)(F.lds + LDS_CTL) + 128, nmt, 4, F.G, (int)blockIdx.x};
        EpiStore E{(bf16_t*)(ws + WS_XG), DM, prm.in[I_BD], 1024, 1 << 30}; gemm_phase<EpiStore, MoeOrder, false, true>(F.lds, F.wave, g, S, E); }
    SEAM(12);
    if (IN(13)) REPS(13) phase12(F);
    SEAM(13);
    if (IN(14)) REPS(14) { Gemm g{(const bf16_t*)(ws + WS_PB), (const bf16_t*)(ws + WS_WPP), 256, 256, 256}; StaticOrder S; S.init(NTOK, DM, F.G, (int)blockIdx.x);
        EpiStore E{(bf16_t*)(ws + WS_PP), DM, nullptr, 0, 1 << 30}; gemm_phase(F.lds, F.wave, g, S, E); }
    __builtin_amdgcn_sched_barrier(0); asm volatile("s_waitcnt vmcnt(0)" ::: "memory"); __syncthreads();
    if (IN(15)) REPS(15) { Gemm g{(const bf16_t*)(ws + WS_HNF8), (const bf16_t*)(ws + WS_WPG), 512, 512, 512}; StaticOrder S; S.init(NTOK, DM, F.G, (int)blockIdx.x);
        EpiFinal E{prm.out, (const bf16_t*)(ws + WS_PP), (const bf16_t*)(ws + WS_X1B)}; gemm_phase<EpiFinal, StaticOrder, false, true>(F.lds, F.wave, g, S, E); }
#ifdef TPROBE_A
    STAMP(16);
    xcd_barrier(bar);
    if (blockIdx.x == 0 && F.wave == 0 && lane_id() == 0) {
        volatile unsigned long long* ts = (volatile unsigned long long*)(ws + WS_ERR);
        const unsigned long long da = ts[TPROBE_A1] - ts[TPROBE_A], db = ts[TPROBE_B1] - ts[TPROBE_B];
        asm volatile("s_waitcnt vmcnt(0)" ::: "memory");
        prm.out[0] += (float)db * (0.01f / 4.0f);
        const unsigned long long t0 = __builtin_amdgcn_s_memrealtime();
        while (__builtin_amdgcn_s_memrealtime() - t0 < 4ull * da) __builtin_amdgcn_s_sleep(4);
    }
#endif
#undef IN
#undef SEAM
}

extern "C" void kernel_launch(void* const* d_in, const int* in_sizes, int n_in, void* d_out, int out_size, void* d_ws, size_t ws_size, hipStream_t stream) {
    static int grid = 0;
    if (grid == 0) {
        int dev = 0, cus = 0, per_cu = 0;
        (void)hipGetDevice(&dev);
        (void)hipDeviceGetAttribute(&cus, hipDeviceAttributeMultiprocessorCount, dev);
        (void)hipFuncSetAttribute((const void*)fwd, hipFuncAttributeMaxDynamicSharedMemorySize, LDS_BYTES);
        (void)hipOccupancyMaxActiveBlocksPerMultiprocessor(&per_cu, (const void*)fwd, NTHREADS, LDS_BYTES);
        fprintf(stderr, "cus %d per_cu %d ws %zu n_in %d\n", cus, per_cu, ws_size, n_in);
        grid = (per_cu >= 1) ? cus : -1;
        if (grid != 256 || n_in != 25 || ws_size < WS_END || out_size != NTOK * DM) { fprintf(stderr, "kernel_launch: unsupported configuration\n"); grid = -1; }
    }
    if (grid < 0) return;
    (void)hipMemsetAsync((char*)d_ws + WS_BAR, 0, WS_BAR_BYTES, stream);
    Params a{};
    for (int i = 0; i < 25; ++i) a.in[i] = (const float*)d_in[i];
    a.out = (float*)d_out; a.ws = (unsigned char*)d_ws;
#ifndef MULTI_LAUNCH
    a.ph_lo = 0; a.ph_hi = NPHASE;
    void* args[] = {&a};
    hipError_t e = hipLaunchCooperativeKernel((const void*)fwd, dim3(grid), dim3(NTHREADS), args, LDS_BYTES, stream);
    if (e != hipSuccess) fprintf(stderr, "cooperative launch failed: %s\n", hipGetErrorString(e));
#else
    for (int k = 0; k < NPHASE; ++k) { a.ph_lo = k; a.ph_hi = k + 1; void* args[] = {&a};
        hipError_t e = hipLaunchCooperativeKernel((const void*)fwd, dim3(grid), dim3(NTHREADS), args, LDS_BYTES, stream);
        if (e != hipSuccess) fprintf(stderr, "launch %d failed: %s\n", k, hipGetErrorString(e)); }
#endif
}
```

```cpp
#include <hip/hip_runtime.h>
#include <hip/hip_cooperative_groups.h>
#include <cstdio>
#include <cstdint>
namespace cg = cooperative_groups;

#define LAS __attribute__((address_space(3)))
typedef unsigned short bf16_t;
typedef short bf16x8 __attribute__((ext_vector_type(8)));
typedef short s16x4 __attribute__((ext_vector_type(4)));
typedef float f32x4 __attribute__((ext_vector_type(4)));
typedef float f32x2 __attribute__((ext_vector_type(2)));
typedef float f32x16 __attribute__((ext_vector_type(16)));
typedef unsigned u32x4 __attribute__((ext_vector_type(4)));
typedef unsigned u32x2 __attribute__((ext_vector_type(2)));
typedef int i32x4 __attribute__((ext_vector_type(4)));
typedef int i32x8 __attribute__((ext_vector_type(8)));
typedef __bf16 bf16x2_t __attribute__((ext_vector_type(2)));

constexpr int NB = 8, SEQ = 2048, NTOK = NB * SEQ, DM = 1024;
constexpr int DIN = 4000, DINP = 4096;
constexpr int NEXP = 32, TOPK = 4, DEXP = 1024;
constexpr int NTHREADS = 512, NWAVES = 8;
constexpr float EPS = 1e-6f;
constexpr float LOG2E = 1.4426950408889634f;
constexpr float C2A = 0.125f * LOG2E;
constexpr float C2B = 0.10206207261596575f * LOG2E;
constexpr int PC_QA = 0, PC_KA = 512, PC_VA = 1024, PC_CQ = 1536, PC_CKV = 1792, PC_KPE = 1920, PC_GA = 2048, PC_GB = 3072;

constexpr size_t MiB = 1u << 20;
constexpr size_t WS_HIST = 0;
constexpr size_t WS_ERR = 64 * 1024;
constexpr size_t WS_BAR = 128 * 1024;
constexpr size_t WS_BAR_BYTES = 16 * 1024;
constexpr size_t WS_KPESS = 576 * 1024;
constexpr size_t WS_TOK = 256 * 1024;
constexpr size_t WS_ROPE = 1 * MiB;
constexpr size_t WS_KMEAN = 2 * MiB;
constexpr size_t WS_SSP = 11 * MiB;
constexpr size_t WS_PAIR = 3 * MiB;
constexpr size_t WS_WUQ = 4 * MiB, WS_WUKV = 4 * MiB + 512 * 1024, WS_WPP = 5 * MiB, WS_WA = 6 * MiB, WS_WB = 7 * MiB, WS_WO = 8 * MiB, WS_WPG = 10 * MiB, WS_WIN = 12 * MiB;
constexpr size_t WS_W1 = 20 * MiB, WS_W2 = 148 * MiB;
constexpr size_t WS_WINF8 = 16 * MiB;
constexpr size_t WS_HNF8 = 84 * MiB;
constexpr size_t WS_HN = 212 * MiB, WS_PB = 244 * MiB;
constexpr size_t WS_X1B = WS_HN;
constexpr size_t WS_CQN = 252 * MiB, WS_CKVN = 260 * MiB, WS_QB = 264 * MiB, WS_KV = 288 * MiB, WS_KB2 = 320 * MiB, WS_Y = 344 * MiB, WS_MERGED = 376 * MiB;
constexpr size_t WS_ACT = 252 * MiB;
constexpr size_t WS_PP = 400 * MiB;
constexpr size_t WS_KA2 = 432 * MiB;
constexpr size_t WS_PROJ = 448 * MiB;
constexpr size_t WS_QA2 = 576 * MiB;
constexpr size_t WS_XG = 448 * MiB;
constexpr size_t WS_END = 592 * MiB;
constexpr int MAXROWS = 73728, MAXMT = 288;

constexpr int RING_BYTES = 131072;
constexpr int LDS_CTL = RING_BYTES;
constexpr int LDS_TOKL = RING_BYTES + 8192 + 256;
constexpr int LDS_BARST = RING_BYTES + 8192;
constexpr int LDS_BYTES = 147456;

__device__ __forceinline__ unsigned cvt_pk_bf16(float lo, float hi) { f32x2 v = {lo, hi}; bf16x2_t b = __builtin_convertvector(v, bf16x2_t); return __builtin_bit_cast(unsigned, b); }
__device__ __forceinline__ unsigned pack4_fp8(float a, float b, float c, float d) { int w = 0; w = __builtin_amdgcn_cvt_pk_fp8_f32(a, b, w, false); w = __builtin_amdgcn_cvt_pk_fp8_f32(c, d, w, true); return (unsigned)w; }
__device__ __forceinline__ float bf2f(unsigned short b) { return __uint_as_float(((unsigned)b) << 16); }
__device__ __forceinline__ float bflo(unsigned w) { return __uint_as_float(w << 16); }
__device__ __forceinline__ float bfhi(unsigned w) { return __uint_as_float(w & 0xffff0000u); }
__device__ __forceinline__ float sigmoidf_(float x) { return __builtin_amdgcn_rcpf(1.0f + __builtin_amdgcn_exp2f(-x * LOG2E)); }
__device__ __forceinline__ int lane_id() { return (int)__builtin_amdgcn_mbcnt_hi(~0u, __builtin_amdgcn_mbcnt_lo(~0u, 0u)); }
__device__ __forceinline__ float wave_sum(float v) {
#pragma unroll
    for (int o = 1; o < 64; o <<= 1) v += __shfl_xor(v, o);
    return v;
}

namespace pg8 {
constexpr int BM = 256, BK = 64, HALF = 128, HTB = HALF * BK * 2, STAGE_BYTES = 8 * HTB, NXCD = 8, WGM = 8;
__host__ __device__ __forceinline__ int lds_byte(int r, int c) { const int st = (r >> 4) * 2 + (c >> 5), rr = r & 15, cc = c & 31, ob = rr * 64 + cc * 2; return st * 1024 + (ob ^ (((ob >> 9) & 1) << 5)); }
__host__ __device__ __forceinline__ void stage_rc(int b, int& R, int& C) { const int st = b / 1024, sb = b % 1024, swz = sb ^ (((sb >> 9) & 1) << 5); R = (st >> 1) * 16 + swz / 64; C = (st & 1) * 32 + (swz % 64) / 2; }
__host__ __device__ __forceinline__ int perm32(int rho) { const int n = rho >> 4, i = rho & 15; return 8 * (i >> 2) + 4 * n + (i & 3); }

struct Unit { int pm, pn, pb, e; int aofs = 0; };
struct Gemm { const bf16_t* A; const bf16_t* Bt; int lda, ldb, K; };

struct StaticOrder {
    int nM, nN, nwg, G, c;
    __device__ void init(int M, int N, int G_, int c_) { nM = M / BM; nN = N / BM; nwg = nM * nN; G = G_; c = c_; }
    __device__ bool next(int i, Unit& u) const {
        const long L = (long)i * G + c; if (L >= nwg) return false;
        int wgid = (int)L; { const int q = nwg / NXCD, r = nwg % NXCD, xcd = wgid % NXCD, off = wgid / NXCD; wgid = (xcd < r ? xcd * (q + 1) : r * (q + 1) + (xcd - r) * q) + off; }
        const int nig = WGM * nN, gid = wgid / nig, fm = gid * WGM, gsz = (nM - fm) < WGM ? (nM - fm) : WGM;
        u.pm = fm + ((wgid % nig) % gsz); u.pn = (wgid % nig) / gsz; u.pb = u.pn; u.e = 0; return true;
    }
};
struct MoeOrder {
    const LAS int* tile_e; int nmt, ntn, G, c;
    __device__ bool next(int i, Unit& u) const {
        const int j = (i * G + c) >> 3; const int mt = (j / ntn) * 8 + (c & 7), pn = j % ntn; if (mt >= nmt) return false;
        const int e = __builtin_amdgcn_readfirstlane(tile_e[mt]);
        u.pm = mt; u.pn = pn; u.pb = e * ntn + pn; u.e = e; return true;
    }
};

template <class Epi, class Sched, bool GATHER = false, bool FP8 = false>
__device__ __forceinline__ void gemm_phase(LAS unsigned char* lds, int wave, const Gemm g, const Sched& S, const Epi& E, const LAS unsigned short* tokl = nullptr) {
    constexpr bool ALIGN_EPI = true;
    int lane = lane_id(); asm volatile("" : "+v"(lane));
    const int wid = wave, tid = wid * 64 + lane, wr = wid >> 2, wc = wid & 3, fr = lane & 15, fq = lane >> 4;
    int K = g.K; asm volatile("" : "+s"(K));
    const int nt = K / BK;
    unsigned voffA[2], voffB[2]; int gR[2]; unsigned gC[2];
#pragma unroll
    for (int i = 0; i < 2; ++i) { int R, C; stage_rc(tid * 16 + i * 8192, R, C); const int Rb = (R & ~31) + perm32(R & 31);
        voffA[i] = (unsigned)(R * g.lda + C) * 2u; voffB[i] = (unsigned)(Rb * g.ldb + C) * 2u; gR[i] = R; gC[i] = (unsigned)C * 2u; }
    unsigned goff[2][2], noff[2][2];
#define PG8_GOFF(dst, ui_) do { _Pragma("unroll") for (int h_ = 0; h_ < 2; ++h_) _Pragma("unroll") for (int i_ = 0; i_ < 2; ++i_) \
        dst[h_][i_] = (unsigned)tokl[(ui_) * 256 + h_ * HALF + gR[i_]] * (unsigned)(g.lda * 2) + gC[i_]; } while (0)
    const size_t kstep = (size_t)(BK * 2);
    const size_t hstepA = (size_t)HALF * g.lda * 2, hstepB = (size_t)HALF * g.ldb * 2;
    const size_t tstepA = 2 * hstepA, tstepB = 2 * hstepB;
    const unsigned ldsw = (unsigned)wid * 1024u;
    const int aoff = lds_byte(wr * 64 + fr, fq * 8), boff = lds_byte(wc * 32 + fr, fq * 8);
#define PG8_SA(b, h) (((b) * 2 + (h)) * HTB)
#define PG8_SB(b, h) ((4 + (b) * 2 + (h)) * HTB)
#define PG8_STAGE(bufoff, gbase, voff) do { _Pragma("unroll") for (int _i = 0; _i < 2; ++_i) \
        __builtin_amdgcn_global_load_lds((const unsigned*)((const char*)(gbase) + (voff)[_i]), (LAS unsigned*)(lds + (bufoff) + ldsw + _i * 8192), 16, 0, 0); } while (0)
#define PG8_STAGE_A(bufoff, ptr_ng, k_g, off_g) do { if constexpr (GATHER) { const char* gb_ = (const char*)g.A + (size_t)(k_g) * kstep; PG8_STAGE(bufoff, gb_, off_g); } else { PG8_STAGE(bufoff, ptr_ng, voffA); } } while (0)
#define PG8_LDA(dst, b, h) do { if constexpr (FP8) { _Pragma("unroll") for (int m = 0; m < 4; ++m) { const i32x4 lo_ = *(const LAS i32x4*)(lds + PG8_SA(b, h) + aoff + m * 2048), hi_ = *(const LAS i32x4*)(lds + PG8_SA(b, h) + aoff + m * 2048 + 1024); dst##8[m] = __builtin_shufflevector(lo_, hi_, 0, 1, 2, 3, 4, 5, 6, 7); } } \
        else { _Pragma("unroll") for (int m = 0; m < 4; ++m) _Pragma("unroll") for (int k = 0; k < 2; ++k) dst[m][k] = *(const LAS bf16x8*)(lds + PG8_SA(b, h) + aoff + m * 2048 + k * 1024); } } while (0)
#define PG8_LDB(dst, b, h) do { if constexpr (FP8) { _Pragma("unroll") for (int n = 0; n < 2; ++n) { const i32x4 lo_ = *(const LAS i32x4*)(lds + PG8_SB(b, h) + boff + n * 2048), hi_ = *(const LAS i32x4*)(lds + PG8_SB(b, h) + boff + n * 2048 + 1024); dst##8[n] = __builtin_shufflevector(lo_, hi_, 0, 1, 2, 3, 4, 5, 6, 7); } } \
        else { _Pragma("unroll") for (int n = 0; n < 2; ++n) _Pragma("unroll") for (int k = 0; k < 2; ++k) dst[n][k] = *(const LAS bf16x8*)(lds + PG8_SB(b, h) + boff + n * 2048 + k * 1024); } } while (0)
#define PG8_CAT8(x, y) __builtin_shufflevector(__builtin_bit_cast(i32x4, x), __builtin_bit_cast(i32x4, y), 0, 1, 2, 3, 4, 5, 6, 7)
#define PG8_MMA(ai, bj, At, Bt) do { __builtin_amdgcn_s_setprio(1); if constexpr (FP8) { _Pragma("unroll") for (int m = 0; m < 4; ++m) _Pragma("unroll") for (int n = 0; n < 2; ++n) \
        asm volatile("v_mfma_scale_f32_16x16x128_f8f6f4 %0, %1, %2, %0, %3, %3 op_sel_hi:[0,0,0]" : "+v"(acc[ai][bj][m][n]) : "v"(Bt##8[n]), "v"(At##8[m]), "v"(sc8)); } \
        else { _Pragma("unroll") for (int m = 0; m < 4; ++m) _Pragma("unroll") for (int n = 0; n < 2; ++n) _Pragma("unroll") for (int k = 0; k < 2; ++k) \
        acc[ai][bj][m][n] = __builtin_amdgcn_mfma_f32_16x16x32_bf16(Bt[n][k], At[m][k], acc[ai][bj][m][n], 0, 0, 0); } __builtin_amdgcn_s_setprio(0); } while (0)
#define PG8_WAIT_V(n) asm volatile("s_waitcnt vmcnt(" #n ")" ::: "memory")
#define PG8_WAIT_L(n) asm volatile("s_waitcnt lgkmcnt(" #n ")" ::: "memory")
#define PG8_BAR __builtin_amdgcn_s_barrier()
#define PG8_SCHED __builtin_amdgcn_sched_barrier(0)
    Unit cur, nxt; int ui = 0;
    if (!S.next(0, cur)) return;
    f32x4 acc[2][2][4][2];
#pragma unroll
    for (int a = 0; a < 2; ++a)
#pragma unroll
        for (int b = 0; b < 2; ++b)
#pragma unroll
            for (int m = 0; m < 4; ++m)
#pragma unroll
                for (int n = 0; n < 2; ++n) acc[a][b][m][n] = (f32x4){0.f, 0.f, 0.f, 0.f};
    const int sc8 = 0x7c7c7c7c;
    bf16x8 At[4][2], B0[2][2], B1[2][2]; i32x8 At8[4], B08[2], B18[2];
    const char* cA = (const char*)g.A + (size_t)cur.pm * tstepA + cur.aofs; const char* cB = (const char*)g.Bt + (size_t)cur.pb * tstepB;
    if constexpr (GATHER) { PG8_GOFF(goff, 0); }
    PG8_STAGE(PG8_SB(0, 0), cB, voffB); PG8_STAGE(PG8_SB(0, 1), cB + hstepB, voffB); PG8_STAGE_A(PG8_SA(0, 0), cA, 0, goff[0]); PG8_STAGE_A(PG8_SA(0, 1), cA + hstepA, 0, goff[1]);
    if (wr == 1) PG8_BAR;
    PG8_WAIT_V(2); PG8_BAR;
    PG8_STAGE(PG8_SB(1, 0), cB + kstep, voffB); PG8_STAGE_A(PG8_SA(1, 0), cA + kstep, 1, goff[0]); PG8_STAGE(PG8_SB(1, 1), cB + hstepB + kstep, voffB);
    PG8_WAIT_V(6); PG8_BAR;
    for (;;) {
        const bool has_next = S.next(ui + 1, nxt);
        const char* nA = has_next ? (const char*)g.A + (size_t)nxt.pm * tstepA + nxt.aofs : cA; const char* nB = has_next ? (const char*)g.Bt + (size_t)nxt.pb * tstepB : cB;
        if constexpr (GATHER) { if (has_next) { PG8_GOFF(noff, ui + 1); } else {
#pragma unroll
            for (int h_ = 0; h_ < 2; ++h_)
#pragma unroll
                for (int i_ = 0; i_ < 2; ++i_) noff[h_][i_] = goff[h_][i_]; } }
        for (int t = 0; t < nt; t += 2) {
            const bool last = (t == nt - 2);
            const char* a1 = cA + (size_t)(t + 1) * kstep;
            const char* a2 = last ? nA : cA + (size_t)(t + 2) * kstep; const char* b2 = last ? nB : cB + (size_t)(t + 2) * kstep;
            const char* a3 = a2 + kstep; const char* b3 = b2 + kstep;
            const int k2 = last ? 0 : t + 2;
            unsigned soff[2][2];
            if constexpr (GATHER) {
#pragma unroll
                for (int h_ = 0; h_ < 2; ++h_)
#pragma unroll
                    for (int i_ = 0; i_ < 2; ++i_) soff[h_][i_] = last ? noff[h_][i_] : goff[h_][i_]; }
            PG8_LDB(B0, 0, 0); PG8_LDB(B1, 0, 1); PG8_SCHED; PG8_LDA(At, 0, 0); PG8_STAGE_A(PG8_SA(1, 1), a1 + hstepA, t + 1, goff[1]);
            PG8_WAIT_V(8); PG8_WAIT_L(0); PG8_BAR; PG8_MMA(0, 0, At, B0); PG8_MMA(0, 1, At, B1); PG8_BAR; PG8_SCHED;
            PG8_LDA(At, 0, 1); PG8_STAGE(PG8_SB(0, 0), b2, voffB); PG8_STAGE(PG8_SB(0, 1), b2 + hstepB, voffB); PG8_STAGE_A(PG8_SA(0, 0), a2, k2, soff[0]);
            PG8_WAIT_V(8); PG8_WAIT_L(0); PG8_BAR; PG8_MMA(1, 0, At, B0); PG8_MMA(1, 1, At, B1); PG8_BAR; PG8_SCHED;
            PG8_LDB(B0, 1, 0); PG8_LDB(B1, 1, 1); PG8_SCHED; PG8_LDA(At, 1, 0); PG8_STAGE_A(PG8_SA(0, 1), a2 + hstepA, k2, soff[1]);
            PG8_WAIT_V(8); PG8_WAIT_L(0); PG8_BAR; PG8_MMA(0, 0, At, B0); PG8_MMA(0, 1, At, B1); PG8_BAR; PG8_SCHED;
            PG8_LDA(At, 1, 1); PG8_STAGE(PG8_SB(1, 0), b3, voffB); PG8_STAGE(PG8_SB(1, 1), b3 + hstepB, voffB); PG8_STAGE_A(PG8_SA(1, 0), a3, k2 + 1, soff[0]);
            PG8_WAIT_V(8); PG8_WAIT_L(0); PG8_BAR; PG8_MMA(1, 0, At, B0); PG8_MMA(1, 1, At, B1); PG8_BAR; PG8_SCHED;
        }
        if constexpr (ALIGN_EPI) { if (wr == 0) PG8_BAR; }
        if constexpr (FP8) asm volatile("s_nop 15\n\ts_nop 15" ::: "memory");
        E(acc, cur, wr, wc, fr, fq);
        if (!has_next) break;
#pragma unroll
        for (int a = 0; a < 2; ++a)
#pragma unroll
            for (int b = 0; b < 2; ++b)
#pragma unroll
                for (int m = 0; m < 4; ++m)
#pragma unroll
                    for (int n = 0; n < 2; ++n) acc[a][b][m][n] = (f32x4){0.f, 0.f, 0.f, 0.f};
        cur = nxt; cA = nA; cB = nB; ++ui;
        if constexpr (GATHER) {
#pragma unroll
            for (int h_ = 0; h_ < 2; ++h_)
#pragma unroll
                for (int i_ = 0; i_ < 2; ++i_) goff[h_][i_] = noff[h_][i_]; }
        if constexpr (ALIGN_EPI) { if (wr == 1) PG8_BAR; }
    }
    PG8_WAIT_V(0);
    if constexpr (!ALIGN_EPI) { if (wr == 0) PG8_BAR; }
    PG8_BAR;
#undef PG8_SA
#undef PG8_SB
#undef PG8_STAGE
#undef PG8_STAGE_A
#undef PG8_GOFF
#undef PG8_LDA
#undef PG8_LDB
#undef PG8_MMA
#undef PG8_CAT8
#undef PG8_WAIT_V
#undef PG8_WAIT_L
#undef PG8_BAR
#undef PG8_SCHED
}

#define EPI_ARGS const f32x4 (&acc)[2][2][4][2], const Unit& u, int wr, int wc, int fr, int fq
__device__ __forceinline__ u32x4 pack8(f32x4 v0, f32x4 v1) { u32x4 w; w.x = cvt_pk_bf16(v0[0], v0[1]); w.y = cvt_pk_bf16(v0[2], v0[3]); w.z = cvt_pk_bf16(v1[0], v1[1]); w.w = cvt_pk_bf16(v1[2], v1[3]); return w; }
__device__ __forceinline__ void unpack8(u32x4 w, f32x4& v0, f32x4& v1) { v0 = (f32x4){bflo(w.x), bfhi(w.x), bflo(w.y), bfhi(w.y)}; v1 = (f32x4){bflo(w.z), bfhi(w.z), bflo(w.w), bfhi(w.w)}; }
__device__ __forceinline__ f32x4 sig4(f32x4 v) { const f32x4 a = v * (-LOG2E); const f32x4 d = (f32x4){__builtin_amdgcn_exp2f(a[0]), __builtin_amdgcn_exp2f(a[1]), __builtin_amdgcn_exp2f(a[2]), __builtin_amdgcn_exp2f(a[3])} + 1.0f;
    return (f32x4){__builtin_amdgcn_rcpf(d[0]), __builtin_amdgcn_rcpf(d[1]), __builtin_amdgcn_rcpf(d[2]), __builtin_amdgcn_rcpf(d[3])}; }

struct EpiStore {
    bf16_t* O; int ldc; const float* bias; int bias_stride; int sig_from;
    __device__ __forceinline__ void operator()(EPI_ARGS) const {
        const int row0 = u.pm * BM + wr * 64 + fr, col0 = u.pn * BM + wc * 32 + 8 * fq;
        const bool sg = u.pn >= sig_from;
        f32x4 bv[2][2];
#pragma unroll
        for (int bj = 0; bj < 2; ++bj)
#pragma unroll
            for (int n = 0; n < 2; ++n) bv[bj][n] = bias ? *(const f32x4*)(bias + (size_t)u.e * bias_stride + col0 + bj * HALF + 4 * n) : (f32x4){0.f, 0.f, 0.f, 0.f};
#pragma unroll
        for (int ai = 0; ai < 2; ++ai)
#pragma unroll
            for (int m = 0; m < 4; ++m) { bf16_t* rowp = O + (size_t)(row0 + ai * HALF + m * 16) * ldc + col0;
#pragma unroll
                for (int bj = 0; bj < 2; ++bj) { f32x4 v0 = acc[ai][bj][m][0] + bv[bj][0], v1 = acc[ai][bj][m][1] + bv[bj][1];
                    if (sg) { v0 = sig4(v0); v1 = sig4(v1); }
                    *(u32x4*)(rowp + bj * HALF) = pack8(v0, v1); } }
    }
};

struct EpiProj {
    bf16_t* PROJ; bf16_t* QA2; bf16_t* KA2; float* KMEAN; bf16_t* CQN; bf16_t* CKVN;
    const float* gq; const float* gk; const float* glq; const float* glkv; const float* cosA; const float* sinA; LAS float* xch;
    float* KPESS;
    __device__ __forceinline__ void operator()(EPI_ARGS) const {
        const int row0 = u.pm * BM + wr * 64 + fr, col0 = u.pn * BM + wc * 32 + 8 * fq;
        if (u.pn < 4) {
            const bool isk = u.pn >= 2; const int h = 4 * (u.pn & 1) + wc; const float* gn = isk ? gk : gq; const float sc = isk ? 1.0f : C2A;
            const f32x4 g1a = *(const f32x4*)(gn + 8 * fq), g1b = *(const f32x4*)(gn + 8 * fq + 4), g2a = *(const f32x4*)(gn + 32 + 8 * fq), g2b = *(const f32x4*)(gn + 36 + 8 * fq);
            bf16_t* dst = isk ? KA2 : QA2;
            f32x4 ks1a = {0.f, 0.f, 0.f, 0.f}, ks1b = ks1a, ks2a = ks1a, ks2b = ks1a;
#pragma unroll
            for (int ai = 0; ai < 2; ++ai)
#pragma unroll
                for (int m = 0; m < 4; ++m) { const int row = row0 + ai * HALF + m * 16; const int pos = row & (SEQ - 1);
                    f32x4 x1a = acc[ai][0][m][0], x1b = acc[ai][0][m][1], x2a = acc[ai][1][m][0], x2b = acc[ai][1][m][1];
                    float ss = (x1a[0] * x1a[0] + x1a[1] * x1a[1]) + (x1a[2] * x1a[2] + x1a[3] * x1a[3]) + (x1b[0] * x1b[0] + x1b[1] * x1b[1]) + (x1b[2] * x1b[2] + x1b[3] * x1b[3])
                             + (x2a[0] * x2a[0] + x2a[1] * x2a[1]) + (x2a[2] * x2a[2] + x2a[3] * x2a[3]) + (x2b[0] * x2b[0] + x2b[1] * x2b[1]) + (x2b[2] * x2b[2] + x2b[3] * x2b[3]);
                    ss += __shfl_xor(ss, 16); ss += __shfl_xor(ss, 32);
                    const float rstd = 1.0f / sqrtf(ss * (1.f / 64.f) + EPS);
                    x1a = x1a * g1a * rstd; x1b = x1b * g1b * rstd; x2a = x2a * g2a * rstd; x2b = x2b * g2b * rstd;
                    const f32x4 ca = *(const f32x4*)(cosA + pos * 32 + 8 * fq), cb = *(const f32x4*)(cosA + pos * 32 + 8 * fq + 4), sa = *(const f32x4*)(sinA + pos * 32 + 8 * fq), sb = *(const f32x4*)(sinA + pos * 32 + 8 * fq + 4);
                    const f32x4 y1a = x1a * ca - x2a * sa, y1b = x1b * cb - x2b * sb, y2a = x2a * ca + x1a * sa, y2b = x2b * cb + x1b * sb;
                    bf16_t* rp = dst + (size_t)row * 512 + h * 64 + 8 * fq;
                    *(u32x4*)rp = pack8(y1a * sc, y1b * sc); *(u32x4*)(rp + 32) = pack8(y2a * sc, y2b * sc);
                    ks1a += y1a; ks1b += y1b; ks2a += y2a; ks2b += y2b; }
            if (isk) {
#pragma unroll
                for (int o = 1; o < 16; o <<= 1) {
#pragma unroll
                    for (int i = 0; i < 4; ++i) { ks1a[i] += __shfl_xor(ks1a[i], o); ks1b[i] += __shfl_xor(ks1b[i], o); ks2a[i] += __shfl_xor(ks2a[i], o); ks2b[i] += __shfl_xor(ks2b[i], o); } }
                if (fr == 0) { float* km = KMEAN + (((size_t)(u.pm >> 3) * 8 + h) * 8 + (u.pm & 7)) * 64 + 8 * fq;
#pragma unroll
                    for (int i = 0; i < 4; ++i) { atomicAdd(km + i, ks1a[i] * (1.f / 256.f)); atomicAdd(km + 4 + i, ks1b[i] * (1.f / 256.f)); atomicAdd(km + 32 + i, ks2a[i] * (1.f / 256.f)); atomicAdd(km + 36 + i, ks2b[i] * (1.f / 256.f)); } } }
        } else if (u.pn == 6 || u.pn == 7) {
            const bool isq = u.pn == 6;
            float ssr[2][4];
#pragma unroll
            for (int ai = 0; ai < 2; ++ai)
#pragma unroll
                for (int m = 0; m < 4; ++m) { float ss = 0.f;
#pragma unroll
                    for (int bj = 0; bj < 2; ++bj) { if (bj == 1 && !isq) continue;
#pragma unroll
                        for (int n = 0; n < 2; ++n) { const f32x4 x = acc[ai][bj][m][n]; ss += (x[0] * x[0] + x[1] * x[1]) + (x[2] * x[2] + x[3] * x[3]); } }
                    ss += __shfl_xor(ss, 16); ss += __shfl_xor(ss, 32);
                    if (fq == 0) xch[(ai * HALF + wr * 64 + m * 16 + fr) * 4 + wc] = ss; }
            asm volatile("s_waitcnt lgkmcnt(0)" ::: "memory"); __builtin_amdgcn_s_barrier(); asm volatile("" ::: "memory");
#pragma unroll
            for (int ai = 0; ai < 2; ++ai)
#pragma unroll
                for (int m = 0; m < 4; ++m) { const f32x4 p4 = *(const LAS f32x4*)(xch + (ai * HALF + wr * 64 + m * 16 + fr) * 4); ssr[ai][m] = (p4[0] + p4[1]) + (p4[2] + p4[3]); }
            asm volatile("s_waitcnt lgkmcnt(0)" ::: "memory"); __builtin_amdgcn_s_barrier(); asm volatile("" ::: "memory");
            const float invn = isq ? (1.f / 256.f) : (1.f / 128.f); const float* gl = isq ? glq : glkv; bf16_t* dn = isq ? CQN : CKVN; const int ldn = isq ? 256 : 128;
            const int c0 = wc * 32 + 8 * fq;
#pragma unroll
            for (int bj = 0; bj < 2; ++bj) {
                if (bj == 1 && !isq) {
#pragma unroll
                    for (int ai = 0; ai < 2; ++ai)
#pragma unroll
                        for (int m = 0; m < 4; ++m) { const f32x4 x0 = acc[ai][1][m][0], x1 = acc[ai][1][m][1];
                            *(u32x4*)(PROJ + (size_t)(row0 + ai * HALF + m * 16) * DINP + col0 + HALF) = pack8(x0, x1);
                            float ss = (x0[0] * x0[0] + x0[1] * x0[1]) + (x0[2] * x0[2] + x0[3] * x0[3]) + (x1[0] * x1[0] + x1[1] * x1[1]) + (x1[2] * x1[2] + x1[3] * x1[3]);
                            ss += __shfl_xor(ss, 16); ss += __shfl_xor(ss, 32);
                            if (wc == 0 && fq == 0) KPESS[row0 + ai * HALF + m * 16] = ss; }
                    continue; }
                const f32x4 ga = *(const f32x4*)(gl + bj * HALF + c0), gb = *(const f32x4*)(gl + bj * HALF + c0 + 4);
#pragma unroll
                for (int ai = 0; ai < 2; ++ai)
#pragma unroll
                    for (int m = 0; m < 4; ++m) { const float rstd = 1.0f / sqrtf(ssr[ai][m] * invn + EPS);
                        *(u32x4*)(dn + (size_t)(row0 + ai * HALF + m * 16) * ldn + bj * HALF + c0) = pack8(acc[ai][bj][m][0] * ga * rstd, acc[ai][bj][m][1] * gb * rstd); } }
        } else {
            const bool sg = u.pn >= 8;
#pragma unroll
            for (int ai = 0; ai < 2; ++ai)
#pragma unroll
                for (int m = 0; m < 4; ++m) { bf16_t* rowp = PROJ + (size_t)(row0 + ai * HALF + m * 16) * DINP + col0;
#pragma unroll
                    for (int bj = 0; bj < 2; ++bj) { f32x4 v0 = acc[ai][bj][m][0], v1 = acc[ai][bj][m][1];
                        if (sg) { v0 = sig4(v0); v1 = sig4(v1); }
                        *(u32x4*)(rowp + bj * HALF) = pack8(v0, v1); } }
        }
    }
};

struct EpiQB {
    bf16_t* QB; const float* gn; const float* cosB; const float* sinB; LAS float* xch;
    __device__ __forceinline__ void operator()(EPI_ARGS) const {
        const int rl0 = wr * 64 + fr, row0 = u.pm * BM + rl0;
#pragma unroll
        for (int ai = 0; ai < 2; ++ai)
#pragma unroll
            for (int m = 0; m < 4; ++m)
#pragma unroll
                for (int bj = 0; bj < 2; ++bj) { const f32x4 x0 = acc[ai][bj][m][0], x1 = acc[ai][bj][m][1];
                    float ss = (x0[0] * x0[0] + x0[1] * x0[1]) + (x0[2] * x0[2] + x0[3] * x0[3]) + (x1[0] * x1[0] + x1[1] * x1[1]) + (x1[2] * x1[2] + x1[3] * x1[3]);
                    ss += __shfl_xor(ss, 16); ss += __shfl_xor(ss, 32);
                    if (fq == 0) xch[((rl0 + ai * HALF + m * 16) * 2 + bj) * 4 + wc] = ss; }
        asm volatile("s_waitcnt lgkmcnt(0)" ::: "memory"); __builtin_amdgcn_s_barrier(); asm volatile("" ::: "memory");
#define QB_RS(ai, m, bj) ({ const f32x4 p4_ = *(const LAS f32x4*)(xch + ((rl0 + (ai) * HALF + (m) * 16) * 2 + (bj)) * 4); C2B / sqrtf(((p4_[0] + p4_[1]) + p4_[2]) * (1.f / 96.f) + EPS); })
        if (wc < 2) { const f32x4 ga = *(const f32x4*)(gn + 32 * wc + 8 * fq), gb = *(const f32x4*)(gn + 32 * wc + 8 * fq + 4);
#pragma unroll
            for (int ai = 0; ai < 2; ++ai)
#pragma unroll
                for (int m = 0; m < 4; ++m)
#pragma unroll
                    for (int bj = 0; bj < 2; ++bj) { const float r = QB_RS(ai, m, bj);
                        *(u32x4*)(QB + (size_t)(row0 + ai * HALF + m * 16) * 768 + (2 * u.pn + bj) * 96 + 32 * wc + 8 * fq) = pack8(acc[ai][bj][m][0] * ga * r, acc[ai][bj][m][1] * gb * r); }
        } else if (wc == 2) { const f32x4 g1 = *(const f32x4*)(gn + 64 + 4 * fq), g2 = *(const f32x4*)(gn + 80 + 4 * fq);
#pragma unroll
            for (int ai = 0; ai < 2; ++ai)
#pragma unroll
                for (int m = 0; m < 4; ++m) { const int row = row0 + ai * HALF + m * 16; const int pos = row & (SEQ - 1);
                    const f32x4 c4 = *(const f32x4*)(cosB + pos * 16 + 4 * fq), s4 = *(const f32x4*)(sinB + pos * 16 + 4 * fq);
#pragma unroll
                    for (int bj = 0; bj < 2; ++bj) { const float r = QB_RS(ai, m, bj); const f32x4 x1 = acc[ai][bj][m][0] * g1 * r, x2 = acc[ai][bj][m][1] * g2 * r;
                        const f32x4 y1 = x1 * c4 - x2 * s4, y2 = x2 * c4 + x1 * s4; bf16_t* rp = QB + (size_t)row * 768 + (2 * u.pn + bj) * 96 + 64 + 4 * fq;
                        *(u32x2*)rp = (u32x2){cvt_pk_bf16(y1[0], y1[1]), cvt_pk_bf16(y1[2], y1[3])}; *(u32x2*)(rp + 16) = (u32x2){cvt_pk_bf16(y2[0], y2[1]), cvt_pk_bf16(y2[2], y2[3])}; } }
        }
    }
};
struct EpiKV {
    bf16_t* KB2; bf16_t* KV; const bf16_t* PROJ; const float* KPESS; const float* gn; const float* cosB; const float* sinB; LAS float* xch;
    __device__ __forceinline__ void operator()(EPI_ARGS) const {
        const int rl0 = wr * 64 + fr, row0 = u.pm * BM + rl0;
        if (wc < 2) {
#pragma unroll
            for (int ai = 0; ai < 2; ++ai)
#pragma unroll
                for (int m = 0; m < 4; ++m)
#pragma unroll
                    for (int bj = 0; bj < 2; ++bj) { const f32x4 x0 = acc[ai][bj][m][0], x1 = acc[ai][bj][m][1];
                        float ss = (x0[0] * x0[0] + x0[1] * x0[1]) + (x0[2] * x0[2] + x0[3] * x0[3]) + (x1[0] * x1[0] + x1[1] * x1[1]) + (x1[2] * x1[2] + x1[3] * x1[3]);
                        ss += __shfl_xor(ss, 16); ss += __shfl_xor(ss, 32);
                        if (fq == 0) xch[((rl0 + ai * HALF + m * 16) * 2 + bj) * 4 + wc] = ss; } }
        asm volatile("s_waitcnt lgkmcnt(0)" ::: "memory"); __builtin_amdgcn_s_barrier(); asm volatile("" ::: "memory");
#define KV_RS(ai, m, bj, pe) ({ const f32x2 p2_ = *(const LAS f32x2*)(xch + ((rl0 + (ai) * HALF + (m) * 16) * 2 + (bj)) * 4); 1.0f / sqrtf(((p2_[0] + p2_[1]) + (pe)) * (1.f / 96.f) + EPS); })
        if (wc < 2) { const f32x4 ga = *(const f32x4*)(gn + 32 * wc + 8 * fq), gb = *(const f32x4*)(gn + 32 * wc + 8 * fq + 4);
#pragma unroll
            for (int ai = 0; ai < 2; ++ai)
#pragma unroll
                for (int m = 0; m < 4; ++m) { const float pe = KPESS[row0 + ai * HALF + m * 16];
#pragma unroll
                    for (int bj = 0; bj < 2; ++bj) { const float r = KV_RS(ai, m, bj, pe);
                        *(u32x4*)(KB2 + (size_t)(row0 + ai * HALF + m * 16) * 768 + (2 * u.pn + bj) * 96 + 32 * wc + 8 * fq) = pack8(acc[ai][bj][m][0] * ga * r, acc[ai][bj][m][1] * gb * r); } }
        } else {
#pragma unroll
            for (int ai = 0; ai < 2; ++ai)
#pragma unroll
                for (int m = 0; m < 4; ++m)
#pragma unroll
                    for (int bj = 0; bj < 2; ++bj) *(u32x4*)(KV + (size_t)(row0 + ai * HALF + m * 16) * 1024 + (2 * u.pn + bj) * 128 + 32 * wc + 8 * fq) = pack8(acc[ai][bj][m][0], acc[ai][bj][m][1]);
            if (wc == 2) {
                const f32x4 g1 = *(const f32x4*)(gn + 64 + 4 * fq), g2 = *(const f32x4*)(gn + 80 + 4 * fq);
#pragma unroll
                for (int ai = 0; ai < 2; ++ai)
#pragma unroll
                    for (int m = 0; m < 4; ++m) { const int row = row0 + ai * HALF + m * 16; const int pos = row & (SEQ - 1); const float pe = KPESS[row];
                        const u32x2 w1 = *(const u32x2*)(PROJ + (size_t)row * DINP + PC_KPE + 4 * fq), w2 = *(const u32x2*)(PROJ + (size_t)row * DINP + PC_KPE + 16 + 4 * fq);
                        const f32x4 k1 = (f32x4){bflo(w1.x), bfhi(w1.x), bflo(w1.y), bfhi(w1.y)} * g1, k2 = (f32x4){bflo(w2.x), bfhi(w2.x), bflo(w2.y), bfhi(w2.y)} * g2;
                        const f32x4 c4 = *(const f32x4*)(cosB + pos * 16 + 4 * fq), s4 = *(const f32x4*)(sinB + pos * 16 + 4 * fq);
                        const f32x4 y1 = k1 * c4 - k2 * s4, y2 = k2 * c4 + k1 * s4;
#pragma unroll
                        for (int bj = 0; bj < 2; ++bj) { const float r = KV_RS(ai, m, bj, pe); bf16_t* rp = KB2 + (size_t)row * 768 + (2 * u.pn + bj) * 96 + 64 + 4 * fq;
                            *(u32x2*)rp = (u32x2){cvt_pk_bf16(y1[0] * r, y1[1] * r), cvt_pk_bf16(y1[2] * r, y1[3] * r)}; *(u32x2*)(rp + 16) = (u32x2){cvt_pk_bf16(y2[0] * r, y2[1] * r), cvt_pk_bf16(y2[2] * r, y2[3] * r)}; } } }
        }
    }
};
#undef QB_RS
#undef KV_RS
template <bool ADD> struct EpiGate {
    bf16_t* O; const bf16_t* G; int ldg; unsigned char* MF8;
    __device__ __forceinline__ void operator()(EPI_ARGS) const {
        const int row0 = u.pm * BM + wr * 64 + fr, col0 = u.pn * BM + wc * 32 + 8 * fq;
#pragma unroll
        for (int ai = 0; ai < 2; ++ai)
#pragma unroll
            for (int m = 0; m < 4; ++m) { const size_t r = (size_t)(row0 + ai * HALF + m * 16);
#pragma unroll
                for (int bj = 0; bj < 2; ++bj) { const int c = col0 + bj * HALF;
                    f32x4 g0, g1; unpack8(*(const u32x4*)(G + r * ldg + c), g0, g1);
                    f32x4 v0 = acc[ai][bj][m][0] * g0, v1 = acc[ai][bj][m][1] * g1;
                    if (ADD) { f32x4 o0, o1; unpack8(*(const u32x4*)(O + r * DM + c), o0, o1); v0 += o0; v1 += o1;
                        *(u32x2*)(MF8 + r * DM + c) = (u32x2){pack4_fp8(v0[0], v0[1], v0[2], v0[3]), pack4_fp8(v1[0], v1[1], v1[2], v1[3])}; }
                    else *(u32x4*)(O + r * DM + c) = pack8(v0, v1); } }
    }
};

struct BranchOrder {
    StaticOrder so;
    __device__ bool next(int i, Unit& u) const { if (i >= 2) return false; if (!so.next(0, u)) return false; u.e = i; u.aofs = i * 512; u.pb = u.pn + 8 * i; return true; }
};
struct EpiGateAB {
    bf16_t* O; const bf16_t* Ga; const bf16_t* Gb; int ldg; unsigned char* MF8;
    __device__ __forceinline__ void operator()(EPI_ARGS) const {
        if (u.e == 0) { EpiGate<false> E{O, Ga, ldg, nullptr}; E(acc, u, wr, wc, fr, fq); }
        else { asm volatile("s_waitcnt vmcnt(0)" ::: "memory");
               EpiGate<true> E{O, Gb, ldg, MF8}; E(acc, u, wr, wc, fr, fq); }
    }
};
struct EpiResF32 {
    const float* base; bf16_t* out; float* ssp;
    __device__ __forceinline__ void operator()(EPI_ARGS) const {
        const int row0 = u.pm * BM + wr * 64 + fr, col0 = u.pn * BM + wc * 32 + 8 * fq;
#pragma unroll
        for (int ai = 0; ai < 2; ++ai)
#pragma unroll
            for (int m = 0; m < 4; ++m) { const size_t r = (size_t)(row0 + ai * HALF + m * 16); float ss = 0.f;
#pragma unroll
                for (int bj = 0; bj < 2; ++bj) { const size_t off = r * DM + col0 + bj * HALF;
                    const f32x4 b0 = *(const f32x4*)(base + off), b1 = *(const f32x4*)(base + off + 4);
                    const f32x4 y0 = b0 + acc[ai][bj][m][0], y1 = b1 + acc[ai][bj][m][1];
                    *(u32x4*)(out + off) = pack8(y0, y1);
                    ss += (y0[0] * y0[0] + y0[1] * y0[1]) + (y0[2] * y0[2] + y0[3] * y0[3]) + (y1[0] * y1[0] + y1[1] * y1[1]) + (y1[2] * y1[2] + y1[3] * y1[3]); }
                ss += __shfl_xor(ss, 16); ss += __shfl_xor(ss, 32);
                if (fq == 0) ssp[r * 16 + u.pn * 4 + wc] = ss; }
    }
};
struct EpiSwiglu {
    unsigned char* O; const float* bias;
    __device__ __forceinline__ void operator()(EPI_ARGS) const {
        const int row0 = u.pm * BM + wr * 64 + fr, j0 = u.pn * HALF + wc * 32 + 8 * fq;
        const float* be = bias + (size_t)u.e * 2048;
        f32x4 bg[2], bu[2];
#pragma unroll
        for (int n = 0; n < 2; ++n) { bg[n] = *(const f32x4*)(be + j0 + 4 * n); bu[n] = *(const f32x4*)(be + 1024 + j0 + 4 * n); }
#pragma unroll
        for (int ai = 0; ai < 2; ++ai)
#pragma unroll
            for (int m = 0; m < 4; ++m) { unsigned char* rowp = O + (size_t)(row0 + ai * HALF + m * 16) * DEXP + j0;
                f32x4 o[2];
#pragma unroll
                for (int n = 0; n < 2; ++n) { const f32x4 gv = acc[ai][0][m][n] + bg[n], uv = acc[ai][1][m][n] + bu[n];
#pragma unroll
                    for (int i = 0; i < 4; i += 2) {
                        const f32x2 gg = {fminf(gv[i], 7.0f), fminf(gv[i + 1], 7.0f)}, uu = {__builtin_amdgcn_fmed3f(uv[i], -7.0f, 7.0f), __builtin_amdgcn_fmed3f(uv[i + 1], -7.0f, 7.0f)};
                        const f32x2 ea = gg * (-1.702f * LOG2E); const f32x2 den = (f32x2){__builtin_amdgcn_exp2f(ea.x), __builtin_amdgcn_exp2f(ea.y)} + 1.0f;
                        const f32x2 num = uu * gg + gg; const f32x2 r = num * (f32x2){__builtin_amdgcn_rcpf(den.x), __builtin_amdgcn_rcpf(den.y)};
                        o[n][i] = r.x; o[n][i + 1] = r.y; } }
                *(u32x2*)rowp = (u32x2){pack4_fp8(o[0][0], o[0][1], o[0][2], o[0][3]), pack4_fp8(o[1][0], o[1][1], o[1][2], o[1][3])}; }
    }
};
struct EpiFinal {
    float* out; const bf16_t* PP; const bf16_t* X2;
    __device__ __forceinline__ void operator()(EPI_ARGS) const {
        const int row0 = u.pm * BM + wr * 64 + fr, col0 = u.pn * BM + wc * 32 + 8 * fq;
#pragma unroll
        for (int ai = 0; ai < 2; ++ai)
#pragma unroll
            for (int m = 0; m < 4; ++m) { const size_t r = (size_t)(row0 + ai * HALF + m * 16);
#pragma unroll
                for (int bj = 0; bj < 2; ++bj) { const size_t off = r * DM + col0 + bj * HALF;
                    f32x4 p0, p1, b0, b1; unpack8(*(const u32x4*)(PP + off), p0, p1); unpack8(*(const u32x4*)(X2 + off), b0, b1);
                    *(f32x4*)(out + off) = b0 + sig4(acc[ai][bj][m][0]) * p0; *(f32x4*)(out + off + 4) = b1 + sig4(acc[ai][bj][m][1]) * p1; } }
    }
};
}

namespace att {
__device__ __forceinline__ int crow(int r, int hi) { return (r & 3) + 8 * (r >> 2) + 4 * hi; }
__device__ __forceinline__ void glds16(const void* gsrc, unsigned lds_dst) { unsigned keep;
    asm volatile("s_mov_b32 %0, m0\n\ts_mov_b32 m0, %2\n\ts_nop 0\n\tglobal_load_lds_dwordx4 %1, off\n\ts_mov_b32 m0, %0" : "=&s"(keep) : "v"(gsrc), "s"(lds_dst) : "memory"); }
__device__ __forceinline__ s16x4 vtr(const LAS unsigned char* p) { return __builtin_bit_cast(s16x4, __builtin_amdgcn_ds_read_tr16_b64_v4i16((LAS s16x4*)p)); }
#define MX3(a, b, c) __builtin_fmaxf(__builtin_fmaxf((a), (b)), (c))
constexpr int VSLOT = 8192, OST_BYTES = NWAVES * 4096, WSF_BYTES = NWAVES * 256;

template <int DQK, bool MOBA>
__device__ __forceinline__ void attn_unit(int b, int qb, const bf16_t* Qh, int ldq, const bf16_t* Kh, int ldk, const bf16_t* Vh, int ldv, unsigned char* Oh, int ldo, const float* kmean, LAS unsigned char* shm, int wave) {
    constexpr int ND = DQK / 16, NCH = DQK / 8, KSLOT = NCH * 1024;
    constexpr int LDS_K = 0, LDS_V = 2 * KSLOT, LDS_WS = LDS_V + 2 * VSLOT, LDS_OST = LDS_WS + WSF_BYTES;
    static_assert(LDS_OST + OST_BYTES <= RING_BYTES, "attention LDS");
    int lane = lane_id(); asm volatile("" : "+v"(lane));
    const int r32 = lane & 31, hi = lane >> 5; const int wid = wave;
    const long rowbase = (long)b * SEQ; const int q0 = qb * 256;
    const unsigned lds0 = (unsigned)(uintptr_t)shm;
    LAS float* wsf = (LAS float*)(shm + LDS_WS) + wid * 64;
    const int NT = 4 * (qb + 1);
    const bf16_t* ksrc0 = Kh + (rowbase + lane) * ldk + wid * 8;
    const bf16_t* vsrc0 = Vh + (rowbase + 16 * (wid & 3) + (lane >> 2)) * ldv + (wid >> 2) * 32 + (lane & 3) * 8;
#define ATT_DMA(kt, s) do { const long ro_ = (long)(kt) * 64; \
        glds16(ksrc0 + ro_ * ldk, (unsigned)__builtin_amdgcn_readfirstlane(lds0 + LDS_K + (s) * KSLOT + wid * 1024)); \
        if (NCH > 8 && wid < NCH - 8) glds16(ksrc0 + ro_ * ldk + 64, (unsigned)__builtin_amdgcn_readfirstlane(lds0 + LDS_K + (s) * KSLOT + (wid + 8) * 1024)); \
        glds16(vsrc0 + ro_ * ldv, (unsigned)__builtin_amdgcn_readfirstlane(lds0 + LDS_V + (s) * VSLOT + wid * 1024)); } while (0)
#define ATT_TILE(i) (MOBA ? ((i) < 4 ? 4 * qb + (i) : (i) - 4) : (i))
    ATT_DMA(ATT_TILE(0), 0);
    const bf16_t* Qw = Qh + (rowbase + q0 + wid * 32 + r32) * ldq + hi * 8;
    bf16x8 qr[ND];
#pragma unroll
    for (int d0 = 0; d0 < ND; ++d0) qr[d0] = *(const bf16x8*)(Qw + d0 * 16);
    unsigned bmask = 0xffffffffu;
    if (MOBA) {
        bmask = 1u << qb;
        if (qb <= 3) bmask |= (1u << qb) - 1u;
        else {
            float gsc[7];
#pragma unroll
            for (int n = 0; n < 7; ++n) { float s = 0.f;
                if (n < qb) {
#pragma unroll
                    for (int d0 = 0; d0 < ND; ++d0) { const float* km = kmean + n * 64 + d0 * 16 + hi * 8; const f32x4 k0 = *(const f32x4*)km, k1 = *(const f32x4*)(km + 4);
                        s += bf2f((unsigned short)qr[d0][0]) * k0[0] + bf2f((unsigned short)qr[d0][1]) * k0[1] + bf2f((unsigned short)qr[d0][2]) * k0[2] + bf2f((unsigned short)qr[d0][3]) * k0[3]
                           + bf2f((unsigned short)qr[d0][4]) * k1[0] + bf2f((unsigned short)qr[d0][5]) * k1[1] + bf2f((unsigned short)qr[d0][6]) * k1[2] + bf2f((unsigned short)qr[d0][7]) * k1[3]; }
                    s += __shfl_xor(s, 32);
                } else s = -INFINITY;
                gsc[n] = s; }
#pragma unroll
            for (int pass = 0; pass < 3; ++pass) { float best = -INFINITY; int bi = 0;
#pragma unroll
                for (int n = 0; n < 7; ++n) { const bool ok = (n < qb) && !((bmask >> n) & 1u) && (gsc[n] > best); best = ok ? gsc[n] : best; bi = ok ? n : bi; }
                bmask |= 1u << bi; }
        }
    }
    asm volatile("s_waitcnt vmcnt(0)" ::: "memory");
#pragma unroll
    for (int d0 = 0; d0 < ND; ++d0) asm volatile("" : "+v"(qr[d0]));
    float mhat = 0.f, l_reg = 0.f; f32x16 o[2]; o[0] = f32x16{}; o[1] = f32x16{}; f32x16 negm = f32x16{}; asm volatile("" : "+v"(negm));
    const int qrel = wid * 32 + r32;
    const LAS unsigned char* kp0 = shm + LDS_K + hi * 1024 + r32 * 16;
    const LAS unsigned char* vp0 = shm + LDS_V + ((lane >> 4) & 1) * 32 + (lane & 3) * 8 + (4 * hi + ((lane & 15) >> 2)) * 64;
    for (int i = 0; i < NT; ++i) {
        const int s = i & 1, kt = ATT_TILE(i);
        asm volatile("s_waitcnt vmcnt(0) lgkmcnt(0)\n\ts_barrier" ::: "memory");
        if (i + 1 < NT) ATT_DMA(ATT_TILE(i + 1), s ^ 1);
        f32x16 cin = negm;
        if (MOBA) { if (i >= 4 && !((bmask >> (kt >> 2)) & 1u)) {
#pragma unroll
            for (int r = 0; r < 16; ++r) cin[r] = -INFINITY; } }
        f32x16 p0, p1;
        { const LAS unsigned char* kb = kp0 + s * KSLOT; bf16x8 kf[2 * ND];
#pragma unroll
            for (int d0 = 0; d0 < ND; ++d0) { kf[2 * d0] = *(const LAS bf16x8*)(kb + d0 * 2048); kf[2 * d0 + 1] = *(const LAS bf16x8*)(kb + d0 * 2048 + 512); }
            __builtin_amdgcn_sched_barrier(0);
#pragma unroll
            for (int d0 = 0; d0 < ND; ++d0) {
                if (d0 == 0) { p0 = __builtin_amdgcn_mfma_f32_32x32x16_bf16(kf[0], qr[0], cin, 0, 0, 0); p1 = __builtin_amdgcn_mfma_f32_32x32x16_bf16(kf[1], qr[0], cin, 0, 0, 0); }
                else { p0 = __builtin_amdgcn_mfma_f32_32x32x16_bf16(kf[2 * d0], qr[d0], p0, 0, 0, 0); p1 = __builtin_amdgcn_mfma_f32_32x32x16_bf16(kf[2 * d0 + 1], qr[d0], p1, 0, 0, 0); } } }
        if (kt >= 4 * qb) { const int kb = 64 * (kt - 4 * qb) + 4 * hi;
#pragma unroll
            for (int r = 0; r < 16; ++r) { const int kv = kb + (r & 3) + 8 * (r >> 2); if (kv > qrel) p0[r] = -INFINITY; if (kv + 32 > qrel) p1[r] = -INFINITY; } }
        bool resc = false;
        { float a = MX3(p0[0], p0[1], p1[0]), bb = MX3(p0[2], p0[3], p1[1]); a = MX3(a, p1[2], p1[3]);
#pragma unroll
            for (int r = 4; r < 16; r += 4) { a = MX3(a, p0[r], p0[r + 1]); bb = MX3(bb, p0[r + 2], p0[r + 3]); a = MX3(a, p1[r], p1[r + 1]); bb = MX3(bb, p1[r + 2], p1[r + 3]); }
            float rm = __builtin_fmaxf(a, bb); rm = __builtin_fmaxf(rm, __shfl_xor(rm, 32));
            const bool first = (i == 0);
            if (first || __any(rm > 6.0f)) {
                const float dl = first ? rm : __builtin_fmaxf(rm, 0.f); mhat += dl;
#pragma unroll
                for (int r = 0; r < 16; ++r) { p0[r] -= dl; p1[r] -= dl; }
#pragma unroll
                for (int r = 0; r < 16; ++r) negm[r] = -mhat;
                asm volatile("" : "+v"(negm));
                const float f = __builtin_amdgcn_exp2f(-dl); l_reg *= f; if (hi == 0) wsf[r32] = f; resc = true; } }
        float sacc = 0.f;
#pragma unroll
        for (int r = 0; r < 16; ++r) { p0[r] = __builtin_amdgcn_exp2f(p0[r]); p1[r] = __builtin_amdgcn_exp2f(p1[r]); sacc += p0[r] + p1[r]; }
        l_reg += sacc;
        u32x4 pw0, pw1, pw2, pw3;
        pw0 = (u32x4){cvt_pk_bf16(p0[0], p0[1]), cvt_pk_bf16(p0[2], p0[3]), cvt_pk_bf16(p0[4], p0[5]), cvt_pk_bf16(p0[6], p0[7])};
        pw1 = (u32x4){cvt_pk_bf16(p0[8], p0[9]), cvt_pk_bf16(p0[10], p0[11]), cvt_pk_bf16(p0[12], p0[13]), cvt_pk_bf16(p0[14], p0[15])};
        pw2 = (u32x4){cvt_pk_bf16(p1[0], p1[1]), cvt_pk_bf16(p1[2], p1[3]), cvt_pk_bf16(p1[4], p1[5]), cvt_pk_bf16(p1[6], p1[7])};
        pw3 = (u32x4){cvt_pk_bf16(p1[8], p1[9]), cvt_pk_bf16(p1[10], p1[11]), cvt_pk_bf16(p1[12], p1[13]), cvt_pk_bf16(p1[14], p1[15])};
        if (resc) {
#pragma unroll
            for (int d_ = 0; d_ < 2; ++d_)
#pragma unroll
                for (int r = 0; r < 16; ++r) o[d_][r] *= wsf[crow(r, hi)];
        }
        { const LAS unsigned char* vp = vp0 + s * VSLOT;
#pragma unroll
            for (int d0 = 0; d0 < 2; ++d0) {
                s16x4 lo[4], hh[4];
#pragma unroll
                for (int ks = 0; ks < 4; ++ks) { lo[ks] = vtr(vp + d0 * 4096 + ks * 1024); hh[ks] = vtr(vp + d0 * 4096 + ks * 1024 + 512); }
                __builtin_amdgcn_sched_barrier(0);
#define PKV(k) (bf16x8){lo[k][0], lo[k][1], lo[k][2], lo[k][3], hh[k][0], hh[k][1], hh[k][2], hh[k][3]}
                o[d0] = __builtin_amdgcn_mfma_f32_32x32x16_bf16(__builtin_bit_cast(bf16x8, pw0), PKV(0), o[d0], 0, 0, 0);
                o[d0] = __builtin_amdgcn_mfma_f32_32x32x16_bf16(__builtin_bit_cast(bf16x8, pw1), PKV(1), o[d0], 0, 0, 0);
                o[d0] = __builtin_amdgcn_mfma_f32_32x32x16_bf16(__builtin_bit_cast(bf16x8, pw2), PKV(2), o[d0], 0, 0, 0);
                o[d0] = __builtin_amdgcn_mfma_f32_32x32x16_bf16(__builtin_bit_cast(bf16x8, pw3), PKV(3), o[d0], 0, 0, 0);
#undef PKV
            } }
    }
    l_reg += __shfl_xor(l_reg, 32);
    if (hi == 0) wsf[32 + r32] = l_reg;
    float rli[16];
#pragma unroll
    for (int r = 0; r < 16; ++r) rli[r] = __builtin_amdgcn_rcpf(wsf[32 + crow(r, hi)]);
    unsigned char* Ow = (unsigned char*)Oh + (rowbase + q0 + wid * 32) * ldo;
    { LAS unsigned char* stg = shm + LDS_OST + wid * 2048;
#pragma unroll
        for (int r = 0; r < 16; ++r) { const int orow = crow(r, hi);
#pragma unroll
            for (int d0 = 0; d0 < 2; ++d0) stg[orow * 64 + d0 * 32 + r32] = (unsigned char)(pack4_fp8(o[d0][r] * rli[r], 0.f, 0.f, 0.f) & 0xffu); }
#pragma unroll
        for (int i = 0; i < 2; ++i) { const int row = i * 16 + (lane >> 2), ch = lane & 3; const u32x4 v = *(const LAS u32x4*)(stg + row * 64 + ch * 16); *(u32x4*)(Ow + (long)row * ldo + ch * 16) = v; } }
    asm volatile("s_waitcnt lgkmcnt(0)\n\ts_barrier" ::: "memory");
#undef ATT_DMA
#undef ATT_TILE
}
#undef MX3
}

#define XB_TMO      128
#define XB_XCNT(j)  (256  + 64 * (j))
#define XB_XSUB(j)  (1280 + 64 * (j))
#define XB_XGEN(j)  (2304 + 64 * (j))
#define XB_TOP      3328
#define XB_TOPGEN   3392
#define XCD_BAR_WORDS 3456
#define XB_SPIN_CAP (1u << 22)
__device__ __forceinline__ unsigned xb_ld(unsigned* p)              { return __hip_atomic_load(p, __ATOMIC_RELAXED, __HIP_MEMORY_SCOPE_AGENT); }
__device__ __forceinline__ unsigned xb_add(unsigned* p, unsigned v) { return __hip_atomic_fetch_add(p, v, __ATOMIC_RELAXED, __HIP_MEMORY_SCOPE_AGENT); }
__device__ __forceinline__ unsigned xb_xcc_id() { return (unsigned)__builtin_amdgcn_s_getreg((3 << 11) | 20) & 0xFu; }
#define XB_SPIN(cond, bar) do { unsigned _sp = 0; while (cond) { __builtin_amdgcn_s_sleep(1); \
    if ((++_sp & 255u) == 0u) { if (xb_ld(&(bar)[XB_TMO])) break; if (_sp > XB_SPIN_CAP) { atomicAdd(&(bar)[XB_TMO], 1u); break; } } } } while (0)
struct XcdBarrier { unsigned* bar; unsigned x; volatile LAS unsigned* st; int wave; };
__device__ __forceinline__ XcdBarrier xcd_barrier_post(unsigned* bar, volatile LAS unsigned* st, int wave) {
    XcdBarrier b; b.bar = bar; b.x = xb_xcc_id(); b.st = st; b.wave = wave;
    if (wave == 0 && lane_id() == 0) (void)xb_add(&bar[XB_XCNT(b.x)], 1u);
    return b;
}
__device__ __forceinline__ void xcd_barrier_complete(unsigned* bar, unsigned x, unsigned& nloc, unsigned& nx) {
    const unsigned G = gridDim.x * gridDim.y * gridDim.z;
    unsigned sum, cnt, mine, sp = 0u;
    for (;;) {
        sum = 0u; cnt = 0u; mine = 0u;
#pragma unroll
        for (unsigned j = 0; j < 16; ++j) { const unsigned c = xb_ld(&bar[XB_XCNT(j)]); sum += c; cnt += (c > 0u) ? 1u : 0u; mine = (j == x) ? c : mine; }
        if (sum == G) break;
        __builtin_amdgcn_s_sleep(1);
        if ((++sp & 255u) == 0u) { if (xb_ld(&bar[XB_TMO])) break; if (sp > XB_SPIN_CAP) { atomicAdd(&bar[XB_TMO], 1u); break; } }
    }
    nloc = mine > 0u ? mine : 1u; nx = cnt > 0u ? cnt : 1u;
}
__device__ __forceinline__ void xcd_barrier(const XcdBarrier& b) {
    asm volatile("s_waitcnt vmcnt(0)" ::: "memory");
    __syncthreads();
    if (b.wave == 0 && lane_id() == 0) {
        unsigned* bar = b.bar;
        __builtin_amdgcn_s_waitcnt(0);
        unsigned nloc = b.st[0], nx = b.st[1];
        if (nloc == 0u) { xcd_barrier_complete(bar, b.x, nloc, nx); b.st[0] = nloc; b.st[1] = nx; }
        const unsigned old = xb_add(&bar[XB_XSUB(b.x)], 1u);
        const unsigned gen = old / nloc;
        if (old + 1u == (gen + 1u) * nloc) {
            __builtin_amdgcn_fence(__ATOMIC_RELEASE, "agent");
            asm volatile("s_waitcnt vmcnt(0)" ::: "memory");
            const unsigned og = xb_add(&bar[XB_TOP], 1u);
            const unsigned tg = og / nx;
            if (og + 1u == (tg + 1u) * nx) xb_add(&bar[XB_TOPGEN], 1u);
            else XB_SPIN(xb_ld(&bar[XB_TOPGEN]) == tg, bar);
            __builtin_amdgcn_fence(__ATOMIC_ACQUIRE, "agent");
            xb_add(&bar[XB_XGEN(b.x)], 1u);
            asm volatile("s_waitcnt vmcnt(0)" ::: "memory");
        } else {
            XB_SPIN(xb_ld(&bar[XB_XGEN(b.x)]) == gen, bar);
            __builtin_amdgcn_fence(__ATOMIC_ACQUIRE, "agent");
            asm volatile("s_waitcnt vmcnt(0)" ::: "memory");
        }
    }
    __syncthreads();
}

struct Params { const float* in[25]; float* out; unsigned char* ws; int ph_lo, ph_hi; };
enum { I_X = 0, I_P, I_GMIX, I_WIN, I_MQN, I_MKN, I_QLATN, I_WUQ, I_KVLATN, I_WUKV, I_MLAQN, I_MLAKN, I_WA, I_WB, I_WO, I_GFFN, I_WR, I_BR, I_WGU, I_BGU, I_WD, I_BD, I_GPLE, I_WPG, I_WPP };
constexpr int NPHASE = 16;

struct Frame {
    LAS unsigned char* lds; int vcu, G, wave;
    const Params* P; unsigned char* ws;
};
struct Ids { int tid, lane, wave; };
#define PHASE_IDS() Ids I_; { int l_ = lane_id(); asm volatile("" : "+v"(l_)); I_.lane = l_; I_.wave = F.wave; I_.tid = F.wave * 64 + l_; }

#ifdef TPROBE_A
#define STAMP(k) do { if (blockIdx.x == 0 && F.wave == 0 && lane_id() == 0) ((volatile unsigned long long*)(ws + WS_ERR))[k] = __builtin_amdgcn_s_memrealtime(); } while (0)
#else
#define STAMP(k) do {} while (0)
#endif
__device__ __forceinline__ int rowmap(int mode, int c) {
    if (mode == 1) {
        if (c < 1024) { const int base = c & 512, s_ = c & 511, h = s_ >> 6, d = s_ & 63; return base + 256 * (h >> 2) + 128 * (d >> 5) + 32 * (h & 3) + (d & 31); }
        return c < 1952 ? c : c + 96; }
    if (mode == 2) return c < 1024 ? 256 * (c >> 7) + (c & 127) : 256 * ((c - 1024) >> 7) + 128 + ((c - 1024) & 127);
    if (mode == 3) {
        const int h = c / 96, d = c % 96; int t;
        if (d < 64) t = d; else if (d < 80) { const int i = d - 64; t = 64 + 8 * (i >> 2) + (i & 3); } else { const int i = d - 80; t = 64 + 8 * (i >> 2) + 4 + (i & 3); }
        return 128 * h + t; }
    return c;
}
__device__ __forceinline__ void tr_item64(const float* W, int ldw, int N, int k0, int n0, bf16_t* dst, int ldd, int mode, LAS float* scr, int lane) {
    const int r = lane >> 4, c4 = lane & 15; const bool inb = (n0 + 4 * c4) < N;
    f32x4 v[16];
#pragma unroll
    for (int i = 0; i < 16; ++i) v[i] = inb ? __builtin_nontemporal_load((const f32x4*)(W + (size_t)(k0 + 4 * i + r) * ldw + n0 + 4 * c4)) : (f32x4){0.f, 0.f, 0.f, 0.f};
#pragma unroll
    for (int i = 0; i < 16; ++i) { LAS float* p = scr + (4 * i + r) * 65 + 4 * c4; p[0] = v[i].x; p[1] = v[i].y; p[2] = v[i].z; p[3] = v[i].w; }
    asm volatile("s_waitcnt lgkmcnt(0)" ::: "memory");
    const int c = lane & 7;
#pragma unroll
    for (int j = 0; j < 8; ++j) { const int n = (lane >> 3) + 8 * j; const LAS float* sp = scr + (8 * c) * 65 + n;
        u32x4 o; o.x = cvt_pk_bf16(sp[0 * 65], sp[1 * 65]); o.y = cvt_pk_bf16(sp[2 * 65], sp[3 * 65]); o.z = cvt_pk_bf16(sp[4 * 65], sp[5 * 65]); o.w = cvt_pk_bf16(sp[6 * 65], sp[7 * 65]);
        if (n0 + n < N) *(u32x4*)(dst + (size_t)rowmap(mode, n0 + n) * ldd + k0 + 8 * c) = o; }
    asm volatile("s_waitcnt lgkmcnt(0)" ::: "memory");
}

__device__ __forceinline__ void tr_item_f8(const float* W, int ldw, int k0, int n0, unsigned char* dst, int ldd, int mode, LAS float* scr, int lane) {
    const int r = lane >> 3, c4 = lane & 7;
    f32x4 v[16];
#pragma unroll
    for (int i = 0; i < 16; ++i) v[i] = __builtin_nontemporal_load((const f32x4*)(W + (size_t)(k0 + 8 * i + r) * ldw + n0 + 4 * c4));
#pragma unroll
    for (int i = 0; i < 16; ++i) { LAS float* p = scr + (8 * i + r) * 33 + 4 * c4; p[0] = v[i].x * 64.f; p[1] = v[i].y * 64.f; p[2] = v[i].z * 64.f; p[3] = v[i].w * 64.f; }
    asm volatile("s_waitcnt lgkmcnt(0)" ::: "memory");
    const int c = lane & 7;
#pragma unroll
    for (int j = 0; j < 4; ++j) { const int n = (lane >> 3) + 8 * j; const LAS float* sp = scr + (16 * c) * 33 + n;
        u32x4 o; o.x = pack4_fp8(sp[0 * 33], sp[1 * 33], sp[2 * 33], sp[3 * 33]); o.y = pack4_fp8(sp[4 * 33], sp[5 * 33], sp[6 * 33], sp[7 * 33]);
        o.z = pack4_fp8(sp[8 * 33], sp[9 * 33], sp[10 * 33], sp[11 * 33]); o.w = pack4_fp8(sp[12 * 33], sp[13 * 33], sp[14 * 33], sp[15 * 33]);
        __builtin_nontemporal_store(o, (u32x4*)(dst + (size_t)rowmap(mode, n0 + n) * ldd + k0 + 16 * c)); }
    asm volatile("s_waitcnt lgkmcnt(0)" ::: "memory");
}

__device__ __forceinline__ void phase0(Frame& F) {
    PHASE_IDS();
    const Params& P = *F.P; unsigned char* ws = F.ws;
    LAS float* scr = (LAS float*)(F.lds + I_.wave * 16896);
    const int gw = F.vcu * NWAVES + I_.wave, NGW = F.G * NWAVES;
    constexpr int I_GU = 32 * 8 * 64, I_DN = 32 * 8 * 32, I_IN = 16 * 31, I_ING = 8 * 64, I_UQ = 4 * 12, I_UKV = 2 * 16, I_A = 8 * 16, I_O = 16 * 16, I_PP = 4 * 16;
    constexpr int I_PG = 8 * 32;
    constexpr int NITEMS = I_GU + I_DN + I_IN + I_ING + I_UQ + I_UKV + 2 * I_A + I_O + I_PG + I_PP;
    for (int it = gw; it < NITEMS; it += NGW) {
        int r = it;
        if (r < I_GU) { const int e = r >> 9, q = r & 511, kb = q >> 6, g = q & 63;
            tr_item_f8(P.in[I_WGU] + (size_t)e * 1024 * 2048, 2048, 128 * kb, 32 * g, ws + WS_W1 + (size_t)e * 2048 * 1024, 1024, 2, scr, I_.lane); continue; } r -= I_GU;
        if (r < I_DN) { const int e = r >> 8, q = r & 255, kb = q >> 5, g = q & 31;
            tr_item_f8(P.in[I_WD] + (size_t)e * 1024 * 1024, 1024, 128 * kb, 32 * g, ws + WS_W2 + (size_t)e * 1024 * 1024, 1024, 0, scr, I_.lane); continue; } r -= I_DN;
        if (r < I_IN) { const int kb = r / 31, g = r % 31; tr_item64(P.in[I_WIN], DIN, 1952, 64 * kb, 64 * g, (bf16_t*)(ws + WS_WIN), 1024, 1, scr, I_.lane); continue; } r -= I_IN;
        if (r < I_ING) { const int kb = r >> 6, g = r & 63; tr_item_f8(P.in[I_WIN] + 1952, DIN, 128 * kb, 32 * g, ws + WS_WINF8, 1024, 0, scr, I_.lane); continue; } r -= I_ING;
        if (r < I_UQ) { const int kb = r / 12, g = r % 12; tr_item64(P.in[I_WUQ], 768, 768, 64 * kb, 64 * g, (bf16_t*)(ws + WS_WUQ), 256, 3, scr, I_.lane); continue; } r -= I_UQ;
        if (r < I_UKV) { const int kb = r / 16, g = r % 16; tr_item64(P.in[I_WUKV], 1024, 1024, 64 * kb, 64 * g, (bf16_t*)(ws + WS_WUKV), 128, 0, scr, I_.lane); continue; } r -= I_UKV;
        if (r < I_A) { const int kb = r >> 5, g = r & 31; tr_item_f8(P.in[I_WA], 1024, 128 * kb, 32 * g, ws + WS_WA, 512, 0, scr, I_.lane); continue; } r -= I_A;
        if (r < I_A) { const int kb = r >> 5, g = r & 31; tr_item_f8(P.in[I_WB], 1024, 128 * kb, 32 * g, ws + WS_WB, 512, 0, scr, I_.lane); continue; } r -= I_A;
        if (r < I_PG) { const int kb = r >> 5, g = r & 31; tr_item_f8(P.in[I_WO], 1024, 128 * kb, 32 * g, ws + WS_WO, 1024, 0, scr, I_.lane); continue; } r -= I_PG;
        if (r < I_PG) { const int kb = r >> 5, g = r & 31; tr_item_f8(P.in[I_WPG], 1024, 128 * kb, 32 * g, ws + WS_WPG, 1024, 0, scr, I_.lane); continue; } r -= I_PG;
        { const int kb = r / 16, g = r % 16; tr_item64(P.in[I_WPP], 1024, 1024, 64 * kb, 64 * g, (bf16_t*)(ws + WS_WPP), 256, 0, scr, I_.lane); }
    }
    STAMP(20);
    { const f32x4* gp = (const f32x4*)P.in[I_GMIX] + I_.lane; f32x4 gv[4];
#pragma unroll
        for (int j = 0; j < 4; ++j) gv[j] = gp[64 * j];
        for (int m0 = gw * 4; m0 < NTOK; m0 += NGW * 4) { f32x4 v[4][4];
#pragma unroll
            for (int q = 0; q < 4; ++q) { const f32x4* xr = (const f32x4*)(P.in[I_X] + (size_t)(m0 + q) * DM) + I_.lane;
#pragma unroll
                for (int j = 0; j < 4; ++j) v[q][j] = xr[64 * j]; }
#pragma unroll
            for (int q = 0; q < 4; ++q) { float s = 0.f;
#pragma unroll
                for (int j = 0; j < 4; ++j) s += (v[q][j].x * v[q][j].x + v[q][j].y * v[q][j].y) + (v[q][j].z * v[q][j].z + v[q][j].w * v[q][j].w);
                const float rstd = 1.0f / sqrtf(wave_sum(s) * (1.f / DM) + EPS);
                u32x2* o8 = (u32x2*)((bf16_t*)(ws + WS_HN) + (size_t)(m0 + q) * DM) + I_.lane; unsigned* o4 = (unsigned*)(ws + WS_HNF8 + (size_t)(m0 + q) * DM) + I_.lane;
#pragma unroll
                for (int j = 0; j < 4; ++j) { const f32x4 y = v[q][j] * rstd * gv[j]; o8[64 * j] = (u32x2){cvt_pk_bf16(y.x, y.y), cvt_pk_bf16(y.z, y.w)}; o4[64 * j] = pack4_fp8(y.x, y.y, y.z, y.w); } } } }
    STAMP(21);
    { float* km = (float*)(ws + WS_KMEAN); for (int i = F.vcu * NTHREADS + I_.tid; i < 8 * 8 * 8 * 64; i += F.G * NTHREADS) km[i] = 0.f; }
    { const size_t n4 = (size_t)NTOK * 256 / 4; const f32x4* pp = (const f32x4*)P.in[I_P]; u32x2* po = (u32x2*)(ws + WS_PB); const size_t T = (size_t)F.G * NTHREADS;
        for (size_t i = (size_t)F.vcu * NTHREADS + I_.tid; i < n4; i += 4 * T) { f32x4 v[4];
#pragma unroll
            for (int q = 0; q < 4; ++q) v[q] = __builtin_nontemporal_load(pp + i + q * T);
#pragma unroll
            for (int q = 0; q < 4; ++q) po[i + q * T] = (u32x2){cvt_pk_bf16(v[q].x, v[q].y), cvt_pk_bf16(v[q].z, v[q].w)}; } }
    STAMP(22);
    { float* tab = (float*)(ws + WS_ROPE);
        for (int i = F.vcu * NTHREADS + I_.tid; i < 2048 * 48; i += F.G * NTHREADS) {
            int pos, j, half; float* cdst; float* sdst;
            if (i < 2048 * 32) { pos = i / 32; j = i % 32; half = 32; cdst = tab + i; sdst = tab + 65536 + i; }
            else { const int q = i - 2048 * 32; pos = q / 16; j = q % 16; half = 16; cdst = tab + 131072 + q; sdst = tab + 131072 + 32768 + q; }
            const float inv = powf(10000.0f, -((float)j / (float)half)); const float ang = (float)pos * inv;
            *cdst = cosf(ang); *sdst = sinf(ang); } }
}

__device__ __forceinline__ void phase2(Frame& F) {
    PHASE_IDS();
    const Params& P = *F.P; unsigned char* ws = F.ws;
    const bf16_t* PROJ = (const bf16_t*)(ws + WS_PROJ);
    const float* cosA = (const float*)(ws + WS_ROPE); const float* sinA = cosA + 65536;
    LAS float* kst = (LAS float*)F.lds;
    LAS float* part = kst + 256 * 68;
    for (int it = F.vcu; it < 512; it += F.G) {
        const int b = it >> 6, blk = (it >> 3) & 7, h = it & 7;
        const int sel = I_.lane >> 5, r = I_.wave * 32 + (I_.lane & 31); const int pos = blk * 256 + r; const size_t row = (size_t)b * SEQ + pos;
        const u32x4* src = (const u32x4*)(PROJ + row * DINP + (sel ? PC_KA : PC_QA) + h * 64);
        u32x4 raw[8];
#pragma unroll
        for (int c = 0; c < 8; ++c) raw[c] = src[c];
        float ss = 0.f;
#pragma unroll
        for (int c = 0; c < 8; ++c) { f32x4 a0, a1; pg8::unpack8(raw[c], a0, a1); ss += (a0[0] * a0[0] + a0[1] * a0[1]) + (a0[2] * a0[2] + a0[3] * a0[3]) + (a1[0] * a1[0] + a1[1] * a1[1]) + (a1[2] * a1[2] + a1[3] * a1[3]); }
        const float rstd = 1.0f / sqrtf(ss * (1.f / 64.f) + EPS);
        const float* gn = sel ? P.in[I_MKN] : P.in[I_MQN];
        const float sc = sel ? 1.0f : C2A;
        bf16_t* dst = (bf16_t*)(ws + (sel ? WS_KA2 : WS_QA2)) + row * 512 + h * 64;
#pragma unroll
        for (int c = 0; c < 4; ++c) { f32x4 x1a, x1b, x2a, x2b; pg8::unpack8(raw[c], x1a, x1b); pg8::unpack8(raw[c + 4], x2a, x2b);
            const f32x4 g1a = *(const f32x4*)(gn + 8 * c), g1b = *(const f32x4*)(gn + 8 * c + 4), g2a = *(const f32x4*)(gn + 32 + 8 * c), g2b = *(const f32x4*)(gn + 36 + 8 * c);
            x1a = x1a * g1a * rstd; x1b = x1b * g1b * rstd; x2a = x2a * g2a * rstd; x2b = x2b * g2b * rstd;
            const f32x4 ca = *(const f32x4*)(cosA + pos * 32 + 8 * c), cb = *(const f32x4*)(cosA + pos * 32 + 8 * c + 4), sa = *(const f32x4*)(sinA + pos * 32 + 8 * c), sb = *(const f32x4*)(sinA + pos * 32 + 8 * c + 4);
            const f32x4 y1a = x1a * ca - x2a * sa, y1b = x1b * cb - x2b * sb, y2a = x2a * ca + x1a * sa, y2b = x2b * cb + x1b * sb;
            *(u32x4*)(dst + 8 * c) = pg8::pack8(y1a * sc, y1b * sc); *(u32x4*)(dst + 32 + 8 * c) = pg8::pack8(y2a * sc, y2b * sc);
            if (sel) { LAS f32x4* kr = (LAS f32x4*)(kst + r * 68); kr[2 * c] = y1a; kr[2 * c + 1] = y1b; kr[8 + 2 * c] = y2a; kr[8 + 2 * c + 1] = y2b; } }
        __syncthreads();
        { const int d = I_.tid & 63, pt = I_.tid >> 6; float s = 0.f;
#pragma unroll 8
            for (int rr = 0; rr < 32; ++rr) s += kst[(pt * 32 + rr) * 68 + d];
            part[pt * 64 + d] = s; }
        __syncthreads();
        if (I_.tid < 64) { float s = 0.f;
#pragma unroll
            for (int pt = 0; pt < 8; ++pt) s += part[pt * 64 + I_.tid];
            ((float*)(ws + WS_KMEAN))[(((size_t)b * 8 + h) * 8 + blk) * 64 + I_.tid] = s * (1.f / 256.f); }
        __syncthreads();
    }
    const int gw = F.vcu * NWAVES + I_.wave, NGW = F.G * NWAVES;
    const f32x4 gq = ((const f32x4*)P.in[I_QLATN])[I_.lane]; const f32x2 gk = ((const f32x2*)P.in[I_KVLATN])[I_.lane];
    for (int m0 = gw * 8; m0 < NTOK; m0 += NGW * 8) {
        u32x2 wq[8]; unsigned wk[8];
#pragma unroll
        for (int q = 0; q < 8; ++q) { wq[q] = *((const u32x2*)(PROJ + (size_t)(m0 + q) * DINP + PC_CQ) + I_.lane); wk[q] = *((const unsigned*)(PROJ + (size_t)(m0 + q) * DINP + PC_CKV) + I_.lane); }
#pragma unroll
        for (int r = 0; r < 8; ++r) { const int m = m0 + r;
            const f32x4 q = {bflo(wq[r].x), bfhi(wq[r].x), bflo(wq[r].y), bfhi(wq[r].y)}; const f32x2 k = {bflo(wk[r]), bfhi(wk[r])};
            const float sq = wave_sum((q.x * q.x + q.y * q.y) + (q.z * q.z + q.w * q.w)), sk = wave_sum(k.x * k.x + k.y * k.y);
            const float rq = 1.0f / sqrtf(sq * (1.f / 256.f) + EPS), rk = 1.0f / sqrtf(sk * (1.f / 128.f) + EPS);
            const f32x4 yq = q * rq * gq; const f32x2 yk = k * rk * gk;
            *((u32x2*)((bf16_t*)(ws + WS_CQN) + (size_t)m * 256) + I_.lane) = (u32x2){cvt_pk_bf16(yq.x, yq.y), cvt_pk_bf16(yq.z, yq.w)};
            *((unsigned*)((bf16_t*)(ws + WS_CKVN) + (size_t)m * 128) + I_.lane) = cvt_pk_bf16(yk.x, yk.y); }
    }
}

__device__ __forceinline__ void phase4(Frame& F) {
    PHASE_IDS();
    const Params& P = *F.P; unsigned char* ws = F.ws;
    const bf16_t* PROJ = (const bf16_t*)(ws + WS_PROJ);
    const float* cosB = (const float*)(ws + WS_ROPE) + 131072; const float* sinB = cosB + 32768;
    const int gw = F.vcu * NWAVES + I_.wave, NGW = F.G * NWAVES;
    for (int it = gw; it < (NTOK / 64) * 16; it += NGW) {
        const int h = it & 7, sel = (it >> 3) & 1, rg = it >> 4; const size_t row = (size_t)rg * 64 + I_.lane; const int pos = (int)(row & (SEQ - 1));
        u32x4 raw[12];
        bf16_t* qrow = (bf16_t*)(ws + WS_QB) + row * 768 + h * 96;
        if (sel == 0) {
#pragma unroll
            for (int c = 0; c < 12; ++c) raw[c] = *(const u32x4*)(qrow + 8 * c);
        } else {
            const bf16_t* kn = (const bf16_t*)(ws + WS_KV) + row * 1024 + h * 128; const bf16_t* kp = PROJ + row * DINP + PC_KPE;
#pragma unroll
            for (int c = 0; c < 8; ++c) raw[c] = *(const u32x4*)(kn + 8 * c);
#pragma unroll
            for (int c = 0; c < 4; ++c) raw[8 + c] = *(const u32x4*)(kp + 8 * c);
        }
        float ss = 0.f;
#pragma unroll
        for (int c = 0; c < 12; ++c) { f32x4 a0, a1; pg8::unpack8(raw[c], a0, a1); ss += (a0[0] * a0[0] + a0[1] * a0[1]) + (a0[2] * a0[2] + a0[3] * a0[3]) + (a1[0] * a1[0] + a1[1] * a1[1]) + (a1[2] * a1[2] + a1[3] * a1[3]); }
        const float rstd = 1.0f / sqrtf(ss * (1.f / 96.f) + EPS);
        const float* gn = sel ? P.in[I_MLAKN] : P.in[I_MLAQN];
        const float sc = sel ? 1.0f : C2B; const float rs = rstd * sc;
        bf16_t* dst = sel ? (bf16_t*)(ws + WS_KB2) + row * 768 + h * 96 : qrow;
#pragma unroll
        for (int c = 0; c < 8; ++c) { f32x4 a0, a1; pg8::unpack8(raw[c], a0, a1); const f32x4 g0 = *(const f32x4*)(gn + 8 * c), g1 = *(const f32x4*)(gn + 8 * c + 4);
            *(u32x4*)(dst + 8 * c) = pg8::pack8(a0 * g0 * rs, a1 * g1 * rs); }
#pragma unroll
        for (int c = 0; c < 2; ++c) { f32x4 x1a, x1b, x2a, x2b; pg8::unpack8(raw[8 + c], x1a, x1b); pg8::unpack8(raw[10 + c], x2a, x2b);
            const f32x4 g1a = *(const f32x4*)(gn + 64 + 8 * c), g1b = *(const f32x4*)(gn + 68 + 8 * c), g2a = *(const f32x4*)(gn + 80 + 8 * c), g2b = *(const f32x4*)(gn + 84 + 8 * c);
            x1a = x1a * g1a * rs; x1b = x1b * g1b * rs; x2a = x2a * g2a * rs; x2b = x2b * g2b * rs;
            const f32x4 ca = *(const f32x4*)(cosB + pos * 16 + 8 * c), cb = *(const f32x4*)(cosB + pos * 16 + 8 * c + 4), sa = *(const f32x4*)(sinB + pos * 16 + 8 * c), sb = *(const f32x4*)(sinB + pos * 16 + 8 * c + 4);
            *(u32x4*)(dst + 64 + 8 * c) = pg8::pack8(x1a * ca - x2a * sa, x1b * cb - x2b * sb);
            *(u32x4*)(dst + 80 + 8 * c) = pg8::pack8(x2a * ca + x1a * sa, x2b * cb + x1b * sb); }
    }
}

__device__ __forceinline__ void phase5(Frame& F) {
    unsigned char* ws = F.ws;
    for (int it = F.vcu; it < 256; it += F.G) {
        const int bh = it >> 2, sidx = it & 3, b = bh >> 3, h = bh & 7;
#pragma unroll 1
        for (int k = 0; k < 2; ++k) { const int qb = k ? 7 - sidx : sidx;
            att::attn_unit<64, true>(b, qb, (const bf16_t*)(ws + WS_QA2) + h * 64, 512, (const bf16_t*)(ws + WS_KA2) + h * 64, 512, (const bf16_t*)(ws + WS_PROJ) + PC_VA + h * 64, DINP,
                                     ws + WS_Y + h * 64, 1024, (const float*)(ws + WS_KMEAN) + (size_t)bh * 512, F.lds, F.wave); }
#pragma unroll 1
        for (int k = 0; k < 2; ++k) { const int qb = k ? 7 - sidx : sidx;
            att::attn_unit<96, false>(b, qb, (const bf16_t*)(ws + WS_QB) + h * 96, 768, (const bf16_t*)(ws + WS_KB2) + h * 96, 768, (const bf16_t*)(ws + WS_KV) + h * 128 + 64, 1024,
                                      ws + WS_Y + 512 + h * 64, 1024, nullptr, F.lds, F.wave); }
    }
}

__device__ __forceinline__ void phase8(Frame& F) {
    PHASE_IDS();
    const Params& P = *F.P; unsigned char* ws = F.ws;
    constexpr int HCS = 132, WCS = 48;
    LAS float* HC = (LAS float*)F.lds;
    LAS float* WC = HC + 2 * 64 * HCS;
    LAS float* RSTD = WC + 2 * 128 * WCS;
    LAS float* LOGIT = RSTD + 64;
    LAS int* pe = (LAS int*)(LOGIT + 64 * 33);
    int* PAIR_E = (int*)(ws + WS_PAIR); int* PAIR_RANK = PAIR_E + 65536; float* PAIR_W = (float*)(PAIR_E + 131072);
    const float* gffn = P.in[I_GFFN]; const float* wr_ = P.in[I_WR]; const float* br_ = P.in[I_BR];
    const int r0 = F.vcu * 64;
    if (I_.tid < 64) { const f32x4* sp = (const f32x4*)((const float*)(ws + WS_SSP) + (size_t)(r0 + I_.tid) * 16); const f32x4 a = sp[0], b = sp[1], c = sp[2], d = sp[3];
        const float ss = (((a[0] + a[1]) + (a[2] + a[3])) + ((b[0] + b[1]) + (b[2] + b[3]))) + (((c[0] + c[1]) + (c[2] + c[3])) + ((d[0] + d[1]) + (d[2] + d[3])));
        RSTD[I_.tid] = 1.0f / sqrtf(ss * (1.f / DM) + EPS); }
    __syncthreads();
    const int eg = I_.wave & 1, rgp = I_.wave >> 1, l15 = I_.lane & 15, l4 = I_.lane >> 4;
    const int srow = I_.tid >> 5, sc4 = I_.tid & 31;
    const int wrow = I_.tid >> 3, wc4 = I_.tid & 7;
    f32x4 stg[4], wst[2];
#define P8_LOAD(kc) do { _Pragma("unroll") for (int i = 0; i < 4; ++i) { const u32x2 w_ = *(const u32x2*)((const bf16_t*)(ws + WS_X1B) + (size_t)(r0 + srow + 16 * i) * DM + (kc) * 128 + 4 * sc4); stg[i] = (f32x4){bflo(w_.x), bfhi(w_.x), bflo(w_.y), bfhi(w_.y)}; } \
        _Pragma("unroll") for (int i = 0; i < 2; ++i) wst[i] = *(const f32x4*)(wr_ + (size_t)((kc) * 128 + wrow + 64 * i) * 32 + 4 * wc4); } while (0)
#define P8_STORE(kc, buf) do { const f32x4 g4 = *(const f32x4*)(gffn + (kc) * 128 + 4 * sc4); _Pragma("unroll") for (int i = 0; i < 4; ++i) { const float rs = RSTD[srow + 16 * i]; const f32x4 y = stg[i] * rs * g4; \
        *(LAS f32x4*)(HC + ((buf) * 64 + srow + 16 * i) * HCS + 4 * sc4) = y; *(unsigned*)(ws + WS_HNF8 + (size_t)(r0 + srow + 16 * i) * DM + (kc) * 128 + 4 * sc4) = pack4_fp8(y.x, y.y, y.z, y.w); } \
        _Pragma("unroll") for (int i = 0; i < 2; ++i) *(LAS f32x4*)(WC + ((buf) * 128 + wrow + 64 * i) * WCS + 4 * wc4) = wst[i]; } while (0)
    P8_LOAD(0); P8_STORE(0, 0);
    __syncthreads();
    f32x4 acc = {0.f, 0.f, 0.f, 0.f};
#pragma unroll 1
    for (int kc = 0; kc < 8; ++kc) { const int buf = kc & 1;
        if (kc + 1 < 8) P8_LOAD(kc + 1);
        const LAS float* wp = WC + (buf * 128 + l4) * WCS + eg * 16 + l15;
        const LAS float* hp = HC + (buf * 64 + rgp * 16 + l15) * HCS + l4;
#pragma unroll
        for (int kk = 0; kk < 32; ++kk) acc = __builtin_amdgcn_mfma_f32_16x16x4f32(wp[4 * kk * WCS], hp[4 * kk], acc, 0, 0, 0);
        if (kc + 1 < 8) P8_STORE(kc + 1, buf ^ 1);
        __syncthreads(); }
#undef P8_LOAD
#undef P8_STORE
#pragma unroll
    for (int i = 0; i < 4; ++i) { const int e = eg * 16 + 4 * l4 + i; LOGIT[(rgp * 16 + l15) * 33 + e] = acc[i] + br_[e]; }
    __syncthreads();
    if (I_.tid < 64) { const int rr = I_.tid, m = r0 + rr;
        float lg[32];
#pragma unroll
        for (int e = 0; e < 32; ++e) lg[e] = LOGIT[rr * 33 + e];
        int te[4]; float tv[4]; unsigned used = 0u;
#pragma unroll
        for (int k = 0; k < 4; ++k) { float best = -INFINITY; int bi = 0;
#pragma unroll
            for (int e = 0; e < 32; ++e) { const bool ok = !((used >> e) & 1u) && (lg[e] > best); best = ok ? lg[e] : best; bi = ok ? e : bi; }
            used |= 1u << bi; te[k] = bi; tv[k] = best; }
        const float e0 = 1.0f, e1 = __expf(tv[1] - tv[0]), e2 = __expf(tv[2] - tv[0]), e3 = __expf(tv[3] - tv[0]); const float inv = 1.0f / (e0 + e1 + e2 + e3);
        *(i32x4*)(PAIR_E + m * 4) = (i32x4){te[0], te[1], te[2], te[3]};
        *(f32x4*)(PAIR_W + m * 4) = (f32x4){e0 * inv, e1 * inv, e2 * inv, e3 * inv};
        *(LAS i32x4*)(pe + rr * 4) = (i32x4){te[0], te[1], te[2], te[3]}; }
    __syncthreads();
    if (I_.tid < 256) { const int e = pe[I_.tid]; int rank = 0;
#pragma unroll 16
        for (int j4 = 0; j4 < 64; ++j4) { const i32x4 v = *(const LAS i32x4*)(pe + 4 * j4); const int j = 4 * j4;
            rank += ((j < I_.tid) && v.x == e) + ((j + 1 < I_.tid) && v.y == e) + ((j + 2 < I_.tid) && v.z == e) + ((j + 3 < I_.tid) && v.w == e); }
        PAIR_RANK[r0 * 4 + I_.tid] = rank; }
    else if (I_.tid < 288) { const int e = I_.tid - 256; int c = 0;
#pragma unroll 16
        for (int j4 = 0; j4 < 64; ++j4) { const i32x4 v = *(const LAS i32x4*)(pe + 4 * j4); c += (v.x == e) + (v.y == e) + (v.z == e) + (v.w == e); }
        ((int*)(ws + WS_HIST))[F.vcu * 32 + e] = c; }
    __syncthreads();
}

__device__ __forceinline__ int moe_layout(Frame& F) {
    PHASE_IDS();
    LAS int* ctl = (LAS int*)(F.lds + LDS_CTL);
    LAS int* part = ctl + 512;
    const int* HIST = (const int*)(F.ws + WS_HIST);
    __syncthreads();
    { const int e = I_.tid & 31, pt = I_.tid >> 5; int tot = 0, before = 0; int c[16];
#pragma unroll
        for (int i = 0; i < 16; ++i) c[i] = HIST[(pt * 16 + i) * 32 + e];
#pragma unroll
        for (int i = 0; i < 16; ++i) { tot += c[i]; before += (pt * 16 + i < F.vcu) ? c[i] : 0; }
        part[pt * 64 + e] = tot; part[pt * 64 + 32 + e] = before; }
    __syncthreads();
    if (I_.tid < 32) { int tot = 0, before = 0;
#pragma unroll
        for (int pt = 0; pt < 16; ++pt) { tot += part[pt * 64 + I_.tid]; before += part[pt * 64 + 32 + I_.tid]; }
        ctl[I_.tid] = tot; ctl[65 + I_.tid] = before; }
    __syncthreads();
    if (I_.tid < 32) { const int e = I_.tid; const int nt_ = (ctl[e] + 255) >> 8; int sc = nt_;
#pragma unroll
        for (int o = 1; o < 32; o <<= 1) { const int up = __shfl_up(sc, o); sc += (e >= o) ? up : 0; }
        const int t0 = sc - nt_; ctl[32 + e] = t0 * 256; ctl[65 + e] += t0 * 256;
        for (int t = 0; t < nt_; ++t) ctl[128 + t0 + t] = e;
        if (e == 31) { ctl[64] = sc * 256; ctl[100] = sc; } }
    __syncthreads();
    return ctl[100];
}

__device__ __forceinline__ void phase9(Frame& F) {
    PHASE_IDS();
    unsigned char* ws = F.ws;
    moe_layout(F);
    LAS int* ctl = (LAS int*)(F.lds + LDS_CTL);
    const int* PAIR_E = (const int*)(ws + WS_PAIR); const int* PAIR_RANK = PAIR_E + 65536; int* ROWDEST = (int*)(ws + WS_PAIR) + 196608; int* TOK = (int*)(ws + WS_TOK);
    const int rows_per_blk = NTOK / F.G;
    if (I_.tid < rows_per_blk * 4) { const int gp = F.vcu * rows_per_blk * 4 + I_.tid;
        const int e = PAIR_E[gp], rk = PAIR_RANK[gp]; const int dest = ctl[65 + e] + rk;
        ROWDEST[gp] = dest; TOK[dest] = gp >> 2; }
    if (F.vcu < 32) { const int e = F.vcu; const int lo = ctl[32 + e] + ctl[e], hi = (e == 31) ? ctl[64] : ctl[33 + e];
        for (int r = lo + I_.tid; r < hi; r += NTHREADS) TOK[r] = 0; }
}

__device__ __forceinline__ void stage_tok(Frame& F, int nmt, int ntn) {
    PHASE_IDS();
    const int* TOK = (const int*)(F.ws + WS_TOK); LAS unsigned short* tokl = (LAS unsigned short*)(F.lds + LDS_TOKL);
    for (int i = 0; i < 10; ++i) { const int j = (i * F.G + (int)blockIdx.x) >> 3; const int mt = (j / ntn) * 8 + ((int)blockIdx.x & 7); if (mt >= nmt) break;
        if (I_.tid < 256) tokl[i * 256 + I_.tid] = (unsigned short)TOK[mt * 256 + I_.tid]; }
    __syncthreads();
}

__device__ __forceinline__ void phase12(Frame& F) {
    PHASE_IDS();
    const Params& P = *F.P; unsigned char* ws = F.ws;
    const int gw = F.vcu * NWAVES + I_.wave, NGW = F.G * NWAVES;
    const float* PAIR_W = (const float*)(ws + WS_PAIR) + 131072; const int* ROWDEST = (const int*)(ws + WS_PAIR) + 196608;
    const bf16_t* YP = (const bf16_t*)(ws + WS_XG);
    const f32x4* gp = (const f32x4*)P.in[I_GPLE] + I_.lane; f32x4 gv[4];
#pragma unroll
    for (int j = 0; j < 4; ++j) gv[j] = gp[64 * j];
    for (int m0 = gw; m0 < NTOK; m0 += 2 * NGW) {
        int mm[2]; mm[0] = m0; mm[1] = (m0 + NGW < NTOK) ? m0 + NGW : m0;
        f32x4 wv[2]; i32x4 dv[2];
#pragma unroll
        for (int q = 0; q < 2; ++q) { wv[q] = *(const f32x4*)(PAIR_W + mm[q] * 4); dv[q] = *(const i32x4*)(ROWDEST + mm[q] * 4); }
        f32x4 v[2][4]; u32x2 y[2][4][4];
#pragma unroll
        for (int q = 0; q < 2; ++q) { const u32x2* xr = (const u32x2*)((const bf16_t*)(ws + WS_X1B) + (size_t)mm[q] * DM) + I_.lane;
#pragma unroll
            for (int j = 0; j < 4; ++j) { const u32x2 w_ = xr[64 * j]; v[q][j] = (f32x4){bflo(w_.x), bfhi(w_.x), bflo(w_.y), bfhi(w_.y)}; }
#pragma unroll
            for (int k = 0; k < 4; ++k) { const u32x2* yr = (const u32x2*)(YP + (size_t)dv[q][k] * DM) + I_.lane;
#pragma unroll
                for (int j = 0; j < 4; ++j) y[q][k][j] = yr[64 * j]; } }
#pragma unroll
        for (int q = 0; q < 2; ++q) { if (q == 1 && mm[1] == mm[0]) break;
            float s = 0.f; u32x2* xw = (u32x2*)((bf16_t*)(ws + WS_X1B) + (size_t)mm[q] * DM) + I_.lane;
#pragma unroll
            for (int j = 0; j < 4; ++j) {
#pragma unroll
                for (int k = 0; k < 4; ++k) { const u32x2 yy = y[q][k][j]; v[q][j] += (f32x4){bflo(yy.x), bfhi(yy.x), bflo(yy.y), bfhi(yy.y)} * wv[q][k]; }
                xw[64 * j] = (u32x2){cvt_pk_bf16(v[q][j].x, v[q][j].y), cvt_pk_bf16(v[q][j].z, v[q][j].w)}; s += (v[q][j].x * v[q][j].x + v[q][j].y * v[q][j].y) + (v[q][j].z * v[q][j].z + v[q][j].w * v[q][j].w); }
            const float rstd = 1.0f / sqrtf(wave_sum(s) * (1.f / DM) + EPS);
            unsigned* o4 = (unsigned*)(ws + WS_HNF8 + (size_t)mm[q] * DM) + I_.lane;
#pragma unroll
            for (int j = 0; j < 4; ++j) { const f32x4 yo = v[q][j] * rstd * gv[j]; o4[64 * j] = pack4_fp8(yo.x, yo.y, yo.z, yo.w); } }
    }
}

__global__ void __launch_bounds__(NTHREADS, 2) fwd(Params prm) {
    extern __shared__ __attribute__((aligned(16))) unsigned char lds_raw[];
    Frame F;
    F.lds = (LAS unsigned char*)lds_raw;
    F.wave = __builtin_amdgcn_readfirstlane((int)threadIdx.x >> 6);
    if (threadIdx.x < 2) ((volatile LAS unsigned*)(F.lds + LDS_BARST))[threadIdx.x] = 0u;
    const XcdBarrier bar = xcd_barrier_post((unsigned*)(prm.ws + WS_BAR), (volatile LAS unsigned*)(F.lds + LDS_BARST), F.wave);
    if (prm.ph_lo < 0) cg::this_grid().sync();
    __syncthreads();
    F.G = gridDim.x; { const int bx = blockIdx.x; F.vcu = (F.G % 8 == 0) ? (bx % 8) * (F.G / 8) + bx / 8 : bx; }
    F.P = &prm; F.ws = prm.ws;
    unsigned char* ws = prm.ws;
    const int lo = prm.ph_lo, hi = prm.ph_hi;
#ifndef PH_MASK
#define PH_MASK 0xffffu
#endif
#ifndef REP_MASK
#define REP_MASK 0u
#endif
#define IN(k) (((PH_MASK >> (k)) & 1u) && lo <= (k) && (k) < hi)
#define REPS(k) for (int rep_ = 0; rep_ < (((REP_MASK >> (k)) & 1u) ? 2 : 1); ++rep_, (((REP_MASK >> (k)) & 1u) && rep_ < 2 ? xcd_barrier(bar) : (void)0))
#define SEAM(k) do { __builtin_amdgcn_sched_barrier(0); asm volatile("" ::: "memory"); if (IN(k) && IN((k) + 1)) xcd_barrier(bar); STAMP((k) + 1); __builtin_amdgcn_sched_barrier(0); asm volatile("" ::: "memory"); } while (0)
    using namespace pg8;
    STAMP(0);
    if (IN(0)) REPS(0) phase0(F);
    SEAM(0);
    if (IN(1)) REPS(1) {
        { Gemm g{(const bf16_t*)(ws + WS_HN), (const bf16_t*)(ws + WS_WIN), DM, DM, DM}; StaticOrder S; S.init(NTOK, 2048, F.G, (int)blockIdx.x);
          const float* cosA_ = (const float*)(ws + WS_ROPE);
          EpiProj E{(bf16_t*)(ws + WS_PROJ), (bf16_t*)(ws + WS_QA2), (bf16_t*)(ws + WS_KA2), (float*)(ws + WS_KMEAN), (bf16_t*)(ws + WS_CQN), (bf16_t*)(ws + WS_CKVN),
                    prm.in[I_MQN], prm.in[I_MKN], prm.in[I_QLATN], prm.in[I_KVLATN], cosA_, cosA_ + 65536, (LAS float*)(F.lds + LDS_TOKL), (float*)(ws + WS_KPESS)};
          gemm_phase(F.lds, F.wave, g, S, E); }
        __builtin_amdgcn_sched_barrier(0); asm volatile("" ::: "memory");
        { Gemm g{(const bf16_t*)(ws + WS_HNF8), (const bf16_t*)(ws + WS_WINF8), 512, 512, 512}; StaticOrder S; S.init(NTOK, 2048, F.G, (int)blockIdx.x);
          EpiStore E{(bf16_t*)(ws + WS_PROJ) + PC_GA, DINP, nullptr, 0, 0}; gemm_phase<EpiStore, StaticOrder, false, true>(F.lds, F.wave, g, S, E); } }
    SEAM(1);
    if (IN(3)) REPS(3) {
        const float* cosB_ = (const float*)(ws + WS_ROPE) + 131072;
        { Gemm g{(const bf16_t*)(ws + WS_CQN), (const bf16_t*)(ws + WS_WUQ), 256, 256, 256}; StaticOrder S; S.init(NTOK, 1024, F.G, (int)blockIdx.x);
          EpiQB E{(bf16_t*)(ws + WS_QB), prm.in[I_MLAQN], cosB_, cosB_ + 32768, (LAS float*)(F.lds + LDS_CTL)}; gemm_phase(F.lds, F.wave, g, S, E); }
        __builtin_amdgcn_sched_barrier(0); asm volatile("" ::: "memory");
        { Gemm g{(const bf16_t*)(ws + WS_CKVN), (const bf16_t*)(ws + WS_WUKV), 128, 128, 128}; StaticOrder S; S.init(NTOK, 1024, F.G, (int)blockIdx.x);
          EpiKV E{(bf16_t*)(ws + WS_KB2), (bf16_t*)(ws + WS_KV), (const bf16_t*)(ws + WS_PROJ), (const float*)(ws + WS_KPESS), prm.in[I_MLAKN], cosB_, cosB_ + 32768, (LAS float*)(F.lds + LDS_CTL)};
          gemm_phase(F.lds, F.wave, g, S, E); } }
    SEAM(3);
    if (IN(5)) REPS(5) phase5(F);
    SEAM(5);
    if (IN(6)) REPS(6) { Gemm g{(const bf16_t*)(ws + WS_Y), (const bf16_t*)(ws + WS_WA), 512, 256, 256}; BranchOrder S; S.so.init(NTOK, DM, F.G, (int)blockIdx.x);
        EpiGateAB E{(bf16_t*)(ws + WS_MERGED), (const bf16_t*)(ws + WS_PROJ) + PC_GA, (const bf16_t*)(ws + WS_PROJ) + PC_GB, DINP, ws + WS_KA2  };
        gemm_phase<EpiGateAB, BranchOrder, false, true>(F.lds, F.wave, g, S, E); }
    SEAM(7);
    if (IN(8)) REPS(8) { Gemm g{(const bf16_t*)(ws + WS_KA2), (const bf16_t*)(ws + WS_WO), 512, 512, 512}; StaticOrder S; S.init(NTOK, DM, F.G, (int)blockIdx.x);
        EpiResF32 E{prm.in[I_X], (bf16_t*)(ws + WS_X1B), (float*)(ws + WS_SSP)}; gemm_phase<EpiResF32, StaticOrder, false, true>(F.lds, F.wave, g, S, E); }
    SEAM(8);
    if (IN(9)) REPS(9) phase8(F);
    SEAM(9);
    if (IN(10)) REPS(10) phase9(F);
    SEAM(10);
    if (IN(11)) REPS(11) { const int nmt = ((const LAS int*)(F.lds + LDS_CTL))[100]; stage_tok(F, nmt, 8);
        Gemm g{(const bf16_t*)(ws + WS_HNF8), (const bf16_t*)(ws + WS_W1), 512, 512, 512}; MoeOrder S{(const LAS int*)(F.lds + LDS_CTL) + 128, nmt, 8, F.G, (int)blockIdx.x};
        EpiSwiglu E{ws + WS_ACT, prm.in[I_BGU]}; gemm_phase<EpiSwiglu, MoeOrder, true, true>(F.lds, F.wave, g, S, E, (const LAS unsigned short*)(F.lds + LDS_TOKL)); }
    SEAM(11);
    if (IN(12)) REPS(12) { const int nmt = ((const LAS int*)(F.lds + LDS_CTL))[100];
        Gemm g{(const bf16_t*)(ws + WS_ACT), (const bf16_t*)(ws + WS_W2), 512, 512, 512}; MoeOrder S{(const LAS int*)(F.lds + LDS_CTL) + 128, nmt, 4, F.G, (int)blockIdx.x};
        EpiStore E{(bf16_t*)(ws + WS_XG), DM, prm.in[I_BD], 1024, 1 << 30}; gemm_phase<EpiStore, MoeOrder, false, true>(F.lds, F.wave, g, S, E); }
    SEAM(12);
    if (IN(13)) REPS(13) phase12(F);
    SEAM(13);
    if (IN(14)) REPS(14) { Gemm g{(const bf16_t*)(ws + WS_PB), (const bf16_t*)(ws + WS_WPP), 256, 256, 256}; StaticOrder S; S.init(NTOK, DM, F.G, (int)blockIdx.x);
        EpiStore E{(bf16_t*)(ws + WS_PP), DM, nullptr, 0, 1 << 30}; gemm_phase(F.lds, F.wave, g, S, E); }
    __builtin_amdgcn_sched_barrier(0); asm volatile("s_waitcnt vmcnt(0)" ::: "memory"); __syncthreads();
    if (IN(15)) REPS(15) { Gemm g{(const bf16_t*)(ws + WS_HNF8), (const bf16_t*)(ws + WS_WPG), 512, 512, 512}; StaticOrder S; S.init(NTOK, DM, F.G, (int)blockIdx.x);
        EpiFinal E{prm.out, (const bf16_t*)(ws + WS_PP), (const bf16_t*)(ws + WS_X1B)}; gemm_phase<EpiFinal, StaticOrder, false, true>(F.lds, F.wave, g, S, E); }
#ifdef TPROBE_A
    STAMP(16);
    xcd_barrier(bar);
    if (blockIdx.x == 0 && F.wave == 0 && lane_id() == 0) {
        volatile unsigned long long* ts = (volatile unsigned long long*)(ws + WS_ERR);
        const unsigned long long da = ts[TPROBE_A1] - ts[TPROBE_A], db = ts[TPROBE_B1] - ts[TPROBE_B];
        asm volatile("s_waitcnt vmcnt(0)" ::: "memory");
        prm.out[0] += (float)db * (0.01f / 4.0f);
        const unsigned long long t0 = __builtin_amdgcn_s_memrealtime();
        while (__builtin_amdgcn_s_memrealtime() - t0 < 4ull * da) __builtin_amdgcn_s_sleep(4);
    }
#endif
#undef IN
#undef SEAM
}

extern "C" void kernel_launch(void* const* d_in, const int* in_sizes, int n_in, void* d_out, int out_size, void* d_ws, size_t ws_size, hipStream_t stream) {
    static int grid = 0;
    if (grid == 0) {
        int dev = 0, cus = 0, per_cu = 0;
        (void)hipGetDevice(&dev);
        (void)hipDeviceGetAttribute(&cus, hipDeviceAttributeMultiprocessorCount, dev);
        (void)hipFuncSetAttribute((const void*)fwd, hipFuncAttributeMaxDynamicSharedMemorySize, LDS_BYTES);
        (void)hipOccupancyMaxActiveBlocksPerMultiprocessor(&per_cu, (const void*)fwd, NTHREADS, LDS_BYTES);
        fprintf(stderr, "cus %d per_cu %d ws %zu n_in %d\n", cus, per_cu, ws_size, n_in);
        grid = (per_cu >= 1) ? cus : -1;
        if (grid != 256 || n_in != 25 || ws_size < WS_END || out_size != NTOK * DM) { fprintf(stderr, "kernel_launch: unsupported configuration\n"); grid = -1; }
    }
    if (grid < 0) return;
    (void)hipMemsetAsync((char*)d_ws + WS_BAR, 0, WS_BAR_BYTES, stream);
    Params a{};
    for (int i = 0; i < 25; ++i) a.in[i] = (const float*)d_in[i];
    a.out = (float*)d_out; a.ws = (unsigned char*)d_ws;
#ifndef MULTI_LAUNCH
    a.ph_lo = 0; a.ph_hi = NPHASE;
    void* args[] = {&a};
    hipError_t e = hipLaunchCooperativeKernel((const void*)fwd, dim3(grid), dim3(NTHREADS), args, LDS_BYTES, stream);
    if (e != hipSuccess) fprintf(stderr, "cooperative launch failed: %s\n", hipGetErrorString(e));
#else
    for (int k = 0; k < NPHASE; ++k) { a.ph_lo = k; a.ph_hi = k + 1; void* args[] = {&a};
        hipError_t e = hipLaunchCooperativeKernel((const void*)fwd, dim3(grid), dim3(NTHREADS), args, LDS_BYTES, stream);
        if (e != hipSuccess) fprintf(stderr, "launch %d failed: %s\n", k, hipGetErrorString(e)); }
#endif
}
```

```cpp
#include <hip/hip_runtime.h>
#include <hip/hip_cooperative_groups.h>
#include <cstdio>
#include <cstdint>
namespace cg = cooperative_groups;

#define LAS __attribute__((address_space(3)))
typedef unsigned short bf16_t;
typedef short bf16x8 __attribute__((ext_vector_type(8)));
typedef short s16x4 __attribute__((ext_vector_type(4)));
typedef float f32x4 __attribute__((ext_vector_type(4)));
typedef float f32x2 __attribute__((ext_vector_type(2)));
typedef float f32x16 __attribute__((ext_vector_type(16)));
typedef unsigned u32x4 __attribute__((ext_vector_type(4)));
typedef unsigned u32x2 __attribute__((ext_vector_type(2)));
typedef int i32x4 __attribute__((ext_vector_type(4)));
typedef int i32x8 __attribute__((ext_vector_type(8)));
typedef __bf16 bf16x2_t __attribute__((ext_vector_type(2)));

constexpr int NB = 8, SEQ = 2048, NTOK = NB * SEQ, DM = 1024;
constexpr int DIN = 4000, DINP = 4096;
constexpr int NEXP = 32, TOPK = 4, DEXP = 1024;
constexpr int NTHREADS = 512, NWAVES = 8;
constexpr float EPS = 1e-6f;
constexpr float LOG2E = 1.4426950408889634f;
constexpr float C2A = 0.125f * LOG2E;
constexpr float C2B = 0.10206207261596575f * LOG2E;
constexpr int PC_QA = 0, PC_KA = 512, PC_VA = 1024, PC_CQ = 1536, PC_CKV = 1792, PC_KPE = 1920, PC_GA = 2048, PC_GB = 3072;

constexpr size_t MiB = 1u << 20;
constexpr size_t WS_HIST = 0;
constexpr size_t WS_ERR = 64 * 1024;
constexpr size_t WS_BAR = 128 * 1024;
constexpr size_t WS_BAR_BYTES = 16 * 1024;
constexpr size_t WS_KPESS = 576 * 1024;
constexpr size_t WS_TOK = 256 * 1024;
constexpr size_t WS_ROPE = 1 * MiB;
constexpr size_t WS_KMEAN = 2 * MiB;
constexpr size_t WS_SSP = 11 * MiB;
constexpr size_t WS_PAIR = 3 * MiB;
constexpr size_t WS_WUQ = 4 * MiB, WS_WUKV = 4 * MiB + 512 * 1024, WS_WPP = 5 * MiB, WS_WA = 6 * MiB, WS_WB = 7 * MiB, WS_WO = 8 * MiB, WS_WPG = 10 * MiB, WS_WIN = 12 * MiB;
constexpr size_t WS_W1 = 20 * MiB, WS_W2 = 148 * MiB;
constexpr size_t WS_WINF8 = 16 * MiB;
constexpr size_t WS_HNF8 = 84 * MiB;
constexpr size_t WS_HN = 212 * MiB, WS_PB = 244 * MiB;
constexpr size_t WS_X1B = WS_HN;
constexpr size_t WS_CQN = 252 * MiB, WS_CKVN = 260 * MiB, WS_QB = 264 * MiB, WS_KV = 288 * MiB, WS_KB2 = 320 * MiB, WS_Y = 344 * MiB, WS_MERGED = 376 * MiB;
constexpr size_t WS_ACT = 252 * MiB;
constexpr size_t WS_PP = 400 * MiB;
constexpr size_t WS_KA2 = 432 * MiB;
constexpr size_t WS_PROJ = 448 * MiB;
constexpr size_t WS_QA2 = 576 * MiB;
constexpr size_t WS_XG = 448 * MiB;
constexpr size_t WS_END = 592 * MiB;
constexpr int MAXROWS = 73728, MAXMT = 288;

constexpr int RING_BYTES = 131072;
constexpr int LDS_CTL = RING_BYTES;
constexpr int LDS_TOKL = RING_BYTES + 8192 + 256;
constexpr int LDS_BARST = RING_BYTES + 8192;
constexpr int LDS_BYTES = 147456;

__device__ __forceinline__ unsigned cvt_pk_bf16(float lo, float hi) { f32x2 v = {lo, hi}; bf16x2_t b = __builtin_convertvector(v, bf16x2_t); return __builtin_bit_cast(unsigned, b); }
__device__ __forceinline__ unsigned pack4_fp8(float a, float b, float c, float d) { int w = 0; w = __builtin_amdgcn_cvt_pk_fp8_f32(a, b, w, false); w = __builtin_amdgcn_cvt_pk_fp8_f32(c, d, w, true); return (unsigned)w; }
__device__ __forceinline__ float bf2f(unsigned short b) { return __uint_as_float(((unsigned)b) << 16); }
__device__ __forceinline__ float bflo(unsigned w) { return __uint_as_float(w << 16); }
__device__ __forceinline__ float bfhi(unsigned w) { return __uint_as_float(w & 0xffff0000u); }
__device__ __forceinline__ float sigmoidf_(float x) { return __builtin_amdgcn_rcpf(1.0f + __builtin_amdgcn_exp2f(-x * LOG2E)); }
__device__ __forceinline__ int lane_id() { return (int)__builtin_amdgcn_mbcnt_hi(~0u, __builtin_amdgcn_mbcnt_lo(~0u, 0u)); }
__device__ __forceinline__ float wave_sum(float v) {
#pragma unroll
    for (int o = 1; o < 64; o <<= 1) v += __shfl_xor(v, o);
    return v;
}

namespace pg8 {
constexpr int BM = 256, BK = 64, HALF = 128, HTB = HALF * BK * 2, STAGE_BYTES = 8 * HTB, NXCD = 8, WGM = 8;
__host__ __device__ __forceinline__ int lds_byte(int r, int c) { const int st = (r >> 4) * 2 + (c >> 5), rr = r & 15, cc = c & 31, ob = rr * 64 + cc * 2; return st * 1024 + (ob ^ (((ob >> 9) & 1) << 5)); }
__host__ __device__ __forceinline__ void stage_rc(int b, int& R, int& C) { const int st = b / 1024, sb = b % 1024, swz = sb ^ (((sb >> 9) & 1) << 5); R = (st >> 1) * 16 + swz / 64; C = (st & 1) * 32 + (swz % 64) / 2; }
__host__ __device__ __forceinline__ int perm32(int rho) { const int n = rho >> 4, i = rho & 15; return 8 * (i >> 2) + 4 * n + (i & 3); }

struct Unit { int pm, pn, pb, e; int aofs = 0; };
struct Gemm { const bf16_t* A; const bf16_t* Bt; int lda, ldb, K; };

struct StaticOrder {
    int nM, nN, nwg, G, c;
    __device__ void init(int M, int N, int G_, int c_) { nM = M / BM; nN = N / BM; nwg = nM * nN; G = G_; c = c_; }
    __device__ bool next(int i, Unit& u) const {
        const long L = (long)i * G + c; if (L >= nwg) return false;
        int wgid = (int)L; { const int q = nwg / NXCD, r = nwg % NXCD, xcd = wgid % NXCD, off = wgid / NXCD; wgid = (xcd < r ? xcd * (q + 1) : r * (q + 1) + (xcd - r) * q) + off; }
        const int nig = WGM * nN, gid = wgid / nig, fm = gid * WGM, gsz = (nM - fm) < WGM ? (nM - fm) : WGM;
        u.pm = fm + ((wgid % nig) % gsz); u.pn = (wgid % nig) / gsz; u.pb = u.pn; u.e = 0; return true;
    }
};
struct MoeOrder {
    const LAS int* tile_e; int nmt, ntn, G, c;
    __device__ bool next(int i, Unit& u) const {
        const int j = (i * G + c) >> 3; const int mt = (j / ntn) * 8 + (c & 7), pn = j % ntn; if (mt >= nmt) return false;
        const int e = __builtin_amdgcn_readfirstlane(tile_e[mt]);
        u.pm = mt; u.pn = pn; u.pb = e * ntn + pn; u.e = e; return true;
    }
};

template <class Epi, class Sched, bool GATHER = false, bool FP8 = false>
__device__ __forceinline__ void gemm_phase(LAS unsigned char* lds, int wave, const Gemm g, const Sched& S, const Epi& E, const LAS unsigned short* tokl = nullptr) {
    constexpr bool ALIGN_EPI = true;
    int lane = lane_id(); asm volatile("" : "+v"(lane));
    const int wid = wave, tid = wid * 64 + lane, wr = wid >> 2, wc = wid & 3, fr = lane & 15, fq = lane >> 4;
    int K = g.K; asm volatile("" : "+s"(K));
    const int nt = K / BK;
    unsigned voffA[2], voffB[2]; int gR[2]; unsigned gC[2];
#pragma unroll
    for (int i = 0; i < 2; ++i) { int R, C; stage_rc(tid * 16 + i * 8192, R, C); const int Rb = (R & ~31) + perm32(R & 31);
        voffA[i] = (unsigned)(R * g.lda + C) * 2u; voffB[i] = (unsigned)(Rb * g.ldb + C) * 2u; gR[i] = R; gC[i] = (unsigned)C * 2u; }
    unsigned goff[2][2], noff[2][2];
#define PG8_GOFF(dst, ui_) do { _Pragma("unroll") for (int h_ = 0; h_ < 2; ++h_) _Pragma("unroll") for (int i_ = 0; i_ < 2; ++i_) \
        dst[h_][i_] = (unsigned)tokl[(ui_) * 256 + h_ * HALF + gR[i_]] * (unsigned)(g.lda * 2) + gC[i_]; } while (0)
    const size_t kstep = (size_t)(BK * 2);
    const size_t hstepA = (size_t)HALF * g.lda * 2, hstepB = (size_t)HALF * g.ldb * 2;
    const size_t tstepA = 2 * hstepA, tstepB = 2 * hstepB;
    const unsigned ldsw = (unsigned)wid * 1024u;
    const int aoff = lds_byte(wr * 64 + fr, fq * 8), boff = lds_byte(wc * 32 + fr, fq * 8);
#define PG8_SA(b, h) (((b) * 2 + (h)) * HTB)
#define PG8_SB(b, h) ((4 + (b) * 2 + (h)) * HTB)
#define PG8_STAGE(bufoff, gbase, voff) do { _Pragma("unroll") for (int _i = 0; _i < 2; ++_i) \
        __builtin_amdgcn_global_load_lds((const unsigned*)((const char*)(gbase) + (voff)[_i]), (LAS unsigned*)(lds + (bufoff) + ldsw + _i * 8192), 16, 0, 0); } while (0)
#define PG8_STAGE_A(bufoff, ptr_ng, k_g, off_g) do { if constexpr (GATHER) { const char* gb_ = (const char*)g.A + (size_t)(k_g) * kstep; PG8_STAGE(bufoff, gb_, off_g); } else { PG8_STAGE(bufoff, ptr_ng, voffA); } } while (0)
#define PG8_LDA(dst, b, h) do { if constexpr (FP8) { _Pragma("unroll") for (int m = 0; m < 4; ++m) { const i32x4 lo_ = *(const LAS i32x4*)(lds + PG8_SA(b, h) + aoff + m * 2048), hi_ = *(const LAS i32x4*)(lds + PG8_SA(b, h) + aoff + m * 2048 + 1024); dst##8[m] = __builtin_shufflevector(lo_, hi_, 0, 1, 2, 3, 4, 5, 6, 7); } } \
        else { _Pragma("unroll") for (int m = 0; m < 4; ++m) _Pragma("unroll") for (int k = 0; k < 2; ++k) dst[m][k] = *(const LAS bf16x8*)(lds + PG8_SA(b, h) + aoff + m * 2048 + k * 1024); } } while (0)
#define PG8_LDB(dst, b, h) do { if constexpr (FP8) { _Pragma("unroll") for (int n = 0; n < 2; ++n) { const i32x4 lo_ = *(const LAS i32x4*)(lds + PG8_SB(b, h) + boff + n * 2048), hi_ = *(const LAS i32x4*)(lds + PG8_SB(b, h) + boff + n * 2048 + 1024); dst##8[n] = __builtin_shufflevector(lo_, hi_, 0, 1, 2, 3, 4, 5, 6, 7); } } \
        else { _Pragma("unroll") for (int n = 0; n < 2; ++n) _Pragma("unroll") for (int k = 0; k < 2; ++k) dst[n][k] = *(const LAS bf16x8*)(lds + PG8_SB(b, h) + boff + n * 2048 + k * 1024); } } while (0)
#define PG8_CAT8(x, y) __builtin_shufflevector(__builtin_bit_cast(i32x4, x), __builtin_bit_cast(i32x4, y), 0, 1, 2, 3, 4, 5, 6, 7)
#define PG8_MMA(ai, bj, At, Bt) do { __builtin_amdgcn_s_setprio(1); if constexpr (FP8) { _Pragma("unroll") for (int m = 0; m < 4; ++m) _Pragma("unroll") for (int n = 0; n < 2; ++n) \
        asm volatile("v_mfma_scale_f32_16x16x128_f8f6f4 %0, %1, %2, %0, %3, %3 op_sel_hi:[0,0,0]" : "+v"(acc[ai][bj][m][n]) : "v"(Bt##8[n]), "v"(At##8[m]), "v"(sc8)); } \
        else { _Pragma("unroll") for (int m = 0; m < 4; ++m) _Pragma("unroll") for (int n = 0; n < 2; ++n) _Pragma("unroll") for (int k = 0; k < 2; ++k) \
        acc[ai][bj][m][n] = __builtin_amdgcn_mfma_f32_16x16x32_bf16(Bt[n][k], At[m][k], acc[ai][bj][m][n], 0, 0, 0); } __builtin_amdgcn_s_setprio(0); } while (0)
#define PG8_WAIT_V(n) asm volatile("s_waitcnt vmcnt(" #n ")" ::: "memory")
#define PG8_WAIT_L(n) asm volatile("s_waitcnt lgkmcnt(" #n ")" ::: "memory")
#define PG8_BAR __builtin_amdgcn_s_barrier()
#define PG8_SCHED __builtin_amdgcn_sched_barrier(0)
    Unit cur, nxt; int ui = 0;
    if (!S.next(0, cur)) return;
    f32x4 acc[2][2][4][2];
#pragma unroll
    for (int a = 0; a < 2; ++a)
#pragma unroll
        for (int b = 0; b < 2; ++b)
#pragma unroll
            for (int m = 0; m < 4; ++m)
#pragma unroll
                for (int n = 0; n < 2; ++n) acc[a][b][m][n] = (f32x4){0.f, 0.f, 0.f, 0.f};
    const int sc8 = 0x7c7c7c7c;
    bf16x8 At[4][2], B0[2][2], B1[2][2]; i32x8 At8[4], B08[2], B18[2];
    const char* cA = (const char*)g.A + (size_t)cur.pm * tstepA + cur.aofs; const char* cB = (const char*)g.Bt + (size_t)cur.pb * tstepB;
    if constexpr (GATHER) { PG8_GOFF(goff, 0); }
    PG8_STAGE(PG8_SB(0, 0), cB, voffB); PG8_STAGE(PG8_SB(0, 1), cB + hstepB, voffB); PG8_STAGE_A(PG8_SA(0, 0), cA, 0, goff[0]); PG8_STAGE_A(PG8_SA(0, 1), cA + hstepA, 0, goff[1]);
    if (wr == 1) PG8_BAR;
    PG8_WAIT_V(2); PG8_BAR;
    PG8_STAGE(PG8_SB(1, 0), cB + kstep, voffB); PG8_STAGE_A(PG8_SA(1, 0), cA + kstep, 1, goff[0]); PG8_STAGE(PG8_SB(1, 1), cB + hstepB + kstep, voffB);
    PG8_WAIT_V(6); PG8_BAR;
    for (;;) {
        const bool has_next = S.next(ui + 1, nxt);
        const char* nA = has_next ? (const char*)g.A + (size_t)nxt.pm * tstepA + nxt.aofs : cA; const char* nB = has_next ? (const char*)g.Bt + (size_t)nxt.pb * tstepB : cB;
        if constexpr (GATHER) { if (has_next) { PG8_GOFF(noff, ui + 1); } else {
#pragma unroll
            for (int h_ = 0; h_ < 2; ++h_)
#pragma unroll
                for (int i_ = 0; i_ < 2; ++i_) noff[h_][i_] = goff[h_][i_]; } }
        for (int t = 0; t < nt; t += 2) {
            const bool last = (t == nt - 2);
            const char* a1 = cA + (size_t)(t + 1) * kstep;
            const char* a2 = last ? nA : cA + (size_t)(t + 2) * kstep; const char* b2 = last ? nB : cB + (size_t)(t + 2) * kstep;
            const char* a3 = a2 + kstep; const char* b3 = b2 + kstep;
            const int k2 = last ? 0 : t + 2;
            unsigned soff[2][2];
            if constexpr (GATHER) {
#pragma unroll
                for (int h_ = 0; h_ < 2; ++h_)
#pragma unroll
                    for (int i_ = 0; i_ < 2; ++i_) soff[h_][i_] = last ? noff[h_][i_] : goff[h_][i_]; }
            PG8_LDB(B0, 0, 0); PG8_LDB(B1, 0, 1); PG8_SCHED; PG8_LDA(At, 0, 0); PG8_STAGE_A(PG8_SA(1, 1), a1 + hstepA, t + 1, goff[1]);
            PG8_WAIT_V(8); PG8_WAIT_L(0); PG8_BAR; PG8_MMA(0, 0, At, B0); PG8_MMA(0, 1, At, B1); PG8_BAR; PG8_SCHED;
            PG8_LDA(At, 0, 1); PG8_STAGE(PG8_SB(0, 0), b2, voffB); PG8_STAGE(PG8_SB(0, 1), b2 + hstepB, voffB); PG8_STAGE_A(PG8_SA(0, 0), a2, k2, soff[0]);
            PG8_WAIT_V(8); PG8_WAIT_L(0); PG8_BAR; PG8_MMA(1, 0, At, B0); PG8_MMA(1, 1, At, B1); PG8_BAR; PG8_SCHED;
            PG8_LDB(B0, 1, 0); PG8_LDB(B1, 1, 1); PG8_SCHED; PG8_LDA(At, 1, 0); PG8_STAGE_A(PG8_SA(0, 1), a2 + hstepA, k2, soff[1]);
            PG8_WAIT_V(8); PG8_WAIT_L(0); PG8_BAR; PG8_MMA(0, 0, At, B0); PG8_MMA(0, 1, At, B1); PG8_BAR; PG8_SCHED;
            PG8_LDA(At, 1, 1); PG8_STAGE(PG8_SB(1, 0), b3, voffB); PG8_STAGE(PG8_SB(1, 1), b3 + hstepB, voffB); PG8_STAGE_A(PG8_SA(1, 0), a3, k2 + 1, soff[0]);
            PG8_WAIT_V(8); PG8_WAIT_L(0); PG8_BAR; PG8_MMA(1, 0, At, B0); PG8_MMA(1, 1, At, B1); PG8_BAR; PG8_SCHED;
        }
        if constexpr (ALIGN_EPI) { if (wr == 0) PG8_BAR; }
        if constexpr (FP8) asm volatile("s_nop 15\n\ts_nop 15" ::: "memory");
        E(acc, cur, wr, wc, fr, fq);
        if (!has_next) break;
#pragma unroll
        for (int a = 0; a < 2; ++a)
#pragma unroll
            for (int b = 0; b < 2; ++b)
#pragma unroll
                for (int m = 0; m < 4; ++m)
#pragma unroll
                    for (int n = 0; n < 2; ++n) acc[a][b][m][n] = (f32x4){0.f, 0.f, 0.f, 0.f};
        cur = nxt; cA = nA; cB = nB; ++ui;
        if constexpr (GATHER) {
#pragma unroll
            for (int h_ = 0; h_ < 2; ++h_)
#pragma unroll
                for (int i_ = 0; i_ < 2; ++i_) goff[h_][i_] = noff[h_][i_]; }
        if constexpr (ALIGN_EPI) { if (wr == 1) PG8_BAR; }
    }
    PG8_WAIT_V(0);
    if constexpr (!ALIGN_EPI) { if (wr == 0) PG8_BAR; }
    PG8_BAR;
#undef PG8_SA
#undef PG8_SB
#undef PG8_STAGE
#undef PG8_STAGE_A
#undef PG8_GOFF
#undef PG8_LDA
#undef PG8_LDB
#undef PG8_MMA
#undef PG8_CAT8
#undef PG8_WAIT_V
#undef PG8_WAIT_L
#undef PG8_BAR
#undef PG8_SCHED
}

#define EPI_ARGS const f32x4 (&acc)[2][2][4][2], const Unit& u, int wr, int wc, int fr, int fq
__device__ __forceinline__ u32x4 pack8(f32x4 v0, f32x4 v1) { u32x4 w; w.x = cvt_pk_bf16(v0[0], v0[1]); w.y = cvt_pk_bf16(v0[2], v0[3]); w.z = cvt_pk_bf16(v1[0], v1[1]); w.w = cvt_pk_bf16(v1[2], v1[3]); return w; }
__device__ __forceinline__ void unpack8(u32x4 w, f32x4& v0, f32x4& v1) { v0 = (f32x4){bflo(w.x), bfhi(w.x), bflo(w.y), bfhi(w.y)}; v1 = (f32x4){bflo(w.z), bfhi(w.z), bflo(w.w), bfhi(w.w)}; }
__device__ __forceinline__ f32x4 sig4(f32x4 v) { const f32x4 a = v * (-LOG2E); const f32x4 d = (f32x4){__builtin_amdgcn_exp2f(a[0]), __builtin_amdgcn_exp2f(a[1]), __builtin_amdgcn_exp2f(a[2]), __builtin_amdgcn_exp2f(a[3])} + 1.0f;
    return (f32x4){__builtin_amdgcn_rcpf(d[0]), __builtin_amdgcn_rcpf(d[1]), __builtin_amdgcn_rcpf(d[2]), __builtin_amdgcn_rcpf(d[3])}; }

struct EpiStore {
    bf16_t* O; int ldc; const float* bias; int bias_stride; int sig_from;
    __device__ __forceinline__ void operator()(EPI_ARGS) const {
        const int row0 = u.pm * BM + wr * 64 + fr, col0 = u.pn * BM + wc * 32 + 8 * fq;
        const bool sg = u.pn >= sig_from;
        f32x4 bv[2][2];
#pragma unroll
        for (int bj = 0; bj < 2; ++bj)
#pragma unroll
            for (int n = 0; n < 2; ++n) bv[bj][n] = bias ? *(const f32x4*)(bias + (size_t)u.e * bias_stride + col0 + bj * HALF + 4 * n) : (f32x4){0.f, 0.f, 0.f, 0.f};
#pragma unroll
        for (int ai = 0; ai < 2; ++ai)
#pragma unroll
            for (int m = 0; m < 4; ++m) { bf16_t* rowp = O + (size_t)(row0 + ai * HALF + m * 16) * ldc + col0;
#pragma unroll
                for (int bj = 0; bj < 2; ++bj) { f32x4 v0 = acc[ai][bj][m][0] + bv[bj][0], v1 = acc[ai][bj][m][1] + bv[bj][1];
                    if (sg) { v0 = sig4(v0); v1 = sig4(v1); }
                    *(u32x4*)(rowp + bj * HALF) = pack8(v0, v1); } }
    }
};

struct EpiProj {
    bf16_t* PROJ; bf16_t* QA2; bf16_t* KA2; float* KMEAN; bf16_t* CQN; bf16_t* CKVN;
    const float* gq; const float* gk; const float* glq; const float* glkv; const float* cosA; const float* sinA; LAS float* xch;
    float* KPESS;
    __device__ __forceinline__ void operator()(EPI_ARGS) const {
        const int row0 = u.pm * BM + wr * 64 + fr, col0 = u.pn * BM + wc * 32 + 8 * fq;
        if (u.pn < 4) {
            const bool isk = u.pn >= 2; const int h = 4 * (u.pn & 1) + wc; const float* gn = isk ? gk : gq; const float sc = isk ? 1.0f : C2A;
            const f32x4 g1a = *(const f32x4*)(gn + 8 * fq), g1b = *(const f32x4*)(gn + 8 * fq + 4), g2a = *(const f32x4*)(gn + 32 + 8 * fq), g2b = *(const f32x4*)(gn + 36 + 8 * fq);
            bf16_t* dst = isk ? KA2 : QA2;
            const f32x4 ifa = *(const f32x4*)(cosA + 196608 + 8 * fq), ifb = *(const f32x4*)(cosA + 196608 + 8 * fq + 4);
            f32x4 ks1a = {0.f, 0.f, 0.f, 0.f}, ks1b = ks1a, ks2a = ks1a, ks2b = ks1a;
#pragma unroll
            for (int ai = 0; ai < 2; ++ai)
#pragma unroll
                for (int m = 0; m < 4; ++m) { const int row = row0 + ai * HALF + m * 16; const int pos = row & (SEQ - 1);
                    f32x4 x1a = acc[ai][0][m][0], x1b = acc[ai][0][m][1], x2a = acc[ai][1][m][0], x2b = acc[ai][1][m][1];
                    float ss = (x1a[0] * x1a[0] + x1a[1] * x1a[1]) + (x1a[2] * x1a[2] + x1a[3] * x1a[3]) + (x1b[0] * x1b[0] + x1b[1] * x1b[1]) + (x1b[2] * x1b[2] + x1b[3] * x1b[3])
                             + (x2a[0] * x2a[0] + x2a[1] * x2a[1]) + (x2a[2] * x2a[2] + x2a[3] * x2a[3]) + (x2b[0] * x2b[0] + x2b[1] * x2b[1]) + (x2b[2] * x2b[2] + x2b[3] * x2b[3]);
                    ss += __shfl_xor(ss, 16); ss += __shfl_xor(ss, 32);
                    const float rstd = 1.0f / sqrtf(ss * (1.f / 64.f) + EPS);
                    x1a = x1a * g1a * rstd; x1b = x1b * g1b * rstd; x2a = x2a * g2a * rstd; x2b = x2b * g2b * rstd;
                    f32x4 ca, cb, sa, sb; { const float fp_ = (float)pos;
#pragma unroll
                        for (int i = 0; i < 4; ++i) { const float ra = __builtin_amdgcn_fractf(fp_ * ifa[i]), rb = __builtin_amdgcn_fractf(fp_ * ifb[i]);
                            ca[i] = __builtin_amdgcn_cosf(ra); sa[i] = __builtin_amdgcn_sinf(ra); cb[i] = __builtin_amdgcn_cosf(rb); sb[i] = __builtin_amdgcn_sinf(rb); } }
                    const f32x4 y1a = x1a * ca - x2a * sa, y1b = x1b * cb - x2b * sb, y2a = x2a * ca + x1a * sa, y2b = x2b * cb + x1b * sb;
                    bf16_t* rp = dst + (size_t)row * 512 + h * 64 + 8 * fq;
                    *(u32x4*)rp = pack8(y1a * sc, y1b * sc); *(u32x4*)(rp + 32) = pack8(y2a * sc, y2b * sc);
                    ks1a += y1a; ks1b += y1b; ks2a += y2a; ks2b += y2b; }
            if (isk) {
#pragma unroll
                for (int o = 1; o < 16; o <<= 1) {
#pragma unroll
                    for (int i = 0; i < 4; ++i) { ks1a[i] += __shfl_xor(ks1a[i], o); ks1b[i] += __shfl_xor(ks1b[i], o); ks2a[i] += __shfl_xor(ks2a[i], o); ks2b[i] += __shfl_xor(ks2b[i], o); } }
                if (fr == 0) { float* km = KMEAN + (((size_t)(u.pm >> 3) * 8 + h) * 8 + (u.pm & 7)) * 64 + 8 * fq;
#pragma unroll
                    for (int i = 0; i < 4; ++i) { atomicAdd(km + i, ks1a[i] * (1.f / 256.f)); atomicAdd(km + 4 + i, ks1b[i] * (1.f / 256.f)); atomicAdd(km + 32 + i, ks2a[i] * (1.f / 256.f)); atomicAdd(km + 36 + i, ks2b[i] * (1.f / 256.f)); } } }
        } else if (u.pn == 6 || u.pn == 7) {
            const bool isq = u.pn == 6;
            float ssr[2][4];
#pragma unroll
            for (int ai = 0; ai < 2; ++ai)
#pragma unroll
                for (int m = 0; m < 4; ++m) { float ss = 0.f;
#pragma unroll
                    for (int bj = 0; bj < 2; ++bj) { if (bj == 1 && !isq) continue;
#pragma unroll
                        for (int n = 0; n < 2; ++n) { const f32x4 x = acc[ai][bj][m][n]; ss += (x[0] * x[0] + x[1] * x[1]) + (x[2] * x[2] + x[3] * x[3]); } }
                    ss += __shfl_xor(ss, 16); ss += __shfl_xor(ss, 32);
                    if (fq == 0) xch[(ai * HALF + wr * 64 + m * 16 + fr) * 4 + wc] = ss; }
            asm volatile("s_waitcnt lgkmcnt(0)" ::: "memory"); __builtin_amdgcn_s_barrier(); asm volatile("" ::: "memory");
#pragma unroll
            for (int ai = 0; ai < 2; ++ai)
#pragma unroll
                for (int m = 0; m < 4; ++m) { const f32x4 p4 = *(const LAS f32x4*)(xch + (ai * HALF + wr * 64 + m * 16 + fr) * 4); ssr[ai][m] = (p4[0] + p4[1]) + (p4[2] + p4[3]); }
            asm volatile("s_waitcnt lgkmcnt(0)" ::: "memory"); __builtin_amdgcn_s_barrier(); asm volatile("" ::: "memory");
            const float invn = isq ? (1.f / 256.f) : (1.f / 128.f); const float* gl = isq ? glq : glkv; bf16_t* dn = isq ? CQN : CKVN; const int ldn = isq ? 256 : 128;
            const int c0 = wc * 32 + 8 * fq;
#pragma unroll
            for (int bj = 0; bj < 2; ++bj) {
                if (bj == 1 && !isq) {
#pragma unroll
                    for (int ai = 0; ai < 2; ++ai)
#pragma unroll
                        for (int m = 0; m < 4; ++m) { const f32x4 x0 = acc[ai][1][m][0], x1 = acc[ai][1][m][1];
                            *(u32x4*)(PROJ + (size_t)(row0 + ai * HALF + m * 16) * DINP + col0 + HALF) = pack8(x0, x1);
                            float ss = (x0[0] * x0[0] + x0[1] * x0[1]) + (x0[2] * x0[2] + x0[3] * x0[3]) + (x1[0] * x1[0] + x1[1] * x1[1]) + (x1[2] * x1[2] + x1[3] * x1[3]);
                            ss += __shfl_xor(ss, 16); ss += __shfl_xor(ss, 32);
                            if (wc == 0 && fq == 0) KPESS[row0 + ai * HALF + m * 16] = ss; }
                    continue; }
                const f32x4 ga = *(const f32x4*)(gl + bj * HALF + c0), gb = *(const f32x4*)(gl + bj * HALF + c0 + 4);
#pragma unroll
                for (int ai = 0; ai < 2; ++ai)
#pragma unroll
                    for (int m = 0; m < 4; ++m) { const float rstd = 1.0f / sqrtf(ssr[ai][m] * invn + EPS);
                        *(u32x4*)(dn + (size_t)(row0 + ai * HALF + m * 16) * ldn + bj * HALF + c0) = pack8(acc[ai][bj][m][0] * ga * rstd, acc[ai][bj][m][1] * gb * rstd); } }
        } else {
            const bool sg = u.pn >= 8;
#pragma unroll
            for (int ai = 0; ai < 2; ++ai)
#pragma unroll
                for (int m = 0; m < 4; ++m) { bf16_t* rowp = PROJ + (size_t)(row0 + ai * HALF + m * 16) * DINP + col0;
#pragma unroll
                    for (int bj = 0; bj < 2; ++bj) { f32x4 v0 = acc[ai][bj][m][0], v1 = acc[ai][bj][m][1];
                        if (sg) { v0 = sig4(v0); v1 = sig4(v1); }
                        *(u32x4*)(rowp + bj * HALF) = pack8(v0, v1); } }
        }
    }
};

struct EpiQB {
    bf16_t* QB; const float* gn; const float* cosB; const float* sinB; LAS float* xch;
    __device__ __forceinline__ void operator()(EPI_ARGS) const {
        const int rl0 = wr * 64 + fr, row0 = u.pm * BM + rl0;
#pragma unroll
        for (int ai = 0; ai < 2; ++ai)
#pragma unroll
            for (int m = 0; m < 4; ++m)
#pragma unroll
                for (int bj = 0; bj < 2; ++bj) { const f32x4 x0 = acc[ai][bj][m][0], x1 = acc[ai][bj][m][1];
                    float ss = (x0[0] * x0[0] + x0[1] * x0[1]) + (x0[2] * x0[2] + x0[3] * x0[3]) + (x1[0] * x1[0] + x1[1] * x1[1]) + (x1[2] * x1[2] + x1[3] * x1[3]);
                    ss += __shfl_xor(ss, 16); ss += __shfl_xor(ss, 32);
                    if (fq == 0) xch[((rl0 + ai * HALF + m * 16) * 2 + bj) * 4 + wc] = ss; }
        asm volatile("s_waitcnt lgkmcnt(0)" ::: "memory"); __builtin_amdgcn_s_barrier(); asm volatile("" ::: "memory");
#define QB_RS(ai, m, bj) ({ const f32x4 p4_ = *(const LAS f32x4*)(xch + ((rl0 + (ai) * HALF + (m) * 16) * 2 + (bj)) * 4); C2B / sqrtf(((p4_[0] + p4_[1]) + p4_[2]) * (1.f / 96.f) + EPS); })
        if (wc < 2) { const f32x4 ga = *(const f32x4*)(gn + 32 * wc + 8 * fq), gb = *(const f32x4*)(gn + 32 * wc + 8 * fq + 4);
#pragma unroll
            for (int ai = 0; ai < 2; ++ai)
#pragma unroll
                for (int m = 0; m < 4; ++m)
#pragma unroll
                    for (int bj = 0; bj < 2; ++bj) { const float r = QB_RS(ai, m, bj);
                        *(u32x4*)(QB + (size_t)(row0 + ai * HALF + m * 16) * 768 + (2 * u.pn + bj) * 96 + 32 * wc + 8 * fq) = pack8(acc[ai][bj][m][0] * ga * r, acc[ai][bj][m][1] * gb * r); }
        } else if (wc == 2) { const f32x4 g1 = *(const f32x4*)(gn + 64 + 4 * fq), g2 = *(const f32x4*)(gn + 80 + 4 * fq);
            const f32x4 ifr = *(const f32x4*)(cosB - 131072 + 196640 + 4 * fq);
#pragma unroll
            for (int ai = 0; ai < 2; ++ai)
#pragma unroll
                for (int m = 0; m < 4; ++m) { const int row = row0 + ai * HALF + m * 16; const int pos = row & (SEQ - 1);
                    f32x4 c4, s4; { const float fp_ = (float)pos;
#pragma unroll
                        for (int i = 0; i < 4; ++i) { const float rv = __builtin_amdgcn_fractf(fp_ * ifr[i]); c4[i] = __builtin_amdgcn_cosf(rv); s4[i] = __builtin_amdgcn_sinf(rv); } }
#pragma unroll
                    for (int bj = 0; bj < 2; ++bj) { const float r = QB_RS(ai, m, bj); const f32x4 x1 = acc[ai][bj][m][0] * g1 * r, x2 = acc[ai][bj][m][1] * g2 * r;
                        const f32x4 y1 = x1 * c4 - x2 * s4, y2 = x2 * c4 + x1 * s4; bf16_t* rp = QB + (size_t)row * 768 + (2 * u.pn + bj) * 96 + 64 + 4 * fq;
                        *(u32x2*)rp = (u32x2){cvt_pk_bf16(y1[0], y1[1]), cvt_pk_bf16(y1[2], y1[3])}; *(u32x2*)(rp + 16) = (u32x2){cvt_pk_bf16(y2[0], y2[1]), cvt_pk_bf16(y2[2], y2[3])}; } }
        }
    }
};
struct EpiKV {
    bf16_t* KB2; bf16_t* KV; const bf16_t* PROJ; const float* KPESS; const float* gn; const float* cosB; const float* sinB; LAS float* xch;
    __device__ __forceinline__ void operator()(EPI_ARGS) const {
        const int rl0 = wr * 64 + fr, row0 = u.pm * BM + rl0;
        if (wc < 2) {
#pragma unroll
            for (int ai = 0; ai < 2; ++ai)
#pragma unroll
                for (int m = 0; m < 4; ++m)
#pragma unroll
                    for (int bj = 0; bj < 2; ++bj) { const f32x4 x0 = acc[ai][bj][m][0], x1 = acc[ai][bj][m][1];
                        float ss = (x0[0] * x0[0] + x0[1] * x0[1]) + (x0[2] * x0[2] + x0[3] * x0[3]) + (x1[0] * x1[0] + x1[1] * x1[1]) + (x1[2] * x1[2] + x1[3] * x1[3]);
                        ss += __shfl_xor(ss, 16); ss += __shfl_xor(ss, 32);
                        if (fq == 0) xch[((rl0 + ai * HALF + m * 16) * 2 + bj) * 4 + wc] = ss; } }
        asm volatile("s_waitcnt lgkmcnt(0)" ::: "memory"); __builtin_amdgcn_s_barrier(); asm volatile("" ::: "memory");
#define KV_RS(ai, m, bj, pe) ({ const f32x2 p2_ = *(const LAS f32x2*)(xch + ((rl0 + (ai) * HALF + (m) * 16) * 2 + (bj)) * 4); 1.0f / sqrtf(((p2_[0] + p2_[1]) + (pe)) * (1.f / 96.f) + EPS); })
        if (wc < 2) { const f32x4 ga = *(const f32x4*)(gn + 32 * wc + 8 * fq), gb = *(const f32x4*)(gn + 32 * wc + 8 * fq + 4);
#pragma unroll
            for (int ai = 0; ai < 2; ++ai)
#pragma unroll
                for (int m = 0; m < 4; ++m) { const float pe = KPESS[row0 + ai * HALF + m * 16];
#pragma unroll
                    for (int bj = 0; bj < 2; ++bj) { const float r = KV_RS(ai, m, bj, pe);
                        *(u32x4*)(KB2 + (size_t)(row0 + ai * HALF + m * 16) * 768 + (2 * u.pn + bj) * 96 + 32 * wc + 8 * fq) = pack8(acc[ai][bj][m][0] * ga * r, acc[ai][bj][m][1] * gb * r); } }
        } else {
#pragma unroll
            for (int ai = 0; ai < 2; ++ai)
#pragma unroll
                for (int m = 0; m < 4; ++m)
#pragma unroll
                    for (int bj = 0; bj < 2; ++bj) *(u32x4*)(KV + (size_t)(row0 + ai * HALF + m * 16) * 1024 + (2 * u.pn + bj) * 128 + 32 * wc + 8 * fq) = pack8(acc[ai][bj][m][0], acc[ai][bj][m][1]);
            if (wc == 2) {
                const f32x4 g1 = *(const f32x4*)(gn + 64 + 4 * fq), g2 = *(const f32x4*)(gn + 80 + 4 * fq);
                const f32x4 ifr = *(const f32x4*)(cosB - 131072 + 196640 + 4 * fq);
#pragma unroll
                for (int ai = 0; ai < 2; ++ai)
#pragma unroll
                    for (int m = 0; m < 4; ++m) { const int row = row0 + ai * HALF + m * 16; const int pos = row & (SEQ - 1); const float pe = KPESS[row];
                        const u32x2 w1 = *(const u32x2*)(PROJ + (size_t)row * DINP + PC_KPE + 4 * fq), w2 = *(const u32x2*)(PROJ + (size_t)row * DINP + PC_KPE + 16 + 4 * fq);
                        const f32x4 k1 = (f32x4){bflo(w1.x), bfhi(w1.x), bflo(w1.y), bfhi(w1.y)} * g1, k2 = (f32x4){bflo(w2.x), bfhi(w2.x), bflo(w2.y), bfhi(w2.y)} * g2;
                        f32x4 c4, s4; { const float fp_ = (float)pos;
#pragma unroll
                            for (int i = 0; i < 4; ++i) { const float rv = __builtin_amdgcn_fractf(fp_ * ifr[i]); c4[i] = __builtin_amdgcn_cosf(rv); s4[i] = __builtin_amdgcn_sinf(rv); } }
                        const f32x4 y1 = k1 * c4 - k2 * s4, y2 = k2 * c4 + k1 * s4;
#pragma unroll
                        for (int bj = 0; bj < 2; ++bj) { const float r = KV_RS(ai, m, bj, pe); bf16_t* rp = KB2 + (size_t)row * 768 + (2 * u.pn + bj) * 96 + 64 + 4 * fq;
                            *(u32x2*)rp = (u32x2){cvt_pk_bf16(y1[0] * r, y1[1] * r), cvt_pk_bf16(y1[2] * r, y1[3] * r)}; *(u32x2*)(rp + 16) = (u32x2){cvt_pk_bf16(y2[0] * r, y2[1] * r), cvt_pk_bf16(y2[2] * r, y2[3] * r)}; } } }
        }
    }
};
#undef QB_RS
#undef KV_RS
template <bool ADD> struct EpiGate {
    bf16_t* O; const bf16_t* G; int ldg; unsigned char* MF8;
    __device__ __forceinline__ void operator()(EPI_ARGS) const {
        const int row0 = u.pm * BM + wr * 64 + fr, col0 = u.pn * BM + wc * 32 + 8 * fq;
#pragma unroll
        for (int ai = 0; ai < 2; ++ai)
#pragma unroll
            for (int m = 0; m < 4; ++m) { const size_t r = (size_t)(row0 + ai * HALF + m * 16);
#pragma unroll
                for (int bj = 0; bj < 2; ++bj) { const int c = col0 + bj * HALF;
                    f32x4 g0, g1; unpack8(*(const u32x4*)(G + r * ldg + c), g0, g1);
                    f32x4 v0 = acc[ai][bj][m][0] * g0, v1 = acc[ai][bj][m][1] * g1;
                    if (ADD) { f32x4 o0, o1; unpack8(*(const u32x4*)(O + r * DM + c), o0, o1); v0 += o0; v1 += o1;
                        *(u32x2*)(MF8 + r * DM + c) = (u32x2){pack4_fp8(v0[0], v0[1], v0[2], v0[3]), pack4_fp8(v1[0], v1[1], v1[2], v1[3])}; }
                    else *(u32x4*)(O + r * DM + c) = pack8(v0, v1); } }
    }
};

struct BranchOrder {
    StaticOrder so;
    __device__ bool next(int i, Unit& u) const { if (i >= 2) return false; if (!so.next(0, u)) return false; u.e = i; u.aofs = i * 512; u.pb = u.pn + 8 * i; return true; }
};
struct EpiGateAB {
    bf16_t* O; const bf16_t* Ga; const bf16_t* Gb; int ldg; unsigned char* MF8;
    __device__ __forceinline__ void operator()(EPI_ARGS) const {
        if (u.e == 0) { EpiGate<false> E{O, Ga, ldg, nullptr}; E(acc, u, wr, wc, fr, fq); }
        else { asm volatile("s_waitcnt vmcnt(0)" ::: "memory");
               EpiGate<true> E{O, Gb, ldg, MF8}; E(acc, u, wr, wc, fr, fq); }
    }
};
struct EpiResF32 {
    const float* base; bf16_t* out; float* ssp;
    __device__ __forceinline__ void operator()(EPI_ARGS) const {
        const int row0 = u.pm * BM + wr * 64 + fr, col0 = u.pn * BM + wc * 32 + 8 * fq;
#pragma unroll
        for (int ai = 0; ai < 2; ++ai)
#pragma unroll
            for (int m = 0; m < 4; ++m) { const size_t r = (size_t)(row0 + ai * HALF + m * 16); float ss = 0.f;
#pragma unroll
                for (int bj = 0; bj < 2; ++bj) { const size_t off = r * DM + col0 + bj * HALF;
                    const f32x4 b0 = *(const f32x4*)(base + off), b1 = *(const f32x4*)(base + off + 4);
                    const f32x4 y0 = b0 + acc[ai][bj][m][0], y1 = b1 + acc[ai][bj][m][1];
                    *(u32x4*)(out + off) = pack8(y0, y1);
                    ss += (y0[0] * y0[0] + y0[1] * y0[1]) + (y0[2] * y0[2] + y0[3] * y0[3]) + (y1[0] * y1[0] + y1[1] * y1[1]) + (y1[2] * y1[2] + y1[3] * y1[3]); }
                ss += __shfl_xor(ss, 16); ss += __shfl_xor(ss, 32);
                if (fq == 0) ssp[r * 16 + u.pn * 4 + wc] = ss; }
    }
};
struct EpiSwiglu {
    unsigned char* O; const float* bias;
    __device__ __forceinline__ void operator()(EPI_ARGS) const {
        const int row0 = u.pm * BM + wr * 64 + fr, j0 = u.pn * HALF + wc * 32 + 8 * fq;
        const float* be = bias + (size_t)u.e * 2048;
        f32x4 bg[2], bu[2];
#pragma unroll
        for (int n = 0; n < 2; ++n) { bg[n] = *(const f32x4*)(be + j0 + 4 * n); bu[n] = *(const f32x4*)(be + 1024 + j0 + 4 * n); }
#pragma unroll
        for (int ai = 0; ai < 2; ++ai)
#pragma unroll
            for (int m = 0; m < 4; ++m) { unsigned char* rowp = O + (size_t)(row0 + ai * HALF + m * 16) * DEXP + j0;
                f32x4 o[2];
#pragma unroll
                for (int n = 0; n < 2; ++n) { const f32x4 gv = acc[ai][0][m][n] + bg[n], uv = acc[ai][1][m][n] + bu[n];
#pragma unroll
                    for (int i = 0; i < 4; i += 2) {
                        const f32x2 gg = {fminf(gv[i], 7.0f), fminf(gv[i + 1], 7.0f)}, uu = {__builtin_amdgcn_fmed3f(uv[i], -7.0f, 7.0f), __builtin_amdgcn_fmed3f(uv[i + 1], -7.0f, 7.0f)};
                        const f32x2 ea = gg * (-1.702f * LOG2E); const f32x2 den = (f32x2){__builtin_amdgcn_exp2f(ea.x), __builtin_amdgcn_exp2f(ea.y)} + 1.0f;
                        const f32x2 num = uu * gg + gg; const f32x2 r = num * (f32x2){__builtin_amdgcn_rcpf(den.x), __builtin_amdgcn_rcpf(den.y)};
                        o[n][i] = r.x; o[n][i + 1] = r.y; } }
                *(u32x2*)rowp = (u32x2){pack4_fp8(o[0][0], o[0][1], o[0][2], o[0][3]), pack4_fp8(o[1][0], o[1][1], o[1][2], o[1][3])}; }
    }
};
struct EpiFinal {
    float* out; const bf16_t* PP; const bf16_t* X2;
    __device__ __forceinline__ void operator()(EPI_ARGS) const {
        const int row0 = u.pm * BM + wr * 64 + fr, col0 = u.pn * BM + wc * 32 + 8 * fq;
#pragma unroll
        for (int ai = 0; ai < 2; ++ai)
#pragma unroll
            for (int m = 0; m < 4; ++m) { const size_t r = (size_t)(row0 + ai * HALF + m * 16);
#pragma unroll
                for (int bj = 0; bj < 2; ++bj) { const size_t off = r * DM + col0 + bj * HALF;
                    f32x4 p0, p1, b0, b1; unpack8(*(const u32x4*)(PP + off), p0, p1); unpack8(*(const u32x4*)(X2 + off), b0, b1);
                    *(f32x4*)(out + off) = b0 + sig4(acc[ai][bj][m][0]) * p0; *(f32x4*)(out + off + 4) = b1 + sig4(acc[ai][bj][m][1]) * p1; } }
    }
};
}

namespace att {
__device__ __forceinline__ int crow(int r, int hi) { return (r & 3) + 8 * (r >> 2) + 4 * hi; }
__device__ __forceinline__ void glds16(const void* gsrc, unsigned lds_dst) { unsigned keep;
    asm volatile("s_mov_b32 %0, m0\n\ts_mov_b32 m0, %2\n\ts_nop 0\n\tglobal_load_lds_dwordx4 %1, off\n\ts_mov_b32 m0, %0" : "=&s"(keep) : "v"(gsrc), "s"(lds_dst) : "memory"); }
__device__ __forceinline__ s16x4 vtr(const LAS unsigned char* p) { return __builtin_bit_cast(s16x4, __builtin_amdgcn_ds_read_tr16_b64_v4i16((LAS s16x4*)p)); }
#define MX3(a, b, c) __builtin_fmaxf(__builtin_fmaxf((a), (b)), (c))
constexpr int VSLOT = 8192, OST_BYTES = NWAVES * 4096, WSF_BYTES = NWAVES * 256;

template <int DQK, bool MOBA>
__device__ __forceinline__ void attn_unit(int b, int qb, const bf16_t* Qh, int ldq, const bf16_t* Kh, int ldk, const bf16_t* Vh, int ldv, unsigned char* Oh, int ldo, const float* kmean, LAS unsigned char* shm, int wave) {
    constexpr int ND = DQK / 16, NCH = DQK / 8, KSLOT = NCH * 1024;
    constexpr int LDS_K = 0, LDS_V = 2 * KSLOT, LDS_WS = LDS_V + 2 * VSLOT, LDS_OST = LDS_WS + WSF_BYTES;
    static_assert(LDS_OST + OST_BYTES <= RING_BYTES, "attention LDS");
    int lane = lane_id(); asm volatile("" : "+v"(lane));
    const int r32 = lane & 31, hi = lane >> 5; const int wid = wave;
    const long rowbase = (long)b * SEQ; const int q0 = qb * 256;
    const unsigned lds0 = (unsigned)(uintptr_t)shm;
    LAS float* wsf = (LAS float*)(shm + LDS_WS) + wid * 64;
    const int NT = 4 * (qb + 1);
    const bf16_t* ksrc0 = Kh + (rowbase + lane) * ldk + wid * 8;
    const bf16_t* vsrc0 = Vh + (rowbase + 16 * (wid & 3) + (lane >> 2)) * ldv + (wid >> 2) * 32 + (lane & 3) * 8;
#define ATT_DMA(kt, s) do { const long ro_ = (long)(kt) * 64; \
        glds16(ksrc0 + ro_ * ldk, (unsigned)__builtin_amdgcn_readfirstlane(lds0 + LDS_K + (s) * KSLOT + wid * 1024)); \
        if (NCH > 8 && wid < NCH - 8) glds16(ksrc0 + ro_ * ldk + 64, (unsigned)__builtin_amdgcn_readfirstlane(lds0 + LDS_K + (s) * KSLOT + (wid + 8) * 1024)); \
        glds16(vsrc0 + ro_ * ldv, (unsigned)__builtin_amdgcn_readfirstlane(lds0 + LDS_V + (s) * VSLOT + wid * 1024)); } while (0)
#define ATT_TILE(i) (MOBA ? ((i) < 4 ? 4 * qb + (i) : (i) - 4) : (i))
    ATT_DMA(ATT_TILE(0), 0);
    const bf16_t* Qw = Qh + (rowbase + q0 + wid * 32 + r32) * ldq + hi * 8;
    bf16x8 qr[ND];
#pragma unroll
    for (int d0 = 0; d0 < ND; ++d0) qr[d0] = *(const bf16x8*)(Qw + d0 * 16);
    unsigned bmask = 0xffffffffu;
    if (MOBA) {
        bmask = 1u << qb;
        if (qb <= 3) bmask |= (1u << qb) - 1u;
        else {
            float gsc[7];
#pragma unroll
            for (int n = 0; n < 7; ++n) { float s = 0.f;
                if (n < qb) {
#pragma unroll
                    for (int d0 = 0; d0 < ND; ++d0) { const float* km = kmean + n * 64 + d0 * 16 + hi * 8; const f32x4 k0 = *(const f32x4*)km, k1 = *(const f32x4*)(km + 4);
                        s += bf2f((unsigned short)qr[d0][0]) * k0[0] + bf2f((unsigned short)qr[d0][1]) * k0[1] + bf2f((unsigned short)qr[d0][2]) * k0[2] + bf2f((unsigned short)qr[d0][3]) * k0[3]
                           + bf2f((unsigned short)qr[d0][4]) * k1[0] + bf2f((unsigned short)qr[d0][5]) * k1[1] + bf2f((unsigned short)qr[d0][6]) * k1[2] + bf2f((unsigned short)qr[d0][7]) * k1[3]; }
                    s += __shfl_xor(s, 32);
                } else s = -INFINITY;
                gsc[n] = s; }
#pragma unroll
            for (int pass = 0; pass < 3; ++pass) { float best = -INFINITY; int bi = 0;
#pragma unroll
                for (int n = 0; n < 7; ++n) { const bool ok = (n < qb) && !((bmask >> n) & 1u) && (gsc[n] > best); best = ok ? gsc[n] : best; bi = ok ? n : bi; }
                bmask |= 1u << bi; }
        }
    }
    asm volatile("s_waitcnt vmcnt(0)" ::: "memory");
#pragma unroll
    for (int d0 = 0; d0 < ND; ++d0) asm volatile("" : "+v"(qr[d0]));
    float mhat = 0.f, l_reg = 0.f; f32x16 o[2]; o[0] = f32x16{}; o[1] = f32x16{}; f32x16 negm = f32x16{}; asm volatile("" : "+v"(negm));
    const int qrel = wid * 32 + r32;
    const LAS unsigned char* kp0 = shm + LDS_K + hi * 1024 + r32 * 16;
    const LAS unsigned char* vp0 = shm + LDS_V + ((lane >> 4) & 1) * 32 + (lane & 3) * 8 + (4 * hi + ((lane & 15) >> 2)) * 64;
    for (int i = 0; i < NT; ++i) {
        const int s = i & 1, kt = ATT_TILE(i);
        asm volatile("s_waitcnt vmcnt(0) lgkmcnt(0)\n\ts_barrier" ::: "memory");
        if (i + 1 < NT) ATT_DMA(ATT_TILE(i + 1), s ^ 1);
        f32x16 cin = negm;
        if (MOBA) { if (i >= 4 && !((bmask >> (kt >> 2)) & 1u)) {
#pragma unroll
            for (int r = 0; r < 16; ++r) cin[r] = -INFINITY; } }
        f32x16 p0, p1;
        { const LAS unsigned char* kb = kp0 + s * KSLOT; bf16x8 kf[2 * ND];
#pragma unroll
            for (int d0 = 0; d0 < ND; ++d0) { kf[2 * d0] = *(const LAS bf16x8*)(kb + d0 * 2048); kf[2 * d0 + 1] = *(const LAS bf16x8*)(kb + d0 * 2048 + 512); }
            __builtin_amdgcn_sched_barrier(0);
#pragma unroll
            for (int d0 = 0; d0 < ND; ++d0) {
                if (d0 == 0) { p0 = __builtin_amdgcn_mfma_f32_32x32x16_bf16(kf[0], qr[0], cin, 0, 0, 0); p1 = __builtin_amdgcn_mfma_f32_32x32x16_bf16(kf[1], qr[0], cin, 0, 0, 0); }
                else { p0 = __builtin_amdgcn_mfma_f32_32x32x16_bf16(kf[2 * d0], qr[d0], p0, 0, 0, 0); p1 = __builtin_amdgcn_mfma_f32_32x32x16_bf16(kf[2 * d0 + 1], qr[d0], p1, 0, 0, 0); } } }
        if (kt >= 4 * qb) { const int kb = 64 * (kt - 4 * qb) + 4 * hi;
#pragma unroll
            for (int r = 0; r < 16; ++r) { const int kv = kb + (r & 3) + 8 * (r >> 2); if (kv > qrel) p0[r] = -INFINITY; if (kv + 32 > qrel) p1[r] = -INFINITY; } }
        bool resc = false;
        { float a = MX3(p0[0], p0[1], p1[0]), bb = MX3(p0[2], p0[3], p1[1]); a = MX3(a, p1[2], p1[3]);
#pragma unroll
            for (int r = 4; r < 16; r += 4) { a = MX3(a, p0[r], p0[r + 1]); bb = MX3(bb, p0[r + 2], p0[r + 3]); a = MX3(a, p1[r], p1[r + 1]); bb = MX3(bb, p1[r + 2], p1[r + 3]); }
            float rm = __builtin_fmaxf(a, bb); rm = __builtin_fmaxf(rm, __shfl_xor(rm, 32));
            const bool first = (i == 0);
            if (first || __any(rm > 6.0f)) {
                const float dl = first ? rm : __builtin_fmaxf(rm, 0.f); mhat += dl;
#pragma unroll
                for (int r = 0; r < 16; ++r) { p0[r] -= dl; p1[r] -= dl; }
#pragma unroll
                for (int r = 0; r < 16; ++r) negm[r] = -mhat;
                asm volatile("" : "+v"(negm));
                const float f = __builtin_amdgcn_exp2f(-dl); l_reg *= f; if (hi == 0) wsf[r32] = f; resc = true; } }
        float sacc = 0.f;
#pragma unroll
        for (int r = 0; r < 16; ++r) { p0[r] = __builtin_amdgcn_exp2f(p0[r]); p1[r] = __builtin_amdgcn_exp2f(p1[r]); sacc += p0[r] + p1[r]; }
        l_reg += sacc;
        u32x4 pw0, pw1, pw2, pw3;
        pw0 = (u32x4){cvt_pk_bf16(p0[0], p0[1]), cvt_pk_bf16(p0[2], p0[3]), cvt_pk_bf16(p0[4], p0[5]), cvt_pk_bf16(p0[6], p0[7])};
        pw1 = (u32x4){cvt_pk_bf16(p0[8], p0[9]), cvt_pk_bf16(p0[10], p0[11]), cvt_pk_bf16(p0[12], p0[13]), cvt_pk_bf16(p0[14], p0[15])};
        pw2 = (u32x4){cvt_pk_bf16(p1[0], p1[1]), cvt_pk_bf16(p1[2], p1[3]), cvt_pk_bf16(p1[4], p1[5]), cvt_pk_bf16(p1[6], p1[7])};
        pw3 = (u32x4){cvt_pk_bf16(p1[8], p1[9]), cvt_pk_bf16(p1[10], p1[11]), cvt_pk_bf16(p1[12], p1[13]), cvt_pk_bf16(p1[14], p1[15])};
        if (resc) {
#pragma unroll
            for (int d_ = 0; d_ < 2; ++d_)
#pragma unroll
                for (int r = 0; r < 16; ++r) o[d_][r] *= wsf[crow(r, hi)];
        }
        { const LAS unsigned char* vp = vp0 + s * VSLOT;
#pragma unroll
            for (int d0 = 0; d0 < 2; ++d0) {
                s16x4 lo[4], hh[4];
#pragma unroll
                for (int ks = 0; ks < 4; ++ks) { lo[ks] = vtr(vp + d0 * 4096 + ks * 1024); hh[ks] = vtr(vp + d0 * 4096 + ks * 1024 + 512); }
                __builtin_amdgcn_sched_barrier(0);
#define PKV(k) (bf16x8){lo[k][0], lo[k][1], lo[k][2], lo[k][3], hh[k][0], hh[k][1], hh[k][2], hh[k][3]}
                o[d0] = __builtin_amdgcn_mfma_f32_32x32x16_bf16(__builtin_bit_cast(bf16x8, pw0), PKV(0), o[d0], 0, 0, 0);
                o[d0] = __builtin_amdgcn_mfma_f32_32x32x16_bf16(__builtin_bit_cast(bf16x8, pw1), PKV(1), o[d0], 0, 0, 0);
                o[d0] = __builtin_amdgcn_mfma_f32_32x32x16_bf16(__builtin_bit_cast(bf16x8, pw2), PKV(2), o[d0], 0, 0, 0);
                o[d0] = __builtin_amdgcn_mfma_f32_32x32x16_bf16(__builtin_bit_cast(bf16x8, pw3), PKV(3), o[d0], 0, 0, 0);
#undef PKV
            } }
    }
    l_reg += __shfl_xor(l_reg, 32);
    if (hi == 0) wsf[32 + r32] = l_reg;
    float rli[16];
#pragma unroll
    for (int r = 0; r < 16; ++r) rli[r] = __builtin_amdgcn_rcpf(wsf[32 + crow(r, hi)]);
    unsigned char* Ow = (unsigned char*)Oh + (rowbase + q0 + wid * 32) * ldo;
    { LAS unsigned char* stg = shm + LDS_OST + wid * 2048;
#pragma unroll
        for (int r = 0; r < 16; ++r) { const int orow = crow(r, hi);
#pragma unroll
            for (int d0 = 0; d0 < 2; ++d0) stg[orow * 64 + d0 * 32 + r32] = (unsigned char)(pack4_fp8(o[d0][r] * rli[r], 0.f, 0.f, 0.f) & 0xffu); }
#pragma unroll
        for (int i = 0; i < 2; ++i) { const int row = i * 16 + (lane >> 2), ch = lane & 3; const u32x4 v = *(const LAS u32x4*)(stg + row * 64 + ch * 16); *(u32x4*)(Ow + (long)row * ldo + ch * 16) = v; } }
    asm volatile("s_waitcnt lgkmcnt(0)\n\ts_barrier" ::: "memory");
#undef ATT_DMA
#undef ATT_TILE
}
#undef MX3
}

#define XB_TMO      128
#define XB_XCNT(j)  (256  + 64 * (j))
#define XB_XSUB(j)  (1280 + 64 * (j))
#define XB_XGEN(j)  (2304 + 64 * (j))
#define XB_TOP      3328
#define XB_TOPGEN   3392
#define XCD_BAR_WORDS 3456
#define XB_SPIN_CAP (1u << 22)
__device__ __forceinline__ unsigned xb_ld(unsigned* p)              { return __hip_atomic_load(p, __ATOMIC_RELAXED, __HIP_MEMORY_SCOPE_AGENT); }
__device__ __forceinline__ unsigned xb_add(unsigned* p, unsigned v) { return __hip_atomic_fetch_add(p, v, __ATOMIC_RELAXED, __HIP_MEMORY_SCOPE_AGENT); }
__device__ __forceinline__ unsigned xb_xcc_id() { return (unsigned)__builtin_amdgcn_s_getreg((3 << 11) | 20) & 0xFu; }
#define XB_SPIN(cond, bar) do { unsigned _sp = 0; while (cond) { __builtin_amdgcn_s_sleep(1); \
    if ((++_sp & 255u) == 0u) { if (xb_ld(&(bar)[XB_TMO])) break; if (_sp > XB_SPIN_CAP) { atomicAdd(&(bar)[XB_TMO], 1u); break; } } } } while (0)
struct XcdBarrier { unsigned* bar; unsigned x; volatile LAS unsigned* st; int wave; };
__device__ __forceinline__ XcdBarrier xcd_barrier_post(unsigned* bar, volatile LAS unsigned* st, int wave) {
    XcdBarrier b; b.bar = bar; b.x = xb_xcc_id(); b.st = st; b.wave = wave;
    if (wave == 0 && lane_id() == 0) (void)xb_add(&bar[XB_XCNT(b.x)], 1u);
    return b;
}
__device__ __forceinline__ void xcd_barrier_complete(unsigned* bar, unsigned x, unsigned& nloc, unsigned& nx) {
    const unsigned G = gridDim.x * gridDim.y * gridDim.z;
    unsigned sum, cnt, mine, sp = 0u;
    for (;;) {
        sum = 0u; cnt = 0u; mine = 0u;
#pragma unroll
        for (unsigned j = 0; j < 16; ++j) { const unsigned c = xb_ld(&bar[XB_XCNT(j)]); sum += c; cnt += (c > 0u) ? 1u : 0u; mine = (j == x) ? c : mine; }
        if (sum == G) break;
        __builtin_amdgcn_s_sleep(1);
        if ((++sp & 255u) == 0u) { if (xb_ld(&bar[XB_TMO])) break; if (sp > XB_SPIN_CAP) { atomicAdd(&bar[XB_TMO], 1u); break; } }
    }
    nloc = mine > 0u ? mine : 1u; nx = cnt > 0u ? cnt : 1u;
}
__device__ __forceinline__ void xcd_barrier(const XcdBarrier& b) {
    asm volatile("s_waitcnt vmcnt(0)" ::: "memory");
    __syncthreads();
    if (b.wave == 0 && lane_id() == 0) {
        unsigned* bar = b.bar;
        __builtin_amdgcn_s_waitcnt(0);
        unsigned nloc = b.st[0], nx = b.st[1];
        if (nloc == 0u) { xcd_barrier_complete(bar, b.x, nloc, nx); b.st[0] = nloc; b.st[1] = nx; }
        const unsigned old = xb_add(&bar[XB_XSUB(b.x)], 1u);
        const unsigned gen = old / nloc;
        if (old + 1u == (gen + 1u) * nloc) {
            __builtin_amdgcn_fence(__ATOMIC_RELEASE, "agent");
            asm volatile("s_waitcnt vmcnt(0)" ::: "memory");
            const unsigned og = xb_add(&bar[XB_TOP], 1u);
            const unsigned tg = og / nx;
            if (og + 1u == (tg + 1u) * nx) xb_add(&bar[XB_TOPGEN], 1u);
            else XB_SPIN(xb_ld(&bar[XB_TOPGEN]) == tg, bar);
            __builtin_amdgcn_fence(__ATOMIC_ACQUIRE, "agent");
            xb_add(&bar[XB_XGEN(b.x)], 1u);
            asm volatile("s_waitcnt vmcnt(0)" ::: "memory");
        } else {
            XB_SPIN(xb_ld(&bar[XB_XGEN(b.x)]) == gen, bar);
            __builtin_amdgcn_fence(__ATOMIC_ACQUIRE, "agent");
            asm volatile("s_waitcnt vmcnt(0)" ::: "memory");
        }
    }
    __syncthreads();
}

struct Params { const float* in[25]; float* out; unsigned char* ws; int ph_lo, ph_hi; };
enum { I_X = 0, I_P, I_GMIX, I_WIN, I_MQN, I_MKN, I_QLATN, I_WUQ, I_KVLATN, I_WUKV, I_MLAQN, I_MLAKN, I_WA, I_WB, I_WO, I_GFFN, I_WR, I_BR, I_WGU, I_BGU, I_WD, I_BD, I_GPLE, I_WPG, I_WPP };
constexpr int NPHASE = 16;

struct Frame {
    LAS unsigned char* lds; int vcu, G, wave;
    const Params* P; unsigned char* ws;
};
struct Ids { int tid, lane, wave; };
#define PHASE_IDS() Ids I_; { int l_ = lane_id(); asm volatile("" : "+v"(l_)); I_.lane = l_; I_.wave = F.wave; I_.tid = F.wave * 64 + l_; }

#ifdef TPROBE_A
#define STAMP(k) do { if (blockIdx.x == 0 && F.wave == 0 && lane_id() == 0) ((volatile unsigned long long*)(ws + WS_ERR))[k] = __builtin_amdgcn_s_memrealtime(); } while (0)
#else
#define STAMP(k) do {} while (0)
#endif
__device__ __forceinline__ int rowmap(int mode, int c) {
    if (mode == 1) {
        if (c < 1024) { const int base = c & 512, s_ = c & 511, h = s_ >> 6, d = s_ & 63; return base + 256 * (h >> 2) + 128 * (d >> 5) + 32 * (h & 3) + (d & 31); }
        return c < 1952 ? c : c + 96; }
    if (mode == 2) return c < 1024 ? 256 * (c >> 7) + (c & 127) : 256 * ((c - 1024) >> 7) + 128 + ((c - 1024) & 127);
    if (mode == 3) {
        const int h = c / 96, d = c % 96; int t;
        if (d < 64) t = d; else if (d < 80) { const int i = d - 64; t = 64 + 8 * (i >> 2) + (i & 3); } else { const int i = d - 80; t = 64 + 8 * (i >> 2) + 4 + (i & 3); }
        return 128 * h + t; }
    return c;
}
__device__ __forceinline__ void tr_item64(const float* W, int ldw, int N, int k0, int n0, bf16_t* dst, int ldd, int mode, LAS float* scr, int lane) {
    const int r = lane >> 4, c4 = lane & 15; const bool inb = (n0 + 4 * c4) < N;
    f32x4 v[16];
#pragma unroll
    for (int i = 0; i < 16; ++i) v[i] = inb ? __builtin_nontemporal_load((const f32x4*)(W + (size_t)(k0 + 4 * i + r) * ldw + n0 + 4 * c4)) : (f32x4){0.f, 0.f, 0.f, 0.f};
#pragma unroll
    for (int i = 0; i < 16; ++i) { LAS float* p = scr + (4 * i + r) * 65 + 4 * c4; p[0] = v[i].x; p[1] = v[i].y; p[2] = v[i].z; p[3] = v[i].w; }
    asm volatile("s_waitcnt lgkmcnt(0)" ::: "memory");
    const int c = lane & 7;
#pragma unroll
    for (int j = 0; j < 8; ++j) { const int n = (lane >> 3) + 8 * j; const LAS float* sp = scr + (8 * c) * 65 + n;
        u32x4 o; o.x = cvt_pk_bf16(sp[0 * 65], sp[1 * 65]); o.y = cvt_pk_bf16(sp[2 * 65], sp[3 * 65]); o.z = cvt_pk_bf16(sp[4 * 65], sp[5 * 65]); o.w = cvt_pk_bf16(sp[6 * 65], sp[7 * 65]);
        if (n0 + n < N) *(u32x4*)(dst + (size_t)rowmap(mode, n0 + n) * ldd + k0 + 8 * c) = o; }
    asm volatile("s_waitcnt lgkmcnt(0)" ::: "memory");
}

__device__ __forceinline__ void tr_item_f8(const float* W, int ldw, int k0, int n0, unsigned char* dst, int ldd, int mode, LAS float* scr, int lane) {
    const int r = lane >> 3, c4 = lane & 7;
    f32x4 v[16];
#pragma unroll
    for (int i = 0; i < 16; ++i) v[i] = __builtin_nontemporal_load((const f32x4*)(W + (size_t)(k0 + 8 * i + r) * ldw + n0 + 4 * c4));
#pragma unroll
    for (int i = 0; i < 16; ++i) { LAS float* p = scr + (8 * i + r) * 33 + 4 * c4; p[0] = v[i].x * 64.f; p[1] = v[i].y * 64.f; p[2] = v[i].z * 64.f; p[3] = v[i].w * 64.f; }
    asm volatile("s_waitcnt lgkmcnt(0)" ::: "memory");
    const int c = lane & 7;
#pragma unroll
    for (int j = 0; j < 4; ++j) { const int n = (lane >> 3) + 8 * j; const LAS float* sp = scr + (16 * c) * 33 + n;
        u32x4 o; o.x = pack4_fp8(sp[0 * 33], sp[1 * 33], sp[2 * 33], sp[3 * 33]); o.y = pack4_fp8(sp[4 * 33], sp[5 * 33], sp[6 * 33], sp[7 * 33]);
        o.z = pack4_fp8(sp[8 * 33], sp[9 * 33], sp[10 * 33], sp[11 * 33]); o.w = pack4_fp8(sp[12 * 33], sp[13 * 33], sp[14 * 33], sp[15 * 33]);
        __builtin_nontemporal_store(o, (u32x4*)(dst + (size_t)rowmap(mode, n0 + n) * ldd + k0 + 16 * c)); }
    asm volatile("s_waitcnt lgkmcnt(0)" ::: "memory");
}

__device__ __forceinline__ void phase0(Frame& F) {
    PHASE_IDS();
    const Params& P = *F.P; unsigned char* ws = F.ws;
    LAS float* scr = (LAS float*)(F.lds + I_.wave * 16896);
    const int gw = F.vcu * NWAVES + I_.wave, NGW = F.G * NWAVES;
    constexpr int I_GU = 32 * 8 * 64, I_DN = 32 * 8 * 32, I_IN = 8 * 61, I_ING = 8 * 64, I_UQ = 4 * 12, I_UKV = 2 * 16, I_A = 8 * 16, I_O = 16 * 16, I_PP = 4 * 16;
    constexpr int I_PG = 8 * 32;
    constexpr int NITEMS = I_GU + I_DN + I_IN + I_ING + I_UQ + I_UKV + 2 * I_A + I_O + I_PG + I_PP;
    for (int it = gw; it < NITEMS; it += NGW) {
        int r = it;
        if (r < I_GU) { const int e = r >> 9, q = r & 511, kb = q >> 6, g = q & 63;
            tr_item_f8(P.in[I_WGU] + (size_t)e * 1024 * 2048, 2048, 128 * kb, 32 * g, ws + WS_W1 + (size_t)e * 2048 * 1024, 1024, 2, scr, I_.lane); continue; } r -= I_GU;
        if (r < I_DN) { const int e = r >> 8, q = r & 255, kb = q >> 5, g = q & 31;
            tr_item_f8(P.in[I_WD] + (size_t)e * 1024 * 1024, 1024, 128 * kb, 32 * g, ws + WS_W2 + (size_t)e * 1024 * 1024, 1024, 0, scr, I_.lane); continue; } r -= I_DN;
        if (r < I_IN) { const int kb = r / 61, g = r % 61; tr_item_f8(P.in[I_WIN], DIN, 128 * kb, 32 * g, ws + WS_WIN, 1024, 1, scr, I_.lane); continue; } r -= I_IN;
        if (r < I_ING) { const int kb = r >> 6, g = r & 63; tr_item_f8(P.in[I_WIN] + 1952, DIN, 128 * kb, 32 * g, ws + WS_WINF8, 1024, 0, scr, I_.lane); continue; } r -= I_ING;
        if (r < I_UQ) { const int kb = r / 12, g = r % 12; tr_item64(P.in[I_WUQ], 768, 768, 64 * kb, 64 * g, (bf16_t*)(ws + WS_WUQ), 256, 3, scr, I_.lane); continue; } r -= I_UQ;
        if (r < I_UKV) { const int kb = r / 16, g = r % 16; tr_item64(P.in[I_WUKV], 1024, 1024, 64 * kb, 64 * g, (bf16_t*)(ws + WS_WUKV), 128, 0, scr, I_.lane); continue; } r -= I_UKV;
        if (r < I_A) { const int kb = r >> 5, g = r & 31; tr_item_f8(P.in[I_WA], 1024, 128 * kb, 32 * g, ws + WS_WA, 512, 0, scr, I_.lane); continue; } r -= I_A;
        if (r < I_A) { const int kb = r >> 5, g = r & 31; tr_item_f8(P.in[I_WB], 1024, 128 * kb, 32 * g, ws + WS_WB, 512, 0, scr, I_.lane); continue; } r -= I_A;
        if (r < I_PG) { const int kb = r >> 5, g = r & 31; tr_item_f8(P.in[I_WO], 1024, 128 * kb, 32 * g, ws + WS_WO, 1024, 0, scr, I_.lane); continue; } r -= I_PG;
        if (r < I_PG) { const int kb = r >> 5, g = r & 31; tr_item_f8(P.in[I_WPG], 1024, 128 * kb, 32 * g, ws + WS_WPG, 1024, 0, scr, I_.lane); continue; } r -= I_PG;
        { const int kb = r / 16, g = r % 16; tr_item64(P.in[I_WPP], 1024, 1024, 64 * kb, 64 * g, (bf16_t*)(ws + WS_WPP), 256, 0, scr, I_.lane); }
    }
    STAMP(20);
    { const f32x4* gp = (const f32x4*)P.in[I_GMIX] + I_.lane; f32x4 gv[4];
#pragma unroll
        for (int j = 0; j < 4; ++j) gv[j] = gp[64 * j];
        for (int m0 = gw * 4; m0 < NTOK; m0 += NGW * 4) { f32x4 v[4][4];
#pragma unroll
            for (int q = 0; q < 4; ++q) { const f32x4* xr = (const f32x4*)(P.in[I_X] + (size_t)(m0 + q) * DM) + I_.lane;
#pragma unroll
                for (int j = 0; j < 4; ++j) v[q][j] = xr[64 * j]; }
#pragma unroll
            for (int q = 0; q < 4; ++q) { float s = 0.f;
#pragma unroll
                for (int j = 0; j < 4; ++j) s += (v[q][j].x * v[q][j].x + v[q][j].y * v[q][j].y) + (v[q][j].z * v[q][j].z + v[q][j].w * v[q][j].w);
                const float rstd = 1.0f / sqrtf(wave_sum(s) * (1.f / DM) + EPS);
                u32x2* o8 = (u32x2*)((bf16_t*)(ws + WS_HN) + (size_t)(m0 + q) * DM) + I_.lane; unsigned* o4 = (unsigned*)(ws + WS_HNF8 + (size_t)(m0 + q) * DM) + I_.lane;
#pragma unroll
                for (int j = 0; j < 4; ++j) { const f32x4 y = v[q][j] * rstd * gv[j]; o8[64 * j] = (u32x2){cvt_pk_bf16(y.x, y.y), cvt_pk_bf16(y.z, y.w)}; o4[64 * j] = pack4_fp8(y.x, y.y, y.z, y.w); } } } }
    STAMP(21);
    { float* km = (float*)(ws + WS_KMEAN); for (int i = F.vcu * NTHREADS + I_.tid; i < 8 * 8 * 8 * 64; i += F.G * NTHREADS) km[i] = 0.f; }
    { const size_t n4 = (size_t)NTOK * 256 / 4; const f32x4* pp = (const f32x4*)P.in[I_P]; u32x2* po = (u32x2*)(ws + WS_PB); const size_t T = (size_t)F.G * NTHREADS;
        for (size_t i = (size_t)F.vcu * NTHREADS + I_.tid; i < n4; i += 4 * T) { f32x4 v[4];
#pragma unroll
            for (int q = 0; q < 4; ++q) v[q] = __builtin_nontemporal_load(pp + i + q * T);
#pragma unroll
            for (int q = 0; q < 4; ++q) po[i + q * T] = (u32x2){cvt_pk_bf16(v[q].x, v[q].y), cvt_pk_bf16(v[q].z, v[q].w)}; } }
    STAMP(22);
    { float* tab = (float*)(ws + WS_ROPE);
        for (int i = F.vcu * NTHREADS + I_.tid; i < 2048 * 48; i += F.G * NTHREADS) {
            int pos, j, half; float* cdst; float* sdst;
            if (i < 2048 * 32) { pos = i / 32; j = i % 32; half = 32; cdst = tab + i; sdst = tab + 65536 + i; }
            else { const int q = i - 2048 * 32; pos = q / 16; j = q % 16; half = 16; cdst = tab + 131072 + q; sdst = tab + 131072 + 32768 + q; }
            const float inv = powf(10000.0f, -((float)j / (float)half)); const float ang = (float)pos * inv;
            *cdst = cosf(ang); *sdst = sinf(ang);
            if (pos == 0) tab[196608 + (half == 32 ? j : 32 + j)] = inv * 0.15915494309189535f; } }
}

__device__ __forceinline__ void phase2(Frame& F) {
    PHASE_IDS();
    const Params& P = *F.P; unsigned char* ws = F.ws;
    const bf16_t* PROJ = (const bf16_t*)(ws + WS_PROJ);
    const float* cosA = (const float*)(ws + WS_ROPE); const float* sinA = cosA + 65536;
    LAS float* kst = (LAS float*)F.lds;
    LAS float* part = kst + 256 * 68;
    for (int it = F.vcu; it < 512; it += F.G) {
        const int b = it >> 6, blk = (it >> 3) & 7, h = it & 7;
        const int sel = I_.lane >> 5, r = I_.wave * 32 + (I_.lane & 31); const int pos = blk * 256 + r; const size_t row = (size_t)b * SEQ + pos;
        const u32x4* src = (const u32x4*)(PROJ + row * DINP + (sel ? PC_KA : PC_QA) + h * 64);
        u32x4 raw[8];
#pragma unroll
        for (int c = 0; c < 8; ++c) raw[c] = src[c];
        float ss = 0.f;
#pragma unroll
        for (int c = 0; c < 8; ++c) { f32x4 a0, a1; pg8::unpack8(raw[c], a0, a1); ss += (a0[0] * a0[0] + a0[1] * a0[1]) + (a0[2] * a0[2] + a0[3] * a0[3]) + (a1[0] * a1[0] + a1[1] * a1[1]) + (a1[2] * a1[2] + a1[3] * a1[3]); }
        const float rstd = 1.0f / sqrtf(ss * (1.f / 64.f) + EPS);
        const float* gn = sel ? P.in[I_MKN] : P.in[I_MQN];
        const float sc = sel ? 1.0f : C2A;
        bf16_t* dst = (bf16_t*)(ws + (sel ? WS_KA2 : WS_QA2)) + row * 512 + h * 64;
#pragma unroll
        for (int c = 0; c < 4; ++c) { f32x4 x1a, x1b, x2a, x2b; pg8::unpack8(raw[c], x1a, x1b); pg8::unpack8(raw[c + 4], x2a, x2b);
            const f32x4 g1a = *(const f32x4*)(gn + 8 * c), g1b = *(const f32x4*)(gn + 8 * c + 4), g2a = *(const f32x4*)(gn + 32 + 8 * c), g2b = *(const f32x4*)(gn + 36 + 8 * c);
            x1a = x1a * g1a * rstd; x1b = x1b * g1b * rstd; x2a = x2a * g2a * rstd; x2b = x2b * g2b * rstd;
            const f32x4 ca = *(const f32x4*)(cosA + pos * 32 + 8 * c), cb = *(const f32x4*)(cosA + pos * 32 + 8 * c + 4), sa = *(const f32x4*)(sinA + pos * 32 + 8 * c), sb = *(const f32x4*)(sinA + pos * 32 + 8 * c + 4);
            const f32x4 y1a = x1a * ca - x2a * sa, y1b = x1b * cb - x2b * sb, y2a = x2a * ca + x1a * sa, y2b = x2b * cb + x1b * sb;
            *(u32x4*)(dst + 8 * c) = pg8::pack8(y1a * sc, y1b * sc); *(u32x4*)(dst + 32 + 8 * c) = pg8::pack8(y2a * sc, y2b * sc);
            if (sel) { LAS f32x4* kr = (LAS f32x4*)(kst + r * 68); kr[2 * c] = y1a; kr[2 * c + 1] = y1b; kr[8 + 2 * c] = y2a; kr[8 + 2 * c + 1] = y2b; } }
        __syncthreads();
        { const int d = I_.tid & 63, pt = I_.tid >> 6; float s = 0.f;
#pragma unroll 8
            for (int rr = 0; rr < 32; ++rr) s += kst[(pt * 32 + rr) * 68 + d];
            part[pt * 64 + d] = s; }
        __syncthreads();
        if (I_.tid < 64) { float s = 0.f;
#pragma unroll
            for (int pt = 0; pt < 8; ++pt) s += part[pt * 64 + I_.tid];
            ((float*)(ws + WS_KMEAN))[(((size_t)b * 8 + h) * 8 + blk) * 64 + I_.tid] = s * (1.f / 256.f); }
        __syncthreads();
    }
    const int gw = F.vcu * NWAVES + I_.wave, NGW = F.G * NWAVES;
    const f32x4 gq = ((const f32x4*)P.in[I_QLATN])[I_.lane]; const f32x2 gk = ((const f32x2*)P.in[I_KVLATN])[I_.lane];
    for (int m0 = gw * 8; m0 < NTOK; m0 += NGW * 8) {
        u32x2 wq[8]; unsigned wk[8];
#pragma unroll
        for (int q = 0; q < 8; ++q) { wq[q] = *((const u32x2*)(PROJ + (size_t)(m0 + q) * DINP + PC_CQ) + I_.lane); wk[q] = *((const unsigned*)(PROJ + (size_t)(m0 + q) * DINP + PC_CKV) + I_.lane); }
#pragma unroll
        for (int r = 0; r < 8; ++r) { const int m = m0 + r;
            const f32x4 q = {bflo(wq[r].x), bfhi(wq[r].x), bflo(wq[r].y), bfhi(wq[r].y)}; const f32x2 k = {bflo(wk[r]), bfhi(wk[r])};
            const float sq = wave_sum((q.x * q.x + q.y * q.y) + (q.z * q.z + q.w * q.w)), sk = wave_sum(k.x * k.x + k.y * k.y);
            const float rq = 1.0f / sqrtf(sq * (1.f / 256.f) + EPS), rk = 1.0f / sqrtf(sk * (1.f / 128.f) + EPS);
            const f32x4 yq = q * rq * gq; const f32x2 yk = k * rk * gk;
            *((u32x2*)((bf16_t*)(ws + WS_CQN) + (size_t)m * 256) + I_.lane) = (u32x2){cvt_pk_bf16(yq.x, yq.y), cvt_pk_bf16(yq.z, yq.w)};
            *((unsigned*)((bf16_t*)(ws + WS_CKVN) + (size_t)m * 128) + I_.lane) = cvt_pk_bf16(yk.x, yk.y); }
    }
}

__device__ __forceinline__ void phase4(Frame& F) {
    PHASE_IDS();
    const Params& P = *F.P; unsigned char* ws = F.ws;
    const bf16_t* PROJ = (const bf16_t*)(ws + WS_PROJ);
    const float* cosB = (const float*)(ws + WS_ROPE) + 131072; const float* sinB = cosB + 32768;
    const int gw = F.vcu * NWAVES + I_.wave, NGW = F.G * NWAVES;
    for (int it = gw; it < (NTOK / 64) * 16; it += NGW) {
        const int h = it & 7, sel = (it >> 3) & 1, rg = it >> 4; const size_t row = (size_t)rg * 64 + I_.lane; const int pos = (int)(row & (SEQ - 1));
        u32x4 raw[12];
        bf16_t* qrow = (bf16_t*)(ws + WS_QB) + row * 768 + h * 96;
        if (sel == 0) {
#pragma unroll
            for (int c = 0; c < 12; ++c) raw[c] = *(const u32x4*)(qrow + 8 * c);
        } else {
            const bf16_t* kn = (const bf16_t*)(ws + WS_KV) + row * 1024 + h * 128; const bf16_t* kp = PROJ + row * DINP + PC_KPE;
#pragma unroll
            for (int c = 0; c < 8; ++c) raw[c] = *(const u32x4*)(kn + 8 * c);
#pragma unroll
            for (int c = 0; c < 4; ++c) raw[8 + c] = *(const u32x4*)(kp + 8 * c);
        }
        float ss = 0.f;
#pragma unroll
        for (int c = 0; c < 12; ++c) { f32x4 a0, a1; pg8::unpack8(raw[c], a0, a1); ss += (a0[0] * a0[0] + a0[1] * a0[1]) + (a0[2] * a0[2] + a0[3] * a0[3]) + (a1[0] * a1[0] + a1[1] * a1[1]) + (a1[2] * a1[2] + a1[3] * a1[3]); }
        const float rstd = 1.0f / sqrtf(ss * (1.f / 96.f) + EPS);
        const float* gn = sel ? P.in[I_MLAKN] : P.in[I_MLAQN];
        const float sc = sel ? 1.0f : C2B; const float rs = rstd * sc;
        bf16_t* dst = sel ? (bf16_t*)(ws + WS_KB2) + row * 768 + h * 96 : qrow;
#pragma unroll
        for (int c = 0; c < 8; ++c) { f32x4 a0, a1; pg8::unpack8(raw[c], a0, a1); const f32x4 g0 = *(const f32x4*)(gn + 8 * c), g1 = *(const f32x4*)(gn + 8 * c + 4);
            *(u32x4*)(dst + 8 * c) = pg8::pack8(a0 * g0 * rs, a1 * g1 * rs); }
#pragma unroll
        for (int c = 0; c < 2; ++c) { f32x4 x1a, x1b, x2a, x2b; pg8::unpack8(raw[8 + c], x1a, x1b); pg8::unpack8(raw[10 + c], x2a, x2b);
            const f32x4 g1a = *(const f32x4*)(gn + 64 + 8 * c), g1b = *(const f32x4*)(gn + 68 + 8 * c), g2a = *(const f32x4*)(gn + 80 + 8 * c), g2b = *(const f32x4*)(gn + 84 + 8 * c);
            x1a = x1a * g1a * rs; x1b = x1b * g1b * rs; x2a = x2a * g2a * rs; x2b = x2b * g2b * rs;
            const f32x4 ca = *(const f32x4*)(cosB + pos * 16 + 8 * c), cb = *(const f32x4*)(cosB + pos * 16 + 8 * c + 4), sa = *(const f32x4*)(sinB + pos * 16 + 8 * c), sb = *(const f32x4*)(sinB + pos * 16 + 8 * c + 4);
            *(u32x4*)(dst + 64 + 8 * c) = pg8::pack8(x1a * ca - x2a * sa, x1b * cb - x2b * sb);
            *(u32x4*)(dst + 80 + 8 * c) = pg8::pack8(x2a * ca + x1a * sa, x2b * cb + x1b * sb); }
    }
}

__device__ __forceinline__ void phase5(Frame& F) {
    unsigned char* ws = F.ws;
    for (int it = F.vcu; it < 256; it += F.G) {
        const int bh = it >> 2, sidx = it & 3, b = bh >> 3, h = bh & 7;
#pragma unroll 1
        for (int k = 0; k < 2; ++k) { const int qb = k ? 7 - sidx : sidx;
            att::attn_unit<64, true>(b, qb, (const bf16_t*)(ws + WS_QA2) + h * 64, 512, (const bf16_t*)(ws + WS_KA2) + h * 64, 512, (const bf16_t*)(ws + WS_PROJ) + PC_VA + h * 64, DINP,
                                     ws + WS_Y + h * 64, 1024, (const float*)(ws + WS_KMEAN) + (size_t)bh * 512, F.lds, F.wave); }
#pragma unroll 1
        for (int k = 0; k < 2; ++k) { const int qb = k ? 7 - sidx : sidx;
            att::attn_unit<96, false>(b, qb, (const bf16_t*)(ws + WS_QB) + h * 96, 768, (const bf16_t*)(ws + WS_KB2) + h * 96, 768, (const bf16_t*)(ws + WS_KV) + h * 128 + 64, 1024,
                                      ws + WS_Y + 512 + h * 64, 1024, nullptr, F.lds, F.wave); }
    }
}

__device__ __forceinline__ void phase8(Frame& F) {
    PHASE_IDS();
    const Params& P = *F.P; unsigned char* ws = F.ws;
    constexpr int HCS = 132, WCS = 48;
    LAS float* HC = (LAS float*)F.lds;
    LAS float* WC = HC + 2 * 64 * HCS;
    LAS float* RSTD = WC + 2 * 128 * WCS;
    LAS float* LOGIT = RSTD + 64;
    LAS int* pe = (LAS int*)(LOGIT + 64 * 33);
    int* PAIR_E = (int*)(ws + WS_PAIR); int* PAIR_RANK = PAIR_E + 65536; float* PAIR_W = (float*)(PAIR_E + 131072);
    const float* gffn = P.in[I_GFFN]; const float* wr_ = P.in[I_WR]; const float* br_ = P.in[I_BR];
    const int r0 = F.vcu * 64;
    if (I_.tid < 64) { const f32x4* sp = (const f32x4*)((const float*)(ws + WS_SSP) + (size_t)(r0 + I_.tid) * 16); const f32x4 a = sp[0], b = sp[1], c = sp[2], d = sp[3];
        const float ss = (((a[0] + a[1]) + (a[2] + a[3])) + ((b[0] + b[1]) + (b[2] + b[3]))) + (((c[0] + c[1]) + (c[2] + c[3])) + ((d[0] + d[1]) + (d[2] + d[3])));
        RSTD[I_.tid] = 1.0f / sqrtf(ss * (1.f / DM) + EPS); }
    __syncthreads();
    const int eg = I_.wave & 1, rgp = I_.wave >> 1, l15 = I_.lane & 15, l4 = I_.lane >> 4;
    const int srow = I_.tid >> 5, sc4 = I_.tid & 31;
    const int wrow = I_.tid >> 3, wc4 = I_.tid & 7;
    f32x4 stg[4], wst[2];
#define P8_LOAD(kc) do { _Pragma("unroll") for (int i = 0; i < 4; ++i) { const u32x2 w_ = *(const u32x2*)((const bf16_t*)(ws + WS_X1B) + (size_t)(r0 + srow + 16 * i) * DM + (kc) * 128 + 4 * sc4); stg[i] = (f32x4){bflo(w_.x), bfhi(w_.x), bflo(w_.y), bfhi(w_.y)}; } \
        _Pragma("unroll") for (int i = 0; i < 2; ++i) wst[i] = *(const f32x4*)(wr_ + (size_t)((kc) * 128 + wrow + 64 * i) * 32 + 4 * wc4); } while (0)
#define P8_STORE(kc, buf) do { const f32x4 g4 = *(const f32x4*)(gffn + (kc) * 128 + 4 * sc4); _Pragma("unroll") for (int i = 0; i < 4; ++i) { const float rs = RSTD[srow + 16 * i]; const f32x4 y = stg[i] * rs * g4; \
        *(LAS f32x4*)(HC + ((buf) * 64 + srow + 16 * i) * HCS + 4 * sc4) = y; *(unsigned*)(ws + WS_HNF8 + (size_t)(r0 + srow + 16 * i) * DM + (kc) * 128 + 4 * sc4) = pack4_fp8(y.x, y.y, y.z, y.w); } \
        _Pragma("unroll") for (int i = 0; i < 2; ++i) *(LAS f32x4*)(WC + ((buf) * 128 + wrow + 64 * i) * WCS + 4 * wc4) = wst[i]; } while (0)
    P8_LOAD(0); P8_STORE(0, 0);
    __syncthreads();
    f32x4 acc = {0.f, 0.f, 0.f, 0.f};
#pragma unroll 1
    for (int kc = 0; kc < 8; ++kc) { const int buf = kc & 1;
        if (kc + 1 < 8) P8_LOAD(kc + 1);
        const LAS float* wp = WC + (buf * 128 + l4) * WCS + eg * 16 + l15;
        const LAS float* hp = HC + (buf * 64 + rgp * 16 + l15) * HCS + l4;
#pragma unroll
        for (int kk = 0; kk < 32; ++kk) acc = __builtin_amdgcn_mfma_f32_16x16x4f32(wp[4 * kk * WCS], hp[4 * kk], acc, 0, 0, 0);
        if (kc + 1 < 8) P8_STORE(kc + 1, buf ^ 1);
        __syncthreads(); }
#undef P8_LOAD
#undef P8_STORE
#pragma unroll
    for (int i = 0; i < 4; ++i) { const int e = eg * 16 + 4 * l4 + i; LOGIT[(rgp * 16 + l15) * 33 + e] = acc[i] + br_[e]; }
    __syncthreads();
    if (I_.tid < 64) { const int rr = I_.tid, m = r0 + rr;
        float lg[32];
#pragma unroll
        for (int e = 0; e < 32; ++e) lg[e] = LOGIT[rr * 33 + e];
        int te[4]; float tv[4]; unsigned used = 0u;
#pragma unroll
        for (int k = 0; k < 4; ++k) { float best = -INFINITY; int bi = 0;
#pragma unroll
            for (int e = 0; e < 32; ++e) { const bool ok = !((used >> e) & 1u) && (lg[e] > best); best = ok ? lg[e] : best; bi = ok ? e : bi; }
            used |= 1u << bi; te[k] = bi; tv[k] = best; }
        const float e0 = 1.0f, e1 = __expf(tv[1] - tv[0]), e2 = __expf(tv[2] - tv[0]), e3 = __expf(tv[3] - tv[0]); const float inv = 1.0f / (e0 + e1 + e2 + e3);
        *(i32x4*)(PAIR_E + m * 4) = (i32x4){te[0], te[1], te[2], te[3]};
        *(f32x4*)(PAIR_W + m * 4) = (f32x4){e0 * inv, e1 * inv, e2 * inv, e3 * inv};
        *(LAS i32x4*)(pe + rr * 4) = (i32x4){te[0], te[1], te[2], te[3]}; }
    __syncthreads();
    if (I_.tid < 256) { const int e = pe[I_.tid]; int rank = 0;
#pragma unroll 16
        for (int j4 = 0; j4 < 64; ++j4) { const i32x4 v = *(const LAS i32x4*)(pe + 4 * j4); const int j = 4 * j4;
            rank += ((j < I_.tid) && v.x == e) + ((j + 1 < I_.tid) && v.y == e) + ((j + 2 < I_.tid) && v.z == e) + ((j + 3 < I_.tid) && v.w == e); }
        PAIR_RANK[r0 * 4 + I_.tid] = rank; }
    else if (I_.tid < 288) { const int e = I_.tid - 256; int c = 0;
#pragma unroll 16
        for (int j4 = 0; j4 < 64; ++j4) { const i32x4 v = *(const LAS i32x4*)(pe + 4 * j4); c += (v.x == e) + (v.y == e) + (v.z == e) + (v.w == e); }
        ((int*)(ws + WS_HIST))[F.vcu * 32 + e] = c; }
    __syncthreads();
}

__device__ __forceinline__ int moe_layout(Frame& F) {
    PHASE_IDS();
    LAS int* ctl = (LAS int*)(F.lds + LDS_CTL);
    LAS int* part = ctl + 512;
    const int* HIST = (const int*)(F.ws + WS_HIST);
    __syncthreads();
    { const int e = I_.tid & 31, pt = I_.tid >> 5; int tot = 0, before = 0; int c[16];
#pragma unroll
        for (int i = 0; i < 16; ++i) c[i] = HIST[(pt * 16 + i) * 32 + e];
#pragma unroll
        for (int i = 0; i < 16; ++i) { tot += c[i]; before += (pt * 16 + i < F.vcu) ? c[i] : 0; }
        part[pt * 64 + e] = tot; part[pt * 64 + 32 + e] = before; }
    __syncthreads();
    if (I_.tid < 32) { int tot = 0, before = 0;
#pragma unroll
        for (int pt = 0; pt < 16; ++pt) { tot += part[pt * 64 + I_.tid]; before += part[pt * 64 + 32 + I_.tid]; }
        ctl[I_.tid] = tot; ctl[65 + I_.tid] = before; }
    __syncthreads();
    if (I_.tid < 32) { const int e = I_.tid; const int nt_ = (ctl[e] + 255) >> 8; int sc = nt_;
#pragma unroll
        for (int o = 1; o < 32; o <<= 1) { const int up = __shfl_up(sc, o); sc += (e >= o) ? up : 0; }
        const int t0 = sc - nt_; ctl[32 + e] = t0 * 256; ctl[65 + e] += t0 * 256;
        for (int t = 0; t < nt_; ++t) ctl[128 + t0 + t] = e;
        if (e == 31) { ctl[64] = sc * 256; ctl[100] = sc; } }
    __syncthreads();
    return ctl[100];
}

__device__ __forceinline__ void phase9(Frame& F) {
    PHASE_IDS();
    unsigned char* ws = F.ws;
    moe_layout(F);
    LAS int* ctl = (LAS int*)(F.lds + LDS_CTL);
    const int* PAIR_E = (const int*)(ws + WS_PAIR); const int* PAIR_RANK = PAIR_E + 65536; int* ROWDEST = (int*)(ws + WS_PAIR) + 196608; int* TOK = (int*)(ws + WS_TOK);
    const int rows_per_blk = NTOK / F.G;
    if (I_.tid < rows_per_blk * 4) { const int gp = F.vcu * rows_per_blk * 4 + I_.tid;
        const int e = PAIR_E[gp], rk = PAIR_RANK[gp]; const int dest = ctl[65 + e] + rk;
        ROWDEST[gp] = dest; TOK[dest] = gp >> 2; }
    if (F.vcu < 32) { const int e = F.vcu; const int lo = ctl[32 + e] + ctl[e], hi = (e == 31) ? ctl[64] : ctl[33 + e];
        for (int r = lo + I_.tid; r < hi; r += NTHREADS) TOK[r] = 0; }
}

__device__ __forceinline__ void stage_tok(Frame& F, int nmt, int ntn) {
    PHASE_IDS();
    const int* TOK = (const int*)(F.ws + WS_TOK); LAS unsigned short* tokl = (LAS unsigned short*)(F.lds + LDS_TOKL);
    for (int i = 0; i < 10; ++i) { const int j = (i * F.G + (int)blockIdx.x) >> 3; const int mt = (j / ntn) * 8 + ((int)blockIdx.x & 7); if (mt >= nmt) break;
        if (I_.tid < 256) tokl[i * 256 + I_.tid] = (unsigned short)TOK[mt * 256 + I_.tid]; }
    __syncthreads();
}

__device__ __forceinline__ void phase12(Frame& F) {
    PHASE_IDS();
    const Params& P = *F.P; unsigned char* ws = F.ws;
    const int gw = F.vcu * NWAVES + I_.wave, NGW = F.G * NWAVES;
    const float* PAIR_W = (const float*)(ws + WS_PAIR) + 131072; const int* ROWDEST = (const int*)(ws + WS_PAIR) + 196608;
    const bf16_t* YP = (const bf16_t*)(ws + WS_XG);
    const f32x4* gp = (const f32x4*)P.in[I_GPLE] + I_.lane; f32x4 gv[4];
#pragma unroll
    for (int j = 0; j < 4; ++j) gv[j] = gp[64 * j];
    for (int m0 = gw; m0 < NTOK; m0 += 2 * NGW) {
        int mm[2]; mm[0] = m0; mm[1] = (m0 + NGW < NTOK) ? m0 + NGW : m0;
        f32x4 wv[2]; i32x4 dv[2];
#pragma unroll
        for (int q = 0; q < 2; ++q) { wv[q] = *(const f32x4*)(PAIR_W + mm[q] * 4); dv[q] = *(const i32x4*)(ROWDEST + mm[q] * 4); }
        f32x4 v[2][4]; u32x2 y[2][4][4];
#pragma unroll
        for (int q = 0; q < 2; ++q) { const u32x2* xr = (const u32x2*)((const bf16_t*)(ws + WS_X1B) + (size_t)mm[q] * DM) + I_.lane;
#pragma unroll
            for (int j = 0; j < 4; ++j) { const u32x2 w_ = xr[64 * j]; v[q][j] = (f32x4){bflo(w_.x), bfhi(w_.x), bflo(w_.y), bfhi(w_.y)}; }
#pragma unroll
            for (int k = 0; k < 4; ++k) { const u32x2* yr = (const u32x2*)(YP + (size_t)dv[q][k] * DM) + I_.lane;
#pragma unroll
                for (int j = 0; j < 4; ++j) y[q][k][j] = yr[64 * j]; } }
#pragma unroll
        for (int q = 0; q < 2; ++q) { if (q == 1 && mm[1] == mm[0]) break;
            float s = 0.f; u32x2* xw = (u32x2*)((bf16_t*)(ws + WS_X1B) + (size_t)mm[q] * DM) + I_.lane;
#pragma unroll
            for (int j = 0; j < 4; ++j) {
#pragma unroll
                for (int k = 0; k < 4; ++k) { const u32x2 yy = y[q][k][j]; v[q][j] += (f32x4){bflo(yy.x), bfhi(yy.x), bflo(yy.y), bfhi(yy.y)} * wv[q][k]; }
                xw[64 * j] = (u32x2){cvt_pk_bf16(v[q][j].x, v[q][j].y), cvt_pk_bf16(v[q][j].z, v[q][j].w)}; s += (v[q][j].x * v[q][j].x + v[q][j].y * v[q][j].y) + (v[q][j].z * v[q][j].z + v[q][j].w * v[q][j].w); }
            const float rstd = 1.0f / sqrtf(wave_sum(s) * (1.f / DM) + EPS);
            unsigned* o4 = (unsigned*)(ws + WS_HNF8 + (size_t)mm[q] * DM) + I_.lane;
#pragma unroll
            for (int j = 0; j < 4; ++j) { const f32x4 yo = v[q][j] * rstd * gv[j]; o4[64 * j] = pack4_fp8(yo.x, yo.y, yo.z, yo.w); } }
    }
}

__global__ void __launch_bounds__(NTHREADS, 2) fwd(Params prm) {
    extern __shared__ __attribute__((aligned(16))) unsigned char lds_raw[];
    Frame F;
    F.lds = (LAS unsigned char*)lds_raw;
    F.wave = __builtin_amdgcn_readfirstlane((int)threadIdx.x >> 6);
    if (threadIdx.x < 2) ((volatile LAS unsigned*)(F.lds + LDS_BARST))[threadIdx.x] = 0u;
    const XcdBarrier bar = xcd_barrier_post((unsigned*)(prm.ws + WS_BAR), (volatile LAS unsigned*)(F.lds + LDS_BARST), F.wave);
    if (prm.ph_lo < 0) cg::this_grid().sync();
    __syncthreads();
    F.G = gridDim.x; { const int bx = blockIdx.x; F.vcu = (F.G % 8 == 0) ? (bx % 8) * (F.G / 8) + bx / 8 : bx; }
    F.P = &prm; F.ws = prm.ws;
    unsigned char* ws = prm.ws;
    const int lo = prm.ph_lo, hi = prm.ph_hi;
#ifndef PH_MASK
#define PH_MASK 0xffffu
#endif
#ifndef REP_MASK
#define REP_MASK 0u
#endif
#define IN(k) (((PH_MASK >> (k)) & 1u) && lo <= (k) && (k) < hi)
#define REPS(k) for (int rep_ = 0; rep_ < (((REP_MASK >> (k)) & 1u) ? 2 : 1); ++rep_, (((REP_MASK >> (k)) & 1u) && rep_ < 2 ? xcd_barrier(bar) : (void)0))
#define SEAM(k) do { __builtin_amdgcn_sched_barrier(0); asm volatile("" ::: "memory"); if (IN(k) && IN((k) + 1)) xcd_barrier(bar); STAMP((k) + 1); __builtin_amdgcn_sched_barrier(0); asm volatile("" ::: "memory"); } while (0)
    using namespace pg8;
    STAMP(0);
    if (IN(0)) REPS(0) phase0(F);
    SEAM(0);
    if (IN(1)) REPS(1) {
        { Gemm g{(const bf16_t*)(ws + WS_HNF8), (const bf16_t*)(ws + WS_WIN), 512, 512, 512}; StaticOrder S; S.init(NTOK, 2048, F.G, (int)blockIdx.x);
          const float* cosA_ = (const float*)(ws + WS_ROPE);
          EpiProj E{(bf16_t*)(ws + WS_PROJ), (bf16_t*)(ws + WS_QA2), (bf16_t*)(ws + WS_KA2), (float*)(ws + WS_KMEAN), (bf16_t*)(ws + WS_CQN), (bf16_t*)(ws + WS_CKVN),
                    prm.in[I_MQN], prm.in[I_MKN], prm.in[I_QLATN], prm.in[I_KVLATN], cosA_, cosA_ + 65536, (LAS float*)(F.lds + LDS_TOKL), (float*)(ws + WS_KPESS)};
          gemm_phase<EpiProj, StaticOrder, false, true>(F.lds, F.wave, g, S, E); }
        __builtin_amdgcn_sched_barrier(0); asm volatile("" ::: "memory");
        { Gemm g{(const bf16_t*)(ws + WS_HNF8), (const bf16_t*)(ws + WS_WINF8), 512, 512, 512}; StaticOrder S; S.init(NTOK, 2048, F.G, (int)blockIdx.x);
          EpiStore E{(bf16_t*)(ws + WS_PROJ) + PC_GA, DINP, nullptr, 0, 0}; gemm_phase<EpiStore, StaticOrder, false, true>(F.lds, F.wave, g, S, E); } }
    SEAM(1);
    if (IN(3)) REPS(3) {
        const float* cosB_ = (const float*)(ws + WS_ROPE) + 131072;
        { Gemm g{(const bf16_t*)(ws + WS_CQN), (const bf16_t*)(ws + WS_WUQ), 256, 256, 256}; StaticOrder S; S.init(NTOK, 1024, F.G, (int)blockIdx.x);
          EpiQB E{(bf16_t*)(ws + WS_QB), prm.in[I_MLAQN], cosB_, cosB_ + 32768, (LAS float*)(F.lds + LDS_CTL)}; gemm_phase(F.lds, F.wave, g, S, E); }
        __builtin_amdgcn_sched_barrier(0); asm volatile("" ::: "memory");
        { Gemm g{(const bf16_t*)(ws + WS_CKVN), (const bf16_t*)(ws + WS_WUKV), 128, 128, 128}; StaticOrder S; S.init(NTOK, 1024, F.G, (int)blockIdx.x);
          EpiKV E{(bf16_t*)(ws + WS_KB2), (bf16_t*)(ws + WS_KV), (const bf16_t*)(ws + WS_PROJ), (const float*)(ws + WS_KPESS), prm.in[I_MLAKN], cosB_, cosB_ + 32768, (LAS float*)(F.lds + LDS_CTL)};
          gemm_phase(F.lds, F.wave, g, S, E); } }
    SEAM(3);
    if (IN(5)) REPS(5) phase5(F);
    SEAM(5);
    if (IN(6)) REPS(6) { Gemm g{(const bf16_t*)(ws + WS_Y), (const bf16_t*)(ws + WS_WA), 512, 256, 256}; BranchOrder S; S.so.init(NTOK, DM, F.G, (int)blockIdx.x);
        EpiGateAB E{(bf16_t*)(ws + WS_MERGED), (const bf16_t*)(ws + WS_PROJ) + PC_GA, (const bf16_t*)(ws + WS_PROJ) + PC_GB, DINP, ws + WS_KA2  };
        gemm_phase<EpiGateAB, BranchOrder, false, true>(F.lds, F.wave, g, S, E); }
    SEAM(7);
    if (IN(8)) REPS(8) { Gemm g{(const bf16_t*)(ws + WS_KA2), (const bf16_t*)(ws + WS_WO), 512, 512, 512}; StaticOrder S; S.init(NTOK, DM, F.G, (int)blockIdx.x);
        EpiResF32 E{prm.in[I_X], (bf16_t*)(ws + WS_X1B), (float*)(ws + WS_SSP)}; gemm_phase<EpiResF32, StaticOrder, false, true>(F.lds, F.wave, g, S, E); }
    SEAM(8);
    if (IN(9)) REPS(9) phase8(F);
    SEAM(9);
    if (IN(10)) REPS(10) phase9(F);
    SEAM(10);
    if (IN(11)) REPS(11) { const int nmt = ((const LAS int*)(F.lds + LDS_CTL))[100]; stage_tok(F, nmt, 8);
        Gemm g{(const bf16_t*)(ws + WS_HNF8), (const bf16_t*)(ws + WS_W1), 512, 512, 512}; MoeOrder S{(const LAS int*)(F.lds + LDS_CTL) + 128, nmt, 8, F.G, (int)blockIdx.x};
        EpiSwiglu E{ws + WS_ACT, prm.in[I_BGU]}; gemm_phase<EpiSwiglu, MoeOrder, true, true>(F.lds, F.wave, g, S, E, (const LAS unsigned short*)(F.lds + LDS_TOKL)); }
    SEAM(11);
    if (IN(12)) REPS(12) { const int nmt = ((const LAS int*)(F.lds + LDS_CTL))[100];
        Gemm g{(const bf16_t*)(ws + WS_ACT), (const bf16_t*)(ws + WS_W2), 512, 512, 512}; MoeOrder S{(const LAS int*)(F.lds + LDS_CTL) + 128, nmt, 4, F.G, (int)blockIdx.x};
        EpiStore E{(bf16_t*)(ws + WS_XG), DM, prm.in[I_BD], 1024, 1 << 30}; gemm_phase<EpiStore, MoeOrder, false, true>(F.lds, F.wave, g, S, E); }
    SEAM(12);
    if (IN(13)) REPS(13) phase12(F);
    SEAM(13);
    if (IN(14)) REPS(14) { Gemm g{(const bf16_t*)(ws + WS_PB), (const bf16_t*)(ws + WS_WPP), 256, 256, 256}; StaticOrder S; S.init(NTOK, DM, F.G, (int)blockIdx.x);
        EpiStore E{(bf16_t*)(ws + WS_PP), DM, nullptr, 0, 1 << 30}; gemm_phase(F.lds, F.wave, g, S, E); }
    __builtin_amdgcn_sched_barrier(0); asm volatile("s_waitcnt vmcnt(0)" ::: "memory"); __syncthreads();
    if (IN(15)) REPS(15) { Gemm g{(const bf16_t*)(ws + WS_HNF8), (const bf16_t*)(ws + WS_WPG), 512, 512, 512}; StaticOrder S; S.init(NTOK, DM, F.G, (int)blockIdx.x);
        EpiFinal E{prm.out, (const bf16_t*)(ws + WS_PP), (const bf16_t*)(ws + WS_X1B)}; gemm_phase<EpiFinal, StaticOrder, false, true>(F.lds, F.wave, g, S, E); }
#ifdef TPROBE_A
    STAMP(16);
    xcd_barrier(bar);
    if (blockIdx.x == 0 && F.wave == 0 && lane_id() == 0) {
        volatile unsigned long long* ts = (volatile unsigned long long*)(ws + WS_ERR);
        const unsigned long long da = ts[TPROBE_A1] - ts[TPROBE_A], db = ts[TPROBE_B1] - ts[TPROBE_B];
        asm volatile("s_waitcnt vmcnt(0)" ::: "memory");
        prm.out[0] += (float)db * (0.01f / 4.0f);
        const unsigned long long t0 = __builtin_amdgcn_s_memrealtime();
        while (__builtin_amdgcn_s_memrealtime() - t0 < 4ull * da) __builtin_amdgcn_s_sleep(4);
    }
#endif
#undef IN
#undef SEAM
}

extern "C" void kernel_launch(void* const* d_in, const int* in_sizes, int n_in, void* d_out, int out_size, void* d_ws, size_t ws_size, hipStream_t stream) {
    static int grid = 0;
    if (grid == 0) {
        int dev = 0, cus = 0, per_cu = 0;
        (void)hipGetDevice(&dev);
        (void)hipDeviceGetAttribute(&cus, hipDeviceAttributeMultiprocessorCount, dev);
        (void)hipFuncSetAttribute((const void*)fwd, hipFuncAttributeMaxDynamicSharedMemorySize, LDS_BYTES);
        (void)hipOccupancyMaxActiveBlocksPerMultiprocessor(&per_cu, (const void*)fwd, NTHREADS, LDS_BYTES);
        fprintf(stderr, "cus %d per_cu %d ws %zu n_in %d\n", cus, per_cu, ws_size, n_in);
        grid = (per_cu >= 1) ? cus : -1;
        if (grid != 256 || n_in != 25 || ws_size < WS_END || out_size != NTOK * DM) { fprintf(stderr, "kernel_launch: unsupported configuration\n"); grid = -1; }
    }
    if (grid < 0) return;
    (void)hipMemsetAsync((char*)d_ws + WS_BAR, 0, WS_BAR_BYTES, stream);
    Params a{};
    for (int i = 0; i < 25; ++i) a.in[i] = (const float*)d_in[i];
    a.out = (float*)d_out; a.ws = (unsigned char*)d_ws;
#ifndef MULTI_LAUNCH
    a.ph_lo = 0; a.ph_hi = NPHASE;
    void* args[] = {&a};
    hipError_t e = hipLaunchCooperativeKernel((const void*)fwd, dim3(grid), dim3(NTHREADS), args, LDS_BYTES, stream);
    if (e != hipSuccess) fprintf(stderr, "cooperative launch failed: %s\n", hipGetErrorString(e));
#else
    for (int k = 0; k < NPHASE; ++k) { a.ph_lo = k; a.ph_hi = k + 1; void* args[] = {&a};
        hipError_t e = hipLaunchCooperativeKernel((const void*)fwd, dim3(grid), dim3(NTHREADS), args, LDS_BYTES, stream);
        if (e != hipSuccess) fprintf(stderr, "launch %d failed: %s\n", k, hipGetErrorString(e)); }
#endif
}
```

```cpp
#include <hip/hip_runtime.h>
#include <hip/hip_cooperative_groups.h>
#include <cstdio>
#include <cstdint>
namespace cg = cooperative_groups;

#define LAS __attribute__((address_space(3)))
typedef unsigned short bf16_t;
typedef short bf16x8 __attribute__((ext_vector_type(8)));
typedef short s16x4 __attribute__((ext_vector_type(4)));
typedef float f32x4 __attribute__((ext_vector_type(4)));
typedef float f32x2 __attribute__((ext_vector_type(2)));
typedef float f32x16 __attribute__((ext_vector_type(16)));
typedef unsigned u32x4 __attribute__((ext_vector_type(4)));
typedef unsigned u32x2 __attribute__((ext_vector_type(2)));
typedef int i32x4 __attribute__((ext_vector_type(4)));
typedef int i32x8 __attribute__((ext_vector_type(8)));
typedef __bf16 bf16x2_t __attribute__((ext_vector_type(2)));

constexpr int NB = 8, SEQ = 2048, NTOK = NB * SEQ, DM = 1024;
constexpr int DIN = 4000, DINP = 4096;
constexpr int NEXP = 32, TOPK = 4, DEXP = 1024;
constexpr int NTHREADS = 512, NWAVES = 8;
constexpr float EPS = 1e-6f;
constexpr float LOG2E = 1.4426950408889634f;
constexpr float C2A = 0.125f * LOG2E;
constexpr float C2B = 0.10206207261596575f * LOG2E;
constexpr int PC_QA = 0, PC_KA = 512, PC_VA = 1024, PC_CQ = 1536, PC_CKV = 1792, PC_KPE = 1920, PC_GA = 2048, PC_GB = 3072;

constexpr size_t MiB = 1u << 20;
constexpr size_t WS_HIST = 0;
constexpr size_t WS_ERR = 64 * 1024;
constexpr size_t WS_BAR = 128 * 1024;
constexpr size_t WS_BAR_BYTES = 16 * 1024;
constexpr size_t WS_KPESS = 576 * 1024;
constexpr size_t WS_TOK = 256 * 1024;
constexpr size_t WS_ROPE = 1 * MiB;
constexpr size_t WS_KMEAN = 2 * MiB;
constexpr size_t WS_SSP = 11 * MiB;
constexpr size_t WS_PAIR = 3 * MiB;
constexpr size_t WS_WUQ = 4 * MiB, WS_WUKV = 4 * MiB + 512 * 1024, WS_WPP = 5 * MiB, WS_WA = 6 * MiB, WS_WB = 7 * MiB, WS_WO = 8 * MiB, WS_WPG = 10 * MiB, WS_WIN = 12 * MiB;
constexpr size_t WS_W1 = 20 * MiB, WS_W2 = 148 * MiB;
constexpr size_t WS_WINF8 = 16 * MiB;
constexpr size_t WS_HNF8 = 84 * MiB;
constexpr size_t WS_HN = 212 * MiB, WS_PB = 244 * MiB;
constexpr size_t WS_X1B = WS_HN;
constexpr size_t WS_CQN = 252 * MiB, WS_CKVN = 260 * MiB, WS_QB = 264 * MiB, WS_KV = 288 * MiB, WS_KB2 = 320 * MiB, WS_Y = 344 * MiB, WS_MERGED = 376 * MiB;
constexpr size_t WS_ACT = 252 * MiB;
constexpr size_t WS_PP = 400 * MiB;
constexpr size_t WS_KA2 = 432 * MiB;
constexpr size_t WS_PROJ = 448 * MiB;
constexpr size_t WS_QA2 = 576 * MiB;
constexpr size_t WS_XG = 448 * MiB;
constexpr size_t WS_END = 592 * MiB;
constexpr int MAXROWS = 73728, MAXMT = 288;

constexpr int RING_BYTES = 131072;
constexpr int LDS_CTL = RING_BYTES;
constexpr int LDS_TOKL = RING_BYTES + 8192 + 256;
constexpr int LDS_BARST = RING_BYTES + 8192;
constexpr int LDS_BYTES = 147456;

__device__ __forceinline__ unsigned cvt_pk_bf16(float lo, float hi) { f32x2 v = {lo, hi}; bf16x2_t b = __builtin_convertvector(v, bf16x2_t); return __builtin_bit_cast(unsigned, b); }
__device__ __forceinline__ unsigned pack4_fp8(float a, float b, float c, float d) { int w = 0; w = __builtin_amdgcn_cvt_pk_fp8_f32(a, b, w, false); w = __builtin_amdgcn_cvt_pk_fp8_f32(c, d, w, true); return (unsigned)w; }
__device__ __forceinline__ float bf2f(unsigned short b) { return __uint_as_float(((unsigned)b) << 16); }
__device__ __forceinline__ float bflo(unsigned w) { return __uint_as_float(w << 16); }
__device__ __forceinline__ float bfhi(unsigned w) { return __uint_as_float(w & 0xffff0000u); }
__device__ __forceinline__ float sigmoidf_(float x) { return __builtin_amdgcn_rcpf(1.0f + __builtin_amdgcn_exp2f(-x * LOG2E)); }
__device__ __forceinline__ int lane_id() { return (int)__builtin_amdgcn_mbcnt_hi(~0u, __builtin_amdgcn_mbcnt_lo(~0u, 0u)); }
__device__ __forceinline__ float wave_sum(float v) {
#pragma unroll
    for (int o = 1; o < 64; o <<= 1) v += __shfl_xor(v, o);
    return v;
}

namespace pg8 {
constexpr int BM = 256, BK = 64, HALF = 128, HTB = HALF * BK * 2, STAGE_BYTES = 8 * HTB, NXCD = 8, WGM = 8;
__host__ __device__ __forceinline__ int lds_byte(int r, int c) { const int st = (r >> 4) * 2 + (c >> 5), rr = r & 15, cc = c & 31, ob = rr * 64 + cc * 2; return st * 1024 + (ob ^ (((ob >> 9) & 1) << 5)); }
__host__ __device__ __forceinline__ void stage_rc(int b, int& R, int& C) { const int st = b / 1024, sb = b % 1024, swz = sb ^ (((sb >> 9) & 1) << 5); R = (st >> 1) * 16 + swz / 64; C = (st & 1) * 32 + (swz % 64) / 2; }
__host__ __device__ __forceinline__ int perm32(int rho) { const int n = rho >> 4, i = rho & 15; return 8 * (i >> 2) + 4 * n + (i & 3); }

struct Unit { int pm, pn, pb, e; int aofs = 0; };
struct Gemm { const bf16_t* A; const bf16_t* Bt; int lda, ldb, K; };

struct StaticOrder {
    int nM, nN, nwg, G, c;
    __device__ void init(int M, int N, int G_, int c_) { nM = M / BM; nN = N / BM; nwg = nM * nN; G = G_; c = c_; }
    __device__ bool next(int i, Unit& u) const {
        const long L = (long)i * G + c; if (L >= nwg) return false;
        int wgid = (int)L; { const int q = nwg / NXCD, r = nwg % NXCD, xcd = wgid % NXCD, off = wgid / NXCD; wgid = (xcd < r ? xcd * (q + 1) : r * (q + 1) + (xcd - r) * q) + off; }
        const int nig = WGM * nN, gid = wgid / nig, fm = gid * WGM, gsz = (nM - fm) < WGM ? (nM - fm) : WGM;
        u.pm = fm + ((wgid % nig) % gsz); u.pn = (wgid % nig) / gsz; u.pb = u.pn; u.e = 0; return true;
    }
};
struct MoeOrder {
    const LAS int* tile_e; int nmt, ntn, G, c;
    __device__ bool next(int i, Unit& u) const {
        const int j = (i * G + c) >> 3; const int mt = (j / ntn) * 8 + (c & 7), pn = j % ntn; if (mt >= nmt) return false;
        const int e = __builtin_amdgcn_readfirstlane(tile_e[mt]);
        u.pm = mt; u.pn = pn; u.pb = e * ntn + pn; u.e = e; return true;
    }
};

template <class Epi, class Sched, bool GATHER = false, bool FP8 = false>
__device__ __forceinline__ void gemm_phase(LAS unsigned char* lds, int wave, const Gemm g, const Sched& S, const Epi& E, const LAS unsigned short* tokl = nullptr) {
    constexpr bool ALIGN_EPI = true;
    int lane = lane_id(); asm volatile("" : "+v"(lane));
    const int wid = wave, tid = wid * 64 + lane, wr = wid >> 2, wc = wid & 3, fr = lane & 15, fq = lane >> 4;
    int K = g.K; asm volatile("" : "+s"(K));
    const int nt = K / BK;
    unsigned voffA[2], voffB[2]; int gR[2]; unsigned gC[2];
#pragma unroll
    for (int i = 0; i < 2; ++i) { int R, C; stage_rc(tid * 16 + i * 8192, R, C); const int Rb = (R & ~31) + perm32(R & 31);
        voffA[i] = (unsigned)(R * g.lda + C) * 2u; voffB[i] = (unsigned)(Rb * g.ldb + C) * 2u; gR[i] = R; gC[i] = (unsigned)C * 2u; }
    unsigned goff[2][2], noff[2][2];
#define PG8_GOFF(dst, ui_) do { _Pragma("unroll") for (int h_ = 0; h_ < 2; ++h_) _Pragma("unroll") for (int i_ = 0; i_ < 2; ++i_) \
        dst[h_][i_] = (unsigned)tokl[(ui_) * 256 + h_ * HALF + gR[i_]] * (unsigned)(g.lda * 2) + gC[i_]; } while (0)
    const size_t kstep = (size_t)(BK * 2);
    const size_t hstepA = (size_t)HALF * g.lda * 2, hstepB = (size_t)HALF * g.ldb * 2;
    const size_t tstepA = 2 * hstepA, tstepB = 2 * hstepB;
    const unsigned ldsw = (unsigned)wid * 1024u;
    const int aoff = lds_byte(wr * 64 + fr, fq * 8), boff = lds_byte(wc * 32 + fr, fq * 8);
#define PG8_SA(b, h) (((b) * 2 + (h)) * HTB)
#define PG8_SB(b, h) ((4 + (b) * 2 + (h)) * HTB)
#define PG8_STAGE(bufoff, gbase, voff) do { _Pragma("unroll") for (int _i = 0; _i < 2; ++_i) \
        __builtin_amdgcn_global_load_lds((const unsigned*)((const char*)(gbase) + (voff)[_i]), (LAS unsigned*)(lds + (bufoff) + ldsw + _i * 8192), 16, 0, 0); } while (0)
#define PG8_STAGE_A(bufoff, ptr_ng, k_g, off_g) do { if constexpr (GATHER) { const char* gb_ = (const char*)g.A + (size_t)(k_g) * kstep; PG8_STAGE(bufoff, gb_, off_g); } else { PG8_STAGE(bufoff, ptr_ng, voffA); } } while (0)
#define PG8_LDA(dst, b, h) do { if constexpr (FP8) { _Pragma("unroll") for (int m = 0; m < 4; ++m) { const i32x4 lo_ = *(const LAS i32x4*)(lds + PG8_SA(b, h) + aoff + m * 2048), hi_ = *(const LAS i32x4*)(lds + PG8_SA(b, h) + aoff + m * 2048 + 1024); dst##8[m] = __builtin_shufflevector(lo_, hi_, 0, 1, 2, 3, 4, 5, 6, 7); } } \
        else { _Pragma("unroll") for (int m = 0; m < 4; ++m) _Pragma("unroll") for (int k = 0; k < 2; ++k) dst[m][k] = *(const LAS bf16x8*)(lds + PG8_SA(b, h) + aoff + m * 2048 + k * 1024); } } while (0)
#define PG8_LDB(dst, b, h) do { if constexpr (FP8) { _Pragma("unroll") for (int n = 0; n < 2; ++n) { const i32x4 lo_ = *(const LAS i32x4*)(lds + PG8_SB(b, h) + boff + n * 2048), hi_ = *(const LAS i32x4*)(lds + PG8_SB(b, h) + boff + n * 2048 + 1024); dst##8[n] = __builtin_shufflevector(lo_, hi_, 0, 1, 2, 3, 4, 5, 6, 7); } } \
        else { _Pragma("unroll") for (int n = 0; n < 2; ++n) _Pragma("unroll") for (int k = 0; k < 2; ++k) dst[n][k] = *(const LAS bf16x8*)(lds + PG8_SB(b, h) + boff + n * 2048 + k * 1024); } } while (0)
#define PG8_CAT8(x, y) __builtin_shufflevector(__builtin_bit_cast(i32x4, x), __builtin_bit_cast(i32x4, y), 0, 1, 2, 3, 4, 5, 6, 7)
#define PG8_MMA(ai, bj, At, Bt) do { __builtin_amdgcn_s_setprio(1); if constexpr (FP8) { _Pragma("unroll") for (int m = 0; m < 4; ++m) _Pragma("unroll") for (int n = 0; n < 2; ++n) \
        asm volatile("v_mfma_scale_f32_16x16x128_f8f6f4 %0, %1, %2, %0, %3, %3 op_sel_hi:[0,0,0]" : "+v"(acc[ai][bj][m][n]) : "v"(Bt##8[n]), "v"(At##8[m]), "v"(sc8)); } \
        else { _Pragma("unroll") for (int m = 0; m < 4; ++m) _Pragma("unroll") for (int n = 0; n < 2; ++n) _Pragma("unroll") for (int k = 0; k < 2; ++k) \
        acc[ai][bj][m][n] = __builtin_amdgcn_mfma_f32_16x16x32_bf16(Bt[n][k], At[m][k], acc[ai][bj][m][n], 0, 0, 0); } __builtin_amdgcn_s_setprio(0); } while (0)
#define PG8_WAIT_V(n) asm volatile("s_waitcnt vmcnt(" #n ")" ::: "memory")
#define PG8_WAIT_L(n) asm volatile("s_waitcnt lgkmcnt(" #n ")" ::: "memory")
#define PG8_BAR __builtin_amdgcn_s_barrier()
#define PG8_SCHED __builtin_amdgcn_sched_barrier(0)
    Unit cur, nxt; int ui = 0;
    if (!S.next(0, cur)) return;
    f32x4 acc[2][2][4][2];
#pragma unroll
    for (int a = 0; a < 2; ++a)
#pragma unroll
        for (int b = 0; b < 2; ++b)
#pragma unroll
            for (int m = 0; m < 4; ++m)
#pragma unroll
                for (int n = 0; n < 2; ++n) acc[a][b][m][n] = (f32x4){0.f, 0.f, 0.f, 0.f};
    const int sc8 = 0x7c7c7c7c;
    bf16x8 At[4][2], B0[2][2], B1[2][2]; i32x8 At8[4], B08[2], B18[2];
    const char* cA = (const char*)g.A + (size_t)cur.pm * tstepA + cur.aofs; const char* cB = (const char*)g.Bt + (size_t)cur.pb * tstepB;
    if constexpr (GATHER) { PG8_GOFF(goff, 0); }
    PG8_STAGE(PG8_SB(0, 0), cB, voffB); PG8_STAGE(PG8_SB(0, 1), cB + hstepB, voffB); PG8_STAGE_A(PG8_SA(0, 0), cA, 0, goff[0]); PG8_STAGE_A(PG8_SA(0, 1), cA + hstepA, 0, goff[1]);
    if (wr == 1) PG8_BAR;
    PG8_WAIT_V(2); PG8_BAR;
    PG8_STAGE(PG8_SB(1, 0), cB + kstep, voffB); PG8_STAGE_A(PG8_SA(1, 0), cA + kstep, 1, goff[0]); PG8_STAGE(PG8_SB(1, 1), cB + hstepB + kstep, voffB);
    PG8_WAIT_V(6); PG8_BAR;
    for (;;) {
        const bool has_next = S.next(ui + 1, nxt);
        const char* nA = has_next ? (const char*)g.A + (size_t)nxt.pm * tstepA + nxt.aofs : cA; const char* nB = has_next ? (const char*)g.Bt + (size_t)nxt.pb * tstepB : cB;
        if constexpr (GATHER) { if (has_next) { PG8_GOFF(noff, ui + 1); } else {
#pragma unroll
            for (int h_ = 0; h_ < 2; ++h_)
#pragma unroll
                for (int i_ = 0; i_ < 2; ++i_) noff[h_][i_] = goff[h_][i_]; } }
        for (int t = 0; t < nt; t += 2) {
            const bool last = (t == nt - 2);
            const char* a1 = cA + (size_t)(t + 1) * kstep;
            const char* a2 = last ? nA : cA + (size_t)(t + 2) * kstep; const char* b2 = last ? nB : cB + (size_t)(t + 2) * kstep;
            const char* a3 = a2 + kstep; const char* b3 = b2 + kstep;
            const int k2 = last ? 0 : t + 2;
            unsigned soff[2][2];
            if constexpr (GATHER) {
#pragma unroll
                for (int h_ = 0; h_ < 2; ++h_)
#pragma unroll
                    for (int i_ = 0; i_ < 2; ++i_) soff[h_][i_] = last ? noff[h_][i_] : goff[h_][i_]; }
            PG8_LDB(B0, 0, 0); PG8_LDB(B1, 0, 1); PG8_SCHED; PG8_LDA(At, 0, 0); PG8_STAGE_A(PG8_SA(1, 1), a1 + hstepA, t + 1, goff[1]);
            PG8_WAIT_V(8); PG8_WAIT_L(0); PG8_BAR; PG8_MMA(0, 0, At, B0); PG8_MMA(0, 1, At, B1); PG8_BAR; PG8_SCHED;
            PG8_LDA(At, 0, 1); PG8_STAGE(PG8_SB(0, 0), b2, voffB); PG8_STAGE(PG8_SB(0, 1), b2 + hstepB, voffB); PG8_STAGE_A(PG8_SA(0, 0), a2, k2, soff[0]);
            PG8_WAIT_V(8); PG8_WAIT_L(0); PG8_BAR; PG8_MMA(1, 0, At, B0); PG8_MMA(1, 1, At, B1); PG8_BAR; PG8_SCHED;
            PG8_LDB(B0, 1, 0); PG8_LDB(B1, 1, 1); PG8_SCHED; PG8_LDA(At, 1, 0); PG8_STAGE_A(PG8_SA(0, 1), a2 + hstepA, k2, soff[1]);
            PG8_WAIT_V(8); PG8_WAIT_L(0); PG8_BAR; PG8_MMA(0, 0, At, B0); PG8_MMA(0, 1, At, B1); PG8_BAR; PG8_SCHED;
            PG8_LDA(At, 1, 1); PG8_STAGE(PG8_SB(1, 0), b3, voffB); PG8_STAGE(PG8_SB(1, 1), b3 + hstepB, voffB); PG8_STAGE_A(PG8_SA(1, 0), a3, k2 + 1, soff[0]);
            PG8_WAIT_V(8); PG8_WAIT_L(0); PG8_BAR; PG8_MMA(1, 0, At, B0); PG8_MMA(1, 1, At, B1); PG8_BAR; PG8_SCHED;
        }
        if constexpr (ALIGN_EPI) { if (wr == 0) PG8_BAR; }
        if constexpr (FP8) asm volatile("s_nop 15\n\ts_nop 15" ::: "memory");
        E(acc, cur, wr, wc, fr, fq);
        if (!has_next) break;
#pragma unroll
        for (int a = 0; a < 2; ++a)
#pragma unroll
            for (int b = 0; b < 2; ++b)
#pragma unroll
                for (int m = 0; m < 4; ++m)
#pragma unroll
                    for (int n = 0; n < 2; ++n) acc[a][b][m][n] = (f32x4){0.f, 0.f, 0.f, 0.f};
        cur = nxt; cA = nA; cB = nB; ++ui;
        if constexpr (GATHER) {
#pragma unroll
            for (int h_ = 0; h_ < 2; ++h_)
#pragma unroll
                for (int i_ = 0; i_ < 2; ++i_) goff[h_][i_] = noff[h_][i_]; }
        if constexpr (ALIGN_EPI) { if (wr == 1) PG8_BAR; }
    }
    PG8_WAIT_V(0);
    if constexpr (!ALIGN_EPI) { if (wr == 0) PG8_BAR; }
    PG8_BAR;
#undef PG8_SA
#undef PG8_SB
#undef PG8_STAGE
#undef PG8_STAGE_A
#undef PG8_GOFF
#undef PG8_LDA
#undef PG8_LDB
#undef PG8_MMA
#undef PG8_CAT8
#undef PG8_WAIT_V
#undef PG8_WAIT_L
#undef PG8_BAR
#undef PG8_SCHED
}

#define EPI_ARGS const f32x4 (&acc)[2][2][4][2], const Unit& u, int wr, int wc, int fr, int fq
__device__ __forceinline__ u32x4 pack8(f32x4 v0, f32x4 v1) { u32x4 w; w.x = cvt_pk_bf16(v0[0], v0[1]); w.y = cvt_pk_bf16(v0[2], v0[3]); w.z = cvt_pk_bf16(v1[0], v1[1]); w.w = cvt_pk_bf16(v1[2], v1[3]); return w; }
__device__ __forceinline__ void unpack8(u32x4 w, f32x4& v0, f32x4& v1) { v0 = (f32x4){bflo(w.x), bfhi(w.x), bflo(w.y), bfhi(w.y)}; v1 = (f32x4){bflo(w.z), bfhi(w.z), bflo(w.w), bfhi(w.w)}; }
__device__ __forceinline__ f32x4 sig4(f32x4 v) { const f32x4 a = v * (-LOG2E); const f32x4 d = (f32x4){__builtin_amdgcn_exp2f(a[0]), __builtin_amdgcn_exp2f(a[1]), __builtin_amdgcn_exp2f(a[2]), __builtin_amdgcn_exp2f(a[3])} + 1.0f;
    return (f32x4){__builtin_amdgcn_rcpf(d[0]), __builtin_amdgcn_rcpf(d[1]), __builtin_amdgcn_rcpf(d[2]), __builtin_amdgcn_rcpf(d[3])}; }

struct EpiStore {
    bf16_t* O; int ldc; const float* bias; int bias_stride; int sig_from;
    __device__ __forceinline__ void operator()(EPI_ARGS) const {
        const int row0 = u.pm * BM + wr * 64 + fr, col0 = u.pn * BM + wc * 32 + 8 * fq;
        const bool sg = u.pn >= sig_from;
        f32x4 bv[2][2];
#pragma unroll
        for (int bj = 0; bj < 2; ++bj)
#pragma unroll
            for (int n = 0; n < 2; ++n) bv[bj][n] = bias ? *(const f32x4*)(bias + (size_t)u.e * bias_stride + col0 + bj * HALF + 4 * n) : (f32x4){0.f, 0.f, 0.f, 0.f};
#pragma unroll
        for (int ai = 0; ai < 2; ++ai)
#pragma unroll
            for (int m = 0; m < 4; ++m) { bf16_t* rowp = O + (size_t)(row0 + ai * HALF + m * 16) * ldc + col0;
#pragma unroll
                for (int bj = 0; bj < 2; ++bj) { f32x4 v0 = acc[ai][bj][m][0] + bv[bj][0], v1 = acc[ai][bj][m][1] + bv[bj][1];
                    if (sg) { v0 = sig4(v0); v1 = sig4(v1); }
                    *(u32x4*)(rowp + bj * HALF) = pack8(v0, v1); } }
    }
};

struct EpiProj {
    bf16_t* PROJ; bf16_t* QA2; bf16_t* KA2; float* KMEAN; bf16_t* CQN; bf16_t* CKVN;
    const float* gq; const float* gk; const float* glq; const float* glkv; const float* cosA; const float* sinA; LAS float* xch;
    float* KPESS;
    __device__ __forceinline__ void operator()(EPI_ARGS) const {
        const int row0 = u.pm * BM + wr * 64 + fr, col0 = u.pn * BM + wc * 32 + 8 * fq;
        if (u.pn < 4) {
            const bool isk = u.pn >= 2; const int h = 4 * (u.pn & 1) + wc; const float* gn = isk ? gk : gq; const float sc = isk ? 1.0f : C2A;
            const f32x4 g1a = *(const f32x4*)(gn + 8 * fq), g1b = *(const f32x4*)(gn + 8 * fq + 4), g2a = *(const f32x4*)(gn + 32 + 8 * fq), g2b = *(const f32x4*)(gn + 36 + 8 * fq);
            bf16_t* dst = isk ? KA2 : QA2;
            const f32x4 ifa = *(const f32x4*)(cosA + 196608 + 8 * fq), ifb = *(const f32x4*)(cosA + 196608 + 8 * fq + 4);
            f32x4 ks1a = {0.f, 0.f, 0.f, 0.f}, ks1b = ks1a, ks2a = ks1a, ks2b = ks1a;
#pragma unroll
            for (int ai = 0; ai < 2; ++ai)
#pragma unroll
                for (int m = 0; m < 4; ++m) { const int row = row0 + ai * HALF + m * 16; const int pos = row & (SEQ - 1);
                    f32x4 x1a = acc[ai][0][m][0], x1b = acc[ai][0][m][1], x2a = acc[ai][1][m][0], x2b = acc[ai][1][m][1];
                    float ss = (x1a[0] * x1a[0] + x1a[1] * x1a[1]) + (x1a[2] * x1a[2] + x1a[3] * x1a[3]) + (x1b[0] * x1b[0] + x1b[1] * x1b[1]) + (x1b[2] * x1b[2] + x1b[3] * x1b[3])
                             + (x2a[0] * x2a[0] + x2a[1] * x2a[1]) + (x2a[2] * x2a[2] + x2a[3] * x2a[3]) + (x2b[0] * x2b[0] + x2b[1] * x2b[1]) + (x2b[2] * x2b[2] + x2b[3] * x2b[3]);
                    ss += __shfl_xor(ss, 16); ss += __shfl_xor(ss, 32);
                    const float rstd = 1.0f / sqrtf(ss * (1.f / 64.f) + EPS);
                    x1a = x1a * g1a * rstd; x1b = x1b * g1b * rstd; x2a = x2a * g2a * rstd; x2b = x2b * g2b * rstd;
                    f32x4 ca, cb, sa, sb; { const float fp_ = (float)pos;
#pragma unroll
                        for (int i = 0; i < 4; ++i) { const float ra = __builtin_amdgcn_fractf(fp_ * ifa[i]), rb = __builtin_amdgcn_fractf(fp_ * ifb[i]);
                            ca[i] = __builtin_amdgcn_cosf(ra); sa[i] = __builtin_amdgcn_sinf(ra); cb[i] = __builtin_amdgcn_cosf(rb); sb[i] = __builtin_amdgcn_sinf(rb); } }
                    const f32x4 y1a = x1a * ca - x2a * sa, y1b = x1b * cb - x2b * sb, y2a = x2a * ca + x1a * sa, y2b = x2b * cb + x1b * sb;
                    bf16_t* rp = dst + (size_t)row * 512 + h * 64 + 8 * fq;
                    *(u32x4*)rp = pack8(y1a * sc, y1b * sc); *(u32x4*)(rp + 32) = pack8(y2a * sc, y2b * sc);
                    ks1a += y1a; ks1b += y1b; ks2a += y2a; ks2b += y2b; }
            if (isk) {
#pragma unroll
                for (int o = 1; o < 16; o <<= 1) {
#pragma unroll
                    for (int i = 0; i < 4; ++i) { ks1a[i] += __shfl_xor(ks1a[i], o); ks1b[i] += __shfl_xor(ks1b[i], o); ks2a[i] += __shfl_xor(ks2a[i], o); ks2b[i] += __shfl_xor(ks2b[i], o); } }
                if (fr == 0) { float* km = KMEAN + (((size_t)(u.pm >> 3) * 8 + h) * 8 + (u.pm & 7)) * 64 + 8 * fq;
#pragma unroll
                    for (int i = 0; i < 4; ++i) { atomicAdd(km + i, ks1a[i] * (1.f / 256.f)); atomicAdd(km + 4 + i, ks1b[i] * (1.f / 256.f)); atomicAdd(km + 32 + i, ks2a[i] * (1.f / 256.f)); atomicAdd(km + 36 + i, ks2b[i] * (1.f / 256.f)); } } }
        } else if (u.pn == 6 || u.pn == 7) {
            const bool isq = u.pn == 6;
            float ssr[2][4];
#pragma unroll
            for (int ai = 0; ai < 2; ++ai)
#pragma unroll
                for (int m = 0; m < 4; ++m) { float ss = 0.f;
#pragma unroll
                    for (int bj = 0; bj < 2; ++bj) { if (bj == 1 && !isq) continue;
#pragma unroll
                        for (int n = 0; n < 2; ++n) { const f32x4 x = acc[ai][bj][m][n]; ss += (x[0] * x[0] + x[1] * x[1]) + (x[2] * x[2] + x[3] * x[3]); } }
                    ss += __shfl_xor(ss, 16); ss += __shfl_xor(ss, 32);
                    if (fq == 0) xch[(ai * HALF + wr * 64 + m * 16 + fr) * 4 + wc] = ss; }
            asm volatile("s_waitcnt lgkmcnt(0)" ::: "memory"); __builtin_amdgcn_s_barrier(); asm volatile("" ::: "memory");
#pragma unroll
            for (int ai = 0; ai < 2; ++ai)
#pragma unroll
                for (int m = 0; m < 4; ++m) { const f32x4 p4 = *(const LAS f32x4*)(xch + (ai * HALF + wr * 64 + m * 16 + fr) * 4); ssr[ai][m] = (p4[0] + p4[1]) + (p4[2] + p4[3]); }
            asm volatile("s_waitcnt lgkmcnt(0)" ::: "memory"); __builtin_amdgcn_s_barrier(); asm volatile("" ::: "memory");
            const float invn = isq ? (1.f / 256.f) : (1.f / 128.f); const float* gl = isq ? glq : glkv; bf16_t* dn = isq ? CQN : CKVN; const int ldn = isq ? 256 : 128;
            const int c0 = wc * 32 + 8 * fq;
#pragma unroll
            for (int bj = 0; bj < 2; ++bj) {
                if (bj == 1 && !isq) {
#pragma unroll
                    for (int ai = 0; ai < 2; ++ai)
#pragma unroll
                        for (int m = 0; m < 4; ++m) { const f32x4 x0 = acc[ai][1][m][0], x1 = acc[ai][1][m][1];
                            *(u32x4*)(PROJ + (size_t)(row0 + ai * HALF + m * 16) * DINP + col0 + HALF) = pack8(x0, x1);
                            float ss = (x0[0] * x0[0] + x0[1] * x0[1]) + (x0[2] * x0[2] + x0[3] * x0[3]) + (x1[0] * x1[0] + x1[1] * x1[1]) + (x1[2] * x1[2] + x1[3] * x1[3]);
                            ss += __shfl_xor(ss, 16); ss += __shfl_xor(ss, 32);
                            if (wc == 0 && fq == 0) KPESS[row0 + ai * HALF + m * 16] = ss; }
                    continue; }
                const f32x4 ga = *(const f32x4*)(gl + bj * HALF + c0), gb = *(const f32x4*)(gl + bj * HALF + c0 + 4);
#pragma unroll
                for (int ai = 0; ai < 2; ++ai)
#pragma unroll
                    for (int m = 0; m < 4; ++m) { const float rstd = 1.0f / sqrtf(ssr[ai][m] * invn + EPS);
                        *(u32x4*)(dn + (size_t)(row0 + ai * HALF + m * 16) * ldn + bj * HALF + c0) = pack8(acc[ai][bj][m][0] * ga * rstd, acc[ai][bj][m][1] * gb * rstd); } }
        } else {
            const bool sg = u.pn >= 8;
#pragma unroll
            for (int ai = 0; ai < 2; ++ai)
#pragma unroll
                for (int m = 0; m < 4; ++m) { bf16_t* rowp = PROJ + (size_t)(row0 + ai * HALF + m * 16) * DINP + col0;
#pragma unroll
                    for (int bj = 0; bj < 2; ++bj) { f32x4 v0 = acc[ai][bj][m][0], v1 = acc[ai][bj][m][1];
                        if (sg) { v0 = sig4(v0); v1 = sig4(v1); }
                        *(u32x4*)(rowp + bj * HALF) = pack8(v0, v1); } }
        }
    }
};

struct EpiQB {
    bf16_t* QB; const float* gn; const float* cosB; const float* sinB; LAS float* xch;
    __device__ __forceinline__ void operator()(EPI_ARGS) const {
        const int rl0 = wr * 64 + fr, row0 = u.pm * BM + rl0;
#pragma unroll
        for (int ai = 0; ai < 2; ++ai)
#pragma unroll
            for (int m = 0; m < 4; ++m)
#pragma unroll
                for (int bj = 0; bj < 2; ++bj) { const f32x4 x0 = acc[ai][bj][m][0], x1 = acc[ai][bj][m][1];
                    float ss = (x0[0] * x0[0] + x0[1] * x0[1]) + (x0[2] * x0[2] + x0[3] * x0[3]) + (x1[0] * x1[0] + x1[1] * x1[1]) + (x1[2] * x1[2] + x1[3] * x1[3]);
                    ss += __shfl_xor(ss, 16); ss += __shfl_xor(ss, 32);
                    if (fq == 0) xch[((rl0 + ai * HALF + m * 16) * 2 + bj) * 4 + wc] = ss; }
        asm volatile("s_waitcnt lgkmcnt(0)" ::: "memory"); __builtin_amdgcn_s_barrier(); asm volatile("" ::: "memory");
#define QB_RS(ai, m, bj) ({ const f32x4 p4_ = *(const LAS f32x4*)(xch + ((rl0 + (ai) * HALF + (m) * 16) * 2 + (bj)) * 4); C2B / sqrtf(((p4_[0] + p4_[1]) + p4_[2]) * (1.f / 96.f) + EPS); })
        if (wc < 2) { const f32x4 ga = *(const f32x4*)(gn + 32 * wc + 8 * fq), gb = *(const f32x4*)(gn + 32 * wc + 8 * fq + 4);
#pragma unroll
            for (int ai = 0; ai < 2; ++ai)
#pragma unroll
                for (int m = 0; m < 4; ++m)
#pragma unroll
                    for (int bj = 0; bj < 2; ++bj) { const float r = QB_RS(ai, m, bj);
                        *(u32x4*)(QB + (size_t)(row0 + ai * HALF + m * 16) * 768 + (2 * u.pn + bj) * 96 + 32 * wc + 8 * fq) = pack8(acc[ai][bj][m][0] * ga * r, acc[ai][bj][m][1] * gb * r); }
        } else if (wc == 2) { const f32x4 g1 = *(const f32x4*)(gn + 64 + 4 * fq), g2 = *(const f32x4*)(gn + 80 + 4 * fq);
            const f32x4 ifr = *(const f32x4*)(cosB - 131072 + 196640 + 4 * fq);
#pragma unroll
            for (int ai = 0; ai < 2; ++ai)
#pragma unroll
                for (int m = 0; m < 4; ++m) { const int row = row0 + ai * HALF + m * 16; const int pos = row & (SEQ - 1);
                    f32x4 c4, s4; { const float fp_ = (float)pos;
#pragma unroll
                        for (int i = 0; i < 4; ++i) { const float rv = __builtin_amdgcn_fractf(fp_ * ifr[i]); c4[i] = __builtin_amdgcn_cosf(rv); s4[i] = __builtin_amdgcn_sinf(rv); } }
#pragma unroll
                    for (int bj = 0; bj < 2; ++bj) { const float r = QB_RS(ai, m, bj); const f32x4 x1 = acc[ai][bj][m][0] * g1 * r, x2 = acc[ai][bj][m][1] * g2 * r;
                        const f32x4 y1 = x1 * c4 - x2 * s4, y2 = x2 * c4 + x1 * s4; bf16_t* rp = QB + (size_t)row * 768 + (2 * u.pn + bj) * 96 + 64 + 4 * fq;
                        *(u32x2*)rp = (u32x2){cvt_pk_bf16(y1[0], y1[1]), cvt_pk_bf16(y1[2], y1[3])}; *(u32x2*)(rp + 16) = (u32x2){cvt_pk_bf16(y2[0], y2[1]), cvt_pk_bf16(y2[2], y2[3])}; } }
        }
    }
};
struct EpiKV {
    bf16_t* KB2; bf16_t* KV; const bf16_t* PROJ; const float* KPESS; const float* gn; const float* cosB; const float* sinB; LAS float* xch;
    __device__ __forceinline__ void operator()(EPI_ARGS) const {
        const int rl0 = wr * 64 + fr, row0 = u.pm * BM + rl0;
        if (wc < 2) {
#pragma unroll
            for (int ai = 0; ai < 2; ++ai)
#pragma unroll
                for (int m = 0; m < 4; ++m)
#pragma unroll
                    for (int bj = 0; bj < 2; ++bj) { const f32x4 x0 = acc[ai][bj][m][0], x1 = acc[ai][bj][m][1];
                        float ss = (x0[0] * x0[0] + x0[1] * x0[1]) + (x0[2] * x0[2] + x0[3] * x0[3]) + (x1[0] * x1[0] + x1[1] * x1[1]) + (x1[2] * x1[2] + x1[3] * x1[3]);
                        ss += __shfl_xor(ss, 16); ss += __shfl_xor(ss, 32);
                        if (fq == 0) xch[((rl0 + ai * HALF + m * 16) * 2 + bj) * 4 + wc] = ss; } }
        asm volatile("s_waitcnt lgkmcnt(0)" ::: "memory"); __builtin_amdgcn_s_barrier(); asm volatile("" ::: "memory");
#define KV_RS(ai, m, bj, pe) ({ const f32x2 p2_ = *(const LAS f32x2*)(xch + ((rl0 + (ai) * HALF + (m) * 16) * 2 + (bj)) * 4); 1.0f / sqrtf(((p2_[0] + p2_[1]) + (pe)) * (1.f / 96.f) + EPS); })
        if (wc < 2) { const f32x4 ga = *(const f32x4*)(gn + 32 * wc + 8 * fq), gb = *(const f32x4*)(gn + 32 * wc + 8 * fq + 4);
#pragma unroll
            for (int ai = 0; ai < 2; ++ai)
#pragma unroll
                for (int m = 0; m < 4; ++m) { const float pe = KPESS[row0 + ai * HALF + m * 16];
#pragma unroll
                    for (int bj = 0; bj < 2; ++bj) { const float r = KV_RS(ai, m, bj, pe);
                        *(u32x4*)(KB2 + (size_t)(row0 + ai * HALF + m * 16) * 768 + (2 * u.pn + bj) * 96 + 32 * wc + 8 * fq) = pack8(acc[ai][bj][m][0] * ga * r, acc[ai][bj][m][1] * gb * r); } }
        } else {
#pragma unroll
            for (int ai = 0; ai < 2; ++ai)
#pragma unroll
                for (int m = 0; m < 4; ++m)
#pragma unroll
                    for (int bj = 0; bj < 2; ++bj) *(u32x4*)(KV + (size_t)(row0 + ai * HALF + m * 16) * 1024 + (2 * u.pn + bj) * 128 + 32 * wc + 8 * fq) = pack8(acc[ai][bj][m][0], acc[ai][bj][m][1]);
            if (wc == 2) {
                const f32x4 g1 = *(const f32x4*)(gn + 64 + 4 * fq), g2 = *(const f32x4*)(gn + 80 + 4 * fq);
                const f32x4 ifr = *(const f32x4*)(cosB - 131072 + 196640 + 4 * fq);
#pragma unroll
                for (int ai = 0; ai < 2; ++ai)
#pragma unroll
                    for (int m = 0; m < 4; ++m) { const int row = row0 + ai * HALF + m * 16; const int pos = row & (SEQ - 1); const float pe = KPESS[row];
                        const u32x2 w1 = *(const u32x2*)(PROJ + (size_t)row * DINP + PC_KPE + 4 * fq), w2 = *(const u32x2*)(PROJ + (size_t)row * DINP + PC_KPE + 16 + 4 * fq);
                        const f32x4 k1 = (f32x4){bflo(w1.x), bfhi(w1.x), bflo(w1.y), bfhi(w1.y)} * g1, k2 = (f32x4){bflo(w2.x), bfhi(w2.x), bflo(w2.y), bfhi(w2.y)} * g2;
                        f32x4 c4, s4; { const float fp_ = (float)pos;
#pragma unroll
                            for (int i = 0; i < 4; ++i) { const float rv = __builtin_amdgcn_fractf(fp_ * ifr[i]); c4[i] = __builtin_amdgcn_cosf(rv); s4[i] = __builtin_amdgcn_sinf(rv); } }
                        const f32x4 y1 = k1 * c4 - k2 * s4, y2 = k2 * c4 + k1 * s4;
#pragma unroll
                        for (int bj = 0; bj < 2; ++bj) { const float r = KV_RS(ai, m, bj, pe); bf16_t* rp = KB2 + (size_t)row * 768 + (2 * u.pn + bj) * 96 + 64 + 4 * fq;
                            *(u32x2*)rp = (u32x2){cvt_pk_bf16(y1[0] * r, y1[1] * r), cvt_pk_bf16(y1[2] * r, y1[3] * r)}; *(u32x2*)(rp + 16) = (u32x2){cvt_pk_bf16(y2[0] * r, y2[1] * r), cvt_pk_bf16(y2[2] * r, y2[3] * r)}; } } }
        }
    }
};
#undef QB_RS
#undef KV_RS
template <bool ADD> struct EpiGate {
    bf16_t* O; const bf16_t* G; int ldg; unsigned char* MF8;
    __device__ __forceinline__ void operator()(EPI_ARGS) const {
        const int row0 = u.pm * BM + wr * 64 + fr, col0 = u.pn * BM + wc * 32 + 8 * fq;
#pragma unroll
        for (int ai = 0; ai < 2; ++ai)
#pragma unroll
            for (int m = 0; m < 4; ++m) { const size_t r = (size_t)(row0 + ai * HALF + m * 16);
#pragma unroll
                for (int bj = 0; bj < 2; ++bj) { const int c = col0 + bj * HALF;
                    f32x4 g0, g1; unpack8(*(const u32x4*)(G + r * ldg + c), g0, g1);
                    f32x4 v0 = acc[ai][bj][m][0] * g0, v1 = acc[ai][bj][m][1] * g1;
                    if (ADD) { f32x4 o0, o1; unpack8(*(const u32x4*)(O + r * DM + c), o0, o1); v0 += o0; v1 += o1;
                        *(u32x2*)(MF8 + r * DM + c) = (u32x2){pack4_fp8(v0[0], v0[1], v0[2], v0[3]), pack4_fp8(v1[0], v1[1], v1[2], v1[3])}; }
                    else *(u32x4*)(O + r * DM + c) = pack8(v0, v1); } }
    }
};

struct BranchOrder {
    StaticOrder so;
    __device__ bool next(int i, Unit& u) const { if (i >= 2) return false; if (!so.next(0, u)) return false; u.e = i; u.aofs = i * 512; u.pb = u.pn + 8 * i; return true; }
};
struct EpiGateAB {
    bf16_t* O; const bf16_t* Ga; const bf16_t* Gb; int ldg; unsigned char* MF8;
    __device__ __forceinline__ void operator()(EPI_ARGS) const {
        if (u.e == 0) { EpiGate<false> E{O, Ga, ldg, nullptr}; E(acc, u, wr, wc, fr, fq); }
        else { asm volatile("s_waitcnt vmcnt(0)" ::: "memory");
               EpiGate<true> E{O, Gb, ldg, MF8}; E(acc, u, wr, wc, fr, fq); }
    }
};
struct EpiResF32 {
    const float* base; bf16_t* out; float* ssp;
    __device__ __forceinline__ void operator()(EPI_ARGS) const {
        const int row0 = u.pm * BM + wr * 64 + fr, col0 = u.pn * BM + wc * 32 + 8 * fq;
#pragma unroll
        for (int ai = 0; ai < 2; ++ai)
#pragma unroll
            for (int m = 0; m < 4; ++m) { const size_t r = (size_t)(row0 + ai * HALF + m * 16); float ss = 0.f;
#pragma unroll
                for (int bj = 0; bj < 2; ++bj) { const size_t off = r * DM + col0 + bj * HALF;
                    const f32x4 b0 = *(const f32x4*)(base + off), b1 = *(const f32x4*)(base + off + 4);
                    const f32x4 y0 = b0 + acc[ai][bj][m][0], y1 = b1 + acc[ai][bj][m][1];
                    *(u32x4*)(out + off) = pack8(y0, y1);
                    ss += (y0[0] * y0[0] + y0[1] * y0[1]) + (y0[2] * y0[2] + y0[3] * y0[3]) + (y1[0] * y1[0] + y1[1] * y1[1]) + (y1[2] * y1[2] + y1[3] * y1[3]); }
                ss += __shfl_xor(ss, 16); ss += __shfl_xor(ss, 32);
                if (fq == 0) ssp[r * 16 + u.pn * 4 + wc] = ss; }
    }
};
struct EpiSwiglu {
    unsigned char* O; const float* bias;
    __device__ __forceinline__ void operator()(EPI_ARGS) const {
        const int row0 = u.pm * BM + wr * 64 + fr, j0 = u.pn * HALF + wc * 32 + 8 * fq;
        const float* be = bias + (size_t)u.e * 2048;
        f32x4 bg[2], bu[2];
#pragma unroll
        for (int n = 0; n < 2; ++n) { bg[n] = *(const f32x4*)(be + j0 + 4 * n); bu[n] = *(const f32x4*)(be + 1024 + j0 + 4 * n); }
#pragma unroll
        for (int ai = 0; ai < 2; ++ai)
#pragma unroll
            for (int m = 0; m < 4; ++m) { unsigned char* rowp = O + (size_t)(row0 + ai * HALF + m * 16) * DEXP + j0;
                f32x4 o[2];
#pragma unroll
                for (int n = 0; n < 2; ++n) { const f32x4 gv = acc[ai][0][m][n] + bg[n], uv = acc[ai][1][m][n] + bu[n];
#pragma unroll
                    for (int i = 0; i < 4; i += 2) {
                        const f32x2 gg = {fminf(gv[i], 7.0f), fminf(gv[i + 1], 7.0f)}, uu = {__builtin_amdgcn_fmed3f(uv[i], -7.0f, 7.0f), __builtin_amdgcn_fmed3f(uv[i + 1], -7.0f, 7.0f)};
                        const f32x2 ea = gg * (-1.702f * LOG2E); const f32x2 den = (f32x2){__builtin_amdgcn_exp2f(ea.x), __builtin_amdgcn_exp2f(ea.y)} + 1.0f;
                        const f32x2 num = uu * gg + gg; const f32x2 r = num * (f32x2){__builtin_amdgcn_rcpf(den.x), __builtin_amdgcn_rcpf(den.y)};
                        o[n][i] = r.x; o[n][i + 1] = r.y; } }
                *(u32x2*)rowp = (u32x2){pack4_fp8(o[0][0], o[0][1], o[0][2], o[0][3]), pack4_fp8(o[1][0], o[1][1], o[1][2], o[1][3])}; }
    }
};
struct EpiFinal {
    float* out; const bf16_t* PP; const bf16_t* X2;
    __device__ __forceinline__ void operator()(EPI_ARGS) const {
        const int row0 = u.pm * BM + wr * 64 + fr, col0 = u.pn * BM + wc * 32 + 8 * fq;
#pragma unroll
        for (int ai = 0; ai < 2; ++ai)
#pragma unroll
            for (int m = 0; m < 4; ++m) { const size_t r = (size_t)(row0 + ai * HALF + m * 16);
#pragma unroll
                for (int bj = 0; bj < 2; ++bj) { const size_t off = r * DM + col0 + bj * HALF;
                    f32x4 p0, p1, b0, b1; unpack8(*(const u32x4*)(PP + off), p0, p1); unpack8(*(const u32x4*)(X2 + off), b0, b1);
                    *(f32x4*)(out + off) = b0 + sig4(acc[ai][bj][m][0]) * p0; *(f32x4*)(out + off + 4) = b1 + sig4(acc[ai][bj][m][1]) * p1; } }
    }
};
}

namespace att {
__device__ __forceinline__ int crow(int r, int hi) { return (r & 3) + 8 * (r >> 2) + 4 * hi; }
__device__ __forceinline__ void glds16(const void* gsrc, unsigned lds_dst) { unsigned keep;
    asm volatile("s_mov_b32 %0, m0\n\ts_mov_b32 m0, %2\n\ts_nop 0\n\tglobal_load_lds_dwordx4 %1, off\n\ts_mov_b32 m0, %0" : "=&s"(keep) : "v"(gsrc), "s"(lds_dst) : "memory"); }
__device__ __forceinline__ s16x4 vtr(const LAS unsigned char* p) { return __builtin_bit_cast(s16x4, __builtin_amdgcn_ds_read_tr16_b64_v4i16((LAS s16x4*)p)); }
#define MX3(a, b, c) __builtin_fmaxf(__builtin_fmaxf((a), (b)), (c))
constexpr int VSLOT = 8192, OST_BYTES = NWAVES * 4096, WSF_BYTES = NWAVES * 256;

template <int DQK, bool MOBA>
__device__ __forceinline__ void attn_unit(int b, int qb, const bf16_t* Qh, int ldq, const bf16_t* Kh, int ldk, const bf16_t* Vh, int ldv, unsigned char* Oh, int ldo, const float* kmean, LAS unsigned char* shm, int wave) {
    constexpr int ND = DQK / 16, NCH = DQK / 8, KSLOT = NCH * 1024;
    constexpr int LDS_K = 0, LDS_V = 2 * KSLOT, LDS_WS = LDS_V + 2 * VSLOT, LDS_OST = LDS_WS + WSF_BYTES;
    static_assert(LDS_OST + OST_BYTES <= RING_BYTES, "attention LDS");
    int lane = lane_id(); asm volatile("" : "+v"(lane));
    const int r32 = lane & 31, hi = lane >> 5; const int wid = wave;
    const long rowbase = (long)b * SEQ; const int q0 = qb * 256;
    const unsigned lds0 = (unsigned)(uintptr_t)shm;
    LAS float* wsf = (LAS float*)(shm + LDS_WS) + wid * 64;
    const int NT = 4 * (qb + 1);
    const bf16_t* ksrc0 = Kh + (rowbase + lane) * ldk + wid * 8;
    const bf16_t* vsrc0 = Vh + (rowbase + 16 * (wid & 3) + (lane >> 2)) * ldv + (wid >> 2) * 32 + (lane & 3) * 8;
#define ATT_DMA(kt, s) do { const long ro_ = (long)(kt) * 64; \
        glds16(ksrc0 + ro_ * ldk, (unsigned)__builtin_amdgcn_readfirstlane(lds0 + LDS_K + (s) * KSLOT + wid * 1024)); \
        if (NCH > 8 && wid < NCH - 8) glds16(ksrc0 + ro_ * ldk + 64, (unsigned)__builtin_amdgcn_readfirstlane(lds0 + LDS_K + (s) * KSLOT + (wid + 8) * 1024)); \
        glds16(vsrc0 + ro_ * ldv, (unsigned)__builtin_amdgcn_readfirstlane(lds0 + LDS_V + (s) * VSLOT + wid * 1024)); } while (0)
#define ATT_TILE(i) (MOBA ? ((i) < 4 ? 4 * qb + (i) : (i) - 4) : (i))
    ATT_DMA(ATT_TILE(0), 0);
    const bf16_t* Qw = Qh + (rowbase + q0 + wid * 32 + r32) * ldq + hi * 8;
    bf16x8 qr[ND];
#pragma unroll
    for (int d0 = 0; d0 < ND; ++d0) qr[d0] = *(const bf16x8*)(Qw + d0 * 16);
    unsigned bmask = 0xffffffffu;
    if (MOBA) {
        bmask = 1u << qb;
        if (qb <= 3) bmask |= (1u << qb) - 1u;
        else {
            float gsc[7];
#pragma unroll
            for (int n = 0; n < 7; ++n) { float s = 0.f;
                if (n < qb) {
#pragma unroll
                    for (int d0 = 0; d0 < ND; ++d0) { const float* km = kmean + n * 64 + d0 * 16 + hi * 8; const f32x4 k0 = *(const f32x4*)km, k1 = *(const f32x4*)(km + 4);
                        s += bf2f((unsigned short)qr[d0][0]) * k0[0] + bf2f((unsigned short)qr[d0][1]) * k0[1] + bf2f((unsigned short)qr[d0][2]) * k0[2] + bf2f((unsigned short)qr[d0][3]) * k0[3]
                           + bf2f((unsigned short)qr[d0][4]) * k1[0] + bf2f((unsigned short)qr[d0][5]) * k1[1] + bf2f((unsigned short)qr[d0][6]) * k1[2] + bf2f((unsigned short)qr[d0][7]) * k1[3]; }
                    s += __shfl_xor(s, 32);
                } else s = -INFINITY;
                gsc[n] = s; }
#pragma unroll
            for (int pass = 0; pass < 3; ++pass) { float best = -INFINITY; int bi = 0;
#pragma unroll
                for (int n = 0; n < 7; ++n) { const bool ok = (n < qb) && !((bmask >> n) & 1u) && (gsc[n] > best); best = ok ? gsc[n] : best; bi = ok ? n : bi; }
                bmask |= 1u << bi; }
        }
    }
    asm volatile("s_waitcnt vmcnt(0)" ::: "memory");
#pragma unroll
    for (int d0 = 0; d0 < ND; ++d0) asm volatile("" : "+v"(qr[d0]));
    float mhat = 0.f, l_reg = 0.f; f32x16 o[2]; o[0] = f32x16{}; o[1] = f32x16{}; f32x16 negm = f32x16{}; asm volatile("" : "+v"(negm));
    const int qrel = wid * 32 + r32;
    const LAS unsigned char* kp0 = shm + LDS_K + hi * 1024 + r32 * 16;
    const LAS unsigned char* vp0 = shm + LDS_V + ((lane >> 4) & 1) * 32 + (lane & 3) * 8 + (4 * hi + ((lane & 15) >> 2)) * 64;
    for (int i = 0; i < NT; ++i) {
        const int s = i & 1, kt = ATT_TILE(i);
        asm volatile("s_waitcnt vmcnt(0) lgkmcnt(0)\n\ts_barrier" ::: "memory");
        if (i + 1 < NT) ATT_DMA(ATT_TILE(i + 1), s ^ 1);
        f32x16 cin = negm;
        if (MOBA) { if (i >= 4 && !((bmask >> (kt >> 2)) & 1u)) {
#pragma unroll
            for (int r = 0; r < 16; ++r) cin[r] = -INFINITY; } }
        f32x16 p0, p1;
        { const LAS unsigned char* kb = kp0 + s * KSLOT; bf16x8 kf[2 * ND];
#pragma unroll
            for (int d0 = 0; d0 < ND; ++d0) { kf[2 * d0] = *(const LAS bf16x8*)(kb + d0 * 2048); kf[2 * d0 + 1] = *(const LAS bf16x8*)(kb + d0 * 2048 + 512); }
            __builtin_amdgcn_sched_barrier(0);
#pragma unroll
            for (int d0 = 0; d0 < ND; ++d0) {
                if (d0 == 0) { p0 = __builtin_amdgcn_mfma_f32_32x32x16_bf16(kf[0], qr[0], cin, 0, 0, 0); p1 = __builtin_amdgcn_mfma_f32_32x32x16_bf16(kf[1], qr[0], cin, 0, 0, 0); }
                else { p0 = __builtin_amdgcn_mfma_f32_32x32x16_bf16(kf[2 * d0], qr[d0], p0, 0, 0, 0); p1 = __builtin_amdgcn_mfma_f32_32x32x16_bf16(kf[2 * d0 + 1], qr[d0], p1, 0, 0, 0); } } }
        if (kt >= 4 * qb) { const int kb = 64 * (kt - 4 * qb) + 4 * hi;
#pragma unroll
            for (int r = 0; r < 16; ++r) { const int kv = kb + (r & 3) + 8 * (r >> 2); if (kv > qrel) p0[r] = -INFINITY; if (kv + 32 > qrel) p1[r] = -INFINITY; } }
        bool resc = false;
        { float a = MX3(p0[0], p0[1], p1[0]), bb = MX3(p0[2], p0[3], p1[1]); a = MX3(a, p1[2], p1[3]);
#pragma unroll
            for (int r = 4; r < 16; r += 4) { a = MX3(a, p0[r], p0[r + 1]); bb = MX3(bb, p0[r + 2], p0[r + 3]); a = MX3(a, p1[r], p1[r + 1]); bb = MX3(bb, p1[r + 2], p1[r + 3]); }
            float rm = __builtin_fmaxf(a, bb); rm = __builtin_fmaxf(rm, __shfl_xor(rm, 32));
            const bool first = (i == 0);
            if (first || __any(rm > 6.0f)) {
                const float dl = first ? rm : __builtin_fmaxf(rm, 0.f); mhat += dl;
#pragma unroll
                for (int r = 0; r < 16; ++r) { p0[r] -= dl; p1[r] -= dl; }
#pragma unroll
                for (int r = 0; r < 16; ++r) negm[r] = -mhat;
                asm volatile("" : "+v"(negm));
                const float f = __builtin_amdgcn_exp2f(-dl); l_reg *= f; if (hi == 0) wsf[r32] = f; resc = true; } }
        float sacc = 0.f;
#pragma unroll
        for (int r = 0; r < 16; ++r) { p0[r] = __builtin_amdgcn_exp2f(p0[r]); p1[r] = __builtin_amdgcn_exp2f(p1[r]); sacc += p0[r] + p1[r]; }
        l_reg += sacc;
        u32x4 pw0, pw1, pw2, pw3;
        pw0 = (u32x4){cvt_pk_bf16(p0[0], p0[1]), cvt_pk_bf16(p0[2], p0[3]), cvt_pk_bf16(p0[4], p0[5]), cvt_pk_bf16(p0[6], p0[7])};
        pw1 = (u32x4){cvt_pk_bf16(p0[8], p0[9]), cvt_pk_bf16(p0[10], p0[11]), cvt_pk_bf16(p0[12], p0[13]), cvt_pk_bf16(p0[14], p0[15])};
        pw2 = (u32x4){cvt_pk_bf16(p1[0], p1[1]), cvt_pk_bf16(p1[2], p1[3]), cvt_pk_bf16(p1[4], p1[5]), cvt_pk_bf16(p1[6], p1[7])};
        pw3 = (u32x4){cvt_pk_bf16(p1[8], p1[9]), cvt_pk_bf16(p1[10], p1[11]), cvt_pk_bf16(p1[12], p1[13]), cvt_pk_bf16(p1[14], p1[15])};
        if (resc) {
#pragma unroll
            for (int d_ = 0; d_ < 2; ++d_)
#pragma unroll
                for (int r = 0; r < 16; ++r) o[d_][r] *= wsf[crow(r, hi)];
        }
        { const LAS unsigned char* vp = vp0 + s * VSLOT;
#pragma unroll
            for (int d0 = 0; d0 < 2; ++d0) {
                s16x4 lo[4], hh[4];
#pragma unroll
                for (int ks = 0; ks < 4; ++ks) { lo[ks] = vtr(vp + d0 * 4096 + ks * 1024); hh[ks] = vtr(vp + d0 * 4096 + ks * 1024 + 512); }
                __builtin_amdgcn_sched_barrier(0);
#define PKV(k) (bf16x8){lo[k][0], lo[k][1], lo[k][2], lo[k][3], hh[k][0], hh[k][1], hh[k][2], hh[k][3]}
                o[d0] = __builtin_amdgcn_mfma_f32_32x32x16_bf16(__builtin_bit_cast(bf16x8, pw0), PKV(0), o[d0], 0, 0, 0);
                o[d0] = __builtin_amdgcn_mfma_f32_32x32x16_bf16(__builtin_bit_cast(bf16x8, pw1), PKV(1), o[d0], 0, 0, 0);
                o[d0] = __builtin_amdgcn_mfma_f32_32x32x16_bf16(__builtin_bit_cast(bf16x8, pw2), PKV(2), o[d0], 0, 0, 0);
                o[d0] = __builtin_amdgcn_mfma_f32_32x32x16_bf16(__builtin_bit_cast(bf16x8, pw3), PKV(3), o[d0], 0, 0, 0);
#undef PKV
            } }
    }
    l_reg += __shfl_xor(l_reg, 32);
    if (hi == 0) wsf[32 + r32] = l_reg;
    float rli[16];
#pragma unroll
    for (int r = 0; r < 16; ++r) rli[r] = __builtin_amdgcn_rcpf(wsf[32 + crow(r, hi)]);
    unsigned char* Ow = (unsigned char*)Oh + (rowbase + q0 + wid * 32) * ldo;
    { LAS unsigned char* stg = shm + LDS_OST + wid * 2048;
#pragma unroll
        for (int r = 0; r < 16; ++r) { const int orow = crow(r, hi);
#pragma unroll
            for (int d0 = 0; d0 < 2; ++d0) stg[orow * 64 + d0 * 32 + r32] = (unsigned char)(pack4_fp8(o[d0][r] * rli[r], 0.f, 0.f, 0.f) & 0xffu); }
#pragma unroll
        for (int i = 0; i < 2; ++i) { const int row = i * 16 + (lane >> 2), ch = lane & 3; const u32x4 v = *(const LAS u32x4*)(stg + row * 64 + ch * 16); *(u32x4*)(Ow + (long)row * ldo + ch * 16) = v; } }
    asm volatile("s_waitcnt lgkmcnt(0)\n\ts_barrier" ::: "memory");
#undef ATT_DMA
#undef ATT_TILE
}
#undef MX3
}

#define XB_TMO      128
#define XB_XCNT(j)  (256  + 64 * (j))
#define XB_XSUB(j)  (1280 + 64 * (j))
#define XB_XGEN(j)  (2304 + 64 * (j))
#define XB_TOP      3328
#define XB_TOPGEN   3392
#define XCD_BAR_WORDS 3456
#define XB_SPIN_CAP (1u << 22)
__device__ __forceinline__ unsigned xb_ld(unsigned* p)              { return __hip_atomic_load(p, __ATOMIC_RELAXED, __HIP_MEMORY_SCOPE_AGENT); }
__device__ __forceinline__ unsigned xb_add(unsigned* p, unsigned v) { return __hip_atomic_fetch_add(p, v, __ATOMIC_RELAXED, __HIP_MEMORY_SCOPE_AGENT); }
__device__ __forceinline__ unsigned xb_xcc_id() { return (unsigned)__builtin_amdgcn_s_getreg((3 << 11) | 20) & 0xFu; }
#define XB_SPIN(cond, bar) do { unsigned _sp = 0; while (cond) { __builtin_amdgcn_s_sleep(1); \
    if ((++_sp & 255u) == 0u) { if (xb_ld(&(bar)[XB_TMO])) break; if (_sp > XB_SPIN_CAP) { atomicAdd(&(bar)[XB_TMO], 1u); break; } } } } while (0)
struct XcdBarrier { unsigned* bar; unsigned x; volatile LAS unsigned* st; int wave; };
__device__ __forceinline__ XcdBarrier xcd_barrier_post(unsigned* bar, volatile LAS unsigned* st, int wave) {
    XcdBarrier b; b.bar = bar; b.x = xb_xcc_id(); b.st = st; b.wave = wave;
    if (wave == 0 && lane_id() == 0) (void)xb_add(&bar[XB_XCNT(b.x)], 1u);
    return b;
}
__device__ __forceinline__ void xcd_barrier_complete(unsigned* bar, unsigned x, unsigned& nloc, unsigned& nx) {
    const unsigned G = gridDim.x * gridDim.y * gridDim.z;
    unsigned sum, cnt, mine, sp = 0u;
    for (;;) {
        sum = 0u; cnt = 0u; mine = 0u;
#pragma unroll
        for (unsigned j = 0; j < 16; ++j) { const unsigned c = xb_ld(&bar[XB_XCNT(j)]); sum += c; cnt += (c > 0u) ? 1u : 0u; mine = (j == x) ? c : mine; }
        if (sum == G) break;
        __builtin_amdgcn_s_sleep(1);
        if ((++sp & 255u) == 0u) { if (xb_ld(&bar[XB_TMO])) break; if (sp > XB_SPIN_CAP) { atomicAdd(&bar[XB_TMO], 1u); break; } }
    }
    nloc = mine > 0u ? mine : 1u; nx = cnt > 0u ? cnt : 1u;
}
__device__ __forceinline__ void xcd_barrier(const XcdBarrier& b) {
    asm volatile("s_waitcnt vmcnt(0)" ::: "memory");
    __syncthreads();
    if (b.wave == 0 && lane_id() == 0) {
        unsigned* bar = b.bar;
        __builtin_amdgcn_s_waitcnt(0);
        unsigned nloc = b.st[0], nx = b.st[1];
        if (nloc == 0u) { xcd_barrier_complete(bar, b.x, nloc, nx); b.st[0] = nloc; b.st[1] = nx; }
        const unsigned old = xb_add(&bar[XB_XSUB(b.x)], 1u);
        const unsigned gen = old / nloc;
        if (old + 1u == (gen + 1u) * nloc) {
            __builtin_amdgcn_fence(__ATOMIC_RELEASE, "agent");
            asm volatile("s_waitcnt vmcnt(0)" ::: "memory");
            const unsigned og = xb_add(&bar[XB_TOP], 1u);
            const unsigned tg = og / nx;
            if (og + 1u == (tg + 1u) * nx) xb_add(&bar[XB_TOPGEN], 1u);
            else XB_SPIN(xb_ld(&bar[XB_TOPGEN]) == tg, bar);
            __builtin_amdgcn_fence(__ATOMIC_ACQUIRE, "agent");
            xb_add(&bar[XB_XGEN(b.x)], 1u);
            asm volatile("s_waitcnt vmcnt(0)" ::: "memory");
        } else {
            XB_SPIN(xb_ld(&bar[XB_XGEN(b.x)]) == gen, bar);
            __builtin_amdgcn_fence(__ATOMIC_ACQUIRE, "agent");
            asm volatile("s_waitcnt vmcnt(0)" ::: "memory");
        }
    }
    __syncthreads();
}

struct Params { const float* in[25]; float* out; unsigned char* ws; int ph_lo, ph_hi; };
enum { I_X = 0, I_P, I_GMIX, I_WIN, I_MQN, I_MKN, I_QLATN, I_WUQ, I_KVLATN, I_WUKV, I_MLAQN, I_MLAKN, I_WA, I_WB, I_WO, I_GFFN, I_WR, I_BR, I_WGU, I_BGU, I_WD, I_BD, I_GPLE, I_WPG, I_WPP };
constexpr int NPHASE = 16;

struct Frame {
    LAS unsigned char* lds; int vcu, G, wave;
    const Params* P; unsigned char* ws;
};
struct Ids { int tid, lane, wave; };
#define PHASE_IDS() Ids I_; { int l_ = lane_id(); asm volatile("" : "+v"(l_)); I_.lane = l_; I_.wave = F.wave; I_.tid = F.wave * 64 + l_; }

#ifdef TPROBE_A
#define STAMP(k) do { if (blockIdx.x == 0 && F.wave == 0 && lane_id() == 0) ((volatile unsigned long long*)(ws + WS_ERR))[k] = __builtin_amdgcn_s_memrealtime(); } while (0)
#else
#define STAMP(k) do {} while (0)
#endif
__device__ __forceinline__ int rowmap(int mode, int c) {
    if (mode == 1) {
        if (c < 1024) { const int base = c & 512, s_ = c & 511, h = s_ >> 6, d = s_ & 63; return base + 256 * (h >> 2) + 128 * (d >> 5) + 32 * (h & 3) + (d & 31); }
        return c < 1952 ? c : c + 96; }
    if (mode == 2) return c < 1024 ? 256 * (c >> 7) + (c & 127) : 256 * ((c - 1024) >> 7) + 128 + ((c - 1024) & 127);
    if (mode == 3) {
        const int h = c / 96, d = c % 96; int t;
        if (d < 64) t = d; else if (d < 80) { const int i = d - 64; t = 64 + 8 * (i >> 2) + (i & 3); } else { const int i = d - 80; t = 64 + 8 * (i >> 2) + 4 + (i & 3); }
        return 128 * h + t; }
    return c;
}
__device__ __forceinline__ void tr_item64(const float* W, int ldw, int N, int k0, int n0, bf16_t* dst, int ldd, int mode, LAS float* scr, int lane) {
    const int r = lane >> 4, c4 = lane & 15; const bool inb = (n0 + 4 * c4) < N;
    f32x4 v[16];
#pragma unroll
    for (int i = 0; i < 16; ++i) v[i] = inb ? __builtin_nontemporal_load((const f32x4*)(W + (size_t)(k0 + 4 * i + r) * ldw + n0 + 4 * c4)) : (f32x4){0.f, 0.f, 0.f, 0.f};
#pragma unroll
    for (int i = 0; i < 16; ++i) { LAS float* p = scr + (4 * i + r) * 65 + 4 * c4; p[0] = v[i].x; p[1] = v[i].y; p[2] = v[i].z; p[3] = v[i].w; }
    asm volatile("s_waitcnt lgkmcnt(0)" ::: "memory");
    const int c = lane & 7;
#pragma unroll
    for (int j = 0; j < 8; ++j) { const int n = (lane >> 3) + 8 * j; const LAS float* sp = scr + (8 * c) * 65 + n;
        u32x4 o; o.x = cvt_pk_bf16(sp[0 * 65], sp[1 * 65]); o.y = cvt_pk_bf16(sp[2 * 65], sp[3 * 65]); o.z = cvt_pk_bf16(sp[4 * 65], sp[5 * 65]); o.w = cvt_pk_bf16(sp[6 * 65], sp[7 * 65]);
        if (n0 + n < N) *(u32x4*)(dst + (size_t)rowmap(mode, n0 + n) * ldd + k0 + 8 * c) = o; }
    asm volatile("s_waitcnt lgkmcnt(0)" ::: "memory");
}

__device__ __forceinline__ void tr_item_f8(const float* W, int ldw, int k0, int n0, unsigned char* dst, int ldd, int mode, LAS float* scr, int lane) {
    const int r = lane >> 3, c4 = lane & 7;
    f32x4 v[16];
#pragma unroll
    for (int i = 0; i < 16; ++i) v[i] = __builtin_nontemporal_load((const f32x4*)(W + (size_t)(k0 + 8 * i + r) * ldw + n0 + 4 * c4));
#pragma unroll
    for (int i = 0; i < 16; ++i) { LAS float* p = scr + (8 * i + r) * 33 + 4 * c4; p[0] = v[i].x * 64.f; p[1] = v[i].y * 64.f; p[2] = v[i].z * 64.f; p[3] = v[i].w * 64.f; }
    asm volatile("s_waitcnt lgkmcnt(0)" ::: "memory");
    const int c = lane & 7;
#pragma unroll
    for (int j = 0; j < 4; ++j) { const int n = (lane >> 3) + 8 * j; const LAS float* sp = scr + (16 * c) * 33 + n;
        u32x4 o; o.x = pack4_fp8(sp[0 * 33], sp[1 * 33], sp[2 * 33], sp[3 * 33]); o.y = pack4_fp8(sp[4 * 33], sp[5 * 33], sp[6 * 33], sp[7 * 33]);
        o.z = pack4_fp8(sp[8 * 33], sp[9 * 33], sp[10 * 33], sp[11 * 33]); o.w = pack4_fp8(sp[12 * 33], sp[13 * 33], sp[14 * 33], sp[15 * 33]);
        __builtin_nontemporal_store(o, (u32x4*)(dst + (size_t)rowmap(mode, n0 + n) * ldd + k0 + 16 * c)); }
    asm volatile("s_waitcnt lgkmcnt(0)" ::: "memory");
}

__device__ __forceinline__ void phase0(Frame& F) {
    PHASE_IDS();
    const Params& P = *F.P; unsigned char* ws = F.ws;
    LAS float* scr = (LAS float*)(F.lds + I_.wave * 16896);
    const int gw = F.vcu * NWAVES + I_.wave, NGW = F.G * NWAVES;
    constexpr int I_GU = 32 * 8 * 64, I_DN = 32 * 8 * 32, I_IN = 8 * 61, I_ING = 8 * 64, I_UQ = 4 * 12, I_UKV = 2 * 16, I_A = 8 * 16, I_O = 16 * 16, I_PP = 4 * 16;
    constexpr int I_PG = 8 * 32;
    constexpr int NITEMS = I_GU + I_DN + I_IN + I_ING + I_UQ + I_UKV + 2 * I_A + I_O + I_PG + I_PP;
    for (int it = gw; it < NITEMS; it += NGW) {
        int r = it;
        if (r < I_GU) { const int e = r >> 9, q = r & 511, kb = q >> 6, g = q & 63;
            tr_item_f8(P.in[I_WGU] + (size_t)e * 1024 * 2048, 2048, 128 * kb, 32 * g, ws + WS_W1 + (size_t)e * 2048 * 1024, 1024, 2, scr, I_.lane); continue; } r -= I_GU;
        if (r < I_DN) { const int e = r >> 8, q = r & 255, kb = q >> 5, g = q & 31;
            tr_item_f8(P.in[I_WD] + (size_t)e * 1024 * 1024, 1024, 128 * kb, 32 * g, ws + WS_W2 + (size_t)e * 1024 * 1024, 1024, 0, scr, I_.lane); continue; } r -= I_DN;
        if (r < I_IN) { const int kb = r / 61, g = r % 61; tr_item_f8(P.in[I_WIN], DIN, 128 * kb, 32 * g, ws + WS_WIN, 1024, 1, scr, I_.lane); continue; } r -= I_IN;
        if (r < I_ING) { const int kb = r >> 6, g = r & 63; tr_item_f8(P.in[I_WIN] + 1952, DIN, 128 * kb, 32 * g, ws + WS_WINF8, 1024, 0, scr, I_.lane); continue; } r -= I_ING;
        if (r < I_UQ) { const int kb = r / 12, g = r % 12; tr_item64(P.in[I_WUQ], 768, 768, 64 * kb, 64 * g, (bf16_t*)(ws + WS_WUQ), 256, 3, scr, I_.lane); continue; } r -= I_UQ;
        if (r < I_UKV) { const int kb = r / 16, g = r % 16; tr_item64(P.in[I_WUKV], 1024, 1024, 64 * kb, 64 * g, (bf16_t*)(ws + WS_WUKV), 128, 0, scr, I_.lane); continue; } r -= I_UKV;
        if (r < I_A) { const int kb = r >> 5, g = r & 31; tr_item_f8(P.in[I_WA], 1024, 128 * kb, 32 * g, ws + WS_WA, 512, 0, scr, I_.lane); continue; } r -= I_A;
        if (r < I_A) { const int kb = r >> 5, g = r & 31; tr_item_f8(P.in[I_WB], 1024, 128 * kb, 32 * g, ws + WS_WB, 512, 0, scr, I_.lane); continue; } r -= I_A;
        if (r < I_PG) { const int kb = r >> 5, g = r & 31; tr_item_f8(P.in[I_WO], 1024, 128 * kb, 32 * g, ws + WS_WO, 1024, 0, scr, I_.lane); continue; } r -= I_PG;
        if (r < I_PG) { const int kb = r >> 5, g = r & 31; tr_item_f8(P.in[I_WPG], 1024, 128 * kb, 32 * g, ws + WS_WPG, 1024, 0, scr, I_.lane); continue; } r -= I_PG;
        { const int kb = r / 16, g = r % 16; tr_item64(P.in[I_WPP], 1024, 1024, 64 * kb, 64 * g, (bf16_t*)(ws + WS_WPP), 256, 0, scr, I_.lane); }
    }
    STAMP(20);
    { const f32x4* gp = (const f32x4*)P.in[I_GMIX] + I_.lane; f32x4 gv[4];
#pragma unroll
        for (int j = 0; j < 4; ++j) gv[j] = gp[64 * j];
        for (int m0 = gw * 4; m0 < NTOK; m0 += NGW * 4) { f32x4 v[4][4];
#pragma unroll
            for (int q = 0; q < 4; ++q) { const f32x4* xr = (const f32x4*)(P.in[I_X] + (size_t)(m0 + q) * DM) + I_.lane;
#pragma unroll
                for (int j = 0; j < 4; ++j) v[q][j] = xr[64 * j]; }
#pragma unroll
            for (int q = 0; q < 4; ++q) { float s = 0.f;
#pragma unroll
                for (int j = 0; j < 4; ++j) s += (v[q][j].x * v[q][j].x + v[q][j].y * v[q][j].y) + (v[q][j].z * v[q][j].z + v[q][j].w * v[q][j].w);
                const float rstd = 1.0f / sqrtf(wave_sum(s) * (1.f / DM) + EPS);
                unsigned* o4 = (unsigned*)(ws + WS_HNF8 + (size_t)(m0 + q) * DM) + I_.lane;
#pragma unroll
                for (int j = 0; j < 4; ++j) { const f32x4 y = v[q][j] * rstd * gv[j]; o4[64 * j] = pack4_fp8(y.x, y.y, y.z, y.w); } } } }
    STAMP(21);
    { float* km = (float*)(ws + WS_KMEAN); for (int i = F.vcu * NTHREADS + I_.tid; i < 8 * 8 * 8 * 64; i += F.G * NTHREADS) km[i] = 0.f; }
    { const size_t n4 = (size_t)NTOK * 256 / 4; const f32x4* pp = (const f32x4*)P.in[I_P]; u32x2* po = (u32x2*)(ws + WS_PB); const size_t T = (size_t)F.G * NTHREADS;
        for (size_t i = (size_t)F.vcu * NTHREADS + I_.tid; i < n4; i += 4 * T) { f32x4 v[4];
#pragma unroll
            for (int q = 0; q < 4; ++q) v[q] = __builtin_nontemporal_load(pp + i + q * T);
#pragma unroll
            for (int q = 0; q < 4; ++q) po[i + q * T] = (u32x2){cvt_pk_bf16(v[q].x, v[q].y), cvt_pk_bf16(v[q].z, v[q].w)}; } }
    STAMP(22);
    { float* tab = (float*)(ws + WS_ROPE);
        const int i = F.vcu * NTHREADS + I_.tid;
        if (i < 48) { const int half = i < 32 ? 32 : 16, j = i < 32 ? i : i - 32; tab[196608 + i] = powf(10000.0f, -((float)j / (float)half)) * 0.15915494309189535f; } }
}

__device__ __forceinline__ void phase2(Frame& F) {
    PHASE_IDS();
    const Params& P = *F.P; unsigned char* ws = F.ws;
    const bf16_t* PROJ = (const bf16_t*)(ws + WS_PROJ);
    const float* cosA = (const float*)(ws + WS_ROPE); const float* sinA = cosA + 65536;
    LAS float* kst = (LAS float*)F.lds;
    LAS float* part = kst + 256 * 68;
    for (int it = F.vcu; it < 512; it += F.G) {
        const int b = it >> 6, blk = (it >> 3) & 7, h = it & 7;
        const int sel = I_.lane >> 5, r = I_.wave * 32 + (I_.lane & 31); const int pos = blk * 256 + r; const size_t row = (size_t)b * SEQ + pos;
        const u32x4* src = (const u32x4*)(PROJ + row * DINP + (sel ? PC_KA : PC_QA) + h * 64);
        u32x4 raw[8];
#pragma unroll
        for (int c = 0; c < 8; ++c) raw[c] = src[c];
        float ss = 0.f;
#pragma unroll
        for (int c = 0; c < 8; ++c) { f32x4 a0, a1; pg8::unpack8(raw[c], a0, a1); ss += (a0[0] * a0[0] + a0[1] * a0[1]) + (a0[2] * a0[2] + a0[3] * a0[3]) + (a1[0] * a1[0] + a1[1] * a1[1]) + (a1[2] * a1[2] + a1[3] * a1[3]); }
        const float rstd = 1.0f / sqrtf(ss * (1.f / 64.f) + EPS);
        const float* gn = sel ? P.in[I_MKN] : P.in[I_MQN];
        const float sc = sel ? 1.0f : C2A;
        bf16_t* dst = (bf16_t*)(ws + (sel ? WS_KA2 : WS_QA2)) + row * 512 + h * 64;
#pragma unroll
        for (int c = 0; c < 4; ++c) { f32x4 x1a, x1b, x2a, x2b; pg8::unpack8(raw[c], x1a, x1b); pg8::unpack8(raw[c + 4], x2a, x2b);
            const f32x4 g1a = *(const f32x4*)(gn + 8 * c), g1b = *(const f32x4*)(gn + 8 * c + 4), g2a = *(const f32x4*)(gn + 32 + 8 * c), g2b = *(const f32x4*)(gn + 36 + 8 * c);
            x1a = x1a * g1a * rstd; x1b = x1b * g1b * rstd; x2a = x2a * g2a * rstd; x2b = x2b * g2b * rstd;
            const f32x4 ca = *(const f32x4*)(cosA + pos * 32 + 8 * c), cb = *(const f32x4*)(cosA + pos * 32 + 8 * c + 4), sa = *(const f32x4*)(sinA + pos * 32 + 8 * c), sb = *(const f32x4*)(sinA + pos * 32 + 8 * c + 4);
            const f32x4 y1a = x1a * ca - x2a * sa, y1b = x1b * cb - x2b * sb, y2a = x2a * ca + x1a * sa, y2b = x2b * cb + x1b * sb;
            *(u32x4*)(dst + 8 * c) = pg8::pack8(y1a * sc, y1b * sc); *(u32x4*)(dst + 32 + 8 * c) = pg8::pack8(y2a * sc, y2b * sc);
            if (sel) { LAS f32x4* kr = (LAS f32x4*)(kst + r * 68); kr[2 * c] = y1a; kr[2 * c + 1] = y1b; kr[8 + 2 * c] = y2a; kr[8 + 2 * c + 1] = y2b; } }
        __syncthreads();
        { const int d = I_.tid & 63, pt = I_.tid >> 6; float s = 0.f;
#pragma unroll 8
            for (int rr = 0; rr < 32; ++rr) s += kst[(pt * 32 + rr) * 68 + d];
            part[pt * 64 + d] = s; }
        __syncthreads();
        if (I_.tid < 64) { float s = 0.f;
#pragma unroll
            for (int pt = 0; pt < 8; ++pt) s += part[pt * 64 + I_.tid];
            ((float*)(ws + WS_KMEAN))[(((size_t)b * 8 + h) * 8 + blk) * 64 + I_.tid] = s * (1.f / 256.f); }
        __syncthreads();
    }
    const int gw = F.vcu * NWAVES + I_.wave, NGW = F.G * NWAVES;
    const f32x4 gq = ((const f32x4*)P.in[I_QLATN])[I_.lane]; const f32x2 gk = ((const f32x2*)P.in[I_KVLATN])[I_.lane];
    for (int m0 = gw * 8; m0 < NTOK; m0 += NGW * 8) {
        u32x2 wq[8]; unsigned wk[8];
#pragma unroll
        for (int q = 0; q < 8; ++q) { wq[q] = *((const u32x2*)(PROJ + (size_t)(m0 + q) * DINP + PC_CQ) + I_.lane); wk[q] = *((const unsigned*)(PROJ + (size_t)(m0 + q) * DINP + PC_CKV) + I_.lane); }
#pragma unroll
        for (int r = 0; r < 8; ++r) { const int m = m0 + r;
            const f32x4 q = {bflo(wq[r].x), bfhi(wq[r].x), bflo(wq[r].y), bfhi(wq[r].y)}; const f32x2 k = {bflo(wk[r]), bfhi(wk[r])};
            const float sq = wave_sum((q.x * q.x + q.y * q.y) + (q.z * q.z + q.w * q.w)), sk = wave_sum(k.x * k.x + k.y * k.y);
            const float rq = 1.0f / sqrtf(sq * (1.f / 256.f) + EPS), rk = 1.0f / sqrtf(sk * (1.f / 128.f) + EPS);
            const f32x4 yq = q * rq * gq; const f32x2 yk = k * rk * gk;
            *((u32x2*)((bf16_t*)(ws + WS_CQN) + (size_t)m * 256) + I_.lane) = (u32x2){cvt_pk_bf16(yq.x, yq.y), cvt_pk_bf16(yq.z, yq.w)};
            *((unsigned*)((bf16_t*)(ws + WS_CKVN) + (size_t)m * 128) + I_.lane) = cvt_pk_bf16(yk.x, yk.y); }
    }
}

__device__ __forceinline__ void phase4(Frame& F) {
    PHASE_IDS();
    const Params& P = *F.P; unsigned char* ws = F.ws;
    const bf16_t* PROJ = (const bf16_t*)(ws + WS_PROJ);
    const float* cosB = (const float*)(ws + WS_ROPE) + 131072; const float* sinB = cosB + 32768;
    const int gw = F.vcu * NWAVES + I_.wave, NGW = F.G * NWAVES;
    for (int it = gw; it < (NTOK / 64) * 16; it += NGW) {
        const int h = it & 7, sel = (it >> 3) & 1, rg = it >> 4; const size_t row = (size_t)rg * 64 + I_.lane; const int pos = (int)(row & (SEQ - 1));
        u32x4 raw[12];
        bf16_t* qrow = (bf16_t*)(ws + WS_QB) + row * 768 + h * 96;
        if (sel == 0) {
#pragma unroll
            for (int c = 0; c < 12; ++c) raw[c] = *(const u32x4*)(qrow + 8 * c);
        } else {
            const bf16_t* kn = (const bf16_t*)(ws + WS_KV) + row * 1024 + h * 128; const bf16_t* kp = PROJ + row * DINP + PC_KPE;
#pragma unroll
            for (int c = 0; c < 8; ++c) raw[c] = *(const u32x4*)(kn + 8 * c);
#pragma unroll
            for (int c = 0; c < 4; ++c) raw[8 + c] = *(const u32x4*)(kp + 8 * c);
        }
        float ss = 0.f;
#pragma unroll
        for (int c = 0; c < 12; ++c) { f32x4 a0, a1; pg8::unpack8(raw[c], a0, a1); ss += (a0[0] * a0[0] + a0[1] * a0[1]) + (a0[2] * a0[2] + a0[3] * a0[3]) + (a1[0] * a1[0] + a1[1] * a1[1]) + (a1[2] * a1[2] + a1[3] * a1[3]); }
        const float rstd = 1.0f / sqrtf(ss * (1.f / 96.f) + EPS);
        const float* gn = sel ? P.in[I_MLAKN] : P.in[I_MLAQN];
        const float sc = sel ? 1.0f : C2B; const float rs = rstd * sc;
        bf16_t* dst = sel ? (bf16_t*)(ws + WS_KB2) + row * 768 + h * 96 : qrow;
#pragma unroll
        for (int c = 0; c < 8; ++c) { f32x4 a0, a1; pg8::unpack8(raw[c], a0, a1); const f32x4 g0 = *(const f32x4*)(gn + 8 * c), g1 = *(const f32x4*)(gn + 8 * c + 4);
            *(u32x4*)(dst + 8 * c) = pg8::pack8(a0 * g0 * rs, a1 * g1 * rs); }
#pragma unroll
        for (int c = 0; c < 2; ++c) { f32x4 x1a, x1b, x2a, x2b; pg8::unpack8(raw[8 + c], x1a, x1b); pg8::unpack8(raw[10 + c], x2a, x2b);
            const f32x4 g1a = *(const f32x4*)(gn + 64 + 8 * c), g1b = *(const f32x4*)(gn + 68 + 8 * c), g2a = *(const f32x4*)(gn + 80 + 8 * c), g2b = *(const f32x4*)(gn + 84 + 8 * c);
            x1a = x1a * g1a * rs; x1b = x1b * g1b * rs; x2a = x2a * g2a * rs; x2b = x2b * g2b * rs;
            const f32x4 ca = *(const f32x4*)(cosB + pos * 16 + 8 * c), cb = *(const f32x4*)(cosB + pos * 16 + 8 * c + 4), sa = *(const f32x4*)(sinB + pos * 16 + 8 * c), sb = *(const f32x4*)(sinB + pos * 16 + 8 * c + 4);
            *(u32x4*)(dst + 64 + 8 * c) = pg8::pack8(x1a * ca - x2a * sa, x1b * cb - x2b * sb);
            *(u32x4*)(dst + 80 + 8 * c) = pg8::pack8(x2a * ca + x1a * sa, x2b * cb + x1b * sb); }
    }
}

__device__ __forceinline__ void phase5(Frame& F) {
    unsigned char* ws = F.ws;
    for (int it = F.vcu; it < 256; it += F.G) {
        const int bh = it >> 2, sidx = it & 3, b = bh >> 3, h = bh & 7;
#pragma unroll 1
        for (int k = 0; k < 2; ++k) { const int qb = k ? 7 - sidx : sidx;
            att::attn_unit<64, true>(b, qb, (const bf16_t*)(ws + WS_QA2) + h * 64, 512, (const bf16_t*)(ws + WS_KA2) + h * 64, 512, (const bf16_t*)(ws + WS_PROJ) + PC_VA + h * 64, DINP,
                                     ws + WS_Y + h * 64, 1024, (const float*)(ws + WS_KMEAN) + (size_t)bh * 512, F.lds, F.wave); }
#pragma unroll 1
        for (int k = 0; k < 2; ++k) { const int qb = k ? 7 - sidx : sidx;
            att::attn_unit<96, false>(b, qb, (const bf16_t*)(ws + WS_QB) + h * 96, 768, (const bf16_t*)(ws + WS_KB2) + h * 96, 768, (const bf16_t*)(ws + WS_KV) + h * 128 + 64, 1024,
                                      ws + WS_Y + 512 + h * 64, 1024, nullptr, F.lds, F.wave); }
    }
}

__device__ __forceinline__ void phase8(Frame& F) {
    PHASE_IDS();
    const Params& P = *F.P; unsigned char* ws = F.ws;
    constexpr int HCS = 132, WCS = 48;
    LAS float* HC = (LAS float*)F.lds;
    LAS float* WC = HC + 2 * 64 * HCS;
    LAS float* RSTD = WC + 2 * 128 * WCS;
    LAS float* LOGIT = RSTD + 64;
    LAS int* pe = (LAS int*)(LOGIT + 64 * 33);
    int* PAIR_E = (int*)(ws + WS_PAIR); int* PAIR_RANK = PAIR_E + 65536; float* PAIR_W = (float*)(PAIR_E + 131072);
    const float* gffn = P.in[I_GFFN]; const float* wr_ = P.in[I_WR]; const float* br_ = P.in[I_BR];
    const int r0 = F.vcu * 64;
    if (I_.tid < 64) { const f32x4* sp = (const f32x4*)((const float*)(ws + WS_SSP) + (size_t)(r0 + I_.tid) * 16); const f32x4 a = sp[0], b = sp[1], c = sp[2], d = sp[3];
        const float ss = (((a[0] + a[1]) + (a[2] + a[3])) + ((b[0] + b[1]) + (b[2] + b[3]))) + (((c[0] + c[1]) + (c[2] + c[3])) + ((d[0] + d[1]) + (d[2] + d[3])));
        RSTD[I_.tid] = 1.0f / sqrtf(ss * (1.f / DM) + EPS); }
    __syncthreads();
    const int eg = I_.wave & 1, rgp = I_.wave >> 1, l15 = I_.lane & 15, l4 = I_.lane >> 4;
    const int srow = I_.tid >> 5, sc4 = I_.tid & 31;
    const int wrow = I_.tid >> 3, wc4 = I_.tid & 7;
    f32x4 stg[4], wst[2];
#define P8_LOAD(kc) do { _Pragma("unroll") for (int i = 0; i < 4; ++i) { const u32x2 w_ = *(const u32x2*)((const bf16_t*)(ws + WS_X1B) + (size_t)(r0 + srow + 16 * i) * DM + (kc) * 128 + 4 * sc4); stg[i] = (f32x4){bflo(w_.x), bfhi(w_.x), bflo(w_.y), bfhi(w_.y)}; } \
        _Pragma("unroll") for (int i = 0; i < 2; ++i) wst[i] = *(const f32x4*)(wr_ + (size_t)((kc) * 128 + wrow + 64 * i) * 32 + 4 * wc4); } while (0)
#define P8_STORE(kc, buf) do { const f32x4 g4 = *(const f32x4*)(gffn + (kc) * 128 + 4 * sc4); _Pragma("unroll") for (int i = 0; i < 4; ++i) { const float rs = RSTD[srow + 16 * i]; const f32x4 y = stg[i] * rs * g4; \
        *(LAS f32x4*)(HC + ((buf) * 64 + srow + 16 * i) * HCS + 4 * sc4) = y; *(unsigned*)(ws + WS_HNF8 + (size_t)(r0 + srow + 16 * i) * DM + (kc) * 128 + 4 * sc4) = pack4_fp8(y.x, y.y, y.z, y.w); } \
        _Pragma("unroll") for (int i = 0; i < 2; ++i) *(LAS f32x4*)(WC + ((buf) * 128 + wrow + 64 * i) * WCS + 4 * wc4) = wst[i]; } while (0)
    P8_LOAD(0); P8_STORE(0, 0);
    __syncthreads();
    f32x4 acc = {0.f, 0.f, 0.f, 0.f};
#pragma unroll 1
    for (int kc = 0; kc < 8; ++kc) { const int buf = kc & 1;
        if (kc + 1 < 8) P8_LOAD(kc + 1);
        const LAS float* wp = WC + (buf * 128 + l4) * WCS + eg * 16 + l15;
        const LAS float* hp = HC + (buf * 64 + rgp * 16 + l15) * HCS + l4;
#pragma unroll
        for (int kk = 0; kk < 32; ++kk) acc = __builtin_amdgcn_mfma_f32_16x16x4f32(wp[4 * kk * WCS], hp[4 * kk], acc, 0, 0, 0);
        if (kc + 1 < 8) P8_STORE(kc + 1, buf ^ 1);
        __syncthreads(); }
#undef P8_LOAD
#undef P8_STORE
#pragma unroll
    for (int i = 0; i < 4; ++i) { const int e = eg * 16 + 4 * l4 + i; LOGIT[(rgp * 16 + l15) * 33 + e] = acc[i] + br_[e]; }
    __syncthreads();
    if (I_.tid < 64) { const int rr = I_.tid, m = r0 + rr;
        float lg[32];
#pragma unroll
        for (int e = 0; e < 32; ++e) lg[e] = LOGIT[rr * 33 + e];
        int te[4]; float tv[4]; unsigned used = 0u;
#pragma unroll
        for (int k = 0; k < 4; ++k) { float best = -INFINITY; int bi = 0;
#pragma unroll
            for (int e = 0; e < 32; ++e) { const bool ok = !((used >> e) & 1u) && (lg[e] > best); best = ok ? lg[e] : best; bi = ok ? e : bi; }
            used |= 1u << bi; te[k] = bi; tv[k] = best; }
        const float e0 = 1.0f, e1 = __expf(tv[1] - tv[0]), e2 = __expf(tv[2] - tv[0]), e3 = __expf(tv[3] - tv[0]); const float inv = 1.0f / (e0 + e1 + e2 + e3);
        *(i32x4*)(PAIR_E + m * 4) = (i32x4){te[0], te[1], te[2], te[3]};
        *(f32x4*)(PAIR_W + m * 4) = (f32x4){e0 * inv, e1 * inv, e2 * inv, e3 * inv};
        *(LAS i32x4*)(pe + rr * 4) = (i32x4){te[0], te[1], te[2], te[3]}; }
    __syncthreads();
    if (I_.tid < 256) { const int e = pe[I_.tid]; int rank = 0;
#pragma unroll 16
        for (int j4 = 0; j4 < 64; ++j4) { const i32x4 v = *(const LAS i32x4*)(pe + 4 * j4); const int j = 4 * j4;
            rank += ((j < I_.tid) && v.x == e) + ((j + 1 < I_.tid) && v.y == e) + ((j + 2 < I_.tid) && v.z == e) + ((j + 3 < I_.tid) && v.w == e); }
        PAIR_RANK[r0 * 4 + I_.tid] = rank; }
    else if (I_.tid < 288) { const int e = I_.tid - 256; int c = 0;
#pragma unroll 16
        for (int j4 = 0; j4 < 64; ++j4) { const i32x4 v = *(const LAS i32x4*)(pe + 4 * j4); c += (v.x == e) + (v.y == e) + (v.z == e) + (v.w == e); }
        ((int*)(ws + WS_HIST))[F.vcu * 32 + e] = c; }
    __syncthreads();
}

__device__ __forceinline__ int moe_layout(Frame& F) {
    PHASE_IDS();
    LAS int* ctl = (LAS int*)(F.lds + LDS_CTL);
    LAS int* part = ctl + 512;
    const int* HIST = (const int*)(F.ws + WS_HIST);
    __syncthreads();
    { const int e = I_.tid & 31, pt = I_.tid >> 5; int tot = 0, before = 0; int c[16];
#pragma unroll
        for (int i = 0; i < 16; ++i) c[i] = HIST[(pt * 16 + i) * 32 + e];
#pragma unroll
        for (int i = 0; i < 16; ++i) { tot += c[i]; before += (pt * 16 + i < F.vcu) ? c[i] : 0; }
        part[pt * 64 + e] = tot; part[pt * 64 + 32 + e] = before; }
    __syncthreads();
    if (I_.tid < 32) { int tot = 0, before = 0;
#pragma unroll
        for (int pt = 0; pt < 16; ++pt) { tot += part[pt * 64 + I_.tid]; before += part[pt * 64 + 32 + I_.tid]; }
        ctl[I_.tid] = tot; ctl[65 + I_.tid] = before; }
    __syncthreads();
    if (I_.tid < 32) { const int e = I_.tid; const int nt_ = (ctl[e] + 255) >> 8; int sc = nt_;
#pragma unroll
        for (int o = 1; o < 32; o <<= 1) { const int up = __shfl_up(sc, o); sc += (e >= o) ? up : 0; }
        const int t0 = sc - nt_; ctl[32 + e] = t0 * 256; ctl[65 + e] += t0 * 256;
        for (int t = 0; t < nt_; ++t) ctl[128 + t0 + t] = e;
        if (e == 31) { ctl[64] = sc * 256; ctl[100] = sc; } }
    __syncthreads();
    return ctl[100];
}

__device__ __forceinline__ void phase9(Frame& F) {
    PHASE_IDS();
    unsigned char* ws = F.ws;
    moe_layout(F);
    LAS int* ctl = (LAS int*)(F.lds + LDS_CTL);
    const int* PAIR_E = (const int*)(ws + WS_PAIR); const int* PAIR_RANK = PAIR_E + 65536; int* ROWDEST = (int*)(ws + WS_PAIR) + 196608; int* TOK = (int*)(ws + WS_TOK);
    const int rows_per_blk = NTOK / F.G;
    if (I_.tid < rows_per_blk * 4) { const int gp = F.vcu * rows_per_blk * 4 + I_.tid;
        const int e = PAIR_E[gp], rk = PAIR_RANK[gp]; const int dest = ctl[65 + e] + rk;
        ROWDEST[gp] = dest; TOK[dest] = gp >> 2; }
    if (F.vcu < 32) { const int e = F.vcu; const int lo = ctl[32 + e] + ctl[e], hi = (e == 31) ? ctl[64] : ctl[33 + e];
        for (int r = lo + I_.tid; r < hi; r += NTHREADS) TOK[r] = 0; }
}

__device__ __forceinline__ void stage_tok(Frame& F, int nmt, int ntn) {
    PHASE_IDS();
    const int* TOK = (const int*)(F.ws + WS_TOK); LAS unsigned short* tokl = (LAS unsigned short*)(F.lds + LDS_TOKL);
    for (int i = 0; i < 10; ++i) { const int j = (i * F.G + (int)blockIdx.x) >> 3; const int mt = (j / ntn) * 8 + ((int)blockIdx.x & 7); if (mt >= nmt) break;
        if (I_.tid < 256) tokl[i * 256 + I_.tid] = (unsigned short)TOK[mt * 256 + I_.tid]; }
    __syncthreads();
}

__device__ __forceinline__ void phase12(Frame& F) {
    PHASE_IDS();
    const Params& P = *F.P; unsigned char* ws = F.ws;
    const int gw = F.vcu * NWAVES + I_.wave, NGW = F.G * NWAVES;
    const float* PAIR_W = (const float*)(ws + WS_PAIR) + 131072; const int* ROWDEST = (const int*)(ws + WS_PAIR) + 196608;
    const bf16_t* YP = (const bf16_t*)(ws + WS_XG);
    const f32x4* gp = (const f32x4*)P.in[I_GPLE] + I_.lane; f32x4 gv[4];
#pragma unroll
    for (int j = 0; j < 4; ++j) gv[j] = gp[64 * j];
    for (int m0 = gw; m0 < NTOK; m0 += 2 * NGW) {
        int mm[2]; mm[0] = m0; mm[1] = (m0 + NGW < NTOK) ? m0 + NGW : m0;
        f32x4 wv[2]; i32x4 dv[2];
#pragma unroll
        for (int q = 0; q < 2; ++q) { wv[q] = *(const f32x4*)(PAIR_W + mm[q] * 4); dv[q] = *(const i32x4*)(ROWDEST + mm[q] * 4); }
        f32x4 v[2][4]; u32x2 y[2][4][4];
#pragma unroll
        for (int q = 0; q < 2; ++q) { const u32x2* xr = (const u32x2*)((const bf16_t*)(ws + WS_X1B) + (size_t)mm[q] * DM) + I_.lane;
#pragma unroll
            for (int j = 0; j < 4; ++j) { const u32x2 w_ = xr[64 * j]; v[q][j] = (f32x4){bflo(w_.x), bfhi(w_.x), bflo(w_.y), bfhi(w_.y)}; }
#pragma unroll
            for (int k = 0; k < 4; ++k) { const u32x2* yr = (const u32x2*)(YP + (size_t)dv[q][k] * DM) + I_.lane;
#pragma unroll
                for (int j = 0; j < 4; ++j) y[q][k][j] = yr[64 * j]; } }
#pragma unroll
        for (int q = 0; q < 2; ++q) { if (q == 1 && mm[1] == mm[0]) break;
            float s = 0.f; u32x2* xw = (u32x2*)((bf16_t*)(ws + WS_X1B) + (size_t)mm[q] * DM) + I_.lane;
#pragma unroll
            for (int j = 0; j < 4; ++j) {
#pragma unroll
                for (int k = 0; k < 4; ++k) { const u32x2 yy = y[q][k][j]; v[q][j] += (f32x4){bflo(yy.x), bfhi(yy.x), bflo(yy.y), bfhi(yy.y)} * wv[q][k]; }
                xw[64 * j] = (u32x2){cvt_pk_bf16(v[q][j].x, v[q][j].y), cvt_pk_bf16(v[q][j].z, v[q][j].w)}; s += (v[q][j].x * v[q][j].x + v[q][j].y * v[q][j].y) + (v[q][j].z * v[q][j].z + v[q][j].w * v[q][j].w); }
            const float rstd = 1.0f / sqrtf(wave_sum(s) * (1.f / DM) + EPS);
            unsigned* o4 = (unsigned*)(ws + WS_HNF8 + (size_t)mm[q] * DM) + I_.lane;
#pragma unroll
            for (int j = 0; j < 4; ++j) { const f32x4 yo = v[q][j] * rstd * gv[j]; o4[64 * j] = pack4_fp8(yo.x, yo.y, yo.z, yo.w); } }
    }
}

__global__ void __launch_bounds__(NTHREADS, 2) fwd(Params prm) {
    extern __shared__ __attribute__((aligned(16))) unsigned char lds_raw[];
    Frame F;
    F.lds = (LAS unsigned char*)lds_raw;
    F.wave = __builtin_amdgcn_readfirstlane((int)threadIdx.x >> 6);
    if (threadIdx.x < 2) ((volatile LAS unsigned*)(F.lds + LDS_BARST))[threadIdx.x] = 0u;
    const XcdBarrier bar = xcd_barrier_post((unsigned*)(prm.ws + WS_BAR), (volatile LAS unsigned*)(F.lds + LDS_BARST), F.wave);
    if (prm.ph_lo < 0) cg::this_grid().sync();
    __syncthreads();
    F.G = gridDim.x; { const int bx = blockIdx.x; F.vcu = (F.G % 8 == 0) ? (bx % 8) * (F.G / 8) + bx / 8 : bx; }
    F.P = &prm; F.ws = prm.ws;
    unsigned char* ws = prm.ws;
    const int lo = prm.ph_lo, hi = prm.ph_hi;
#ifndef PH_MASK
#define PH_MASK 0xffffu
#endif
#ifndef REP_MASK
#define REP_MASK 0u
#endif
#define IN(k) (((PH_MASK >> (k)) & 1u) && lo <= (k) && (k) < hi)
#define REPS(k) for (int rep_ = 0; rep_ < (((REP_MASK >> (k)) & 1u) ? 2 : 1); ++rep_, (((REP_MASK >> (k)) & 1u) && rep_ < 2 ? xcd_barrier(bar) : (void)0))
#define SEAM(k) do { __builtin_amdgcn_sched_barrier(0); asm volatile("" ::: "memory"); if (IN(k) && IN((k) + 1)) xcd_barrier(bar); STAMP((k) + 1); __builtin_amdgcn_sched_barrier(0); asm volatile("" ::: "memory"); } while (0)
    using namespace pg8;
    STAMP(0);
    if (IN(0)) REPS(0) phase0(F);
    SEAM(0);
    if (IN(1)) REPS(1) {
        { Gemm g{(const bf16_t*)(ws + WS_HNF8), (const bf16_t*)(ws + WS_WIN), 512, 512, 512}; StaticOrder S; S.init(NTOK, 2048, F.G, (int)blockIdx.x);
          const float* cosA_ = (const float*)(ws + WS_ROPE);
          EpiProj E{(bf16_t*)(ws + WS_PROJ), (bf16_t*)(ws + WS_QA2), (bf16_t*)(ws + WS_KA2), (float*)(ws + WS_KMEAN), (bf16_t*)(ws + WS_CQN), (bf16_t*)(ws + WS_CKVN),
                    prm.in[I_MQN], prm.in[I_MKN], prm.in[I_QLATN], prm.in[I_KVLATN], cosA_, cosA_ + 65536, (LAS float*)(F.lds + LDS_TOKL), (float*)(ws + WS_KPESS)};
          gemm_phase<EpiProj, StaticOrder, false, true>(F.lds, F.wave, g, S, E); }
        __builtin_amdgcn_sched_barrier(0); asm volatile("" ::: "memory");
        { Gemm g{(const bf16_t*)(ws + WS_HNF8), (const bf16_t*)(ws + WS_WINF8), 512, 512, 512}; StaticOrder S; S.init(NTOK, 2048, F.G, (int)blockIdx.x);
          EpiStore E{(bf16_t*)(ws + WS_PROJ) + PC_GA, DINP, nullptr, 0, 0}; gemm_phase<EpiStore, StaticOrder, false, true>(F.lds, F.wave, g, S, E); } }
    SEAM(1);
    if (IN(3)) REPS(3) {
        const float* cosB_ = (const float*)(ws + WS_ROPE) + 131072;
        { Gemm g{(const bf16_t*)(ws + WS_CQN), (const bf16_t*)(ws + WS_WUQ), 256, 256, 256}; StaticOrder S; S.init(NTOK, 1024, F.G, (int)blockIdx.x);
          EpiQB E{(bf16_t*)(ws + WS_QB), prm.in[I_MLAQN], cosB_, cosB_ + 32768, (LAS float*)(F.lds + LDS_CTL)}; gemm_phase(F.lds, F.wave, g, S, E); }
        __builtin_amdgcn_sched_barrier(0); asm volatile("" ::: "memory");
        { Gemm g{(const bf16_t*)(ws + WS_CKVN), (const bf16_t*)(ws + WS_WUKV), 128, 128, 128}; StaticOrder S; S.init(NTOK, 1024, F.G, (int)blockIdx.x);
          EpiKV E{(bf16_t*)(ws + WS_KB2), (bf16_t*)(ws + WS_KV), (const bf16_t*)(ws + WS_PROJ), (const float*)(ws + WS_KPESS), prm.in[I_MLAKN], cosB_, cosB_ + 32768, (LAS float*)(F.lds + LDS_CTL)};
          gemm_phase(F.lds, F.wave, g, S, E); } }
    SEAM(3);
    if (IN(5)) REPS(5) phase5(F);
    SEAM(5);
    if (IN(6)) REPS(6) { Gemm g{(const bf16_t*)(ws + WS_Y), (const bf16_t*)(ws + WS_WA), 512, 256, 256}; BranchOrder S; S.so.init(NTOK, DM, F.G, (int)blockIdx.x);
        EpiGateAB E{(bf16_t*)(ws + WS_MERGED), (const bf16_t*)(ws + WS_PROJ) + PC_GA, (const bf16_t*)(ws + WS_PROJ) + PC_GB, DINP, ws + WS_KA2  };
        gemm_phase<EpiGateAB, BranchOrder, false, true>(F.lds, F.wave, g, S, E); }
    SEAM(7);
    if (IN(8)) REPS(8) { Gemm g{(const bf16_t*)(ws + WS_KA2), (const bf16_t*)(ws + WS_WO), 512, 512, 512}; StaticOrder S; S.init(NTOK, DM, F.G, (int)blockIdx.x);
        EpiResF32 E{prm.in[I_X], (bf16_t*)(ws + WS_X1B), (float*)(ws + WS_SSP)}; gemm_phase<EpiResF32, StaticOrder, false, true>(F.lds, F.wave, g, S, E); }
    SEAM(8);
    if (IN(9)) REPS(9) phase8(F);
    SEAM(9);
    if (IN(10)) REPS(10) phase9(F);
    SEAM(10);
    if (IN(11)) REPS(11) { const int nmt = ((const LAS int*)(F.lds + LDS_CTL))[100]; stage_tok(F, nmt, 8);
        Gemm g{(const bf16_t*)(ws + WS_HNF8), (const bf16_t*)(ws + WS_W1), 512, 512, 512}; MoeOrder S{(const LAS int*)(F.lds + LDS_CTL) + 128, nmt, 8, F.G, (int)blockIdx.x};
        EpiSwiglu E{ws + WS_ACT, prm.in[I_BGU]}; gemm_phase<EpiSwiglu, MoeOrder, true, true>(F.lds, F.wave, g, S, E, (const LAS unsigned short*)(F.lds + LDS_TOKL)); }
    SEAM(11);
    if (IN(12)) REPS(12) { const int nmt = ((const LAS int*)(F.lds + LDS_CTL))[100];
        Gemm g{(const bf16_t*)(ws + WS_ACT), (const bf16_t*)(ws + WS_W2), 512, 512, 512}; MoeOrder S{(const LAS int*)(F.lds + LDS_CTL) + 128, nmt, 4, F.G, (int)blockIdx.x};
        EpiStore E{(bf16_t*)(ws + WS_XG), DM, prm.in[I_BD], 1024, 1 << 30}; gemm_phase<EpiStore, MoeOrder, false, true>(F.lds, F.wave, g, S, E); }
    SEAM(12);
    if (IN(13)) REPS(13) phase12(F);
    SEAM(13);
    if (IN(14)) REPS(14) { Gemm g{(const bf16_t*)(ws + WS_PB), (const bf16_t*)(ws + WS_WPP), 256, 256, 256}; StaticOrder S; S.init(NTOK, DM, F.G, (int)blockIdx.x);
        EpiStore E{(bf16_t*)(ws + WS_PP), DM, nullptr, 0, 1 << 30}; gemm_phase(F.lds, F.wave, g, S, E); }
    __builtin_amdgcn_sched_barrier(0); asm volatile("s_waitcnt vmcnt(0)" ::: "memory"); __syncthreads();
    if (IN(15)) REPS(15) { Gemm g{(const bf16_t*)(ws + WS_HNF8), (const bf16_t*)(ws + WS_WPG), 512, 512, 512}; StaticOrder S; S.init(NTOK, DM, F.G, (int)blockIdx.x);
        EpiFinal E{prm.out, (const bf16_t*)(ws + WS_PP), (const bf16_t*)(ws + WS_X1B)}; gemm_phase<EpiFinal, StaticOrder, false, true>(F.lds, F.wave, g, S, E); }
#ifdef TPROBE_A
    STAMP(16);
    xcd_barrier(bar);
    if (blockIdx.x == 0 && F.wave == 0 && lane_id() == 0) {
        volatile unsigned long long* ts = (volatile unsigned long long*)(ws + WS_ERR);
        const unsigned long long da = ts[TPROBE_A1] - ts[TPROBE_A], db = ts[TPROBE_B1] - ts[TPROBE_B];
        asm volatile("s_waitcnt vmcnt(0)" ::: "memory");
        prm.out[0] += (float)db * (0.01f / 4.0f);
        const unsigned long long t0 = __builtin_amdgcn_s_memrealtime();
        while (__builtin_amdgcn_s_memrealtime() - t0 < 4ull * da) __builtin_amdgcn_s_sleep(4);
    }
#endif
#undef IN
#undef SEAM
}

extern "C" void kernel_launch(void* const* d_in, const int* in_sizes, int n_in, void* d_out, int out_size, void* d_ws, size_t ws_size, hipStream_t stream) {
    static int grid = 0;
    if (grid == 0) {
        int dev = 0, cus = 0, per_cu = 0;
        (void)hipGetDevice(&dev);
        (void)hipDeviceGetAttribute(&cus, hipDeviceAttributeMultiprocessorCount, dev);
        (void)hipFuncSetAttribute((const void*)fwd, hipFuncAttributeMaxDynamicSharedMemorySize, LDS_BYTES);
        (void)hipOccupancyMaxActiveBlocksPerMultiprocessor(&per_cu, (const void*)fwd, NTHREADS, LDS_BYTES);
        fprintf(stderr, "cus %d per_cu %d ws %zu n_in %d\n", cus, per_cu, ws_size, n_in);
        grid = (per_cu >= 1) ? cus : -1;
        if (grid != 256 || n_in != 25 || ws_size < WS_END || out_size != NTOK * DM) { fprintf(stderr, "kernel_launch: unsupported configuration\n"); grid = -1; }
    }
    if (grid < 0) return;
    (void)hipMemsetAsync((char*)d_ws + WS_BAR, 0, WS_BAR_BYTES, stream);
    Params a{};
    for (int i = 0; i < 25; ++i) a.in[i] = (const float*)d_in[i];
    a.out = (float*)d_out; a.ws = (unsigned char*)d_ws;
#ifndef MULTI_LAUNCH
    a.ph_lo = 0; a.ph_hi = NPHASE;
    void* args[] = {&a};
    hipError_t e = hipLaunchCooperativeKernel((const void*)fwd, dim3(grid), dim3(NTHREADS), args, LDS_BYTES, stream);
    if (e != hipSuccess) fprintf(stderr, "cooperative launch failed: %s\n", hipGetErrorString(e));
#else
    for (int k = 0; k < NPHASE; ++k) { a.ph_lo = k; a.ph_hi = k + 1; void* args[] = {&a};
        hipError_t e = hipLaunchCooperativeKernel((const void*)fwd, dim3(grid), dim3(NTHREADS), args, LDS_BYTES, stream);
        if (e != hipSuccess) fprintf(stderr, "launch %d failed: %s\n", k, hipGetErrorString(e)); }
#endif
}
```

```cpp
#include <hip/hip_runtime.h>
#include <hip/hip_cooperative_groups.h>
#include <cstdio>
#include <cstdint>
namespace cg = cooperative_groups;

#define LAS __attribute__((address_space(3)))
typedef unsigned short bf16_t;
typedef short bf16x8 __attribute__((ext_vector_type(8)));
typedef short s16x4 __attribute__((ext_vector_type(4)));
typedef float f32x4 __attribute__((ext_vector_type(4)));
typedef float f32x2 __attribute__((ext_vector_type(2)));
typedef float f32x16 __attribute__((ext_vector_type(16)));
typedef unsigned u32x4 __attribute__((ext_vector_type(4)));
typedef unsigned u32x2 __attribute__((ext_vector_type(2)));
typedef int i32x4 __attribute__((ext_vector_type(4)));
typedef int i32x8 __attribute__((ext_vector_type(8)));
typedef __bf16 bf16x2_t __attribute__((ext_vector_type(2)));

constexpr int NB = 8, SEQ = 2048, NTOK = NB * SEQ, DM = 1024;
constexpr int DIN = 4000, DINP = 4096;
constexpr int NEXP = 32, TOPK = 4, DEXP = 1024;
constexpr int NTHREADS = 512, NWAVES = 8;
constexpr float EPS = 1e-6f;
constexpr float LOG2E = 1.4426950408889634f;
constexpr float C2A = 0.125f * LOG2E;
constexpr float C2B = 0.10206207261596575f * LOG2E;
constexpr int PC_QA = 0, PC_KA = 512, PC_VA = 1024, PC_CQ = 1536, PC_CKV = 1792, PC_KPE = 1920, PC_GA = 2048, PC_GB = 3072;

constexpr size_t MiB = 1u << 20;
constexpr size_t WS_HIST = 0;
constexpr size_t WS_ERR = 64 * 1024;
constexpr size_t WS_BAR = 128 * 1024;
constexpr size_t WS_BAR_BYTES = 16 * 1024;
constexpr size_t WS_KPESS = 576 * 1024;
constexpr size_t WS_TOK = 256 * 1024;
constexpr size_t WS_ROPE = 1 * MiB;
constexpr size_t WS_KMEAN = 2 * MiB;
constexpr size_t WS_SSP = 11 * MiB;
constexpr size_t WS_PAIR = 3 * MiB;
constexpr size_t WS_WUQ = 4 * MiB, WS_WUKV = 4 * MiB + 512 * 1024, WS_WPP = 5 * MiB, WS_WA = 6 * MiB, WS_WB = 7 * MiB, WS_WO = 8 * MiB, WS_WPG = 10 * MiB, WS_WIN = 12 * MiB;
constexpr size_t WS_W1 = 20 * MiB, WS_W2 = 148 * MiB;
constexpr size_t WS_WINF8 = 16 * MiB;
constexpr size_t WS_HNF8 = 84 * MiB;
constexpr size_t WS_HN = 212 * MiB, WS_PB = 244 * MiB;
constexpr size_t WS_X1B = WS_HN;
constexpr size_t WS_CQN = 252 * MiB, WS_CKVN = 260 * MiB, WS_QB = 264 * MiB, WS_KV = 288 * MiB, WS_KB2 = 320 * MiB, WS_Y = 344 * MiB, WS_MERGED = 376 * MiB;
constexpr size_t WS_ACT = 252 * MiB;
constexpr size_t WS_PP = 400 * MiB;
constexpr size_t WS_KA2 = 432 * MiB;
constexpr size_t WS_PROJ = 448 * MiB;
constexpr size_t WS_QA2 = 576 * MiB;
constexpr size_t WS_XG = 448 * MiB;
constexpr size_t WS_END = 592 * MiB;
constexpr int MAXROWS = 73728, MAXMT = 288;

constexpr int RING_BYTES = 131072;
constexpr int LDS_CTL = RING_BYTES;
constexpr int LDS_TOKL = RING_BYTES + 8192 + 256;
constexpr int LDS_BARST = RING_BYTES + 8192;
constexpr int LDS_BYTES = 147456;

__device__ __forceinline__ unsigned cvt_pk_bf16(float lo, float hi) { f32x2 v = {lo, hi}; bf16x2_t b = __builtin_convertvector(v, bf16x2_t); return __builtin_bit_cast(unsigned, b); }
__device__ __forceinline__ unsigned pack4_fp8(float a, float b, float c, float d) { int w = 0; w = __builtin_amdgcn_cvt_pk_fp8_f32(a, b, w, false); w = __builtin_amdgcn_cvt_pk_fp8_f32(c, d, w, true); return (unsigned)w; }
__device__ __forceinline__ float bf2f(unsigned short b) { return __uint_as_float(((unsigned)b) << 16); }
__device__ __forceinline__ float bflo(unsigned w) { return __uint_as_float(w << 16); }
__device__ __forceinline__ float bfhi(unsigned w) { return __uint_as_float(w & 0xffff0000u); }
__device__ __forceinline__ float sigmoidf_(float x) { return __builtin_amdgcn_rcpf(1.0f + __builtin_amdgcn_exp2f(-x * LOG2E)); }
__device__ __forceinline__ int lane_id() { return (int)__builtin_amdgcn_mbcnt_hi(~0u, __builtin_amdgcn_mbcnt_lo(~0u, 0u)); }
__device__ __forceinline__ float wave_sum(float v) {
#pragma unroll
    for (int o = 1; o < 64; o <<= 1) v += __shfl_xor(v, o);
    return v;
}

namespace pg8 {
constexpr int BM = 256, BK = 64, HALF = 128, HTB = HALF * BK * 2, STAGE_BYTES = 8 * HTB, NXCD = 8, WGM = 8;
__host__ __device__ __forceinline__ int lds_byte(int r, int c) { const int st = (r >> 4) * 2 + (c >> 5), rr = r & 15, cc = c & 31, ob = rr * 64 + cc * 2; return st * 1024 + (ob ^ (((ob >> 9) & 1) << 5)); }
__host__ __device__ __forceinline__ void stage_rc(int b, int& R, int& C) { const int st = b / 1024, sb = b % 1024, swz = sb ^ (((sb >> 9) & 1) << 5); R = (st >> 1) * 16 + swz / 64; C = (st & 1) * 32 + (swz % 64) / 2; }
__host__ __device__ __forceinline__ int perm32(int rho) { const int n = rho >> 4, i = rho & 15; return 8 * (i >> 2) + 4 * n + (i & 3); }

struct Unit { int pm, pn, pb, e; int aofs = 0; };
struct Gemm { const bf16_t* A; const bf16_t* Bt; int lda, ldb, K; };

struct StaticOrder {
    int nM, nN, nwg, G, c;
    __device__ void init(int M, int N, int G_, int c_) { nM = M / BM; nN = N / BM; nwg = nM * nN; G = G_; c = c_; }
    __device__ bool next(int i, Unit& u) const {
        const long L = (long)i * G + c; if (L >= nwg) return false;
        int wgid = (int)L; { const int q = nwg / NXCD, r = nwg % NXCD, xcd = wgid % NXCD, off = wgid / NXCD; wgid = (xcd < r ? xcd * (q + 1) : r * (q + 1) + (xcd - r) * q) + off; }
        const int nig = WGM * nN, gid = wgid / nig, fm = gid * WGM, gsz = (nM - fm) < WGM ? (nM - fm) : WGM;
        u.pm = fm + ((wgid % nig) % gsz); u.pn = (wgid % nig) / gsz; u.pb = u.pn; u.e = 0; return true;
    }
};
struct MoeOrder {
    const LAS int* tile_e; int nmt, ntn, G, c;
    __device__ bool next(int i, Unit& u) const {
        const int j = (i * G + c) >> 3; const int mt = (j / ntn) * 8 + (c & 7), pn = j % ntn; if (mt >= nmt) return false;
        const int e = __builtin_amdgcn_readfirstlane(tile_e[mt]);
        u.pm = mt; u.pn = pn; u.pb = e * ntn + pn; u.e = e; return true;
    }
};

template <class Epi, class Sched, bool GATHER = false, bool FP8 = false>
__device__ __forceinline__ void gemm_phase(LAS unsigned char* lds, int wave, const Gemm g, const Sched& S, const Epi& E, const LAS unsigned short* tokl = nullptr) {
    constexpr bool ALIGN_EPI = true;
    int lane = lane_id(); asm volatile("" : "+v"(lane));
    const int wid = wave, tid = wid * 64 + lane, wr = wid >> 2, wc = wid & 3, fr = lane & 15, fq = lane >> 4;
    int K = g.K; asm volatile("" : "+s"(K));
    const int nt = K / BK;
    unsigned voffA[2], voffB[2]; int gR[2]; unsigned gC[2];
#pragma unroll
    for (int i = 0; i < 2; ++i) { int R, C; stage_rc(tid * 16 + i * 8192, R, C); const int Rb = (R & ~31) + perm32(R & 31);
        voffA[i] = (unsigned)(R * g.lda + C) * 2u; voffB[i] = (unsigned)(Rb * g.ldb + C) * 2u; gR[i] = R; gC[i] = (unsigned)C * 2u; }
    unsigned goff[2][2], noff[2][2];
#define PG8_GOFF(dst, ui_) do { _Pragma("unroll") for (int h_ = 0; h_ < 2; ++h_) _Pragma("unroll") for (int i_ = 0; i_ < 2; ++i_) \
        dst[h_][i_] = (unsigned)tokl[(ui_) * 256 + h_ * HALF + gR[i_]] * (unsigned)(g.lda * 2) + gC[i_]; } while (0)
    const size_t kstep = (size_t)(BK * 2);
    const size_t hstepA = (size_t)HALF * g.lda * 2, hstepB = (size_t)HALF * g.ldb * 2;
    const size_t tstepA = 2 * hstepA, tstepB = 2 * hstepB;
    const unsigned ldsw = (unsigned)wid * 1024u;
    const int aoff = lds_byte(wr * 64 + fr, fq * 8), boff = lds_byte(wc * 32 + fr, fq * 8);
#define PG8_SA(b, h) (((b) * 2 + (h)) * HTB)
#define PG8_SB(b, h) ((4 + (b) * 2 + (h)) * HTB)
#define PG8_STAGE(bufoff, gbase, voff) do { _Pragma("unroll") for (int _i = 0; _i < 2; ++_i) \
        __builtin_amdgcn_global_load_lds((const unsigned*)((const char*)(gbase) + (voff)[_i]), (LAS unsigned*)(lds + (bufoff) + ldsw + _i * 8192), 16, 0, 0); } while (0)
#define PG8_STAGE_A(bufoff, ptr_ng, k_g, off_g) do { if constexpr (GATHER) { const char* gb_ = (const char*)g.A + (size_t)(k_g) * kstep; PG8_STAGE(bufoff, gb_, off_g); } else { PG8_STAGE(bufoff, ptr_ng, voffA); } } while (0)
#define PG8_LDA(dst, b, h) do { if constexpr (FP8) { _Pragma("unroll") for (int m = 0; m < 4; ++m) { const i32x4 lo_ = *(const LAS i32x4*)(lds + PG8_SA(b, h) + aoff + m * 2048), hi_ = *(const LAS i32x4*)(lds + PG8_SA(b, h) + aoff + m * 2048 + 1024); dst##8[m] = __builtin_shufflevector(lo_, hi_, 0, 1, 2, 3, 4, 5, 6, 7); } } \
        else { _Pragma("unroll") for (int m = 0; m < 4; ++m) _Pragma("unroll") for (int k = 0; k < 2; ++k) dst[m][k] = *(const LAS bf16x8*)(lds + PG8_SA(b, h) + aoff + m * 2048 + k * 1024); } } while (0)
#define PG8_LDB(dst, b, h) do { if constexpr (FP8) { _Pragma("unroll") for (int n = 0; n < 2; ++n) { const i32x4 lo_ = *(const LAS i32x4*)(lds + PG8_SB(b, h) + boff + n * 2048), hi_ = *(const LAS i32x4*)(lds + PG8_SB(b, h) + boff + n * 2048 + 1024); dst##8[n] = __builtin_shufflevector(lo_, hi_, 0, 1, 2, 3, 4, 5, 6, 7); } } \
        else { _Pragma("unroll") for (int n = 0; n < 2; ++n) _Pragma("unroll") for (int k = 0; k < 2; ++k) dst[n][k] = *(const LAS bf16x8*)(lds + PG8_SB(b, h) + boff + n * 2048 + k * 1024); } } while (0)
#define PG8_CAT8(x, y) __builtin_shufflevector(__builtin_bit_cast(i32x4, x), __builtin_bit_cast(i32x4, y), 0, 1, 2, 3, 4, 5, 6, 7)
#define PG8_MMA(ai, bj, At, Bt) do { __builtin_amdgcn_s_setprio(1); if constexpr (FP8) { _Pragma("unroll") for (int m = 0; m < 4; ++m) _Pragma("unroll") for (int n = 0; n < 2; ++n) \
        asm volatile("v_mfma_scale_f32_16x16x128_f8f6f4 %0, %1, %2, %0, %3, %3 op_sel_hi:[0,0,0]" : "+v"(acc[ai][bj][m][n]) : "v"(Bt##8[n]), "v"(At##8[m]), "v"(sc8)); } \
        else { _Pragma("unroll") for (int m = 0; m < 4; ++m) _Pragma("unroll") for (int n = 0; n < 2; ++n) _Pragma("unroll") for (int k = 0; k < 2; ++k) \
        acc[ai][bj][m][n] = __builtin_amdgcn_mfma_f32_16x16x32_bf16(Bt[n][k], At[m][k], acc[ai][bj][m][n], 0, 0, 0); } __builtin_amdgcn_s_setprio(0); } while (0)
#define PG8_WAIT_V(n) asm volatile("s_waitcnt vmcnt(" #n ")" ::: "memory")
#define PG8_WAIT_L(n) asm volatile("s_waitcnt lgkmcnt(" #n ")" ::: "memory")
#define PG8_BAR __builtin_amdgcn_s_barrier()
#define PG8_SCHED __builtin_amdgcn_sched_barrier(0)
    Unit cur, nxt; int ui = 0; typename Epi::Pre pre;
    if (!S.next(0, cur)) return;
    f32x4 acc[2][2][4][2];
#pragma unroll
    for (int a = 0; a < 2; ++a)
#pragma unroll
        for (int b = 0; b < 2; ++b)
#pragma unroll
            for (int m = 0; m < 4; ++m)
#pragma unroll
                for (int n = 0; n < 2; ++n) acc[a][b][m][n] = (f32x4){0.f, 0.f, 0.f, 0.f};
    const int sc8 = 0x7c7c7c7c;
    bf16x8 At[4][2], B0[2][2], B1[2][2]; i32x8 At8[4], B08[2], B18[2];
    const char* cA = (const char*)g.A + (size_t)cur.pm * tstepA + cur.aofs; const char* cB = (const char*)g.Bt + (size_t)cur.pb * tstepB;
    if constexpr (GATHER) { PG8_GOFF(goff, 0); }
    PG8_STAGE(PG8_SB(0, 0), cB, voffB); PG8_STAGE(PG8_SB(0, 1), cB + hstepB, voffB); PG8_STAGE_A(PG8_SA(0, 0), cA, 0, goff[0]); PG8_STAGE_A(PG8_SA(0, 1), cA + hstepA, 0, goff[1]);
    if (wr == 1) PG8_BAR;
    PG8_WAIT_V(2); PG8_BAR;
    PG8_STAGE(PG8_SB(1, 0), cB + kstep, voffB); PG8_STAGE_A(PG8_SA(1, 0), cA + kstep, 1, goff[0]); PG8_STAGE(PG8_SB(1, 1), cB + hstepB + kstep, voffB);
    PG8_WAIT_V(6); PG8_BAR;
    for (;;) {
        const bool has_next = S.next(ui + 1, nxt);
        const char* nA = has_next ? (const char*)g.A + (size_t)nxt.pm * tstepA + nxt.aofs : cA; const char* nB = has_next ? (const char*)g.Bt + (size_t)nxt.pb * tstepB : cB;
        if constexpr (GATHER) { if (has_next) { PG8_GOFF(noff, ui + 1); } else {
#pragma unroll
            for (int h_ = 0; h_ < 2; ++h_)
#pragma unroll
                for (int i_ = 0; i_ < 2; ++i_) noff[h_][i_] = goff[h_][i_]; } }
        for (int t = 0; t < nt; t += 2) {
            const bool last = (t == nt - 2);
            const char* a1 = cA + (size_t)(t + 1) * kstep;
            const char* a2 = last ? nA : cA + (size_t)(t + 2) * kstep; const char* b2 = last ? nB : cB + (size_t)(t + 2) * kstep;
            const char* a3 = a2 + kstep; const char* b3 = b2 + kstep;
            const int k2 = last ? 0 : t + 2;
            unsigned soff[2][2];
            if constexpr (GATHER) {
#pragma unroll
                for (int h_ = 0; h_ < 2; ++h_)
#pragma unroll
                    for (int i_ = 0; i_ < 2; ++i_) soff[h_][i_] = last ? noff[h_][i_] : goff[h_][i_]; }
            PG8_LDB(B0, 0, 0); PG8_LDB(B1, 0, 1); PG8_SCHED; PG8_LDA(At, 0, 0); PG8_STAGE_A(PG8_SA(1, 1), a1 + hstepA, t + 1, goff[1]);
            PG8_WAIT_V(8); PG8_WAIT_L(0); PG8_BAR; PG8_MMA(0, 0, At, B0); PG8_MMA(0, 1, At, B1); PG8_BAR; PG8_SCHED;
            PG8_LDA(At, 0, 1); PG8_STAGE(PG8_SB(0, 0), b2, voffB); PG8_STAGE(PG8_SB(0, 1), b2 + hstepB, voffB); PG8_STAGE_A(PG8_SA(0, 0), a2, k2, soff[0]);
            PG8_WAIT_V(8); PG8_WAIT_L(0); PG8_BAR; PG8_MMA(1, 0, At, B0); PG8_MMA(1, 1, At, B1); PG8_BAR; PG8_SCHED;
            PG8_LDB(B0, 1, 0); PG8_LDB(B1, 1, 1); PG8_SCHED; PG8_LDA(At, 1, 0); PG8_STAGE_A(PG8_SA(0, 1), a2 + hstepA, k2, soff[1]);
            PG8_WAIT_V(8); PG8_WAIT_L(0); PG8_BAR; PG8_MMA(0, 0, At, B0); PG8_MMA(0, 1, At, B1); PG8_BAR; PG8_SCHED;
            if constexpr (Epi::HAS_PRE) { if (last) E.preload(pre, cur, wc, fq); }
            PG8_LDA(At, 1, 1); PG8_STAGE(PG8_SB(1, 0), b3, voffB); PG8_STAGE(PG8_SB(1, 1), b3 + hstepB, voffB); PG8_STAGE_A(PG8_SA(1, 0), a3, k2 + 1, soff[0]);
            PG8_WAIT_V(8); PG8_WAIT_L(0); PG8_BAR; PG8_MMA(1, 0, At, B0); PG8_MMA(1, 1, At, B1); PG8_BAR; PG8_SCHED;
        }
        if constexpr (ALIGN_EPI) { if (wr == 0) PG8_BAR; }
        if constexpr (FP8) asm volatile("s_nop 15\n\ts_nop 15" ::: "memory");
        if constexpr (Epi::HAS_PRE) E(acc, cur, wr, wc, fr, fq, pre); else E(acc, cur, wr, wc, fr, fq);
        if (!has_next) break;
#pragma unroll
        for (int a = 0; a < 2; ++a)
#pragma unroll
            for (int b = 0; b < 2; ++b)
#pragma unroll
                for (int m = 0; m < 4; ++m)
#pragma unroll
                    for (int n = 0; n < 2; ++n) acc[a][b][m][n] = (f32x4){0.f, 0.f, 0.f, 0.f};
        cur = nxt; cA = nA; cB = nB; ++ui;
        if constexpr (GATHER) {
#pragma unroll
            for (int h_ = 0; h_ < 2; ++h_)
#pragma unroll
                for (int i_ = 0; i_ < 2; ++i_) goff[h_][i_] = noff[h_][i_]; }
        if constexpr (ALIGN_EPI) { if (wr == 1) PG8_BAR; }
    }
    PG8_WAIT_V(0);
    if constexpr (!ALIGN_EPI) { if (wr == 0) PG8_BAR; }
    PG8_BAR;
#undef PG8_SA
#undef PG8_SB
#undef PG8_STAGE
#undef PG8_STAGE_A
#undef PG8_GOFF
#undef PG8_LDA
#undef PG8_LDB
#undef PG8_MMA
#undef PG8_CAT8
#undef PG8_WAIT_V
#undef PG8_WAIT_L
#undef PG8_BAR
#undef PG8_SCHED
}

#define EPI_ARGS const f32x4 (&acc)[2][2][4][2], const Unit& u, int wr, int wc, int fr, int fq
#define EPI_NOPRE struct Pre {}; static constexpr bool HAS_PRE = false;
__device__ __forceinline__ u32x4 pack8(f32x4 v0, f32x4 v1) { u32x4 w; w.x = cvt_pk_bf16(v0[0], v0[1]); w.y = cvt_pk_bf16(v0[2], v0[3]); w.z = cvt_pk_bf16(v1[0], v1[1]); w.w = cvt_pk_bf16(v1[2], v1[3]); return w; }
__device__ __forceinline__ void unpack8(u32x4 w, f32x4& v0, f32x4& v1) { v0 = (f32x4){bflo(w.x), bfhi(w.x), bflo(w.y), bfhi(w.y)}; v1 = (f32x4){bflo(w.z), bfhi(w.z), bflo(w.w), bfhi(w.w)}; }
__device__ __forceinline__ f32x4 sig4(f32x4 v) { const f32x4 a = v * (-LOG2E); const f32x4 d = (f32x4){__builtin_amdgcn_exp2f(a[0]), __builtin_amdgcn_exp2f(a[1]), __builtin_amdgcn_exp2f(a[2]), __builtin_amdgcn_exp2f(a[3])} + 1.0f;
    return (f32x4){__builtin_amdgcn_rcpf(d[0]), __builtin_amdgcn_rcpf(d[1]), __builtin_amdgcn_rcpf(d[2]), __builtin_amdgcn_rcpf(d[3])}; }

struct EpiStore { EPI_NOPRE
    bf16_t* O; int ldc; const float* bias; int bias_stride; int sig_from;
    __device__ __forceinline__ void operator()(EPI_ARGS) const {
        const int row0 = u.pm * BM + wr * 64 + fr, col0 = u.pn * BM + wc * 32 + 8 * fq;
        const bool sg = u.pn >= sig_from;
        f32x4 bv[2][2];
#pragma unroll
        for (int bj = 0; bj < 2; ++bj)
#pragma unroll
            for (int n = 0; n < 2; ++n) bv[bj][n] = bias ? *(const f32x4*)(bias + (size_t)u.e * bias_stride + col0 + bj * HALF + 4 * n) : (f32x4){0.f, 0.f, 0.f, 0.f};
#pragma unroll
        for (int ai = 0; ai < 2; ++ai)
#pragma unroll
            for (int m = 0; m < 4; ++m) { bf16_t* rowp = O + (size_t)(row0 + ai * HALF + m * 16) * ldc + col0;
#pragma unroll
                for (int bj = 0; bj < 2; ++bj) { f32x4 v0 = acc[ai][bj][m][0] + bv[bj][0], v1 = acc[ai][bj][m][1] + bv[bj][1];
                    if (sg) { v0 = sig4(v0); v1 = sig4(v1); }
                    *(u32x4*)(rowp + bj * HALF) = pack8(v0, v1); } }
    }
};

struct EpiProj { EPI_NOPRE
    bf16_t* PROJ; bf16_t* QA2; bf16_t* KA2; float* KMEAN; bf16_t* CQN; bf16_t* CKVN;
    const float* gq; const float* gk; const float* glq; const float* glkv; const float* cosA; const float* sinA; LAS float* xch;
    float* KPESS;
    __device__ __forceinline__ void operator()(EPI_ARGS) const {
        const int row0 = u.pm * BM + wr * 64 + fr, col0 = u.pn * BM + wc * 32 + 8 * fq;
        if (u.pn < 4) {
            const bool isk = u.pn >= 2; const int h = 4 * (u.pn & 1) + wc; const float* gn = isk ? gk : gq; const float sc = isk ? 1.0f : C2A;
            const f32x4 g1a = *(const f32x4*)(gn + 8 * fq), g1b = *(const f32x4*)(gn + 8 * fq + 4), g2a = *(const f32x4*)(gn + 32 + 8 * fq), g2b = *(const f32x4*)(gn + 36 + 8 * fq);
            bf16_t* dst = isk ? KA2 : QA2;
            const f32x4 ifa = *(const f32x4*)(cosA + 196608 + 8 * fq), ifb = *(const f32x4*)(cosA + 196608 + 8 * fq + 4);
            f32x4 ks1a = {0.f, 0.f, 0.f, 0.f}, ks1b = ks1a, ks2a = ks1a, ks2b = ks1a;
#pragma unroll
            for (int ai = 0; ai < 2; ++ai)
#pragma unroll
                for (int m = 0; m < 4; ++m) { const int row = row0 + ai * HALF + m * 16; const int pos = row & (SEQ - 1);
                    f32x4 x1a = acc[ai][0][m][0], x1b = acc[ai][0][m][1], x2a = acc[ai][1][m][0], x2b = acc[ai][1][m][1];
                    float ss = (x1a[0] * x1a[0] + x1a[1] * x1a[1]) + (x1a[2] * x1a[2] + x1a[3] * x1a[3]) + (x1b[0] * x1b[0] + x1b[1] * x1b[1]) + (x1b[2] * x1b[2] + x1b[3] * x1b[3])
                             + (x2a[0] * x2a[0] + x2a[1] * x2a[1]) + (x2a[2] * x2a[2] + x2a[3] * x2a[3]) + (x2b[0] * x2b[0] + x2b[1] * x2b[1]) + (x2b[2] * x2b[2] + x2b[3] * x2b[3]);
                    ss += __shfl_xor(ss, 16); ss += __shfl_xor(ss, 32);
                    const float rstd = 1.0f / sqrtf(ss * (1.f / 64.f) + EPS);
                    x1a = x1a * g1a * rstd; x1b = x1b * g1b * rstd; x2a = x2a * g2a * rstd; x2b = x2b * g2b * rstd;
                    f32x4 ca, cb, sa, sb; { const float fp_ = (float)pos;
#pragma unroll
                        for (int i = 0; i < 4; ++i) { const float ra = __builtin_amdgcn_fractf(fp_ * ifa[i]), rb = __builtin_amdgcn_fractf(fp_ * ifb[i]);
                            ca[i] = __builtin_amdgcn_cosf(ra); sa[i] = __builtin_amdgcn_sinf(ra); cb[i] = __builtin_amdgcn_cosf(rb); sb[i] = __builtin_amdgcn_sinf(rb); } }
                    const f32x4 y1a = x1a * ca - x2a * sa, y1b = x1b * cb - x2b * sb, y2a = x2a * ca + x1a * sa, y2b = x2b * cb + x1b * sb;
                    bf16_t* rp = dst + (size_t)row * 512 + h * 64 + 8 * fq;
                    *(u32x4*)rp = pack8(y1a * sc, y1b * sc); *(u32x4*)(rp + 32) = pack8(y2a * sc, y2b * sc);
                    ks1a += y1a; ks1b += y1b; ks2a += y2a; ks2b += y2b; }
            if (isk) {
#pragma unroll
                for (int o = 1; o < 16; o <<= 1) {
#pragma unroll
                    for (int i = 0; i < 4; ++i) { ks1a[i] += __shfl_xor(ks1a[i], o); ks1b[i] += __shfl_xor(ks1b[i], o); ks2a[i] += __shfl_xor(ks2a[i], o); ks2b[i] += __shfl_xor(ks2b[i], o); } }
                if (fr == 0) { float* km = KMEAN + (((size_t)(u.pm >> 3) * 8 + h) * 8 + (u.pm & 7)) * 64 + 8 * fq;
#pragma unroll
                    for (int i = 0; i < 4; ++i) { atomicAdd(km + i, ks1a[i] * (1.f / 256.f)); atomicAdd(km + 4 + i, ks1b[i] * (1.f / 256.f)); atomicAdd(km + 32 + i, ks2a[i] * (1.f / 256.f)); atomicAdd(km + 36 + i, ks2b[i] * (1.f / 256.f)); } } }
        } else if (u.pn == 6 || u.pn == 7) {
            const bool isq = u.pn == 6;
            float ssr[2][4];
#pragma unroll
            for (int ai = 0; ai < 2; ++ai)
#pragma unroll
                for (int m = 0; m < 4; ++m) { float ss = 0.f;
#pragma unroll
                    for (int bj = 0; bj < 2; ++bj) { if (bj == 1 && !isq) continue;
#pragma unroll
                        for (int n = 0; n < 2; ++n) { const f32x4 x = acc[ai][bj][m][n]; ss += (x[0] * x[0] + x[1] * x[1]) + (x[2] * x[2] + x[3] * x[3]); } }
                    ss += __shfl_xor(ss, 16); ss += __shfl_xor(ss, 32);
                    if (fq == 0) xch[(ai * HALF + wr * 64 + m * 16 + fr) * 4 + wc] = ss; }
            asm volatile("s_waitcnt lgkmcnt(0)" ::: "memory"); __builtin_amdgcn_s_barrier(); asm volatile("" ::: "memory");
#pragma unroll
            for (int ai = 0; ai < 2; ++ai)
#pragma unroll
                for (int m = 0; m < 4; ++m) { const f32x4 p4 = *(const LAS f32x4*)(xch + (ai * HALF + wr * 64 + m * 16 + fr) * 4); ssr[ai][m] = (p4[0] + p4[1]) + (p4[2] + p4[3]); }
            asm volatile("s_waitcnt lgkmcnt(0)" ::: "memory"); __builtin_amdgcn_s_barrier(); asm volatile("" ::: "memory");
            const float invn = isq ? (1.f / 256.f) : (1.f / 128.f); const float* gl = isq ? glq : glkv; bf16_t* dn = isq ? CQN : CKVN; const int ldn = isq ? 256 : 128;
            const int c0 = wc * 32 + 8 * fq;
#pragma unroll
            for (int bj = 0; bj < 2; ++bj) {
                if (bj == 1 && !isq) {
#pragma unroll
                    for (int ai = 0; ai < 2; ++ai)
#pragma unroll
                        for (int m = 0; m < 4; ++m) { const f32x4 x0 = acc[ai][1][m][0], x1 = acc[ai][1][m][1];
                            *(u32x4*)(PROJ + (size_t)(row0 + ai * HALF + m * 16) * DINP + col0 + HALF) = pack8(x0, x1);
                            float ss = (x0[0] * x0[0] + x0[1] * x0[1]) + (x0[2] * x0[2] + x0[3] * x0[3]) + (x1[0] * x1[0] + x1[1] * x1[1]) + (x1[2] * x1[2] + x1[3] * x1[3]);
                            ss += __shfl_xor(ss, 16); ss += __shfl_xor(ss, 32);
                            if (wc == 0 && fq == 0) KPESS[row0 + ai * HALF + m * 16] = ss; }
                    continue; }
                const f32x4 ga = *(const f32x4*)(gl + bj * HALF + c0), gb = *(const f32x4*)(gl + bj * HALF + c0 + 4);
#pragma unroll
                for (int ai = 0; ai < 2; ++ai)
#pragma unroll
                    for (int m = 0; m < 4; ++m) { const float rstd = 1.0f / sqrtf(ssr[ai][m] * invn + EPS);
                        *(u32x4*)(dn + (size_t)(row0 + ai * HALF + m * 16) * ldn + bj * HALF + c0) = pack8(acc[ai][bj][m][0] * ga * rstd, acc[ai][bj][m][1] * gb * rstd); } }
        } else {
            const bool sg = u.pn >= 8;
#pragma unroll
            for (int ai = 0; ai < 2; ++ai)
#pragma unroll
                for (int m = 0; m < 4; ++m) { bf16_t* rowp = PROJ + (size_t)(row0 + ai * HALF + m * 16) * DINP + col0;
#pragma unroll
                    for (int bj = 0; bj < 2; ++bj) { f32x4 v0 = acc[ai][bj][m][0], v1 = acc[ai][bj][m][1];
                        if (sg) { v0 = sig4(v0); v1 = sig4(v1); }
                        *(u32x4*)(rowp + bj * HALF) = pack8(v0, v1); } }
        }
    }
};

struct EpiQB { EPI_NOPRE
    bf16_t* QB; const float* gn; const float* cosB; const float* sinB; LAS float* xch;
    __device__ __forceinline__ void operator()(EPI_ARGS) const {
        const int rl0 = wr * 64 + fr, row0 = u.pm * BM + rl0;
#pragma unroll
        for (int ai = 0; ai < 2; ++ai)
#pragma unroll
            for (int m = 0; m < 4; ++m)
#pragma unroll
                for (int bj = 0; bj < 2; ++bj) { const f32x4 x0 = acc[ai][bj][m][0], x1 = acc[ai][bj][m][1];
                    float ss = (x0[0] * x0[0] + x0[1] * x0[1]) + (x0[2] * x0[2] + x0[3] * x0[3]) + (x1[0] * x1[0] + x1[1] * x1[1]) + (x1[2] * x1[2] + x1[3] * x1[3]);
                    ss += __shfl_xor(ss, 16); ss += __shfl_xor(ss, 32);
                    if (fq == 0) xch[((rl0 + ai * HALF + m * 16) * 2 + bj) * 4 + wc] = ss; }
        asm volatile("s_waitcnt lgkmcnt(0)" ::: "memory"); __builtin_amdgcn_s_barrier(); asm volatile("" ::: "memory");
#define QB_RS(ai, m, bj) ({ const f32x4 p4_ = *(const LAS f32x4*)(xch + ((rl0 + (ai) * HALF + (m) * 16) * 2 + (bj)) * 4); C2B / sqrtf(((p4_[0] + p4_[1]) + p4_[2]) * (1.f / 96.f) + EPS); })
        if (wc < 2) { const f32x4 ga = *(const f32x4*)(gn + 32 * wc + 8 * fq), gb = *(const f32x4*)(gn + 32 * wc + 8 * fq + 4);
#pragma unroll
            for (int ai = 0; ai < 2; ++ai)
#pragma unroll
                for (int m = 0; m < 4; ++m)
#pragma unroll
                    for (int bj = 0; bj < 2; ++bj) { const float r = QB_RS(ai, m, bj);
                        *(u32x4*)(QB + (size_t)(row0 + ai * HALF + m * 16) * 768 + (2 * u.pn + bj) * 96 + 32 * wc + 8 * fq) = pack8(acc[ai][bj][m][0] * ga * r, acc[ai][bj][m][1] * gb * r); }
        } else if (wc == 2) { const f32x4 g1 = *(const f32x4*)(gn + 64 + 4 * fq), g2 = *(const f32x4*)(gn + 80 + 4 * fq);
            const f32x4 ifr = *(const f32x4*)(cosB - 131072 + 196640 + 4 * fq);
#pragma unroll
            for (int ai = 0; ai < 2; ++ai)
#pragma unroll
                for (int m = 0; m < 4; ++m) { const int row = row0 + ai * HALF + m * 16; const int pos = row & (SEQ - 1);
                    f32x4 c4, s4; { const float fp_ = (float)pos;
#pragma unroll
                        for (int i = 0; i < 4; ++i) { const float rv = __builtin_amdgcn_fractf(fp_ * ifr[i]); c4[i] = __builtin_amdgcn_cosf(rv); s4[i] = __builtin_amdgcn_sinf(rv); } }
#pragma unroll
                    for (int bj = 0; bj < 2; ++bj) { const float r = QB_RS(ai, m, bj); const f32x4 x1 = acc[ai][bj][m][0] * g1 * r, x2 = acc[ai][bj][m][1] * g2 * r;
                        const f32x4 y1 = x1 * c4 - x2 * s4, y2 = x2 * c4 + x1 * s4; bf16_t* rp = QB + (size_t)row * 768 + (2 * u.pn + bj) * 96 + 64 + 4 * fq;
                        *(u32x2*)rp = (u32x2){cvt_pk_bf16(y1[0], y1[1]), cvt_pk_bf16(y1[2], y1[3])}; *(u32x2*)(rp + 16) = (u32x2){cvt_pk_bf16(y2[0], y2[1]), cvt_pk_bf16(y2[2], y2[3])}; } }
        }
    }
};
struct EpiKV { EPI_NOPRE
    bf16_t* KB2; bf16_t* KV; const bf16_t* PROJ; const float* KPESS; const float* gn; const float* cosB; const float* sinB; LAS float* xch;
    __device__ __forceinline__ void operator()(EPI_ARGS) const {
        const int rl0 = wr * 64 + fr, row0 = u.pm * BM + rl0;
        if (wc < 2) {
#pragma unroll
            for (int ai = 0; ai < 2; ++ai)
#pragma unroll
                for (int m = 0; m < 4; ++m)
#pragma unroll
                    for (int bj = 0; bj < 2; ++bj) { const f32x4 x0 = acc[ai][bj][m][0], x1 = acc[ai][bj][m][1];
                        float ss = (x0[0] * x0[0] + x0[1] * x0[1]) + (x0[2] * x0[2] + x0[3] * x0[3]) + (x1[0] * x1[0] + x1[1] * x1[1]) + (x1[2] * x1[2] + x1[3] * x1[3]);
                        ss += __shfl_xor(ss, 16); ss += __shfl_xor(ss, 32);
                        if (fq == 0) xch[((rl0 + ai * HALF + m * 16) * 2 + bj) * 4 + wc] = ss; } }
        asm volatile("s_waitcnt lgkmcnt(0)" ::: "memory"); __builtin_amdgcn_s_barrier(); asm volatile("" ::: "memory");
#define KV_RS(ai, m, bj, pe) ({ const f32x2 p2_ = *(const LAS f32x2*)(xch + ((rl0 + (ai) * HALF + (m) * 16) * 2 + (bj)) * 4); 1.0f / sqrtf(((p2_[0] + p2_[1]) + (pe)) * (1.f / 96.f) + EPS); })
        if (wc < 2) { const f32x4 ga = *(const f32x4*)(gn + 32 * wc + 8 * fq), gb = *(const f32x4*)(gn + 32 * wc + 8 * fq + 4);
#pragma unroll
            for (int ai = 0; ai < 2; ++ai)
#pragma unroll
                for (int m = 0; m < 4; ++m) { const float pe = KPESS[row0 + ai * HALF + m * 16];
#pragma unroll
                    for (int bj = 0; bj < 2; ++bj) { const float r = KV_RS(ai, m, bj, pe);
                        *(u32x4*)(KB2 + (size_t)(row0 + ai * HALF + m * 16) * 768 + (2 * u.pn + bj) * 96 + 32 * wc + 8 * fq) = pack8(acc[ai][bj][m][0] * ga * r, acc[ai][bj][m][1] * gb * r); } }
        } else {
#pragma unroll
            for (int ai = 0; ai < 2; ++ai)
#pragma unroll
                for (int m = 0; m < 4; ++m)
#pragma unroll
                    for (int bj = 0; bj < 2; ++bj) *(u32x4*)(KV + (size_t)(row0 + ai * HALF + m * 16) * 1024 + (2 * u.pn + bj) * 128 + 32 * wc + 8 * fq) = pack8(acc[ai][bj][m][0], acc[ai][bj][m][1]);
            if (wc == 2) {
                const f32x4 g1 = *(const f32x4*)(gn + 64 + 4 * fq), g2 = *(const f32x4*)(gn + 80 + 4 * fq);
                const f32x4 ifr = *(const f32x4*)(cosB - 131072 + 196640 + 4 * fq);
#pragma unroll
                for (int ai = 0; ai < 2; ++ai)
#pragma unroll
                    for (int m = 0; m < 4; ++m) { const int row = row0 + ai * HALF + m * 16; const int pos = row & (SEQ - 1); const float pe = KPESS[row];
                        const u32x2 w1 = *(const u32x2*)(PROJ + (size_t)row * DINP + PC_KPE + 4 * fq), w2 = *(const u32x2*)(PROJ + (size_t)row * DINP + PC_KPE + 16 + 4 * fq);
                        const f32x4 k1 = (f32x4){bflo(w1.x), bfhi(w1.x), bflo(w1.y), bfhi(w1.y)} * g1, k2 = (f32x4){bflo(w2.x), bfhi(w2.x), bflo(w2.y), bfhi(w2.y)} * g2;
                        f32x4 c4, s4; { const float fp_ = (float)pos;
#pragma unroll
                            for (int i = 0; i < 4; ++i) { const float rv = __builtin_amdgcn_fractf(fp_ * ifr[i]); c4[i] = __builtin_amdgcn_cosf(rv); s4[i] = __builtin_amdgcn_sinf(rv); } }
                        const f32x4 y1 = k1 * c4 - k2 * s4, y2 = k2 * c4 + k1 * s4;
#pragma unroll
                        for (int bj = 0; bj < 2; ++bj) { const float r = KV_RS(ai, m, bj, pe); bf16_t* rp = KB2 + (size_t)row * 768 + (2 * u.pn + bj) * 96 + 64 + 4 * fq;
                            *(u32x2*)rp = (u32x2){cvt_pk_bf16(y1[0] * r, y1[1] * r), cvt_pk_bf16(y1[2] * r, y1[3] * r)}; *(u32x2*)(rp + 16) = (u32x2){cvt_pk_bf16(y2[0] * r, y2[1] * r), cvt_pk_bf16(y2[2] * r, y2[3] * r)}; } } }
        }
    }
};
#undef QB_RS
#undef KV_RS
template <bool ADD> struct EpiGate { EPI_NOPRE
    bf16_t* O; const bf16_t* G; int ldg; unsigned char* MF8;
    __device__ __forceinline__ void operator()(EPI_ARGS) const {
        const int row0 = u.pm * BM + wr * 64 + fr, col0 = u.pn * BM + wc * 32 + 8 * fq;
#pragma unroll
        for (int ai = 0; ai < 2; ++ai)
#pragma unroll
            for (int m = 0; m < 4; ++m) { const size_t r = (size_t)(row0 + ai * HALF + m * 16);
#pragma unroll
                for (int bj = 0; bj < 2; ++bj) { const int c = col0 + bj * HALF;
                    f32x4 g0, g1; unpack8(*(const u32x4*)(G + r * ldg + c), g0, g1);
                    f32x4 v0 = acc[ai][bj][m][0] * g0, v1 = acc[ai][bj][m][1] * g1;
                    if (ADD) { f32x4 o0, o1; unpack8(*(const u32x4*)(O + r * DM + c), o0, o1); v0 += o0; v1 += o1;
                        *(u32x2*)(MF8 + r * DM + c) = (u32x2){pack4_fp8(v0[0], v0[1], v0[2], v0[3]), pack4_fp8(v1[0], v1[1], v1[2], v1[3])}; }
                    else *(u32x4*)(O + r * DM + c) = pack8(v0, v1); } }
    }
};

struct BranchOrder {
    StaticOrder so;
    __device__ bool next(int i, Unit& u) const { if (i >= 2) return false; if (!so.next(0, u)) return false; u.e = i; u.aofs = i * 512; u.pb = u.pn + 8 * i; return true; }
};
struct EpiGateAB { EPI_NOPRE
    bf16_t* O; const bf16_t* Ga; const bf16_t* Gb; int ldg; unsigned char* MF8;
    __device__ __forceinline__ void operator()(EPI_ARGS) const {
        if (u.e == 0) { EpiGate<false> E{O, Ga, ldg, nullptr}; E(acc, u, wr, wc, fr, fq); }
        else { asm volatile("s_waitcnt vmcnt(0)" ::: "memory");
               EpiGate<true> E{O, Gb, ldg, MF8}; E(acc, u, wr, wc, fr, fq); }
    }
};
struct EpiResF32 { EPI_NOPRE
    const float* base; bf16_t* out; float* ssp;
    __device__ __forceinline__ void operator()(EPI_ARGS) const {
        const int row0 = u.pm * BM + wr * 64 + fr, col0 = u.pn * BM + wc * 32 + 8 * fq;
#pragma unroll
        for (int ai = 0; ai < 2; ++ai)
#pragma unroll
            for (int m = 0; m < 4; ++m) { const size_t r = (size_t)(row0 + ai * HALF + m * 16); float ss = 0.f;
#pragma unroll
                for (int bj = 0; bj < 2; ++bj) { const size_t off = r * DM + col0 + bj * HALF;
                    const f32x4 b0 = *(const f32x4*)(base + off), b1 = *(const f32x4*)(base + off + 4);
                    const f32x4 y0 = b0 + acc[ai][bj][m][0], y1 = b1 + acc[ai][bj][m][1];
                    *(u32x4*)(out + off) = pack8(y0, y1);
                    ss += (y0[0] * y0[0] + y0[1] * y0[1]) + (y0[2] * y0[2] + y0[3] * y0[3]) + (y1[0] * y1[0] + y1[1] * y1[1]) + (y1[2] * y1[2] + y1[3] * y1[3]); }
                ss += __shfl_xor(ss, 16); ss += __shfl_xor(ss, 32);
                if (fq == 0) ssp[r * 16 + u.pn * 4 + wc] = ss; }
    }
};
struct EpiSwiglu {
    struct Pre { f32x4 bg[2], bu[2]; }; static constexpr bool HAS_PRE = true;
    unsigned char* O; const float* bias;
    __device__ __forceinline__ void preload(Pre& p, const Unit& u, int wc, int fq) const { const float* be = bias + (size_t)u.e * 2048 + u.pn * HALF + wc * 32 + 8 * fq;
#pragma unroll
        for (int n = 0; n < 2; ++n) { p.bg[n] = *(const f32x4*)(be + 4 * n); p.bu[n] = *(const f32x4*)(be + 1024 + 4 * n); } }
    __device__ __forceinline__ void operator()(EPI_ARGS, const Pre& p) const {
        const int row0 = u.pm * BM + wr * 64 + fr, j0 = u.pn * HALF + wc * 32 + 8 * fq;
#pragma unroll
        for (int ai = 0; ai < 2; ++ai)
#pragma unroll
            for (int m = 0; m < 4; ++m) { unsigned char* rowp = O + (size_t)(row0 + ai * HALF + m * 16) * DEXP + j0;
                f32x4 o[2];
#pragma unroll
                for (int n = 0; n < 2; ++n) { const f32x4 gv = acc[ai][0][m][n] + p.bg[n], uv = acc[ai][1][m][n] + p.bu[n];
#pragma unroll
                    for (int i = 0; i < 4; i += 2) {
                        const f32x2 gg = {fminf(gv[i], 7.0f), fminf(gv[i + 1], 7.0f)}, uu = {__builtin_amdgcn_fmed3f(uv[i], -7.0f, 7.0f), __builtin_amdgcn_fmed3f(uv[i + 1], -7.0f, 7.0f)};
                        const f32x2 ea = gg * (-1.702f * LOG2E); const f32x2 den = (f32x2){__builtin_amdgcn_exp2f(ea.x), __builtin_amdgcn_exp2f(ea.y)} + 1.0f;
                        const f32x2 num = uu * gg + gg; const f32x2 r = num * (f32x2){__builtin_amdgcn_rcpf(den.x), __builtin_amdgcn_rcpf(den.y)};
                        o[n][i] = r.x; o[n][i + 1] = r.y; } }
                *(u32x2*)rowp = (u32x2){pack4_fp8(o[0][0], o[0][1], o[0][2], o[0][3]), pack4_fp8(o[1][0], o[1][1], o[1][2], o[1][3])}; }
    }
};
struct EpiStoreBias {
    struct Pre { f32x4 bv[2][2]; }; static constexpr bool HAS_PRE = true;
    bf16_t* O; int ldc; const float* bias; int bias_stride;
    __device__ __forceinline__ void preload(Pre& p, const Unit& u, int wc, int fq) const { const float* be = bias + (size_t)u.e * bias_stride + u.pn * BM + wc * 32 + 8 * fq;
#pragma unroll
        for (int bj = 0; bj < 2; ++bj)
#pragma unroll
            for (int n = 0; n < 2; ++n) p.bv[bj][n] = *(const f32x4*)(be + bj * HALF + 4 * n); }
    __device__ __forceinline__ void operator()(EPI_ARGS, const Pre& p) const {
        const int row0 = u.pm * BM + wr * 64 + fr, col0 = u.pn * BM + wc * 32 + 8 * fq;
#pragma unroll
        for (int ai = 0; ai < 2; ++ai)
#pragma unroll
            for (int m = 0; m < 4; ++m) { bf16_t* rowp = O + (size_t)(row0 + ai * HALF + m * 16) * ldc + col0;
#pragma unroll
                for (int bj = 0; bj < 2; ++bj) *(u32x4*)(rowp + bj * HALF) = pack8(acc[ai][bj][m][0] + p.bv[bj][0], acc[ai][bj][m][1] + p.bv[bj][1]); }
    }
};
struct EpiFinal { EPI_NOPRE
    float* out; const bf16_t* PP; const bf16_t* X2;
    __device__ __forceinline__ void operator()(EPI_ARGS) const {
        const int row0 = u.pm * BM + wr * 64 + fr, col0 = u.pn * BM + wc * 32 + 8 * fq;
#pragma unroll
        for (int ai = 0; ai < 2; ++ai)
#pragma unroll
            for (int m = 0; m < 4; ++m) { const size_t r = (size_t)(row0 + ai * HALF + m * 16);
#pragma unroll
                for (int bj = 0; bj < 2; ++bj) { const size_t off = r * DM + col0 + bj * HALF;
                    f32x4 p0, p1, b0, b1; unpack8(*(const u32x4*)(PP + off), p0, p1); unpack8(*(const u32x4*)(X2 + off), b0, b1);
                    *(f32x4*)(out + off) = b0 + sig4(acc[ai][bj][m][0]) * p0; *(f32x4*)(out + off + 4) = b1 + sig4(acc[ai][bj][m][1]) * p1; } }
    }
};
}

namespace att {
__device__ __forceinline__ int crow(int r, int hi) { return (r & 3) + 8 * (r >> 2) + 4 * hi; }
__device__ __forceinline__ void glds16(const void* gsrc, unsigned lds_dst) { unsigned keep;
    asm volatile("s_mov_b32 %0, m0\n\ts_mov_b32 m0, %2\n\ts_nop 0\n\tglobal_load_lds_dwordx4 %1, off\n\ts_mov_b32 m0, %0" : "=&s"(keep) : "v"(gsrc), "s"(lds_dst) : "memory"); }
__device__ __forceinline__ s16x4 vtr(const LAS unsigned char* p) { return __builtin_bit_cast(s16x4, __builtin_amdgcn_ds_read_tr16_b64_v4i16((LAS s16x4*)p)); }
#define MX3(a, b, c) __builtin_fmaxf(__builtin_fmaxf((a), (b)), (c))
constexpr int VSLOT = 8192, OST_BYTES = NWAVES * 4096, WSF_BYTES = NWAVES * 256;

template <int DQK, bool MOBA>
__device__ __forceinline__ void attn_unit(int b, int qb, const bf16_t* Qh, int ldq, const bf16_t* Kh, int ldk, const bf16_t* Vh, int ldv, unsigned char* Oh, int ldo, const float* kmean, LAS unsigned char* shm, int wave) {
    constexpr int ND = DQK / 16, NCH = DQK / 8, KSLOT = NCH * 1024;
    constexpr int LDS_K = 0, LDS_V = 2 * KSLOT, LDS_WS = LDS_V + 2 * VSLOT, LDS_OST = LDS_WS + WSF_BYTES;
    static_assert(LDS_OST + OST_BYTES <= RING_BYTES, "attention LDS");
    int lane = lane_id(); asm volatile("" : "+v"(lane));
    const int r32 = lane & 31, hi = lane >> 5; const int wid = wave;
    const long rowbase = (long)b * SEQ; const int q0 = qb * 256;
    const unsigned lds0 = (unsigned)(uintptr_t)shm;
    LAS float* wsf = (LAS float*)(shm + LDS_WS) + wid * 64;
    const int NT = 4 * (qb + 1);
    const bf16_t* ksrc0 = Kh + (rowbase + lane) * ldk + wid * 8;
    const bf16_t* vsrc0 = Vh + (rowbase + 16 * (wid & 3) + (lane >> 2)) * ldv + (wid >> 2) * 32 + (lane & 3) * 8;
#define ATT_DMA(kt, s) do { const long ro_ = (long)(kt) * 64; \
        glds16(ksrc0 + ro_ * ldk, (unsigned)__builtin_amdgcn_readfirstlane(lds0 + LDS_K + (s) * KSLOT + wid * 1024)); \
        if (NCH > 8 && wid < NCH - 8) glds16(ksrc0 + ro_ * ldk + 64, (unsigned)__builtin_amdgcn_readfirstlane(lds0 + LDS_K + (s) * KSLOT + (wid + 8) * 1024)); \
        glds16(vsrc0 + ro_ * ldv, (unsigned)__builtin_amdgcn_readfirstlane(lds0 + LDS_V + (s) * VSLOT + wid * 1024)); } while (0)
#define ATT_TILE(i) (MOBA ? ((i) < 4 ? 4 * qb + (i) : (i) - 4) : (i))
    ATT_DMA(ATT_TILE(0), 0);
    const bf16_t* Qw = Qh + (rowbase + q0 + wid * 32 + r32) * ldq + hi * 8;
    bf16x8 qr[ND];
#pragma unroll
    for (int d0 = 0; d0 < ND; ++d0) qr[d0] = *(const bf16x8*)(Qw + d0 * 16);
    unsigned bmask = 0xffffffffu;
    if (MOBA) {
        bmask = 1u << qb;
        if (qb <= 3) bmask |= (1u << qb) - 1u;
        else {
            float gsc[7];
#pragma unroll
            for (int n = 0; n < 7; ++n) { float s = 0.f;
                if (n < qb) {
#pragma unroll
                    for (int d0 = 0; d0 < ND; ++d0) { const float* km = kmean + n * 64 + d0 * 16 + hi * 8; const f32x4 k0 = *(const f32x4*)km, k1 = *(const f32x4*)(km + 4);
                        s += bf2f((unsigned short)qr[d0][0]) * k0[0] + bf2f((unsigned short)qr[d0][1]) * k0[1] + bf2f((unsigned short)qr[d0][2]) * k0[2] + bf2f((unsigned short)qr[d0][3]) * k0[3]
                           + bf2f((unsigned short)qr[d0][4]) * k1[0] + bf2f((unsigned short)qr[d0][5]) * k1[1] + bf2f((unsigned short)qr[d0][6]) * k1[2] + bf2f((unsigned short)qr[d0][7]) * k1[3]; }
                    s += __shfl_xor(s, 32);
                } else s = -INFINITY;
                gsc[n] = s; }
#pragma unroll
            for (int pass = 0; pass < 3; ++pass) { float best = -INFINITY; int bi = 0;
#pragma unroll
                for (int n = 0; n < 7; ++n) { const bool ok = (n < qb) && !((bmask >> n) & 1u) && (gsc[n] > best); best = ok ? gsc[n] : best; bi = ok ? n : bi; }
                bmask |= 1u << bi; }
        }
    }
    asm volatile("s_waitcnt vmcnt(0)" ::: "memory");
#pragma unroll
    for (int d0 = 0; d0 < ND; ++d0) asm volatile("" : "+v"(qr[d0]));
    float mhat = 0.f, l_reg = 0.f; f32x16 o[2]; o[0] = f32x16{}; o[1] = f32x16{}; f32x16 negm = f32x16{}; asm volatile("" : "+v"(negm));
    const int qrel = wid * 32 + r32;
    const LAS unsigned char* kp0 = shm + LDS_K + hi * 1024 + r32 * 16;
    const LAS unsigned char* vp0 = shm + LDS_V + ((lane >> 4) & 1) * 32 + (lane & 3) * 8 + (4 * hi + ((lane & 15) >> 2)) * 64;
    for (int i = 0; i < NT; ++i) {
        const int s = i & 1, kt = ATT_TILE(i);
        asm volatile("s_waitcnt vmcnt(0) lgkmcnt(0)\n\ts_barrier" ::: "memory");
        if (i + 1 < NT) ATT_DMA(ATT_TILE(i + 1), s ^ 1);
        f32x16 cin = negm;
        if (MOBA) { if (i >= 4 && !((bmask >> (kt >> 2)) & 1u)) {
#pragma unroll
            for (int r = 0; r < 16; ++r) cin[r] = -INFINITY; } }
        f32x16 p0, p1;
        { const LAS unsigned char* kb = kp0 + s * KSLOT; bf16x8 kf[2 * ND];
#pragma unroll
            for (int d0 = 0; d0 < ND; ++d0) { kf[2 * d0] = *(const LAS bf16x8*)(kb + d0 * 2048); kf[2 * d0 + 1] = *(const LAS bf16x8*)(kb + d0 * 2048 + 512); }
            __builtin_amdgcn_sched_barrier(0);
#pragma unroll
            for (int d0 = 0; d0 < ND; ++d0) {
                if (d0 == 0) { p0 = __builtin_amdgcn_mfma_f32_32x32x16_bf16(kf[0], qr[0], cin, 0, 0, 0); p1 = __builtin_amdgcn_mfma_f32_32x32x16_bf16(kf[1], qr[0], cin, 0, 0, 0); }
                else { p0 = __builtin_amdgcn_mfma_f32_32x32x16_bf16(kf[2 * d0], qr[d0], p0, 0, 0, 0); p1 = __builtin_amdgcn_mfma_f32_32x32x16_bf16(kf[2 * d0 + 1], qr[d0], p1, 0, 0, 0); } } }
        if (kt >= 4 * qb) { const int kb = 64 * (kt - 4 * qb) + 4 * hi;
#pragma unroll
            for (int r = 0; r < 16; ++r) { const int kv = kb + (r & 3) + 8 * (r >> 2); if (kv > qrel) p0[r] = -INFINITY; if (kv + 32 > qrel) p1[r] = -INFINITY; } }
        bool resc = false;
        { float a = MX3(p0[0], p0[1], p1[0]), bb = MX3(p0[2], p0[3], p1[1]); a = MX3(a, p1[2], p1[3]);
#pragma unroll
            for (int r = 4; r < 16; r += 4) { a = MX3(a, p0[r], p0[r + 1]); bb = MX3(bb, p0[r + 2], p0[r + 3]); a = MX3(a, p1[r], p1[r + 1]); bb = MX3(bb, p1[r + 2], p1[r + 3]); }
            float rm = __builtin_fmaxf(a, bb); rm = __builtin_fmaxf(rm, __shfl_xor(rm, 32));
            const bool first = (i == 0);
            if (first || __any(rm > 6.0f)) {
                const float dl = first ? rm : __builtin_fmaxf(rm, 0.f); mhat += dl;
#pragma unroll
                for (int r = 0; r < 16; ++r) { p0[r] -= dl; p1[r] -= dl; }
#pragma unroll
                for (int r = 0; r < 16; ++r) negm[r] = -mhat;
                asm volatile("" : "+v"(negm));
                const float f = __builtin_amdgcn_exp2f(-dl); l_reg *= f; if (hi == 0) wsf[r32] = f; resc = true; } }
        float sacc = 0.f;
#pragma unroll
        for (int r = 0; r < 16; ++r) { p0[r] = __builtin_amdgcn_exp2f(p0[r]); p1[r] = __builtin_amdgcn_exp2f(p1[r]); sacc += p0[r] + p1[r]; }
        l_reg += sacc;
        u32x4 pw0, pw1, pw2, pw3;
        pw0 = (u32x4){cvt_pk_bf16(p0[0], p0[1]), cvt_pk_bf16(p0[2], p0[3]), cvt_pk_bf16(p0[4], p0[5]), cvt_pk_bf16(p0[6], p0[7])};
        pw1 = (u32x4){cvt_pk_bf16(p0[8], p0[9]), cvt_pk_bf16(p0[10], p0[11]), cvt_pk_bf16(p0[12], p0[13]), cvt_pk_bf16(p0[14], p0[15])};
        pw2 = (u32x4){cvt_pk_bf16(p1[0], p1[1]), cvt_pk_bf16(p1[2], p1[3]), cvt_pk_bf16(p1[4], p1[5]), cvt_pk_bf16(p1[6], p1[7])};
        pw3 = (u32x4){cvt_pk_bf16(p1[8], p1[9]), cvt_pk_bf16(p1[10], p1[11]), cvt_pk_bf16(p1[12], p1[13]), cvt_pk_bf16(p1[14], p1[15])};
        if (resc) {
#pragma unroll
            for (int d_ = 0; d_ < 2; ++d_)
#pragma unroll
                for (int r = 0; r < 16; ++r) o[d_][r] *= wsf[crow(r, hi)];
        }
        { const LAS unsigned char* vp = vp0 + s * VSLOT;
#pragma unroll
            for (int d0 = 0; d0 < 2; ++d0) {
                s16x4 lo[4], hh[4];
#pragma unroll
                for (int ks = 0; ks < 4; ++ks) { lo[ks] = vtr(vp + d0 * 4096 + ks * 1024); hh[ks] = vtr(vp + d0 * 4096 + ks * 1024 + 512); }
                __builtin_amdgcn_sched_barrier(0);
#define PKV(k) (bf16x8){lo[k][0], lo[k][1], lo[k][2], lo[k][3], hh[k][0], hh[k][1], hh[k][2], hh[k][3]}
                o[d0] = __builtin_amdgcn_mfma_f32_32x32x16_bf16(__builtin_bit_cast(bf16x8, pw0), PKV(0), o[d0], 0, 0, 0);
                o[d0] = __builtin_amdgcn_mfma_f32_32x32x16_bf16(__builtin_bit_cast(bf16x8, pw1), PKV(1), o[d0], 0, 0, 0);
                o[d0] = __builtin_amdgcn_mfma_f32_32x32x16_bf16(__builtin_bit_cast(bf16x8, pw2), PKV(2), o[d0], 0, 0, 0);
                o[d0] = __builtin_amdgcn_mfma_f32_32x32x16_bf16(__builtin_bit_cast(bf16x8, pw3), PKV(3), o[d0], 0, 0, 0);
#undef PKV
            } }
    }
    l_reg += __shfl_xor(l_reg, 32);
    if (hi == 0) wsf[32 + r32] = l_reg;
    float rli[16];
#pragma unroll
    for (int r = 0; r < 16; ++r) rli[r] = __builtin_amdgcn_rcpf(wsf[32 + crow(r, hi)]);
    unsigned char* Ow = (unsigned char*)Oh + (rowbase + q0 + wid * 32) * ldo;
    { LAS unsigned char* stg = shm + LDS_OST + wid * 2048;
#pragma unroll
        for (int r = 0; r < 16; ++r) { const int orow = crow(r, hi);
#pragma unroll
            for (int d0 = 0; d0 < 2; ++d0) stg[orow * 64 + d0 * 32 + r32] = (unsigned char)(pack4_fp8(o[d0][r] * rli[r], 0.f, 0.f, 0.f) & 0xffu); }
#pragma unroll
        for (int i = 0; i < 2; ++i) { const int row = i * 16 + (lane >> 2), ch = lane & 3; const u32x4 v = *(const LAS u32x4*)(stg + row * 64 + ch * 16); *(u32x4*)(Ow + (long)row * ldo + ch * 16) = v; } }
    asm volatile("s_waitcnt lgkmcnt(0)\n\ts_barrier" ::: "memory");
#undef ATT_DMA
#undef ATT_TILE
}
#undef MX3
}

#define XB_TMO      128
#define XB_XCNT(j)  (256  + 64 * (j))
#define XB_XSUB(j)  (1280 + 64 * (j))
#define XB_XGEN(j)  (2304 + 64 * (j))
#define XB_TOP      3328
#define XB_TOPGEN   3392
#define XCD_BAR_WORDS 3456
#define XB_SPIN_CAP (1u << 22)
__device__ __forceinline__ unsigned xb_ld(unsigned* p)              { return __hip_atomic_load(p, __ATOMIC_RELAXED, __HIP_MEMORY_SCOPE_AGENT); }
__device__ __forceinline__ unsigned xb_add(unsigned* p, unsigned v) { return __hip_atomic_fetch_add(p, v, __ATOMIC_RELAXED, __HIP_MEMORY_SCOPE_AGENT); }
__device__ __forceinline__ unsigned xb_xcc_id() { return (unsigned)__builtin_amdgcn_s_getreg((3 << 11) | 20) & 0xFu; }
#define XB_SPIN(cond, bar) do { unsigned _sp = 0; while (cond) { __builtin_amdgcn_s_sleep(1); \
    if ((++_sp & 255u) == 0u) { if (xb_ld(&(bar)[XB_TMO])) break; if (_sp > XB_SPIN_CAP) { atomicAdd(&(bar)[XB_TMO], 1u); break; } } } } while (0)
struct XcdBarrier { unsigned* bar; unsigned x; volatile LAS unsigned* st; int wave; };
__device__ __forceinline__ XcdBarrier xcd_barrier_post(unsigned* bar, volatile LAS unsigned* st, int wave) {
    XcdBarrier b; b.bar = bar; b.x = xb_xcc_id(); b.st = st; b.wave = wave;
    if (wave == 0 && lane_id() == 0) (void)xb_add(&bar[XB_XCNT(b.x)], 1u);
    return b;
}
__device__ __forceinline__ void xcd_barrier_complete(unsigned* bar, unsigned x, unsigned& nloc, unsigned& nx) {
    const unsigned G = gridDim.x * gridDim.y * gridDim.z;
    unsigned sum, cnt, mine, sp = 0u;
    for (;;) {
        sum = 0u; cnt = 0u; mine = 0u;
#pragma unroll
        for (unsigned j = 0; j < 16; ++j) { const unsigned c = xb_ld(&bar[XB_XCNT(j)]); sum += c; cnt += (c > 0u) ? 1u : 0u; mine = (j == x) ? c : mine; }
        if (sum == G) break;
        __builtin_amdgcn_s_sleep(1);
        if ((++sp & 255u) == 0u) { if (xb_ld(&bar[XB_TMO])) break; if (sp > XB_SPIN_CAP) { atomicAdd(&bar[XB_TMO], 1u); break; } }
    }
    nloc = mine > 0u ? mine : 1u; nx = cnt > 0u ? cnt : 1u;
}
__device__ __forceinline__ void xcd_barrier(const XcdBarrier& b) {
    asm volatile("s_waitcnt vmcnt(0)" ::: "memory");
    __syncthreads();
    if (b.wave == 0 && lane_id() == 0) {
        unsigned* bar = b.bar;
        __builtin_amdgcn_s_waitcnt(0);
        unsigned nloc = b.st[0], nx = b.st[1];
        if (nloc == 0u) { xcd_barrier_complete(bar, b.x, nloc, nx); b.st[0] = nloc; b.st[1] = nx; }
        const unsigned old = xb_add(&bar[XB_XSUB(b.x)], 1u);
        const unsigned gen = old / nloc;
        if (old + 1u == (gen + 1u) * nloc) {
            __builtin_amdgcn_fence(__ATOMIC_RELEASE, "agent");
            asm volatile("s_waitcnt vmcnt(0)" ::: "memory");
            const unsigned og = xb_add(&bar[XB_TOP], 1u);
            const unsigned tg = og / nx;
            if (og + 1u == (tg + 1u) * nx) xb_add(&bar[XB_TOPGEN], 1u);
            else XB_SPIN(xb_ld(&bar[XB_TOPGEN]) == tg, bar);
            __builtin_amdgcn_fence(__ATOMIC_ACQUIRE, "agent");
            xb_add(&bar[XB_XGEN(b.x)], 1u);
            asm volatile("s_waitcnt vmcnt(0)" ::: "memory");
        } else {
            XB_SPIN(xb_ld(&bar[XB_XGEN(b.x)]) == gen, bar);
            __builtin_amdgcn_fence(__ATOMIC_ACQUIRE, "agent");
            asm volatile("s_waitcnt vmcnt(0)" ::: "memory");
        }
    }
    __syncthreads();
}

struct Params { const float* in[25]; float* out; unsigned char* ws; int ph_lo, ph_hi; };
enum { I_X = 0, I_P, I_GMIX, I_WIN, I_MQN, I_MKN, I_QLATN, I_WUQ, I_KVLATN, I_WUKV, I_MLAQN, I_MLAKN, I_WA, I_WB, I_WO, I_GFFN, I_WR, I_BR, I_WGU, I_BGU, I_WD, I_BD, I_GPLE, I_WPG, I_WPP };
constexpr int NPHASE = 16;

struct Frame {
    LAS unsigned char* lds; int vcu, G, wave;
    const Params* P; unsigned char* ws;
};
struct Ids { int tid, lane, wave; };
#define PHASE_IDS() Ids I_; { int l_ = lane_id(); asm volatile("" : "+v"(l_)); I_.lane = l_; I_.wave = F.wave; I_.tid = F.wave * 64 + l_; }

#ifdef TPROBE_A
#define STAMP(k) do { if (blockIdx.x == 0 && F.wave == 0 && lane_id() == 0) ((volatile unsigned long long*)(ws + WS_ERR))[k] = __builtin_amdgcn_s_memrealtime(); } while (0)
#else
#define STAMP(k) do {} while (0)
#endif
__device__ __forceinline__ int rowmap(int mode, int c) {
    if (mode == 1) {
        if (c < 1024) { const int base = c & 512, s_ = c & 511, h = s_ >> 6, d = s_ & 63; return base + 256 * (h >> 2) + 128 * (d >> 5) + 32 * (h & 3) + (d & 31); }
        return c < 1952 ? c : c + 96; }
    if (mode == 2) return c < 1024 ? 256 * (c >> 7) + (c & 127) : 256 * ((c - 1024) >> 7) + 128 + ((c - 1024) & 127);
    if (mode == 3) {
        const int h = c / 96, d = c % 96; int t;
        if (d < 64) t = d; else if (d < 80) { const int i = d - 64; t = 64 + 8 * (i >> 2) + (i & 3); } else { const int i = d - 80; t = 64 + 8 * (i >> 2) + 4 + (i & 3); }
        return 128 * h + t; }
    return c;
}
__device__ __forceinline__ void tr_item64(const float* W, int ldw, int N, int k0, int n0, bf16_t* dst, int ldd, int mode, LAS float* scr, int lane) {
    const int r = lane >> 4, c4 = lane & 15; const bool inb = (n0 + 4 * c4) < N;
    f32x4 v[16];
#pragma unroll
    for (int i = 0; i < 16; ++i) v[i] = inb ? __builtin_nontemporal_load((const f32x4*)(W + (size_t)(k0 + 4 * i + r) * ldw + n0 + 4 * c4)) : (f32x4){0.f, 0.f, 0.f, 0.f};
#pragma unroll
    for (int i = 0; i < 16; ++i) { LAS float* p = scr + (4 * i + r) * 65 + 4 * c4; p[0] = v[i].x; p[1] = v[i].y; p[2] = v[i].z; p[3] = v[i].w; }
    asm volatile("s_waitcnt lgkmcnt(0)" ::: "memory");
    const int c = lane & 7;
#pragma unroll
    for (int j = 0; j < 8; ++j) { const int n = (lane >> 3) + 8 * j; const LAS float* sp = scr + (8 * c) * 65 + n;
        u32x4 o; o.x = cvt_pk_bf16(sp[0 * 65], sp[1 * 65]); o.y = cvt_pk_bf16(sp[2 * 65], sp[3 * 65]); o.z = cvt_pk_bf16(sp[4 * 65], sp[5 * 65]); o.w = cvt_pk_bf16(sp[6 * 65], sp[7 * 65]);
        if (n0 + n < N) *(u32x4*)(dst + (size_t)rowmap(mode, n0 + n) * ldd + k0 + 8 * c) = o; }
    asm volatile("s_waitcnt lgkmcnt(0)" ::: "memory");
}

__device__ __forceinline__ void tr_item_f8(const float* W, int ldw, int k0, int n0, unsigned char* dst, int ldd, int mode, LAS float* scr, int lane) {
    const int r = lane >> 3, c4 = lane & 7;
    f32x4 v[16];
#pragma unroll
    for (int i = 0; i < 16; ++i) v[i] = __builtin_nontemporal_load((const f32x4*)(W + (size_t)(k0 + 8 * i + r) * ldw + n0 + 4 * c4));
#pragma unroll
    for (int i = 0; i < 16; ++i) { LAS float* p = scr + (8 * i + r) * 33 + 4 * c4; p[0] = v[i].x * 64.f; p[1] = v[i].y * 64.f; p[2] = v[i].z * 64.f; p[3] = v[i].w * 64.f; }
    asm volatile("s_waitcnt lgkmcnt(0)" ::: "memory");
    const int c = lane & 7;
#pragma unroll
    for (int j = 0; j < 4; ++j) { const int n = (lane >> 3) + 8 * j; const LAS float* sp = scr + (16 * c) * 33 + n;
        u32x4 o; o.x = pack4_fp8(sp[0 * 33], sp[1 * 33], sp[2 * 33], sp[3 * 33]); o.y = pack4_fp8(sp[4 * 33], sp[5 * 33], sp[6 * 33], sp[7 * 33]);
        o.z = pack4_fp8(sp[8 * 33], sp[9 * 33], sp[10 * 33], sp[11 * 33]); o.w = pack4_fp8(sp[12 * 33], sp[13 * 33], sp[14 * 33], sp[15 * 33]);
        __builtin_nontemporal_store(o, (u32x4*)(dst + (size_t)rowmap(mode, n0 + n) * ldd + k0 + 16 * c)); }
    asm volatile("s_waitcnt lgkmcnt(0)" ::: "memory");
}

__device__ __forceinline__ void phase0(Frame& F) {
    PHASE_IDS();
    const Params& P = *F.P; unsigned char* ws = F.ws;
    LAS float* scr = (LAS float*)(F.lds + I_.wave * 16896);
    const int gw = F.vcu * NWAVES + I_.wave, NGW = F.G * NWAVES;
    constexpr int I_GU = 32 * 8 * 64, I_DN = 32 * 8 * 32, I_IN = 8 * 61, I_ING = 8 * 64, I_UQ = 4 * 12, I_UKV = 2 * 16, I_A = 8 * 16, I_O = 16 * 16, I_PP = 4 * 16;
    constexpr int I_PG = 8 * 32;
    constexpr int NITEMS = I_GU + I_DN + I_IN + I_ING + I_UQ + I_UKV + 2 * I_A + I_O + I_PG + I_PP;
    for (int it = gw; it < NITEMS; it += NGW) {
        int r = it;
        if (r < I_GU) { const int e = r >> 9, q = r & 511, kb = q >> 6, g = q & 63;
            tr_item_f8(P.in[I_WGU] + (size_t)e * 1024 * 2048, 2048, 128 * kb, 32 * g, ws + WS_W1 + (size_t)e * 2048 * 1024, 1024, 2, scr, I_.lane); continue; } r -= I_GU;
        if (r < I_DN) { const int e = r >> 8, q = r & 255, kb = q >> 5, g = q & 31;
            tr_item_f8(P.in[I_WD] + (size_t)e * 1024 * 1024, 1024, 128 * kb, 32 * g, ws + WS_W2 + (size_t)e * 1024 * 1024, 1024, 0, scr, I_.lane); continue; } r -= I_DN;
        if (r < I_IN) { const int kb = r / 61, g = r % 61; tr_item_f8(P.in[I_WIN], DIN, 128 * kb, 32 * g, ws + WS_WIN, 1024, 1, scr, I_.lane); continue; } r -= I_IN;
        if (r < I_ING) { const int kb = r >> 6, g = r & 63; tr_item_f8(P.in[I_WIN] + 1952, DIN, 128 * kb, 32 * g, ws + WS_WINF8, 1024, 0, scr, I_.lane); continue; } r -= I_ING;
        if (r < I_UQ) { const int kb = r / 12, g = r % 12; tr_item64(P.in[I_WUQ], 768, 768, 64 * kb, 64 * g, (bf16_t*)(ws + WS_WUQ), 256, 3, scr, I_.lane); continue; } r -= I_UQ;
        if (r < I_UKV) { const int kb = r / 16, g = r % 16; tr_item64(P.in[I_WUKV], 1024, 1024, 64 * kb, 64 * g, (bf16_t*)(ws + WS_WUKV), 128, 0, scr, I_.lane); continue; } r -= I_UKV;
        if (r < I_A) { const int kb = r >> 5, g = r & 31; tr_item_f8(P.in[I_WA], 1024, 128 * kb, 32 * g, ws + WS_WA, 512, 0, scr, I_.lane); continue; } r -= I_A;
        if (r < I_A) { const int kb = r >> 5, g = r & 31; tr_item_f8(P.in[I_WB], 1024, 128 * kb, 32 * g, ws + WS_WB, 512, 0, scr, I_.lane); continue; } r -= I_A;
        if (r < I_PG) { const int kb = r >> 5, g = r & 31; tr_item_f8(P.in[I_WO], 1024, 128 * kb, 32 * g, ws + WS_WO, 1024, 0, scr, I_.lane); continue; } r -= I_PG;
        if (r < I_PG) { const int kb = r >> 5, g = r & 31; tr_item_f8(P.in[I_WPG], 1024, 128 * kb, 32 * g, ws + WS_WPG, 1024, 0, scr, I_.lane); continue; } r -= I_PG;
        { const int kb = r / 16, g = r % 16; tr_item64(P.in[I_WPP], 1024, 1024, 64 * kb, 64 * g, (bf16_t*)(ws + WS_WPP), 256, 0, scr, I_.lane); }
    }
    STAMP(20);
    { const f32x4* gp = (const f32x4*)P.in[I_GMIX] + I_.lane; f32x4 gv[4];
#pragma unroll
        for (int j = 0; j < 4; ++j) gv[j] = gp[64 * j];
        for (int m0 = gw * 4; m0 < NTOK; m0 += NGW * 4) { f32x4 v[4][4];
#pragma unroll
            for (int q = 0; q < 4; ++q) { const f32x4* xr = (const f32x4*)(P.in[I_X] + (size_t)(m0 + q) * DM) + I_.lane;
#pragma unroll
                for (int j = 0; j < 4; ++j) v[q][j] = xr[64 * j]; }
#pragma unroll
            for (int q = 0; q < 4; ++q) { float s = 0.f;
#pragma unroll
                for (int j = 0; j < 4; ++j) s += (v[q][j].x * v[q][j].x + v[q][j].y * v[q][j].y) + (v[q][j].z * v[q][j].z + v[q][j].w * v[q][j].w);
                const float rstd = 1.0f / sqrtf(wave_sum(s) * (1.f / DM) + EPS);
                unsigned* o4 = (unsigned*)(ws + WS_HNF8 + (size_t)(m0 + q) * DM) + I_.lane;
#pragma unroll
                for (int j = 0; j < 4; ++j) { const f32x4 y = v[q][j] * rstd * gv[j]; o4[64 * j] = pack4_fp8(y.x, y.y, y.z, y.w); } } } }
    STAMP(21);
    { float* km = (float*)(ws + WS_KMEAN); for (int i = F.vcu * NTHREADS + I_.tid; i < 8 * 8 * 8 * 64; i += F.G * NTHREADS) km[i] = 0.f; }
    { const size_t n4 = (size_t)NTOK * 256 / 4; const f32x4* pp = (const f32x4*)P.in[I_P]; u32x2* po = (u32x2*)(ws + WS_PB); const size_t T = (size_t)F.G * NTHREADS;
        for (size_t i = (size_t)F.vcu * NTHREADS + I_.tid; i < n4; i += 4 * T) { f32x4 v[4];
#pragma unroll
            for (int q = 0; q < 4; ++q) v[q] = __builtin_nontemporal_load(pp + i + q * T);
#pragma unroll
            for (int q = 0; q < 4; ++q) po[i + q * T] = (u32x2){cvt_pk_bf16(v[q].x, v[q].y), cvt_pk_bf16(v[q].z, v[q].w)}; } }
    STAMP(22);
    { float* tab = (float*)(ws + WS_ROPE);
        const int i = F.vcu * NTHREADS + I_.tid;
        if (i < 48) { const int half = i < 32 ? 32 : 16, j = i < 32 ? i : i - 32; tab[196608 + i] = powf(10000.0f, -((float)j / (float)half)) * 0.15915494309189535f; } }
}

__device__ __forceinline__ void phase2(Frame& F) {
    PHASE_IDS();
    const Params& P = *F.P; unsigned char* ws = F.ws;
    const bf16_t* PROJ = (const bf16_t*)(ws + WS_PROJ);
    const float* cosA = (const float*)(ws + WS_ROPE); const float* sinA = cosA + 65536;
    LAS float* kst = (LAS float*)F.lds;
    LAS float* part = kst + 256 * 68;
    for (int it = F.vcu; it < 512; it += F.G) {
        const int b = it >> 6, blk = (it >> 3) & 7, h = it & 7;
        const int sel = I_.lane >> 5, r = I_.wave * 32 + (I_.lane & 31); const int pos = blk * 256 + r; const size_t row = (size_t)b * SEQ + pos;
        const u32x4* src = (const u32x4*)(PROJ + row * DINP + (sel ? PC_KA : PC_QA) + h * 64);
        u32x4 raw[8];
#pragma unroll
        for (int c = 0; c < 8; ++c) raw[c] = src[c];
        float ss = 0.f;
#pragma unroll
        for (int c = 0; c < 8; ++c) { f32x4 a0, a1; pg8::unpack8(raw[c], a0, a1); ss += (a0[0] * a0[0] + a0[1] * a0[1]) + (a0[2] * a0[2] + a0[3] * a0[3]) + (a1[0] * a1[0] + a1[1] * a1[1]) + (a1[2] * a1[2] + a1[3] * a1[3]); }
        const float rstd = 1.0f / sqrtf(ss * (1.f / 64.f) + EPS);
        const float* gn = sel ? P.in[I_MKN] : P.in[I_MQN];
        const float sc = sel ? 1.0f : C2A;
        bf16_t* dst = (bf16_t*)(ws + (sel ? WS_KA2 : WS_QA2)) + row * 512 + h * 64;
#pragma unroll
        for (int c = 0; c < 4; ++c) { f32x4 x1a, x1b, x2a, x2b; pg8::unpack8(raw[c], x1a, x1b); pg8::unpack8(raw[c + 4], x2a, x2b);
            const f32x4 g1a = *(const f32x4*)(gn + 8 * c), g1b = *(const f32x4*)(gn + 8 * c + 4), g2a = *(const f32x4*)(gn + 32 + 8 * c), g2b = *(const f32x4*)(gn + 36 + 8 * c);
            x1a = x1a * g1a * rstd; x1b = x1b * g1b * rstd; x2a = x2a * g2a * rstd; x2b = x2b * g2b * rstd;
            const f32x4 ca = *(const f32x4*)(cosA + pos * 32 + 8 * c), cb = *(const f32x4*)(cosA + pos * 32 + 8 * c + 4), sa = *(const f32x4*)(sinA + pos * 32 + 8 * c), sb = *(const f32x4*)(sinA + pos * 32 + 8 * c + 4);
            const f32x4 y1a = x1a * ca - x2a * sa, y1b = x1b * cb - x2b * sb, y2a = x2a * ca + x1a * sa, y2b = x2b * cb + x1b * sb;
            *(u32x4*)(dst + 8 * c) = pg8::pack8(y1a * sc, y1b * sc); *(u32x4*)(dst + 32 + 8 * c) = pg8::pack8(y2a * sc, y2b * sc);
            if (sel) { LAS f32x4* kr = (LAS f32x4*)(kst + r * 68); kr[2 * c] = y1a; kr[2 * c + 1] = y1b; kr[8 + 2 * c] = y2a; kr[8 + 2 * c + 1] = y2b; } }
        __syncthreads();
        { const int d = I_.tid & 63, pt = I_.tid >> 6; float s = 0.f;
#pragma unroll 8
            for (int rr = 0; rr < 32; ++rr) s += kst[(pt * 32 + rr) * 68 + d];
            part[pt * 64 + d] = s; }
        __syncthreads();
        if (I_.tid < 64) { float s = 0.f;
#pragma unroll
            for (int pt = 0; pt < 8; ++pt) s += part[pt * 64 + I_.tid];
            ((float*)(ws + WS_KMEAN))[(((size_t)b * 8 + h) * 8 + blk) * 64 + I_.tid] = s * (1.f / 256.f); }
        __syncthreads();
    }
    const int gw = F.vcu * NWAVES + I_.wave, NGW = F.G * NWAVES;
    const f32x4 gq = ((const f32x4*)P.in[I_QLATN])[I_.lane]; const f32x2 gk = ((const f32x2*)P.in[I_KVLATN])[I_.lane];
    for (int m0 = gw * 8; m0 < NTOK; m0 += NGW * 8) {
        u32x2 wq[8]; unsigned wk[8];
#pragma unroll
        for (int q = 0; q < 8; ++q) { wq[q] = *((const u32x2*)(PROJ + (size_t)(m0 + q) * DINP + PC_CQ) + I_.lane); wk[q] = *((const unsigned*)(PROJ + (size_t)(m0 + q) * DINP + PC_CKV) + I_.lane); }
#pragma unroll
        for (int r = 0; r < 8; ++r) { const int m = m0 + r;
            const f32x4 q = {bflo(wq[r].x), bfhi(wq[r].x), bflo(wq[r].y), bfhi(wq[r].y)}; const f32x2 k = {bflo(wk[r]), bfhi(wk[r])};
            const float sq = wave_sum((q.x * q.x + q.y * q.y) + (q.z * q.z + q.w * q.w)), sk = wave_sum(k.x * k.x + k.y * k.y);
            const float rq = 1.0f / sqrtf(sq * (1.f / 256.f) + EPS), rk = 1.0f / sqrtf(sk * (1.f / 128.f) + EPS);
            const f32x4 yq = q * rq * gq; const f32x2 yk = k * rk * gk;
            *((u32x2*)((bf16_t*)(ws + WS_CQN) + (size_t)m * 256) + I_.lane) = (u32x2){cvt_pk_bf16(yq.x, yq.y), cvt_pk_bf16(yq.z, yq.w)};
            *((unsigned*)((bf16_t*)(ws + WS_CKVN) + (size_t)m * 128) + I_.lane) = cvt_pk_bf16(yk.x, yk.y); }
    }
}

__device__ __forceinline__ void phase4(Frame& F) {
    PHASE_IDS();
    const Params& P = *F.P; unsigned char* ws = F.ws;
    const bf16_t* PROJ = (const bf16_t*)(ws + WS_PROJ);
    const float* cosB = (const float*)(ws + WS_ROPE) + 131072; const float* sinB = cosB + 32768;
    const int gw = F.vcu * NWAVES + I_.wave, NGW = F.G * NWAVES;
    for (int it = gw; it < (NTOK / 64) * 16; it += NGW) {
        const int h = it & 7, sel = (it >> 3) & 1, rg = it >> 4; const size_t row = (size_t)rg * 64 + I_.lane; const int pos = (int)(row & (SEQ - 1));
        u32x4 raw[12];
        bf16_t* qrow = (bf16_t*)(ws + WS_QB) + row * 768 + h * 96;
        if (sel == 0) {
#pragma unroll
            for (int c = 0; c < 12; ++c) raw[c] = *(const u32x4*)(qrow + 8 * c);
        } else {
            const bf16_t* kn = (const bf16_t*)(ws + WS_KV) + row * 1024 + h * 128; const bf16_t* kp = PROJ + row * DINP + PC_KPE;
#pragma unroll
            for (int c = 0; c < 8; ++c) raw[c] = *(const u32x4*)(kn + 8 * c);
#pragma unroll
            for (int c = 0; c < 4; ++c) raw[8 + c] = *(const u32x4*)(kp + 8 * c);
        }
        float ss = 0.f;
#pragma unroll
        for (int c = 0; c < 12; ++c) { f32x4 a0, a1; pg8::unpack8(raw[c], a0, a1); ss += (a0[0] * a0[0] + a0[1] * a0[1]) + (a0[2] * a0[2] + a0[3] * a0[3]) + (a1[0] * a1[0] + a1[1] * a1[1]) + (a1[2] * a1[2] + a1[3] * a1[3]); }
        const float rstd = 1.0f / sqrtf(ss * (1.f / 96.f) + EPS);
        const float* gn = sel ? P.in[I_MLAKN] : P.in[I_MLAQN];
        const float sc = sel ? 1.0f : C2B; const float rs = rstd * sc;
        bf16_t* dst = sel ? (bf16_t*)(ws + WS_KB2) + row * 768 + h * 96 : qrow;
#pragma unroll
        for (int c = 0; c < 8; ++c) { f32x4 a0, a1; pg8::unpack8(raw[c], a0, a1); const f32x4 g0 = *(const f32x4*)(gn + 8 * c), g1 = *(const f32x4*)(gn + 8 * c + 4);
            *(u32x4*)(dst + 8 * c) = pg8::pack8(a0 * g0 * rs, a1 * g1 * rs); }
#pragma unroll
        for (int c = 0; c < 2; ++c) { f32x4 x1a, x1b, x2a, x2b; pg8::unpack8(raw[8 + c], x1a, x1b); pg8::unpack8(raw[10 + c], x2a, x2b);
            const f32x4 g1a = *(const f32x4*)(gn + 64 + 8 * c), g1b = *(const f32x4*)(gn + 68 + 8 * c), g2a = *(const f32x4*)(gn + 80 + 8 * c), g2b = *(const f32x4*)(gn + 84 + 8 * c);
            x1a = x1a * g1a * rs; x1b = x1b * g1b * rs; x2a = x2a * g2a * rs; x2b = x2b * g2b * rs;
            const f32x4 ca = *(const f32x4*)(cosB + pos * 16 + 8 * c), cb = *(const f32x4*)(cosB + pos * 16 + 8 * c + 4), sa = *(const f32x4*)(sinB + pos * 16 + 8 * c), sb = *(const f32x4*)(sinB + pos * 16 + 8 * c + 4);
            *(u32x4*)(dst + 64 + 8 * c) = pg8::pack8(x1a * ca - x2a * sa, x1b * cb - x2b * sb);
            *(u32x4*)(dst + 80 + 8 * c) = pg8::pack8(x2a * ca + x1a * sa, x2b * cb + x1b * sb); }
    }
}

__device__ __forceinline__ void phase5(Frame& F) {
    unsigned char* ws = F.ws;
    for (int it = F.vcu; it < 256; it += F.G) {
        const int bh = it >> 2, sidx = it & 3, b = bh >> 3, h = bh & 7;
#pragma unroll 1
        for (int k = 0; k < 2; ++k) { const int qb = k ? 7 - sidx : sidx;
            att::attn_unit<64, true>(b, qb, (const bf16_t*)(ws + WS_QA2) + h * 64, 512, (const bf16_t*)(ws + WS_KA2) + h * 64, 512, (const bf16_t*)(ws + WS_PROJ) + PC_VA + h * 64, DINP,
                                     ws + WS_Y + h * 64, 1024, (const float*)(ws + WS_KMEAN) + (size_t)bh * 512, F.lds, F.wave); }
#pragma unroll 1
        for (int k = 0; k < 2; ++k) { const int qb = k ? 7 - sidx : sidx;
            att::attn_unit<96, false>(b, qb, (const bf16_t*)(ws + WS_QB) + h * 96, 768, (const bf16_t*)(ws + WS_KB2) + h * 96, 768, (const bf16_t*)(ws + WS_KV) + h * 128 + 64, 1024,
                                      ws + WS_Y + 512 + h * 64, 1024, nullptr, F.lds, F.wave); }
    }
}

__device__ __forceinline__ void phase8(Frame& F) {
    PHASE_IDS();
    const Params& P = *F.P; unsigned char* ws = F.ws;
    constexpr int HCS = 132, WCS = 48;
    LAS float* HC = (LAS float*)F.lds;
    LAS float* WC = HC + 2 * 64 * HCS;
    LAS float* RSTD = WC + 2 * 128 * WCS;
    LAS float* LOGIT = RSTD + 64;
    LAS int* pe = (LAS int*)(LOGIT + 64 * 33);
    int* PAIR_E = (int*)(ws + WS_PAIR); int* PAIR_RANK = PAIR_E + 65536; float* PAIR_W = (float*)(PAIR_E + 131072);
    const float* gffn = P.in[I_GFFN]; const float* wr_ = P.in[I_WR]; const float* br_ = P.in[I_BR];
    const int r0 = F.vcu * 64;
    if (I_.tid < 64) { const f32x4* sp = (const f32x4*)((const float*)(ws + WS_SSP) + (size_t)(r0 + I_.tid) * 16); const f32x4 a = sp[0], b = sp[1], c = sp[2], d = sp[3];
        const float ss = (((a[0] + a[1]) + (a[2] + a[3])) + ((b[0] + b[1]) + (b[2] + b[3]))) + (((c[0] + c[1]) + (c[2] + c[3])) + ((d[0] + d[1]) + (d[2] + d[3])));
        RSTD[I_.tid] = 1.0f / sqrtf(ss * (1.f / DM) + EPS); }
    __syncthreads();
    const int eg = I_.wave & 1, rgp = I_.wave >> 1, l15 = I_.lane & 15, l4 = I_.lane >> 4;
    const int srow = I_.tid >> 5, sc4 = I_.tid & 31;
    const int wrow = I_.tid >> 3, wc4 = I_.tid & 7;
    f32x4 stg[4], wst[2];
#define P8_LOAD(kc) do { _Pragma("unroll") for (int i = 0; i < 4; ++i) { const u32x2 w_ = *(const u32x2*)((const bf16_t*)(ws + WS_X1B) + (size_t)(r0 + srow + 16 * i) * DM + (kc) * 128 + 4 * sc4); stg[i] = (f32x4){bflo(w_.x), bfhi(w_.x), bflo(w_.y), bfhi(w_.y)}; } \
        _Pragma("unroll") for (int i = 0; i < 2; ++i) wst[i] = *(const f32x4*)(wr_ + (size_t)((kc) * 128 + wrow + 64 * i) * 32 + 4 * wc4); } while (0)
#define P8_STORE(kc, buf) do { const f32x4 g4 = *(const f32x4*)(gffn + (kc) * 128 + 4 * sc4); _Pragma("unroll") for (int i = 0; i < 4; ++i) { const float rs = RSTD[srow + 16 * i]; const f32x4 y = stg[i] * rs * g4; \
        *(LAS f32x4*)(HC + ((buf) * 64 + srow + 16 * i) * HCS + 4 * sc4) = y; *(unsigned*)(ws + WS_HNF8 + (size_t)(r0 + srow + 16 * i) * DM + (kc) * 128 + 4 * sc4) = pack4_fp8(y.x, y.y, y.z, y.w); } \
        _Pragma("unroll") for (int i = 0; i < 2; ++i) *(LAS f32x4*)(WC + ((buf) * 128 + wrow + 64 * i) * WCS + 4 * wc4) = wst[i]; } while (0)
    P8_LOAD(0); P8_STORE(0, 0);
    __syncthreads();
    f32x4 acc = {0.f, 0.f, 0.f, 0.f};
#pragma unroll 1
    for (int kc = 0; kc < 8; ++kc) { const int buf = kc & 1;
        if (kc + 1 < 8) P8_LOAD(kc + 1);
        const LAS float* wp = WC + (buf * 128 + l4) * WCS + eg * 16 + l15;
        const LAS float* hp = HC + (buf * 64 + rgp * 16 + l15) * HCS + l4;
#pragma unroll
        for (int kk = 0; kk < 32; ++kk) acc = __builtin_amdgcn_mfma_f32_16x16x4f32(wp[4 * kk * WCS], hp[4 * kk], acc, 0, 0, 0);
        if (kc + 1 < 8) P8_STORE(kc + 1, buf ^ 1);
        __syncthreads(); }
#undef P8_LOAD
#undef P8_STORE
#pragma unroll
    for (int i = 0; i < 4; ++i) { const int e = eg * 16 + 4 * l4 + i; LOGIT[(rgp * 16 + l15) * 33 + e] = acc[i] + br_[e]; }
    __syncthreads();
    if (I_.tid < 64) { const int rr = I_.tid, m = r0 + rr;
        float lg[32];
#pragma unroll
        for (int e = 0; e < 32; ++e) lg[e] = LOGIT[rr * 33 + e];
        int te[4]; float tv[4]; unsigned used = 0u;
#pragma unroll
        for (int k = 0; k < 4; ++k) { float best = -INFINITY; int bi = 0;
#pragma unroll
            for (int e = 0; e < 32; ++e) { const bool ok = !((used >> e) & 1u) && (lg[e] > best); best = ok ? lg[e] : best; bi = ok ? e : bi; }
            used |= 1u << bi; te[k] = bi; tv[k] = best; }
        const float e0 = 1.0f, e1 = __expf(tv[1] - tv[0]), e2 = __expf(tv[2] - tv[0]), e3 = __expf(tv[3] - tv[0]); const float inv = 1.0f / (e0 + e1 + e2 + e3);
        *(i32x4*)(PAIR_E + m * 4) = (i32x4){te[0], te[1], te[2], te[3]};
        *(f32x4*)(PAIR_W + m * 4) = (f32x4){e0 * inv, e1 * inv, e2 * inv, e3 * inv};
        *(LAS i32x4*)(pe + rr * 4) = (i32x4){te[0], te[1], te[2], te[3]}; }
    __syncthreads();
    if (I_.tid < 256) { const int e = pe[I_.tid]; int rank = 0;
#pragma unroll 16
        for (int j4 = 0; j4 < 64; ++j4) { const i32x4 v = *(const LAS i32x4*)(pe + 4 * j4); const int j = 4 * j4;
            rank += ((j < I_.tid) && v.x == e) + ((j + 1 < I_.tid) && v.y == e) + ((j + 2 < I_.tid) && v.z == e) + ((j + 3 < I_.tid) && v.w == e); }
        PAIR_RANK[r0 * 4 + I_.tid] = rank; }
    else if (I_.tid < 288) { const int e = I_.tid - 256; int c = 0;
#pragma unroll 16
        for (int j4 = 0; j4 < 64; ++j4) { const i32x4 v = *(const LAS i32x4*)(pe + 4 * j4); c += (v.x == e) + (v.y == e) + (v.z == e) + (v.w == e); }
        ((int*)(ws + WS_HIST))[F.vcu * 32 + e] = c; }
    __syncthreads();
}

__device__ __forceinline__ int moe_layout(Frame& F) {
    PHASE_IDS();
    LAS int* ctl = (LAS int*)(F.lds + LDS_CTL);
    LAS int* part = ctl + 512;
    const int* HIST = (const int*)(F.ws + WS_HIST);
    __syncthreads();
    { const int e = I_.tid & 31, pt = I_.tid >> 5; int tot = 0, before = 0; int c[16];
#pragma unroll
        for (int i = 0; i < 16; ++i) c[i] = HIST[(pt * 16 + i) * 32 + e];
#pragma unroll
        for (int i = 0; i < 16; ++i) { tot += c[i]; before += (pt * 16 + i < F.vcu) ? c[i] : 0; }
        part[pt * 64 + e] = tot; part[pt * 64 + 32 + e] = before; }
    __syncthreads();
    if (I_.tid < 32) { int tot = 0, before = 0;
#pragma unroll
        for (int pt = 0; pt < 16; ++pt) { tot += part[pt * 64 + I_.tid]; before += part[pt * 64 + 32 + I_.tid]; }
        ctl[I_.tid] = tot; ctl[65 + I_.tid] = before; }
    __syncthreads();
    if (I_.tid < 32) { const int e = I_.tid; const int nt_ = (ctl[e] + 255) >> 8; int sc = nt_;
#pragma unroll
        for (int o = 1; o < 32; o <<= 1) { const int up = __shfl_up(sc, o); sc += (e >= o) ? up : 0; }
        const int t0 = sc - nt_; ctl[32 + e] = t0 * 256; ctl[65 + e] += t0 * 256;
        for (int t = 0; t < nt_; ++t) ctl[128 + t0 + t] = e;
        if (e == 31) { ctl[64] = sc * 256; ctl[100] = sc; } }
    __syncthreads();
    return ctl[100];
}

__device__ __forceinline__ void phase9(Frame& F) {
    PHASE_IDS();
    unsigned char* ws = F.ws;
    moe_layout(F);
    LAS int* ctl = (LAS int*)(F.lds + LDS_CTL);
    const int* PAIR_E = (const int*)(ws + WS_PAIR); const int* PAIR_RANK = PAIR_E + 65536; int* ROWDEST = (int*)(ws + WS_PAIR) + 196608; int* TOK = (int*)(ws + WS_TOK);
    const int rows_per_blk = NTOK / F.G;
    if (I_.tid < rows_per_blk * 4) { const int gp = F.vcu * rows_per_blk * 4 + I_.tid;
        const int e = PAIR_E[gp], rk = PAIR_RANK[gp]; const int dest = ctl[65 + e] + rk;
        ROWDEST[gp] = dest; TOK[dest] = gp >> 2; }
    if (F.vcu < 32) { const int e = F.vcu; const int lo = ctl[32 + e] + ctl[e], hi = (e == 31) ? ctl[64] : ctl[33 + e];
        for (int r = lo + I_.tid; r < hi; r += NTHREADS) TOK[r] = 0; }
}

__device__ __forceinline__ void stage_tok(Frame& F, int nmt, int ntn) {
    PHASE_IDS();
    const int* TOK = (const int*)(F.ws + WS_TOK); LAS unsigned short* tokl = (LAS unsigned short*)(F.lds + LDS_TOKL);
    for (int i = 0; i < 10; ++i) { const int j = (i * F.G + (int)blockIdx.x) >> 3; const int mt = (j / ntn) * 8 + ((int)blockIdx.x & 7); if (mt >= nmt) break;
        if (I_.tid < 256) tokl[i * 256 + I_.tid] = (unsigned short)TOK[mt * 256 + I_.tid]; }
    __syncthreads();
}

__device__ __forceinline__ void phase12(Frame& F) {
    PHASE_IDS();
    const Params& P = *F.P; unsigned char* ws = F.ws;
    const int gw = F.vcu * NWAVES + I_.wave, NGW = F.G * NWAVES;
    const float* PAIR_W = (const float*)(ws + WS_PAIR) + 131072; const int* ROWDEST = (const int*)(ws + WS_PAIR) + 196608;
    const bf16_t* YP = (const bf16_t*)(ws + WS_XG);
    const f32x4* gp = (const f32x4*)P.in[I_GPLE] + I_.lane; f32x4 gv[4];
#pragma unroll
    for (int j = 0; j < 4; ++j) gv[j] = gp[64 * j];
    for (int m0 = gw; m0 < NTOK; m0 += 2 * NGW) {
        int mm[2]; mm[0] = m0; mm[1] = (m0 + NGW < NTOK) ? m0 + NGW : m0;
        f32x4 wv[2]; i32x4 dv[2];
#pragma unroll
        for (int q = 0; q < 2; ++q) { wv[q] = *(const f32x4*)(PAIR_W + mm[q] * 4); dv[q] = *(const i32x4*)(ROWDEST + mm[q] * 4); }
        f32x4 v[2][4]; u32x2 y[2][4][4];
#pragma unroll
        for (int q = 0; q < 2; ++q) { const u32x2* xr = (const u32x2*)((const bf16_t*)(ws + WS_X1B) + (size_t)mm[q] * DM) + I_.lane;
#pragma unroll
            for (int j = 0; j < 4; ++j) { const u32x2 w_ = xr[64 * j]; v[q][j] = (f32x4){bflo(w_.x), bfhi(w_.x), bflo(w_.y), bfhi(w_.y)}; }
#pragma unroll
            for (int k = 0; k < 4; ++k) { const u32x2* yr = (const u32x2*)(YP + (size_t)dv[q][k] * DM) + I_.lane;
#pragma unroll
                for (int j = 0; j < 4; ++j) y[q][k][j] = yr[64 * j]; } }
#pragma unroll
        for (int q = 0; q < 2; ++q) { if (q == 1 && mm[1] == mm[0]) break;
            float s = 0.f; u32x2* xw = (u32x2*)((bf16_t*)(ws + WS_X1B) + (size_t)mm[q] * DM) + I_.lane;
#pragma unroll
            for (int j = 0; j < 4; ++j) {
#pragma unroll
                for (int k = 0; k < 4; ++k) { const u32x2 yy = y[q][k][j]; v[q][j] += (f32x4){bflo(yy.x), bfhi(yy.x), bflo(yy.y), bfhi(yy.y)} * wv[q][k]; }
                xw[64 * j] = (u32x2){cvt_pk_bf16(v[q][j].x, v[q][j].y), cvt_pk_bf16(v[q][j].z, v[q][j].w)}; s += (v[q][j].x * v[q][j].x + v[q][j].y * v[q][j].y) + (v[q][j].z * v[q][j].z + v[q][j].w * v[q][j].w); }
            const float rstd = 1.0f / sqrtf(wave_sum(s) * (1.f / DM) + EPS);
            unsigned* o4 = (unsigned*)(ws + WS_HNF8 + (size_t)mm[q] * DM) + I_.lane;
#pragma unroll
            for (int j = 0; j < 4; ++j) { const f32x4 yo = v[q][j] * rstd * gv[j]; o4[64 * j] = pack4_fp8(yo.x, yo.y, yo.z, yo.w); } }
    }
}

__global__ void __launch_bounds__(NTHREADS, 2) fwd(Params prm) {
    extern __shared__ __attribute__((aligned(16))) unsigned char lds_raw[];
    Frame F;
    F.lds = (LAS unsigned char*)lds_raw;
    F.wave = __builtin_amdgcn_readfirstlane((int)threadIdx.x >> 6);
    if (threadIdx.x < 2) ((volatile LAS unsigned*)(F.lds + LDS_BARST))[threadIdx.x] = 0u;
    const XcdBarrier bar = xcd_barrier_post((unsigned*)(prm.ws + WS_BAR), (volatile LAS unsigned*)(F.lds + LDS_BARST), F.wave);
    if (prm.ph_lo < 0) cg::this_grid().sync();
    __syncthreads();
    F.G = gridDim.x; { const int bx = blockIdx.x; F.vcu = (F.G % 8 == 0) ? (bx % 8) * (F.G / 8) + bx / 8 : bx; }
    F.P = &prm; F.ws = prm.ws;
    unsigned char* ws = prm.ws;
    const int lo = prm.ph_lo, hi = prm.ph_hi;
#ifndef PH_MASK
#define PH_MASK 0xffffu
#endif
#ifndef REP_MASK
#define REP_MASK 0u
#endif
#define IN(k) (((PH_MASK >> (k)) & 1u) && lo <= (k) && (k) < hi)
#define REPS(k) for (int rep_ = 0; rep_ < (((REP_MASK >> (k)) & 1u) ? 2 : 1); ++rep_, (((REP_MASK >> (k)) & 1u) && rep_ < 2 ? xcd_barrier(bar) : (void)0))
#define SEAM(k) do { __builtin_amdgcn_sched_barrier(0); asm volatile("" ::: "memory"); if (IN(k) && IN((k) + 1)) xcd_barrier(bar); STAMP((k) + 1); __builtin_amdgcn_sched_barrier(0); asm volatile("" ::: "memory"); } while (0)
    using namespace pg8;
    STAMP(0);
    if (IN(0)) REPS(0) phase0(F);
    SEAM(0);
    if (IN(1)) REPS(1) {
        { Gemm g{(const bf16_t*)(ws + WS_HNF8), (const bf16_t*)(ws + WS_WIN), 512, 512, 512}; StaticOrder S; S.init(NTOK, 2048, F.G, (int)blockIdx.x);
          const float* cosA_ = (const float*)(ws + WS_ROPE);
          EpiProj E{(bf16_t*)(ws + WS_PROJ), (bf16_t*)(ws + WS_QA2), (bf16_t*)(ws + WS_KA2), (float*)(ws + WS_KMEAN), (bf16_t*)(ws + WS_CQN), (bf16_t*)(ws + WS_CKVN),
                    prm.in[I_MQN], prm.in[I_MKN], prm.in[I_QLATN], prm.in[I_KVLATN], cosA_, cosA_ + 65536, (LAS float*)(F.lds + LDS_TOKL), (float*)(ws + WS_KPESS)};
          gemm_phase<EpiProj, StaticOrder, false, true>(F.lds, F.wave, g, S, E); }
        __builtin_amdgcn_sched_barrier(0); asm volatile("" ::: "memory");
        { Gemm g{(const bf16_t*)(ws + WS_HNF8), (const bf16_t*)(ws + WS_WINF8), 512, 512, 512}; StaticOrder S; S.init(NTOK, 2048, F.G, (int)blockIdx.x);
          EpiStore E{(bf16_t*)(ws + WS_PROJ) + PC_GA, DINP, nullptr, 0, 0}; gemm_phase<EpiStore, StaticOrder, false, true>(F.lds, F.wave, g, S, E); } }
    SEAM(1);
    if (IN(3)) REPS(3) {
        const float* cosB_ = (const float*)(ws + WS_ROPE) + 131072;
        { Gemm g{(const bf16_t*)(ws + WS_CQN), (const bf16_t*)(ws + WS_WUQ), 256, 256, 256}; StaticOrder S; S.init(NTOK, 1024, F.G, (int)blockIdx.x);
          EpiQB E{(bf16_t*)(ws + WS_QB), prm.in[I_MLAQN], cosB_, cosB_ + 32768, (LAS float*)(F.lds + LDS_CTL)}; gemm_phase(F.lds, F.wave, g, S, E); }
        __builtin_amdgcn_sched_barrier(0); asm volatile("" ::: "memory");
        { Gemm g{(const bf16_t*)(ws + WS_CKVN), (const bf16_t*)(ws + WS_WUKV), 128, 128, 128}; StaticOrder S; S.init(NTOK, 1024, F.G, (int)blockIdx.x);
          EpiKV E{(bf16_t*)(ws + WS_KB2), (bf16_t*)(ws + WS_KV), (const bf16_t*)(ws + WS_PROJ), (const float*)(ws + WS_KPESS), prm.in[I_MLAKN], cosB_, cosB_ + 32768, (LAS float*)(F.lds + LDS_CTL)};
          gemm_phase(F.lds, F.wave, g, S, E); } }
    SEAM(3);
    if (IN(5)) REPS(5) phase5(F);
    SEAM(5);
    if (IN(6)) REPS(6) { Gemm g{(const bf16_t*)(ws + WS_Y), (const bf16_t*)(ws + WS_WA), 512, 256, 256}; BranchOrder S; S.so.init(NTOK, DM, F.G, (int)blockIdx.x);
        EpiGateAB E{(bf16_t*)(ws + WS_MERGED), (const bf16_t*)(ws + WS_PROJ) + PC_GA, (const bf16_t*)(ws + WS_PROJ) + PC_GB, DINP, ws + WS_KA2  };
        gemm_phase<EpiGateAB, BranchOrder, false, true>(F.lds, F.wave, g, S, E); }
    SEAM(7);
    if (IN(8)) REPS(8) { Gemm g{(const bf16_t*)(ws + WS_KA2), (const bf16_t*)(ws + WS_WO), 512, 512, 512}; StaticOrder S; S.init(NTOK, DM, F.G, (int)blockIdx.x);
        EpiResF32 E{prm.in[I_X], (bf16_t*)(ws + WS_X1B), (float*)(ws + WS_SSP)}; gemm_phase<EpiResF32, StaticOrder, false, true>(F.lds, F.wave, g, S, E); }
    SEAM(8);
    if (IN(9)) REPS(9) phase8(F);
    SEAM(9);
    if (IN(10)) REPS(10) phase9(F);
    SEAM(10);
    if (IN(11)) REPS(11) { const int nmt = ((const LAS int*)(F.lds + LDS_CTL))[100]; stage_tok(F, nmt, 8);
        Gemm g{(const bf16_t*)(ws + WS_HNF8), (const bf16_t*)(ws + WS_W1), 512, 512, 512}; MoeOrder S{(const LAS int*)(F.lds + LDS_CTL) + 128, nmt, 8, F.G, (int)blockIdx.x};
        EpiSwiglu E{ws + WS_ACT, prm.in[I_BGU]}; gemm_phase<EpiSwiglu, MoeOrder, true, true>(F.lds, F.wave, g, S, E, (const LAS unsigned short*)(F.lds + LDS_TOKL)); }
    SEAM(11);
    if (IN(12)) REPS(12) { const int nmt = ((const LAS int*)(F.lds + LDS_CTL))[100];
        Gemm g{(const bf16_t*)(ws + WS_ACT), (const bf16_t*)(ws + WS_W2), 512, 512, 512}; MoeOrder S{(const LAS int*)(F.lds + LDS_CTL) + 128, nmt, 4, F.G, (int)blockIdx.x};
        EpiStoreBias E{(bf16_t*)(ws + WS_XG), DM, prm.in[I_BD], 1024}; gemm_phase<EpiStoreBias, MoeOrder, false, true>(F.lds, F.wave, g, S, E); }
    SEAM(12);
    if (IN(13)) REPS(13) phase12(F);
    SEAM(13);
    if (IN(14)) REPS(14) { Gemm g{(const bf16_t*)(ws + WS_PB), (const bf16_t*)(ws + WS_WPP), 256, 256, 256}; StaticOrder S; S.init(NTOK, DM, F.G, (int)blockIdx.x);
        EpiStore E{(bf16_t*)(ws + WS_PP), DM, nullptr, 0, 1 << 30}; gemm_phase(F.lds, F.wave, g, S, E); }
    __builtin_amdgcn_sched_barrier(0); asm volatile("s_waitcnt vmcnt(0)" ::: "memory"); __syncthreads();
    if (IN(15)) REPS(15) { Gemm g{(const bf16_t*)(ws + WS_HNF8), (const bf16_t*)(ws + WS_WPG), 512, 512, 512}; StaticOrder S; S.init(NTOK, DM, F.G, (int)blockIdx.x);
        EpiFinal E{prm.out, (const bf16_t*)(ws + WS_PP), (const bf16_t*)(ws + WS_X1B)}; gemm_phase<EpiFinal, StaticOrder, false, true>(F.lds, F.wave, g, S, E); }
#ifdef TPROBE_A
    STAMP(16);
    xcd_barrier(bar);
    if (blockIdx.x == 0 && F.wave == 0 && lane_id() == 0) {
        volatile unsigned long long* ts = (volatile unsigned long long*)(ws + WS_ERR);
        const unsigned long long da = ts[TPROBE_A1] - ts[TPROBE_A], db = ts[TPROBE_B1] - ts[TPROBE_B];
        asm volatile("s_waitcnt vmcnt(0)" ::: "memory");
        prm.out[0] += (float)db * (0.01f / 4.0f);
        const unsigned long long t0 = __builtin_amdgcn_s_memrealtime();
        while (__builtin_amdgcn_s_memrealtime() - t0 < 4ull * da) __builtin_amdgcn_s_sleep(4);
    }
#endif
#undef IN
#undef SEAM
}

extern "C" void kernel_launch(void* const* d_in, const int* in_sizes, int n_in, void* d_out, int out_size, void* d_ws, size_t ws_size, hipStream_t stream) {
    static int grid = 0;
    if (grid == 0) {
        int dev = 0, cus = 0, per_cu = 0;
        (void)hipGetDevice(&dev);
        (void)hipDeviceGetAttribute(&cus, hipDeviceAttributeMultiprocessorCount, dev);
        (void)hipFuncSetAttribute((const void*)fwd, hipFuncAttributeMaxDynamicSharedMemorySize, LDS_BYTES);
        (void)hipOccupancyMaxActiveBlocksPerMultiprocessor(&per_cu, (const void*)fwd, NTHREADS, LDS_BYTES);
        fprintf(stderr, "cus %d per_cu %d ws %zu n_in %d\n", cus, per_cu, ws_size, n_in);
        grid = (per_cu >= 1) ? cus : -1;
        if (grid != 256 || n_in != 25 || ws_size < WS_END || out_size != NTOK * DM) { fprintf(stderr, "kernel_launch: unsupported configuration\n"); grid = -1; }
    }
    if (grid < 0) return;
    (void)hipMemsetAsync((char*)d_ws + WS_BAR, 0, WS_BAR_BYTES, stream);
    Params a{};
    for (int i = 0; i < 25; ++i) a.in[i] = (const float*)d_in[i];
    a.out = (float*)d_out; a.ws = (unsigned char*)d_ws;
#ifndef MULTI_LAUNCH
    a.ph_lo = 0; a.ph_hi = NPHASE;
    void* args[] = {&a};
    hipError_t e = hipLaunchCooperativeKernel((const void*)fwd, dim3(grid), dim3(NTHREADS), args, LDS_BYTES, stream);
    if (e != hipSuccess) fprintf(stderr, "cooperative launch failed: %s\n", hipGetErrorString(e));
#else
    for (int k = 0; k < NPHASE; ++k) { a.ph_lo = k; a.ph_hi = k + 1; void* args[] = {&a};
        hipError_t e = hipLaunchCooperativeKernel((const void*)fwd, dim3(grid), dim3(NTHREADS), args, LDS_BYTES, stream);
        if (e != hipSuccess) fprintf(stderr, "launch %d failed: %s\n", k, hipGetErrorString(e)); }
#endif
}
```

```cpp
#include <hip/hip_runtime.h>
#include <hip/hip_cooperative_groups.h>
#include <cstdio>
#include <cstdint>
namespace cg = cooperative_groups;

#define LAS __attribute__((address_space(3)))
typedef unsigned short bf16_t;
typedef short bf16x8 __attribute__((ext_vector_type(8)));
typedef short s16x4 __attribute__((ext_vector_type(4)));
typedef float f32x4 __attribute__((ext_vector_type(4)));
typedef float f32x2 __attribute__((ext_vector_type(2)));
typedef float f32x16 __attribute__((ext_vector_type(16)));
typedef unsigned u32x4 __attribute__((ext_vector_type(4)));
typedef unsigned u32x2 __attribute__((ext_vector_type(2)));
typedef int i32x4 __attribute__((ext_vector_type(4)));
typedef int i32x8 __attribute__((ext_vector_type(8)));
typedef __bf16 bf16x2_t __attribute__((ext_vector_type(2)));

constexpr int NB = 8, SEQ = 2048, NTOK = NB * SEQ, DM = 1024;
constexpr int DIN = 4000, DINP = 4096;
constexpr int NEXP = 32, TOPK = 4, DEXP = 1024;
constexpr int NTHREADS = 512, NWAVES = 8;
constexpr float EPS = 1e-6f;
constexpr float LOG2E = 1.4426950408889634f;
constexpr float C2A = 0.125f * LOG2E;
constexpr float C2B = 0.10206207261596575f * LOG2E;
constexpr int PC_QA = 0, PC_KA = 512, PC_VA = 1024, PC_CQ = 1536, PC_CKV = 1792, PC_KPE = 1920, PC_GA = 2048, PC_GB = 3072;

constexpr size_t MiB = 1u << 20;
constexpr size_t WS_HIST = 0;
constexpr size_t WS_ERR = 64 * 1024;
#ifndef CONV_DEPTH
#define CONV_DEPTH 2
#endif
#ifndef CONV_IN_ATTN
#define CONV_IN_ATTN 1
#endif
constexpr int Q_HEAD_WORD = 3584;
constexpr size_t WS_BAR = 128 * 1024;
constexpr size_t WS_BAR_BYTES = 16 * 1024;
constexpr size_t WS_KPESS = 576 * 1024;
constexpr size_t WS_TOK = 256 * 1024;
constexpr size_t WS_ROPE = 1 * MiB;
constexpr size_t WS_KMEAN = 2 * MiB;
constexpr size_t WS_SSP = 11 * MiB;
constexpr size_t WS_PAIR = 3 * MiB;
constexpr size_t WS_WUQ = 4 * MiB, WS_WUKV = 4 * MiB + 512 * 1024, WS_WPP = 5 * MiB, WS_WA = 6 * MiB, WS_WB = 7 * MiB, WS_WO = 8 * MiB, WS_WPG = 10 * MiB, WS_WIN = 12 * MiB;
constexpr size_t WS_W1 = 20 * MiB, WS_W2 = 148 * MiB;
constexpr size_t WS_WINF8 = 14 * MiB;
constexpr size_t WS_HNF8 = 84 * MiB;
constexpr size_t WS_HN = 212 * MiB, WS_PB = 244 * MiB;
constexpr size_t WS_X1B = WS_HN;
constexpr size_t WS_CQN = 252 * MiB, WS_CKVN = 260 * MiB, WS_QB = 264 * MiB, WS_KV = 288 * MiB, WS_KB2 = 320 * MiB, WS_Y = 344 * MiB, WS_MERGED = 376 * MiB;
constexpr size_t WS_ACT = 252 * MiB;
constexpr size_t WS_PP = 400 * MiB;
constexpr size_t WS_KA2 = 432 * MiB;
constexpr size_t WS_PROJ = 448 * MiB;
constexpr size_t WS_QA2 = 576 * MiB;
constexpr size_t WS_XG = 448 * MiB;
constexpr size_t WS_END = 592 * MiB;
constexpr int MAXROWS = 73728, MAXMT = 288;

constexpr int RING_BYTES = 131072;
constexpr int LDS_CTL = RING_BYTES;
constexpr int LDS_TOKL = RING_BYTES + 8192 + 256;
constexpr int LDS_BARST = RING_BYTES + 8192;
constexpr int LDS_BYTES = 147456;

__device__ __forceinline__ unsigned cvt_pk_bf16(float lo, float hi) { f32x2 v = {lo, hi}; bf16x2_t b = __builtin_convertvector(v, bf16x2_t); return __builtin_bit_cast(unsigned, b); }
__device__ __forceinline__ unsigned pack4_fp8(float a, float b, float c, float d) { int w = 0; w = __builtin_amdgcn_cvt_pk_fp8_f32(a, b, w, false); w = __builtin_amdgcn_cvt_pk_fp8_f32(c, d, w, true); return (unsigned)w; }
__device__ __forceinline__ float bf2f(unsigned short b) { return __uint_as_float(((unsigned)b) << 16); }
__device__ __forceinline__ float bflo(unsigned w) { return __uint_as_float(w << 16); }
__device__ __forceinline__ float bfhi(unsigned w) { return __uint_as_float(w & 0xffff0000u); }
__device__ __forceinline__ float sigmoidf_(float x) { return __builtin_amdgcn_rcpf(1.0f + __builtin_amdgcn_exp2f(-x * LOG2E)); }
__device__ __forceinline__ int lane_id() { return (int)__builtin_amdgcn_mbcnt_hi(~0u, __builtin_amdgcn_mbcnt_lo(~0u, 0u)); }
__device__ __forceinline__ float wave_sum(float v) {
#pragma unroll
    for (int o = 1; o < 64; o <<= 1) v += __shfl_xor(v, o);
    return v;
}

namespace pg8 {
constexpr int BM = 256, BK = 64, HALF = 128, HTB = HALF * BK * 2, STAGE_BYTES = 8 * HTB, NXCD = 8, WGM = 8;
__host__ __device__ __forceinline__ int lds_byte(int r, int c) { const int st = (r >> 4) * 2 + (c >> 5), rr = r & 15, cc = c & 31, ob = rr * 64 + cc * 2; return st * 1024 + (ob ^ (((ob >> 9) & 1) << 5)); }
__host__ __device__ __forceinline__ void stage_rc(int b, int& R, int& C) { const int st = b / 1024, sb = b % 1024, swz = sb ^ (((sb >> 9) & 1) << 5); R = (st >> 1) * 16 + swz / 64; C = (st & 1) * 32 + (swz % 64) / 2; }
__host__ __device__ __forceinline__ int perm32(int rho) { const int n = rho >> 4, i = rho & 15; return 8 * (i >> 2) + 4 * n + (i & 3); }

struct Unit { int pm, pn, pb, e; int aofs = 0; };
struct Gemm { const bf16_t* A; const bf16_t* Bt; int lda, ldb, K; };

template <class A_, class B_> struct same_t { static constexpr bool v = false; }; template <class A_> struct same_t<A_, A_> { static constexpr bool v = true; };
struct EpiSwiglu; struct EpiStoreBias; struct EpiStore; struct EpiResF32; struct EpiFinal; struct EpiGateAB; struct EpiQB; struct EpiKV;
struct StaticOrder {
    int nM, nN, nwg, G, c;
    __device__ void init(int M, int N, int G_, int c_) { nM = M / BM; nN = N / BM; nwg = nM * nN; G = G_; c = c_; }
    __device__ bool next(int i, Unit& u) const {
        const long L = (long)i * G + c; if (L >= nwg) return false;
        int wgid = (int)L; { const int q = nwg / NXCD, r = nwg % NXCD, xcd = wgid % NXCD, off = wgid / NXCD; wgid = (xcd < r ? xcd * (q + 1) : r * (q + 1) + (xcd - r) * q) + off; }
        const int nig = WGM * nN, gid = wgid / nig, fm = gid * WGM, gsz = (nM - fm) < WGM ? (nM - fm) : WGM;
        u.pm = fm + ((wgid % nig) % gsz); u.pn = (wgid % nig) / gsz; u.pb = u.pn; u.e = 0; return true;
    }
};
__host__ __device__ __forceinline__ int moe_mt(int j, int ntn, int per, int c, int nmt) { const int row = j / ntn, R = 8 * per, i = row / per;
    if ((i + 1) * R <= nmt) return i * R + (c & 7) * per + row % per;
    return i * R + (row % per) * 8 + (c & 7); }
struct MoeOrder {
    const LAS int* tile_e; int nmt, ntn, G, c, per;
    __device__ bool next(int i, Unit& u) const {
        const int j = (i * G + c) >> 3; const int mt = moe_mt(j, ntn, per, c, nmt), pn = j % ntn; if (mt >= nmt) return false;
        const int e = __builtin_amdgcn_readfirstlane(tile_e[mt]);
        u.pm = mt; u.pn = pn; u.pb = e * ntn + pn; u.e = e; return true;
    }
};

#ifdef XPROBE
struct ProbeOrder { int mode, G, c, reps;
    __device__ bool next(int i, Unit& u) const { if (i >= reps) return false; u.e = 0; u.aofs = 0;
        if (mode == 1) { u.pm = 0; u.pn = 0; u.pb = 0; }
        else if (mode == 2) { StaticOrder S; S.init(16384, 2048, G, c); Unit t; S.next(i & 1, t); u.pm = t.pm; u.pn = t.pn; u.pb = t.pb; }
        else { u.pm = c; u.pn = 0; u.pb = (c + 1) & 255; }
        return true; } };
struct EpiNone { struct Pre {}; static constexpr bool HAS_PRE = false;
    float* O;
    __device__ __forceinline__ void operator()(const f32x4 (&acc)[2][2][4][2], const Unit& u, int wr, int wc, int fr, int fq) const { if (acc[0][0][0][0][0] == 123456.789f && acc[1][1][3][1][3] == 3.25f) *O = 1.0f; } };
#endif
template <class Epi, class Sched, bool GATHER = false, bool FP8 = false>
__device__ __forceinline__ void gemm_phase(LAS unsigned char* lds, int wave, const Gemm g, const Sched& S, const Epi& E, const LAS unsigned short* tokl = nullptr) {
    constexpr bool ALIGN_EPI = true;
    int lane = lane_id(); asm volatile("" : "+v"(lane));
    const int wid = wave, tid = wid * 64 + lane, wr = wid >> 2, wc = wid & 3, fr = lane & 15, fq = lane >> 4;
    int K = g.K; asm volatile("" : "+s"(K));
    const int nt = K / BK;
    unsigned voffA[2], voffB[2]; int gR[2]; unsigned gC[2];
#pragma unroll
    for (int i = 0; i < 2; ++i) { int R, C; stage_rc(tid * 16 + i * 8192, R, C); const int Rb = (R & ~31) + perm32(R & 31);
        voffA[i] = (unsigned)(R * g.lda + C) * 2u; voffB[i] = (unsigned)(Rb * g.ldb + C) * 2u; gR[i] = R; gC[i] = (unsigned)C * 2u; }
    unsigned goff[2][2], noff[2][2];
#define PG8_GOFF(dst, ui_) do { _Pragma("unroll") for (int h_ = 0; h_ < 2; ++h_) _Pragma("unroll") for (int i_ = 0; i_ < 2; ++i_) \
        dst[h_][i_] = (unsigned)tokl[(ui_) * 256 + h_ * HALF + gR[i_]] * (unsigned)(g.lda * 2) + gC[i_]; } while (0)
    const size_t kstep = (size_t)(BK * 2);
    const size_t hstepA = (size_t)HALF * g.lda * 2, hstepB = (size_t)HALF * g.ldb * 2;
    const size_t tstepA = 2 * hstepA, tstepB = 2 * hstepB;
    const unsigned ldsw = (unsigned)wid * 1024u;
    const int aoff = lds_byte(wr * 64 + fr, fq * 8), boff = lds_byte(wc * 32 + fr, fq * 8);
#define PG8_SA(b, h) (((b) * 2 + (h)) * HTB)
#define PG8_SB(b, h) ((4 + (b) * 2 + (h)) * HTB)
#define PG8_STAGE(bufoff, gbase, voff) do { _Pragma("unroll") for (int _i = 0; _i < 2; ++_i) \
        __builtin_amdgcn_global_load_lds((const unsigned*)((const char*)(gbase) + (voff)[_i]), (LAS unsigned*)(lds + (bufoff) + ldsw + _i * 8192), 16, 0, 0); } while (0)
#define PG8_STAGE_A(bufoff, ptr_ng, k_g, off_g) do { if constexpr (GATHER) { const char* gb_ = (const char*)g.A + (size_t)(k_g) * kstep; PG8_STAGE(bufoff, gb_, off_g); } else { PG8_STAGE(bufoff, ptr_ng, voffA); } } while (0)
#define PG8_LDA(dst, b, h) do { if constexpr (FP8) { _Pragma("unroll") for (int m = 0; m < 4; ++m) { const i32x4 lo_ = *(const LAS i32x4*)(lds + PG8_SA(b, h) + aoff + m * 2048), hi_ = *(const LAS i32x4*)(lds + PG8_SA(b, h) + aoff + m * 2048 + 1024); dst##8[m] = __builtin_shufflevector(lo_, hi_, 0, 1, 2, 3, 4, 5, 6, 7); } } \
        else { _Pragma("unroll") for (int m = 0; m < 4; ++m) _Pragma("unroll") for (int k = 0; k < 2; ++k) dst[m][k] = *(const LAS bf16x8*)(lds + PG8_SA(b, h) + aoff + m * 2048 + k * 1024); } } while (0)
#define PG8_LDB(dst, b, h) do { if constexpr (FP8) { _Pragma("unroll") for (int n = 0; n < 2; ++n) { const i32x4 lo_ = *(const LAS i32x4*)(lds + PG8_SB(b, h) + boff + n * 2048), hi_ = *(const LAS i32x4*)(lds + PG8_SB(b, h) + boff + n * 2048 + 1024); dst##8[n] = __builtin_shufflevector(lo_, hi_, 0, 1, 2, 3, 4, 5, 6, 7); } } \
        else { _Pragma("unroll") for (int n = 0; n < 2; ++n) _Pragma("unroll") for (int k = 0; k < 2; ++k) dst[n][k] = *(const LAS bf16x8*)(lds + PG8_SB(b, h) + boff + n * 2048 + k * 1024); } } while (0)
#define PG8_CAT8(x, y) __builtin_shufflevector(__builtin_bit_cast(i32x4, x), __builtin_bit_cast(i32x4, y), 0, 1, 2, 3, 4, 5, 6, 7)
#define PG8_MMA(ai, bj, At, Bt) do { __builtin_amdgcn_s_setprio(1); if constexpr (FP8) { _Pragma("unroll") for (int m = 0; m < 4; ++m) _Pragma("unroll") for (int n = 0; n < 2; ++n) \
        asm volatile("v_mfma_scale_f32_16x16x128_f8f6f4 %0, %1, %2, %0, %3, %3 op_sel_hi:[0,0,0]" : "+v"(acc[ai][bj][m][n]) : "v"(Bt##8[n]), "v"(At##8[m]), "v"(sc8)); } \
        else { _Pragma("unroll") for (int m = 0; m < 4; ++m) _Pragma("unroll") for (int n = 0; n < 2; ++n) _Pragma("unroll") for (int k = 0; k < 2; ++k) \
        acc[ai][bj][m][n] = __builtin_amdgcn_mfma_f32_16x16x32_bf16(Bt[n][k], At[m][k], acc[ai][bj][m][n], 0, 0, 0); } __builtin_amdgcn_s_setprio(0); } while (0)
#define PG8_WAIT_V(n) asm volatile("s_waitcnt vmcnt(" #n ")" ::: "memory")
#define PG8_WAIT_L(n) asm volatile("s_waitcnt lgkmcnt(" #n ")" ::: "memory")
#define PG8_BAR __builtin_amdgcn_s_barrier()
#define PG8_SCHED __builtin_amdgcn_sched_barrier(0)
    Unit cur, nxt; int ui = 0; typename Epi::Pre pre;
    if (!S.next(0, cur)) return;
    f32x4 acc[2][2][4][2];
#pragma unroll
    for (int a = 0; a < 2; ++a)
#pragma unroll
        for (int b = 0; b < 2; ++b)
#pragma unroll
            for (int m = 0; m < 4; ++m)
#pragma unroll
                for (int n = 0; n < 2; ++n) acc[a][b][m][n] = (f32x4){0.f, 0.f, 0.f, 0.f};
    const int sc8 = 0x7c7c7c7c;
    bf16x8 At[4][2], B0[2][2], B1[2][2]; i32x8 At8[4], B08[2], B18[2];
    const char* cA = (const char*)g.A + (size_t)cur.pm * tstepA + cur.aofs; const char* cB = (const char*)g.Bt + (size_t)cur.pb * tstepB;
    if constexpr (GATHER) { PG8_GOFF(goff, 0); }
    PG8_STAGE(PG8_SB(0, 0), cB, voffB); PG8_STAGE(PG8_SB(0, 1), cB + hstepB, voffB); PG8_STAGE_A(PG8_SA(0, 0), cA, 0, goff[0]); PG8_STAGE_A(PG8_SA(0, 1), cA + hstepA, 0, goff[1]);
    PG8_STAGE(PG8_SB(1, 0), cB + kstep, voffB); PG8_STAGE_A(PG8_SA(1, 0), cA + kstep, 1, goff[0]); PG8_STAGE(PG8_SB(1, 1), cB + hstepB + kstep, voffB);
    if (wr == 1) PG8_BAR;
    PG8_WAIT_V(8); PG8_BAR;
    PG8_WAIT_V(6); PG8_BAR;
    for (;;) {
        const bool has_next = S.next(ui + 1, nxt);
        const char* nA = has_next ? (const char*)g.A + (size_t)nxt.pm * tstepA + nxt.aofs : cA; const char* nB = has_next ? (const char*)g.Bt + (size_t)nxt.pb * tstepB : cB;
        if constexpr (GATHER) { if (has_next) { PG8_GOFF(noff, ui + 1); } else {
#pragma unroll
            for (int h_ = 0; h_ < 2; ++h_)
#pragma unroll
                for (int i_ = 0; i_ < 2; ++i_) noff[h_][i_] = goff[h_][i_]; } }
        for (int t = 0; t < nt; t += 2) {
            const bool last = (t == nt - 2);
            const char* a1 = cA + (size_t)(t + 1) * kstep;
            const char* a2 = last ? nA : cA + (size_t)(t + 2) * kstep; const char* b2 = last ? nB : cB + (size_t)(t + 2) * kstep;
            const char* a3 = a2 + kstep; const char* b3 = b2 + kstep;
            const int k2 = last ? 0 : t + 2;
            unsigned soff[2][2];
            if constexpr (GATHER) {
#pragma unroll
                for (int h_ = 0; h_ < 2; ++h_)
#pragma unroll
                    for (int i_ = 0; i_ < 2; ++i_) soff[h_][i_] = last ? noff[h_][i_] : goff[h_][i_]; }
            PG8_LDB(B0, 0, 0); PG8_LDB(B1, 0, 1); PG8_SCHED; PG8_LDA(At, 0, 0); PG8_STAGE_A(PG8_SA(1, 1), a1 + hstepA, t + 1, goff[1]);
            PG8_WAIT_V(8); PG8_WAIT_L(0); PG8_BAR; PG8_MMA(0, 0, At, B0); PG8_MMA(0, 1, At, B1); PG8_BAR; PG8_SCHED;
            PG8_LDA(At, 0, 1); PG8_STAGE(PG8_SB(0, 0), b2, voffB); PG8_STAGE(PG8_SB(0, 1), b2 + hstepB, voffB); PG8_STAGE_A(PG8_SA(0, 0), a2, k2, soff[0]);
            PG8_WAIT_V(8); PG8_WAIT_L(0); PG8_BAR; PG8_MMA(1, 0, At, B0); PG8_MMA(1, 1, At, B1); PG8_BAR; PG8_SCHED;
            PG8_LDB(B0, 1, 0); PG8_LDB(B1, 1, 1); PG8_SCHED; PG8_LDA(At, 1, 0); PG8_STAGE_A(PG8_SA(0, 1), a2 + hstepA, k2, soff[1]);
            PG8_WAIT_V(8); PG8_WAIT_L(0); PG8_BAR; PG8_MMA(0, 0, At, B0); PG8_MMA(0, 1, At, B1); PG8_BAR; PG8_SCHED;
            if constexpr (Epi::HAS_PRE) { if (last) E.preload(pre, cur, wc, fq); }
            PG8_LDA(At, 1, 1); PG8_STAGE(PG8_SB(1, 0), b3, voffB); PG8_STAGE(PG8_SB(1, 1), b3 + hstepB, voffB); PG8_STAGE_A(PG8_SA(1, 0), a3, k2 + 1, soff[0]);
            PG8_WAIT_V(8); PG8_WAIT_L(0); PG8_BAR; PG8_MMA(1, 0, At, B0); PG8_MMA(1, 1, At, B1); PG8_BAR; PG8_SCHED;
        }
        if constexpr (ALIGN_EPI) { if (wr == 0) PG8_BAR; }
        if constexpr (FP8) asm volatile("s_nop 15\n\ts_nop 15" ::: "memory");
        if constexpr (Epi::HAS_PRE) E(acc, cur, wr, wc, fr, fq, pre); else E(acc, cur, wr, wc, fr, fq);
#ifdef EPI2X
        if constexpr (same_t<Epi, EPI2X>::v) { asm volatile("" ::: "memory"); PG8_SCHED; if constexpr (Epi::HAS_PRE) E(acc, cur, wr, wc, fr, fq, pre); else E(acc, cur, wr, wc, fr, fq); }
#endif
        if (!has_next) break;
#pragma unroll
        for (int a = 0; a < 2; ++a)
#pragma unroll
            for (int b = 0; b < 2; ++b)
#pragma unroll
                for (int m = 0; m < 4; ++m)
#pragma unroll
                    for (int n = 0; n < 2; ++n) acc[a][b][m][n] = (f32x4){0.f, 0.f, 0.f, 0.f};
        cur = nxt; cA = nA; cB = nB; ++ui;
        if constexpr (GATHER) {
#pragma unroll
            for (int h_ = 0; h_ < 2; ++h_)
#pragma unroll
                for (int i_ = 0; i_ < 2; ++i_) goff[h_][i_] = noff[h_][i_]; }
        if constexpr (ALIGN_EPI) { if (wr == 1) PG8_BAR; }
    }
    PG8_WAIT_V(0);
    if constexpr (!ALIGN_EPI) { if (wr == 0) PG8_BAR; }
    PG8_BAR;
#undef PG8_SA
#undef PG8_SB
#undef PG8_STAGE
#undef PG8_STAGE_A
#undef PG8_GOFF
#undef PG8_LDA
#undef PG8_LDB
#undef PG8_MMA
#undef PG8_CAT8
#undef PG8_WAIT_V
#undef PG8_WAIT_L
#undef PG8_BAR
#undef PG8_SCHED
}

#define EPI_ARGS const f32x4 (&acc)[2][2][4][2], const Unit& u, int wr, int wc, int fr, int fq
#define EPI_NOPRE struct Pre {}; static constexpr bool HAS_PRE = false;
__device__ __forceinline__ u32x4 pack8(f32x4 v0, f32x4 v1) { u32x4 w; w.x = cvt_pk_bf16(v0[0], v0[1]); w.y = cvt_pk_bf16(v0[2], v0[3]); w.z = cvt_pk_bf16(v1[0], v1[1]); w.w = cvt_pk_bf16(v1[2], v1[3]); return w; }
__device__ __forceinline__ void unpack8(u32x4 w, f32x4& v0, f32x4& v1) { v0 = (f32x4){bflo(w.x), bfhi(w.x), bflo(w.y), bfhi(w.y)}; v1 = (f32x4){bflo(w.z), bfhi(w.z), bflo(w.w), bfhi(w.w)}; }
__device__ __forceinline__ f32x4 sig4(f32x4 v) { const f32x4 a = v * (-LOG2E); const f32x4 d = (f32x4){__builtin_amdgcn_exp2f(a[0]), __builtin_amdgcn_exp2f(a[1]), __builtin_amdgcn_exp2f(a[2]), __builtin_amdgcn_exp2f(a[3])} + 1.0f;
    return (f32x4){__builtin_amdgcn_rcpf(d[0]), __builtin_amdgcn_rcpf(d[1]), __builtin_amdgcn_rcpf(d[2]), __builtin_amdgcn_rcpf(d[3])}; }

struct EpiStore { EPI_NOPRE
    bf16_t* O; int ldc; const float* bias; int bias_stride; int sig_from;
    __device__ __forceinline__ void operator()(EPI_ARGS) const {
        const int row0 = u.pm * BM + wr * 64 + fr, col0 = u.pn * BM + wc * 32 + 8 * fq;
        const bool sg = u.pn >= sig_from;
        f32x4 bv[2][2];
#pragma unroll
        for (int bj = 0; bj < 2; ++bj)
#pragma unroll
            for (int n = 0; n < 2; ++n) bv[bj][n] = bias ? *(const f32x4*)(bias + (size_t)u.e * bias_stride + col0 + bj * HALF + 4 * n) : (f32x4){0.f, 0.f, 0.f, 0.f};
#pragma unroll
        for (int ai = 0; ai < 2; ++ai)
#pragma unroll
            for (int m = 0; m < 4; ++m) { bf16_t* rowp = O + (size_t)(row0 + ai * HALF + m * 16) * ldc + col0;
#pragma unroll
                for (int bj = 0; bj < 2; ++bj) { f32x4 v0 = acc[ai][bj][m][0] + bv[bj][0], v1 = acc[ai][bj][m][1] + bv[bj][1];
                    if (sg) { v0 = sig4(v0); v1 = sig4(v1); }
                    *(u32x4*)(rowp + bj * HALF) = pack8(v0, v1); } }
    }
};

struct EpiProj { EPI_NOPRE
    bf16_t* PROJ; bf16_t* QA2; bf16_t* KA2; float* KMEAN; bf16_t* CQN; bf16_t* CKVN;
    const float* gq; const float* gk; const float* glq; const float* glkv; const float* cosA; const float* sinA; LAS float* xch;
    float* KPESS;
    __device__ __forceinline__ void operator()(EPI_ARGS) const {
        const int row0 = u.pm * BM + wr * 64 + fr, col0 = u.pn * BM + wc * 32 + 8 * fq;
        if (u.pn < 4) {
            const bool isk = u.pn >= 2; const int h = 4 * (u.pn & 1) + wc; const float* gn = isk ? gk : gq; const float sc = isk ? 1.0f : C2A;
            const f32x4 g1a = *(const f32x4*)(gn + 8 * fq), g1b = *(const f32x4*)(gn + 8 * fq + 4), g2a = *(const f32x4*)(gn + 32 + 8 * fq), g2b = *(const f32x4*)(gn + 36 + 8 * fq);
            bf16_t* dst = isk ? KA2 : QA2;
            const f32x4 ifa = *(const f32x4*)(cosA + 196608 + 8 * fq), ifb = *(const f32x4*)(cosA + 196608 + 8 * fq + 4);
            f32x4 ks1a = {0.f, 0.f, 0.f, 0.f}, ks1b = ks1a, ks2a = ks1a, ks2b = ks1a;
#pragma unroll
            for (int ai = 0; ai < 2; ++ai)
#pragma unroll
                for (int m = 0; m < 4; ++m) { const int row = row0 + ai * HALF + m * 16; const int pos = row & (SEQ - 1);
                    f32x4 x1a = acc[ai][0][m][0], x1b = acc[ai][0][m][1], x2a = acc[ai][1][m][0], x2b = acc[ai][1][m][1];
                    float ss = (x1a[0] * x1a[0] + x1a[1] * x1a[1]) + (x1a[2] * x1a[2] + x1a[3] * x1a[3]) + (x1b[0] * x1b[0] + x1b[1] * x1b[1]) + (x1b[2] * x1b[2] + x1b[3] * x1b[3])
                             + (x2a[0] * x2a[0] + x2a[1] * x2a[1]) + (x2a[2] * x2a[2] + x2a[3] * x2a[3]) + (x2b[0] * x2b[0] + x2b[1] * x2b[1]) + (x2b[2] * x2b[2] + x2b[3] * x2b[3]);
                    ss += __shfl_xor(ss, 16); ss += __shfl_xor(ss, 32);
                    const float rstd = 1.0f / sqrtf(ss * (1.f / 64.f) + EPS);
                    x1a = x1a * g1a * rstd; x1b = x1b * g1b * rstd; x2a = x2a * g2a * rstd; x2b = x2b * g2b * rstd;
                    f32x4 ca, cb, sa, sb; { const float fp_ = (float)pos;
#pragma unroll
                        for (int i = 0; i < 4; ++i) { const float ra = __builtin_amdgcn_fractf(fp_ * ifa[i]), rb = __builtin_amdgcn_fractf(fp_ * ifb[i]);
                            ca[i] = __builtin_amdgcn_cosf(ra); sa[i] = __builtin_amdgcn_sinf(ra); cb[i] = __builtin_amdgcn_cosf(rb); sb[i] = __builtin_amdgcn_sinf(rb); } }
                    const f32x4 y1a = x1a * ca - x2a * sa, y1b = x1b * cb - x2b * sb, y2a = x2a * ca + x1a * sa, y2b = x2b * cb + x1b * sb;
                    bf16_t* rp = dst + (size_t)row * 512 + h * 64 + 8 * fq;
                    *(u32x4*)rp = pack8(y1a * sc, y1b * sc); *(u32x4*)(rp + 32) = pack8(y2a * sc, y2b * sc);
                    ks1a += y1a; ks1b += y1b; ks2a += y2a; ks2b += y2b; }
            if (isk) {
#pragma unroll
                for (int o = 1; o < 16; o <<= 1) {
#pragma unroll
                    for (int i = 0; i < 4; ++i) { ks1a[i] += __shfl_xor(ks1a[i], o); ks1b[i] += __shfl_xor(ks1b[i], o); ks2a[i] += __shfl_xor(ks2a[i], o); ks2b[i] += __shfl_xor(ks2b[i], o); } }
                if (fr == 0) { float* km = KMEAN + (((size_t)(u.pm >> 3) * 8 + h) * 8 + (u.pm & 7)) * 64 + 8 * fq;
#pragma unroll
                    for (int i = 0; i < 4; ++i) { atomicAdd(km + i, ks1a[i] * (1.f / 256.f)); atomicAdd(km + 4 + i, ks1b[i] * (1.f / 256.f)); atomicAdd(km + 32 + i, ks2a[i] * (1.f / 256.f)); atomicAdd(km + 36 + i, ks2b[i] * (1.f / 256.f)); } } }
        } else if (u.pn == 6 || u.pn == 7) {
            const bool isq = u.pn == 6;
            float ssr[2][4];
#pragma unroll
            for (int ai = 0; ai < 2; ++ai)
#pragma unroll
                for (int m = 0; m < 4; ++m) { float ss = 0.f;
#pragma unroll
                    for (int bj = 0; bj < 2; ++bj) { if (bj == 1 && !isq) continue;
#pragma unroll
                        for (int n = 0; n < 2; ++n) { const f32x4 x = acc[ai][bj][m][n]; ss += (x[0] * x[0] + x[1] * x[1]) + (x[2] * x[2] + x[3] * x[3]); } }
                    ss += __shfl_xor(ss, 16); ss += __shfl_xor(ss, 32);
                    if (fq == 0) xch[(ai * HALF + wr * 64 + m * 16 + fr) * 4 + wc] = ss; }
            asm volatile("s_waitcnt lgkmcnt(0)" ::: "memory"); __builtin_amdgcn_s_barrier(); asm volatile("" ::: "memory");
#pragma unroll
            for (int ai = 0; ai < 2; ++ai)
#pragma unroll
                for (int m = 0; m < 4; ++m) { const f32x4 p4 = *(const LAS f32x4*)(xch + (ai * HALF + wr * 64 + m * 16 + fr) * 4); ssr[ai][m] = (p4[0] + p4[1]) + (p4[2] + p4[3]); }
            asm volatile("s_waitcnt lgkmcnt(0)" ::: "memory"); __builtin_amdgcn_s_barrier(); asm volatile("" ::: "memory");
            const float invn = isq ? (1.f / 256.f) : (1.f / 128.f); const float* gl = isq ? glq : glkv; bf16_t* dn = isq ? CQN : CKVN; const int ldn = isq ? 256 : 128;
            const int c0 = wc * 32 + 8 * fq;
#pragma unroll
            for (int bj = 0; bj < 2; ++bj) {
                if (bj == 1 && !isq) {
#pragma unroll
                    for (int ai = 0; ai < 2; ++ai)
#pragma unroll
                        for (int m = 0; m < 4; ++m) { const f32x4 x0 = acc[ai][1][m][0], x1 = acc[ai][1][m][1];
                            *(u32x4*)(PROJ + (size_t)(row0 + ai * HALF + m * 16) * DINP + col0 + HALF) = pack8(x0, x1);
                            float ss = (x0[0] * x0[0] + x0[1] * x0[1]) + (x0[2] * x0[2] + x0[3] * x0[3]) + (x1[0] * x1[0] + x1[1] * x1[1]) + (x1[2] * x1[2] + x1[3] * x1[3]);
                            ss += __shfl_xor(ss, 16); ss += __shfl_xor(ss, 32);
                            if (wc == 0 && fq == 0) KPESS[row0 + ai * HALF + m * 16] = ss; }
                    continue; }
                const f32x4 ga = *(const f32x4*)(gl + bj * HALF + c0), gb = *(const f32x4*)(gl + bj * HALF + c0 + 4);
#pragma unroll
                for (int ai = 0; ai < 2; ++ai)
#pragma unroll
                    for (int m = 0; m < 4; ++m) { const float rstd = 1.0f / sqrtf(ssr[ai][m] * invn + EPS);
                        *(u32x4*)(dn + (size_t)(row0 + ai * HALF + m * 16) * ldn + bj * HALF + c0) = pack8(acc[ai][bj][m][0] * ga * rstd, acc[ai][bj][m][1] * gb * rstd); } }
        } else {
            const bool sg = u.pn >= 8;
#pragma unroll
            for (int ai = 0; ai < 2; ++ai)
#pragma unroll
                for (int m = 0; m < 4; ++m) { bf16_t* rowp = PROJ + (size_t)(row0 + ai * HALF + m * 16) * DINP + col0;
#pragma unroll
                    for (int bj = 0; bj < 2; ++bj) { f32x4 v0 = acc[ai][bj][m][0], v1 = acc[ai][bj][m][1];
                        if (sg) { v0 = sig4(v0); v1 = sig4(v1); }
                        *(u32x4*)(rowp + bj * HALF) = pack8(v0, v1); } }
        }
    }
};

struct EpiQB { EPI_NOPRE
    bf16_t* QB; const float* gn; const float* cosB; const float* sinB; LAS float* xch;
    __device__ __forceinline__ void operator()(EPI_ARGS) const {
        const int rl0 = wr * 64 + fr, row0 = u.pm * BM + rl0;
#pragma unroll
        for (int ai = 0; ai < 2; ++ai)
#pragma unroll
            for (int m = 0; m < 4; ++m)
#pragma unroll
                for (int bj = 0; bj < 2; ++bj) { const f32x4 x0 = acc[ai][bj][m][0], x1 = acc[ai][bj][m][1];
                    float ss = (x0[0] * x0[0] + x0[1] * x0[1]) + (x0[2] * x0[2] + x0[3] * x0[3]) + (x1[0] * x1[0] + x1[1] * x1[1]) + (x1[2] * x1[2] + x1[3] * x1[3]);
                    ss += __shfl_xor(ss, 16); ss += __shfl_xor(ss, 32);
                    if (fq == 0) xch[((rl0 + ai * HALF + m * 16) * 2 + bj) * 4 + wc] = ss; }
        asm volatile("s_waitcnt lgkmcnt(0)" ::: "memory"); __builtin_amdgcn_s_barrier(); asm volatile("" ::: "memory");
#define QB_RS(ai, m, bj) ({ const f32x4 p4_ = *(const LAS f32x4*)(xch + ((rl0 + (ai) * HALF + (m) * 16) * 2 + (bj)) * 4); C2B / sqrtf(((p4_[0] + p4_[1]) + p4_[2]) * (1.f / 96.f) + EPS); })
        if (wc < 2) { const f32x4 ga = *(const f32x4*)(gn + 32 * wc + 8 * fq), gb = *(const f32x4*)(gn + 32 * wc + 8 * fq + 4);
#pragma unroll
            for (int ai = 0; ai < 2; ++ai)
#pragma unroll
                for (int m = 0; m < 4; ++m)
#pragma unroll
                    for (int bj = 0; bj < 2; ++bj) { const float r = QB_RS(ai, m, bj);
                        *(u32x4*)(QB + (size_t)(row0 + ai * HALF + m * 16) * 768 + (2 * u.pn + bj) * 96 + 32 * wc + 8 * fq) = pack8(acc[ai][bj][m][0] * ga * r, acc[ai][bj][m][1] * gb * r); }
        } else if (wc == 2) { const f32x4 g1 = *(const f32x4*)(gn + 64 + 4 * fq), g2 = *(const f32x4*)(gn + 80 + 4 * fq);
            const f32x4 ifr = *(const f32x4*)(cosB - 131072 + 196640 + 4 * fq);
#pragma unroll
            for (int ai = 0; ai < 2; ++ai)
#pragma unroll
                for (int m = 0; m < 4; ++m) { const int row = row0 + ai * HALF + m * 16; const int pos = row & (SEQ - 1);
                    f32x4 c4, s4; { const float fp_ = (float)pos;
#pragma unroll
                        for (int i = 0; i < 4; ++i) { const float rv = __builtin_amdgcn_fractf(fp_ * ifr[i]); c4[i] = __builtin_amdgcn_cosf(rv); s4[i] = __builtin_amdgcn_sinf(rv); } }
#pragma unroll
                    for (int bj = 0; bj < 2; ++bj) { const float r = QB_RS(ai, m, bj); const f32x4 x1 = acc[ai][bj][m][0] * g1 * r, x2 = acc[ai][bj][m][1] * g2 * r;
                        const f32x4 y1 = x1 * c4 - x2 * s4, y2 = x2 * c4 + x1 * s4; bf16_t* rp = QB + (size_t)row * 768 + (2 * u.pn + bj) * 96 + 64 + 4 * fq;
                        *(u32x2*)rp = (u32x2){cvt_pk_bf16(y1[0], y1[1]), cvt_pk_bf16(y1[2], y1[3])}; *(u32x2*)(rp + 16) = (u32x2){cvt_pk_bf16(y2[0], y2[1]), cvt_pk_bf16(y2[2], y2[3])}; } }
        }
    }
};
struct EpiKV { EPI_NOPRE
    bf16_t* KB2; bf16_t* KV; const bf16_t* PROJ; const float* KPESS; const float* gn; const float* cosB; const float* sinB; LAS float* xch;
    __device__ __forceinline__ void operator()(EPI_ARGS) const {
        const int rl0 = wr * 64 + fr, row0 = u.pm * BM + rl0;
        if (wc < 2) {
#pragma unroll
            for (int ai = 0; ai < 2; ++ai)
#pragma unroll
                for (int m = 0; m < 4; ++m)
#pragma unroll
                    for (int bj = 0; bj < 2; ++bj) { const f32x4 x0 = acc[ai][bj][m][0], x1 = acc[ai][bj][m][1];
                        float ss = (x0[0] * x0[0] + x0[1] * x0[1]) + (x0[2] * x0[2] + x0[3] * x0[3]) + (x1[0] * x1[0] + x1[1] * x1[1]) + (x1[2] * x1[2] + x1[3] * x1[3]);
                        ss += __shfl_xor(ss, 16); ss += __shfl_xor(ss, 32);
                        if (fq == 0) xch[((rl0 + ai * HALF + m * 16) * 2 + bj) * 4 + wc] = ss; } }
        asm volatile("s_waitcnt lgkmcnt(0)" ::: "memory"); __builtin_amdgcn_s_barrier(); asm volatile("" ::: "memory");
#define KV_RS(ai, m, bj, pe) ({ const f32x2 p2_ = *(const LAS f32x2*)(xch + ((rl0 + (ai) * HALF + (m) * 16) * 2 + (bj)) * 4); 1.0f / sqrtf(((p2_[0] + p2_[1]) + (pe)) * (1.f / 96.f) + EPS); })
        if (wc < 2) { const f32x4 ga = *(const f32x4*)(gn + 32 * wc + 8 * fq), gb = *(const f32x4*)(gn + 32 * wc + 8 * fq + 4);
#pragma unroll
            for (int ai = 0; ai < 2; ++ai)
#pragma unroll
                for (int m = 0; m < 4; ++m) { const float pe = KPESS[row0 + ai * HALF + m * 16];
#pragma unroll
                    for (int bj = 0; bj < 2; ++bj) { const float r = KV_RS(ai, m, bj, pe);
                        *(u32x4*)(KB2 + (size_t)(row0 + ai * HALF + m * 16) * 768 + (2 * u.pn + bj) * 96 + 32 * wc + 8 * fq) = pack8(acc[ai][bj][m][0] * ga * r, acc[ai][bj][m][1] * gb * r); } }
        } else {
#pragma unroll
            for (int ai = 0; ai < 2; ++ai)
#pragma unroll
                for (int m = 0; m < 4; ++m)
#pragma unroll
                    for (int bj = 0; bj < 2; ++bj) *(u32x4*)(KV + (size_t)(row0 + ai * HALF + m * 16) * 1024 + (2 * u.pn + bj) * 128 + 32 * wc + 8 * fq) = pack8(acc[ai][bj][m][0], acc[ai][bj][m][1]);
            if (wc == 2) {
                const f32x4 g1 = *(const f32x4*)(gn + 64 + 4 * fq), g2 = *(const f32x4*)(gn + 80 + 4 * fq);
                const f32x4 ifr = *(const f32x4*)(cosB - 131072 + 196640 + 4 * fq);
#pragma unroll
                for (int ai = 0; ai < 2; ++ai)
#pragma unroll
                    for (int m = 0; m < 4; ++m) { const int row = row0 + ai * HALF + m * 16; const int pos = row & (SEQ - 1); const float pe = KPESS[row];
                        const u32x2 w1 = *(const u32x2*)(PROJ + (size_t)row * DINP + PC_KPE + 4 * fq), w2 = *(const u32x2*)(PROJ + (size_t)row * DINP + PC_KPE + 16 + 4 * fq);
                        const f32x4 k1 = (f32x4){bflo(w1.x), bfhi(w1.x), bflo(w1.y), bfhi(w1.y)} * g1, k2 = (f32x4){bflo(w2.x), bfhi(w2.x), bflo(w2.y), bfhi(w2.y)} * g2;
                        f32x4 c4, s4; { const float fp_ = (float)pos;
#pragma unroll
                            for (int i = 0; i < 4; ++i) { const float rv = __builtin_amdgcn_fractf(fp_ * ifr[i]); c4[i] = __builtin_amdgcn_cosf(rv); s4[i] = __builtin_amdgcn_sinf(rv); } }
                        const f32x4 y1 = k1 * c4 - k2 * s4, y2 = k2 * c4 + k1 * s4;
#pragma unroll
                        for (int bj = 0; bj < 2; ++bj) { const float r = KV_RS(ai, m, bj, pe); bf16_t* rp = KB2 + (size_t)row * 768 + (2 * u.pn + bj) * 96 + 64 + 4 * fq;
                            *(u32x2*)rp = (u32x2){cvt_pk_bf16(y1[0] * r, y1[1] * r), cvt_pk_bf16(y1[2] * r, y1[3] * r)}; *(u32x2*)(rp + 16) = (u32x2){cvt_pk_bf16(y2[0] * r, y2[1] * r), cvt_pk_bf16(y2[2] * r, y2[3] * r)}; } } }
        }
    }
};
#undef QB_RS
#undef KV_RS
template <bool ADD> struct EpiGate { EPI_NOPRE
    bf16_t* O; const bf16_t* G; int ldg; unsigned char* MF8;
    __device__ __forceinline__ void operator()(EPI_ARGS) const {
        const int row0 = u.pm * BM + wr * 64 + fr, col0 = u.pn * BM + wc * 32 + 8 * fq;
#pragma unroll
        for (int ai = 0; ai < 2; ++ai)
#pragma unroll
            for (int m = 0; m < 4; ++m) { const size_t r = (size_t)(row0 + ai * HALF + m * 16);
#pragma unroll
                for (int bj = 0; bj < 2; ++bj) { const int c = col0 + bj * HALF;
                    f32x4 g0, g1; unpack8(*(const u32x4*)(G + r * ldg + c), g0, g1);
                    f32x4 v0 = acc[ai][bj][m][0] * g0, v1 = acc[ai][bj][m][1] * g1;
                    if (ADD) { f32x4 o0, o1; unpack8(*(const u32x4*)(O + r * DM + c), o0, o1); v0 += o0; v1 += o1;
                        *(u32x2*)(MF8 + r * DM + c) = (u32x2){pack4_fp8(v0[0], v0[1], v0[2], v0[3]), pack4_fp8(v1[0], v1[1], v1[2], v1[3])}; }
                    else *(u32x4*)(O + r * DM + c) = pack8(v0, v1); } }
    }
};

struct ProjOrder {
    StaticOrder so;
    __device__ bool next(int i, Unit& u) const { if (!so.next(i, u)) return false; if (u.pn >= 4 && u.pn < 8) { u.pn = 4 + ((u.pn + 2) & 3); u.pb = u.pn; } return true; }
};
struct BranchOrder {
    StaticOrder so;
    __device__ bool next(int i, Unit& u) const { if (i >= 2) return false; if (!so.next(0, u)) return false; u.e = i; u.aofs = i * 512; u.pb = u.pn + 8 * i; return true; }
};
struct EpiGateAB { EPI_NOPRE
    bf16_t* O; const bf16_t* Ga; const bf16_t* Gb; int ldg; unsigned char* MF8;
    __device__ __forceinline__ void operator()(EPI_ARGS) const {
        if (u.e == 0) { EpiGate<false> E{O, Ga, ldg, nullptr}; E(acc, u, wr, wc, fr, fq); }
        else { asm volatile("s_waitcnt vmcnt(0)" ::: "memory");
               EpiGate<true> E{O, Gb, ldg, MF8}; E(acc, u, wr, wc, fr, fq); }
    }
};
struct EpiResF32 { EPI_NOPRE
    const float* base; bf16_t* out; float* ssp;
    __device__ __forceinline__ void operator()(EPI_ARGS) const {
        const int row0 = u.pm * BM + wr * 64 + fr, col0 = u.pn * BM + wc * 32 + 8 * fq;
#pragma unroll
        for (int ai = 0; ai < 2; ++ai)
#pragma unroll
            for (int m = 0; m < 4; ++m) { const size_t r = (size_t)(row0 + ai * HALF + m * 16); float ss = 0.f;
#pragma unroll
                for (int bj = 0; bj < 2; ++bj) { const size_t off = r * DM + col0 + bj * HALF;
                    const f32x4 b0 = *(const f32x4*)(base + off), b1 = *(const f32x4*)(base + off + 4);
                    const f32x4 y0 = b0 + acc[ai][bj][m][0], y1 = b1 + acc[ai][bj][m][1];
                    *(u32x4*)(out + off) = pack8(y0, y1);
                    ss += (y0[0] * y0[0] + y0[1] * y0[1]) + (y0[2] * y0[2] + y0[3] * y0[3]) + (y1[0] * y1[0] + y1[1] * y1[1]) + (y1[2] * y1[2] + y1[3] * y1[3]); }
                ss += __shfl_xor(ss, 16); ss += __shfl_xor(ss, 32);
                if (fq == 0) ssp[r * 16 + u.pn * 4 + wc] = ss; }
    }
};
struct EpiSwiglu {
    struct Pre { f32x4 bg[2], bu[2]; }; static constexpr bool HAS_PRE = true;
    unsigned char* O; const float* bias;
    __device__ __forceinline__ void preload(Pre& p, const Unit& u, int wc, int fq) const { const float* be = bias + (size_t)u.e * 2048 + u.pn * HALF + wc * 32 + 8 * fq;
#pragma unroll
        for (int n = 0; n < 2; ++n) { p.bg[n] = *(const f32x4*)(be + 4 * n); p.bu[n] = *(const f32x4*)(be + 1024 + 4 * n); } }
    __device__ __forceinline__ void operator()(EPI_ARGS, const Pre& p) const {
        const int row0 = u.pm * BM + wr * 64 + fr, j0 = u.pn * HALF + wc * 32 + 8 * fq;
#pragma unroll
        for (int ai = 0; ai < 2; ++ai)
#pragma unroll
            for (int m = 0; m < 4; ++m) { unsigned char* rowp = O + (size_t)(row0 + ai * HALF + m * 16) * DEXP + j0;
                f32x4 o[2];
#pragma unroll
                for (int n = 0; n < 2; ++n) { const f32x4 gv = acc[ai][0][m][n] + p.bg[n], uv = acc[ai][1][m][n] + p.bu[n];
#pragma unroll
                    for (int i = 0; i < 4; i += 2) {
                        const f32x2 gg = {fminf(gv[i], 7.0f), fminf(gv[i + 1], 7.0f)}, uu = {__builtin_amdgcn_fmed3f(uv[i], -7.0f, 7.0f), __builtin_amdgcn_fmed3f(uv[i + 1], -7.0f, 7.0f)};
                        const f32x2 ea = gg * (-1.702f * LOG2E); const f32x2 den = (f32x2){__builtin_amdgcn_exp2f(ea.x), __builtin_amdgcn_exp2f(ea.y)} + 1.0f;
                        const f32x2 num = uu * gg + gg; const f32x2 r = num * (f32x2){__builtin_amdgcn_rcpf(den.x), __builtin_amdgcn_rcpf(den.y)};
                        o[n][i] = r.x; o[n][i + 1] = r.y; } }
                *(u32x2*)rowp = (u32x2){pack4_fp8(o[0][0], o[0][1], o[0][2], o[0][3]), pack4_fp8(o[1][0], o[1][1], o[1][2], o[1][3])}; }
    }
};
struct EpiStoreBias {
    struct Pre { f32x4 bv[2][2]; }; static constexpr bool HAS_PRE = true;
    bf16_t* O; int ldc; const float* bias; int bias_stride;
    __device__ __forceinline__ void preload(Pre& p, const Unit& u, int wc, int fq) const { const float* be = bias + (size_t)u.e * bias_stride + u.pn * BM + wc * 32 + 8 * fq;
#pragma unroll
        for (int bj = 0; bj < 2; ++bj)
#pragma unroll
            for (int n = 0; n < 2; ++n) p.bv[bj][n] = *(const f32x4*)(be + bj * HALF + 4 * n); }
    __device__ __forceinline__ void operator()(EPI_ARGS, const Pre& p) const {
        const int row0 = u.pm * BM + wr * 64 + fr, col0 = u.pn * BM + wc * 32 + 8 * fq;
#pragma unroll
        for (int ai = 0; ai < 2; ++ai)
#pragma unroll
            for (int m = 0; m < 4; ++m) { bf16_t* rowp = O + (size_t)(row0 + ai * HALF + m * 16) * ldc + col0;
#pragma unroll
                for (int bj = 0; bj < 2; ++bj) *(u32x4*)(rowp + bj * HALF) = pack8(acc[ai][bj][m][0] + p.bv[bj][0], acc[ai][bj][m][1] + p.bv[bj][1]); }
    }
};
struct EpiFinal { EPI_NOPRE
    float* out; const bf16_t* PP; const bf16_t* X2;
    __device__ __forceinline__ void operator()(EPI_ARGS) const {
        const int row0 = u.pm * BM + wr * 64 + fr, col0 = u.pn * BM + wc * 32 + 8 * fq;
#pragma unroll
        for (int ai = 0; ai < 2; ++ai)
#pragma unroll
            for (int m = 0; m < 4; ++m) { const size_t r = (size_t)(row0 + ai * HALF + m * 16);
#pragma unroll
                for (int bj = 0; bj < 2; ++bj) { const size_t off = r * DM + col0 + bj * HALF;
                    f32x4 p0, p1, b0, b1; unpack8(*(const u32x4*)(PP + off), p0, p1); unpack8(*(const u32x4*)(X2 + off), b0, b1);
                    *(f32x4*)(out + off) = b0 + sig4(acc[ai][bj][m][0]) * p0; *(f32x4*)(out + off + 4) = b1 + sig4(acc[ai][bj][m][1]) * p1; } }
    }
};
}

namespace att {
__device__ __forceinline__ int crow(int r, int hi) { return (r & 3) + 8 * (r >> 2) + 4 * hi; }
__device__ __forceinline__ void glds16(const void* gsrc, unsigned lds_dst) { unsigned keep;
    asm volatile("s_mov_b32 %0, m0\n\ts_mov_b32 m0, %2\n\ts_nop 0\n\tglobal_load_lds_dwordx4 %1, off\n\ts_mov_b32 m0, %0" : "=&s"(keep) : "v"(gsrc), "s"(lds_dst) : "memory"); }
__device__ __forceinline__ s16x4 vtr(const LAS unsigned char* p) { return __builtin_bit_cast(s16x4, __builtin_amdgcn_ds_read_tr16_b64_v4i16((LAS s16x4*)p)); }
#define MX3(a, b, c) __builtin_fmaxf(__builtin_fmaxf((a), (b)), (c))
constexpr int VSLOT = 8192, OST_BYTES = NWAVES * 4096, WSF_BYTES = NWAVES * 256;

template <int DQK, bool MOBA>
__device__ __forceinline__ void attn_unit(int b, int qb, const bf16_t* Qh, int ldq, const bf16_t* Kh, int ldk, const bf16_t* Vh, int ldv, unsigned char* Oh, int ldo, const float* kmean, LAS unsigned char* shm, int wave) {
    constexpr int ND = DQK / 16, NCH = DQK / 8, KSLOT = NCH * 1024;
    constexpr int LDS_K = 0, LDS_V = 2 * KSLOT, LDS_WS = LDS_V + 2 * VSLOT, LDS_OST = LDS_WS + WSF_BYTES;
    static_assert(LDS_OST + OST_BYTES <= RING_BYTES, "attention LDS");
    int lane = lane_id(); asm volatile("" : "+v"(lane));
    const int r32 = lane & 31, hi = lane >> 5; const int wid = wave;
    const long rowbase = (long)b * SEQ; const int q0 = qb * 256;
    const unsigned lds0 = (unsigned)(uintptr_t)shm;
    LAS float* wsf = (LAS float*)(shm + LDS_WS) + wid * 64;
    const int NT = 4 * (qb + 1);
    const bf16_t* ksrc0 = Kh + (rowbase + lane) * ldk + wid * 8;
    const bf16_t* vsrc0 = Vh + (rowbase + 16 * (wid & 3) + (lane >> 2)) * ldv + (wid >> 2) * 32 + (lane & 3) * 8;
#define ATT_DMA(kt, s) do { const long ro_ = (long)(kt) * 64; \
        glds16(ksrc0 + ro_ * ldk, (unsigned)__builtin_amdgcn_readfirstlane(lds0 + LDS_K + (s) * KSLOT + wid * 1024)); \
        if (NCH > 8 && wid < NCH - 8) glds16(ksrc0 + ro_ * ldk + 64, (unsigned)__builtin_amdgcn_readfirstlane(lds0 + LDS_K + (s) * KSLOT + (wid + 8) * 1024)); \
        glds16(vsrc0 + ro_ * ldv, (unsigned)__builtin_amdgcn_readfirstlane(lds0 + LDS_V + (s) * VSLOT + wid * 1024)); } while (0)
#define ATT_TILE(i) (MOBA ? ((i) < 4 ? 4 * qb + (i) : (i) - 4) : (i))
    ATT_DMA(ATT_TILE(0), 0);
    const bf16_t* Qw = Qh + (rowbase + q0 + wid * 32 + r32) * ldq + hi * 8;
    bf16x8 qr[ND];
#pragma unroll
    for (int d0 = 0; d0 < ND; ++d0) qr[d0] = *(const bf16x8*)(Qw + d0 * 16);
    unsigned bmask = 0xffffffffu;
    if (MOBA) {
        bmask = 1u << qb;
        if (qb <= 3) bmask |= (1u << qb) - 1u;
        else {
            float gsc[7];
#pragma unroll
            for (int n = 0; n < 7; ++n) { float s = 0.f;
                if (n < qb) {
#pragma unroll
                    for (int d0 = 0; d0 < ND; ++d0) { const float* km = kmean + n * 64 + d0 * 16 + hi * 8; const f32x4 k0 = *(const f32x4*)km, k1 = *(const f32x4*)(km + 4);
                        s += bf2f((unsigned short)qr[d0][0]) * k0[0] + bf2f((unsigned short)qr[d0][1]) * k0[1] + bf2f((unsigned short)qr[d0][2]) * k0[2] + bf2f((unsigned short)qr[d0][3]) * k0[3]
                           + bf2f((unsigned short)qr[d0][4]) * k1[0] + bf2f((unsigned short)qr[d0][5]) * k1[1] + bf2f((unsigned short)qr[d0][6]) * k1[2] + bf2f((unsigned short)qr[d0][7]) * k1[3]; }
                    s += __shfl_xor(s, 32);
                } else s = -INFINITY;
                gsc[n] = s; }
#pragma unroll
            for (int pass = 0; pass < 3; ++pass) { float best = -INFINITY; int bi = 0;
#pragma unroll
                for (int n = 0; n < 7; ++n) { const bool ok = (n < qb) && !((bmask >> n) & 1u) && (gsc[n] > best); best = ok ? gsc[n] : best; bi = ok ? n : bi; }
                bmask |= 1u << bi; }
        }
    }
    asm volatile("s_waitcnt vmcnt(0)" ::: "memory");
#pragma unroll
    for (int d0 = 0; d0 < ND; ++d0) asm volatile("" : "+v"(qr[d0]));
    float z_ = 0.f; asm volatile("" : "+v"(z_));
    f32x16 zt_;
#pragma unroll
    for (int r = 0; r < 16; ++r) zt_[r] = z_;
    float mhat = 0.f, l_reg = 0.f; f32x16 o[2]; o[0] = zt_; o[1] = zt_; f32x16 negm = zt_; asm volatile("" : "+v"(negm));
    const int qrel = wid * 32 + r32;
    const LAS unsigned char* kp0 = shm + LDS_K + hi * 1024 + r32 * 16;
    const LAS unsigned char* vp0 = shm + LDS_V + ((lane >> 4) & 1) * 32 + (lane & 3) * 8 + (4 * hi + ((lane & 15) >> 2)) * 64;
    for (int i = 0; i < NT; ++i) {
        const int s = i & 1, kt = ATT_TILE(i);
        asm volatile("s_waitcnt vmcnt(0) lgkmcnt(0)\n\ts_barrier" ::: "memory");
        if (i + 1 < NT) ATT_DMA(ATT_TILE(i + 1), s ^ 1);
        f32x16 cin = negm;
        if (MOBA) { if (i >= 4 && !((bmask >> (kt >> 2)) & 1u)) {
#pragma unroll
            for (int r = 0; r < 16; ++r) cin[r] = -INFINITY; } }
        f32x16 p0, p1;
        { const LAS unsigned char* kb = kp0 + s * KSLOT; bf16x8 kf[2 * ND];
#pragma unroll
            for (int d0 = 0; d0 < ND; ++d0) { kf[2 * d0] = *(const LAS bf16x8*)(kb + d0 * 2048); kf[2 * d0 + 1] = *(const LAS bf16x8*)(kb + d0 * 2048 + 512); }
            __builtin_amdgcn_sched_barrier(0);
#pragma unroll
            for (int d0 = 0; d0 < ND; ++d0) {
                if (d0 == 0) { p0 = __builtin_amdgcn_mfma_f32_32x32x16_bf16(kf[0], qr[0], cin, 0, 0, 0); p1 = __builtin_amdgcn_mfma_f32_32x32x16_bf16(kf[1], qr[0], cin, 0, 0, 0); }
                else { p0 = __builtin_amdgcn_mfma_f32_32x32x16_bf16(kf[2 * d0], qr[d0], p0, 0, 0, 0); p1 = __builtin_amdgcn_mfma_f32_32x32x16_bf16(kf[2 * d0 + 1], qr[d0], p1, 0, 0, 0); } } }
        if (kt >= 4 * qb) { const int kb = 64 * (kt - 4 * qb) + 4 * hi;
#pragma unroll
            for (int r = 0; r < 16; ++r) { const int kv = kb + (r & 3) + 8 * (r >> 2); if (kv > qrel) p0[r] = -INFINITY; if (kv + 32 > qrel) p1[r] = -INFINITY; } }
        bool resc = false;
        { float a = MX3(p0[0], p0[1], p1[0]), bb = MX3(p0[2], p0[3], p1[1]); a = MX3(a, p1[2], p1[3]);
#pragma unroll
            for (int r = 4; r < 16; r += 4) { a = MX3(a, p0[r], p0[r + 1]); bb = MX3(bb, p0[r + 2], p0[r + 3]); a = MX3(a, p1[r], p1[r + 1]); bb = MX3(bb, p1[r + 2], p1[r + 3]); }
            float rm = __builtin_fmaxf(a, bb); rm = __builtin_fmaxf(rm, __shfl_xor(rm, 32));
            const bool first = (i == 0);
            if (first || __any(rm > 6.0f)) {
                const float dl = first ? rm : __builtin_fmaxf(rm, 0.f); mhat += dl;
#pragma unroll
                for (int r = 0; r < 16; ++r) { p0[r] -= dl; p1[r] -= dl; }
#pragma unroll
                for (int r = 0; r < 16; ++r) negm[r] = -mhat;
                asm volatile("" : "+v"(negm));
                const float f = __builtin_amdgcn_exp2f(-dl); l_reg *= f; if (hi == 0) wsf[r32] = f; resc = true; } }
        float sacc = 0.f;
#pragma unroll
        for (int r = 0; r < 16; ++r) { p0[r] = __builtin_amdgcn_exp2f(p0[r]); p1[r] = __builtin_amdgcn_exp2f(p1[r]); sacc += p0[r] + p1[r]; }
        l_reg += sacc;
        u32x4 pw0, pw1, pw2, pw3;
        pw0 = (u32x4){cvt_pk_bf16(p0[0], p0[1]), cvt_pk_bf16(p0[2], p0[3]), cvt_pk_bf16(p0[4], p0[5]), cvt_pk_bf16(p0[6], p0[7])};
        pw1 = (u32x4){cvt_pk_bf16(p0[8], p0[9]), cvt_pk_bf16(p0[10], p0[11]), cvt_pk_bf16(p0[12], p0[13]), cvt_pk_bf16(p0[14], p0[15])};
        pw2 = (u32x4){cvt_pk_bf16(p1[0], p1[1]), cvt_pk_bf16(p1[2], p1[3]), cvt_pk_bf16(p1[4], p1[5]), cvt_pk_bf16(p1[6], p1[7])};
        pw3 = (u32x4){cvt_pk_bf16(p1[8], p1[9]), cvt_pk_bf16(p1[10], p1[11]), cvt_pk_bf16(p1[12], p1[13]), cvt_pk_bf16(p1[14], p1[15])};
        if (resc) {
#pragma unroll
            for (int d_ = 0; d_ < 2; ++d_)
#pragma unroll
                for (int r = 0; r < 16; ++r) o[d_][r] *= wsf[crow(r, hi)];
        }
        { const LAS unsigned char* vp = vp0 + s * VSLOT;
#pragma unroll
            for (int d0 = 0; d0 < 2; ++d0) {
                s16x4 lo[4], hh[4];
#pragma unroll
                for (int ks = 0; ks < 4; ++ks) { lo[ks] = vtr(vp + d0 * 4096 + ks * 1024); hh[ks] = vtr(vp + d0 * 4096 + ks * 1024 + 512); }
                __builtin_amdgcn_sched_barrier(0);
#define PKV(k) (bf16x8){lo[k][0], lo[k][1], lo[k][2], lo[k][3], hh[k][0], hh[k][1], hh[k][2], hh[k][3]}
                o[d0] = __builtin_amdgcn_mfma_f32_32x32x16_bf16(__builtin_bit_cast(bf16x8, pw0), PKV(0), o[d0], 0, 0, 0);
                o[d0] = __builtin_amdgcn_mfma_f32_32x32x16_bf16(__builtin_bit_cast(bf16x8, pw1), PKV(1), o[d0], 0, 0, 0);
                o[d0] = __builtin_amdgcn_mfma_f32_32x32x16_bf16(__builtin_bit_cast(bf16x8, pw2), PKV(2), o[d0], 0, 0, 0);
                o[d0] = __builtin_amdgcn_mfma_f32_32x32x16_bf16(__builtin_bit_cast(bf16x8, pw3), PKV(3), o[d0], 0, 0, 0);
#undef PKV
            } }
    }
    l_reg += __shfl_xor(l_reg, 32);
    if (hi == 0) wsf[32 + r32] = l_reg;
    float rli[16];
#pragma unroll
    for (int r = 0; r < 16; ++r) rli[r] = __builtin_amdgcn_rcpf(wsf[32 + crow(r, hi)]);
    unsigned char* Ow = (unsigned char*)Oh + (rowbase + q0 + wid * 32) * ldo;
    { LAS unsigned char* stg = shm + LDS_OST + wid * 2048;
#pragma unroll
        for (int r = 0; r < 16; ++r) { const int orow = crow(r, hi);
#pragma unroll
            for (int d0 = 0; d0 < 2; ++d0) stg[orow * 64 + d0 * 32 + r32] = (unsigned char)(pack4_fp8(o[d0][r] * rli[r], 0.f, 0.f, 0.f) & 0xffu); }
#pragma unroll
        for (int i = 0; i < 2; ++i) { const int row = i * 16 + (lane >> 2), ch = lane & 3; const u32x4 v = *(const LAS u32x4*)(stg + row * 64 + ch * 16); *(u32x4*)(Ow + (long)row * ldo + ch * 16) = v; } }
    asm volatile("s_waitcnt lgkmcnt(0)\n\ts_barrier" ::: "memory");
#undef ATT_DMA
#undef ATT_TILE
}
#undef MX3
}

#define XB_TMO      128
#define XB_XCNT(j)  (256  + 64 * (j))
#define XB_XSUB(j)  (1280 + 64 * (j))
#define XB_XGEN(j)  (2304 + 64 * (j))
#define XB_TOP      3328
#define XB_TOPGEN   3392
#define XCD_BAR_WORDS 3456
#define XB_SPIN_CAP (1u << 22)
__device__ __forceinline__ unsigned xb_ld(unsigned* p)              { return __hip_atomic_load(p, __ATOMIC_RELAXED, __HIP_MEMORY_SCOPE_AGENT); }
__device__ __forceinline__ unsigned xb_add(unsigned* p, unsigned v) { return __hip_atomic_fetch_add(p, v, __ATOMIC_RELAXED, __HIP_MEMORY_SCOPE_AGENT); }
__device__ __forceinline__ unsigned xb_xcc_id() { return (unsigned)__builtin_amdgcn_s_getreg((3 << 11) | 20) & 0xFu; }
#define XB_SPIN(cond, bar) do { unsigned _sp = 0; while (cond) { __builtin_amdgcn_s_sleep(1); \
    if ((++_sp & 255u) == 0u) { if (xb_ld(&(bar)[XB_TMO])) break; if (_sp > XB_SPIN_CAP) { atomicAdd(&(bar)[XB_TMO], 1u); break; } } } } while (0)
struct XcdBarrier { unsigned* bar; unsigned x; volatile LAS unsigned* st; int wave; };
__device__ __forceinline__ XcdBarrier xcd_barrier_post(unsigned* bar, volatile LAS unsigned* st, int wave) {
    XcdBarrier b; b.bar = bar; b.x = xb_xcc_id(); b.st = st; b.wave = wave;
    if (wave == 0 && lane_id() == 0) (void)xb_add(&bar[XB_XCNT(b.x)], 1u);
    return b;
}
__device__ __forceinline__ void xcd_barrier_complete(unsigned* bar, unsigned x, unsigned& nloc, unsigned& nx) {
    const unsigned G = gridDim.x * gridDim.y * gridDim.z;
    unsigned sum, cnt, mine, sp = 0u;
    for (;;) {
        sum = 0u; cnt = 0u; mine = 0u;
#pragma unroll
        for (unsigned j = 0; j < 16; ++j) { const unsigned c = xb_ld(&bar[XB_XCNT(j)]); sum += c; cnt += (c > 0u) ? 1u : 0u; mine = (j == x) ? c : mine; }
        if (sum == G) break;
        __builtin_amdgcn_s_sleep(1);
        if ((++sp & 255u) == 0u) { if (xb_ld(&bar[XB_TMO])) break; if (sp > XB_SPIN_CAP) { atomicAdd(&bar[XB_TMO], 1u); break; } }
    }
    nloc = mine > 0u ? mine : 1u; nx = cnt > 0u ? cnt : 1u;
}
__device__ __forceinline__ void xcd_barrier(const XcdBarrier& b) {
    asm volatile("s_waitcnt vmcnt(0)" ::: "memory");
    __syncthreads();
    if (b.wave == 0 && lane_id() == 0) {
        unsigned* bar = b.bar;
        __builtin_amdgcn_s_waitcnt(0);
        unsigned nloc = b.st[0], nx = b.st[1];
        if (nloc == 0u) { xcd_barrier_complete(bar, b.x, nloc, nx); b.st[0] = nloc; b.st[1] = nx; }
        const unsigned old = xb_add(&bar[XB_XSUB(b.x)], 1u);
        const unsigned gen = old / nloc;
        if (old + 1u == (gen + 1u) * nloc) {
            __builtin_amdgcn_fence(__ATOMIC_RELEASE, "agent");
            asm volatile("s_waitcnt vmcnt(0)" ::: "memory");
            const unsigned og = xb_add(&bar[XB_TOP], 1u);
            const unsigned tg = og / nx;
            if (og + 1u == (tg + 1u) * nx) xb_add(&bar[XB_TOPGEN], 1u);
            else XB_SPIN(xb_ld(&bar[XB_TOPGEN]) == tg, bar);
            __builtin_amdgcn_fence(__ATOMIC_ACQUIRE, "agent");
            xb_add(&bar[XB_XGEN(b.x)], 1u);
            asm volatile("s_waitcnt vmcnt(0)" ::: "memory");
        } else {
            XB_SPIN(xb_ld(&bar[XB_XGEN(b.x)]) == gen, bar);
            __builtin_amdgcn_fence(__ATOMIC_ACQUIRE, "agent");
            asm volatile("s_waitcnt vmcnt(0)" ::: "memory");
        }
    }
    __syncthreads();
}

struct Params { const float* in[25]; float* out; unsigned char* ws; int ph_lo, ph_hi; };
enum { I_X = 0, I_P, I_GMIX, I_WIN, I_MQN, I_MKN, I_QLATN, I_WUQ, I_KVLATN, I_WUKV, I_MLAQN, I_MLAKN, I_WA, I_WB, I_WO, I_GFFN, I_WR, I_BR, I_WGU, I_BGU, I_WD, I_BD, I_GPLE, I_WPG, I_WPP };
constexpr int NPHASE = 16;

struct Frame {
    LAS unsigned char* lds; int vcu, G, wave;
    const Params* P; unsigned char* ws;
};
struct Ids { int tid, lane, wave; };
#define PHASE_IDS() Ids I_; { int l_ = lane_id(); asm volatile("" : "+v"(l_)); I_.lane = l_; I_.wave = F.wave; I_.tid = F.wave * 64 + l_; }

#ifdef SKPROBE
#define STAMPB(k) do { if ((k) == SKPROBE && F.wave == 0 && lane_id() == 0) { asm volatile("s_waitcnt vmcnt(0)" ::: "memory"); ((volatile unsigned long long*)(ws + WS_ERR + 16384))[blockIdx.x] = __builtin_amdgcn_s_memrealtime(); } } while (0)
#else
#define STAMPB(k) do {} while (0)
#endif
#ifdef TPROBE_A
#define STAMP(k) do { if (blockIdx.x == 0 && F.wave == 0 && lane_id() == 0) ((volatile unsigned long long*)(ws + WS_ERR))[k] = __builtin_amdgcn_s_memrealtime(); } while (0)
#else
#define STAMP(k) do {} while (0)
#endif
__device__ __forceinline__ int rowmap(int mode, int c) {
    if (mode == 1) {
        if (c < 1024) { const int base = c & 512, s_ = c & 511, h = s_ >> 6, d = s_ & 63; return base + 256 * (h >> 2) + 128 * (d >> 5) + 32 * (h & 3) + (d & 31); }
        return c < 1952 ? c : c + 96; }
    if (mode == 2) return c < 1024 ? 256 * (c >> 7) + (c & 127) : 256 * ((c - 1024) >> 7) + 128 + ((c - 1024) & 127);
    if (mode == 3) {
        const int h = c / 96, d = c % 96; int t;
        if (d < 64) t = d; else if (d < 80) { const int i = d - 64; t = 64 + 8 * (i >> 2) + (i & 3); } else { const int i = d - 80; t = 64 + 8 * (i >> 2) + 4 + (i & 3); }
        return 128 * h + t; }
    return c;
}
__device__ __forceinline__ void tr_item64(const float* W, int ldw, int N, int k0, int n0, bf16_t* dst, int ldd, int mode, LAS float* scr, int lane, const unsigned& qnv, int& qnxt) {
    const int r = lane >> 4, c4 = lane & 15; const bool inb = (n0 + 4 * c4) < N;
    f32x4 v[16];
#pragma unroll
    for (int i = 0; i < 16; ++i) v[i] = inb ? __builtin_nontemporal_load((const f32x4*)(W + (size_t)(k0 + 4 * i + r) * ldw + n0 + 4 * c4)) : (f32x4){0.f, 0.f, 0.f, 0.f};
#pragma unroll
    for (int i = 0; i < 16; ++i) { LAS float* p = scr + (4 * i + r) * 65 + 4 * c4; p[0] = v[i].x; p[1] = v[i].y; p[2] = v[i].z; p[3] = v[i].w; }
    asm volatile("s_waitcnt lgkmcnt(0)" ::: "memory");
    qnxt = (int)__builtin_amdgcn_readfirstlane(qnv);
    const int c = lane & 7;
#pragma unroll
    for (int j = 0; j < 8; ++j) { const int n = (lane >> 3) + 8 * j; const LAS float* sp = scr + (8 * c) * 65 + n;
        u32x4 o; o.x = cvt_pk_bf16(sp[0 * 65], sp[1 * 65]); o.y = cvt_pk_bf16(sp[2 * 65], sp[3 * 65]); o.z = cvt_pk_bf16(sp[4 * 65], sp[5 * 65]); o.w = cvt_pk_bf16(sp[6 * 65], sp[7 * 65]);
        if (n0 + n < N) *(u32x4*)(dst + (size_t)rowmap(mode, n0 + n) * ldd + k0 + 8 * c) = o; }
    asm volatile("s_waitcnt lgkmcnt(0)" ::: "memory");
}

__device__ __forceinline__ void tr_item_f8(const float* W, int ldw, int k0, int n0, unsigned char* dst, int ldd, int mode, LAS float* scr, int lane, const unsigned& qnv, int& qnxt) {
    const int r = lane >> 3, c4 = lane & 7;
    f32x4 v[16];
#pragma unroll
    for (int i = 0; i < 16; ++i) v[i] = __builtin_nontemporal_load((const f32x4*)(W + (size_t)(k0 + 8 * i + r) * ldw + n0 + 4 * c4));
#pragma unroll
    for (int i = 0; i < 16; ++i) { LAS float* p = scr + (8 * i + r) * 33 + 4 * c4; p[0] = v[i].x * 64.f; p[1] = v[i].y * 64.f; p[2] = v[i].z * 64.f; p[3] = v[i].w * 64.f; }
    asm volatile("s_waitcnt lgkmcnt(0)" ::: "memory");
    qnxt = (int)__builtin_amdgcn_readfirstlane(qnv);
    const int c = lane & 7;
#pragma unroll
    for (int j = 0; j < 4; ++j) { const int n = (lane >> 3) + 8 * j; const LAS float* sp = scr + (16 * c) * 33 + n;
        u32x4 o; o.x = pack4_fp8(sp[0 * 33], sp[1 * 33], sp[2 * 33], sp[3 * 33]); o.y = pack4_fp8(sp[4 * 33], sp[5 * 33], sp[6 * 33], sp[7 * 33]);
        o.z = pack4_fp8(sp[8 * 33], sp[9 * 33], sp[10 * 33], sp[11 * 33]); o.w = pack4_fp8(sp[12 * 33], sp[13 * 33], sp[14 * 33], sp[15 * 33]);
        *(u32x4*)(dst + (size_t)rowmap(mode, n0 + n) * ldd + k0 + 16 * c) = o; }
    asm volatile("s_waitcnt lgkmcnt(0)" ::: "memory");
}

__device__ __forceinline__ void phase0(Frame& F) {
    PHASE_IDS();
    const Params& P = *F.P; unsigned char* ws = F.ws;
    LAS float* scr = (LAS float*)(F.lds + I_.wave * 16896);
    const int gw = F.vcu * NWAVES + I_.wave, NGW = F.G * NWAVES;
    constexpr int I_GU = 32 * 8 * 64, I_DN = 32 * 8 * 32, I_IN = 8 * 61, I_ING = 8 * 64, I_UQ = 4 * 12, I_UKV = 2 * 16, I_A = 8 * 16, I_O = 16 * 16, I_PP = 4 * 16;
    constexpr int I_PG = 8 * 32;
    constexpr int NITEMS = I_GU + I_DN + I_IN + I_ING + I_UQ + I_UKV + 2 * I_A + I_O + I_PG + I_PP;
    constexpr int RPI = CONV_IN_ATTN ? 8 : 4, NRMS = NTOK / RPI, NPB = CONV_IN_ATTN ? 0 : NTOK * 256 / 4 / 1024, QSKIP = CONV_IN_ATTN ? I_GU + I_DN : 0, NALL = NITEMS - QSKIP + NRMS + NPB, NGROUPS = NALL / 8;
    static_assert(NALL % 8 == 0, "groups of 8 items");
    const f32x4* gp = (const f32x4*)P.in[I_GMIX] + I_.lane;
    unsigned nv = 0u; int nxt = 0;
    for (int t = 0; t < (NGROUPS + 255) / 256; ++t) {
        const int g = F.vcu + 256 * t; if (g >= NGROUPS) break;
        int r = g * 8 + I_.wave + QSKIP;
        do {
        if (r < I_GU) { const int e = r >> 9, q = r & 511, kb = q >> 6, g = q & 63;
            tr_item_f8(P.in[I_WGU] + (size_t)e * 1024 * 2048, 2048, 128 * kb, 32 * g, ws + WS_W1 + (size_t)e * 2048 * 1024, 1024, 2, scr, I_.lane, nv, nxt); continue; } r -= I_GU;
        if (r < I_DN) { const int e = r >> 8, q = r & 255, kb = q >> 5, g = q & 31;
            tr_item_f8(P.in[I_WD] + (size_t)e * 1024 * 1024, 1024, 128 * kb, 32 * g, ws + WS_W2 + (size_t)e * 1024 * 1024, 1024, 0, scr, I_.lane, nv, nxt); continue; } r -= I_DN;
        if (r < I_IN) { const int kb = r / 61, g = r % 61; tr_item_f8(P.in[I_WIN], DIN, 128 * kb, 32 * g, ws + WS_WIN, 1024, 1, scr, I_.lane, nv, nxt); continue; } r -= I_IN;
        if (r < I_ING) { const int kb = r >> 6, g = r & 63; tr_item_f8(P.in[I_WIN] + 1952, DIN, 128 * kb, 32 * g, ws + WS_WINF8, 1024, 0, scr, I_.lane, nv, nxt); continue; } r -= I_ING;
        if (r < I_UQ) { const int kb = r / 12, g = r % 12; tr_item64(P.in[I_WUQ], 768, 768, 64 * kb, 64 * g, (bf16_t*)(ws + WS_WUQ), 256, 3, scr, I_.lane, nv, nxt); continue; } r -= I_UQ;
        if (r < I_UKV) { const int kb = r / 16, g = r % 16; tr_item64(P.in[I_WUKV], 1024, 1024, 64 * kb, 64 * g, (bf16_t*)(ws + WS_WUKV), 128, 0, scr, I_.lane, nv, nxt); continue; } r -= I_UKV;
        if (r < I_A) { const int kb = r >> 5, g = r & 31; tr_item_f8(P.in[I_WA], 1024, 128 * kb, 32 * g, ws + WS_WA, 512, 0, scr, I_.lane, nv, nxt); continue; } r -= I_A;
        if (r < I_A) { const int kb = r >> 5, g = r & 31; tr_item_f8(P.in[I_WB], 1024, 128 * kb, 32 * g, ws + WS_WB, 512, 0, scr, I_.lane, nv, nxt); continue; } r -= I_A;
        if (r < I_PG) { const int kb = r >> 5, g = r & 31; tr_item_f8(P.in[I_WO], 1024, 128 * kb, 32 * g, ws + WS_WO, 1024, 0, scr, I_.lane, nv, nxt); continue; } r -= I_PG;
        if (r < I_PG) { const int kb = r >> 5, g = r & 31; tr_item_f8(P.in[I_WPG], 1024, 128 * kb, 32 * g, ws + WS_WPG, 1024, 0, scr, I_.lane, nv, nxt); continue; } r -= I_PG;
        if (r < I_PP) { const int kb = r / 16, g = r % 16; tr_item64(P.in[I_WPP], 1024, 1024, 64 * kb, 64 * g, (bf16_t*)(ws + WS_WPP), 256, 0, scr, I_.lane, nv, nxt); continue; } r -= I_PP;
        if (r < NRMS) {
            const int m0 = r * RPI; f32x4 v[RPI][4], gv[4];
#pragma unroll
            for (int q = 0; q < RPI; ++q) { const f32x4* xr = (const f32x4*)(P.in[I_X] + (size_t)(m0 + q) * DM) + I_.lane;
#pragma unroll
                for (int j = 0; j < 4; ++j) v[q][j] = __builtin_nontemporal_load(xr + 64 * j); }
#pragma unroll
            for (int j = 0; j < 4; ++j) gv[j] = gp[64 * j];
            asm volatile("s_waitcnt vmcnt(0)" ::: "memory"); nxt = (int)__builtin_amdgcn_readfirstlane(nv);
#pragma unroll
            for (int q = 0; q < RPI; ++q) { float s_ = 0.f;
#pragma unroll
                for (int j = 0; j < 4; ++j) s_ += (v[q][j].x * v[q][j].x + v[q][j].y * v[q][j].y) + (v[q][j].z * v[q][j].z + v[q][j].w * v[q][j].w);
                const float rstd = 1.0f / sqrtf(wave_sum(s_) * (1.f / DM) + EPS);
                unsigned* o4 = (unsigned*)(ws + WS_HNF8 + (size_t)(m0 + q) * DM) + I_.lane;
#pragma unroll
                for (int j = 0; j < 4; ++j) { const f32x4 y = v[q][j] * rstd * gv[j]; o4[64 * j] = pack4_fp8(y.x, y.y, y.z, y.w); } }
            continue; } r -= NRMS;
#if !CONV_IN_ATTN
        {
            const f32x4* pp = (const f32x4*)P.in[I_P] + (size_t)r * 1024 + I_.lane; u32x2* po = (u32x2*)(ws + WS_PB) + (size_t)r * 1024 + I_.lane; f32x4 v[16];
#pragma unroll
            for (int q = 0; q < 16; ++q) v[q] = __builtin_nontemporal_load(pp + 64 * q);
            asm volatile("s_waitcnt vmcnt(0)" ::: "memory"); nxt = (int)__builtin_amdgcn_readfirstlane(nv);
#pragma unroll
            for (int q = 0; q < 16; ++q) po[64 * q] = (u32x2){cvt_pk_bf16(v[q].x, v[q].y), cvt_pk_bf16(v[q].z, v[q].w)}; }
#endif
        } while (0);
    }
    STAMP(28); STAMPB(100);
    STAMP(21); STAMPB(101);
    { float* km = (float*)(ws + WS_KMEAN); for (int i = F.vcu * NTHREADS + I_.tid; i < 8 * 8 * 8 * 64; i += F.G * NTHREADS) km[i] = 0.f; }
    STAMP(29);
    { float* tab = (float*)(ws + WS_ROPE);
        const int i = F.vcu * NTHREADS + I_.tid;
        if (i < 48) { const int half = i < 32 ? 32 : 16, j = i < 32 ? i : i - 32; tab[196608 + i] = powf(10000.0f, -((float)j / (float)half)) * 0.15915494309189535f; } }
}

__device__ __forceinline__ void phase2(Frame& F) {
    PHASE_IDS();
    const Params& P = *F.P; unsigned char* ws = F.ws;
    const bf16_t* PROJ = (const bf16_t*)(ws + WS_PROJ);
    const float* cosA = (const float*)(ws + WS_ROPE); const float* sinA = cosA + 65536;
    LAS float* kst = (LAS float*)F.lds;
    LAS float* part = kst + 256 * 68;
    for (int it = F.vcu; it < 512; it += F.G) {
        const int b = it >> 6, blk = (it >> 3) & 7, h = it & 7;
        const int sel = I_.lane >> 5, r = I_.wave * 32 + (I_.lane & 31); const int pos = blk * 256 + r; const size_t row = (size_t)b * SEQ + pos;
        const u32x4* src = (const u32x4*)(PROJ + row * DINP + (sel ? PC_KA : PC_QA) + h * 64);
        u32x4 raw[8];
#pragma unroll
        for (int c = 0; c < 8; ++c) raw[c] = src[c];
        float ss = 0.f;
#pragma unroll
        for (int c = 0; c < 8; ++c) { f32x4 a0, a1; pg8::unpack8(raw[c], a0, a1); ss += (a0[0] * a0[0] + a0[1] * a0[1]) + (a0[2] * a0[2] + a0[3] * a0[3]) + (a1[0] * a1[0] + a1[1] * a1[1]) + (a1[2] * a1[2] + a1[3] * a1[3]); }
        const float rstd = 1.0f / sqrtf(ss * (1.f / 64.f) + EPS);
        const float* gn = sel ? P.in[I_MKN] : P.in[I_MQN];
        const float sc = sel ? 1.0f : C2A;
        bf16_t* dst = (bf16_t*)(ws + (sel ? WS_KA2 : WS_QA2)) + row * 512 + h * 64;
#pragma unroll
        for (int c = 0; c < 4; ++c) { f32x4 x1a, x1b, x2a, x2b; pg8::unpack8(raw[c], x1a, x1b); pg8::unpack8(raw[c + 4], x2a, x2b);
            const f32x4 g1a = *(const f32x4*)(gn + 8 * c), g1b = *(const f32x4*)(gn + 8 * c + 4), g2a = *(const f32x4*)(gn + 32 + 8 * c), g2b = *(const f32x4*)(gn + 36 + 8 * c);
            x1a = x1a * g1a * rstd; x1b = x1b * g1b * rstd; x2a = x2a * g2a * rstd; x2b = x2b * g2b * rstd;
            const f32x4 ca = *(const f32x4*)(cosA + pos * 32 + 8 * c), cb = *(const f32x4*)(cosA + pos * 32 + 8 * c + 4), sa = *(const f32x4*)(sinA + pos * 32 + 8 * c), sb = *(const f32x4*)(sinA + pos * 32 + 8 * c + 4);
            const f32x4 y1a = x1a * ca - x2a * sa, y1b = x1b * cb - x2b * sb, y2a = x2a * ca + x1a * sa, y2b = x2b * cb + x1b * sb;
            *(u32x4*)(dst + 8 * c) = pg8::pack8(y1a * sc, y1b * sc); *(u32x4*)(dst + 32 + 8 * c) = pg8::pack8(y2a * sc, y2b * sc);
            if (sel) { LAS f32x4* kr = (LAS f32x4*)(kst + r * 68); kr[2 * c] = y1a; kr[2 * c + 1] = y1b; kr[8 + 2 * c] = y2a; kr[8 + 2 * c + 1] = y2b; } }
        __syncthreads();
        { const int d = I_.tid & 63, pt = I_.tid >> 6; float s = 0.f;
#pragma unroll 8
            for (int rr = 0; rr < 32; ++rr) s += kst[(pt * 32 + rr) * 68 + d];
            part[pt * 64 + d] = s; }
        __syncthreads();
        if (I_.tid < 64) { float s = 0.f;
#pragma unroll
            for (int pt = 0; pt < 8; ++pt) s += part[pt * 64 + I_.tid];
            ((float*)(ws + WS_KMEAN))[(((size_t)b * 8 + h) * 8 + blk) * 64 + I_.tid] = s * (1.f / 256.f); }
        __syncthreads();
    }
    const int gw = F.vcu * NWAVES + I_.wave, NGW = F.G * NWAVES;
    const f32x4 gq = ((const f32x4*)P.in[I_QLATN])[I_.lane]; const f32x2 gk = ((const f32x2*)P.in[I_KVLATN])[I_.lane];
    for (int m0 = gw * 8; m0 < NTOK; m0 += NGW * 8) {
        u32x2 wq[8]; unsigned wk[8];
#pragma unroll
        for (int q = 0; q < 8; ++q) { wq[q] = *((const u32x2*)(PROJ + (size_t)(m0 + q) * DINP + PC_CQ) + I_.lane); wk[q] = *((const unsigned*)(PROJ + (size_t)(m0 + q) * DINP + PC_CKV) + I_.lane); }
#pragma unroll
        for (int r = 0; r < 8; ++r) { const int m = m0 + r;
            const f32x4 q = {bflo(wq[r].x), bfhi(wq[r].x), bflo(wq[r].y), bfhi(wq[r].y)}; const f32x2 k = {bflo(wk[r]), bfhi(wk[r])};
            const float sq = wave_sum((q.x * q.x + q.y * q.y) + (q.z * q.z + q.w * q.w)), sk = wave_sum(k.x * k.x + k.y * k.y);
            const float rq = 1.0f / sqrtf(sq * (1.f / 256.f) + EPS), rk = 1.0f / sqrtf(sk * (1.f / 128.f) + EPS);
            const f32x4 yq = q * rq * gq; const f32x2 yk = k * rk * gk;
            *((u32x2*)((bf16_t*)(ws + WS_CQN) + (size_t)m * 256) + I_.lane) = (u32x2){cvt_pk_bf16(yq.x, yq.y), cvt_pk_bf16(yq.z, yq.w)};
            *((unsigned*)((bf16_t*)(ws + WS_CKVN) + (size_t)m * 128) + I_.lane) = cvt_pk_bf16(yk.x, yk.y); }
    }
}

__device__ __forceinline__ void phase4(Frame& F) {
    PHASE_IDS();
    const Params& P = *F.P; unsigned char* ws = F.ws;
    const bf16_t* PROJ = (const bf16_t*)(ws + WS_PROJ);
    const float* cosB = (const float*)(ws + WS_ROPE) + 131072; const float* sinB = cosB + 32768;
    const int gw = F.vcu * NWAVES + I_.wave, NGW = F.G * NWAVES;
    for (int it = gw; it < (NTOK / 64) * 16; it += NGW) {
        const int h = it & 7, sel = (it >> 3) & 1, rg = it >> 4; const size_t row = (size_t)rg * 64 + I_.lane; const int pos = (int)(row & (SEQ - 1));
        u32x4 raw[12];
        bf16_t* qrow = (bf16_t*)(ws + WS_QB) + row * 768 + h * 96;
        if (sel == 0) {
#pragma unroll
            for (int c = 0; c < 12; ++c) raw[c] = *(const u32x4*)(qrow + 8 * c);
        } else {
            const bf16_t* kn = (const bf16_t*)(ws + WS_KV) + row * 1024 + h * 128; const bf16_t* kp = PROJ + row * DINP + PC_KPE;
#pragma unroll
            for (int c = 0; c < 8; ++c) raw[c] = *(const u32x4*)(kn + 8 * c);
#pragma unroll
            for (int c = 0; c < 4; ++c) raw[8 + c] = *(const u32x4*)(kp + 8 * c);
        }
        float ss = 0.f;
#pragma unroll
        for (int c = 0; c < 12; ++c) { f32x4 a0, a1; pg8::unpack8(raw[c], a0, a1); ss += (a0[0] * a0[0] + a0[1] * a0[1]) + (a0[2] * a0[2] + a0[3] * a0[3]) + (a1[0] * a1[0] + a1[1] * a1[1]) + (a1[2] * a1[2] + a1[3] * a1[3]); }
        const float rstd = 1.0f / sqrtf(ss * (1.f / 96.f) + EPS);
        const float* gn = sel ? P.in[I_MLAKN] : P.in[I_MLAQN];
        const float sc = sel ? 1.0f : C2B; const float rs = rstd * sc;
        bf16_t* dst = sel ? (bf16_t*)(ws + WS_KB2) + row * 768 + h * 96 : qrow;
#pragma unroll
        for (int c = 0; c < 8; ++c) { f32x4 a0, a1; pg8::unpack8(raw[c], a0, a1); const f32x4 g0 = *(const f32x4*)(gn + 8 * c), g1 = *(const f32x4*)(gn + 8 * c + 4);
            *(u32x4*)(dst + 8 * c) = pg8::pack8(a0 * g0 * rs, a1 * g1 * rs); }
#pragma unroll
        for (int c = 0; c < 2; ++c) { f32x4 x1a, x1b, x2a, x2b; pg8::unpack8(raw[8 + c], x1a, x1b); pg8::unpack8(raw[10 + c], x2a, x2b);
            const f32x4 g1a = *(const f32x4*)(gn + 64 + 8 * c), g1b = *(const f32x4*)(gn + 68 + 8 * c), g2a = *(const f32x4*)(gn + 80 + 8 * c), g2b = *(const f32x4*)(gn + 84 + 8 * c);
            x1a = x1a * g1a * rs; x1b = x1b * g1b * rs; x2a = x2a * g2a * rs; x2b = x2b * g2b * rs;
            const f32x4 ca = *(const f32x4*)(cosB + pos * 16 + 8 * c), cb = *(const f32x4*)(cosB + pos * 16 + 8 * c + 4), sa = *(const f32x4*)(sinB + pos * 16 + 8 * c), sb = *(const f32x4*)(sinB + pos * 16 + 8 * c + 4);
            *(u32x4*)(dst + 64 + 8 * c) = pg8::pack8(x1a * ca - x2a * sa, x1b * cb - x2b * sb);
            *(u32x4*)(dst + 80 + 8 * c) = pg8::pack8(x2a * ca + x1a * sa, x2b * cb + x1b * sb); }
    }
}

__device__ __forceinline__ void tr_load_f8(const float* W, int ldw, int k0, int n0, int lane, f32x4 (&v)[16]) {
    const int r = lane >> 3, c4 = lane & 7;
#pragma unroll
    for (int i = 0; i < 16; ++i) v[i] = __builtin_nontemporal_load((const f32x4*)(W + (size_t)(k0 + 8 * i + r) * ldw + n0 + 4 * c4));
}
__device__ __forceinline__ void tr_body_f8(const f32x4 (&v)[16], int k0, int n0, unsigned char* dst, int ldd, int mode, LAS float* scr, int lane) {
    const int r = lane >> 3, c4 = lane & 7;
#pragma unroll
    for (int i = 0; i < 16; ++i) { LAS float* p = scr + (8 * i + r) * 33 + 4 * c4; p[0] = v[i].x * 64.f; p[1] = v[i].y * 64.f; p[2] = v[i].z * 64.f; p[3] = v[i].w * 64.f; }
    asm volatile("s_waitcnt lgkmcnt(0)" ::: "memory");
    const int c = lane & 7;
#pragma unroll
    for (int j = 0; j < 4; ++j) { const int n = (lane >> 3) + 8 * j; const LAS float* sp = scr + (16 * c) * 33 + n;
        u32x4 o; o.x = pack4_fp8(sp[0 * 33], sp[1 * 33], sp[2 * 33], sp[3 * 33]); o.y = pack4_fp8(sp[4 * 33], sp[5 * 33], sp[6 * 33], sp[7 * 33]);
        o.z = pack4_fp8(sp[8 * 33], sp[9 * 33], sp[10 * 33], sp[11 * 33]); o.w = pack4_fp8(sp[12 * 33], sp[13 * 33], sp[14 * 33], sp[15 * 33]);
        __builtin_nontemporal_store(o, (u32x4*)(dst + (size_t)rowmap(mode, n0 + n) * ldd + k0 + 16 * c)); }
    asm volatile("s_waitcnt lgkmcnt(0)" ::: "memory");
}
__device__ __forceinline__ void conv_slot(Frame& F) {
    PHASE_IDS();
    const Params& P = *F.P; unsigned char* ws = F.ws;
    LAS float* scr = (LAS float*)(F.lds + I_.wave * 16896);
    const int e = F.vcu >> 3, kb = F.vcu & 7;
    const float* W1s = P.in[I_WGU] + (size_t)e * 1024 * 2048; unsigned char* D1 = ws + WS_W1 + (size_t)e * 2048 * 1024;
    const float* W2s = P.in[I_WD] + (size_t)e * 1024 * 1024;  unsigned char* D2 = ws + WS_W2 + (size_t)e * 1024 * 1024;
    const f32x4* pp = (const f32x4*)P.in[I_P] + (size_t)F.vcu * 4096 + I_.wave * 512 + I_.lane; u32x2* po = (u32x2*)(ws + WS_PB) + (size_t)F.vcu * 4096 + I_.wave * 512 + I_.lane; f32x4 pv[8];
#pragma unroll
    for (int q = 0; q < 8; ++q) pv[q] = __builtin_nontemporal_load(pp + 64 * q);
#pragma unroll 1
    for (int it0 = 0; it0 < 12; it0 += CONV_DEPTH) { f32x4 v[CONV_DEPTH][16];
#pragma unroll
        for (int u = 0; u < CONV_DEPTH; ++u) { const int it = it0 + u; const bool gu = it < 8;
            tr_load_f8(gu ? W1s : W2s, gu ? 2048 : 1024, 128 * kb, 32 * (8 * (gu ? it : it - 8) + I_.wave), I_.lane, v[u]); }
#pragma unroll
        for (int u = 0; u < CONV_DEPTH; ++u) { const int it = it0 + u; const bool gu = it < 8;
            tr_body_f8(v[u], 128 * kb, 32 * (8 * (gu ? it : it - 8) + I_.wave), gu ? D1 : D2, 1024, gu ? 2 : 0, scr, I_.lane); } }
#pragma unroll
    for (int q = 0; q < 8; ++q) po[64 * q] = (u32x2){cvt_pk_bf16(pv[q].x, pv[q].y), cvt_pk_bf16(pv[q].z, pv[q].w)};
    __syncthreads();
}
__device__ __forceinline__ void phase5(Frame& F) {
    unsigned char* ws = F.ws;
    const int cls = CONV_IN_ATTN ? ((F.vcu >> 2) & 3) : -1;
    for (int it = F.vcu; it < 256; it += F.G) {
        const int bh = it >> 2, sidx = it & 3, b = bh >> 3, h = bh & 7;
#pragma unroll 1
        for (int k = 0; k < 2; ++k) { const int qb = k ? 7 - sidx : sidx; if (cls == k) conv_slot(F);
            att::attn_unit<64, true>(b, qb, (const bf16_t*)(ws + WS_QA2) + h * 64, 512, (const bf16_t*)(ws + WS_KA2) + h * 64, 512, (const bf16_t*)(ws + WS_PROJ) + PC_VA + h * 64, DINP,
                                     ws + WS_Y + h * 64, 1024, (const float*)(ws + WS_KMEAN) + (size_t)bh * 512, F.lds, F.wave); }
#pragma unroll 1
        for (int k = 0; k < 2; ++k) { const int qb = k ? 7 - sidx : sidx; if (cls == 2 + k) conv_slot(F);
            att::attn_unit<96, false>(b, qb, (const bf16_t*)(ws + WS_QB) + h * 96, 768, (const bf16_t*)(ws + WS_KB2) + h * 96, 768, (const bf16_t*)(ws + WS_KV) + h * 128 + 64, 1024,
                                      ws + WS_Y + 512 + h * 64, 1024, nullptr, F.lds, F.wave); }
    }
}

__device__ __forceinline__ void phase8(Frame& F) {
    PHASE_IDS();
    const Params& P = *F.P; unsigned char* ws = F.ws;
    constexpr int HCS = 132, WCS = 48;
    LAS float* HC = (LAS float*)F.lds;
    LAS float* WC = HC + 2 * 64 * HCS;
    LAS float* RSTD = WC + 2 * 128 * WCS;
    LAS float* LOGIT = RSTD + 64;
    LAS int* pe = (LAS int*)(LOGIT + 64 * 33);
    int* PAIR_E = (int*)(ws + WS_PAIR); int* PAIR_RANK = PAIR_E + 65536; float* PAIR_W = (float*)(PAIR_E + 131072);
    const float* gffn = P.in[I_GFFN]; const float* wr_ = P.in[I_WR]; const float* br_ = P.in[I_BR];
    const int r0 = F.vcu * 64;
    STAMP(20);
    const int eg = I_.wave & 1, rgp = I_.wave >> 1, l15 = I_.lane & 15, l4 = I_.lane >> 4;
    const int srow = I_.tid >> 5, sc4 = I_.tid & 31;
    const int wrow = I_.tid >> 3, wc4 = I_.tid & 7;
    u32x2 raw[8][4]; f32x4 wraw[8][2], g4[8];
#pragma unroll
    for (int kc = 0; kc < 8; ++kc) {
#pragma unroll
        for (int i = 0; i < 4; ++i) raw[kc][i] = __builtin_nontemporal_load((const u32x2*)((const bf16_t*)(ws + WS_X1B) + (size_t)(r0 + srow + 16 * i) * DM + kc * 128 + 4 * sc4));
#pragma unroll
        for (int i = 0; i < 2; ++i) wraw[kc][i] = *(const f32x4*)(wr_ + (size_t)(kc * 128 + wrow + 64 * i) * 32 + 4 * wc4);
        g4[kc] = *(const f32x4*)(gffn + kc * 128 + 4 * sc4); }
    if (I_.tid < 64) { const f32x4* sp = (const f32x4*)((const float*)(ws + WS_SSP) + (size_t)(r0 + I_.tid) * 16); const f32x4 a = sp[0], b = sp[1], c = sp[2], d = sp[3];
        const float ss = (((a[0] + a[1]) + (a[2] + a[3])) + ((b[0] + b[1]) + (b[2] + b[3]))) + (((c[0] + c[1]) + (c[2] + c[3])) + ((d[0] + d[1]) + (d[2] + d[3])));
        RSTD[I_.tid] = 1.0f / sqrtf(ss * (1.f / DM) + EPS); }
    __syncthreads();
    STAMP(21);
    float rs4[4];
#pragma unroll
    for (int i = 0; i < 4; ++i) rs4[i] = RSTD[srow + 16 * i];
#define P8_STORE(kc, buf) do { _Pragma("unroll") for (int i = 0; i < 4; ++i) { const u32x2 w_ = raw[kc][i]; const f32x4 y = (f32x4){bflo(w_.x), bfhi(w_.x), bflo(w_.y), bfhi(w_.y)} * rs4[i] * g4[kc]; \
        *(LAS f32x4*)(HC + ((buf) * 64 + srow + 16 * i) * HCS + 4 * sc4) = y; *(unsigned*)(ws + WS_HNF8 + (size_t)(r0 + srow + 16 * i) * DM + (kc) * 128 + 4 * sc4) = pack4_fp8(y.x, y.y, y.z, y.w); } \
        _Pragma("unroll") for (int i = 0; i < 2; ++i) *(LAS f32x4*)(WC + ((buf) * 128 + wrow + 64 * i) * WCS + 4 * wc4) = wraw[kc][i]; } while (0)
    P8_STORE(0, 0);
    __syncthreads();
    f32x4 acc = {0.f, 0.f, 0.f, 0.f};
#pragma unroll
    for (int kc = 0; kc < 8; ++kc) { const int buf = kc & 1;
        const LAS float* wp = WC + (buf * 128 + l4) * WCS + eg * 16 + l15;
        const LAS float* hp = HC + (buf * 64 + rgp * 16 + l15) * HCS + l4;
#pragma unroll
        for (int kk = 0; kk < 32; ++kk) acc = __builtin_amdgcn_mfma_f32_16x16x4f32(wp[4 * kk * WCS], hp[4 * kk], acc, 0, 0, 0);
        if (kc + 1 < 8) P8_STORE(kc + 1, buf ^ 1);
        __syncthreads(); }
#undef P8_STORE
    STAMP(22);
#pragma unroll
    for (int i = 0; i < 4; ++i) { const int e = eg * 16 + 4 * l4 + i; LOGIT[(rgp * 16 + l15) * 33 + e] = acc[i] + br_[e]; }
    __syncthreads();
    if (I_.tid < 64) { const int rr = I_.tid, m = r0 + rr;
        float lg[32];
#pragma unroll
        for (int e = 0; e < 32; ++e) lg[e] = LOGIT[rr * 33 + e];
        int te[4]; float tv[4]; unsigned used = 0u;
#pragma unroll
        for (int k = 0; k < 4; ++k) { float best = -INFINITY; int bi = 0;
#pragma unroll
            for (int e = 0; e < 32; ++e) { const bool ok = !((used >> e) & 1u) && (lg[e] > best); best = ok ? lg[e] : best; bi = ok ? e : bi; }
            used |= 1u << bi; te[k] = bi; tv[k] = best; }
        const float e0 = 1.0f, e1 = __expf(tv[1] - tv[0]), e2 = __expf(tv[2] - tv[0]), e3 = __expf(tv[3] - tv[0]); const float inv = 1.0f / (e0 + e1 + e2 + e3);
        *(i32x4*)(PAIR_E + m * 4) = (i32x4){te[0], te[1], te[2], te[3]};
        *(f32x4*)(PAIR_W + m * 4) = (f32x4){e0 * inv, e1 * inv, e2 * inv, e3 * inv};
        *(LAS i32x4*)(pe + rr * 4) = (i32x4){te[0], te[1], te[2], te[3]}; }
    __syncthreads();
    STAMP(23);
    LAS int* wcnt = pe + 256;
    int e_ = 0, myrank = 0;
    if (I_.wave < 4) { e_ = pe[I_.tid]; int cntl = 0;
#pragma unroll
        for (int ee = 0; ee < 32; ++ee) { const unsigned long long m = __ballot(e_ == ee);
            const int below = (int)__builtin_amdgcn_mbcnt_hi((unsigned)(m >> 32), __builtin_amdgcn_mbcnt_lo((unsigned)m, 0u));
            myrank = (e_ == ee) ? below : myrank; cntl = (I_.lane == ee) ? (int)__builtin_popcountll(m) : cntl; }
        if (I_.lane < 32) wcnt[I_.wave * 32 + I_.lane] = cntl; }
    __syncthreads();
    if (I_.wave < 4) { int base = 0;
#pragma unroll
        for (int w2 = 0; w2 < 3; ++w2) base += (w2 < I_.wave) ? wcnt[w2 * 32 + e_] : 0;
        PAIR_RANK[r0 * 4 + I_.tid] = myrank + base; }
    else if (I_.tid < 288) { const int e = I_.tid - 256; ((int*)(ws + WS_HIST))[F.vcu * 32 + e] = (wcnt[e] + wcnt[32 + e]) + (wcnt[64 + e] + wcnt[96 + e]); }
    __syncthreads();
    STAMP(24);
}

__device__ __forceinline__ int moe_layout(Frame& F) {
    PHASE_IDS();
    LAS int* ctl = (LAS int*)(F.lds + LDS_CTL);
    LAS int* part = ctl + 512;
    const int* HIST = (const int*)(F.ws + WS_HIST);
    __syncthreads();
    { const int e = I_.tid & 31, pt = I_.tid >> 5; int tot = 0, before = 0; int c[16];
#pragma unroll
        for (int i = 0; i < 16; ++i) c[i] = HIST[(pt * 16 + i) * 32 + e];
#pragma unroll
        for (int i = 0; i < 16; ++i) { tot += c[i]; before += (pt * 16 + i < F.vcu) ? c[i] : 0; }
        part[pt * 64 + e] = tot; part[pt * 64 + 32 + e] = before; }
    __syncthreads();
    if (I_.tid < 32) { int tot = 0, before = 0;
#pragma unroll
        for (int pt = 0; pt < 16; ++pt) { tot += part[pt * 64 + I_.tid]; before += part[pt * 64 + 32 + I_.tid]; }
        ctl[I_.tid] = tot; ctl[65 + I_.tid] = before; }
    __syncthreads();
    if (I_.tid < 32) { const int e = I_.tid; const int nt_ = (ctl[e] + 255) >> 8; int sc = nt_;
#pragma unroll
        for (int o = 1; o < 32; o <<= 1) { const int up = __shfl_up(sc, o); sc += (e >= o) ? up : 0; }
        const int t0 = sc - nt_; ctl[32 + e] = t0 * 256; ctl[65 + e] += t0 * 256;
        for (int t = 0; t < nt_; ++t) ctl[128 + t0 + t] = e;
        if (e == 31) { ctl[64] = sc * 256; ctl[100] = sc; } }
    __syncthreads();
    return ctl[100];
}

__device__ __forceinline__ void phase9(Frame& F) {
    PHASE_IDS();
    unsigned char* ws = F.ws;
    const int* PAIR_E = (const int*)(ws + WS_PAIR); const int* PAIR_RANK = PAIR_E + 65536; int* ROWDEST = (int*)(ws + WS_PAIR) + 196608; int* TOK = (int*)(ws + WS_TOK);
    const int rows_per_blk = NTOK / F.G;
    const bool has = I_.tid < rows_per_blk * 4; const int gp = F.vcu * rows_per_blk * 4 + I_.tid;
    int e = 0, rk = 0; if (has) { e = PAIR_E[gp]; rk = PAIR_RANK[gp]; }
    moe_layout(F);
    LAS int* ctl = (LAS int*)(F.lds + LDS_CTL);
    if (has) { const int dest = ctl[65 + e] + rk; ROWDEST[gp] = dest; TOK[dest] = gp >> 2; }
    if (F.vcu < 32) { const int e = F.vcu; const int lo = ctl[32 + e] + ctl[e], hi = (e == 31) ? ctl[64] : ctl[33 + e];
        for (int r = lo + I_.tid; r < hi; r += NTHREADS) TOK[r] = 0; }
}

__device__ __forceinline__ void stage_tok(Frame& F, int nmt, int ntn, int per) {
    PHASE_IDS();
    const int* TOK = (const int*)(F.ws + WS_TOK); LAS unsigned short* tokl = (LAS unsigned short*)(F.lds + LDS_TOKL);
    for (int i = 0; i < 10; ++i) { const int j = (i * F.G + (int)blockIdx.x) >> 3; const int mt = pg8::moe_mt(j, ntn, per, (int)blockIdx.x, nmt); if (mt >= nmt) break;
        if (I_.tid < 256) tokl[i * 256 + I_.tid] = (unsigned short)TOK[mt * 256 + I_.tid]; }
    __syncthreads();
}

__device__ __forceinline__ void phase12(Frame& F) {
    PHASE_IDS();
    const Params& P = *F.P; unsigned char* ws = F.ws;
    const int gw = F.vcu * NWAVES + I_.wave, NGW = F.G * NWAVES;
    const float* PAIR_W = (const float*)(ws + WS_PAIR) + 131072; const int* ROWDEST = (const int*)(ws + WS_PAIR) + 196608;
    const bf16_t* YP = (const bf16_t*)(ws + WS_XG);
    const f32x4* gp = (const f32x4*)P.in[I_GPLE] + I_.lane; f32x4 gv[4];
#pragma unroll
    for (int j = 0; j < 4; ++j) gv[j] = gp[64 * j];
    for (int m0 = gw; m0 < NTOK; m0 += 2 * NGW) {
        int mm[2]; mm[0] = m0; mm[1] = (m0 + NGW < NTOK) ? m0 + NGW : m0;
        f32x4 wv[2]; i32x4 dv[2];
#pragma unroll
        for (int q = 0; q < 2; ++q) { wv[q] = *(const f32x4*)(PAIR_W + mm[q] * 4); dv[q] = *(const i32x4*)(ROWDEST + mm[q] * 4); }
        f32x4 v[2][4]; u32x2 y[2][4][4];
#pragma unroll
        for (int q = 0; q < 2; ++q) { const u32x2* xr = (const u32x2*)((const bf16_t*)(ws + WS_X1B) + (size_t)mm[q] * DM) + I_.lane;
#pragma unroll
            for (int j = 0; j < 4; ++j) { const u32x2 w_ = xr[64 * j]; v[q][j] = (f32x4){bflo(w_.x), bfhi(w_.x), bflo(w_.y), bfhi(w_.y)}; }
#pragma unroll
            for (int k = 0; k < 4; ++k) { const u32x2* yr = (const u32x2*)(YP + (size_t)dv[q][k] * DM) + I_.lane;
#pragma unroll
                for (int j = 0; j < 4; ++j) y[q][k][j] = __builtin_nontemporal_load(yr + 64 * j); } }
#pragma unroll
        for (int q = 0; q < 2; ++q) { if (q == 1 && mm[1] == mm[0]) break;
            float s = 0.f; u32x2* xw = (u32x2*)((bf16_t*)(ws + WS_X1B) + (size_t)mm[q] * DM) + I_.lane;
#pragma unroll
            for (int j = 0; j < 4; ++j) {
#pragma unroll
                for (int k = 0; k < 4; ++k) { const u32x2 yy = y[q][k][j]; v[q][j] += (f32x4){bflo(yy.x), bfhi(yy.x), bflo(yy.y), bfhi(yy.y)} * wv[q][k]; }
                xw[64 * j] = (u32x2){cvt_pk_bf16(v[q][j].x, v[q][j].y), cvt_pk_bf16(v[q][j].z, v[q][j].w)}; s += (v[q][j].x * v[q][j].x + v[q][j].y * v[q][j].y) + (v[q][j].z * v[q][j].z + v[q][j].w * v[q][j].w); }
            const float rstd = 1.0f / sqrtf(wave_sum(s) * (1.f / DM) + EPS);
            unsigned* o4 = (unsigned*)(ws + WS_HNF8 + (size_t)mm[q] * DM) + I_.lane;
#pragma unroll
            for (int j = 0; j < 4; ++j) { const f32x4 yo = v[q][j] * rstd * gv[j]; o4[64 * j] = pack4_fp8(yo.x, yo.y, yo.z, yo.w); } }
    }
}

__global__ void __launch_bounds__(NTHREADS, 2) fwd(Params prm) {
    extern __shared__ __attribute__((aligned(16))) unsigned char lds_raw[];
    Frame F;
    F.lds = (LAS unsigned char*)lds_raw;
    F.wave = __builtin_amdgcn_readfirstlane((int)threadIdx.x >> 6);
    if (threadIdx.x < 2) ((volatile LAS unsigned*)(F.lds + LDS_BARST))[threadIdx.x] = 0u;
    const XcdBarrier bar = xcd_barrier_post((unsigned*)(prm.ws + WS_BAR), (volatile LAS unsigned*)(F.lds + LDS_BARST), F.wave);
    if (prm.ph_lo < 0) cg::this_grid().sync();
    __syncthreads();
    F.G = gridDim.x; { const int bx = blockIdx.x; F.vcu = (F.G % 8 == 0) ? (bx % 8) * (F.G / 8) + bx / 8 : bx; }
    F.P = &prm; F.ws = prm.ws;
    unsigned char* ws = prm.ws;
    const int lo = prm.ph_lo, hi = prm.ph_hi;
#ifndef STAG12
#define STAG12 0
#endif
#ifndef PER12
#define PER12 8
#endif
#ifndef PH_MASK
#define PH_MASK 0xffffu
#endif
#ifndef REP_MASK
#define REP_MASK 0u
#endif
#define IN(k) (((PH_MASK >> (k)) & 1u) && lo <= (k) && (k) < hi)
#define REPS(k) for (int rep_ = 0; rep_ < (((REP_MASK >> (k)) & 1u) ? 2 : 1); ++rep_, (((REP_MASK >> (k)) & 1u) && rep_ < 2 ? xcd_barrier(bar) : (void)0))
#define SEAM(k) do { __builtin_amdgcn_sched_barrier(0); asm volatile("" ::: "memory"); STAMPB(k); if (IN(k) && IN((k) + 1)) xcd_barrier(bar); STAMP((k) + 1); __builtin_amdgcn_sched_barrier(0); asm volatile("" ::: "memory"); } while (0)
    using namespace pg8;
#ifdef XCDPROBE
    if (F.wave == 0 && lane_id() == 0) ((volatile unsigned*)(ws + WS_ERR + 4096))[blockIdx.x] = bar.x;
#endif
    STAMP(0); STAMPB(102);
    if (IN(0)) REPS(0) phase0(F);
    SEAM(0);
    if (IN(1)) REPS(1) {
        { Gemm g{(const bf16_t*)(ws + WS_HNF8), (const bf16_t*)(ws + WS_WIN), 512, 512, 512}; ProjOrder S; S.so.init(NTOK, 4096, F.G, (int)blockIdx.x);
          const float* cosA_ = (const float*)(ws + WS_ROPE);
          EpiProj E{(bf16_t*)(ws + WS_PROJ), (bf16_t*)(ws + WS_QA2), (bf16_t*)(ws + WS_KA2), (float*)(ws + WS_KMEAN), (bf16_t*)(ws + WS_CQN), (bf16_t*)(ws + WS_CKVN),
                    prm.in[I_MQN], prm.in[I_MKN], prm.in[I_QLATN], prm.in[I_KVLATN], cosA_, cosA_ + 65536, (LAS float*)(F.lds + LDS_TOKL), (float*)(ws + WS_KPESS)};
          gemm_phase<EpiProj, ProjOrder, false, true>(F.lds, F.wave, g, S, E); }
        }
    SEAM(1);
    if (IN(3)) REPS(3) {
        const float* cosB_ = (const float*)(ws + WS_ROPE) + 131072;
        { Gemm g{(const bf16_t*)(ws + WS_CQN), (const bf16_t*)(ws + WS_WUQ), 256, 256, 256}; StaticOrder S; S.init(NTOK, 1024, F.G, (int)blockIdx.x);
          EpiQB E{(bf16_t*)(ws + WS_QB), prm.in[I_MLAQN], cosB_, cosB_ + 32768, (LAS float*)(F.lds + LDS_CTL)}; gemm_phase(F.lds, F.wave, g, S, E); }
        __builtin_amdgcn_sched_barrier(0); asm volatile("" ::: "memory");
        { Gemm g{(const bf16_t*)(ws + WS_CKVN), (const bf16_t*)(ws + WS_WUKV), 128, 128, 128}; StaticOrder S; S.init(NTOK, 1024, F.G, (int)blockIdx.x);
          EpiKV E{(bf16_t*)(ws + WS_KB2), (bf16_t*)(ws + WS_KV), (const bf16_t*)(ws + WS_PROJ), (const float*)(ws + WS_KPESS), prm.in[I_MLAKN], cosB_, cosB_ + 32768, (LAS float*)(F.lds + LDS_CTL)};
          gemm_phase(F.lds, F.wave, g, S, E); } }
    SEAM(3);
    if (IN(5)) REPS(5) phase5(F);
    SEAM(5);
    if (IN(6)) REPS(6) { Gemm g{(const bf16_t*)(ws + WS_Y), (const bf16_t*)(ws + WS_WA), 512, 256, 256}; BranchOrder S; S.so.init(NTOK, DM, F.G, (int)blockIdx.x);
        EpiGateAB E{(bf16_t*)(ws + WS_MERGED), (const bf16_t*)(ws + WS_PROJ) + PC_GA, (const bf16_t*)(ws + WS_PROJ) + PC_GB, DINP, ws + WS_KA2  };
        gemm_phase<EpiGateAB, BranchOrder, false, true>(F.lds, F.wave, g, S, E); }
    SEAM(7);
    if (IN(8)) REPS(8) { Gemm g{(const bf16_t*)(ws + WS_KA2), (const bf16_t*)(ws + WS_WO), 512, 512, 512}; StaticOrder S; S.init(NTOK, DM, F.G, (int)blockIdx.x);
        EpiResF32 E{prm.in[I_X], (bf16_t*)(ws + WS_X1B), (float*)(ws + WS_SSP)}; gemm_phase<EpiResF32, StaticOrder, false, true>(F.lds, F.wave, g, S, E); }
    SEAM(8);
    if (IN(9)) REPS(9) phase8(F);
    SEAM(9);
    if (IN(10)) REPS(10) phase9(F);
    SEAM(10);
    if (IN(11)) REPS(11) { const int nmt = ((const LAS int*)(F.lds + LDS_CTL))[100]; stage_tok(F, nmt, 8, 4);
        Gemm g{(const bf16_t*)(ws + WS_HNF8), (const bf16_t*)(ws + WS_W1), 512, 512, 512}; MoeOrder S{(const LAS int*)(F.lds + LDS_CTL) + 128, nmt, 8, F.G, (int)blockIdx.x, 4};
        EpiSwiglu E{ws + WS_ACT, prm.in[I_BGU]}; gemm_phase<EpiSwiglu, MoeOrder, true, true>(F.lds, F.wave, g, S, E, (const LAS unsigned short*)(F.lds + LDS_TOKL)); }
    SEAM(11);
    if (IN(12)) REPS(12) { const int nmt = ((const LAS int*)(F.lds + LDS_CTL))[100];
        Gemm g{(const bf16_t*)(ws + WS_ACT), (const bf16_t*)(ws + WS_W2), 512, 512, 512}; MoeOrder S{(const LAS int*)(F.lds + LDS_CTL) + 128, nmt, 4, F.G, (int)blockIdx.x, PER12};
        EpiStoreBias E{(bf16_t*)(ws + WS_XG), DM, prm.in[I_BD], 1024};
#if STAG12 > 0
        { const int nmt_s = __builtin_amdgcn_readfirstlane(nmt), off = moe_mt(((int)blockIdx.x >> 3), 4, PER12, (int)blockIdx.x), n = nmt_s > off ? (nmt_s - off + 63) >> 6 : 0, nmax = (nmt_s * 4 + 255) >> 8;
          if (n > 0 && n < nmax) { const unsigned long long d = (unsigned long long)(((int)blockIdx.x >> 5) * STAG12), t0 = __builtin_amdgcn_s_memrealtime();
              while (__builtin_amdgcn_s_memrealtime() - t0 < d) __builtin_amdgcn_s_sleep(8); } }
#endif
        gemm_phase<EpiStoreBias, MoeOrder, false, true>(F.lds, F.wave, g, S, E); }
    SEAM(12);
    if (IN(13)) REPS(13) phase12(F);
    SEAM(13);
    if (IN(14)) REPS(14) { Gemm g{(const bf16_t*)(ws + WS_PB), (const bf16_t*)(ws + WS_WPP), 256, 256, 256}; StaticOrder S; S.init(NTOK, DM, F.G, (int)blockIdx.x);
        EpiStore E{(bf16_t*)(ws + WS_PP), DM, nullptr, 0, 1 << 30}; gemm_phase(F.lds, F.wave, g, S, E); }
    __builtin_amdgcn_sched_barrier(0); asm volatile("s_waitcnt vmcnt(0)" ::: "memory"); __syncthreads();
    if (IN(15)) REPS(15) { Gemm g{(const bf16_t*)(ws + WS_HNF8), (const bf16_t*)(ws + WS_WPG), 512, 512, 512}; StaticOrder S; S.init(NTOK, DM, F.G, (int)blockIdx.x);
        EpiFinal E{prm.out, (const bf16_t*)(ws + WS_PP), (const bf16_t*)(ws + WS_X1B)}; gemm_phase<EpiFinal, StaticOrder, false, true>(F.lds, F.wave, g, S, E); }
#ifdef XPROBE
    xcd_barrier(bar);
    { Gemm g{(const bf16_t*)(ws + (XPROBE == 2 ? WS_HNF8 : WS_W1)), (const bf16_t*)(ws + (XPROBE == 2 ? WS_WIN : WS_W1)), 512, 512, 512}; ProbeOrder S{XPROBE, F.G, (int)blockIdx.x, 8};
      EpiNone E{(float*)(ws + WS_ERR + 8192)}; gemm_phase<EpiNone, ProbeOrder, false, true>(F.lds, F.wave, g, S, E); }
#endif
#ifdef SKPROBE
    xcd_barrier(bar);
    if (blockIdx.x == 0 && F.wave == 0 && lane_id() == 0) {
        volatile unsigned long long* tb = (volatile unsigned long long*)(ws + WS_ERR + 16384); unsigned long long mx = 0ull, sum = 0ull;
        for (int c2 = 0; c2 < 256; ++c2) { const unsigned long long v = tb[c2]; mx = v > mx ? v : mx; sum += v; }
        const unsigned long long wt = SKMODE == 0 ? 4ull * (mx - sum / 256ull) : 0ull, t0 = __builtin_amdgcn_s_memrealtime();
        while (__builtin_amdgcn_s_memrealtime() - t0 < wt) __builtin_amdgcn_s_sleep(4);
    }
#endif
#ifdef XCDPROBE
    xcd_barrier(bar);
    if (blockIdx.x == 0 && F.wave == 0 && lane_id() == 0) {
        volatile unsigned* ids = (volatile unsigned*)(ws + WS_ERR + 4096); unsigned bad_same = 0, bad_id = 0;
        for (int c2 = 0; c2 < 256; ++c2) { const unsigned v = ids[c2]; bad_same += (v != ids[c2 & 7]) ? 1u : 0u; bad_id += (v != (unsigned)(c2 & 7)) ? 1u : 0u; }
        const unsigned long long wt = (bad_same ? 20000ull : 0ull) + (bad_id ? 10000ull : 0ull), t0 = __builtin_amdgcn_s_memrealtime();
        while (__builtin_amdgcn_s_memrealtime() - t0 < wt) __builtin_amdgcn_s_sleep(4);
    }
#endif
#ifdef TPROBE_A
    STAMP(16);
    xcd_barrier(bar);
    if (blockIdx.x == 0 && F.wave == 0 && lane_id() == 0) {
        volatile unsigned long long* ts = (volatile unsigned long long*)(ws + WS_ERR);
        const unsigned long long da = ts[TPROBE_A1] - ts[TPROBE_A], db = ts[TPROBE_B1] - ts[TPROBE_B];
        asm volatile("s_waitcnt vmcnt(0)" ::: "memory");
        prm.out[0] += (float)db * (0.01f / 4.0f);
        const unsigned long long t0 = __builtin_amdgcn_s_memrealtime();
        while (__builtin_amdgcn_s_memrealtime() - t0 < 4ull * da) __builtin_amdgcn_s_sleep(4);
    }
#endif
#undef IN
#undef SEAM
}

extern "C" void kernel_launch(void* const* d_in, const int* in_sizes, int n_in, void* d_out, int out_size, void* d_ws, size_t ws_size, hipStream_t stream) {
    static int grid = 0;
    if (grid == 0) {
        int dev = 0, cus = 0, per_cu = 0;
        (void)hipGetDevice(&dev);
        (void)hipDeviceGetAttribute(&cus, hipDeviceAttributeMultiprocessorCount, dev);
        (void)hipFuncSetAttribute((const void*)fwd, hipFuncAttributeMaxDynamicSharedMemorySize, LDS_BYTES);
        (void)hipOccupancyMaxActiveBlocksPerMultiprocessor(&per_cu, (const void*)fwd, NTHREADS, LDS_BYTES);
        fprintf(stderr, "cus %d per_cu %d ws %zu n_in %d\n", cus, per_cu, ws_size, n_in);
        grid = (per_cu >= 1) ? cus : -1;
        if (grid != 256 || n_in != 25 || ws_size < WS_END || out_size != NTOK * DM) { fprintf(stderr, "kernel_launch: unsupported configuration\n"); grid = -1; }
    }
    if (grid < 0) return;
    (void)hipMemsetAsync((char*)d_ws + WS_BAR, 0, WS_BAR_BYTES, stream);
    Params a{};
    for (int i = 0; i < 25; ++i) a.in[i] = (const float*)d_in[i];
    a.out = (float*)d_out; a.ws = (unsigned char*)d_ws;
#ifndef MULTI_LAUNCH
    a.ph_lo = 0; a.ph_hi = NPHASE;
    void* args[] = {&a};
    hipError_t e = hipLaunchCooperativeKernel((const void*)fwd, dim3(grid), dim3(NTHREADS), args, LDS_BYTES, stream);
    if (e != hipSuccess) fprintf(stderr, "cooperative launch failed: %s\n", hipGetErrorString(e));
#else
    for (int k = 0; k < NPHASE; ++k) { a.ph_lo = k; a.ph_hi = k + 1; void* args[] = {&a};
        hipError_t e = hipLaunchCooperativeKernel((const void*)fwd, dim3(grid), dim3(NTHREADS), args, LDS_BYTES, stream);
        if (e != hipSuccess) fprintf(stderr, "launch %d failed: %s\n", k, hipGetErrorString(e)); }
#endif
}
```
